# Optimizing an MI355X kernel written in HIP

```python
import jax, jax.numpy as jnp
from jax import lax
import numpy as np

D_MODEL = 1024
BATCH = 8
SEQ = 4096
DEPTH = 4

CHUNK = 64
N_MIXERS = 3
N_POOL_LAYERS = (DEPTH + 2) // 3
N_CONV_LAYERS = (DEPTH + 1) // 3
N_GMLP_LAYERS = DEPTH // 3
EPS = 1e-6

POOL_WINDOWS = (2, 4, 8, 16)
POOL_GROUP = D_MODEL // len(POOL_WINDOWS)

CONV_WIDTH = 3

GMLP_BLOCK = 128
GMLP_HALF = 3 * D_MODEL
GMLP_GROUPS = 8
GMLP_GROUP_DIM = GMLP_HALF // GMLP_GROUPS

PEER_HEADS = 8
PEER_NKEYS = 128
PEER_EXPERTS = PEER_NKEYS * PEER_NKEYS
PEER_DKEY = 256
PEER_DHALF = PEER_DKEY // 2
PEER_TOPK = 16
PEER_TOKEN_BLOCK = 128

kernel_name = "hybrid_pool_conv_gmlp_peer_trunk"


def rmsnorm(x, g):
    xf = x.astype(jnp.float32)
    y = xf * lax.rsqrt(jnp.mean(xf * xf, axis=-1, keepdims=True) + EPS)
    return (y * g.astype(jnp.float32)).astype(x.dtype)


def layernorm(x, g, b):
    xf = x.astype(jnp.float32)
    mu = jnp.mean(xf, axis=-1, keepdims=True)
    var = jnp.mean(jnp.square(xf - mu), axis=-1, keepdims=True)
    y = (xf - mu) * lax.rsqrt(var + EPS)
    return (y * g.astype(jnp.float32) + b.astype(jnp.float32)).astype(x.dtype)


def modulate(h, shift, scale):
    return h * (1 + scale[:, None, :]) + shift[:, None, :]


def pool_mixer(h, w_in, w_grp, scale, w_out):
    s = h.shape[1]
    u = h @ w_in
    cs = jnp.cumsum(u.astype(jnp.float32), axis=1)
    t = jnp.arange(1, s + 1, dtype=jnp.float32)[None, :, None]
    outs = []
    for g, w in enumerate(POOL_WINDOWS):
        lo, hi = g * POOL_GROUP, (g + 1) * POOL_GROUP
        cg = cs[..., lo:hi]
        lag = jnp.pad(cg, ((0, 0), (w, 0), (0, 0)))[:, :s]
        mean = (cg - lag) / jnp.minimum(t, float(w))
        p = mean.astype(u.dtype) - u[..., lo:hi]
        outs.append(p @ w_grp[g])
    z = jnp.concatenate(outs, axis=-1) * scale
    return z @ w_out


def conv_mixer(h, w_in, conv_w, w_out):
    bg, cg, xt = jnp.split(h @ w_in, 3, axis=-1)
    z = cg * xt
    zc = lax.conv_general_dilated(
        z, conv_w[:, None, :].astype(z.dtype),
        window_strides=(1,), padding=[(CONV_WIDTH - 1, 0)],
        dimension_numbers=('NWC', 'WIO', 'NWC'),
        feature_group_count=D_MODEL)
    return (bg * zc) @ w_out


def gmlp_mixer(h, w_in, ln_g, ln_b, w_s, b_s, w_out):
    b, s, _ = h.shape
    z = jax.nn.gelu(h @ w_in)
    u, v = jnp.split(z, 2, axis=-1)
    v = layernorm(v, ln_g, ln_b)
    v = v.reshape(b, s // GMLP_BLOCK, GMLP_BLOCK, GMLP_GROUPS, GMLP_GROUP_DIM)
    pos = jnp.arange(GMLP_BLOCK) // CHUNK
    mask = pos[None, :] <= pos[:, None]
    ws = jnp.where(mask[None], w_s, jnp.zeros_like(w_s))
    vs = jnp.einsum('gij,bnjgc->bnigc', ws, v) + b_s.T[None, None, :, :, None]
    return (u * vs.reshape(b, s, GMLP_HALF)) @ w_out


def peer_ffn(h, w_q, keys, u_tab, v_tab):
    b, s, d = h.shape

    def one_block(hb):
        t = hb.shape[0]
        q = (hb @ w_q).reshape(t, PEER_HEADS, 2, PEER_DHALF)
        sub = jnp.einsum('thpd,hpkd->thpk', q, keys)
        sv, si = lax.top_k(sub, PEER_TOPK)
        cand_s = (sv[:, :, 0, :, None] + sv[:, :, 1, None, :]).reshape(t, PEER_HEADS, PEER_TOPK * PEER_TOPK)
        cand_e = (si[:, :, 0, :, None] * PEER_NKEYS + si[:, :, 1, None, :]).reshape(t, PEER_HEADS, PEER_TOPK * PEER_TOPK)
        top_s, top_pos = lax.top_k(cand_s, PEER_TOPK)
        expert = jnp.take_along_axis(cand_e, top_pos, axis=-1)
        g = jax.nn.softmax(top_s.astype(jnp.float32), axis=-1).astype(hb.dtype)
        act = jax.nn.gelu(jnp.einsum('thkd,td->thk', u_tab[expert], hb))
        return jnp.einsum('thk,thkd->td', g * act, v_tab[expert])

    out = lax.map(one_block, h.reshape(-1, PEER_TOKEN_BLOCK, d))
    return out.reshape(b, s, d)


def setup_inputs(seed: int = 0) -> dict:
    key = jax.random.key(seed)
    ks = iter(jax.random.split(key, 32))
    D = D_MODEL

    def nrm(shape, scale):
        return jax.random.normal(next(ks), shape, jnp.float32) * scale

    return {
        "x": nrm((BATCH, SEQ, D), 1.0),
        "c": nrm((BATCH, D), 1.0),
        "ada_w": nrm((DEPTH, D, 6 * D), 0.5 * D ** -0.5),
        "ada_b": nrm((DEPTH, 6 * D), 0.02),
        "norm_g": 1.0 + nrm((DEPTH, 2, D), 0.05),
        "pool_w_in": nrm((N_POOL_LAYERS, D, D), D ** -0.5),
        "pool_w_grp": nrm((N_POOL_LAYERS, len(POOL_WINDOWS), POOL_GROUP, POOL_GROUP), POOL_GROUP ** -0.5),
        "pool_scale": 1.0 + nrm((N_POOL_LAYERS, D), 0.1),
        "pool_w_out": nrm((N_POOL_LAYERS, D, D), D ** -0.5),
        "conv_w_in": nrm((N_CONV_LAYERS, D, 3 * D), D ** -0.5),
        "conv_w": nrm((N_CONV_LAYERS, CONV_WIDTH, D), CONV_WIDTH ** -0.5),
        "conv_w_out": nrm((N_CONV_LAYERS, D, D), D ** -0.5),
        "gmlp_w_in": nrm((N_GMLP_LAYERS, D, 2 * GMLP_HALF), D ** -0.5),
        "gmlp_ln_g": 1.0 + nrm((N_GMLP_LAYERS, GMLP_HALF), 0.05),
        "gmlp_ln_b": nrm((N_GMLP_LAYERS, GMLP_HALF), 0.02),
        "gmlp_w_s": nrm((N_GMLP_LAYERS, GMLP_GROUPS, GMLP_BLOCK, GMLP_BLOCK), GMLP_BLOCK ** -0.5),
        "gmlp_b_s": 1.0 + nrm((N_GMLP_LAYERS, GMLP_GROUPS, GMLP_BLOCK), 0.1),
        "gmlp_w_out": nrm((N_GMLP_LAYERS, GMLP_HALF, D), GMLP_HALF ** -0.5),
        "peer_w_q": nrm((DEPTH, D, PEER_HEADS * PEER_DKEY), D ** -0.5),
        "peer_keys": nrm((DEPTH, PEER_HEADS, 2, PEER_NKEYS, PEER_DHALF), PEER_DHALF ** -0.5),
        "peer_u": nrm((DEPTH, PEER_EXPERTS, D), D ** -0.5),
        "peer_v": nrm((DEPTH, PEER_EXPERTS, D), 0.5),
        "final_g": 1.0 + nrm((D,), 0.05),
    }


def reference(x, c, ada_w, ada_b, norm_g,
              pool_w_in, pool_w_grp, pool_scale, pool_w_out,
              conv_w_in, conv_w, conv_w_out,
              gmlp_w_in, gmlp_ln_g, gmlp_ln_b, gmlp_w_s, gmlp_b_s, gmlp_w_out,
              peer_w_q, peer_keys, peer_u, peer_v, final_g):
    cond = jax.nn.silu(c)
    for i in range(DEPTH):
        mod = cond @ ada_w[i] + ada_b[i]
        sh1, sc1, g1, sh2, sc2, g2 = jnp.split(mod, 6, axis=-1)
        h = modulate(rmsnorm(x, norm_g[i, 0]), sh1, sc1)
        kind, j = i % N_MIXERS, i // N_MIXERS
        if kind == 0:
            y = pool_mixer(h, pool_w_in[j], pool_w_grp[j], pool_scale[j], pool_w_out[j])
        elif kind == 1:
            y = conv_mixer(h, conv_w_in[j], conv_w[j], conv_w_out[j])
        else:
            y = gmlp_mixer(h, gmlp_w_in[j], gmlp_ln_g[j], gmlp_ln_b[j],
                           gmlp_w_s[j], gmlp_b_s[j], gmlp_w_out[j])
        x = x + g1[:, None, :] * y
        h = modulate(rmsnorm(x, norm_g[i, 1]), sh2, sc2)
        x = x + g2[:, None, :] * peer_ffn(h, peer_w_q[i], peer_keys[i], peer_u[i], peer_v[i])
    return rmsnorm(x, final_g)
```

```cpp
#include <hip/hip_runtime.h>
#include <hip/hip_cooperative_groups.h>
#include <cstdio>
#include <cstdint>
namespace cg = cooperative_groups;

#ifndef MK_ONE_LAUNCH
#define MK_ONE_LAUNCH 0
#endif

#define LAS __attribute__((address_space(3)))
typedef unsigned short bf16_t;
typedef short bf16x8 __attribute__((ext_vector_type(8)));
typedef float f32x2 __attribute__((ext_vector_type(2)));
typedef float f32x4 __attribute__((ext_vector_type(4)));
typedef float f32x16 __attribute__((ext_vector_type(16)));
typedef unsigned u32x2 __attribute__((ext_vector_type(2)));
typedef unsigned u32x4 __attribute__((ext_vector_type(4)));
typedef int i32x4 __attribute__((ext_vector_type(4)));
typedef __bf16 bf16x2 __attribute__((ext_vector_type(2)));

constexpr int DM = 1024, BATCH = 8, SEQ = 4096, MTOK = BATCH * SEQ, DEPTH = 4;
constexpr int GH = 3072;
constexpr int NEXP = 16384, NPICK = 128;
constexpr float EPS = 1e-6f;

constexpr size_t MiB = 1u << 20;
constexpr size_t WS_CTL = 0, WS_MOD = 1 * MiB, ZERO_BYTES = 2 * MiB;
constexpr size_t WS_POOL_WIN = 2 * MiB, WS_POOL_WGRP = 6 * MiB, WS_POOL_WOUT = 7 * MiB;
constexpr size_t WS_CONV_WIN = 11 * MiB, WS_CONV_WOUT = 17 * MiB;
constexpr size_t WS_GMLP_WIN = 19 * MiB, WS_GMLP_WOUT = 31 * MiB;
constexpr size_t WS_PEER_WQ = 37 * MiB, WS_KEYS = 53 * MiB;
constexpr size_t WS_H = 56 * MiB;
constexpr size_t WS_SELI = 120 * MiB, WS_SELW = 136 * MiB;
constexpr size_t WS_TABU = 152 * MiB, WS_TABV = 280 * MiB;
constexpr size_t WS_MIX = 408 * MiB;
constexpr size_t WS_ADAP = 792 * MiB;
constexpr size_t WS_END = 804 * MiB;

__device__ __forceinline__ unsigned cvt_pk_bf16(float lo, float hi) { unsigned r; asm volatile("v_cvt_pk_bf16_f32 %0, %1, %2" : "=v"(r) : "v"(lo), "v"(hi)); return r; }
__device__ __forceinline__ int opaque(int x) { asm volatile("" : "+v"(x)); return x; }
__device__ __forceinline__ float bf_lo(unsigned w) { return __uint_as_float(w << 16); }
__device__ __forceinline__ float bf_hi(unsigned w) { return __uint_as_float(w & 0xffff0000u); }
__device__ __forceinline__ float gelu_tanh(float x) {
    const float y = x * (1.0f + 0.044715f * x * x);
    const float e = __builtin_amdgcn_exp2f(-2.302208198f * y);
    return x * __builtin_amdgcn_rcpf(1.0f + e);
}
__device__ __forceinline__ float wave_sum_all(float v) {
#pragma unroll
    for (int o = 1; o < 64; o <<= 1) v += __shfl_xor(v, o);
    return v;
}
__device__ __forceinline__ float dot2_bf16(unsigned w, unsigned x, float acc) { return __builtin_amdgcn_fdot2_f32_bf16(__builtin_bit_cast(bf16x2, w), __builtin_bit_cast(bf16x2, x), acc, false); }

namespace pg8 {
constexpr int BM = 256, BK = 64, HALF = 128, HTB = HALF * BK * 2, STAGE_BYTES = 8 * HTB, NXCD = 8, WGM = 8;
__device__ __forceinline__ int lds_byte(int r, int c) { const int st = (r >> 4) * 2 + (c >> 5), rr = r & 15, cc = c & 31, ob = rr * 64 + cc * 2; return st * 1024 + (ob ^ (((ob >> 9) & 1) << 5)); }
__device__ __forceinline__ void stage_rc(int b, int& R, int& C) { const int st = b / 1024, sb = b % 1024, swz = sb ^ (((sb >> 9) & 1) << 5); R = (st >> 1) * 16 + swz / 64; C = (st & 1) * 32 + (swz % 64) / 2; }
__device__ __forceinline__ int perm32(int rho) { const int n = rho >> 4, i = rho & 15; return 8 * (i >> 2) + 4 * n + (i & 3); }

struct Unit { int pm, pn; };
struct Gemm { const bf16_t* A; const bf16_t* Bt; int M, N, K, lda, ldb, a_pn_off; };

struct StaticOrder {
    int nM, nN, nwg, G, c;
    __device__ __forceinline__ void init(int M, int N, int G_, int c_) { nM = M / BM; nN = N / BM; nwg = nM * nN; G = G_; c = c_; }
    __device__ __forceinline__ bool next(int i, Unit& u) const {
        const long L = (long)i * G + c; if (L >= nwg) return false;
        int wgid = (int)L; { const int q = nwg / NXCD, r = nwg % NXCD, xcd = wgid % NXCD, off = wgid / NXCD; wgid = (xcd < r ? xcd * (q + 1) : r * (q + 1) + (xcd - r) * q) + off; }
        const int nig = WGM * nN, gid = wgid / nig, fm = gid * WGM, gsz = (nM - fm) < WGM ? (nM - fm) : WGM;
        u.pm = fm + ((wgid % nig) % gsz); u.pn = (wgid % nig) / gsz; return true;
    }
};

template <class Epi>
__device__ __forceinline__ void gemm_phase(LAS unsigned char* lds, const Gemm g, const StaticOrder& S, const Epi& E) {
    const int tid = opaque((int)threadIdx.x), wid = __builtin_amdgcn_readfirstlane(tid >> 6), lane = tid & 63, wr = wid >> 2, wc = wid & 3, fr = lane & 15, fq = lane >> 4;
    const int nt = g.K / BK;
    unsigned voffA[2], voffB[2];
#pragma unroll
    for (int i = 0; i < 2; ++i) { int R, C; stage_rc(tid * 16 + i * 8192, R, C); const int Rb = Epi::PERM ? ((R & ~31) + perm32(R & 31)) : R;
        voffA[i] = (unsigned)(R * g.lda + C) * 2u; voffB[i] = (unsigned)(Rb * g.ldb + C) * 2u; }
    const size_t kstep = (size_t)(BK * 2);
    const size_t hstepA = (size_t)HALF * g.lda * 2, hstepB = (size_t)HALF * g.ldb * 2;
    const size_t tstepA = 2 * hstepA, tstepB = 2 * hstepB;
    const unsigned ldsw = (unsigned)wid * 1024u;
    const int aoff = lds_byte(wr * 64 + fr, fq * 8), boff = lds_byte(wc * 32 + fr, fq * 8);
#define PG8_SA(b, h) (((b) * 2 + (h)) * HTB)
#define PG8_SB(b, h) ((4 + (b) * 2 + (h)) * HTB)
#define PG8_STAGE(bufoff, gbase, voff) do { _Pragma("unroll") for (int _i = 0; _i < 2; ++_i) \
        __builtin_amdgcn_global_load_lds((const unsigned*)((const char*)(gbase) + (voff)[_i]), (LAS unsigned*)(lds + (bufoff) + ldsw + _i * 8192), 16, 0, 0); } while (0)
#define PG8_LDA(dst, b, h) do { _Pragma("unroll") for (int m = 0; m < 4; ++m) _Pragma("unroll") for (int k = 0; k < 2; ++k) dst[m][k] = *(const LAS bf16x8*)(lds + PG8_SA(b, h) + aoff + m * 2048 + k * 1024); } while (0)
#define PG8_LDB(dst, b, h) do { _Pragma("unroll") for (int n = 0; n < 2; ++n) _Pragma("unroll") for (int k = 0; k < 2; ++k) dst[n][k] = *(const LAS bf16x8*)(lds + PG8_SB(b, h) + boff + n * 2048 + k * 1024); } while (0)
#define PG8_MMA(ai, bj, At, Bt) do { __builtin_amdgcn_s_setprio(1); _Pragma("unroll") for (int m = 0; m < 4; ++m) _Pragma("unroll") for (int n = 0; n < 2; ++n) _Pragma("unroll") for (int k = 0; k < 2; ++k) \
        acc[ai][bj][m][n] = Epi::SWAP ? __builtin_amdgcn_mfma_f32_16x16x32_bf16(At[m][k], Bt[n][k], acc[ai][bj][m][n], 0, 0, 0) \
                                      : __builtin_amdgcn_mfma_f32_16x16x32_bf16(Bt[n][k], At[m][k], acc[ai][bj][m][n], 0, 0, 0); __builtin_amdgcn_s_setprio(0); } while (0)
#define PG8_WAIT_V(n) asm volatile("s_waitcnt vmcnt(" #n ")" ::: "memory")
#define PG8_WAIT_L(n) asm volatile("s_waitcnt lgkmcnt(" #n ")" ::: "memory")
#define PG8_BAR __builtin_amdgcn_s_barrier()
#define PG8_SCHED __builtin_amdgcn_sched_barrier(0)
    Unit cur, nxt; int ui = 0;
    if (!S.next(0, cur)) return;
    f32x4 acc[2][2][4][2];
#pragma unroll
    for (int a = 0; a < 2; ++a)
#pragma unroll
        for (int b = 0; b < 2; ++b)
#pragma unroll
            for (int m = 0; m < 4; ++m)
#pragma unroll
                for (int n = 0; n < 2; ++n) acc[a][b][m][n] = (f32x4){0.f, 0.f, 0.f, 0.f};
    bf16x8 At[4][2], B0[2][2], B1[2][2];
    const char* cA = (const char*)g.A + (size_t)cur.pm * tstepA + (size_t)cur.pn * g.a_pn_off * 2; const char* cB = (const char*)g.Bt + (size_t)cur.pn * tstepB;
    PG8_STAGE(PG8_SB(0, 0), cB, voffB); PG8_STAGE(PG8_SA(0, 0), cA, voffA); PG8_STAGE(PG8_SB(0, 1), cB + hstepB, voffB); PG8_STAGE(PG8_SA(0, 1), cA + hstepA, voffA);
    if (wr == 1) PG8_BAR;
    PG8_WAIT_V(4); PG8_BAR;
    PG8_STAGE(PG8_SB(1, 0), cB + kstep, voffB); PG8_STAGE(PG8_SA(1, 0), cA + kstep, voffA); PG8_STAGE(PG8_SB(1, 1), cB + hstepB + kstep, voffB);
    PG8_WAIT_V(6); PG8_BAR;
    for (;;) {
        const bool has_next = S.next(ui + 1, nxt);
        const char* nA = has_next ? (const char*)g.A + (size_t)nxt.pm * tstepA + (size_t)nxt.pn * g.a_pn_off * 2 : cA; const char* nB = has_next ? (const char*)g.Bt + (size_t)nxt.pn * tstepB : cB;
        for (int t = 0; t < nt; t += 2) {
            const bool last = (t == nt - 2);
            const char* a1 = cA + (size_t)(t + 1) * kstep;
            const char* a2 = last ? nA : cA + (size_t)(t + 2) * kstep; const char* b2 = last ? nB : cB + (size_t)(t + 2) * kstep;
            const char* a3 = a2 + kstep; const char* b3 = b2 + kstep;
            PG8_LDB(B0, 0, 0); PG8_SCHED; PG8_LDA(At, 0, 0); PG8_STAGE(PG8_SA(1, 1), a1 + hstepA, voffA);
            PG8_WAIT_L(8); PG8_BAR; PG8_WAIT_L(0); PG8_MMA(0, 0, At, B0); PG8_BAR; PG8_SCHED;
            PG8_LDB(B1, 0, 1); PG8_STAGE(PG8_SB(0, 0), b2, voffB);
            PG8_BAR; PG8_WAIT_L(0); PG8_MMA(0, 1, At, B1); PG8_BAR;
            PG8_LDA(At, 0, 1); PG8_STAGE(PG8_SA(0, 0), a2, voffA);
            PG8_BAR; PG8_WAIT_L(0); PG8_MMA(1, 0, At, B0); PG8_BAR; PG8_SCHED;
            PG8_STAGE(PG8_SB(0, 1), b2 + hstepB, voffB);
            PG8_WAIT_V(6); PG8_BAR; PG8_MMA(1, 1, At, B1); PG8_BAR;
            PG8_LDB(B0, 1, 0); PG8_SCHED; PG8_LDA(At, 1, 0); PG8_STAGE(PG8_SA(0, 1), a2 + hstepA, voffA);
            PG8_WAIT_L(8); PG8_BAR; PG8_WAIT_L(0); PG8_MMA(0, 0, At, B0); PG8_BAR; PG8_SCHED;
            PG8_LDB(B1, 1, 1); PG8_STAGE(PG8_SB(1, 0), b3, voffB);
            PG8_BAR; PG8_WAIT_L(0); PG8_MMA(0, 1, At, B1); PG8_BAR;
            PG8_LDA(At, 1, 1); PG8_STAGE(PG8_SA(1, 0), a3, voffA);
            PG8_BAR; PG8_WAIT_L(0); PG8_MMA(1, 0, At, B0); PG8_BAR; PG8_SCHED;
            PG8_STAGE(PG8_SB(1, 1), b3 + hstepB, voffB);
            PG8_WAIT_V(6); PG8_BAR; PG8_MMA(1, 1, At, B1); PG8_BAR;
        }
        { const int l2 = opaque((int)threadIdx.x) & 63; E(acc, cur, wr, wc, l2 & 15, l2 >> 4); }
        if (!has_next) break;
#pragma unroll
        for (int a = 0; a < 2; ++a)
#pragma unroll
            for (int b = 0; b < 2; ++b)
#pragma unroll
                for (int m = 0; m < 4; ++m)
#pragma unroll
                    for (int n = 0; n < 2; ++n) acc[a][b][m][n] = (f32x4){0.f, 0.f, 0.f, 0.f};
        cur = nxt; cA = nA; cB = nB; ++ui;
    }
    PG8_WAIT_V(0);
    if (wr == 0) PG8_BAR;
    PG8_BAR;
#undef PG8_SA
#undef PG8_SB
#undef PG8_STAGE
#undef PG8_LDA
#undef PG8_LDB
#undef PG8_MMA
#undef PG8_WAIT_V
#undef PG8_WAIT_L
#undef PG8_BAR
#undef PG8_SCHED
}

template <int ACT> struct EpiBf16 {
    static constexpr bool PERM = true, SWAP = false;
    bf16_t* O; int ldc;
    __device__ __forceinline__ void operator()(const f32x4 (&acc)[2][2][4][2], const Unit& u, int wr, int wc, int fr, int fq) const {
        const int row0 = u.pm * BM + wr * 64 + fr, col0 = u.pn * BM + wc * 32 + 8 * fq;
#pragma unroll
        for (int ai = 0; ai < 2; ++ai)
#pragma unroll
            for (int m = 0; m < 4; ++m) { bf16_t* rowp = O + (size_t)(row0 + ai * HALF + m * 16) * ldc + col0;
#pragma unroll
                for (int bj = 0; bj < 2; ++bj) { f32x4 v0 = acc[ai][bj][m][0], v1 = acc[ai][bj][m][1];
                    if (ACT == 1) {
#pragma unroll
                        for (int j = 0; j < 4; ++j) { v0[j] = gelu_tanh(v0[j]); v1[j] = gelu_tanh(v1[j]); } }
                    u32x4 w; w.x = cvt_pk_bf16(v0[0], v0[1]); w.y = cvt_pk_bf16(v0[2], v0[3]); w.z = cvt_pk_bf16(v1[0], v1[1]); w.w = cvt_pk_bf16(v1[2], v1[3]);
                    *(u32x4*)(rowp + bj * HALF) = w; } }
    }
};
struct EpiPoolGrp {
    static constexpr bool PERM = true, SWAP = false;
    bf16_t* O; const float* scale;
    __device__ __forceinline__ void operator()(const f32x4 (&acc)[2][2][4][2], const Unit& u, int wr, int wc, int fr, int fq) const {
        const int row0 = u.pm * BM + wr * 64 + fr, col0 = u.pn * BM + wc * 32 + 8 * fq;
#pragma unroll
        for (int bj = 0; bj < 2; ++bj) {
            const f32x4 s0 = *(const f32x4*)(scale + col0 + bj * HALF), s1 = *(const f32x4*)(scale + col0 + bj * HALF + 4);
#pragma unroll
            for (int ai = 0; ai < 2; ++ai)
#pragma unroll
                for (int m = 0; m < 4; ++m) { bf16_t* rowp = O + (size_t)(row0 + ai * HALF + m * 16) * DM + col0 + bj * HALF;
                    const f32x4 v0 = acc[ai][bj][m][0] * s0, v1 = acc[ai][bj][m][1] * s1;
                    u32x4 w; w.x = cvt_pk_bf16(v0[0], v0[1]); w.y = cvt_pk_bf16(v0[2], v0[3]); w.z = cvt_pk_bf16(v1[0], v1[1]); w.w = cvt_pk_bf16(v1[2], v1[3]);
                    *(u32x4*)rowp = w; }
            asm volatile("" ::: "memory");
        }
    }
};
struct EpiConvIn {
    static constexpr bool PERM = true, SWAP = false;
    bf16_t* BG; bf16_t* Z;
    __device__ __forceinline__ void operator()(const f32x4 (&acc)[2][2][4][2], const Unit& u, int wr, int wc, int fr, int fq) const {
        const int row0 = u.pm * BM + wr * 64 + fr;
        if (u.pn < 4) {
            const int col0 = u.pn * BM + wc * 32 + 8 * fq;
#pragma unroll
            for (int ai = 0; ai < 2; ++ai)
#pragma unroll
                for (int m = 0; m < 4; ++m) { bf16_t* rowp = BG + (size_t)(row0 + ai * HALF + m * 16) * DM + col0;
#pragma unroll
                    for (int bj = 0; bj < 2; ++bj) { const f32x4 v0 = acc[ai][bj][m][0], v1 = acc[ai][bj][m][1];
                        u32x4 w; w.x = cvt_pk_bf16(v0[0], v0[1]); w.y = cvt_pk_bf16(v0[2], v0[3]); w.z = cvt_pk_bf16(v1[0], v1[1]); w.w = cvt_pk_bf16(v1[2], v1[3]);
                        *(u32x4*)(rowp + bj * HALF) = w; } }
        } else {
            const int col0 = (u.pn - 4) * HALF + wc * 32 + 8 * fq;
#pragma unroll
            for (int ai = 0; ai < 2; ++ai)
#pragma unroll
                for (int m = 0; m < 4; ++m) { bf16_t* rowp = Z + (size_t)(row0 + ai * HALF + m * 16) * DM + col0;
                    const f32x4 v0 = acc[ai][0][m][0] * acc[ai][1][m][0], v1 = acc[ai][0][m][1] * acc[ai][1][m][1];
                    u32x4 w; w.x = cvt_pk_bf16(v0[0], v0[1]); w.y = cvt_pk_bf16(v0[2], v0[3]); w.z = cvt_pk_bf16(v1[0], v1[1]); w.w = cvt_pk_bf16(v1[2], v1[3]);
                    *(u32x4*)rowp = w; }
        }
    }
};
struct EpiResid {
    static constexpr bool PERM = false, SWAP = false;
    const float* base; float* out; const float* gacc; const float* gbias;
    __device__ __forceinline__ void operator()(const f32x4 (&acc)[2][2][4][2], const Unit& u, int wr, int wc, int fr, int fq) const {
        const int row0 = u.pm * BM + wr * 64 + fr, col0 = u.pn * BM + wc * 32 + 4 * fq;
        const float* gp = gacc + (size_t)(u.pm >> 4) * (6 * DM);
#pragma unroll
        for (int bj = 0; bj < 2; ++bj)
#pragma unroll
            for (int n = 0; n < 2; ++n) { const int cc = col0 + bj * HALF + n * 16;
                const f32x4 gv = *(const f32x4*)(gp + cc);
#pragma unroll
                for (int ai = 0; ai < 2; ++ai) {
#pragma unroll
                    for (int m = 0; m < 4; ++m) { const size_t off = (size_t)(row0 + ai * HALF + m * 16) * DM + cc;
                        const f32x4 bs = *(const f32x4*)(base + off);
                        *(f32x4*)(out + off) = bs + gv * acc[ai][bj][m][n]; }
                    asm volatile("" ::: "memory"); } }
    }
};
struct EpiGmlpV {
    static constexpr bool PERM = false, SWAP = true;
    bf16_t* VT;
    __device__ __forceinline__ void operator()(const f32x4 (&acc)[2][2][4][2], const Unit& u, int wr, int wc, int fr, int fq) const {
        const int row0 = u.pm * BM + wr * 64 + 4 * fq, col0 = u.pn * BM + wc * 32 + fr;
#pragma unroll
        for (int bj = 0; bj < 2; ++bj)
#pragma unroll
            for (int n = 0; n < 2; ++n) { bf16_t* colp = VT + (size_t)(col0 + bj * HALF + n * 16) * MTOK + row0;
#pragma unroll
                for (int ai = 0; ai < 2; ++ai)
#pragma unroll
                    for (int m = 0; m < 4; ++m) { const f32x4 v = acc[ai][bj][m][n];
                        u32x2 w; w.x = cvt_pk_bf16(gelu_tanh(v[0]), gelu_tanh(v[1])); w.y = cvt_pk_bf16(gelu_tanh(v[2]), gelu_tanh(v[3]));
                        *(u32x2*)(colp + ai * HALF + m * 16) = w; } }
    }
};
}

constexpr int RING_BYTES = 131072;
constexpr int LDS_BYTES = 147456;
constexpr int NTHREADS = 512;

#define CE_DESC(a, b) do { const float _x = fmaxf(a, b), _y = fminf(a, b); a = _x; b = _y; } while (0)
#define CE_ASC(a, b)  do { const float _x = fminf(a, b), _y = fmaxf(a, b); a = _x; b = _y; } while (0)
template <int OFF, int N>
__device__ __forceinline__ void sort16_desc(float (&v)[N]) {
#pragma unroll
    for (int k = 2; k <= 16; k <<= 1)
#pragma unroll
        for (int j = k >> 1; j > 0; j >>= 1)
#pragma unroll
            for (int i = 0; i < 16; ++i) { const int l = i ^ j; if (l > i) { if ((i & k) == 0) CE_DESC(v[OFF + i], v[OFF + l]); else CE_ASC(v[OFF + i], v[OFF + l]); } }
}
template <int OFF, int N>
__device__ __forceinline__ void bmerge16_desc(float (&v)[N]) {
#pragma unroll
    for (int j = 8; j > 0; j >>= 1)
#pragma unroll
        for (int i = 0; i < 16; ++i) { const int l = i ^ j; if (l > i) CE_DESC(v[OFF + i], v[OFF + l]); }
}
template <int A, int B, int N>
__device__ __forceinline__ void merge_top16(float (&v)[N]) {
#pragma unroll
    for (int i = 0; i < 16; ++i) v[A + i] = fmaxf(v[A + i], v[B + 15 - i]);
    bmerge16_desc<A, N>(v);
}
__device__ __forceinline__ void top16_of_64(float (&v)[64]) {
    sort16_desc<0, 64>(v); sort16_desc<16, 64>(v); sort16_desc<32, 64>(v); sort16_desc<48, 64>(v);
    merge_top16<0, 16, 64>(v); merge_top16<32, 48, 64>(v); merge_top16<0, 32, 64>(v);
}

struct Args { const float* in[23]; float* out; unsigned char* ws; int ph_lo, ph_hi; };
typedef const __attribute__((address_space(4))) Args* ArgP;
enum { I_X = 0, I_C, I_ADA_W, I_ADA_B, I_NORM_G, I_POOL_WIN, I_POOL_WGRP, I_POOL_SCALE, I_POOL_WOUT, I_CONV_WIN, I_CONV_W, I_CONV_WOUT,
       I_GMLP_WIN, I_GMLP_LNG, I_GMLP_LNB, I_GMLP_WS, I_GMLP_BS, I_GMLP_WOUT, I_PEER_WQ, I_PEER_KEYS, I_PEER_U, I_PEER_V, I_FINAL_G };

__device__ __forceinline__ void transpose_item(const float* W, int K, int N, bf16_t* WT, int dst_row0, LAS float* scr, int k0, int n0, int lane) {
#pragma unroll 8
    for (int i = 0; i < 32; ++i) { const int kk = 2 * i + (lane >> 5); scr[kk * 33 + (lane & 31)] = W[(size_t)(k0 + kk) * N + n0 + (lane & 31)]; }
    asm volatile("s_waitcnt lgkmcnt(0)" ::: "memory");
    const int c = lane & 7;
#pragma unroll
    for (int j = 0; j < 4; ++j) { const int n = (lane >> 3) + 8 * j; const LAS float* s = scr + (8 * c) * 33 + n;
        u32x4 o; o.x = cvt_pk_bf16(s[0 * 33], s[1 * 33]); o.y = cvt_pk_bf16(s[2 * 33], s[3 * 33]); o.z = cvt_pk_bf16(s[4 * 33], s[5 * 33]); o.w = cvt_pk_bf16(s[6 * 33], s[7 * 33]);
        *(u32x4*)(WT + (size_t)(dst_row0 + n) * K + k0 + 8 * c) = o; }
    asm volatile("s_waitcnt lgkmcnt(0)" ::: "memory");
}
__device__ __forceinline__ void convert_stream(const float* src, bf16_t* dst, size_t n8, size_t gt, size_t stride) {
    for (size_t i = gt; i < n8; i += stride) {
        const f32x4 a = __builtin_nontemporal_load((const f32x4*)src + 2 * i), b = __builtin_nontemporal_load((const f32x4*)src + 2 * i + 1);
        u32x4 o; o.x = cvt_pk_bf16(a[0], a[1]); o.y = cvt_pk_bf16(a[2], a[3]); o.z = cvt_pk_bf16(b[0], b[1]); o.w = cvt_pk_bf16(b[2], b[3]);
        *((u32x4*)dst + i) = o; }
}
__device__ __forceinline__ void prologue_phase(ArgP Ap, LAS unsigned char* lds, int vcu, int G, int tid, int wid, int lane) {
    unsigned char* ws = Ap->ws;
    const int gw = vcu * 8 + wid, NGW = G * 8;
    LAS float* scr = (LAS float*)(lds + wid * 16384);
    constexpr int NT_ITEMS = 1024 + 256 + 1024 + 1536 + 512 + 3072 + 1536 + 4096;
    for (int it = gw; it < NT_ITEMS; it += NGW) {
        int r = it; const float* src; bf16_t* dst; int K, N, kind = 0;
        if (r < 1024) { const int m = r >> 9; r &= 511; src = Ap->in[I_POOL_WIN] + (size_t)m * DM * DM; dst = (bf16_t*)(ws + WS_POOL_WIN) + (size_t)m * DM * DM; K = DM; N = DM; }
        else if ((r -= 1024) < 256) { const int m = r >> 5; r &= 31; src = Ap->in[I_POOL_WGRP] + (size_t)m * 65536; dst = (bf16_t*)(ws + WS_POOL_WGRP) + (size_t)m * 65536; K = 256; N = 256; }
        else if ((r -= 256) < 1024) { const int m = r >> 9; r &= 511; src = Ap->in[I_POOL_WOUT] + (size_t)m * DM * DM; dst = (bf16_t*)(ws + WS_POOL_WOUT) + (size_t)m * DM * DM; K = DM; N = DM; }
        else if ((r -= 1024) < 1536) { src = Ap->in[I_CONV_WIN]; dst = (bf16_t*)(ws + WS_CONV_WIN); K = DM; N = 3 * DM; kind = 1; }
        else if ((r -= 1536) < 512) { src = Ap->in[I_CONV_WOUT]; dst = (bf16_t*)(ws + WS_CONV_WOUT); K = DM; N = DM; }
        else if ((r -= 512) < 3072) { src = Ap->in[I_GMLP_WIN]; dst = (bf16_t*)(ws + WS_GMLP_WIN); K = DM; N = 2 * GH; }
        else if ((r -= 3072) < 1536) { src = Ap->in[I_GMLP_WOUT]; dst = (bf16_t*)(ws + WS_GMLP_WOUT); K = GH; N = DM; }
        else { r -= 1536; const int m = r >> 10; r &= 1023; src = Ap->in[I_PEER_WQ] + (size_t)m * DM * 2048; dst = (bf16_t*)(ws + WS_PEER_WQ) + (size_t)m * DM * 2048; K = DM; N = 2048; }
        const int nblk = N / 32, kb = r / nblk, nb = r % nblk, n0 = 32 * nb;
        int drow = n0;
        if (kind == 1 && n0 >= DM) { const int xt = n0 >= 2 * DM, ch = n0 - (xt ? 2 * DM : DM); drow = DM + 256 * (ch >> 7) + 128 * xt + (ch & 127); }
        transpose_item(src, K, N, dst, drow, scr, 64 * kb, n0, lane);
    }
    const size_t gt = (size_t)vcu * NTHREADS + tid, stride = (size_t)G * NTHREADS;
    convert_stream(Ap->in[I_PEER_KEYS], (bf16_t*)(ws + WS_KEYS), (size_t)DEPTH * 16 * 128 * 128 / 8, gt, stride);
    convert_stream(Ap->in[I_PEER_U], (bf16_t*)(ws + WS_TABU), (size_t)DEPTH * NEXP * DM / 8, gt, stride);
    convert_stream(Ap->in[I_PEER_V], (bf16_t*)(ws + WS_TABV), (size_t)DEPTH * NEXP * DM / 8, gt, stride);
    __syncthreads();
    LAS float* cond = (LAS float*)lds;
    for (int i = tid; i < BATCH * DM; i += NTHREADS) { const int b = i >> 10, k = i & 1023; const float c = Ap->in[I_C][i]; cond[k * 8 + b] = c * __builtin_amdgcn_rcpf(1.0f + __expf(-c)); }
    __syncthreads();
    float* modp = (float*)(ws + WS_ADAP);
    for (int it = gw; it < DEPTH * 24 * 16; it += NGW) {
        const int l = it / 384, r = it % 384, cgp = r >> 4, kc = r & 15;
        const float* wp = Ap->in[I_ADA_W] + ((size_t)l * DM + kc * 64) * (6 * DM) + cgp * 256 + 4 * lane;
        f32x4 acc[8];
#pragma unroll
        for (int b = 0; b < 8; ++b) acc[b] = (f32x4){0.f, 0.f, 0.f, 0.f};
#pragma unroll 8
        for (int k = 0; k < 64; ++k) { const f32x4 w = __builtin_nontemporal_load((const f32x4*)(wp + (size_t)k * (6 * DM)));
            const f32x4 c0 = *(const LAS f32x4*)(cond + (kc * 64 + k) * 8), c1 = *(const LAS f32x4*)(cond + (kc * 64 + k) * 8 + 4);
            acc[0] += c0[0] * w; acc[1] += c0[1] * w; acc[2] += c0[2] * w; acc[3] += c0[3] * w; acc[4] += c1[0] * w; acc[5] += c1[1] * w; acc[6] += c1[2] * w; acc[7] += c1[3] * w; }
#pragma unroll
        for (int b = 0; b < 8; ++b) *(f32x4*)(modp + (((size_t)kc * DEPTH + l) * 8 + b) * (6 * DM) + cgp * 256 + 4 * lane) = acc[b];
    }
}
__device__ __forceinline__ void modreduce_phase(ArgP Ap, int vcu, int G, int tid) {
    unsigned char* ws = Ap->ws; const float* modp = (const float*)(ws + WS_ADAP); float* mod = (float*)(ws + WS_MOD);
    constexpr int N4 = DEPTH * BATCH * 6 * DM / 4;
    for (int i = vcu * NTHREADS + tid; i < N4; i += G * NTHREADS) {
        const int n4 = i % (6 * DM / 4), l = i / (BATCH * 6 * DM / 4);
        f32x4 a = *((const f32x4*)(Ap->in[I_ADA_B] + (size_t)l * 6 * DM) + n4);
#pragma unroll
        for (int kc = 0; kc < 16; ++kc) a += *((const f32x4*)modp + (size_t)kc * N4 + i);
        *((f32x4*)mod + i) = a; }
}

__device__ __forceinline__ void norm_phase(const float* x, const float* gn, const float* macc  , const float* mbias  , int sh_off, int sc_off, bf16_t* H, int gw, int NGW, int lane) {
    for (int ch = gw; ch < MTOK / 16; ch += NGW) {
        const int row0 = ch * 16, b = row0 >> 12;
        f32x4 c1[4], shv[4];
#pragma unroll
        for (int j = 0; j < 4; ++j) { const int col = 4 * lane + 256 * j;
            const f32x4 sc = *(const f32x4*)(macc + (size_t)b * 6 * DM + sc_off + col);
            c1[j] = *(const f32x4*)(gn + col) * (1.0f + sc);
            shv[j] = *(const f32x4*)(macc + (size_t)b * 6 * DM + sh_off + col); }
        for (int r = row0; r < row0 + 16; ++r) {
            const f32x4* xr = (const f32x4*)(x + (size_t)r * DM) + lane;
            f32x4 v[4]; float ss = 0.f;
#pragma unroll
            for (int j = 0; j < 4; ++j) { v[j] = xr[64 * j]; ss += (v[j][0] * v[j][0] + v[j][1] * v[j][1]) + (v[j][2] * v[j][2] + v[j][3] * v[j][3]); }
            const float rstd = __builtin_amdgcn_rsqf(wave_sum_all(ss) * (1.0f / DM) + EPS);
            u32x2* o8 = (u32x2*)(H + (size_t)r * DM) + lane;
#pragma unroll
            for (int j = 0; j < 4; ++j) { const f32x4 o = v[j] * rstd * c1[j] + shv[j]; u32x2 w; w.x = cvt_pk_bf16(o[0], o[1]); w.y = cvt_pk_bf16(o[2], o[3]); o8[64 * j] = w; }
        }
    }
}
__device__ __forceinline__ void final_phase(float* x, const float* gf, int gw, int NGW, int lane) {
    f32x4 gv[4];
#pragma unroll
    for (int j = 0; j < 4; ++j) gv[j] = *(const f32x4*)(gf + 4 * lane + 256 * j);
    for (int r = gw; r < MTOK; r += NGW) {
        f32x4* xr = (f32x4*)(x + (size_t)r * DM) + lane;
        f32x4 v[4]; float ss = 0.f;
#pragma unroll
        for (int j = 0; j < 4; ++j) { v[j] = xr[64 * j]; ss += (v[j][0] * v[j][0] + v[j][1] * v[j][1]) + (v[j][2] * v[j][2] + v[j][3] * v[j][3]); }
        const float rstd = __builtin_amdgcn_rsqf(wave_sum_all(ss) * (1.0f / DM) + EPS);
#pragma unroll
        for (int j = 0; j < 4; ++j) xr[64 * j] = v[j] * rstd * gv[j];
    }
}

__device__ __forceinline__ void unpack8(const u32x4 w, float (&f)[8]) { f[0] = bf_lo(w.x); f[1] = bf_hi(w.x); f[2] = bf_lo(w.y); f[3] = bf_hi(w.y); f[4] = bf_lo(w.z); f[5] = bf_hi(w.z); f[6] = bf_lo(w.w); f[7] = bf_hi(w.w); }
__device__ __forceinline__ u32x4 pack8(const float (&f)[8]) { u32x4 o; o.x = cvt_pk_bf16(f[0], f[1]); o.y = cvt_pk_bf16(f[2], f[3]); o.z = cvt_pk_bf16(f[4], f[5]); o.w = cvt_pk_bf16(f[6], f[7]); return o; }
__device__ __forceinline__ void pool_elem_phase(const bf16_t* U, bf16_t* P, int vcu, int G, int tid) {
    const int chunk = tid & 127, run = tid >> 7, c0 = 8 * chunk, w = 2 << (c0 >> 8);
    for (int unit = vcu; unit < MTOK / 128; unit += G) {
        const int t0 = unit * 128 + run * 32, seq0 = t0 & ~(SEQ - 1);
        float s[8];
#pragma unroll
        for (int j = 0; j < 8; ++j) s[j] = 0.f;
        for (int tau = t0 - w; tau < t0; ++tau) if (tau >= seq0) { float f[8];     unpack8(*(const u32x4*)(U + (size_t)tau * DM + c0), f);
#pragma unroll
            for (int j = 0; j < 8; ++j) s[j] += f[j]; }
        for (int t = t0; t < t0 + 32; ++t) {
            float f[8], o[8]; unpack8(*(const u32x4*)(U + (size_t)t * DM + c0), f);
#pragma unroll
            for (int j = 0; j < 8; ++j) s[j] += f[j];
            if (t - w >= seq0) { float q[8]; unpack8(*(const u32x4*)(U + (size_t)(t - w) * DM + c0), q);
#pragma unroll
                for (int j = 0; j < 8; ++j) s[j] -= q[j]; }
            const int pos1 = t - seq0 + 1; const float inv = 1.0f / (float)(pos1 < w ? pos1 : w);
#pragma unroll
            for (int j = 0; j < 8; ++j) o[j] = s[j] * inv - f[j];
            *(u32x4*)(P + (size_t)t * DM + c0) = pack8(o);
        }
    }
}
__device__ __forceinline__ void conv_elem_phase(const bf16_t* BG, const bf16_t* Z, const float* cw  , bf16_t* Aout, int vcu, int G, int tid) {
    const int chunk = tid & 127, run = tid >> 7, c0 = 8 * chunk;
    float w0[8], w1[8], w2[8];
#pragma unroll
    for (int j = 0; j < 8; ++j) { w0[j] = cw[c0 + j]; w1[j] = cw[DM + c0 + j]; w2[j] = cw[2 * DM + c0 + j]; }
    for (int unit = vcu; unit < MTOK / 128; unit += G) {
        const int t0 = unit * 128 + run * 32, seq0 = t0 & ~(SEQ - 1);
        float zm2[8], zm1[8];
#pragma unroll
        for (int j = 0; j < 8; ++j) { zm2[j] = 0.f; zm1[j] = 0.f; }
        if (t0 - 2 >= seq0) unpack8(*(const u32x4*)(Z + (size_t)(t0 - 2) * DM + c0), zm2);
        if (t0 - 1 >= seq0) unpack8(*(const u32x4*)(Z + (size_t)(t0 - 1) * DM + c0), zm1);
        for (int t = t0; t < t0 + 32; ++t) {
            float z[8], bg[8], o[8]; unpack8(*(const u32x4*)(Z + (size_t)t * DM + c0), z); unpack8(*(const u32x4*)(BG + (size_t)t * DM + c0), bg);
#pragma unroll
            for (int j = 0; j < 8; ++j) { o[j] = bg[j] * (w0[j] * zm2[j] + w1[j] * zm1[j] + w2[j] * z[j]); zm2[j] = zm1[j]; zm1[j] = z[j]; }
            *(u32x4*)(Aout + (size_t)t * DM + c0) = pack8(o);
        }
    }
}

__device__ __forceinline__ int wp_off(int row, int chunk) { return row * 256 + ((chunk ^ (row & 15)) << 4); }
__device__ __forceinline__ void mix_phase(LAS unsigned char* lds, bf16_t* UA, const bf16_t* VT, const float* WS, const float* BS, const float* LNG, const float* LNB, int vcu, int G, int tid, int wid, int lane) {
    LAS unsigned char* WP = lds;
    LAS float* MU = (LAS float*)(lds + 32768); LAS float* RSTD = MU + 128; LAS float* R1 = MU + 256; LAS float* R2 = MU + 384;
    LAS float* PART = (LAS float*)(lds + 36864);
    for (int n = vcu; n < MTOK / 128; n += G) {
        {
            const int cgp = tid >> 4, tl = tid & 15;
            float s[8], q[8];
#pragma unroll
            for (int j = 0; j < 8; ++j) { s[j] = 0.f; q[j] = 0.f; }
#pragma unroll 4
            for (int it = 0; it < GH / 32; ++it) { float f[8]; unpack8(*(const u32x4*)(VT + (size_t)(it * 32 + cgp) * MTOK + n * 128 + tl * 8), f);
#pragma unroll
                for (int j = 0; j < 8; ++j) { s[j] += f[j]; q[j] += f[j] * f[j]; } }
#pragma unroll
            for (int j = 0; j < 8; ++j) { PART[(cgp * 128 + tl * 8 + j) * 2] = s[j]; PART[(cgp * 128 + tl * 8 + j) * 2 + 1] = q[j]; }
            __syncthreads();
            if (tid < 128) { float S = 0.f, Q = 0.f;
                for (int k = 0; k < 32; ++k) { S += PART[(k * 128 + tid) * 2]; Q += PART[(k * 128 + tid) * 2 + 1]; }
                const float mu = S * (1.0f / GH), var = Q * (1.0f / GH) - mu * mu; MU[tid] = mu; RSTD[tid] = __builtin_amdgcn_rsqf(fmaxf(var, 0.f) + EPS); }
            __syncthreads();
        }
        for (int g = 0; g < 8; ++g) {
            {
                const int i = tid >> 2, part = tid & 3;
                const float* wrow = WS + ((size_t)g * 128 + i) * 128 + part * 32;
                float r1 = 0.f, r2 = 0.f;
#pragma unroll
                for (int jj = 0; jj < 32; jj += 8) { const int j0 = part * 32 + jj;
                    f32x4 a = *(const f32x4*)(wrow + jj), b = *(const f32x4*)(wrow + jj + 4);
                    if (i < 64 && j0 >= 64) { a = (f32x4){0.f, 0.f, 0.f, 0.f}; b = a; }
                    const f32x4 ra = *(const LAS f32x4*)(RSTD + j0), rb = *(const LAS f32x4*)(RSTD + j0 + 4), ma = *(const LAS f32x4*)(MU + j0), mb = *(const LAS f32x4*)(MU + j0 + 4);
                    const f32x4 wa = a * ra, wb = b * rb;
                    r1 += (wa[0] * ma[0] + wa[1] * ma[1]) + (wa[2] * ma[2] + wa[3] * ma[3]) + (wb[0] * mb[0] + wb[1] * mb[1]) + (wb[2] * mb[2] + wb[3] * mb[3]);
                    r2 += (a[0] + a[1]) + (a[2] + a[3]) + (b[0] + b[1]) + (b[2] + b[3]);
                    u32x4 o; o.x = cvt_pk_bf16(wa[0], wa[1]); o.y = cvt_pk_bf16(wa[2], wa[3]); o.z = cvt_pk_bf16(wb[0], wb[1]); o.w = cvt_pk_bf16(wb[2], wb[3]);
                    *(LAS u32x4*)(WP + wp_off(i, j0 >> 3)) = o; }
                r1 += __shfl_xor(r1, 1); r1 += __shfl_xor(r1, 2); r2 += __shfl_xor(r2, 1); r2 += __shfl_xor(r2, 2);
                if (part == 0) { R1[i] = r1; R2[i] = r2; }
            }
            __syncthreads();
            f32x4 acc[3][8];
#pragma unroll
            for (int ct = 0; ct < 3; ++ct)
#pragma unroll
                for (int it = 0; it < 8; ++it) acc[ct][it] = (f32x4){0.f, 0.f, 0.f, 0.f};
            const int fr = lane & 15, fq = lane >> 4, cbase = g * 384 + wid * 48;
#pragma unroll 1
            for (int ks = 0; ks < 4; ++ks) {
                bf16x8 av[3];
#pragma unroll
                for (int ct = 0; ct < 3; ++ct) av[ct] = *(const bf16x8*)(VT + (size_t)(cbase + ct * 16 + fr) * MTOK + n * 128 + ks * 32 + fq * 8);
#pragma unroll
                for (int it = 0; it < 8; ++it) { const bf16x8 bw = *(const LAS bf16x8*)(WP + wp_off(it * 16 + fr, ks * 4 + fq));
#pragma unroll
                    for (int ct = 0; ct < 3; ++ct) acc[ct][it] = __builtin_amdgcn_mfma_f32_16x16x32_bf16(av[ct], bw, acc[ct][it], 0, 0, 0); }
            }
#pragma unroll
            for (int ct = 0; ct < 3; ++ct) { const int c4 = cbase + ct * 16 + 4 * fq;
                const f32x4 lg = *(const f32x4*)(LNG + c4), lb = *(const f32x4*)(LNB + c4);
#pragma unroll
                for (int it = 0; it < 8; ++it) { const int i = it * 16 + fr; const float r1 = R1[i], r2 = R2[i], bs = BS[g * 128 + i];
                    bf16_t* up = UA + (size_t)(n * 128 + i) * GH + c4; const u32x2 uu = *(const u32x2*)up;
                    const f32x4 vs = lg * (acc[ct][it] - r1) + lb * r2 + bs;
                    u32x2 o; o.x = cvt_pk_bf16(bf_lo(uu.x) * vs[0], bf_hi(uu.x) * vs[1]); o.y = cvt_pk_bf16(bf_lo(uu.y) * vs[2], bf_hi(uu.y) * vs[3]);
                    *(u32x2*)up = o; } }
            __syncthreads();
        }
    }
}

__device__ __forceinline__ void topk_phase(LAS unsigned char* lds, const bf16_t* Q, const bf16_t* KEYS, int* SELI, float* SELW, int vcu, int G, int tid, int wid, int lane) {
    LAS float* topv = (LAS float*)lds;
    const int p = wid >> 2, sub = wid & 3, tl = lane & 31, hi = lane >> 5;
    for (int unit = vcu; unit < (MTOK / 128) * 8; unit += G) {
        const int tile = unit >> 3, h = unit & 7;
        {
            const bf16_t* qrow = Q + (size_t)(tile * 128 + sub * 32 + tl) * 2048 + h * 256 + p * 128 + hi * 8;
            const bf16_t* krow = KEYS + ((size_t)(h * 2 + p) * 128 + tl) * 128 + hi * 8;
            f32x16 acc[4];
#pragma unroll
            for (int kt = 0; kt < 4; ++kt)
#pragma unroll
                for (int r = 0; r < 16; ++r) acc[kt][r] = 0.f;
#pragma unroll
            for (int ks = 0; ks < 8; ++ks) { const bf16x8 bq = *(const bf16x8*)(qrow + ks * 16);
#pragma unroll
                for (int kt = 0; kt < 4; ++kt) { const bf16x8 ak = *(const bf16x8*)(krow + kt * 32 * 128 + ks * 16);
                    acc[kt] = __builtin_amdgcn_mfma_f32_32x32x16_bf16(ak, bq, acc[kt], 0, 0, 0); } }
            float v[64];
#pragma unroll
            for (int kt = 0; kt < 4; ++kt)
#pragma unroll
                for (int r = 0; r < 16; ++r) { const unsigned key = (unsigned)(kt * 32 + (r & 3) + 8 * (r >> 2) + 4 * hi);
                    v[kt * 16 + r] = __uint_as_float((__float_as_uint(acc[kt][r]) & ~127u) | key); }
            top16_of_64(v);
            float m[16];
#pragma unroll
            for (int i = 0; i < 16; ++i) m[i] = fmaxf(v[i], __shfl_xor(v[15 - i], 32));
            bmerge16_desc<0, 16>(m);
            if (hi == 0) { LAS f32x4* dst = (LAS f32x4*)(topv + (p * 128 + sub * 32 + tl) * 16);
#pragma unroll
                for (int i = 0; i < 4; ++i) dst[i] = (f32x4){m[4 * i], m[4 * i + 1], m[4 * i + 2], m[4 * i + 3]}; }
        }
        __syncthreads();
        if (tid < 128) {
            float s0[16], s1[16];
#pragma unroll
            for (int i = 0; i < 4; ++i) { const f32x4 a = *(const LAS f32x4*)(topv + tid * 16 + 4 * i), b = *(const LAS f32x4*)(topv + (128 + tid) * 16 + 4 * i);
                s0[4 * i] = a[0]; s0[4 * i + 1] = a[1]; s0[4 * i + 2] = a[2]; s0[4 * i + 3] = a[3]; s1[4 * i] = b[0]; s1[4 * i + 1] = b[1]; s1[4 * i + 2] = b[2]; s1[4 * i + 3] = b[3]; }
            float c[64];
            constexpr int pre[16] = {0, 16, 24, 29, 33, 36, 38, 40, 42, 43, 44, 45, 46, 47, 48, 49};
#pragma unroll
            for (int a = 0; a < 16; ++a)
#pragma unroll
                for (int b = 0; b < 16; ++b) if ((a + 1) * (b + 1) <= 16) c[pre[a] + b] = __uint_as_float((__float_as_uint(s0[a] + s1[b]) & ~255u) | (unsigned)(a * 16 + b));
#pragma unroll
            for (int i = 50; i < 64; ++i) c[i] = -3.0e38f;
            top16_of_64(c);
            float e[16], sum = 0.f;
#pragma unroll
            for (int k = 0; k < 16; ++k) { e[k] = __builtin_amdgcn_exp2f((c[k] - c[0]) * 1.44269504f); sum += e[k]; }
            const float inv = 1.0f / sum;
            const size_t o = (size_t)(tile * 128 + tid) * NPICK + h * 16;
#pragma unroll
            for (int k4 = 0; k4 < 4; ++k4) { i32x4 ei; f32x4 wv;
#pragma unroll
                for (int j = 0; j < 4; ++j) { const unsigned code = __float_as_uint(c[4 * k4 + j]) & 255u;
                    const unsigned i1 = __float_as_uint(topv[tid * 16 + (code >> 4)]) & 127u, i2 = __float_as_uint(topv[(128 + tid) * 16 + (code & 15u)]) & 127u;
                    ei[j] = (int)(i1 * 128u + i2); wv[j] = e[4 * k4 + j] * inv; }
                *(i32x4*)(SELI + o + 4 * k4) = ei; *(f32x4*)(SELW + o + 4 * k4) = wv; }
        }
        __syncthreads();
    }
}

__device__ __forceinline__ void gather_phase(const bf16_t* H, const bf16_t* TU, const bf16_t* TV, const int* SELI, const float* SELW, float* x, const float* gacc, const float* gbias, int gw, int NGW, int lane) {
    for (int ch = gw; ch < MTOK / 16; ch += NGW) {
        const int b = (ch * 16) >> 12;
        for (int tk = ch * 16; tk < ch * 16 + 16; ++tk) {
            const u32x4* hp = (const u32x4*)(H + (size_t)tk * DM);
            const u32x4 h0 = hp[lane], h1 = hp[64 + lane];
            const int e0 = SELI[(size_t)tk * NPICK + lane], e1 = SELI[(size_t)tk * NPICK + 64 + lane];
            const float w0 = SELW[(size_t)tk * NPICK + lane], w1 = SELW[(size_t)tk * NPICK + 64 + lane];
            float acc[16];
#pragma unroll
            for (int j = 0; j < 16; ++j) acc[j] = 0.f;
            for (int kb = 0; kb < 16; ++kb) {
                int e[8]; float wk[8];
#pragma unroll
                for (int j = 0; j < 8; ++j) { const int k = (kb & 7) * 8 + j;
                    e[j] = kb < 8 ? __builtin_amdgcn_readlane(e0, k) : __builtin_amdgcn_readlane(e1, k);
                    wk[j] = __uint_as_float(kb < 8 ? __builtin_amdgcn_readlane(__float_as_uint(w0), k) : __builtin_amdgcn_readlane(__float_as_uint(w1), k)); }
                u32x4 ua[8], ub[8];
#pragma unroll
                for (int j = 0; j < 8; ++j) { const u32x4* up = (const u32x4*)(TU + (size_t)e[j] * DM); ua[j] = up[lane]; ub[j] = up[64 + lane]; }
                float coef[8];
#pragma unroll
                for (int j = 0; j < 8; ++j) { float d0 = 0.f, d1 = 0.f;
                    d0 = dot2_bf16(ua[j].x, h0.x, d0); d1 = dot2_bf16(ua[j].y, h0.y, d1); d0 = dot2_bf16(ua[j].z, h0.z, d0); d1 = dot2_bf16(ua[j].w, h0.w, d1);
                    d0 = dot2_bf16(ub[j].x, h1.x, d0); d1 = dot2_bf16(ub[j].y, h1.y, d1); d0 = dot2_bf16(ub[j].z, h1.z, d0); d1 = dot2_bf16(ub[j].w, h1.w, d1);
                    coef[j] = wk[j] * gelu_tanh(wave_sum_all(d0 + d1)); }
#pragma unroll
                for (int j = 0; j < 8; ++j) { const u32x4* vp = (const u32x4*)(TV + (size_t)e[j] * DM); const u32x4 va = vp[lane], vb = vp[64 + lane]; const float cf = coef[j];
                    acc[0] += cf * bf_lo(va.x); acc[1] += cf * bf_hi(va.x); acc[2] += cf * bf_lo(va.y); acc[3] += cf * bf_hi(va.y);
                    acc[4] += cf * bf_lo(va.z); acc[5] += cf * bf_hi(va.z); acc[6] += cf * bf_lo(va.w); acc[7] += cf * bf_hi(va.w);
                    acc[8] += cf * bf_lo(vb.x); acc[9] += cf * bf_hi(vb.x); acc[10] += cf * bf_lo(vb.y); acc[11] += cf * bf_hi(vb.y);
                    acc[12] += cf * bf_lo(vb.z); acc[13] += cf * bf_hi(vb.z); acc[14] += cf * bf_lo(vb.w); acc[15] += cf * bf_hi(vb.w); }
            }
#pragma unroll
            for (int hh = 0; hh < 2; ++hh) { const int col = hh * 512 + 8 * lane;
                const f32x4 ga = *(const f32x4*)(gacc + (size_t)b * 6 * DM + col), gb = *(const f32x4*)(gacc + (size_t)b * 6 * DM + col + 4);
                f32x4* xp = (f32x4*)(x + (size_t)tk * DM + col);
                f32x4 xa = xp[0], xb = xp[1];
                xa += ga * (f32x4){acc[hh * 8 + 0], acc[hh * 8 + 1], acc[hh * 8 + 2], acc[hh * 8 + 3]};
                xb += gb * (f32x4){acc[hh * 8 + 4], acc[hh * 8 + 5], acc[hh * 8 + 6], acc[hh * 8 + 7]};
                xp[0] = xa; xp[1] = xb; }
        }
    }
}

constexpr int NPHASES = 37;
#ifndef PH_MASK
#define PH_MASK 0xFFFFFF
#endif
#define PHM(bit, call) do { if constexpr ((PH_MASK & (bit)) != 0) { call; } } while (0)
__global__ void __launch_bounds__(NTHREADS, 2) trunk_fwd(Args A) {
    extern __shared__ __attribute__((aligned(16))) unsigned char lds_raw[];
    LAS unsigned char* lds = (LAS unsigned char*)lds_raw;
    const int tid0 = threadIdx.x, wid = __builtin_amdgcn_readfirstlane(tid0 >> 6);
    const int G = gridDim.x, bx = blockIdx.x, vcu = (G % 8 == 0) ? (bx % 8) * (G / 8) + bx / 8 : bx;
    const int gw = vcu * 8 + wid, NGW = G * 8;
    const int ph_lo = A.ph_lo, ph_hi = A.ph_hi;

    for (int ph = ph_lo; ph < ph_hi; ++ph) {
        const int tid = opaque(tid0), lane = tid & 63;
        ArgP Ap = (ArgP)__builtin_amdgcn_kernarg_segment_ptr();
        asm volatile("" : "+s"(Ap));
        unsigned char* ws = Ap->ws;
        bf16_t* Hb = (bf16_t*)(ws + WS_H);
        unsigned char* mixb = ws + WS_MIX;
        const float* mod = (const float*)(ws + WS_MOD);
        float* xo = Ap->out;
        int layer, step;
        if (ph < 2) { layer = -1; step = ph; }
        else if (ph < 11) { layer = 0; step = ph - 2; }
        else if (ph < 19) { layer = 1; step = ph - 11; }
        else if (ph < 27) { layer = 2; step = ph - 19; }
        else if (ph < 36) { layer = 3; step = ph - 27; }
        else { layer = 4; step = 0; }
        const int kind = layer % 3, jl = layer / 3;
        const int nmix = (kind == 0) ? 5 : 4;
        const float* macc = mod + (size_t)(layer < 0 ? 0 : (layer > 3 ? 3 : layer)) * BATCH * 6 * DM;
        const float* mbias = Ap->in[I_ADA_B] + (size_t)(layer < 0 ? 0 : (layer > 3 ? 3 : layer)) * 6 * DM;
        const float* xin = (layer == 0) ? Ap->in[I_X] : xo;

        if (layer < 0) {
            if (step == 0) { PHM(1, prologue_phase(Ap, lds, vcu, G, tid, wid, lane)); }
            else { PHM(1, modreduce_phase(Ap, vcu, G, tid)); }
        } else if (layer > 3) {
            PHM(256, final_phase(xo, Ap->in[I_FINAL_G], gw, NGW, lane));
        } else if (step == 0) {
            PHM(2, norm_phase(xin, Ap->in[I_NORM_G] + (size_t)(layer * 2 + 0) * DM, macc, mbias, 0, DM, Hb, gw, NGW, lane));
        } else if (step < nmix) {
            pg8::StaticOrder S;
            if (kind == 0) {
                bf16_t* U = (bf16_t*)mixb; bf16_t* P = (bf16_t*)(mixb + 64 * MiB); bf16_t* Z = (bf16_t*)(mixb + 128 * MiB);
                if (step == 1) { pg8::Gemm g{Hb, (const bf16_t*)(ws + WS_POOL_WIN) + (size_t)jl * DM * DM, MTOK, DM, DM, DM, DM, 0}; S.init(MTOK, DM, G, bx);
                    pg8::EpiBf16<0> E{U, DM}; PHM(0x1000, pg8::gemm_phase(lds, g, S, E)); }
                else if (step == 2) { PHM(8, pool_elem_phase(U, P, vcu, G, tid)); }
                else if (step == 3) { pg8::Gemm g{P, (const bf16_t*)(ws + WS_POOL_WGRP) + (size_t)jl * 4 * 65536, MTOK, DM, 256, DM, 256, 256}; S.init(MTOK, DM, G, bx);
                    pg8::EpiPoolGrp E{Z, Ap->in[I_POOL_SCALE] + (size_t)jl * DM}; PHM(0x2000, pg8::gemm_phase(lds, g, S, E)); }
                else { pg8::Gemm g{Z, (const bf16_t*)(ws + WS_POOL_WOUT) + (size_t)jl * DM * DM, MTOK, DM, DM, DM, DM, 0}; S.init(MTOK, DM, G, bx);
                    pg8::EpiResid E{xin, xo, macc + 2 * DM, mbias + 2 * DM}; PHM(0x8000, pg8::gemm_phase(lds, g, S, E)); }
            } else if (kind == 1) {
                bf16_t* BG = (bf16_t*)mixb; bf16_t* Z = (bf16_t*)(mixb + 64 * MiB); bf16_t* AA = (bf16_t*)(mixb + 128 * MiB);
                if (step == 1) { pg8::Gemm g{Hb, (const bf16_t*)(ws + WS_CONV_WIN), MTOK, 3 * DM, DM, DM, DM, 0}; S.init(MTOK, 3 * DM, G, bx);
                    pg8::EpiConvIn E{BG, Z}; PHM(0x4000, pg8::gemm_phase(lds, g, S, E)); }
                else if (step == 2) { PHM(16, conv_elem_phase(BG, Z, Ap->in[I_CONV_W], AA, vcu, G, tid)); }
                else { pg8::Gemm g{AA, (const bf16_t*)(ws + WS_CONV_WOUT), MTOK, DM, DM, DM, DM, 0}; S.init(MTOK, DM, G, bx);
                    pg8::EpiResid E{xin, xo, macc + 2 * DM, mbias + 2 * DM}; PHM(0x8000, pg8::gemm_phase(lds, g, S, E)); }
            } else {
                bf16_t* UA = (bf16_t*)mixb; bf16_t* VT = (bf16_t*)(mixb + 192 * MiB);
                if (step == 1) {
                    { pg8::Gemm g{Hb, (const bf16_t*)(ws + WS_GMLP_WIN), MTOK, GH, DM, DM, DM, 0}; S.init(MTOK, GH, G, bx);
                      pg8::EpiBf16<1> E{UA, GH}; PHM(0x1000, pg8::gemm_phase(lds, g, S, E)); }
                    { pg8::Gemm g{Hb, (const bf16_t*)(ws + WS_GMLP_WIN) + (size_t)GH * DM, MTOK, GH, DM, DM, DM, 0}; S.init(MTOK, GH, G, bx);
                      pg8::EpiGmlpV E{VT}; PHM(0x10000, pg8::gemm_phase(lds, g, S, E)); }
                }
                else if (step == 2) { PHM(32, mix_phase(lds, UA, VT, Ap->in[I_GMLP_WS], Ap->in[I_GMLP_BS], Ap->in[I_GMLP_LNG], Ap->in[I_GMLP_LNB], vcu, G, tid, wid, lane)); }
                else { pg8::Gemm g{UA, (const bf16_t*)(ws + WS_GMLP_WOUT), MTOK, DM, GH, GH, GH, 0}; S.init(MTOK, DM, G, bx);
                    pg8::EpiResid E{xin, xo, macc + 2 * DM, mbias + 2 * DM}; PHM(0x8000, pg8::gemm_phase(lds, g, S, E)); }
            }
        } else {
            const int ps = step - nmix;
            bf16_t* Qb = (bf16_t*)mixb;
            if (ps == 0) { PHM(2, norm_phase(xo, Ap->in[I_NORM_G] + (size_t)(layer * 2 + 1) * DM, macc, mbias, 3 * DM, 4 * DM, Hb, gw, NGW, lane)); }
            else if (ps == 1) { pg8::StaticOrder S; pg8::Gemm g{Hb, (const bf16_t*)(ws + WS_PEER_WQ) + (size_t)layer * DM * 2048, MTOK, 2048, DM, DM, DM, 0}; S.init(MTOK, 2048, G, bx);
                pg8::EpiBf16<0> E{Qb, 2048}; PHM(0x1000, pg8::gemm_phase(lds, g, S, E)); }
            else if (ps == 2) PHM(64, topk_phase(lds, Qb, (const bf16_t*)(ws + WS_KEYS) + (size_t)layer * 16 * 128 * 128, (int*)(ws + WS_SELI), (float*)(ws + WS_SELW), vcu, G, tid, wid, lane));
            else PHM(128, gather_phase(Hb, (const bf16_t*)(ws + WS_TABU) + (size_t)layer * NEXP * DM, (const bf16_t*)(ws + WS_TABV) + (size_t)layer * NEXP * DM,
                              (const int*)(ws + WS_SELI), (const float*)(ws + WS_SELW), xo, macc + 5 * DM, mbias + 5 * DM, gw, NGW, lane));
        }
#if MK_ONE_LAUNCH
        if (ph + 1 < ph_hi) { cg::this_grid().sync(); }
#endif
    }
}

extern "C" void kernel_launch(void* const* d_in, const int* in_sizes, int n_in, void* d_out, int out_size, void* d_ws, size_t ws_size, hipStream_t stream) {
    static int grid = 0;
    if (grid == 0) {
        if (n_in != 23 || in_sizes[0] != MTOK * DM || out_size != MTOK * DM || ws_size < WS_END) {
            fprintf(stderr, "kernel_launch: unexpected shapes (n_in %d, in0 %d, out %d, ws %zu; need ws >= %zu); nothing launched\n", n_in, n_in > 0 ? in_sizes[0] : -1, out_size, ws_size, (size_t)WS_END); grid = -1; return; }
        int dev = 0, cus = 0, per_cu = 0;
        if (hipGetDevice(&dev) != hipSuccess || hipDeviceGetAttribute(&cus, hipDeviceAttributeMultiprocessorCount, dev) != hipSuccess) { grid = -1; return; }
        if (hipFuncSetAttribute((const void*)trunk_fwd, hipFuncAttributeMaxDynamicSharedMemorySize, LDS_BYTES) != hipSuccess) { fprintf(stderr, "kernel_launch: hipFuncSetAttribute failed\n"); grid = -1; return; }
        if (hipOccupancyMaxActiveBlocksPerMultiprocessor(&per_cu, (const void*)trunk_fwd, NTHREADS, LDS_BYTES) != hipSuccess || per_cu < 1) { fprintf(stderr, "kernel_launch: occupancy query says %d blocks per CU\n", per_cu); (void)hipGetLastError(); grid = -1; return; }
        grid = cus * (per_cu < 1 ? 1 : 1);
    }
    if (grid < 0) return;
    (void)hipMemsetAsync((char*)d_ws + WS_CTL, 0, ZERO_BYTES, stream);
    Args a{};
    for (int i = 0; i < 23; ++i) a.in[i] = (const float*)d_in[i];
    a.out = (float*)d_out; a.ws = (unsigned char*)d_ws;
#if MK_ONE_LAUNCH
    a.ph_lo = 0; a.ph_hi = NPHASES;
    void* args[] = {&a};
    hipError_t e = hipLaunchCooperativeKernel((const void*)trunk_fwd, dim3(grid), dim3(NTHREADS), args, LDS_BYTES, stream);
    if (e != hipSuccess) fprintf(stderr, "cooperative launch failed: %s (grid %d)\n", hipGetErrorString(e), grid);
#else
    for (int ph = 0; ph < NPHASES; ++ph) { a.ph_lo = ph; a.ph_hi = ph + 1; hipLaunchKernelGGL(trunk_fwd, dim3(grid), dim3(NTHREADS), LDS_BYTES, stream, a); }
#endif
}
```

```cpp
#include <hip/hip_runtime.h>
#include <hip/hip_cooperative_groups.h>
#include <cstdio>
#include <cstdint>
namespace cg = cooperative_groups;

#ifndef MK_ONE_LAUNCH
#define MK_ONE_LAUNCH 1
#endif

#define LAS __attribute__((address_space(3)))
typedef unsigned short bf16_t;
typedef short bf16x8 __attribute__((ext_vector_type(8)));
typedef float f32x2 __attribute__((ext_vector_type(2)));
typedef float f32x4 __attribute__((ext_vector_type(4)));
typedef float f32x16 __attribute__((ext_vector_type(16)));
typedef unsigned u32x2 __attribute__((ext_vector_type(2)));
typedef unsigned u32x4 __attribute__((ext_vector_type(4)));
typedef int i32x4 __attribute__((ext_vector_type(4)));
typedef __bf16 bf16x2 __attribute__((ext_vector_type(2)));

constexpr int DM = 1024, BATCH = 8, SEQ = 4096, MTOK = BATCH * SEQ, DEPTH = 4;
constexpr int GH = 3072;
constexpr int NEXP = 16384, NPICK = 128;
constexpr float EPS = 1e-6f;

constexpr size_t MiB = 1u << 20;
constexpr size_t WS_CTL = 0, WS_MOD = 1 * MiB, ZERO_BYTES = 2 * MiB;
constexpr size_t WS_POOL_WIN = 2 * MiB, WS_POOL_WGRP = 6 * MiB, WS_POOL_WOUT = 7 * MiB;
constexpr size_t WS_CONV_WIN = 11 * MiB, WS_CONV_WOUT = 17 * MiB;
constexpr size_t WS_GMLP_WIN = 19 * MiB, WS_GMLP_WOUT = 31 * MiB;
constexpr size_t WS_PEER_WQ = 37 * MiB, WS_KEYS = 53 * MiB;
constexpr size_t WS_H = 56 * MiB;
constexpr size_t WS_SELI = 120 * MiB, WS_SELW = 136 * MiB;
constexpr size_t WS_TABU = 152 * MiB, WS_TABV = 280 * MiB;
constexpr size_t WS_MIX = 408 * MiB;
constexpr size_t WS_ADAP = 792 * MiB;
constexpr size_t WS_END = 804 * MiB;

__device__ __forceinline__ unsigned cvt_pk_bf16(float lo, float hi) { unsigned r; asm volatile("v_cvt_pk_bf16_f32 %0, %1, %2" : "=v"(r) : "v"(lo), "v"(hi)); return r; }
__device__ __forceinline__ int opaque(int x) { asm volatile("" : "+v"(x)); return x; }
__device__ __forceinline__ float bf_lo(unsigned w) { return __uint_as_float(w << 16); }
__device__ __forceinline__ float bf_hi(unsigned w) { return __uint_as_float(w & 0xffff0000u); }
__device__ __forceinline__ float gelu_tanh(float x) {
    const float y = x * (1.0f + 0.044715f * x * x);
    const float e = __builtin_amdgcn_exp2f(-2.302208198f * y);
    return x * __builtin_amdgcn_rcpf(1.0f + e);
}
__device__ __forceinline__ float wave_sum_all(float v) {
#pragma unroll
    for (int o = 1; o < 64; o <<= 1) v += __shfl_xor(v, o);
    return v;
}
__device__ __forceinline__ float dot2_bf16(unsigned w, unsigned x, float acc) { return __builtin_amdgcn_fdot2_f32_bf16(__builtin_bit_cast(bf16x2, w), __builtin_bit_cast(bf16x2, x), acc, false); }

namespace pg8 {
constexpr int BM = 256, BK = 64, HALF = 128, HTB = HALF * BK * 2, STAGE_BYTES = 8 * HTB, NXCD = 8, WGM = 8;
__device__ __forceinline__ int lds_byte(int r, int c) { const int st = (r >> 4) * 2 + (c >> 5), rr = r & 15, cc = c & 31, ob = rr * 64 + cc * 2; return st * 1024 + (ob ^ (((ob >> 9) & 1) << 5)); }
__device__ __forceinline__ void stage_rc(int b, int& R, int& C) { const int st = b / 1024, sb = b % 1024, swz = sb ^ (((sb >> 9) & 1) << 5); R = (st >> 1) * 16 + swz / 64; C = (st & 1) * 32 + (swz % 64) / 2; }
__device__ __forceinline__ int perm32(int rho) { const int n = rho >> 4, i = rho & 15; return 8 * (i >> 2) + 4 * n + (i & 3); }

struct Unit { int pm, pn; };
struct Gemm { const bf16_t* A; const bf16_t* Bt; int M, N, K, lda, ldb, a_pn_off; };

struct StaticOrder {
    int nM, nN, nwg, G, c;
    __device__ __forceinline__ void init(int M, int N, int G_, int c_) { nM = M / BM; nN = N / BM; nwg = nM * nN; G = G_; c = c_; }
    __device__ __forceinline__ bool next(int i, Unit& u) const {
        const long L = (long)i * G + c; if (L >= nwg) return false;
        int wgid = (int)L; { const int q = nwg / NXCD, r = nwg % NXCD, xcd = wgid % NXCD, off = wgid / NXCD; wgid = (xcd < r ? xcd * (q + 1) : r * (q + 1) + (xcd - r) * q) + off; }
        const int nig = WGM * nN, gid = wgid / nig, fm = gid * WGM, gsz = (nM - fm) < WGM ? (nM - fm) : WGM;
        u.pm = fm + ((wgid % nig) % gsz); u.pn = (wgid % nig) / gsz; return true;
    }
};

template <class Epi>
__device__ __forceinline__ void gemm_phase(LAS unsigned char* lds, const Gemm g, const StaticOrder& S, const Epi& E) {
    const int tid = opaque((int)threadIdx.x), wid = __builtin_amdgcn_readfirstlane(tid >> 6), lane = tid & 63, wr = wid >> 2, wc = wid & 3, fr = lane & 15, fq = lane >> 4;
    const int nt = g.K / BK;
    unsigned voffA[2], voffB[2];
#pragma unroll
    for (int i = 0; i < 2; ++i) { int R, C; stage_rc(tid * 16 + i * 8192, R, C); const int Rb = Epi::PERM ? ((R & ~31) + perm32(R & 31)) : R;
        voffA[i] = (unsigned)(R * g.lda + C) * 2u; voffB[i] = (unsigned)(Rb * g.ldb + C) * 2u; }
    const size_t kstep = (size_t)(BK * 2);
    const size_t hstepA = (size_t)HALF * g.lda * 2, hstepB = (size_t)HALF * g.ldb * 2;
    const size_t tstepA = 2 * hstepA, tstepB = 2 * hstepB;
    const unsigned ldsw = (unsigned)wid * 1024u;
    const int aoff = lds_byte(wr * 64 + fr, fq * 8), boff = lds_byte(wc * 32 + fr, fq * 8);
#define PG8_SA(b, h) (((b) * 2 + (h)) * HTB)
#define PG8_SB(b, h) ((4 + (b) * 2 + (h)) * HTB)
#define PG8_STAGE(bufoff, gbase, voff) do { _Pragma("unroll") for (int _i = 0; _i < 2; ++_i) \
        __builtin_amdgcn_global_load_lds((const unsigned*)((const char*)(gbase) + (voff)[_i]), (LAS unsigned*)(lds + (bufoff) + ldsw + _i * 8192), 16, 0, 0); } while (0)
#define PG8_LDA(dst, b, h) do { _Pragma("unroll") for (int m = 0; m < 4; ++m) _Pragma("unroll") for (int k = 0; k < 2; ++k) dst[m][k] = *(const LAS bf16x8*)(lds + PG8_SA(b, h) + aoff + m * 2048 + k * 1024); } while (0)
#define PG8_LDB(dst, b, h) do { _Pragma("unroll") for (int n = 0; n < 2; ++n) _Pragma("unroll") for (int k = 0; k < 2; ++k) dst[n][k] = *(const LAS bf16x8*)(lds + PG8_SB(b, h) + boff + n * 2048 + k * 1024); } while (0)
#define PG8_MMA(ai, bj, At, Bt) do { __builtin_amdgcn_s_setprio(1); _Pragma("unroll") for (int m = 0; m < 4; ++m) _Pragma("unroll") for (int n = 0; n < 2; ++n) _Pragma("unroll") for (int k = 0; k < 2; ++k) \
        acc[ai][bj][m][n] = Epi::SWAP ? __builtin_amdgcn_mfma_f32_16x16x32_bf16(At[m][k], Bt[n][k], acc[ai][bj][m][n], 0, 0, 0) \
                                      : __builtin_amdgcn_mfma_f32_16x16x32_bf16(Bt[n][k], At[m][k], acc[ai][bj][m][n], 0, 0, 0); __builtin_amdgcn_s_setprio(0); } while (0)
#define PG8_WAIT_V(n) asm volatile("s_waitcnt vmcnt(" #n ")" ::: "memory")
#define PG8_WAIT_L(n) asm volatile("s_waitcnt lgkmcnt(" #n ")" ::: "memory")
#define PG8_BAR __builtin_amdgcn_s_barrier()
#define PG8_SCHED __builtin_amdgcn_sched_barrier(0)
    Unit cur, nxt; int ui = 0;
    if (!S.next(0, cur)) return;
    f32x4 acc[2][2][4][2];
#pragma unroll
    for (int a = 0; a < 2; ++a)
#pragma unroll
        for (int b = 0; b < 2; ++b)
#pragma unroll
            for (int m = 0; m < 4; ++m)
#pragma unroll
                for (int n = 0; n < 2; ++n) acc[a][b][m][n] = (f32x4){0.f, 0.f, 0.f, 0.f};
    bf16x8 At[4][2], B0[2][2], B1[2][2];
    const char* cA = (const char*)g.A + (size_t)cur.pm * tstepA + (size_t)cur.pn * g.a_pn_off * 2; const char* cB = (const char*)g.Bt + (size_t)cur.pn * tstepB;
    PG8_STAGE(PG8_SB(0, 0), cB, voffB); PG8_STAGE(PG8_SA(0, 0), cA, voffA); PG8_STAGE(PG8_SB(0, 1), cB + hstepB, voffB); PG8_STAGE(PG8_SA(0, 1), cA + hstepA, voffA);
    if (wr == 1) PG8_BAR;
    PG8_WAIT_V(4); PG8_BAR;
    PG8_STAGE(PG8_SB(1, 0), cB + kstep, voffB); PG8_STAGE(PG8_SA(1, 0), cA + kstep, voffA); PG8_STAGE(PG8_SB(1, 1), cB + hstepB + kstep, voffB);
    PG8_WAIT_V(6); PG8_BAR;
    for (;;) {
        const bool has_next = S.next(ui + 1, nxt);
        const char* nA = has_next ? (const char*)g.A + (size_t)nxt.pm * tstepA + (size_t)nxt.pn * g.a_pn_off * 2 : cA; const char* nB = has_next ? (const char*)g.Bt + (size_t)nxt.pn * tstepB : cB;
        for (int t = 0; t < nt; t += 2) {
            const bool last = (t == nt - 2);
            const char* a1 = cA + (size_t)(t + 1) * kstep;
            const char* a2 = last ? nA : cA + (size_t)(t + 2) * kstep; const char* b2 = last ? nB : cB + (size_t)(t + 2) * kstep;
            const char* a3 = a2 + kstep; const char* b3 = b2 + kstep;
            PG8_LDB(B0, 0, 0); PG8_SCHED; PG8_LDA(At, 0, 0); PG8_STAGE(PG8_SA(1, 1), a1 + hstepA, voffA);
            PG8_WAIT_L(8); PG8_BAR; PG8_WAIT_L(0); PG8_MMA(0, 0, At, B0); PG8_BAR; PG8_SCHED;
            PG8_LDB(B1, 0, 1); PG8_STAGE(PG8_SB(0, 0), b2, voffB);
            PG8_BAR; PG8_WAIT_L(0); PG8_MMA(0, 1, At, B1); PG8_BAR;
            PG8_LDA(At, 0, 1); PG8_STAGE(PG8_SA(0, 0), a2, voffA);
            PG8_BAR; PG8_WAIT_L(0); PG8_MMA(1, 0, At, B0); PG8_BAR; PG8_SCHED;
            PG8_STAGE(PG8_SB(0, 1), b2 + hstepB, voffB);
            PG8_WAIT_V(6); PG8_BAR; PG8_MMA(1, 1, At, B1); PG8_BAR;
            PG8_LDB(B0, 1, 0); PG8_SCHED; PG8_LDA(At, 1, 0); PG8_STAGE(PG8_SA(0, 1), a2 + hstepA, voffA);
            PG8_WAIT_L(8); PG8_BAR; PG8_WAIT_L(0); PG8_MMA(0, 0, At, B0); PG8_BAR; PG8_SCHED;
            PG8_LDB(B1, 1, 1); PG8_STAGE(PG8_SB(1, 0), b3, voffB);
            PG8_BAR; PG8_WAIT_L(0); PG8_MMA(0, 1, At, B1); PG8_BAR;
            PG8_LDA(At, 1, 1); PG8_STAGE(PG8_SA(1, 0), a3, voffA);
            PG8_BAR; PG8_WAIT_L(0); PG8_MMA(1, 0, At, B0); PG8_BAR; PG8_SCHED;
            PG8_STAGE(PG8_SB(1, 1), b3 + hstepB, voffB);
            PG8_WAIT_V(6); PG8_BAR; PG8_MMA(1, 1, At, B1); PG8_BAR;
        }
        { const int l2 = opaque((int)threadIdx.x) & 63; E(acc, cur, wr, wc, l2 & 15, l2 >> 4); }
        if (!has_next) break;
#pragma unroll
        for (int a = 0; a < 2; ++a)
#pragma unroll
            for (int b = 0; b < 2; ++b)
#pragma unroll
                for (int m = 0; m < 4; ++m)
#pragma unroll
                    for (int n = 0; n < 2; ++n) acc[a][b][m][n] = (f32x4){0.f, 0.f, 0.f, 0.f};
        cur = nxt; cA = nA; cB = nB; ++ui;
    }
    PG8_WAIT_V(0);
    if (wr == 0) PG8_BAR;
    PG8_BAR;
#undef PG8_SA
#undef PG8_SB
#undef PG8_STAGE
#undef PG8_LDA
#undef PG8_LDB
#undef PG8_MMA
#undef PG8_WAIT_V
#undef PG8_WAIT_L
#undef PG8_BAR
#undef PG8_SCHED
}

template <int ACT> struct EpiBf16 {
    static constexpr bool PERM = true, SWAP = false;
    bf16_t* O; int ldc;
    __device__ __forceinline__ void operator()(const f32x4 (&acc)[2][2][4][2], const Unit& u, int wr, int wc, int fr, int fq) const {
        const int row0 = u.pm * BM + wr * 64 + fr, col0 = u.pn * BM + wc * 32 + 8 * fq;
#pragma unroll
        for (int ai = 0; ai < 2; ++ai)
#pragma unroll
            for (int m = 0; m < 4; ++m) { bf16_t* rowp = O + (size_t)(row0 + ai * HALF + m * 16) * ldc + col0;
#pragma unroll
                for (int bj = 0; bj < 2; ++bj) { f32x4 v0 = acc[ai][bj][m][0], v1 = acc[ai][bj][m][1];
                    if (ACT == 1) {
#pragma unroll
                        for (int j = 0; j < 4; ++j) { v0[j] = gelu_tanh(v0[j]); v1[j] = gelu_tanh(v1[j]); } }
                    u32x4 w; w.x = cvt_pk_bf16(v0[0], v0[1]); w.y = cvt_pk_bf16(v0[2], v0[3]); w.z = cvt_pk_bf16(v1[0], v1[1]); w.w = cvt_pk_bf16(v1[2], v1[3]);
                    *(u32x4*)(rowp + bj * HALF) = w; } }
    }
};
struct EpiPoolGrp {
    static constexpr bool PERM = true, SWAP = false;
    bf16_t* O; const float* scale;
    __device__ __forceinline__ void operator()(const f32x4 (&acc)[2][2][4][2], const Unit& u, int wr, int wc, int fr, int fq) const {
        const int row0 = u.pm * BM + wr * 64 + fr, col0 = u.pn * BM + wc * 32 + 8 * fq;
#pragma unroll
        for (int bj = 0; bj < 2; ++bj) {
            const f32x4 s0 = *(const f32x4*)(scale + col0 + bj * HALF), s1 = *(const f32x4*)(scale + col0 + bj * HALF + 4);
#pragma unroll
            for (int ai = 0; ai < 2; ++ai)
#pragma unroll
                for (int m = 0; m < 4; ++m) { bf16_t* rowp = O + (size_t)(row0 + ai * HALF + m * 16) * DM + col0 + bj * HALF;
                    const f32x4 v0 = acc[ai][bj][m][0] * s0, v1 = acc[ai][bj][m][1] * s1;
                    u32x4 w; w.x = cvt_pk_bf16(v0[0], v0[1]); w.y = cvt_pk_bf16(v0[2], v0[3]); w.z = cvt_pk_bf16(v1[0], v1[1]); w.w = cvt_pk_bf16(v1[2], v1[3]);
                    *(u32x4*)rowp = w; }
            asm volatile("" ::: "memory");
        }
    }
};
struct EpiConvIn {
    static constexpr bool PERM = true, SWAP = false;
    bf16_t* BG; bf16_t* Z;
    __device__ __forceinline__ void operator()(const f32x4 (&acc)[2][2][4][2], const Unit& u, int wr, int wc, int fr, int fq) const {
        const int row0 = u.pm * BM + wr * 64 + fr;
        if (u.pn < 4) {
            const int col0 = u.pn * BM + wc * 32 + 8 * fq;
#pragma unroll
            for (int ai = 0; ai < 2; ++ai)
#pragma unroll
                for (int m = 0; m < 4; ++m) { bf16_t* rowp = BG + (size_t)(row0 + ai * HALF + m * 16) * DM + col0;
#pragma unroll
                    for (int bj = 0; bj < 2; ++bj) { const f32x4 v0 = acc[ai][bj][m][0], v1 = acc[ai][bj][m][1];
                        u32x4 w; w.x = cvt_pk_bf16(v0[0], v0[1]); w.y = cvt_pk_bf16(v0[2], v0[3]); w.z = cvt_pk_bf16(v1[0], v1[1]); w.w = cvt_pk_bf16(v1[2], v1[3]);
                        *(u32x4*)(rowp + bj * HALF) = w; } }
        } else {
            const int col0 = (u.pn - 4) * HALF + wc * 32 + 8 * fq;
#pragma unroll
            for (int ai = 0; ai < 2; ++ai)
#pragma unroll
                for (int m = 0; m < 4; ++m) { bf16_t* rowp = Z + (size_t)(row0 + ai * HALF + m * 16) * DM + col0;
                    const f32x4 v0 = acc[ai][0][m][0] * acc[ai][1][m][0], v1 = acc[ai][0][m][1] * acc[ai][1][m][1];
                    u32x4 w; w.x = cvt_pk_bf16(v0[0], v0[1]); w.y = cvt_pk_bf16(v0[2], v0[3]); w.z = cvt_pk_bf16(v1[0], v1[1]); w.w = cvt_pk_bf16(v1[2], v1[3]);
                    *(u32x4*)rowp = w; }
        }
    }
};
struct EpiResid {
    static constexpr bool PERM = false, SWAP = false;
    const float* base; float* out; const float* gacc; const float* gbias;
    __device__ __forceinline__ void operator()(const f32x4 (&acc)[2][2][4][2], const Unit& u, int wr, int wc, int fr, int fq) const {
        const int row0 = u.pm * BM + wr * 64 + fr, col0 = u.pn * BM + wc * 32 + 4 * fq;
        const float* gp = gacc + (size_t)(u.pm >> 4) * (6 * DM);
#pragma unroll
        for (int bj = 0; bj < 2; ++bj)
#pragma unroll
            for (int n = 0; n < 2; ++n) { const int cc = col0 + bj * HALF + n * 16;
                const f32x4 gv = *(const f32x4*)(gp + cc);
#pragma unroll
                for (int ai = 0; ai < 2; ++ai) {
#pragma unroll
                    for (int m = 0; m < 4; ++m) { const size_t off = (size_t)(row0 + ai * HALF + m * 16) * DM + cc;
                        const f32x4 bs = *(const f32x4*)(base + off);
                        *(f32x4*)(out + off) = bs + gv * acc[ai][bj][m][n]; }
                    asm volatile("" ::: "memory"); } }
    }
};
struct EpiGmlpV {
    static constexpr bool PERM = false, SWAP = true;
    bf16_t* VT;
    __device__ __forceinline__ void operator()(const f32x4 (&acc)[2][2][4][2], const Unit& u, int wr, int wc, int fr, int fq) const {
        const int row0 = u.pm * BM + wr * 64 + 4 * fq, col0 = u.pn * BM + wc * 32 + fr;
#pragma unroll
        for (int bj = 0; bj < 2; ++bj)
#pragma unroll
            for (int n = 0; n < 2; ++n) { bf16_t* colp = VT + (size_t)(col0 + bj * HALF + n * 16) * MTOK + row0;
#pragma unroll
                for (int ai = 0; ai < 2; ++ai)
#pragma unroll
                    for (int m = 0; m < 4; ++m) { const f32x4 v = acc[ai][bj][m][n];
                        u32x2 w; w.x = cvt_pk_bf16(gelu_tanh(v[0]), gelu_tanh(v[1])); w.y = cvt_pk_bf16(gelu_tanh(v[2]), gelu_tanh(v[3]));
                        *(u32x2*)(colp + ai * HALF + m * 16) = w; } }
    }
};
}

constexpr int RING_BYTES = 131072;
constexpr int LDS_BYTES = 147456;
constexpr int NTHREADS = 512;

#define CE_DESC(a, b) do { const float _x = fmaxf(a, b), _y = fminf(a, b); a = _x; b = _y; } while (0)
#define CE_ASC(a, b)  do { const float _x = fminf(a, b), _y = fmaxf(a, b); a = _x; b = _y; } while (0)
template <int OFF, int N>
__device__ __forceinline__ void sort16_desc(float (&v)[N]) {
#pragma unroll
    for (int k = 2; k <= 16; k <<= 1)
#pragma unroll
        for (int j = k >> 1; j > 0; j >>= 1)
#pragma unroll
            for (int i = 0; i < 16; ++i) { const int l = i ^ j; if (l > i) { if ((i & k) == 0) CE_DESC(v[OFF + i], v[OFF + l]); else CE_ASC(v[OFF + i], v[OFF + l]); } }
}
template <int OFF, int N>
__device__ __forceinline__ void bmerge16_desc(float (&v)[N]) {
#pragma unroll
    for (int j = 8; j > 0; j >>= 1)
#pragma unroll
        for (int i = 0; i < 16; ++i) { const int l = i ^ j; if (l > i) CE_DESC(v[OFF + i], v[OFF + l]); }
}
template <int A, int B, int N>
__device__ __forceinline__ void merge_top16(float (&v)[N]) {
#pragma unroll
    for (int i = 0; i < 16; ++i) v[A + i] = fmaxf(v[A + i], v[B + 15 - i]);
    bmerge16_desc<A, N>(v);
}
__device__ __forceinline__ void top16_of_64(float (&v)[64]) {
    sort16_desc<0, 64>(v); sort16_desc<16, 64>(v); sort16_desc<32, 64>(v); sort16_desc<48, 64>(v);
    merge_top16<0, 16, 64>(v); merge_top16<32, 48, 64>(v); merge_top16<0, 32, 64>(v);
}

struct Args { const float* in[23]; float* out; unsigned char* ws; int ph_lo, ph_hi; };
typedef const __attribute__((address_space(4))) Args* ArgP;
enum { I_X = 0, I_C, I_ADA_W, I_ADA_B, I_NORM_G, I_POOL_WIN, I_POOL_WGRP, I_POOL_SCALE, I_POOL_WOUT, I_CONV_WIN, I_CONV_W, I_CONV_WOUT,
       I_GMLP_WIN, I_GMLP_LNG, I_GMLP_LNB, I_GMLP_WS, I_GMLP_BS, I_GMLP_WOUT, I_PEER_WQ, I_PEER_KEYS, I_PEER_U, I_PEER_V, I_FINAL_G };

__device__ __forceinline__ void transpose_item(const float* W, int K, int N, bf16_t* WT, int dst_row0, LAS float* scr, int k0, int n0, int lane) {
#pragma unroll 8
    for (int i = 0; i < 32; ++i) { const int kk = 2 * i + (lane >> 5); scr[kk * 33 + (lane & 31)] = W[(size_t)(k0 + kk) * N + n0 + (lane & 31)]; }
    asm volatile("s_waitcnt lgkmcnt(0)" ::: "memory");
    const int c = lane & 7;
#pragma unroll
    for (int j = 0; j < 4; ++j) { const int n = (lane >> 3) + 8 * j; const LAS float* s = scr + (8 * c) * 33 + n;
        u32x4 o; o.x = cvt_pk_bf16(s[0 * 33], s[1 * 33]); o.y = cvt_pk_bf16(s[2 * 33], s[3 * 33]); o.z = cvt_pk_bf16(s[4 * 33], s[5 * 33]); o.w = cvt_pk_bf16(s[6 * 33], s[7 * 33]);
        *(u32x4*)(WT + (size_t)(dst_row0 + n) * K + k0 + 8 * c) = o; }
    asm volatile("s_waitcnt lgkmcnt(0)" ::: "memory");
}
__device__ __forceinline__ void convert_stream(const float* src, bf16_t* dst, size_t n8, size_t gt, size_t stride) {
    for (size_t i = gt; i < n8; i += stride) {
        const f32x4 a = __builtin_nontemporal_load((const f32x4*)src + 2 * i), b = __builtin_nontemporal_load((const f32x4*)src + 2 * i + 1);
        u32x4 o; o.x = cvt_pk_bf16(a[0], a[1]); o.y = cvt_pk_bf16(a[2], a[3]); o.z = cvt_pk_bf16(b[0], b[1]); o.w = cvt_pk_bf16(b[2], b[3]);
        *((u32x4*)dst + i) = o; }
}
__device__ __forceinline__ void prologue_phase(ArgP Ap, LAS unsigned char* lds, int vcu, int G, int tid, int wid, int lane) {
    unsigned char* ws = Ap->ws;
    const int gw = vcu * 8 + wid, NGW = G * 8;
    LAS float* scr = (LAS float*)(lds + wid * 16384);
    constexpr int NT_ITEMS = 1024 + 256 + 1024 + 1536 + 512 + 3072 + 1536 + 4096;
    for (int it = gw; it < NT_ITEMS; it += NGW) {
        int r = it; const float* src; bf16_t* dst; int K, N, kind = 0;
        if (r < 1024) { const int m = r >> 9; r &= 511; src = Ap->in[I_POOL_WIN] + (size_t)m * DM * DM; dst = (bf16_t*)(ws + WS_POOL_WIN) + (size_t)m * DM * DM; K = DM; N = DM; }
        else if ((r -= 1024) < 256) { const int m = r >> 5; r &= 31; src = Ap->in[I_POOL_WGRP] + (size_t)m * 65536; dst = (bf16_t*)(ws + WS_POOL_WGRP) + (size_t)m * 65536; K = 256; N = 256; }
        else if ((r -= 256) < 1024) { const int m = r >> 9; r &= 511; src = Ap->in[I_POOL_WOUT] + (size_t)m * DM * DM; dst = (bf16_t*)(ws + WS_POOL_WOUT) + (size_t)m * DM * DM; K = DM; N = DM; }
        else if ((r -= 1024) < 1536) { src = Ap->in[I_CONV_WIN]; dst = (bf16_t*)(ws + WS_CONV_WIN); K = DM; N = 3 * DM; kind = 1; }
        else if ((r -= 1536) < 512) { src = Ap->in[I_CONV_WOUT]; dst = (bf16_t*)(ws + WS_CONV_WOUT); K = DM; N = DM; }
        else if ((r -= 512) < 3072) { src = Ap->in[I_GMLP_WIN]; dst = (bf16_t*)(ws + WS_GMLP_WIN); K = DM; N = 2 * GH; }
        else if ((r -= 3072) < 1536) { src = Ap->in[I_GMLP_WOUT]; dst = (bf16_t*)(ws + WS_GMLP_WOUT); K = GH; N = DM; }
        else { r -= 1536; const int m = r >> 10; r &= 1023; src = Ap->in[I_PEER_WQ] + (size_t)m * DM * 2048; dst = (bf16_t*)(ws + WS_PEER_WQ) + (size_t)m * DM * 2048; K = DM; N = 2048; }
        const int nblk = N / 32, kb = r / nblk, nb = r % nblk, n0 = 32 * nb;
        int drow = n0;
        if (kind == 1 && n0 >= DM) { const int xt = n0 >= 2 * DM, ch = n0 - (xt ? 2 * DM : DM); drow = DM + 256 * (ch >> 7) + 128 * xt + (ch & 127); }
        transpose_item(src, K, N, dst, drow, scr, 64 * kb, n0, lane);
    }
    const size_t gt = (size_t)vcu * NTHREADS + tid, stride = (size_t)G * NTHREADS;
    convert_stream(Ap->in[I_PEER_KEYS], (bf16_t*)(ws + WS_KEYS), (size_t)DEPTH * 16 * 128 * 128 / 8, gt, stride);
    convert_stream(Ap->in[I_PEER_U], (bf16_t*)(ws + WS_TABU), (size_t)DEPTH * NEXP * DM / 8, gt, stride);
    convert_stream(Ap->in[I_PEER_V], (bf16_t*)(ws + WS_TABV), (size_t)DEPTH * NEXP * DM / 8, gt, stride);
    __syncthreads();
    LAS float* cond = (LAS float*)lds;
    for (int i = tid; i < BATCH * DM; i += NTHREADS) { const int b = i >> 10, k = i & 1023; const float c = Ap->in[I_C][i]; cond[k * 8 + b] = c * __builtin_amdgcn_rcpf(1.0f + __expf(-c)); }
    __syncthreads();
    float* modp = (float*)(ws + WS_ADAP);
    for (int it = gw; it < DEPTH * 24 * 16; it += NGW) {
        const int l = it / 384, r = it % 384, cgp = r >> 4, kc = r & 15;
        const float* wp = Ap->in[I_ADA_W] + ((size_t)l * DM + kc * 64) * (6 * DM) + cgp * 256 + 4 * lane;
        f32x4 acc[8];
#pragma unroll
        for (int b = 0; b < 8; ++b) acc[b] = (f32x4){0.f, 0.f, 0.f, 0.f};
#pragma unroll 8
        for (int k = 0; k < 64; ++k) { const f32x4 w = __builtin_nontemporal_load((const f32x4*)(wp + (size_t)k * (6 * DM)));
            const f32x4 c0 = *(const LAS f32x4*)(cond + (kc * 64 + k) * 8), c1 = *(const LAS f32x4*)(cond + (kc * 64 + k) * 8 + 4);
            acc[0] += c0[0] * w; acc[1] += c0[1] * w; acc[2] += c0[2] * w; acc[3] += c0[3] * w; acc[4] += c1[0] * w; acc[5] += c1[1] * w; acc[6] += c1[2] * w; acc[7] += c1[3] * w; }
#pragma unroll
        for (int b = 0; b < 8; ++b) *(f32x4*)(modp + (((size_t)kc * DEPTH + l) * 8 + b) * (6 * DM) + cgp * 256 + 4 * lane) = acc[b];
    }
}
__device__ __forceinline__ void modreduce_phase(ArgP Ap, int vcu, int G, int tid) {
    unsigned char* ws = Ap->ws; const float* modp = (const float*)(ws + WS_ADAP); float* mod = (float*)(ws + WS_MOD);
    constexpr int N4 = DEPTH * BATCH * 6 * DM / 4;
    for (int i = vcu * NTHREADS + tid; i < N4; i += G * NTHREADS) {
        const int n4 = i % (6 * DM / 4), l = i / (BATCH * 6 * DM / 4);
        f32x4 a = *((const f32x4*)(Ap->in[I_ADA_B] + (size_t)l * 6 * DM) + n4);
#pragma unroll
        for (int kc = 0; kc < 16; ++kc) a += *((const f32x4*)modp + (size_t)kc * N4 + i);
        *((f32x4*)mod + i) = a; }
}

__device__ __forceinline__ void norm_phase(const float* x, const float* gn, const float* macc  , const float* mbias  , int sh_off, int sc_off, bf16_t* H, int gw, int NGW, int lane) {
    for (int ch = gw; ch < MTOK / 16; ch += NGW) {
        const int row0 = ch * 16, b = row0 >> 12;
        f32x4 c1[4], shv[4];
#pragma unroll
        for (int j = 0; j < 4; ++j) { const int col = 4 * lane + 256 * j;
            const f32x4 sc = *(const f32x4*)(macc + (size_t)b * 6 * DM + sc_off + col);
            c1[j] = *(const f32x4*)(gn + col) * (1.0f + sc);
            shv[j] = *(const f32x4*)(macc + (size_t)b * 6 * DM + sh_off + col); }
        for (int r = row0; r < row0 + 16; ++r) {
            const f32x4* xr = (const f32x4*)(x + (size_t)r * DM) + lane;
            f32x4 v[4]; float ss = 0.f;
#pragma unroll
            for (int j = 0; j < 4; ++j) { v[j] = xr[64 * j]; ss += (v[j][0] * v[j][0] + v[j][1] * v[j][1]) + (v[j][2] * v[j][2] + v[j][3] * v[j][3]); }
            const float rstd = __builtin_amdgcn_rsqf(wave_sum_all(ss) * (1.0f / DM) + EPS);
            u32x2* o8 = (u32x2*)(H + (size_t)r * DM) + lane;
#pragma unroll
            for (int j = 0; j < 4; ++j) { const f32x4 o = v[j] * rstd * c1[j] + shv[j]; u32x2 w; w.x = cvt_pk_bf16(o[0], o[1]); w.y = cvt_pk_bf16(o[2], o[3]); o8[64 * j] = w; }
        }
    }
}
__device__ __forceinline__ void final_phase(float* x, const float* gf, int gw, int NGW, int lane) {
    f32x4 gv[4];
#pragma unroll
    for (int j = 0; j < 4; ++j) gv[j] = *(const f32x4*)(gf + 4 * lane + 256 * j);
    for (int r = gw; r < MTOK; r += NGW) {
        f32x4* xr = (f32x4*)(x + (size_t)r * DM) + lane;
        f32x4 v[4]; float ss = 0.f;
#pragma unroll
        for (int j = 0; j < 4; ++j) { v[j] = xr[64 * j]; ss += (v[j][0] * v[j][0] + v[j][1] * v[j][1]) + (v[j][2] * v[j][2] + v[j][3] * v[j][3]); }
        const float rstd = __builtin_amdgcn_rsqf(wave_sum_all(ss) * (1.0f / DM) + EPS);
#pragma unroll
        for (int j = 0; j < 4; ++j) xr[64 * j] = v[j] * rstd * gv[j];
    }
}

__device__ __forceinline__ void unpack8(const u32x4 w, float (&f)[8]) { f[0] = bf_lo(w.x); f[1] = bf_hi(w.x); f[2] = bf_lo(w.y); f[3] = bf_hi(w.y); f[4] = bf_lo(w.z); f[5] = bf_hi(w.z); f[6] = bf_lo(w.w); f[7] = bf_hi(w.w); }
__device__ __forceinline__ u32x4 pack8(const float (&f)[8]) { u32x4 o; o.x = cvt_pk_bf16(f[0], f[1]); o.y = cvt_pk_bf16(f[2], f[3]); o.z = cvt_pk_bf16(f[4], f[5]); o.w = cvt_pk_bf16(f[6], f[7]); return o; }
__device__ __forceinline__ void pool_elem_phase(const bf16_t* U, bf16_t* P, int vcu, int G, int tid) {
    const int chunk = tid & 127, run = tid >> 7, c0 = 8 * chunk, w = 2 << (c0 >> 8);
    for (int unit = vcu; unit < MTOK / 128; unit += G) {
        const int t0 = unit * 128 + run * 32, seq0 = t0 & ~(SEQ - 1);
        float s[8];
#pragma unroll
        for (int j = 0; j < 8; ++j) s[j] = 0.f;
        for (int tau = t0 - w; tau < t0; ++tau) if (tau >= seq0) { float f[8];     unpack8(*(const u32x4*)(U + (size_t)tau * DM + c0), f);
#pragma unroll
            for (int j = 0; j < 8; ++j) s[j] += f[j]; }
        for (int t = t0; t < t0 + 32; ++t) {
            float f[8], o[8]; unpack8(*(const u32x4*)(U + (size_t)t * DM + c0), f);
#pragma unroll
            for (int j = 0; j < 8; ++j) s[j] += f[j];
            if (t - w >= seq0) { float q[8]; unpack8(*(const u32x4*)(U + (size_t)(t - w) * DM + c0), q);
#pragma unroll
                for (int j = 0; j < 8; ++j) s[j] -= q[j]; }
            const int pos1 = t - seq0 + 1; const float inv = 1.0f / (float)(pos1 < w ? pos1 : w);
#pragma unroll
            for (int j = 0; j < 8; ++j) o[j] = s[j] * inv - f[j];
            *(u32x4*)(P + (size_t)t * DM + c0) = pack8(o);
        }
    }
}
__device__ __forceinline__ void conv_elem_phase(const bf16_t* BG, const bf16_t* Z, const float* cw  , bf16_t* Aout, int vcu, int G, int tid) {
    const int chunk = tid & 127, run = tid >> 7, c0 = 8 * chunk;
    float w0[8], w1[8], w2[8];
#pragma unroll
    for (int j = 0; j < 8; ++j) { w0[j] = cw[c0 + j]; w1[j] = cw[DM + c0 + j]; w2[j] = cw[2 * DM + c0 + j]; }
    for (int unit = vcu; unit < MTOK / 128; unit += G) {
        const int t0 = unit * 128 + run * 32, seq0 = t0 & ~(SEQ - 1);
        float zm2[8], zm1[8];
#pragma unroll
        for (int j = 0; j < 8; ++j) { zm2[j] = 0.f; zm1[j] = 0.f; }
        if (t0 - 2 >= seq0) unpack8(*(const u32x4*)(Z + (size_t)(t0 - 2) * DM + c0), zm2);
        if (t0 - 1 >= seq0) unpack8(*(const u32x4*)(Z + (size_t)(t0 - 1) * DM + c0), zm1);
        for (int t = t0; t < t0 + 32; ++t) {
            float z[8], bg[8], o[8]; unpack8(*(const u32x4*)(Z + (size_t)t * DM + c0), z); unpack8(*(const u32x4*)(BG + (size_t)t * DM + c0), bg);
#pragma unroll
            for (int j = 0; j < 8; ++j) { o[j] = bg[j] * (w0[j] * zm2[j] + w1[j] * zm1[j] + w2[j] * z[j]); zm2[j] = zm1[j]; zm1[j] = z[j]; }
            *(u32x4*)(Aout + (size_t)t * DM + c0) = pack8(o);
        }
    }
}

__device__ __forceinline__ int wp_off(int row, int chunk) { return row * 256 + ((chunk ^ (row & 15)) << 4); }
__device__ __forceinline__ void mix_phase(LAS unsigned char* lds, bf16_t* UA, const bf16_t* VT, const float* WS, const float* BS, const float* LNG, const float* LNB, int vcu, int G, int tid, int wid, int lane) {
    LAS unsigned char* WP = lds;
    LAS float* MU = (LAS float*)(lds + 32768); LAS float* RSTD = MU + 128; LAS float* R1 = MU + 256; LAS float* R2 = MU + 384;
    LAS float* PART = (LAS float*)(lds + 36864);
    for (int n = vcu; n < MTOK / 128; n += G) {
        {
            const int cgp = tid >> 4, tl = tid & 15;
            float s[8], q[8];
#pragma unroll
            for (int j = 0; j < 8; ++j) { s[j] = 0.f; q[j] = 0.f; }
#pragma unroll 4
            for (int it = 0; it < GH / 32; ++it) { float f[8]; unpack8(*(const u32x4*)(VT + (size_t)(it * 32 + cgp) * MTOK + n * 128 + tl * 8), f);
#pragma unroll
                for (int j = 0; j < 8; ++j) { s[j] += f[j]; q[j] += f[j] * f[j]; } }
#pragma unroll
            for (int j = 0; j < 8; ++j) { PART[(cgp * 128 + tl * 8 + j) * 2] = s[j]; PART[(cgp * 128 + tl * 8 + j) * 2 + 1] = q[j]; }
            __syncthreads();
            if (tid < 128) { float S = 0.f, Q = 0.f;
                for (int k = 0; k < 32; ++k) { S += PART[(k * 128 + tid) * 2]; Q += PART[(k * 128 + tid) * 2 + 1]; }
                const float mu = S * (1.0f / GH), var = Q * (1.0f / GH) - mu * mu; MU[tid] = mu; RSTD[tid] = __builtin_amdgcn_rsqf(fmaxf(var, 0.f) + EPS); }
            __syncthreads();
        }
        for (int g = 0; g < 8; ++g) {
            {
                const int i = tid >> 2, part = tid & 3;
                const float* wrow = WS + ((size_t)g * 128 + i) * 128 + part * 32;
                float r1 = 0.f, r2 = 0.f;
#pragma unroll
                for (int jj = 0; jj < 32; jj += 8) { const int j0 = part * 32 + jj;
                    f32x4 a = *(const f32x4*)(wrow + jj), b = *(const f32x4*)(wrow + jj + 4);
                    if (i < 64 && j0 >= 64) { a = (f32x4){0.f, 0.f, 0.f, 0.f}; b = a; }
                    const f32x4 ra = *(const LAS f32x4*)(RSTD + j0), rb = *(const LAS f32x4*)(RSTD + j0 + 4), ma = *(const LAS f32x4*)(MU + j0), mb = *(const LAS f32x4*)(MU + j0 + 4);
                    const f32x4 wa = a * ra, wb = b * rb;
                    r1 += (wa[0] * ma[0] + wa[1] * ma[1]) + (wa[2] * ma[2] + wa[3] * ma[3]) + (wb[0] * mb[0] + wb[1] * mb[1]) + (wb[2] * mb[2] + wb[3] * mb[3]);
                    r2 += (a[0] + a[1]) + (a[2] + a[3]) + (b[0] + b[1]) + (b[2] + b[3]);
                    u32x4 o; o.x = cvt_pk_bf16(wa[0], wa[1]); o.y = cvt_pk_bf16(wa[2], wa[3]); o.z = cvt_pk_bf16(wb[0], wb[1]); o.w = cvt_pk_bf16(wb[2], wb[3]);
                    *(LAS u32x4*)(WP + wp_off(i, j0 >> 3)) = o; }
                r1 += __shfl_xor(r1, 1); r1 += __shfl_xor(r1, 2); r2 += __shfl_xor(r2, 1); r2 += __shfl_xor(r2, 2);
                if (part == 0) { R1[i] = r1; R2[i] = r2; }
            }
            __syncthreads();
            f32x4 acc[3][8];
#pragma unroll
            for (int ct = 0; ct < 3; ++ct)
#pragma unroll
                for (int it = 0; it < 8; ++it) acc[ct][it] = (f32x4){0.f, 0.f, 0.f, 0.f};
            const int fr = lane & 15, fq = lane >> 4, cbase = g * 384 + wid * 48;
#pragma unroll 1
            for (int ks = 0; ks < 4; ++ks) {
                bf16x8 av[3];
#pragma unroll
                for (int ct = 0; ct < 3; ++ct) av[ct] = *(const bf16x8*)(VT + (size_t)(cbase + ct * 16 + fr) * MTOK + n * 128 + ks * 32 + fq * 8);
#pragma unroll
                for (int it = 0; it < 8; ++it) { const bf16x8 bw = *(const LAS bf16x8*)(WP + wp_off(it * 16 + fr, ks * 4 + fq));
#pragma unroll
                    for (int ct = 0; ct < 3; ++ct) acc[ct][it] = __builtin_amdgcn_mfma_f32_16x16x32_bf16(av[ct], bw, acc[ct][it], 0, 0, 0); }
            }
#pragma unroll
            for (int ct = 0; ct < 3; ++ct) { const int c4 = cbase + ct * 16 + 4 * fq;
                const f32x4 lg = *(const f32x4*)(LNG + c4), lb = *(const f32x4*)(LNB + c4);
#pragma unroll
                for (int it = 0; it < 8; ++it) { const int i = it * 16 + fr; const float r1 = R1[i], r2 = R2[i], bs = BS[g * 128 + i];
                    bf16_t* up = UA + (size_t)(n * 128 + i) * GH + c4; const u32x2 uu = *(const u32x2*)up;
                    const f32x4 vs = lg * (acc[ct][it] - r1) + lb * r2 + bs;
                    u32x2 o; o.x = cvt_pk_bf16(bf_lo(uu.x) * vs[0], bf_hi(uu.x) * vs[1]); o.y = cvt_pk_bf16(bf_lo(uu.y) * vs[2], bf_hi(uu.y) * vs[3]);
                    *(u32x2*)up = o; } }
            __syncthreads();
        }
    }
}

__device__ __forceinline__ void topk_phase(LAS unsigned char* lds, const bf16_t* Q, const bf16_t* KEYS, int* SELI, float* SELW, int vcu, int G, int tid, int wid, int lane) {
    LAS float* topv = (LAS float*)lds;
    const int p = wid >> 2, sub = wid & 3, tl = lane & 31, hi = lane >> 5;
    for (int unit = vcu; unit < (MTOK / 128) * 8; unit += G) {
        const int tile = unit >> 3, h = unit & 7;
        {
            const bf16_t* qrow = Q + (size_t)(tile * 128 + sub * 32 + tl) * 2048 + h * 256 + p * 128 + hi * 8;
            const bf16_t* krow = KEYS + ((size_t)(h * 2 + p) * 128 + tl) * 128 + hi * 8;
            f32x16 acc[4];
#pragma unroll
            for (int kt = 0; kt < 4; ++kt)
#pragma unroll
                for (int r = 0; r < 16; ++r) acc[kt][r] = 0.f;
#pragma unroll
            for (int ks = 0; ks < 8; ++ks) { const bf16x8 bq = *(const bf16x8*)(qrow + ks * 16);
#pragma unroll
                for (int kt = 0; kt < 4; ++kt) { const bf16x8 ak = *(const bf16x8*)(krow + kt * 32 * 128 + ks * 16);
                    acc[kt] = __builtin_amdgcn_mfma_f32_32x32x16_bf16(ak, bq, acc[kt], 0, 0, 0); } }
            float v[64];
#pragma unroll
            for (int kt = 0; kt < 4; ++kt)
#pragma unroll
                for (int r = 0; r < 16; ++r) { const unsigned key = (unsigned)(kt * 32 + (r & 3) + 8 * (r >> 2) + 4 * hi);
                    v[kt * 16 + r] = __uint_as_float((__float_as_uint(acc[kt][r]) & ~127u) | key); }
            top16_of_64(v);
            float m[16];
#pragma unroll
            for (int i = 0; i < 16; ++i) m[i] = fmaxf(v[i], __shfl_xor(v[15 - i], 32));
            bmerge16_desc<0, 16>(m);
            if (hi == 0) { LAS f32x4* dst = (LAS f32x4*)(topv + (p * 128 + sub * 32 + tl) * 16);
#pragma unroll
                for (int i = 0; i < 4; ++i) dst[i] = (f32x4){m[4 * i], m[4 * i + 1], m[4 * i + 2], m[4 * i + 3]}; }
        }
        __syncthreads();
        if (tid < 128) {
            float s0[16], s1[16];
#pragma unroll
            for (int i = 0; i < 4; ++i) { const f32x4 a = *(const LAS f32x4*)(topv + tid * 16 + 4 * i), b = *(const LAS f32x4*)(topv + (128 + tid) * 16 + 4 * i);
                s0[4 * i] = a[0]; s0[4 * i + 1] = a[1]; s0[4 * i + 2] = a[2]; s0[4 * i + 3] = a[3]; s1[4 * i] = b[0]; s1[4 * i + 1] = b[1]; s1[4 * i + 2] = b[2]; s1[4 * i + 3] = b[3]; }
            float c[64];
            constexpr int pre[16] = {0, 16, 24, 29, 33, 36, 38, 40, 42, 43, 44, 45, 46, 47, 48, 49};
#pragma unroll
            for (int a = 0; a < 16; ++a)
#pragma unroll
                for (int b = 0; b < 16; ++b) if ((a + 1) * (b + 1) <= 16) c[pre[a] + b] = __uint_as_float((__float_as_uint(s0[a] + s1[b]) & ~255u) | (unsigned)(a * 16 + b));
#pragma unroll
            for (int i = 50; i < 64; ++i) c[i] = -3.0e38f;
            top16_of_64(c);
            float e[16], sum = 0.f;
#pragma unroll
            for (int k = 0; k < 16; ++k) { e[k] = __builtin_amdgcn_exp2f((c[k] - c[0]) * 1.44269504f); sum += e[k]; }
            const float inv = 1.0f / sum;
            const size_t o = (size_t)(tile * 128 + tid) * NPICK + h * 16;
#pragma unroll
            for (int k4 = 0; k4 < 4; ++k4) { i32x4 ei; f32x4 wv;
#pragma unroll
                for (int j = 0; j < 4; ++j) { const unsigned code = __float_as_uint(c[4 * k4 + j]) & 255u;
                    const unsigned i1 = __float_as_uint(topv[tid * 16 + (code >> 4)]) & 127u, i2 = __float_as_uint(topv[(128 + tid) * 16 + (code & 15u)]) & 127u;
                    ei[j] = (int)(i1 * 128u + i2); wv[j] = e[4 * k4 + j] * inv; }
                *(i32x4*)(SELI + o + 4 * k4) = ei; *(f32x4*)(SELW + o + 4 * k4) = wv; }
        }
        __syncthreads();
    }
}

__device__ __forceinline__ void gather_phase(const bf16_t* H, const bf16_t* TU, const bf16_t* TV, const int* SELI, const float* SELW, float* x, const float* gacc, const float* gbias, int gw, int NGW, int lane) {
    for (int ch = gw; ch < MTOK / 16; ch += NGW) {
        const int b = (ch * 16) >> 12;
        for (int tk = ch * 16; tk < ch * 16 + 16; ++tk) {
            const u32x4* hp = (const u32x4*)(H + (size_t)tk * DM);
            const u32x4 h0 = hp[lane], h1 = hp[64 + lane];
            const int e0 = SELI[(size_t)tk * NPICK + lane], e1 = SELI[(size_t)tk * NPICK + 64 + lane];
            const float w0 = SELW[(size_t)tk * NPICK + lane], w1 = SELW[(size_t)tk * NPICK + 64 + lane];
            float acc[16];
#pragma unroll
            for (int j = 0; j < 16; ++j) acc[j] = 0.f;
            for (int kb = 0; kb < 16; ++kb) {
                int e[8]; float wk[8];
#pragma unroll
                for (int j = 0; j < 8; ++j) { const int k = (kb & 7) * 8 + j;
                    e[j] = kb < 8 ? __builtin_amdgcn_readlane(e0, k) : __builtin_amdgcn_readlane(e1, k);
                    wk[j] = __uint_as_float(kb < 8 ? __builtin_amdgcn_readlane(__float_as_uint(w0), k) : __builtin_amdgcn_readlane(__float_as_uint(w1), k)); }
                u32x4 ua[8], ub[8];
#pragma unroll
                for (int j = 0; j < 8; ++j) { const u32x4* up = (const u32x4*)(TU + (size_t)e[j] * DM); ua[j] = up[lane]; ub[j] = up[64 + lane]; }
                float coef[8];
#pragma unroll
                for (int j = 0; j < 8; ++j) { float d0 = 0.f, d1 = 0.f;
                    d0 = dot2_bf16(ua[j].x, h0.x, d0); d1 = dot2_bf16(ua[j].y, h0.y, d1); d0 = dot2_bf16(ua[j].z, h0.z, d0); d1 = dot2_bf16(ua[j].w, h0.w, d1);
                    d0 = dot2_bf16(ub[j].x, h1.x, d0); d1 = dot2_bf16(ub[j].y, h1.y, d1); d0 = dot2_bf16(ub[j].z, h1.z, d0); d1 = dot2_bf16(ub[j].w, h1.w, d1);
                    coef[j] = wk[j] * gelu_tanh(wave_sum_all(d0 + d1)); }
#pragma unroll
                for (int j = 0; j < 8; ++j) { const u32x4* vp = (const u32x4*)(TV + (size_t)e[j] * DM); const u32x4 va = vp[lane], vb = vp[64 + lane]; const float cf = coef[j];
                    acc[0] += cf * bf_lo(va.x); acc[1] += cf * bf_hi(va.x); acc[2] += cf * bf_lo(va.y); acc[3] += cf * bf_hi(va.y);
                    acc[4] += cf * bf_lo(va.z); acc[5] += cf * bf_hi(va.z); acc[6] += cf * bf_lo(va.w); acc[7] += cf * bf_hi(va.w);
                    acc[8] += cf * bf_lo(vb.x); acc[9] += cf * bf_hi(vb.x); acc[10] += cf * bf_lo(vb.y); acc[11] += cf * bf_hi(vb.y);
                    acc[12] += cf * bf_lo(vb.z); acc[13] += cf * bf_hi(vb.z); acc[14] += cf * bf_lo(vb.w); acc[15] += cf * bf_hi(vb.w); }
            }
#pragma unroll
            for (int hh = 0; hh < 2; ++hh) { const int col = hh * 512 + 8 * lane;
                const f32x4 ga = *(const f32x4*)(gacc + (size_t)b * 6 * DM + col), gb = *(const f32x4*)(gacc + (size_t)b * 6 * DM + col + 4);
                f32x4* xp = (f32x4*)(x + (size_t)tk * DM + col);
                f32x4 xa = xp[0], xb = xp[1];
                xa += ga * (f32x4){acc[hh * 8 + 0], acc[hh * 8 + 1], acc[hh * 8 + 2], acc[hh * 8 + 3]};
                xb += gb * (f32x4){acc[hh * 8 + 4], acc[hh * 8 + 5], acc[hh * 8 + 6], acc[hh * 8 + 7]};
                xp[0] = xa; xp[1] = xb; }
        }
    }
}

constexpr int NPHASES = 37;
#ifndef PH_MASK
#define PH_MASK 0xFFFFFF
#endif
#define PHM(bit, call) do { if constexpr ((PH_MASK & (bit)) != 0) { call; } } while (0)
__global__ void __launch_bounds__(NTHREADS, 2) trunk_fwd(Args A) {
    extern __shared__ __attribute__((aligned(16))) unsigned char lds_raw[];
    LAS unsigned char* lds = (LAS unsigned char*)lds_raw;
    const int tid0 = threadIdx.x, wid = __builtin_amdgcn_readfirstlane(tid0 >> 6);
    const int G = gridDim.x, bx = blockIdx.x, vcu = (G % 8 == 0) ? (bx % 8) * (G / 8) + bx / 8 : bx;
    const int gw = vcu * 8 + wid, NGW = G * 8;
    const int ph_lo = A.ph_lo, ph_hi = A.ph_hi;

    for (int ph = ph_lo; ph < ph_hi; ++ph) {
        const int tid = opaque(tid0), lane = tid & 63;
        ArgP Ap = (ArgP)__builtin_amdgcn_kernarg_segment_ptr();
        asm volatile("" : "+s"(Ap));
        unsigned char* ws = Ap->ws;
        bf16_t* Hb = (bf16_t*)(ws + WS_H);
        unsigned char* mixb = ws + WS_MIX;
        const float* mod = (const float*)(ws + WS_MOD);
        float* xo = Ap->out;
        int layer, step;
        if (ph < 2) { layer = -1; step = ph; }
        else if (ph < 11) { layer = 0; step = ph - 2; }
        else if (ph < 19) { layer = 1; step = ph - 11; }
        else if (ph < 27) { layer = 2; step = ph - 19; }
        else if (ph < 36) { layer = 3; step = ph - 27; }
        else { layer = 4; step = 0; }
        const int kind = layer % 3, jl = layer / 3;
        const int nmix = (kind == 0) ? 5 : 4;
        const float* macc = mod + (size_t)(layer < 0 ? 0 : (layer > 3 ? 3 : layer)) * BATCH * 6 * DM;
        const float* mbias = Ap->in[I_ADA_B] + (size_t)(layer < 0 ? 0 : (layer > 3 ? 3 : layer)) * 6 * DM;
        const float* xin = (layer == 0) ? Ap->in[I_X] : xo;

        if (layer < 0) {
            if (step == 0) { PHM(1, prologue_phase(Ap, lds, vcu, G, tid, wid, lane)); }
            else { PHM(1, modreduce_phase(Ap, vcu, G, tid)); }
        } else if (layer > 3) {
            PHM(256, final_phase(xo, Ap->in[I_FINAL_G], gw, NGW, lane));
        } else if (step == 0) {
            PHM(2, norm_phase(xin, Ap->in[I_NORM_G] + (size_t)(layer * 2 + 0) * DM, macc, mbias, 0, DM, Hb, gw, NGW, lane));
        } else if (step < nmix) {
            pg8::StaticOrder S;
            if (kind == 0) {
                bf16_t* U = (bf16_t*)mixb; bf16_t* P = (bf16_t*)(mixb + 64 * MiB); bf16_t* Z = (bf16_t*)(mixb + 128 * MiB);
                if (step == 1) { pg8::Gemm g{Hb, (const bf16_t*)(ws + WS_POOL_WIN) + (size_t)jl * DM * DM, MTOK, DM, DM, DM, DM, 0}; S.init(MTOK, DM, G, bx);
                    pg8::EpiBf16<0> E{U, DM}; PHM(0x1000, pg8::gemm_phase(lds, g, S, E)); }
                else if (step == 2) { PHM(8, pool_elem_phase(U, P, vcu, G, tid)); }
                else if (step == 3) { pg8::Gemm g{P, (const bf16_t*)(ws + WS_POOL_WGRP) + (size_t)jl * 4 * 65536, MTOK, DM, 256, DM, 256, 256}; S.init(MTOK, DM, G, bx);
                    pg8::EpiPoolGrp E{Z, Ap->in[I_POOL_SCALE] + (size_t)jl * DM}; PHM(0x2000, pg8::gemm_phase(lds, g, S, E)); }
                else { pg8::Gemm g{Z, (const bf16_t*)(ws + WS_POOL_WOUT) + (size_t)jl * DM * DM, MTOK, DM, DM, DM, DM, 0}; S.init(MTOK, DM, G, bx);
                    pg8::EpiResid E{xin, xo, macc + 2 * DM, mbias + 2 * DM}; PHM(0x8000, pg8::gemm_phase(lds, g, S, E)); }
            } else if (kind == 1) {
                bf16_t* BG = (bf16_t*)mixb; bf16_t* Z = (bf16_t*)(mixb + 64 * MiB); bf16_t* AA = (bf16_t*)(mixb + 128 * MiB);
                if (step == 1) { pg8::Gemm g{Hb, (const bf16_t*)(ws + WS_CONV_WIN), MTOK, 3 * DM, DM, DM, DM, 0}; S.init(MTOK, 3 * DM, G, bx);
                    pg8::EpiConvIn E{BG, Z}; PHM(0x4000, pg8::gemm_phase(lds, g, S, E)); }
                else if (step == 2) { PHM(16, conv_elem_phase(BG, Z, Ap->in[I_CONV_W], AA, vcu, G, tid)); }
                else { pg8::Gemm g{AA, (const bf16_t*)(ws + WS_CONV_WOUT), MTOK, DM, DM, DM, DM, 0}; S.init(MTOK, DM, G, bx);
                    pg8::EpiResid E{xin, xo, macc + 2 * DM, mbias + 2 * DM}; PHM(0x8000, pg8::gemm_phase(lds, g, S, E)); }
            } else {
                bf16_t* UA = (bf16_t*)mixb; bf16_t* VT = (bf16_t*)(mixb + 192 * MiB);
                if (step == 1) {
                    { pg8::Gemm g{Hb, (const bf16_t*)(ws + WS_GMLP_WIN), MTOK, GH, DM, DM, DM, 0}; S.init(MTOK, GH, G, bx);
                      pg8::EpiBf16<1> E{UA, GH}; PHM(0x1000, pg8::gemm_phase(lds, g, S, E)); }
                    { pg8::Gemm g{Hb, (const bf16_t*)(ws + WS_GMLP_WIN) + (size_t)GH * DM, MTOK, GH, DM, DM, DM, 0}; S.init(MTOK, GH, G, bx);
                      pg8::EpiGmlpV E{VT}; PHM(0x10000, pg8::gemm_phase(lds, g, S, E)); }
                }
                else if (step == 2) { PHM(32, mix_phase(lds, UA, VT, Ap->in[I_GMLP_WS], Ap->in[I_GMLP_BS], Ap->in[I_GMLP_LNG], Ap->in[I_GMLP_LNB], vcu, G, tid, wid, lane)); }
                else { pg8::Gemm g{UA, (const bf16_t*)(ws + WS_GMLP_WOUT), MTOK, DM, GH, GH, GH, 0}; S.init(MTOK, DM, G, bx);
                    pg8::EpiResid E{xin, xo, macc + 2 * DM, mbias + 2 * DM}; PHM(0x8000, pg8::gemm_phase(lds, g, S, E)); }
            }
        } else {
            const int ps = step - nmix;
            bf16_t* Qb = (bf16_t*)mixb;
            if (ps == 0) { PHM(2, norm_phase(xo, Ap->in[I_NORM_G] + (size_t)(layer * 2 + 1) * DM, macc, mbias, 3 * DM, 4 * DM, Hb, gw, NGW, lane)); }
            else if (ps == 1) { pg8::StaticOrder S; pg8::Gemm g{Hb, (const bf16_t*)(ws + WS_PEER_WQ) + (size_t)layer * DM * 2048, MTOK, 2048, DM, DM, DM, 0}; S.init(MTOK, 2048, G, bx);
                pg8::EpiBf16<0> E{Qb, 2048}; PHM(0x1000, pg8::gemm_phase(lds, g, S, E)); }
            else if (ps == 2) PHM(64, topk_phase(lds, Qb, (const bf16_t*)(ws + WS_KEYS) + (size_t)layer * 16 * 128 * 128, (int*)(ws + WS_SELI), (float*)(ws + WS_SELW), vcu, G, tid, wid, lane));
            else PHM(128, gather_phase(Hb, (const bf16_t*)(ws + WS_TABU) + (size_t)layer * NEXP * DM, (const bf16_t*)(ws + WS_TABV) + (size_t)layer * NEXP * DM,
                              (const int*)(ws + WS_SELI), (const float*)(ws + WS_SELW), xo, macc + 5 * DM, mbias + 5 * DM, gw, NGW, lane));
        }
#if MK_ONE_LAUNCH
        if (ph + 1 < ph_hi) { cg::this_grid().sync(); }
#endif
    }
}

extern "C" void kernel_launch(void* const* d_in, const int* in_sizes, int n_in, void* d_out, int out_size, void* d_ws, size_t ws_size, hipStream_t stream) {
    static int grid = 0;
    if (grid == 0) {
        if (n_in != 23 || in_sizes[0] != MTOK * DM || out_size != MTOK * DM || ws_size < WS_END) {
            fprintf(stderr, "kernel_launch: unexpected shapes (n_in %d, in0 %d, out %d, ws %zu; need ws >= %zu); nothing launched\n", n_in, n_in > 0 ? in_sizes[0] : -1, out_size, ws_size, (size_t)WS_END); grid = -1; return; }
        int dev = 0, cus = 0, per_cu = 0;
        if (hipGetDevice(&dev) != hipSuccess || hipDeviceGetAttribute(&cus, hipDeviceAttributeMultiprocessorCount, dev) != hipSuccess) { grid = -1; return; }
        if (hipFuncSetAttribute((const void*)trunk_fwd, hipFuncAttributeMaxDynamicSharedMemorySize, LDS_BYTES) != hipSuccess) { fprintf(stderr, "kernel_launch: hipFuncSetAttribute failed\n"); grid = -1; return; }
        if (hipOccupancyMaxActiveBlocksPerMultiprocessor(&per_cu, (const void*)trunk_fwd, NTHREADS, LDS_BYTES) != hipSuccess || per_cu < 1) { fprintf(stderr, "kernel_launch: occupancy query says %d blocks per CU\n", per_cu); (void)hipGetLastError(); grid = -1; return; }
        grid = cus * (per_cu < 1 ? 1 : 1);
    }
    if (grid < 0) return;
    Args a{};
    for (int i = 0; i < 23; ++i) a.in[i] = (const float*)d_in[i];
    a.out = (float*)d_out; a.ws = (unsigned char*)d_ws;
#if MK_ONE_LAUNCH
    a.ph_lo = 0; a.ph_hi = NPHASES;
    void* args[] = {&a};
    hipError_t e = hipLaunchCooperativeKernel((const void*)trunk_fwd, dim3(grid), dim3(NTHREADS), args, LDS_BYTES, stream);
    if (e != hipSuccess) fprintf(stderr, "cooperative launch failed: %s (grid %d)\n", hipGetErrorString(e), grid);
#else
    for (int ph = 0; ph < NPHASES; ++ph) { a.ph_lo = ph; a.ph_hi = ph + 1; hipLaunchKernelGGL(trunk_fwd, dim3(grid), dim3(NTHREADS), LDS_BYTES, stream, a); }
#endif
}
```

```cpp
#include <hip/hip_runtime.h>
#include <hip/hip_cooperative_groups.h>
#include <cstdio>
#include <cstdint>
namespace cg = cooperative_groups;

#ifndef MK_ONE_LAUNCH
#define MK_ONE_LAUNCH 1
#endif

#define LAS __attribute__((address_space(3)))
typedef unsigned short bf16_t;
typedef short bf16x8 __attribute__((ext_vector_type(8)));
typedef float f32x2 __attribute__((ext_vector_type(2)));
typedef float f32x4 __attribute__((ext_vector_type(4)));
typedef float f32x16 __attribute__((ext_vector_type(16)));
typedef unsigned u32x2 __attribute__((ext_vector_type(2)));
typedef unsigned u32x4 __attribute__((ext_vector_type(4)));
typedef int i32x4 __attribute__((ext_vector_type(4)));
typedef __bf16 bf16x2 __attribute__((ext_vector_type(2)));

constexpr int DM = 1024, BATCH = 8, SEQ = 4096, MTOK = BATCH * SEQ, DEPTH = 4;
constexpr int GH = 3072;
constexpr int NEXP = 16384, NPICK = 128;
constexpr float EPS = 1e-6f;

constexpr size_t MiB = 1u << 20;
constexpr size_t WS_CTL = 0, WS_SCU = 0, WS_SCV = 512 * 1024, WS_MOD = 1 * MiB, ZERO_BYTES = 2 * MiB;
constexpr size_t WS_POOL_WIN = 2 * MiB, WS_POOL_WGRP = 6 * MiB, WS_POOL_WOUT = 7 * MiB;
constexpr size_t WS_CONV_WIN = 11 * MiB, WS_CONV_WOUT = 17 * MiB;
constexpr size_t WS_GMLP_WIN = 19 * MiB, WS_GMLP_WOUT = 31 * MiB;
constexpr size_t WS_PEER_WQ = 37 * MiB, WS_KEYS = 53 * MiB;
constexpr size_t WS_H = 56 * MiB;
constexpr size_t WS_SELI = 120 * MiB, WS_SELW = 136 * MiB;
constexpr size_t WS_TABU = 152 * MiB, WS_TABV = 280 * MiB;
constexpr size_t WS_MIX = 408 * MiB;
constexpr size_t WS_ADAP = 792 * MiB;
constexpr size_t WS_COEF = 804 * MiB;
constexpr size_t WS_END = 820 * MiB;

__device__ __forceinline__ unsigned cvt_pk_bf16(float lo, float hi) { unsigned r; asm volatile("v_cvt_pk_bf16_f32 %0, %1, %2" : "=v"(r) : "v"(lo), "v"(hi)); return r; }
__device__ __forceinline__ int opaque(int x) { asm volatile("" : "+v"(x)); return x; }
__device__ __forceinline__ float bf_lo(unsigned w) { return __uint_as_float(w << 16); }
__device__ __forceinline__ float bf_hi(unsigned w) { return __uint_as_float(w & 0xffff0000u); }
__device__ __forceinline__ float gelu_tanh(float x) {
    const float y = x * (1.0f + 0.044715f * x * x);
    const float e = __builtin_amdgcn_exp2f(-2.302208198f * y);
    return x * __builtin_amdgcn_rcpf(1.0f + e);
}
__device__ __forceinline__ float wave_sum_all(float v) {
#pragma unroll
    for (int o = 1; o < 64; o <<= 1) v += __shfl_xor(v, o);
    return v;
}
__device__ __forceinline__ float dot2_bf16(unsigned w, unsigned x, float acc) { return __builtin_amdgcn_fdot2_f32_bf16(__builtin_bit_cast(bf16x2, w), __builtin_bit_cast(bf16x2, x), acc, false); }


__device__ __forceinline__ float dpp_row_shr(float v, int n) {
    const int iv = __builtin_bit_cast(int, v); int r;
    switch (n) { case 1: r = __builtin_amdgcn_update_dpp(0, iv, 0x111, 0xf, 0xf, true); break; case 2: r = __builtin_amdgcn_update_dpp(0, iv, 0x112, 0xf, 0xf, true); break;
                 case 4: r = __builtin_amdgcn_update_dpp(0, iv, 0x114, 0xf, 0xf, true); break; default: r = __builtin_amdgcn_update_dpp(0, iv, 0x118, 0xf, 0xf, true); break; }
    return __builtin_bit_cast(float, r);
}
__device__ __forceinline__ float wave_sum_uniform(float v) {
    v += dpp_row_shr(v, 1); v += dpp_row_shr(v, 2); v += dpp_row_shr(v, 4); v += dpp_row_shr(v, 8);
    v += __builtin_bit_cast(float, __builtin_amdgcn_update_dpp(0, __builtin_bit_cast(int, v), 0x142, 0xa, 0xf, false));
    v += __builtin_bit_cast(float, __builtin_amdgcn_update_dpp(0, __builtin_bit_cast(int, v), 0x143, 0xc, 0xf, false));
    return __uint_as_float(__builtin_amdgcn_readlane(__float_as_uint(v), 63));
}

namespace pg8 {
constexpr int BM = 256, BK = 64, HALF = 128, HTB = HALF * BK * 2, STAGE_BYTES = 8 * HTB, NXCD = 8, WGM = 8;
__device__ __forceinline__ int lds_byte(int r, int c) { const int st = (r >> 4) * 2 + (c >> 5), rr = r & 15, cc = c & 31, ob = rr * 64 + cc * 2; return st * 1024 + (ob ^ (((ob >> 9) & 1) << 5)); }
__device__ __forceinline__ void stage_rc(int b, int& R, int& C) { const int st = b / 1024, sb = b % 1024, swz = sb ^ (((sb >> 9) & 1) << 5); R = (st >> 1) * 16 + swz / 64; C = (st & 1) * 32 + (swz % 64) / 2; }
__device__ __forceinline__ int perm32(int rho) { const int n = rho >> 4, i = rho & 15; return 8 * (i >> 2) + 4 * n + (i & 3); }

struct Unit { int pm, pn; };
struct Gemm { const bf16_t* A; const bf16_t* Bt; int M, N, K, lda, ldb, a_pn_off; };

struct StaticOrder {
    int nM, nN, nwg, G, c;
    __device__ __forceinline__ void init(int M, int N, int G_, int c_) { nM = M / BM; nN = N / BM; nwg = nM * nN; G = G_; c = c_; }
    __device__ __forceinline__ bool next(int i, Unit& u) const {
        const long L = (long)i * G + c; if (L >= nwg) return false;
        int wgid = (int)L; { const int q = nwg / NXCD, r = nwg % NXCD, xcd = wgid % NXCD, off = wgid / NXCD; wgid = (xcd < r ? xcd * (q + 1) : r * (q + 1) + (xcd - r) * q) + off; }
        const int nig = WGM * nN, gid = wgid / nig, fm = gid * WGM, gsz = (nM - fm) < WGM ? (nM - fm) : WGM;
        u.pm = fm + ((wgid % nig) % gsz); u.pn = (wgid % nig) / gsz; return true;
    }
};

template <class Epi>
__device__ __forceinline__ void gemm_phase(LAS unsigned char* lds, const Gemm g, const StaticOrder& S, const Epi& E) {
    const int tid = opaque((int)threadIdx.x), wid = __builtin_amdgcn_readfirstlane(tid >> 6), lane = tid & 63, wr = wid >> 2, wc = wid & 3, fr = lane & 15, fq = lane >> 4;
    const int nt = g.K / BK;
    unsigned voffA[2], voffB[2];
#pragma unroll
    for (int i = 0; i < 2; ++i) { int R, C; stage_rc(tid * 16 + i * 8192, R, C); const int Rb = Epi::PERM ? ((R & ~31) + perm32(R & 31)) : R;
        voffA[i] = (unsigned)(R * g.lda + C) * 2u; voffB[i] = (unsigned)(Rb * g.ldb + C) * 2u; }
    const size_t kstep = (size_t)(BK * 2);
    const size_t hstepA = (size_t)HALF * g.lda * 2, hstepB = (size_t)HALF * g.ldb * 2;
    const size_t tstepA = 2 * hstepA, tstepB = 2 * hstepB;
    const unsigned ldsw = (unsigned)wid * 1024u;
    const int aoff = lds_byte(wr * 64 + fr, fq * 8), boff = lds_byte(wc * 32 + fr, fq * 8);
#define PG8_SA(b, h) (((b) * 2 + (h)) * HTB)
#define PG8_SB(b, h) ((4 + (b) * 2 + (h)) * HTB)
#define PG8_STAGE(bufoff, gbase, voff) do { _Pragma("unroll") for (int _i = 0; _i < 2; ++_i) \
        __builtin_amdgcn_global_load_lds((const unsigned*)((const char*)(gbase) + (voff)[_i]), (LAS unsigned*)(lds + (bufoff) + ldsw + _i * 8192), 16, 0, 0); } while (0)
#define PG8_LDA(dst, b, h) do { _Pragma("unroll") for (int m = 0; m < 4; ++m) _Pragma("unroll") for (int k = 0; k < 2; ++k) dst[m][k] = *(const LAS bf16x8*)(lds + PG8_SA(b, h) + aoff + m * 2048 + k * 1024); } while (0)
#define PG8_LDB(dst, b, h) do { _Pragma("unroll") for (int n = 0; n < 2; ++n) _Pragma("unroll") for (int k = 0; k < 2; ++k) dst[n][k] = *(const LAS bf16x8*)(lds + PG8_SB(b, h) + boff + n * 2048 + k * 1024); } while (0)
#define PG8_MMA(ai, bj, At, Bt) do { __builtin_amdgcn_s_setprio(1); _Pragma("unroll") for (int m = 0; m < 4; ++m) _Pragma("unroll") for (int n = 0; n < 2; ++n) _Pragma("unroll") for (int k = 0; k < 2; ++k) \
        acc[ai][bj][m][n] = Epi::SWAP ? __builtin_amdgcn_mfma_f32_16x16x32_bf16(At[m][k], Bt[n][k], acc[ai][bj][m][n], 0, 0, 0) \
                                      : __builtin_amdgcn_mfma_f32_16x16x32_bf16(Bt[n][k], At[m][k], acc[ai][bj][m][n], 0, 0, 0); __builtin_amdgcn_s_setprio(0); } while (0)
#define PG8_WAIT_V(n) asm volatile("s_waitcnt vmcnt(" #n ")" ::: "memory")
#define PG8_WAIT_L(n) asm volatile("s_waitcnt lgkmcnt(" #n ")" ::: "memory")
#define PG8_BAR __builtin_amdgcn_s_barrier()
#define PG8_SCHED __builtin_amdgcn_sched_barrier(0)
    Unit cur, nxt; int ui = 0;
    if (!S.next(0, cur)) return;
    f32x4 acc[2][2][4][2];
#pragma unroll
    for (int a = 0; a < 2; ++a)
#pragma unroll
        for (int b = 0; b < 2; ++b)
#pragma unroll
            for (int m = 0; m < 4; ++m)
#pragma unroll
                for (int n = 0; n < 2; ++n) acc[a][b][m][n] = (f32x4){0.f, 0.f, 0.f, 0.f};
    bf16x8 At[4][2], B0[2][2], B1[2][2];
    const char* cA = (const char*)g.A + (size_t)cur.pm * tstepA + (size_t)cur.pn * g.a_pn_off * 2; const char* cB = (const char*)g.Bt + (size_t)cur.pn * tstepB;
    PG8_STAGE(PG8_SB(0, 0), cB, voffB); PG8_STAGE(PG8_SA(0, 0), cA, voffA); PG8_STAGE(PG8_SB(0, 1), cB + hstepB, voffB); PG8_STAGE(PG8_SA(0, 1), cA + hstepA, voffA);
    if (wr == 1) PG8_BAR;
    PG8_WAIT_V(4); PG8_BAR;
    PG8_STAGE(PG8_SB(1, 0), cB + kstep, voffB); PG8_STAGE(PG8_SA(1, 0), cA + kstep, voffA); PG8_STAGE(PG8_SB(1, 1), cB + hstepB + kstep, voffB);
    PG8_WAIT_V(6); PG8_BAR;
    for (;;) {
        const bool has_next = S.next(ui + 1, nxt);
        const char* nA = has_next ? (const char*)g.A + (size_t)nxt.pm * tstepA + (size_t)nxt.pn * g.a_pn_off * 2 : cA; const char* nB = has_next ? (const char*)g.Bt + (size_t)nxt.pn * tstepB : cB;
        for (int t = 0; t < nt; t += 2) {
            const bool last = (t == nt - 2);
            const char* a1 = cA + (size_t)(t + 1) * kstep;
            const char* a2 = last ? nA : cA + (size_t)(t + 2) * kstep; const char* b2 = last ? nB : cB + (size_t)(t + 2) * kstep;
            const char* a3 = a2 + kstep; const char* b3 = b2 + kstep;
            PG8_LDB(B0, 0, 0); PG8_SCHED; PG8_LDA(At, 0, 0); PG8_STAGE(PG8_SA(1, 1), a1 + hstepA, voffA);
            PG8_WAIT_L(8); PG8_BAR; PG8_WAIT_L(0); PG8_MMA(0, 0, At, B0); PG8_BAR; PG8_SCHED;
            PG8_LDB(B1, 0, 1); PG8_STAGE(PG8_SB(0, 0), b2, voffB);
            PG8_BAR; PG8_WAIT_L(0); PG8_MMA(0, 1, At, B1); PG8_BAR;
            PG8_LDA(At, 0, 1); PG8_STAGE(PG8_SA(0, 0), a2, voffA);
            PG8_BAR; PG8_WAIT_L(0); PG8_MMA(1, 0, At, B0); PG8_BAR; PG8_SCHED;
            PG8_STAGE(PG8_SB(0, 1), b2 + hstepB, voffB);
            PG8_WAIT_V(6); PG8_BAR; PG8_MMA(1, 1, At, B1); PG8_BAR;
            PG8_LDB(B0, 1, 0); PG8_SCHED; PG8_LDA(At, 1, 0); PG8_STAGE(PG8_SA(0, 1), a2 + hstepA, voffA);
            PG8_WAIT_L(8); PG8_BAR; PG8_WAIT_L(0); PG8_MMA(0, 0, At, B0); PG8_BAR; PG8_SCHED;
            PG8_LDB(B1, 1, 1); PG8_STAGE(PG8_SB(1, 0), b3, voffB);
            PG8_BAR; PG8_WAIT_L(0); PG8_MMA(0, 1, At, B1); PG8_BAR;
            PG8_LDA(At, 1, 1); PG8_STAGE(PG8_SA(1, 0), a3, voffA);
            PG8_BAR; PG8_WAIT_L(0); PG8_MMA(1, 0, At, B0); PG8_BAR; PG8_SCHED;
            PG8_STAGE(PG8_SB(1, 1), b3 + hstepB, voffB);
            PG8_WAIT_V(6); PG8_BAR; PG8_MMA(1, 1, At, B1); PG8_BAR;
        }
        { const int l2 = opaque((int)threadIdx.x) & 63; E(acc, cur, wr, wc, l2 & 15, l2 >> 4); }
        if (!has_next) break;
#pragma unroll
        for (int a = 0; a < 2; ++a)
#pragma unroll
            for (int b = 0; b < 2; ++b)
#pragma unroll
                for (int m = 0; m < 4; ++m)
#pragma unroll
                    for (int n = 0; n < 2; ++n) acc[a][b][m][n] = (f32x4){0.f, 0.f, 0.f, 0.f};
        cur = nxt; cA = nA; cB = nB; ++ui;
    }
    PG8_WAIT_V(0);
    if (wr == 0) PG8_BAR;
    PG8_BAR;
#undef PG8_SA
#undef PG8_SB
#undef PG8_STAGE
#undef PG8_LDA
#undef PG8_LDB
#undef PG8_MMA
#undef PG8_WAIT_V
#undef PG8_WAIT_L
#undef PG8_BAR
#undef PG8_SCHED
}

template <int ACT> struct EpiBf16 {
    static constexpr bool PERM = true, SWAP = false;
    bf16_t* O; int ldc;
    __device__ __forceinline__ void operator()(const f32x4 (&acc)[2][2][4][2], const Unit& u, int wr, int wc, int fr, int fq) const {
        const int row0 = u.pm * BM + wr * 64 + fr, col0 = u.pn * BM + wc * 32 + 8 * fq;
#pragma unroll
        for (int ai = 0; ai < 2; ++ai)
#pragma unroll
            for (int m = 0; m < 4; ++m) { bf16_t* rowp = O + (size_t)(row0 + ai * HALF + m * 16) * ldc + col0;
#pragma unroll
                for (int bj = 0; bj < 2; ++bj) { f32x4 v0 = acc[ai][bj][m][0], v1 = acc[ai][bj][m][1];
                    if (ACT == 1) {
#pragma unroll
                        for (int j = 0; j < 4; ++j) { v0[j] = gelu_tanh(v0[j]); v1[j] = gelu_tanh(v1[j]); } }
                    u32x4 w; w.x = cvt_pk_bf16(v0[0], v0[1]); w.y = cvt_pk_bf16(v0[2], v0[3]); w.z = cvt_pk_bf16(v1[0], v1[1]); w.w = cvt_pk_bf16(v1[2], v1[3]);
                    *(u32x4*)(rowp + bj * HALF) = w; } }
    }
};
struct EpiPoolGrp {
    static constexpr bool PERM = true, SWAP = false;
    bf16_t* O; const float* scale;
    __device__ __forceinline__ void operator()(const f32x4 (&acc)[2][2][4][2], const Unit& u, int wr, int wc, int fr, int fq) const {
        const int row0 = u.pm * BM + wr * 64 + fr, col0 = u.pn * BM + wc * 32 + 8 * fq;
#pragma unroll
        for (int bj = 0; bj < 2; ++bj) {
            const f32x4 s0 = *(const f32x4*)(scale + col0 + bj * HALF), s1 = *(const f32x4*)(scale + col0 + bj * HALF + 4);
#pragma unroll
            for (int ai = 0; ai < 2; ++ai)
#pragma unroll
                for (int m = 0; m < 4; ++m) { bf16_t* rowp = O + (size_t)(row0 + ai * HALF + m * 16) * DM + col0 + bj * HALF;
                    const f32x4 v0 = acc[ai][bj][m][0] * s0, v1 = acc[ai][bj][m][1] * s1;
                    u32x4 w; w.x = cvt_pk_bf16(v0[0], v0[1]); w.y = cvt_pk_bf16(v0[2], v0[3]); w.z = cvt_pk_bf16(v1[0], v1[1]); w.w = cvt_pk_bf16(v1[2], v1[3]);
                    *(u32x4*)rowp = w; }
            asm volatile("" ::: "memory");
        }
    }
};
struct EpiConvIn {
    static constexpr bool PERM = true, SWAP = false;
    bf16_t* BG; bf16_t* Z;
    __device__ __forceinline__ void operator()(const f32x4 (&acc)[2][2][4][2], const Unit& u, int wr, int wc, int fr, int fq) const {
        const int row0 = u.pm * BM + wr * 64 + fr;
        if (u.pn < 4) {
            const int col0 = u.pn * BM + wc * 32 + 8 * fq;
#pragma unroll
            for (int ai = 0; ai < 2; ++ai)
#pragma unroll
                for (int m = 0; m < 4; ++m) { bf16_t* rowp = BG + (size_t)(row0 + ai * HALF + m * 16) * DM + col0;
#pragma unroll
                    for (int bj = 0; bj < 2; ++bj) { const f32x4 v0 = acc[ai][bj][m][0], v1 = acc[ai][bj][m][1];
                        u32x4 w; w.x = cvt_pk_bf16(v0[0], v0[1]); w.y = cvt_pk_bf16(v0[2], v0[3]); w.z = cvt_pk_bf16(v1[0], v1[1]); w.w = cvt_pk_bf16(v1[2], v1[3]);
                        *(u32x4*)(rowp + bj * HALF) = w; } }
        } else {
            const int col0 = (u.pn - 4) * HALF + wc * 32 + 8 * fq;
#pragma unroll
            for (int ai = 0; ai < 2; ++ai)
#pragma unroll
                for (int m = 0; m < 4; ++m) { bf16_t* rowp = Z + (size_t)(row0 + ai * HALF + m * 16) * DM + col0;
                    const f32x4 v0 = acc[ai][0][m][0] * acc[ai][1][m][0], v1 = acc[ai][0][m][1] * acc[ai][1][m][1];
                    u32x4 w; w.x = cvt_pk_bf16(v0[0], v0[1]); w.y = cvt_pk_bf16(v0[2], v0[3]); w.z = cvt_pk_bf16(v1[0], v1[1]); w.w = cvt_pk_bf16(v1[2], v1[3]);
                    *(u32x4*)rowp = w; }
        }
    }
};
struct EpiResid {
    static constexpr bool PERM = false, SWAP = false;
    const float* base; float* out; const float* gacc; const float* gbias;
    __device__ __forceinline__ void operator()(const f32x4 (&acc)[2][2][4][2], const Unit& u, int wr, int wc, int fr, int fq) const {
        const int row0 = u.pm * BM + wr * 64 + fr, col0 = u.pn * BM + wc * 32 + 4 * fq;
        const float* gp = gacc + (size_t)(u.pm >> 4) * (6 * DM);
#pragma unroll
        for (int bj = 0; bj < 2; ++bj)
#pragma unroll
            for (int n = 0; n < 2; ++n) { const int cc = col0 + bj * HALF + n * 16;
                const f32x4 gv = *(const f32x4*)(gp + cc);
#pragma unroll
                for (int ai = 0; ai < 2; ++ai) {
#pragma unroll
                    for (int m = 0; m < 4; ++m) { const size_t off = (size_t)(row0 + ai * HALF + m * 16) * DM + cc;
                        const f32x4 bs = *(const f32x4*)(base + off);
                        *(f32x4*)(out + off) = bs + gv * acc[ai][bj][m][n]; }
                    asm volatile("" ::: "memory"); } }
    }
};
struct EpiGmlpV {
    static constexpr bool PERM = false, SWAP = true;
    bf16_t* VT;
    __device__ __forceinline__ void operator()(const f32x4 (&acc)[2][2][4][2], const Unit& u, int wr, int wc, int fr, int fq) const {
        const int row0 = u.pm * BM + wr * 64 + 4 * fq, col0 = u.pn * BM + wc * 32 + fr;
#pragma unroll
        for (int bj = 0; bj < 2; ++bj)
#pragma unroll
            for (int n = 0; n < 2; ++n) { bf16_t* colp = VT + (size_t)(col0 + bj * HALF + n * 16) * MTOK + row0;
#pragma unroll
                for (int ai = 0; ai < 2; ++ai)
#pragma unroll
                    for (int m = 0; m < 4; ++m) { const f32x4 v = acc[ai][bj][m][n];
                        u32x2 w; w.x = cvt_pk_bf16(gelu_tanh(v[0]), gelu_tanh(v[1])); w.y = cvt_pk_bf16(gelu_tanh(v[2]), gelu_tanh(v[3]));
                        *(u32x2*)(colp + ai * HALF + m * 16) = w; } }
    }
};
}

constexpr int RING_BYTES = 131072;
constexpr int LDS_BYTES = 147456;
constexpr int LDS_XB_OFF = RING_BYTES;
constexpr int NTHREADS = 512;

#define CE_DESC(a, b) do { const float _x = fmaxf(a, b), _y = fminf(a, b); a = _x; b = _y; } while (0)
#define CE_ASC(a, b)  do { const float _x = fminf(a, b), _y = fmaxf(a, b); a = _x; b = _y; } while (0)
template <int OFF, int N>
__device__ __forceinline__ void sort16_desc(float (&v)[N]) {
#pragma unroll
    for (int k = 2; k <= 16; k <<= 1)
#pragma unroll
        for (int j = k >> 1; j > 0; j >>= 1)
#pragma unroll
            for (int i = 0; i < 16; ++i) { const int l = i ^ j; if (l > i) { if ((i & k) == 0) CE_DESC(v[OFF + i], v[OFF + l]); else CE_ASC(v[OFF + i], v[OFF + l]); } }
}
template <int OFF, int N>
__device__ __forceinline__ void bmerge16_desc(float (&v)[N]) {
#pragma unroll
    for (int j = 8; j > 0; j >>= 1)
#pragma unroll
        for (int i = 0; i < 16; ++i) { const int l = i ^ j; if (l > i) CE_DESC(v[OFF + i], v[OFF + l]); }
}
template <int A, int B, int N>
__device__ __forceinline__ void merge_top16(float (&v)[N]) {
#pragma unroll
    for (int i = 0; i < 16; ++i) v[A + i] = fmaxf(v[A + i], v[B + 15 - i]);
    bmerge16_desc<A, N>(v);
}
__device__ __forceinline__ void top16_of_64(float (&v)[64]) {
    sort16_desc<0, 64>(v); sort16_desc<16, 64>(v); sort16_desc<32, 64>(v); sort16_desc<48, 64>(v);
    merge_top16<0, 16, 64>(v); merge_top16<32, 48, 64>(v); merge_top16<0, 32, 64>(v);
}

struct Args { const float* in[23]; float* out; unsigned char* ws; int ph_lo, ph_hi; };
typedef const __attribute__((address_space(4))) Args* ArgP;
enum { I_X = 0, I_C, I_ADA_W, I_ADA_B, I_NORM_G, I_POOL_WIN, I_POOL_WGRP, I_POOL_SCALE, I_POOL_WOUT, I_CONV_WIN, I_CONV_W, I_CONV_WOUT,
       I_GMLP_WIN, I_GMLP_LNG, I_GMLP_LNB, I_GMLP_WS, I_GMLP_BS, I_GMLP_WOUT, I_PEER_WQ, I_PEER_KEYS, I_PEER_U, I_PEER_V, I_FINAL_G };

__device__ __forceinline__ void transpose_item(const float* W, int K, int N, bf16_t* WT, int dst_row0, LAS float* scr, int k0, int n0, int lane) {
#pragma unroll 8
    for (int i = 0; i < 32; ++i) { const int kk = 2 * i + (lane >> 5); scr[kk * 33 + (lane & 31)] = W[(size_t)(k0 + kk) * N + n0 + (lane & 31)]; }
    asm volatile("s_waitcnt lgkmcnt(0)" ::: "memory");
    const int c = lane & 7;
#pragma unroll
    for (int j = 0; j < 4; ++j) { const int n = (lane >> 3) + 8 * j; const LAS float* s = scr + (8 * c) * 33 + n;
        u32x4 o; o.x = cvt_pk_bf16(s[0 * 33], s[1 * 33]); o.y = cvt_pk_bf16(s[2 * 33], s[3 * 33]); o.z = cvt_pk_bf16(s[4 * 33], s[5 * 33]); o.w = cvt_pk_bf16(s[6 * 33], s[7 * 33]);
        *(u32x4*)(WT + (size_t)(dst_row0 + n) * K + k0 + 8 * c) = o; }
    asm volatile("s_waitcnt lgkmcnt(0)" ::: "memory");
}
__device__ __forceinline__ void convert_stream(const float* src, bf16_t* dst, size_t n8, size_t gt, size_t stride) {
    for (size_t i = gt; i < n8; i += stride) {
        const f32x4 a = __builtin_nontemporal_load((const f32x4*)src + 2 * i), b = __builtin_nontemporal_load((const f32x4*)src + 2 * i + 1);
        u32x4 o; o.x = cvt_pk_bf16(a[0], a[1]); o.y = cvt_pk_bf16(a[2], a[3]); o.z = cvt_pk_bf16(b[0], b[1]); o.w = cvt_pk_bf16(b[2], b[3]);
        *((u32x4*)dst + i) = o; }
}
__device__ __forceinline__ void prologue_phase(ArgP Ap, LAS unsigned char* lds, int vcu, int G, int tid, int wid, int lane) {
    unsigned char* ws = Ap->ws;
    const int gw = vcu * 8 + wid, NGW = G * 8;
    LAS float* scr = (LAS float*)(lds + wid * 16384);
    constexpr int NT_ITEMS = 1024 + 256 + 1024 + 1536 + 512 + 3072 + 1536 + 4096;
    for (int it = gw; it < NT_ITEMS; it += NGW) {
        int r = it; const float* src; bf16_t* dst; int K, N, kind = 0;
        if (r < 1024) { const int m = r >> 9; r &= 511; src = Ap->in[I_POOL_WIN] + (size_t)m * DM * DM; dst = (bf16_t*)(ws + WS_POOL_WIN) + (size_t)m * DM * DM; K = DM; N = DM; }
        else if ((r -= 1024) < 256) { const int m = r >> 5; r &= 31; src = Ap->in[I_POOL_WGRP] + (size_t)m * 65536; dst = (bf16_t*)(ws + WS_POOL_WGRP) + (size_t)m * 65536; K = 256; N = 256; }
        else if ((r -= 256) < 1024) { const int m = r >> 9; r &= 511; src = Ap->in[I_POOL_WOUT] + (size_t)m * DM * DM; dst = (bf16_t*)(ws + WS_POOL_WOUT) + (size_t)m * DM * DM; K = DM; N = DM; }
        else if ((r -= 1024) < 1536) { src = Ap->in[I_CONV_WIN]; dst = (bf16_t*)(ws + WS_CONV_WIN); K = DM; N = 3 * DM; kind = 1; }
        else if ((r -= 1536) < 512) { src = Ap->in[I_CONV_WOUT]; dst = (bf16_t*)(ws + WS_CONV_WOUT); K = DM; N = DM; }
        else if ((r -= 512) < 3072) { src = Ap->in[I_GMLP_WIN]; dst = (bf16_t*)(ws + WS_GMLP_WIN); K = DM; N = 2 * GH; }
        else if ((r -= 3072) < 1536) { src = Ap->in[I_GMLP_WOUT]; dst = (bf16_t*)(ws + WS_GMLP_WOUT); K = GH; N = DM; }
        else { r -= 1536; const int m = r >> 10; r &= 1023; src = Ap->in[I_PEER_WQ] + (size_t)m * DM * 2048; dst = (bf16_t*)(ws + WS_PEER_WQ) + (size_t)m * DM * 2048; K = DM; N = 2048; }
        const int nblk = N / 32, kb = r / nblk, nb = r % nblk, n0 = 32 * nb;
        int drow = n0;
        if (kind == 1 && n0 >= DM) { const int xt = n0 >= 2 * DM, ch = n0 - (xt ? 2 * DM : DM); drow = DM + 256 * (ch >> 7) + 128 * xt + (ch & 127); }
        transpose_item(src, K, N, dst, drow, scr, 64 * kb, n0, lane);
    }
    const size_t gt = (size_t)vcu * NTHREADS + tid, stride = (size_t)G * NTHREADS;
    convert_stream(Ap->in[I_PEER_KEYS], (bf16_t*)(ws + WS_KEYS), (size_t)DEPTH * 16 * 128 * 128 / 8, gt, stride);
    for (int row = gw; row < 2 * DEPTH * NEXP; row += NGW) {
        const int tab = row >> 16, lrow = row & 65535, l = lrow >> 14, e = lrow & (NEXP - 1);
        const f32x4* src = (const f32x4*)((tab ? Ap->in[I_PEER_V] : Ap->in[I_PEER_U]) + (size_t)lrow * DM) + lane;
        f32x4 v[4]; float m = 0.f;
#pragma unroll
        for (int j = 0; j < 4; ++j) { v[j] = __builtin_nontemporal_load(src + 64 * j); m = fmaxf(fmaxf(m, fmaxf(fabsf(v[j][0]), fabsf(v[j][1]))), fmaxf(fabsf(v[j][2]), fabsf(v[j][3]))); }
#pragma unroll
        for (int o = 1; o < 64; o <<= 1) m = fmaxf(m, __shfl_xor(m, o));
        const float S = m > 0.f ? 256.0f / m : 1.0f;
        unsigned char* dst = ws + (tab ? WS_TABV : WS_TABU);
#pragma unroll
        for (int j = 0; j < 4; ++j) { int pk = __builtin_amdgcn_cvt_pk_fp8_f32(v[j][0] * S, v[j][1] * S, 0, false); pk = __builtin_amdgcn_cvt_pk_fp8_f32(v[j][2] * S, v[j][3] * S, pk, true);
            const int d0 = 256 * j + 4 * lane;
            *(int*)(dst + (((size_t)l * 8 + (d0 >> 7)) * NEXP + e) * 128 + (d0 & 127)) = pk; }
        if (lane == 0) ((float*)(ws + (tab ? WS_SCV : WS_SCU)))[lrow] = m > 0.f ? m * (1.0f / 256.0f) : 1.0f;
    }
    __syncthreads();
    LAS float* cond = (LAS float*)lds;
    for (int i = tid; i < BATCH * DM; i += NTHREADS) { const int b = i >> 10, k = i & 1023; const float c = Ap->in[I_C][i]; cond[k * 8 + b] = c * __builtin_amdgcn_rcpf(1.0f + __expf(-c)); }
    __syncthreads();
    float* modp = (float*)(ws + WS_ADAP);
    for (int it = gw; it < DEPTH * 24 * 16; it += NGW) {
        const int l = it / 384, r = it % 384, cgp = r >> 4, kc = r & 15;
        const float* wp = Ap->in[I_ADA_W] + ((size_t)l * DM + kc * 64) * (6 * DM) + cgp * 256 + 4 * lane;
        f32x4 acc[8];
#pragma unroll
        for (int b = 0; b < 8; ++b) acc[b] = (f32x4){0.f, 0.f, 0.f, 0.f};
#pragma unroll 8
        for (int k = 0; k < 64; ++k) { const f32x4 w = __builtin_nontemporal_load((const f32x4*)(wp + (size_t)k * (6 * DM)));
            const f32x4 c0 = *(const LAS f32x4*)(cond + (kc * 64 + k) * 8), c1 = *(const LAS f32x4*)(cond + (kc * 64 + k) * 8 + 4);
            acc[0] += c0[0] * w; acc[1] += c0[1] * w; acc[2] += c0[2] * w; acc[3] += c0[3] * w; acc[4] += c1[0] * w; acc[5] += c1[1] * w; acc[6] += c1[2] * w; acc[7] += c1[3] * w; }
#pragma unroll
        for (int b = 0; b < 8; ++b) *(f32x4*)(modp + (((size_t)kc * DEPTH + l) * 8 + b) * (6 * DM) + cgp * 256 + 4 * lane) = acc[b];
    }
}
__device__ __forceinline__ void modreduce_phase(ArgP Ap, int vcu, int G, int tid) {
    unsigned char* ws = Ap->ws; const float* modp = (const float*)(ws + WS_ADAP); float* mod = (float*)(ws + WS_MOD);
    constexpr int N4 = DEPTH * BATCH * 6 * DM / 4;
    for (int i = vcu * NTHREADS + tid; i < N4; i += G * NTHREADS) {
        const int n4 = i % (6 * DM / 4), l = i / (BATCH * 6 * DM / 4);
        f32x4 a = *((const f32x4*)(Ap->in[I_ADA_B] + (size_t)l * 6 * DM) + n4);
#pragma unroll
        for (int kc = 0; kc < 16; ++kc) a += *((const f32x4*)modp + (size_t)kc * N4 + i);
        *((f32x4*)mod + i) = a; }
}

__device__ __forceinline__ void norm_phase(const float* x, const float* gn, const float* macc  , const float* mbias  , int sh_off, int sc_off, bf16_t* H, int gw, int NGW, int lane) {
    for (int ch = gw; ch < MTOK / 16; ch += NGW) {
        const int row0 = ch * 16, b = row0 >> 12;
        f32x4 c1[4], shv[4];
#pragma unroll
        for (int j = 0; j < 4; ++j) { const int col = 4 * lane + 256 * j;
            const f32x4 sc = *(const f32x4*)(macc + (size_t)b * 6 * DM + sc_off + col);
            c1[j] = *(const f32x4*)(gn + col) * (1.0f + sc);
            shv[j] = *(const f32x4*)(macc + (size_t)b * 6 * DM + sh_off + col); }
        for (int r = row0; r < row0 + 16; ++r) {
            const f32x4* xr = (const f32x4*)(x + (size_t)r * DM) + lane;
            f32x4 v[4]; float ss = 0.f;
#pragma unroll
            for (int j = 0; j < 4; ++j) { v[j] = xr[64 * j]; ss += (v[j][0] * v[j][0] + v[j][1] * v[j][1]) + (v[j][2] * v[j][2] + v[j][3] * v[j][3]); }
            const float rstd = __builtin_amdgcn_rsqf(wave_sum_all(ss) * (1.0f / DM) + EPS);
            u32x2* o8 = (u32x2*)(H + (size_t)r * DM) + lane;
#pragma unroll
            for (int j = 0; j < 4; ++j) { const f32x4 o = v[j] * rstd * c1[j] + shv[j]; u32x2 w; w.x = cvt_pk_bf16(o[0], o[1]); w.y = cvt_pk_bf16(o[2], o[3]); o8[64 * j] = w; }
        }
    }
}
__device__ __forceinline__ void final_phase(float* x, const float* gf, int gw, int NGW, int lane) {
    f32x4 gv[4];
#pragma unroll
    for (int j = 0; j < 4; ++j) gv[j] = *(const f32x4*)(gf + 4 * lane + 256 * j);
    for (int r = gw; r < MTOK; r += NGW) {
        f32x4* xr = (f32x4*)(x + (size_t)r * DM) + lane;
        f32x4 v[4]; float ss = 0.f;
#pragma unroll
        for (int j = 0; j < 4; ++j) { v[j] = xr[64 * j]; ss += (v[j][0] * v[j][0] + v[j][1] * v[j][1]) + (v[j][2] * v[j][2] + v[j][3] * v[j][3]); }
        const float rstd = __builtin_amdgcn_rsqf(wave_sum_all(ss) * (1.0f / DM) + EPS);
#pragma unroll
        for (int j = 0; j < 4; ++j) xr[64 * j] = v[j] * rstd * gv[j];
    }
}

__device__ __forceinline__ void unpack8(const u32x4 w, float (&f)[8]) { f[0] = bf_lo(w.x); f[1] = bf_hi(w.x); f[2] = bf_lo(w.y); f[3] = bf_hi(w.y); f[4] = bf_lo(w.z); f[5] = bf_hi(w.z); f[6] = bf_lo(w.w); f[7] = bf_hi(w.w); }
__device__ __forceinline__ u32x4 pack8(const float (&f)[8]) { u32x4 o; o.x = cvt_pk_bf16(f[0], f[1]); o.y = cvt_pk_bf16(f[2], f[3]); o.z = cvt_pk_bf16(f[4], f[5]); o.w = cvt_pk_bf16(f[6], f[7]); return o; }
__device__ __forceinline__ void pool_elem_phase(const bf16_t* U, bf16_t* P, int vcu, int G, int tid) {
    const int chunk = tid & 127, run = tid >> 7, c0 = 8 * chunk, w = 2 << (c0 >> 8);
    for (int unit = vcu; unit < MTOK / 128; unit += G) {
        const int t0 = unit * 128 + run * 32, seq0 = t0 & ~(SEQ - 1);
        float s[8];
#pragma unroll
        for (int j = 0; j < 8; ++j) s[j] = 0.f;
        for (int tau = t0 - w; tau < t0; ++tau) if (tau >= seq0) { float f[8];     unpack8(*(const u32x4*)(U + (size_t)tau * DM + c0), f);
#pragma unroll
            for (int j = 0; j < 8; ++j) s[j] += f[j]; }
        for (int t = t0; t < t0 + 32; ++t) {
            float f[8], o[8]; unpack8(*(const u32x4*)(U + (size_t)t * DM + c0), f);
#pragma unroll
            for (int j = 0; j < 8; ++j) s[j] += f[j];
            if (t - w >= seq0) { float q[8]; unpack8(*(const u32x4*)(U + (size_t)(t - w) * DM + c0), q);
#pragma unroll
                for (int j = 0; j < 8; ++j) s[j] -= q[j]; }
            const int pos1 = t - seq0 + 1; const float inv = 1.0f / (float)(pos1 < w ? pos1 : w);
#pragma unroll
            for (int j = 0; j < 8; ++j) o[j] = s[j] * inv - f[j];
            *(u32x4*)(P + (size_t)t * DM + c0) = pack8(o);
        }
    }
}
__device__ __forceinline__ void conv_elem_phase(const bf16_t* BG, const bf16_t* Z, const float* cw  , bf16_t* Aout, int vcu, int G, int tid) {
    const int chunk = tid & 127, run = tid >> 7, c0 = 8 * chunk;
    float w0[8], w1[8], w2[8];
#pragma unroll
    for (int j = 0; j < 8; ++j) { w0[j] = cw[c0 + j]; w1[j] = cw[DM + c0 + j]; w2[j] = cw[2 * DM + c0 + j]; }
    for (int unit = vcu; unit < MTOK / 128; unit += G) {
        const int t0 = unit * 128 + run * 32, seq0 = t0 & ~(SEQ - 1);
        float zm2[8], zm1[8];
#pragma unroll
        for (int j = 0; j < 8; ++j) { zm2[j] = 0.f; zm1[j] = 0.f; }
        if (t0 - 2 >= seq0) unpack8(*(const u32x4*)(Z + (size_t)(t0 - 2) * DM + c0), zm2);
        if (t0 - 1 >= seq0) unpack8(*(const u32x4*)(Z + (size_t)(t0 - 1) * DM + c0), zm1);
        for (int t = t0; t < t0 + 32; ++t) {
            float z[8], bg[8], o[8]; unpack8(*(const u32x4*)(Z + (size_t)t * DM + c0), z); unpack8(*(const u32x4*)(BG + (size_t)t * DM + c0), bg);
#pragma unroll
            for (int j = 0; j < 8; ++j) { o[j] = bg[j] * (w0[j] * zm2[j] + w1[j] * zm1[j] + w2[j] * z[j]); zm2[j] = zm1[j]; zm1[j] = z[j]; }
            *(u32x4*)(Aout + (size_t)t * DM + c0) = pack8(o);
        }
    }
}

__device__ __forceinline__ int wp_off(int row, int chunk) { return row * 256 + ((chunk ^ (row & 15)) << 4); }
__device__ __forceinline__ void mix_phase(LAS unsigned char* lds, bf16_t* UA, const bf16_t* VT, const float* WS, const float* BS, const float* LNG, const float* LNB, int vcu, int G, int tid, int wid, int lane) {
    LAS unsigned char* WP = lds;
    LAS float* MU = (LAS float*)(lds + 32768); LAS float* RSTD = MU + 128; LAS float* R1 = MU + 256; LAS float* R2 = MU + 384;
    LAS float* PART = (LAS float*)(lds + 36864);
    for (int n = vcu; n < MTOK / 128; n += G) {
        {
            const int cgp = tid >> 4, tl = tid & 15;
            float s[8], q[8];
#pragma unroll
            for (int j = 0; j < 8; ++j) { s[j] = 0.f; q[j] = 0.f; }
#pragma unroll 4
            for (int it = 0; it < GH / 32; ++it) { float f[8]; unpack8(*(const u32x4*)(VT + (size_t)(it * 32 + cgp) * MTOK + n * 128 + tl * 8), f);
#pragma unroll
                for (int j = 0; j < 8; ++j) { s[j] += f[j]; q[j] += f[j] * f[j]; } }
#pragma unroll
            for (int j = 0; j < 8; ++j) { PART[(cgp * 128 + tl * 8 + j) * 2] = s[j]; PART[(cgp * 128 + tl * 8 + j) * 2 + 1] = q[j]; }
            __syncthreads();
            if (tid < 128) { float S = 0.f, Q = 0.f;
                for (int k = 0; k < 32; ++k) { S += PART[(k * 128 + tid) * 2]; Q += PART[(k * 128 + tid) * 2 + 1]; }
                const float mu = S * (1.0f / GH), var = Q * (1.0f / GH) - mu * mu; MU[tid] = mu; RSTD[tid] = __builtin_amdgcn_rsqf(fmaxf(var, 0.f) + EPS); }
            __syncthreads();
        }
        for (int g = 0; g < 8; ++g) {
            {
                const int i = tid >> 2, part = tid & 3;
                const float* wrow = WS + ((size_t)g * 128 + i) * 128 + part * 32;
                float r1 = 0.f, r2 = 0.f;
#pragma unroll
                for (int jj = 0; jj < 32; jj += 8) { const int j0 = part * 32 + jj;
                    f32x4 a = *(const f32x4*)(wrow + jj), b = *(const f32x4*)(wrow + jj + 4);
                    if (i < 64 && j0 >= 64) { a = (f32x4){0.f, 0.f, 0.f, 0.f}; b = a; }
                    const f32x4 ra = *(const LAS f32x4*)(RSTD + j0), rb = *(const LAS f32x4*)(RSTD + j0 + 4), ma = *(const LAS f32x4*)(MU + j0), mb = *(const LAS f32x4*)(MU + j0 + 4);
                    const f32x4 wa = a * ra, wb = b * rb;
                    r1 += (wa[0] * ma[0] + wa[1] * ma[1]) + (wa[2] * ma[2] + wa[3] * ma[3]) + (wb[0] * mb[0] + wb[1] * mb[1]) + (wb[2] * mb[2] + wb[3] * mb[3]);
                    r2 += (a[0] + a[1]) + (a[2] + a[3]) + (b[0] + b[1]) + (b[2] + b[3]);
                    u32x4 o; o.x = cvt_pk_bf16(wa[0], wa[1]); o.y = cvt_pk_bf16(wa[2], wa[3]); o.z = cvt_pk_bf16(wb[0], wb[1]); o.w = cvt_pk_bf16(wb[2], wb[3]);
                    *(LAS u32x4*)(WP + wp_off(i, j0 >> 3)) = o; }
                r1 += __shfl_xor(r1, 1); r1 += __shfl_xor(r1, 2); r2 += __shfl_xor(r2, 1); r2 += __shfl_xor(r2, 2);
                if (part == 0) { R1[i] = r1; R2[i] = r2; }
            }
            __syncthreads();
            f32x4 acc[3][8];
#pragma unroll
            for (int ct = 0; ct < 3; ++ct)
#pragma unroll
                for (int it = 0; it < 8; ++it) acc[ct][it] = (f32x4){0.f, 0.f, 0.f, 0.f};
            const int fr = lane & 15, fq = lane >> 4, cbase = g * 384 + wid * 48;
#pragma unroll 1
            for (int ks = 0; ks < 4; ++ks) {
                bf16x8 av[3];
#pragma unroll
                for (int ct = 0; ct < 3; ++ct) av[ct] = *(const bf16x8*)(VT + (size_t)(cbase + ct * 16 + fr) * MTOK + n * 128 + ks * 32 + fq * 8);
#pragma unroll
                for (int it = 0; it < 8; ++it) { const bf16x8 bw = *(const LAS bf16x8*)(WP + wp_off(it * 16 + fr, ks * 4 + fq));
#pragma unroll
                    for (int ct = 0; ct < 3; ++ct) acc[ct][it] = __builtin_amdgcn_mfma_f32_16x16x32_bf16(av[ct], bw, acc[ct][it], 0, 0, 0); }
            }
#pragma unroll
            for (int ct = 0; ct < 3; ++ct) { const int c4 = cbase + ct * 16 + 4 * fq;
                const f32x4 lg = *(const f32x4*)(LNG + c4), lb = *(const f32x4*)(LNB + c4);
#pragma unroll
                for (int it = 0; it < 8; ++it) { const int i = it * 16 + fr; const float r1 = R1[i], r2 = R2[i], bs = BS[g * 128 + i];
                    bf16_t* up = UA + (size_t)(n * 128 + i) * GH + c4; const u32x2 uu = *(const u32x2*)up;
                    const f32x4 vs = lg * (acc[ct][it] - r1) + lb * r2 + bs;
                    u32x2 o; o.x = cvt_pk_bf16(bf_lo(uu.x) * vs[0], bf_hi(uu.x) * vs[1]); o.y = cvt_pk_bf16(bf_lo(uu.y) * vs[2], bf_hi(uu.y) * vs[3]);
                    *(u32x2*)up = o; } }
            __syncthreads();
        }
    }
}

__device__ __forceinline__ void topk_phase(LAS unsigned char* lds, const bf16_t* Q, const bf16_t* KEYS, int* SELI, float* SELW, int vcu, int G, int tid, int wid, int lane) {
    LAS float* topv = (LAS float*)lds;
    const int p = wid >> 2, sub = wid & 3, tl = lane & 31, hi = lane >> 5;
    for (int unit = vcu; unit < (MTOK / 128) * 8; unit += G) {
        const int tile = unit >> 3, h = unit & 7;
        {
            const bf16_t* qrow = Q + (size_t)(tile * 128 + sub * 32 + tl) * 2048 + h * 256 + p * 128 + hi * 8;
            const bf16_t* krow = KEYS + ((size_t)(h * 2 + p) * 128 + tl) * 128 + hi * 8;
            f32x16 acc[4];
#pragma unroll
            for (int kt = 0; kt < 4; ++kt)
#pragma unroll
                for (int r = 0; r < 16; ++r) acc[kt][r] = 0.f;
#pragma unroll
            for (int ks = 0; ks < 8; ++ks) { const bf16x8 bq = *(const bf16x8*)(qrow + ks * 16);
#pragma unroll
                for (int kt = 0; kt < 4; ++kt) { const bf16x8 ak = *(const bf16x8*)(krow + kt * 32 * 128 + ks * 16);
                    acc[kt] = __builtin_amdgcn_mfma_f32_32x32x16_bf16(ak, bq, acc[kt], 0, 0, 0); } }
            float v[64];
#pragma unroll
            for (int kt = 0; kt < 4; ++kt)
#pragma unroll
                for (int r = 0; r < 16; ++r) { const unsigned key = (unsigned)(kt * 32 + (r & 3) + 8 * (r >> 2) + 4 * hi);
                    v[kt * 16 + r] = __uint_as_float((__float_as_uint(acc[kt][r]) & ~127u) | key); }
            top16_of_64(v);
            float m[16];
#pragma unroll
            for (int i = 0; i < 16; ++i) m[i] = fmaxf(v[i], __shfl_xor(v[15 - i], 32));
            bmerge16_desc<0, 16>(m);
            if (hi == 0) { LAS f32x4* dst = (LAS f32x4*)(topv + (p * 128 + sub * 32 + tl) * 16);
#pragma unroll
                for (int i = 0; i < 4; ++i) dst[i] = (f32x4){m[4 * i], m[4 * i + 1], m[4 * i + 2], m[4 * i + 3]}; }
        }
        __syncthreads();
        if (tid < 128) {
            float s0[16], s1[16];
#pragma unroll
            for (int i = 0; i < 4; ++i) { const f32x4 a = *(const LAS f32x4*)(topv + tid * 16 + 4 * i), b = *(const LAS f32x4*)(topv + (128 + tid) * 16 + 4 * i);
                s0[4 * i] = a[0]; s0[4 * i + 1] = a[1]; s0[4 * i + 2] = a[2]; s0[4 * i + 3] = a[3]; s1[4 * i] = b[0]; s1[4 * i + 1] = b[1]; s1[4 * i + 2] = b[2]; s1[4 * i + 3] = b[3]; }
            float c[64];
            constexpr int pre[16] = {0, 16, 24, 29, 33, 36, 38, 40, 42, 43, 44, 45, 46, 47, 48, 49};
#pragma unroll
            for (int a = 0; a < 16; ++a)
#pragma unroll
                for (int b = 0; b < 16; ++b) if ((a + 1) * (b + 1) <= 16) c[pre[a] + b] = __uint_as_float((__float_as_uint(s0[a] + s1[b]) & ~255u) | (unsigned)(a * 16 + b));
#pragma unroll
            for (int i = 50; i < 64; ++i) c[i] = -3.0e38f;
            top16_of_64(c);
            float e[16], sum = 0.f;
#pragma unroll
            for (int k = 0; k < 16; ++k) { e[k] = __builtin_amdgcn_exp2f((c[k] - c[0]) * 1.44269504f); sum += e[k]; }
            const float inv = 1.0f / sum;
            const size_t o = (size_t)(tile * 128 + tid) * NPICK + h * 16;
#pragma unroll
            for (int k4 = 0; k4 < 4; ++k4) { i32x4 ei; f32x4 wv;
#pragma unroll
                for (int j = 0; j < 4; ++j) { const unsigned code = __float_as_uint(c[4 * k4 + j]) & 255u;
                    const unsigned i1 = __float_as_uint(topv[tid * 16 + (code >> 4)]) & 127u, i2 = __float_as_uint(topv[(128 + tid) * 16 + (code & 15u)]) & 127u;
                    ei[j] = (int)(i1 * 128u + i2); wv[j] = e[4 * k4 + j] * inv; }
                *(i32x4*)(SELI + o + 4 * k4) = ei; *(f32x4*)(SELW + o + 4 * k4) = wv; }
        }
        __syncthreads();
    }
}

typedef const unsigned char* cbytes;
template <int CTRL> __device__ __forceinline__ float dpp_f(float v) { return __builtin_bit_cast(float, __builtin_amdgcn_update_dpp(0, __builtin_bit_cast(int, v), CTRL, 0xf, 0xf, false)); }
#define DPP_F(v, ctrl) dpp_f<(ctrl)>(v)
#define P_IDX(EV, T) do { const i32x4* _ip = (const i32x4*)(SELI + (size_t)((T) < tk0 + 127 ? (T) : tk0 + 127) * NPICK + 16 * g8); \
        _Pragma("unroll") for (int q = 0; q < 4; ++q) { const i32x4 _e = _ip[q]; EV[4 * q] = _e[0]; EV[4 * q + 1] = _e[1]; EV[4 * q + 2] = _e[2]; EV[4 * q + 3] = _e[3]; } } while (0)
#define P_GATHER8(BUF, EV, J0) do { _Pragma("unroll") for (int j = 0; j < 8; ++j) BUF[j] = *(const u32x4*)(slice + ((unsigned)EV[(J0) + j] * 128u + s8 * 16u)); } while (0)
#define PU_H(HA, HB, T) do { const u32x4* _hp = (const u32x4*)(H + (size_t)((T) < tk0 + 127 ? (T) : tk0 + 127) * DM + p * 128 + s8 * 16); HA = _hp[0]; HB = _hp[1]; } while (0)
#define PU_HF(HA, HB) do { hf[0] = (f32x2){bf_lo(HA.x), bf_hi(HA.x)}; hf[1] = (f32x2){bf_lo(HA.y), bf_hi(HA.y)}; hf[2] = (f32x2){bf_lo(HA.z), bf_hi(HA.z)}; hf[3] = (f32x2){bf_lo(HA.w), bf_hi(HA.w)}; \
        hf[4] = (f32x2){bf_lo(HB.x), bf_hi(HB.x)}; hf[5] = (f32x2){bf_lo(HB.y), bf_hi(HB.y)}; hf[6] = (f32x2){bf_lo(HB.z), bf_hi(HB.z)}; hf[7] = (f32x2){bf_lo(HB.w), bf_hi(HB.w)}; } while (0)
#define PU_COMP8(BUF, O) do { _Pragma("unroll") for (int j = 0; j < 8; ++j) { const u32x4 u = BUF[j]; \
            f32x2 a = __builtin_amdgcn_cvt_pk_f32_fp8(u.x, false) * hf[0]; a += __builtin_amdgcn_cvt_pk_f32_fp8(u.x, true) * hf[1]; \
            a += __builtin_amdgcn_cvt_pk_f32_fp8(u.y, false) * hf[2]; a += __builtin_amdgcn_cvt_pk_f32_fp8(u.y, true) * hf[3]; \
            a += __builtin_amdgcn_cvt_pk_f32_fp8(u.z, false) * hf[4]; a += __builtin_amdgcn_cvt_pk_f32_fp8(u.z, true) * hf[5]; \
            a += __builtin_amdgcn_cvt_pk_f32_fp8(u.w, false) * hf[6]; a += __builtin_amdgcn_cvt_pk_f32_fp8(u.w, true) * hf[7]; \
            float d = a.x + a.y; d += DPP_F(d, 0xB1); d += DPP_F(d, 0x4E); d += DPP_F(d, 0x141);     \
            O = (s8 == j) ? d : O; } } while (0)
__device__ __forceinline__ void peer_u_phase(const bf16_t* H, cbytes TUP, const int* SELI, float* PD, int vcu, int G, int wid, int lane) {
    const int g8 = lane >> 3, s8 = lane & 7;
    for (int pr = vcu; pr < 256; pr += G) {
        const int p = pr >> 5, r = pr & 31;
        cbytes slice = TUP + (size_t)p * NEXP * 128;
        const int tk0 = r * 1024 + wid * 128;
        int ev[16]; u32x4 bufA[8], bufB[8]; u32x4 hCa, hCb, hNa, hNb;
        P_IDX(ev, tk0); PU_H(hCa, hCb, tk0); P_GATHER8(bufA, ev, 0); P_GATHER8(bufB, ev, 8); P_IDX(ev, tk0 + 1); PU_H(hNa, hNb, tk0 + 1);
#pragma unroll 1
        for (int ti = 0; ti < 128; ++ti) {
            const int tk = tk0 + ti;
            f32x2 hf[8]; PU_HF(hCa, hCb); float o0 = 0.f, o1 = 0.f;
            PU_COMP8(bufA, o0); __builtin_amdgcn_sched_barrier(0);
            P_GATHER8(bufA, ev, 0); __builtin_amdgcn_sched_barrier(0);
            PU_COMP8(bufB, o1); __builtin_amdgcn_sched_barrier(0);
            P_GATHER8(bufB, ev, 8); hCa = hNa; hCb = hNb; P_IDX(ev, tk + 2); PU_H(hNa, hNb, tk + 2); __builtin_amdgcn_sched_barrier(0);
            float* pd = PD + ((size_t)p * MTOK + tk) * NPICK + 16 * g8 + s8; pd[0] = o0; pd[8] = o1;
        }
    }
}
#undef PU_H
#undef PU_HF
#undef PU_COMP8
__device__ __forceinline__ void peer_combine_phase(const float* PD, const float* SELW, const int* SELI, const float* SCU, const float* SCV, float* COEF, int vcu, int G, int tid) {
    constexpr int N4 = MTOK * NPICK / 4;
    for (int i = vcu * NTHREADS + tid; i < N4; i += G * NTHREADS) {
        f32x4 a = *((const f32x4*)PD + i);
#pragma unroll
        for (int p = 1; p < 8; ++p) a += *((const f32x4*)PD + (size_t)p * N4 + i);
        const f32x4 w = *((const f32x4*)SELW + i); const i32x4 e = *((const i32x4*)SELI + i);
        f32x4 o;
#pragma unroll
        for (int j = 0; j < 4; ++j) o[j] = w[j] * gelu_tanh(a[j] * SCU[e[j]]) * SCV[e[j]];
        *((f32x4*)COEF + i) = o; }
}
#define PV_COEF(CV, T) do { const f32x4* _cp = (const f32x4*)(COEF + (size_t)((T) < tk0 + 127 ? (T) : tk0 + 127) * NPICK + 16 * g8); \
        _Pragma("unroll") for (int q = 0; q < 4; ++q) { const f32x4 _c = _cp[q]; CV[4 * q] = _c[0]; CV[4 * q + 1] = _c[1]; CV[4 * q + 2] = _c[2]; CV[4 * q + 3] = _c[3]; } } while (0)
#define PV_X(XV, T) do { XV = *(const f32x2*)(x + (size_t)((T) < tk0 + 127 ? (T) : tk0 + 127) * DM + xcol); } while (0)
#define PV_COMP8(BUF, CV, J0) do { _Pragma("unroll") for (int j = 0; j < 8; ++j) { const u32x4 v = BUF[j]; const float c = CV[(J0) + j]; \
            acc[0] += c * __builtin_amdgcn_cvt_pk_f32_fp8(v.x, false); acc[1] += c * __builtin_amdgcn_cvt_pk_f32_fp8(v.x, true); \
            acc[2] += c * __builtin_amdgcn_cvt_pk_f32_fp8(v.y, false); acc[3] += c * __builtin_amdgcn_cvt_pk_f32_fp8(v.y, true); \
            acc[4] += c * __builtin_amdgcn_cvt_pk_f32_fp8(v.z, false); acc[5] += c * __builtin_amdgcn_cvt_pk_f32_fp8(v.z, true); \
            acc[6] += c * __builtin_amdgcn_cvt_pk_f32_fp8(v.w, false); acc[7] += c * __builtin_amdgcn_cvt_pk_f32_fp8(v.w, true); } } while (0)
#define PV_REDUCE_STORE(XV, T) do { \
        f32x2 k4[4]; _Pragma("unroll") for (int j = 0; j < 4; ++j) { f32x2 lo = acc[j], hi = acc[4 + j];          \
            lo.x += DPP_F(lo.x, 0x128); lo.y += DPP_F(lo.y, 0x128); hi.x += DPP_F(hi.x, 0x128); hi.y += DPP_F(hi.y, 0x128); k4[j] = b3 ? hi : lo; }     \
        f32x2 k2[2]; _Pragma("unroll") for (int j = 0; j < 2; ++j) { const f32x2 snd = b4 ? k4[j] : k4[2 + j]; k2[j] = b4 ? k4[2 + j] : k4[j]; \
            k2[j].x += __shfl_xor(snd.x, 16); k2[j].y += __shfl_xor(snd.y, 16); }                                 \
        const f32x2 snd = b5 ? k2[0] : k2[1]; f32x2 k1 = b5 ? k2[1] : k2[0]; \
        k1.x += __shfl_xor(snd.x, 32); k1.y += __shfl_xor(snd.y, 32);                                             \
        *(f32x2*)(x + (size_t)(T) * DM + xcol) = XV + gate * k1; } while (0)
__device__ __forceinline__ void peer_v_phase(cbytes TVP, const int* SELI, const float* COEF, float* x, const float* gacc, float gscale  , int vcu, int G, int wid, int lane) {
    const int g8 = lane >> 3, s8 = lane & 7;
    const bool b3 = (lane & 8) != 0, b4 = (lane & 16) != 0, b5 = (lane & 32) != 0;
    for (int pr = vcu; pr < 256; pr += G) {
        const int p = pr >> 5, r = pr & 31;
        cbytes slice = TVP + (size_t)p * NEXP * 128;
        const int tk0 = r * 1024 + wid * 128;
        const int xcol = p * 128 + s8 * 16 + 8 * (g8 & 1) + 4 * ((g8 >> 1) & 1) + 2 * (g8 >> 2);
        const f32x2 gate = *(const f32x2*)(gacc + (size_t)(tk0 >> 12) * 6 * DM + xcol) * gscale;
        int ev[16]; u32x4 bufA[8], bufB[8]; float cC[16], cN[16]; f32x2 xC, xN;
        P_IDX(ev, tk0); PV_COEF(cC, tk0); PV_X(xC, tk0); P_GATHER8(bufA, ev, 0); P_GATHER8(bufB, ev, 8); P_IDX(ev, tk0 + 1); PV_COEF(cN, tk0 + 1); PV_X(xN, tk0 + 1);
#pragma unroll 1
        for (int ti = 0; ti < 128; ++ti) {
            const int tk = tk0 + ti;
            f32x2 acc[8];
#pragma unroll
            for (int j = 0; j < 8; ++j) acc[j] = (f32x2){0.f, 0.f};
            PV_COMP8(bufA, cC, 0); __builtin_amdgcn_sched_barrier(0);
            P_GATHER8(bufA, ev, 0); __builtin_amdgcn_sched_barrier(0);
            PV_COMP8(bufB, cC, 8); __builtin_amdgcn_sched_barrier(0);
            P_GATHER8(bufB, ev, 8); P_IDX(ev, tk + 2); __builtin_amdgcn_sched_barrier(0);
            PV_REDUCE_STORE(xC, tk);
#pragma unroll
            for (int j = 0; j < 16; ++j) cC[j] = cN[j];
            xC = xN; PV_COEF(cN, tk + 2); PV_X(xN, tk + 2); __builtin_amdgcn_sched_barrier(0);
        }
    }
}
#undef PV_COEF
#undef PV_X
#undef PV_COMP8
#undef PV_REDUCE_STORE
#undef P_IDX
#undef P_GATHER8


constexpr size_t WS_BAR = 768 * 1024;
#define XB_TMO      128
#define XB_XCNT(j)  (256  + 64 * (j))
#define XB_XSUB(j)  (1280 + 64 * (j))
#define XB_XGEN(j)  (2304 + 64 * (j))
#define XB_TOP      3328
#define XB_TOPGEN   3392
#define XCD_BAR_WORDS 3456
#define XB_SPIN_CAP (1u << 22)
__device__ __forceinline__ unsigned xb_ld(unsigned* p)              { return __hip_atomic_load(p, __ATOMIC_RELAXED, __HIP_MEMORY_SCOPE_AGENT); }
__device__ __forceinline__ unsigned xb_add(unsigned* p, unsigned v) { return __hip_atomic_fetch_add(p, v, __ATOMIC_RELAXED, __HIP_MEMORY_SCOPE_AGENT); }
__device__ __forceinline__ unsigned xb_xcc_id() { return (unsigned)__builtin_amdgcn_s_getreg((3 << 11) | 20) & 0xFu; }
#define XB_SPIN(cond, bar) do { unsigned _sp = 0; while (cond) { __builtin_amdgcn_s_sleep(1); \
    if ((++_sp & 255u) == 0u) { if (xb_ld(&(bar)[XB_TMO])) break; if (_sp > XB_SPIN_CAP) { atomicAdd(&(bar)[XB_TMO], 1u); break; } } } } while (0)
struct XcdBarrier { unsigned* bar; unsigned x; volatile LAS unsigned* st; };
__device__ __forceinline__ void xcd_barrier_complete(unsigned* bar, unsigned x, unsigned& nloc, unsigned& nx) {
    const unsigned G = gridDim.x * gridDim.y * gridDim.z;
    unsigned sum, cnt, mine, sp = 0u;
    for (;;) {
        sum = 0u; cnt = 0u; mine = 0u;
#pragma unroll
        for (unsigned j = 0; j < 16; ++j) { const unsigned c = xb_ld(&bar[XB_XCNT(j)]); sum += c; cnt += (c > 0u) ? 1u : 0u; mine = (j == x) ? c : mine; }
        if (sum == G) break;
        __builtin_amdgcn_s_sleep(1);
        if ((++sp & 255u) == 0u) { if (xb_ld(&bar[XB_TMO])) break; if (sp > XB_SPIN_CAP) { atomicAdd(&bar[XB_TMO], 1u); break; } }
    }
    nloc = mine > 0u ? mine : 1u; nx = cnt > 0u ? cnt : 1u;
}
__device__ __forceinline__ void xcd_barrier(const XcdBarrier& b) {
    asm volatile("s_waitcnt vmcnt(0)" ::: "memory");
    __syncthreads();
    if (threadIdx.x == 0) {
        unsigned* bar = b.bar;
        __builtin_amdgcn_s_waitcnt(0);
        unsigned nloc = b.st[0], nx = b.st[1];
        if (nloc == 0u) { xcd_barrier_complete(bar, b.x, nloc, nx); b.st[0] = nloc; b.st[1] = nx; }
        const unsigned old = xb_add(&bar[XB_XSUB(b.x)], 1u);
        const unsigned gen = old / nloc;
        if (old + 1u == (gen + 1u) * nloc) {
            __builtin_amdgcn_fence(__ATOMIC_RELEASE, "agent");
            asm volatile("s_waitcnt vmcnt(0)" ::: "memory");
            const unsigned og = xb_add(&bar[XB_TOP], 1u);
            const unsigned tg = og / nx;
            if (og + 1u == (tg + 1u) * nx) xb_add(&bar[XB_TOPGEN], 1u);
            else XB_SPIN(xb_ld(&bar[XB_TOPGEN]) == tg, bar);
            __builtin_amdgcn_fence(__ATOMIC_ACQUIRE, "agent");
            xb_add(&bar[XB_XGEN(b.x)], 1u);
            asm volatile("s_waitcnt vmcnt(0)" ::: "memory");
        } else {
            XB_SPIN(xb_ld(&bar[XB_XGEN(b.x)]) == gen, bar);
            __builtin_amdgcn_fence(__ATOMIC_ACQUIRE, "agent");
            asm volatile("s_waitcnt vmcnt(0)" ::: "memory");
        }
    }
    __syncthreads();
}

constexpr int NPHASES = 45;
#ifndef PH_MASK
#define PH_MASK 0xFFFFFF
#endif
#ifndef DUP_MASK
#define DUP_MASK 0
#endif
__device__ __forceinline__ int opaque_s(int x) { asm volatile("" : "+s"(x)); return x; }
#define PHM(bit, call) do { if constexpr ((PH_MASK & (bit)) != 0) { if constexpr ((DUP_MASK & (bit)) != 0) { const int _nrep = opaque_s(2); for (int _rep = 0; _rep < _nrep; ++_rep) { call; __syncthreads(); } } else { call; } } } while (0)
__global__ void __launch_bounds__(NTHREADS, 2) trunk_fwd(Args A) {
    extern __shared__ __attribute__((aligned(16))) unsigned char lds_raw[];
    LAS unsigned char* lds = (LAS unsigned char*)lds_raw;
    const int tid0 = threadIdx.x, wid = __builtin_amdgcn_readfirstlane(tid0 >> 6);
    const int G = gridDim.x, bx = blockIdx.x, vcu = (G % 8 == 0) ? (bx % 8) * (G / 8) + bx / 8 : bx;
    const int gw = vcu * 8 + wid, NGW = G * 8;
    const int ph_lo = A.ph_lo, ph_hi = A.ph_hi;
#if MK_ONE_LAUNCH
    if (tid0 < 2) ((volatile LAS unsigned*)(lds + LDS_XB_OFF))[tid0] = 0u;
    if (bx == 0) { unsigned* b0 = (unsigned*)(A.ws + WS_BAR); for (int i = tid0; i < XCD_BAR_WORDS; i += NTHREADS) b0[i] = 0u; }
#endif

    for (int ph = ph_lo; ph < ph_hi; ++ph) {
        const int tid = opaque(tid0), lane = tid & 63;
        ArgP Ap = (ArgP)__builtin_amdgcn_kernarg_segment_ptr();
        asm volatile("" : "+s"(Ap));
        unsigned char* ws = Ap->ws;
        bf16_t* Hb = (bf16_t*)(ws + WS_H);
        unsigned char* mixb = ws + WS_MIX;
        const float* mod = (const float*)(ws + WS_MOD);
        float* xo = Ap->out;
        int layer, step;
        if (ph < 2) { layer = -1; step = ph; }
        else if (ph < 13) { layer = 0; step = ph - 2; }
        else if (ph < 23) { layer = 1; step = ph - 13; }
        else if (ph < 33) { layer = 2; step = ph - 23; }
        else if (ph < 44) { layer = 3; step = ph - 33; }
        else { layer = 4; step = 0; }
        const int kind = layer % 3, jl = layer / 3;
        const int nmix = (kind == 0) ? 5 : 4;
        const float* macc = mod + (size_t)(layer < 0 ? 0 : (layer > 3 ? 3 : layer)) * BATCH * 6 * DM;
        const float* mbias = Ap->in[I_ADA_B] + (size_t)(layer < 0 ? 0 : (layer > 3 ? 3 : layer)) * 6 * DM;
        const float* xin = (layer == 0) ? Ap->in[I_X] : xo;

        if (layer < 0) {
            if (step == 0) { PHM(1, prologue_phase(Ap, lds, vcu, G, tid, wid, lane)); }
            else { PHM(1, modreduce_phase(Ap, vcu, G, tid)); }
        } else if (layer > 3) {
            PHM(256, final_phase(xo, Ap->in[I_FINAL_G], gw, NGW, lane));
        } else if (step == 0) {
            PHM(2, norm_phase(xin, Ap->in[I_NORM_G] + (size_t)(layer * 2 + 0) * DM, macc, mbias, 0, DM, Hb, gw, NGW, lane));
        } else if (step < nmix) {
            pg8::StaticOrder S;
            if (kind == 0) {
                bf16_t* U = (bf16_t*)mixb; bf16_t* P = (bf16_t*)(mixb + 64 * MiB); bf16_t* Z = (bf16_t*)(mixb + 128 * MiB);
                if (step == 1) { pg8::Gemm g{Hb, (const bf16_t*)(ws + WS_POOL_WIN) + (size_t)jl * DM * DM, MTOK, DM, DM, DM, DM, 0}; S.init(MTOK, DM, G, bx);
                    pg8::EpiBf16<0> E{U, DM}; PHM(0x1000, pg8::gemm_phase(lds, g, S, E)); }
                else if (step == 2) { PHM(8, pool_elem_phase(U, P, vcu, G, tid)); }
                else if (step == 3) { pg8::Gemm g{P, (const bf16_t*)(ws + WS_POOL_WGRP) + (size_t)jl * 4 * 65536, MTOK, DM, 256, DM, 256, 256}; S.init(MTOK, DM, G, bx);
                    pg8::EpiPoolGrp E{Z, Ap->in[I_POOL_SCALE] + (size_t)jl * DM}; PHM(0x2000, pg8::gemm_phase(lds, g, S, E)); }
                else { pg8::Gemm g{Z, (const bf16_t*)(ws + WS_POOL_WOUT) + (size_t)jl * DM * DM, MTOK, DM, DM, DM, DM, 0}; S.init(MTOK, DM, G, bx);
                    pg8::EpiResid E{xin, xo, macc + 2 * DM, mbias + 2 * DM}; PHM(0x8000, pg8::gemm_phase(lds, g, S, E)); }
            } else if (kind == 1) {
                bf16_t* BG = (bf16_t*)mixb; bf16_t* Z = (bf16_t*)(mixb + 64 * MiB); bf16_t* AA = (bf16_t*)(mixb + 128 * MiB);
                if (step == 1) { pg8::Gemm g{Hb, (const bf16_t*)(ws + WS_CONV_WIN), MTOK, 3 * DM, DM, DM, DM, 0}; S.init(MTOK, 3 * DM, G, bx);
                    pg8::EpiConvIn E{BG, Z}; PHM(0x4000, pg8::gemm_phase(lds, g, S, E)); }
                else if (step == 2) { PHM(16, conv_elem_phase(BG, Z, Ap->in[I_CONV_W], AA, vcu, G, tid)); }
                else { pg8::Gemm g{AA, (const bf16_t*)(ws + WS_CONV_WOUT), MTOK, DM, DM, DM, DM, 0}; S.init(MTOK, DM, G, bx);
                    pg8::EpiResid E{xin, xo, macc + 2 * DM, mbias + 2 * DM}; PHM(0x8000, pg8::gemm_phase(lds, g, S, E)); }
            } else {
                bf16_t* UA = (bf16_t*)mixb; bf16_t* VT = (bf16_t*)(mixb + 192 * MiB);
                if (step == 1) {
                    { pg8::Gemm g{Hb, (const bf16_t*)(ws + WS_GMLP_WIN), MTOK, GH, DM, DM, DM, 0}; S.init(MTOK, GH, G, bx);
                      pg8::EpiBf16<1> E{UA, GH}; PHM(0x1000, pg8::gemm_phase(lds, g, S, E)); }
                    { pg8::Gemm g{Hb, (const bf16_t*)(ws + WS_GMLP_WIN) + (size_t)GH * DM, MTOK, GH, DM, DM, DM, 0}; S.init(MTOK, GH, G, bx);
                      pg8::EpiGmlpV E{VT}; PHM(0x10000, pg8::gemm_phase(lds, g, S, E)); }
                }
                else if (step == 2) { PHM(32, mix_phase(lds, UA, VT, Ap->in[I_GMLP_WS], Ap->in[I_GMLP_BS], Ap->in[I_GMLP_LNG], Ap->in[I_GMLP_LNB], vcu, G, tid, wid, lane)); }
                else { pg8::Gemm g{UA, (const bf16_t*)(ws + WS_GMLP_WOUT), MTOK, DM, GH, GH, GH, 0}; S.init(MTOK, DM, G, bx);
                    pg8::EpiResid E{xin, xo, macc + 2 * DM, mbias + 2 * DM}; PHM(0x8000, pg8::gemm_phase(lds, g, S, E)); }
            }
        } else {
            const int ps = step - nmix;
            bf16_t* Qb = (bf16_t*)mixb;
            if (ps == 0) { PHM(2, norm_phase(xo, Ap->in[I_NORM_G] + (size_t)(layer * 2 + 1) * DM, macc, mbias, 3 * DM, 4 * DM, Hb, gw, NGW, lane)); }
            else if (ps == 1) { pg8::StaticOrder S; pg8::Gemm g{Hb, (const bf16_t*)(ws + WS_PEER_WQ) + (size_t)layer * DM * 2048, MTOK, 2048, DM, DM, DM, 0}; S.init(MTOK, 2048, G, bx);
                pg8::EpiBf16<0> E{Qb, 2048}; PHM(0x1000, pg8::gemm_phase(lds, g, S, E)); }
            else if (ps == 2) PHM(64, topk_phase(lds, Qb, (const bf16_t*)(ws + WS_KEYS) + (size_t)layer * 16 * 128 * 128, (int*)(ws + WS_SELI), (float*)(ws + WS_SELW), vcu, G, tid, wid, lane));
            else if (ps == 3) { PHM(128, peer_u_phase(Hb, (cbytes)(ws + WS_TABU) + (size_t)layer * NEXP * DM, (const int*)(ws + WS_SELI), (float*)(mixb + 128 * MiB), vcu, G, wid, lane)); }
            else if (ps == 4) { PHM(0x400, peer_combine_phase((const float*)(mixb + 128 * MiB), (const float*)(ws + WS_SELW), (const int*)(ws + WS_SELI), (const float*)(ws + WS_SCU) + (size_t)layer * NEXP, (const float*)(ws + WS_SCV) + (size_t)layer * NEXP, (float*)(ws + WS_COEF), vcu, G, tid)); }
            else { if constexpr ((DUP_MASK & 0x200) != 0) { peer_v_phase((cbytes)(ws + WS_TABV) + (size_t)layer * NEXP * DM, (const int*)(ws + WS_SELI), (const float*)(ws + WS_COEF), xo, macc + 5 * DM, 0.f, vcu, G, wid, lane); }
                   peer_v_phase((cbytes)(ws + WS_TABV) + (size_t)layer * NEXP * DM, (const int*)(ws + WS_SELI), (const float*)(ws + WS_COEF), xo, macc + 5 * DM, 1.f, vcu, G, wid, lane); }
        }
#if MK_ONE_LAUNCH
        if (ph + 1 < ph_hi) {
            XcdBarrier xbar; xbar.bar = (unsigned*)(Ap->ws + WS_BAR); xbar.x = xb_xcc_id(); xbar.st = (volatile LAS unsigned*)(lds + LDS_XB_OFF);
            if (ph == ph_lo) { cg::this_grid().sync(); if (tid0 == 0) (void)xb_add(&xbar.bar[XB_XCNT(xbar.x)], 1u); }
            else { xcd_barrier(xbar); if constexpr ((DUP_MASK & 0x800) != 0) xcd_barrier(xbar); }
        }
#endif
    }
}

extern "C" void kernel_launch(void* const* d_in, const int* in_sizes, int n_in, void* d_out, int out_size, void* d_ws, size_t ws_size, hipStream_t stream) {
    static int grid = 0;
    if (grid == 0) {
        if (n_in != 23 || in_sizes[0] != MTOK * DM || out_size != MTOK * DM || ws_size < WS_END) {
            fprintf(stderr, "kernel_launch: unexpected shapes (n_in %d, in0 %d, out %d, ws %zu; need ws >= %zu); nothing launched\n", n_in, n_in > 0 ? in_sizes[0] : -1, out_size, ws_size, (size_t)WS_END); grid = -1; return; }
        int dev = 0, cus = 0, per_cu = 0;
        if (hipGetDevice(&dev) != hipSuccess || hipDeviceGetAttribute(&cus, hipDeviceAttributeMultiprocessorCount, dev) != hipSuccess) { grid = -1; return; }
        if (hipFuncSetAttribute((const void*)trunk_fwd, hipFuncAttributeMaxDynamicSharedMemorySize, LDS_BYTES) != hipSuccess) { fprintf(stderr, "kernel_launch: hipFuncSetAttribute failed\n"); grid = -1; return; }
        if (hipOccupancyMaxActiveBlocksPerMultiprocessor(&per_cu, (const void*)trunk_fwd, NTHREADS, LDS_BYTES) != hipSuccess || per_cu < 1) { fprintf(stderr, "kernel_launch: occupancy query says %d blocks per CU\n", per_cu); (void)hipGetLastError(); grid = -1; return; }
        grid = cus * (per_cu < 1 ? 1 : 1);
    }
    if (grid < 0) return;
    Args a{};
    for (int i = 0; i < 23; ++i) a.in[i] = (const float*)d_in[i];
    a.out = (float*)d_out; a.ws = (unsigned char*)d_ws;
#if MK_ONE_LAUNCH
    a.ph_lo = 0; a.ph_hi = NPHASES;
    void* args[] = {&a};
    hipError_t e = hipLaunchCooperativeKernel((const void*)trunk_fwd, dim3(grid), dim3(NTHREADS), args, LDS_BYTES, stream);
    if (e != hipSuccess) fprintf(stderr, "cooperative launch failed: %s (grid %d)\n", hipGetErrorString(e), grid);
#else
    for (int ph = 0; ph < NPHASES; ++ph) { a.ph_lo = ph; a.ph_hi = ph + 1; hipLaunchKernelGGL(trunk_fwd, dim3(grid), dim3(NTHREADS), LDS_BYTES, stream, a); }
#endif
}
```

```cpp
#include <hip/hip_runtime.h>
#include <hip/hip_cooperative_groups.h>
#include <cstdio>
#include <cstdint>
namespace cg = cooperative_groups;

#ifndef MK_ONE_LAUNCH
#define MK_ONE_LAUNCH 1
#endif

#define LAS __attribute__((address_space(3)))
typedef unsigned short bf16_t;
typedef short bf16x8 __attribute__((ext_vector_type(8)));
typedef float f32x2 __attribute__((ext_vector_type(2)));
typedef float f32x4 __attribute__((ext_vector_type(4)));
typedef float f32x16 __attribute__((ext_vector_type(16)));
typedef unsigned u32x2 __attribute__((ext_vector_type(2)));
typedef unsigned u32x4 __attribute__((ext_vector_type(4)));
typedef int i32x4 __attribute__((ext_vector_type(4)));
typedef __bf16 bf16x2 __attribute__((ext_vector_type(2)));

constexpr int DM = 1024, BATCH = 8, SEQ = 4096, MTOK = BATCH * SEQ, DEPTH = 4;
constexpr int GH = 3072;
constexpr int NEXP = 16384, NPICK = 128;
constexpr float EPS = 1e-6f;

constexpr size_t MiB = 1u << 20;
constexpr size_t WS_CTL = 0, WS_SCU = 0, WS_SCV = 512 * 1024, WS_MOD = 1 * MiB, ZERO_BYTES = 2 * MiB;
constexpr size_t WS_POOL_WIN = 2 * MiB, WS_POOL_WGRP = 6 * MiB, WS_POOL_WOUT = 7 * MiB;
constexpr size_t WS_CONV_WIN = 11 * MiB, WS_CONV_WOUT = 17 * MiB;
constexpr size_t WS_GMLP_WIN = 19 * MiB, WS_GMLP_WOUT = 31 * MiB;
constexpr size_t WS_PEER_WQ = 37 * MiB, WS_KEYS = 53 * MiB;
constexpr size_t WS_H = 56 * MiB;
constexpr size_t WS_SELI = 120 * MiB, WS_SELW = 136 * MiB;
constexpr size_t WS_TABU = 152 * MiB, WS_TABV = 280 * MiB;
constexpr size_t WS_MIX = 408 * MiB;
constexpr size_t WS_ADAP = 792 * MiB;
constexpr size_t WS_COEF = 804 * MiB;
constexpr size_t WS_END = 820 * MiB;

__device__ __forceinline__ unsigned cvt_pk_bf16(float lo, float hi) { unsigned r; asm volatile("v_cvt_pk_bf16_f32 %0, %1, %2" : "=v"(r) : "v"(lo), "v"(hi)); return r; }
__device__ __forceinline__ int opaque(int x) { asm volatile("" : "+v"(x)); return x; }
__device__ __forceinline__ float bf_lo(unsigned w) { return __uint_as_float(w << 16); }
__device__ __forceinline__ float bf_hi(unsigned w) { return __uint_as_float(w & 0xffff0000u); }
__device__ __forceinline__ float gelu_tanh(float x) {
    const float y = x * (1.0f + 0.044715f * x * x);
    const float e = __builtin_amdgcn_exp2f(-2.302208198f * y);
    return x * __builtin_amdgcn_rcpf(1.0f + e);
}
__device__ __forceinline__ float wave_sum_all(float v) {
#pragma unroll
    for (int o = 1; o < 64; o <<= 1) v += __shfl_xor(v, o);
    return v;
}
__device__ __forceinline__ float dot2_bf16(unsigned w, unsigned x, float acc) { return __builtin_amdgcn_fdot2_f32_bf16(__builtin_bit_cast(bf16x2, w), __builtin_bit_cast(bf16x2, x), acc, false); }


__device__ __forceinline__ float dpp_row_shr(float v, int n) {
    const int iv = __builtin_bit_cast(int, v); int r;
    switch (n) { case 1: r = __builtin_amdgcn_update_dpp(0, iv, 0x111, 0xf, 0xf, true); break; case 2: r = __builtin_amdgcn_update_dpp(0, iv, 0x112, 0xf, 0xf, true); break;
                 case 4: r = __builtin_amdgcn_update_dpp(0, iv, 0x114, 0xf, 0xf, true); break; default: r = __builtin_amdgcn_update_dpp(0, iv, 0x118, 0xf, 0xf, true); break; }
    return __builtin_bit_cast(float, r);
}
__device__ __forceinline__ float wave_sum_uniform(float v) {
    v += dpp_row_shr(v, 1); v += dpp_row_shr(v, 2); v += dpp_row_shr(v, 4); v += dpp_row_shr(v, 8);
    v += __builtin_bit_cast(float, __builtin_amdgcn_update_dpp(0, __builtin_bit_cast(int, v), 0x142, 0xa, 0xf, false));
    v += __builtin_bit_cast(float, __builtin_amdgcn_update_dpp(0, __builtin_bit_cast(int, v), 0x143, 0xc, 0xf, false));
    return __uint_as_float(__builtin_amdgcn_readlane(__float_as_uint(v), 63));
}

namespace pg8 {
constexpr int BM = 256, BK = 64, HALF = 128, HTB = HALF * BK * 2, STAGE_BYTES = 8 * HTB, NXCD = 8, WGM = 8;
__device__ __forceinline__ int lds_byte(int r, int c) { const int st = (r >> 4) * 2 + (c >> 5), rr = r & 15, cc = c & 31, ob = rr * 64 + cc * 2; return st * 1024 + (ob ^ (((ob >> 9) & 1) << 5)); }
__device__ __forceinline__ void stage_rc(int b, int& R, int& C) { const int st = b / 1024, sb = b % 1024, swz = sb ^ (((sb >> 9) & 1) << 5); R = (st >> 1) * 16 + swz / 64; C = (st & 1) * 32 + (swz % 64) / 2; }
__device__ __forceinline__ int perm32(int rho) { const int n = rho >> 4, i = rho & 15; return 8 * (i >> 2) + 4 * n + (i & 3); }

struct Unit { int pm, pn; };
struct Gemm { const bf16_t* A; const bf16_t* Bt; int M, N, K, lda, ldb, a_pn_off; };

struct StaticOrder {
    int nM, nN, nwg, G, c;
    __device__ __forceinline__ void init(int M, int N, int G_, int c_) { nM = M / BM; nN = N / BM; nwg = nM * nN; G = G_; c = c_; }
    __device__ __forceinline__ bool next(int i, Unit& u) const {
        const int L = i * G + c; if (L >= nwg) return false;
        int wgid = L; { const int q = nwg / NXCD, r = nwg % NXCD, xcd = wgid % NXCD, off = wgid / NXCD; wgid = (xcd < r ? xcd * (q + 1) : r * (q + 1) + (xcd - r) * q) + off; }
        const int nig = WGM * nN, gid = wgid / nig, fm = gid * WGM, gsz = (nM - fm) < WGM ? (nM - fm) : WGM;
        u.pm = fm + ((wgid % nig) % gsz); u.pn = (wgid % nig) / gsz; return true;
    }
};

template <class Epi>
__device__ __forceinline__ void gemm_phase(LAS unsigned char* lds, const Gemm g, const StaticOrder& S, const Epi& E) {
    const int tid = opaque((int)threadIdx.x), wid = __builtin_amdgcn_readfirstlane(tid >> 6), lane = tid & 63, wr = wid >> 2, wc = wid & 3, fr = lane & 15, fq = lane >> 4;
    int nt = g.K / BK; asm volatile("" : "+s"(nt));
    unsigned voffA[2], voffB[2];
#pragma unroll
    for (int i = 0; i < 2; ++i) { int R, C; stage_rc(tid * 16 + i * 8192, R, C); const int Rb = Epi::PERM ? ((R & ~31) + perm32(R & 31)) : R;
        voffA[i] = (unsigned)(R * g.lda + C) * 2u; voffB[i] = (unsigned)(Rb * g.ldb + C) * 2u; }
    const size_t kstep = (size_t)(BK * 2);
    const size_t hstepA = (size_t)HALF * g.lda * 2, hstepB = (size_t)HALF * g.ldb * 2;
    const size_t tstepA = 2 * hstepA, tstepB = 2 * hstepB;
    const unsigned ldsw = (unsigned)wid * 1024u;
    const int aoff = lds_byte(wr * 64 + fr, fq * 8), boff = lds_byte(wc * 32 + fr, fq * 8);
#define PG8_SA(b, h) (((b) * 2 + (h)) * HTB)
#define PG8_SB(b, h) ((4 + (b) * 2 + (h)) * HTB)
#define PG8_STAGE(bufoff, gbase, voff) do { _Pragma("unroll") for (int _i = 0; _i < 2; ++_i) \
        __builtin_amdgcn_global_load_lds((const unsigned*)((const char*)(gbase) + (voff)[_i]), (LAS unsigned*)(lds + (bufoff) + ldsw + _i * 8192), 16, 0, 0); } while (0)
#define PG8_LDA(dst, b, h) do { _Pragma("unroll") for (int m = 0; m < 4; ++m) _Pragma("unroll") for (int k = 0; k < 2; ++k) dst[m][k] = *(const LAS bf16x8*)(lds + PG8_SA(b, h) + aoff + m * 2048 + k * 1024); } while (0)
#define PG8_LDB(dst, b, h) do { _Pragma("unroll") for (int n = 0; n < 2; ++n) _Pragma("unroll") for (int k = 0; k < 2; ++k) dst[n][k] = *(const LAS bf16x8*)(lds + PG8_SB(b, h) + boff + n * 2048 + k * 1024); } while (0)
#define PG8_MMA(ai, bj, At, Bt) do { __builtin_amdgcn_s_setprio(1); _Pragma("unroll") for (int m = 0; m < 4; ++m) _Pragma("unroll") for (int n = 0; n < 2; ++n) _Pragma("unroll") for (int k = 0; k < 2; ++k) \
        acc[ai][bj][m][n] = Epi::SWAP ? __builtin_amdgcn_mfma_f32_16x16x32_bf16(At[m][k], Bt[n][k], acc[ai][bj][m][n], 0, 0, 0) \
                                      : __builtin_amdgcn_mfma_f32_16x16x32_bf16(Bt[n][k], At[m][k], acc[ai][bj][m][n], 0, 0, 0); __builtin_amdgcn_s_setprio(0); } while (0)
#define PG8_WAIT_V(n) asm volatile("s_waitcnt vmcnt(" #n ")" ::: "memory")
#define PG8_WAIT_L(n) asm volatile("s_waitcnt lgkmcnt(" #n ")" ::: "memory")
#define PG8_BAR __builtin_amdgcn_s_barrier()
#define PG8_SCHED __builtin_amdgcn_sched_barrier(0)
    Unit cur, nxt; int ui = 0;
    if (!S.next(0, cur)) return;
    f32x4 acc[2][2][4][2];
#pragma unroll
    for (int a = 0; a < 2; ++a)
#pragma unroll
        for (int b = 0; b < 2; ++b)
#pragma unroll
            for (int m = 0; m < 4; ++m)
#pragma unroll
                for (int n = 0; n < 2; ++n) acc[a][b][m][n] = (f32x4){0.f, 0.f, 0.f, 0.f};
    bf16x8 At[4][2], B0[2][2], B1[2][2];
    const char* cA = (const char*)g.A + (size_t)cur.pm * tstepA + (size_t)cur.pn * g.a_pn_off * 2; const char* cB = (const char*)g.Bt + (size_t)cur.pn * tstepB;
    PG8_STAGE(PG8_SB(0, 0), cB, voffB); PG8_STAGE(PG8_SB(0, 1), cB + hstepB, voffB); PG8_STAGE(PG8_SA(0, 0), cA, voffA); PG8_STAGE(PG8_SA(0, 1), cA + hstepA, voffA);
    if (wr == 1) PG8_BAR;
    PG8_WAIT_V(2); PG8_BAR;
    PG8_STAGE(PG8_SB(1, 0), cB + kstep, voffB); PG8_STAGE(PG8_SA(1, 0), cA + kstep, voffA); PG8_STAGE(PG8_SB(1, 1), cB + hstepB + kstep, voffB);
    PG8_WAIT_V(6); PG8_BAR;
    for (;;) {
        const bool has_next = S.next(ui + 1, nxt);
        const char* nA = has_next ? (const char*)g.A + (size_t)nxt.pm * tstepA + (size_t)nxt.pn * g.a_pn_off * 2 : cA; const char* nB = has_next ? (const char*)g.Bt + (size_t)nxt.pn * tstepB : cB;
        for (int t = 0; t < nt; t += 2) {
            const bool last = (t == nt - 2);
            const char* a1 = cA + (size_t)(t + 1) * kstep;
            const char* a2 = last ? nA : cA + (size_t)(t + 2) * kstep; const char* b2 = last ? nB : cB + (size_t)(t + 2) * kstep;
            const char* a3 = a2 + kstep; const char* b3 = b2 + kstep;
            PG8_LDB(B0, 0, 0); PG8_LDB(B1, 0, 1); PG8_SCHED; PG8_LDA(At, 0, 0); PG8_STAGE(PG8_SA(1, 1), a1 + hstepA, voffA);
            PG8_WAIT_V(8); PG8_WAIT_L(0); PG8_BAR; PG8_MMA(0, 0, At, B0); PG8_MMA(0, 1, At, B1); PG8_BAR; PG8_SCHED;
            PG8_LDA(At, 0, 1); PG8_STAGE(PG8_SB(0, 0), b2, voffB); PG8_STAGE(PG8_SB(0, 1), b2 + hstepB, voffB); PG8_STAGE(PG8_SA(0, 0), a2, voffA);
            PG8_WAIT_V(8); PG8_WAIT_L(0); PG8_BAR; PG8_MMA(1, 0, At, B0); PG8_MMA(1, 1, At, B1); PG8_BAR; PG8_SCHED;
            PG8_LDB(B0, 1, 0); PG8_LDB(B1, 1, 1); PG8_SCHED; PG8_LDA(At, 1, 0); PG8_STAGE(PG8_SA(0, 1), a2 + hstepA, voffA);
            PG8_WAIT_V(8); PG8_WAIT_L(0); PG8_BAR; PG8_MMA(0, 0, At, B0); PG8_MMA(0, 1, At, B1); PG8_BAR; PG8_SCHED;
            PG8_LDA(At, 1, 1); PG8_STAGE(PG8_SB(1, 0), b3, voffB); PG8_STAGE(PG8_SB(1, 1), b3 + hstepB, voffB); PG8_STAGE(PG8_SA(1, 0), a3, voffA);
            PG8_WAIT_V(8); PG8_WAIT_L(0); PG8_BAR; PG8_MMA(1, 0, At, B0); PG8_MMA(1, 1, At, B1); PG8_BAR; PG8_SCHED;
        }
        { const int l2 = opaque((int)threadIdx.x) & 63; E(acc, cur, wr, wc, l2 & 15, l2 >> 4); }
        if (!has_next) break;
#pragma unroll
        for (int a = 0; a < 2; ++a)
#pragma unroll
            for (int b = 0; b < 2; ++b)
#pragma unroll
                for (int m = 0; m < 4; ++m)
#pragma unroll
                    for (int n = 0; n < 2; ++n) acc[a][b][m][n] = (f32x4){0.f, 0.f, 0.f, 0.f};
        cur = nxt; cA = nA; cB = nB; ++ui;
    }
    PG8_WAIT_V(0);
    if (wr == 0) PG8_BAR;
    PG8_BAR;
#undef PG8_SA
#undef PG8_SB
#undef PG8_STAGE
#undef PG8_LDA
#undef PG8_LDB
#undef PG8_MMA
#undef PG8_WAIT_V
#undef PG8_WAIT_L
#undef PG8_BAR
#undef PG8_SCHED
}

template <int ACT> struct EpiBf16 {
    static constexpr bool PERM = true, SWAP = false;
    bf16_t* O; int ldc;
    __device__ __forceinline__ void operator()(const f32x4 (&acc)[2][2][4][2], const Unit& u, int wr, int wc, int fr, int fq) const {
        const int row0 = u.pm * BM + wr * 64 + fr, col0 = u.pn * BM + wc * 32 + 8 * fq;
#pragma unroll
        for (int ai = 0; ai < 2; ++ai)
#pragma unroll
            for (int m = 0; m < 4; ++m) { bf16_t* rowp = O + (size_t)(row0 + ai * HALF + m * 16) * ldc + col0;
#pragma unroll
                for (int bj = 0; bj < 2; ++bj) { f32x4 v0 = acc[ai][bj][m][0], v1 = acc[ai][bj][m][1];
                    if (ACT == 1) {
#pragma unroll
                        for (int j = 0; j < 4; ++j) { v0[j] = gelu_tanh(v0[j]); v1[j] = gelu_tanh(v1[j]); } }
                    u32x4 w; w.x = cvt_pk_bf16(v0[0], v0[1]); w.y = cvt_pk_bf16(v0[2], v0[3]); w.z = cvt_pk_bf16(v1[0], v1[1]); w.w = cvt_pk_bf16(v1[2], v1[3]);
                    *(u32x4*)(rowp + bj * HALF) = w; } }
    }
};
struct EpiQT {
    static constexpr bool PERM = true, SWAP = false;
    bf16_t* O;
    __device__ __forceinline__ void operator()(const f32x4 (&acc)[2][2][4][2], const Unit& u, int wr, int wc, int fr, int fq) const {
        const int row0 = u.pm * BM + wr * 64 + fr;
#pragma unroll
        for (int ai = 0; ai < 2; ++ai)
#pragma unroll
            for (int m = 0; m < 4; ++m) { const int row = row0 + ai * HALF + m * 16;
                bf16_t* base = O + ((size_t)((row >> 7) * 8 + u.pn) * 32 * 128 + (row & 127)) * 8;
#pragma unroll
                for (int bj = 0; bj < 2; ++bj) { const f32x4 v0 = acc[ai][bj][m][0], v1 = acc[ai][bj][m][1];
                    u32x4 w; w.x = cvt_pk_bf16(v0[0], v0[1]); w.y = cvt_pk_bf16(v0[2], v0[3]); w.z = cvt_pk_bf16(v1[0], v1[1]); w.w = cvt_pk_bf16(v1[2], v1[3]);
                    *(u32x4*)(base + (size_t)(16 * bj + 4 * wc + fq) * 128 * 8) = w; } }
    }
};
struct EpiPoolGrp {
    static constexpr bool PERM = true, SWAP = false;
    bf16_t* O; const float* scale;
    __device__ __forceinline__ void operator()(const f32x4 (&acc)[2][2][4][2], const Unit& u, int wr, int wc, int fr, int fq) const {
        const int row0 = u.pm * BM + wr * 64 + fr, col0 = u.pn * BM + wc * 32 + 8 * fq;
#pragma unroll
        for (int bj = 0; bj < 2; ++bj) {
            const f32x4 s0 = *(const f32x4*)(scale + col0 + bj * HALF), s1 = *(const f32x4*)(scale + col0 + bj * HALF + 4);
#pragma unroll
            for (int ai = 0; ai < 2; ++ai)
#pragma unroll
                for (int m = 0; m < 4; ++m) { bf16_t* rowp = O + (size_t)(row0 + ai * HALF + m * 16) * DM + col0 + bj * HALF;
                    const f32x4 v0 = acc[ai][bj][m][0] * s0, v1 = acc[ai][bj][m][1] * s1;
                    u32x4 w; w.x = cvt_pk_bf16(v0[0], v0[1]); w.y = cvt_pk_bf16(v0[2], v0[3]); w.z = cvt_pk_bf16(v1[0], v1[1]); w.w = cvt_pk_bf16(v1[2], v1[3]);
                    *(u32x4*)rowp = w; }
            asm volatile("" ::: "memory");
        }
    }
};
struct EpiConvIn {
    static constexpr bool PERM = true, SWAP = false;
    bf16_t* BG; bf16_t* Z;
    __device__ __forceinline__ void operator()(const f32x4 (&acc)[2][2][4][2], const Unit& u, int wr, int wc, int fr, int fq) const {
        const int row0 = u.pm * BM + wr * 64 + fr;
        if (u.pn < 4) {
            const int col0 = u.pn * BM + wc * 32 + 8 * fq;
#pragma unroll
            for (int ai = 0; ai < 2; ++ai)
#pragma unroll
                for (int m = 0; m < 4; ++m) { bf16_t* rowp = BG + (size_t)(row0 + ai * HALF + m * 16) * DM + col0;
#pragma unroll
                    for (int bj = 0; bj < 2; ++bj) { const f32x4 v0 = acc[ai][bj][m][0], v1 = acc[ai][bj][m][1];
                        u32x4 w; w.x = cvt_pk_bf16(v0[0], v0[1]); w.y = cvt_pk_bf16(v0[2], v0[3]); w.z = cvt_pk_bf16(v1[0], v1[1]); w.w = cvt_pk_bf16(v1[2], v1[3]);
                        *(u32x4*)(rowp + bj * HALF) = w; } }
        } else {
            const int col0 = (u.pn - 4) * HALF + wc * 32 + 8 * fq;
#pragma unroll
            for (int ai = 0; ai < 2; ++ai)
#pragma unroll
                for (int m = 0; m < 4; ++m) { bf16_t* rowp = Z + (size_t)(row0 + ai * HALF + m * 16) * DM + col0;
                    const f32x4 v0 = acc[ai][0][m][0] * acc[ai][1][m][0], v1 = acc[ai][0][m][1] * acc[ai][1][m][1];
                    u32x4 w; w.x = cvt_pk_bf16(v0[0], v0[1]); w.y = cvt_pk_bf16(v0[2], v0[3]); w.z = cvt_pk_bf16(v1[0], v1[1]); w.w = cvt_pk_bf16(v1[2], v1[3]);
                    *(u32x4*)rowp = w; }
        }
    }
};
struct EpiResid {
    static constexpr bool PERM = false, SWAP = false;
    const float* base; float* out; const float* gacc; const float* gbias;
    __device__ __forceinline__ void operator()(const f32x4 (&acc)[2][2][4][2], const Unit& u, int wr, int wc, int fr, int fq) const {
        const int row0 = u.pm * BM + wr * 64 + fr, col0 = u.pn * BM + wc * 32 + 4 * fq;
        const float* gp = gacc + (size_t)(u.pm >> 4) * (6 * DM);
#pragma unroll
        for (int bj = 0; bj < 2; ++bj)
#pragma unroll
            for (int n = 0; n < 2; ++n) { const int cc = col0 + bj * HALF + n * 16;
                const f32x4 gv = *(const f32x4*)(gp + cc);
#pragma unroll
                for (int ai = 0; ai < 2; ++ai) {
#pragma unroll
                    for (int m = 0; m < 4; ++m) { const size_t off = (size_t)(row0 + ai * HALF + m * 16) * DM + cc;
                        const f32x4 bs = *(const f32x4*)(base + off);
                        *(f32x4*)(out + off) = bs + gv * acc[ai][bj][m][n]; }
                    asm volatile("" ::: "memory"); } }
    }
};
struct EpiGmlpV {
    static constexpr bool PERM = false, SWAP = true;
    bf16_t* VT;
    __device__ __forceinline__ void operator()(const f32x4 (&acc)[2][2][4][2], const Unit& u, int wr, int wc, int fr, int fq) const {
        const int row0 = u.pm * BM + wr * 64 + 4 * fq, col0 = u.pn * BM + wc * 32 + fr;
#pragma unroll
        for (int bj = 0; bj < 2; ++bj)
#pragma unroll
            for (int n = 0; n < 2; ++n) { const int c = col0 + bj * HALF + n * 16;
#pragma unroll
                for (int ai = 0; ai < 2; ++ai)
#pragma unroll
                    for (int m = 0; m < 4; ++m) { const f32x4 v = acc[ai][bj][m][n]; const int r = row0 + ai * HALF + m * 16;
                        u32x2 w; w.x = cvt_pk_bf16(gelu_tanh(v[0]), gelu_tanh(v[1])); w.y = cvt_pk_bf16(gelu_tanh(v[2]), gelu_tanh(v[3]));
                        *(u32x2*)(VT + ((size_t)(r >> 7) * GH + c) * 128 + (r & 127)) = w; } }
    }
};
}

constexpr int RING_BYTES = 131072;
constexpr int LDS_BYTES = 147456;
constexpr int LDS_XB_OFF = LDS_BYTES - 64;
constexpr int NTHREADS = 512;

#define CE_DESC(a, b) do { const float _x = fmaxf(a, b), _y = fminf(a, b); a = _x; b = _y; } while (0)
#define CE_ASC(a, b)  do { const float _x = fminf(a, b), _y = fmaxf(a, b); a = _x; b = _y; } while (0)
template <int OFF, int N>
__device__ __forceinline__ void sort16_desc(float (&v)[N]) {
#pragma unroll
    for (int k = 2; k <= 16; k <<= 1)
#pragma unroll
        for (int j = k >> 1; j > 0; j >>= 1)
#pragma unroll
            for (int i = 0; i < 16; ++i) { const int l = i ^ j; if (l > i) { if ((i & k) == 0) CE_DESC(v[OFF + i], v[OFF + l]); else CE_ASC(v[OFF + i], v[OFF + l]); } }
}
template <int OFF, int N>
__device__ __forceinline__ void bmerge16_desc(float (&v)[N]) {
#pragma unroll
    for (int j = 8; j > 0; j >>= 1)
#pragma unroll
        for (int i = 0; i < 16; ++i) { const int l = i ^ j; if (l > i) CE_DESC(v[OFF + i], v[OFF + l]); }
}
template <int A, int B, int N>
__device__ __forceinline__ void merge_top16(float (&v)[N]) {
#pragma unroll
    for (int i = 0; i < 16; ++i) v[A + i] = fmaxf(v[A + i], v[B + 15 - i]);
    bmerge16_desc<A, N>(v);
}
__device__ __forceinline__ void top16_of_64(float (&v)[64]) {
    sort16_desc<0, 64>(v); sort16_desc<16, 64>(v); sort16_desc<32, 64>(v); sort16_desc<48, 64>(v);
    merge_top16<0, 16, 64>(v); merge_top16<32, 48, 64>(v); merge_top16<0, 32, 64>(v);
}

struct Args { const float* in[23]; float* out; unsigned char* ws; int ph_lo, ph_hi; };
typedef const __attribute__((address_space(4))) Args* ArgP;
enum { I_X = 0, I_C, I_ADA_W, I_ADA_B, I_NORM_G, I_POOL_WIN, I_POOL_WGRP, I_POOL_SCALE, I_POOL_WOUT, I_CONV_WIN, I_CONV_W, I_CONV_WOUT,
       I_GMLP_WIN, I_GMLP_LNG, I_GMLP_LNB, I_GMLP_WS, I_GMLP_BS, I_GMLP_WOUT, I_PEER_WQ, I_PEER_KEYS, I_PEER_U, I_PEER_V, I_FINAL_G };

__device__ __forceinline__ void transpose_item(const float* W, int K, int N, bf16_t* WT, int dst_row0, LAS float* scr, int k0, int n0, int lane) {
    float wv[32];
#pragma unroll
    for (int i = 0; i < 32; ++i) wv[i] = W[(size_t)(k0 + 2 * i + (lane >> 5)) * N + n0 + (lane & 31)];
#pragma unroll
    for (int i = 0; i < 32; ++i) scr[(2 * i + (lane >> 5)) * 33 + (lane & 31)] = wv[i];
    asm volatile("s_waitcnt lgkmcnt(0)" ::: "memory");
    const int c = lane & 7;
#pragma unroll
    for (int j = 0; j < 4; ++j) { const int n = (lane >> 3) + 8 * j; const LAS float* s = scr + (8 * c) * 33 + n;
        u32x4 o; o.x = cvt_pk_bf16(s[0 * 33], s[1 * 33]); o.y = cvt_pk_bf16(s[2 * 33], s[3 * 33]); o.z = cvt_pk_bf16(s[4 * 33], s[5 * 33]); o.w = cvt_pk_bf16(s[6 * 33], s[7 * 33]);
        *(u32x4*)(WT + (size_t)(dst_row0 + n) * K + k0 + 8 * c) = o; }
    asm volatile("s_waitcnt lgkmcnt(0)" ::: "memory");
}
__device__ __forceinline__ void convert_stream(const float* src, bf16_t* dst, size_t n8, size_t gt, size_t stride) {
    for (size_t i = gt; i < n8; i += stride) {
        const f32x4 a = __builtin_nontemporal_load((const f32x4*)src + 2 * i), b = __builtin_nontemporal_load((const f32x4*)src + 2 * i + 1);
        u32x4 o; o.x = cvt_pk_bf16(a[0], a[1]); o.y = cvt_pk_bf16(a[2], a[3]); o.z = cvt_pk_bf16(b[0], b[1]); o.w = cvt_pk_bf16(b[2], b[3]);
        *((u32x4*)dst + i) = o; }
}
__device__ __forceinline__ void prologue_phase(ArgP Ap, LAS unsigned char* lds, int vcu, int G, int tid, int wid, int lane) {
    unsigned char* ws = Ap->ws;
    const int gw = vcu * 8 + wid, NGW = G * 8;
    LAS float* scr = (LAS float*)(lds + wid * 16384);
    constexpr int NT_ITEMS = 1024 + 256 + 1024 + 1536 + 512 + 3072 + 1536 + 4096;
    for (int it = gw; it < NT_ITEMS; it += NGW) {
        int r = it; const float* src; bf16_t* dst; int K, N, kind = 0;
        if (r < 1024) { const int m = r >> 9; r &= 511; src = Ap->in[I_POOL_WIN] + (size_t)m * DM * DM; dst = (bf16_t*)(ws + WS_POOL_WIN) + (size_t)m * DM * DM; K = DM; N = DM; }
        else if ((r -= 1024) < 256) { const int m = r >> 5; r &= 31; src = Ap->in[I_POOL_WGRP] + (size_t)m * 65536; dst = (bf16_t*)(ws + WS_POOL_WGRP) + (size_t)m * 65536; K = 256; N = 256; }
        else if ((r -= 256) < 1024) { const int m = r >> 9; r &= 511; src = Ap->in[I_POOL_WOUT] + (size_t)m * DM * DM; dst = (bf16_t*)(ws + WS_POOL_WOUT) + (size_t)m * DM * DM; K = DM; N = DM; }
        else if ((r -= 1024) < 1536) { src = Ap->in[I_CONV_WIN]; dst = (bf16_t*)(ws + WS_CONV_WIN); K = DM; N = 3 * DM; kind = 1; }
        else if ((r -= 1536) < 512) { src = Ap->in[I_CONV_WOUT]; dst = (bf16_t*)(ws + WS_CONV_WOUT); K = DM; N = DM; }
        else if ((r -= 512) < 3072) { src = Ap->in[I_GMLP_WIN]; dst = (bf16_t*)(ws + WS_GMLP_WIN); K = DM; N = 2 * GH; }
        else if ((r -= 3072) < 1536) { src = Ap->in[I_GMLP_WOUT]; dst = (bf16_t*)(ws + WS_GMLP_WOUT); K = GH; N = DM; }
        else { r -= 1536; const int m = r >> 10; r &= 1023; src = Ap->in[I_PEER_WQ] + (size_t)m * DM * 2048; dst = (bf16_t*)(ws + WS_PEER_WQ) + (size_t)m * DM * 2048; K = DM; N = 2048; }
        const int nblk = N / 32, kb = r / nblk, nb = r % nblk, n0 = 32 * nb;
        int drow = n0;
        if (kind == 1 && n0 >= DM) { const int xt = n0 >= 2 * DM, ch = n0 - (xt ? 2 * DM : DM); drow = DM + 256 * (ch >> 7) + 128 * xt + (ch & 127); }
        transpose_item(src, K, N, dst, drow, scr, 64 * kb, n0, lane);
    }
    const size_t gt = (size_t)vcu * NTHREADS + tid, stride = (size_t)G * NTHREADS;
    convert_stream(Ap->in[I_PEER_KEYS], (bf16_t*)(ws + WS_KEYS), (size_t)DEPTH * 16 * 128 * 128 / 8, gt, stride);
    for (int row0 = gw * 8; row0 < 2 * DEPTH * NEXP; row0 += NGW * 8) {
        f32x4 v[8][4]; float m[8];
#pragma unroll
        for (int rr = 0; rr < 8; ++rr) { const int row = row0 + rr, tab = row >> 16, lrow = row & 65535;
            const f32x4* src = (const f32x4*)((tab ? Ap->in[I_PEER_V] : Ap->in[I_PEER_U]) + (size_t)lrow * DM) + lane;
#pragma unroll
            for (int j = 0; j < 4; ++j) v[rr][j] = __builtin_nontemporal_load(src + 64 * j); }
#pragma unroll
        for (int rr = 0; rr < 8; ++rr) { float mm = 0.f;
#pragma unroll
            for (int j = 0; j < 4; ++j) mm = fmaxf(fmaxf(mm, fmaxf(fabsf(v[rr][j][0]), fabsf(v[rr][j][1]))), fmaxf(fabsf(v[rr][j][2]), fabsf(v[rr][j][3])));
#pragma unroll
            for (int o = 1; o < 64; o <<= 1) mm = fmaxf(mm, __shfl_xor(mm, o));
            m[rr] = mm; }
#pragma unroll
        for (int rr = 0; rr < 8; ++rr) { const int row = row0 + rr, tab = row >> 16, lrow = row & 65535, l = lrow >> 14, e = lrow & (NEXP - 1);
            const float S = m[rr] > 0.f ? 256.0f / m[rr] : 1.0f;
            unsigned char* dst = ws + (tab ? WS_TABV : WS_TABU);
#pragma unroll
            for (int j = 0; j < 4; ++j) { int pk = __builtin_amdgcn_cvt_pk_fp8_f32(v[rr][j][0] * S, v[rr][j][1] * S, 0, false); pk = __builtin_amdgcn_cvt_pk_fp8_f32(v[rr][j][2] * S, v[rr][j][3] * S, pk, true);
                const int d0 = 256 * j + 4 * lane;
                *(int*)(dst + (((size_t)l * 8 + (d0 >> 7)) * NEXP + e) * 128 + (d0 & 127)) = pk; }
            if (lane == 0) ((unsigned short*)(ws + WS_SCU))[2 * lrow + tab] = (unsigned short)(cvt_pk_bf16(m[rr] > 0.f ? m[rr] * (1.0f / 256.0f) : 1.0f, 0.f) & 0xffffu); }
    }
    __syncthreads();
    LAS float* cond = (LAS float*)lds;
    for (int i = tid; i < BATCH * DM; i += NTHREADS) { const int b = i >> 10, k = i & 1023; const float c = Ap->in[I_C][i]; cond[k * 8 + b] = c * __builtin_amdgcn_rcpf(1.0f + __expf(-c)); }
    __syncthreads();
    float* modp = (float*)(ws + WS_ADAP);
    for (int it = gw; it < DEPTH * 24 * 16; it += NGW) {
        const int l = it / 384, r = it % 384, cgp = r >> 4, kc = r & 15;
        const float* wp = Ap->in[I_ADA_W] + ((size_t)l * DM + kc * 64) * (6 * DM) + cgp * 256 + 4 * lane;
        f32x4 acc[8];
#pragma unroll
        for (int b = 0; b < 8; ++b) acc[b] = (f32x4){0.f, 0.f, 0.f, 0.f};
#pragma unroll 16
        for (int k = 0; k < 64; ++k) { const f32x4 w = __builtin_nontemporal_load((const f32x4*)(wp + (size_t)k * (6 * DM)));
            const f32x4 c0 = *(const LAS f32x4*)(cond + (kc * 64 + k) * 8), c1 = *(const LAS f32x4*)(cond + (kc * 64 + k) * 8 + 4);
            acc[0] += c0[0] * w; acc[1] += c0[1] * w; acc[2] += c0[2] * w; acc[3] += c0[3] * w; acc[4] += c1[0] * w; acc[5] += c1[1] * w; acc[6] += c1[2] * w; acc[7] += c1[3] * w; }
#pragma unroll
        for (int b = 0; b < 8; ++b) *(f32x4*)(modp + (((size_t)kc * DEPTH + l) * 8 + b) * (6 * DM) + cgp * 256 + 4 * lane) = acc[b];
    }
}
__device__ __forceinline__ void modreduce_phase(ArgP Ap, int vcu, int G, int tid) {
    unsigned char* ws = Ap->ws; const float* modp = (const float*)(ws + WS_ADAP); float* mod = (float*)(ws + WS_MOD);
    constexpr int N4 = DEPTH * BATCH * 6 * DM / 4;
    for (int i = vcu * NTHREADS + tid; i < N4; i += G * NTHREADS) {
        const int n4 = i % (6 * DM / 4), l = i / (BATCH * 6 * DM / 4);
        f32x4 a = *((const f32x4*)(Ap->in[I_ADA_B] + (size_t)l * 6 * DM) + n4);
#pragma unroll
        for (int kc = 0; kc < 16; ++kc) a += *((const f32x4*)modp + (size_t)kc * N4 + i);
        *((f32x4*)mod + i) = a; }
}

__device__ __forceinline__ void norm_phase(const float* x, const float* gn, const float* macc  , const float* mbias  , int sh_off, int sc_off, bf16_t* H, int gw, int NGW, int lane) {
    for (int ch = gw; ch < MTOK / 16; ch += NGW) {
        const int row0 = ch * 16, b = row0 >> 12;
        f32x4 c1[4], shv[4];
#pragma unroll
        for (int j = 0; j < 4; ++j) { const int col = 4 * lane + 256 * j;
            const f32x4 sc = *(const f32x4*)(macc + (size_t)b * 6 * DM + sc_off + col);
            c1[j] = *(const f32x4*)(gn + col) * (1.0f + sc);
            shv[j] = *(const f32x4*)(macc + (size_t)b * 6 * DM + sh_off + col); }
        for (int r = row0; r < row0 + 16; ++r) {
            const f32x4* xr = (const f32x4*)(x + (size_t)r * DM) + lane;
            f32x4 v[4]; float ss = 0.f;
#pragma unroll
            for (int j = 0; j < 4; ++j) { v[j] = xr[64 * j]; ss += (v[j][0] * v[j][0] + v[j][1] * v[j][1]) + (v[j][2] * v[j][2] + v[j][3] * v[j][3]); }
            const float rstd = __builtin_amdgcn_rsqf(wave_sum_all(ss) * (1.0f / DM) + EPS);
            u32x2* o8 = (u32x2*)(H + (size_t)r * DM) + lane;
#pragma unroll
            for (int j = 0; j < 4; ++j) { const f32x4 o = v[j] * rstd * c1[j] + shv[j]; u32x2 w; w.x = cvt_pk_bf16(o[0], o[1]); w.y = cvt_pk_bf16(o[2], o[3]); o8[64 * j] = w; }
        }
    }
}
__device__ __forceinline__ void resnorm_phase(const float* xb, float* xo, const bf16_t* Y, const float* gate  , const float* gn, const float* macc, int sh_off, int sc_off, bf16_t* H, int gw, int NGW, int lane) {
    for (int ch = gw; ch < MTOK / 16; ch += NGW) {
        const int row0 = ch * 16, b = row0 >> 12;
        f32x4 c1[4], shv[4], gt[4];
#pragma unroll
        for (int j = 0; j < 4; ++j) { const int col = 4 * lane + 256 * j;
            const f32x4 sc = *(const f32x4*)(macc + (size_t)b * 6 * DM + sc_off + col);
            c1[j] = *(const f32x4*)(gn + col) * (1.0f + sc);
            shv[j] = *(const f32x4*)(macc + (size_t)b * 6 * DM + sh_off + col);
            gt[j] = *(const f32x4*)(gate + (size_t)b * 6 * DM + col); }
        for (int r = row0; r < row0 + 16; ++r) {
            const f32x4* xr = (const f32x4*)(xb + (size_t)r * DM) + lane; const u32x2* yr = (const u32x2*)(Y + (size_t)r * DM) + lane;
            f32x4 v[4]; float ss = 0.f;
#pragma unroll
            for (int j = 0; j < 4; ++j) { const u32x2 y = yr[64 * j]; v[j] = xr[64 * j] + gt[j] * (f32x4){bf_lo(y.x), bf_hi(y.x), bf_lo(y.y), bf_hi(y.y)};
                ss += (v[j][0] * v[j][0] + v[j][1] * v[j][1]) + (v[j][2] * v[j][2] + v[j][3] * v[j][3]); }
            const float rstd = __builtin_amdgcn_rsqf(wave_sum_all(ss) * (1.0f / DM) + EPS);
            u32x2* o8 = (u32x2*)(H + (size_t)r * DM) + lane;
#pragma unroll
            for (int j = 0; j < 4; ++j) { const f32x4 o = v[j] * rstd * c1[j] + shv[j]; u32x2 w; w.x = cvt_pk_bf16(o[0], o[1]); w.y = cvt_pk_bf16(o[2], o[3]); o8[64 * j] = w; }
        }
    }
}
__device__ __forceinline__ void final_phase(float* x, const float* gf, int gw, int NGW, int lane) {
    f32x4 gv[4];
#pragma unroll
    for (int j = 0; j < 4; ++j) gv[j] = *(const f32x4*)(gf + 4 * lane + 256 * j);
    for (int r = gw; r < MTOK; r += NGW) {
        f32x4* xr = (f32x4*)(x + (size_t)r * DM) + lane;
        f32x4 v[4]; float ss = 0.f;
#pragma unroll
        for (int j = 0; j < 4; ++j) { v[j] = xr[64 * j]; ss += (v[j][0] * v[j][0] + v[j][1] * v[j][1]) + (v[j][2] * v[j][2] + v[j][3] * v[j][3]); }
        const float rstd = __builtin_amdgcn_rsqf(wave_sum_all(ss) * (1.0f / DM) + EPS);
#pragma unroll
        for (int j = 0; j < 4; ++j) xr[64 * j] = v[j] * rstd * gv[j];
    }
}

__device__ __forceinline__ void unpack8(const u32x4 w, float (&f)[8]) { f[0] = bf_lo(w.x); f[1] = bf_hi(w.x); f[2] = bf_lo(w.y); f[3] = bf_hi(w.y); f[4] = bf_lo(w.z); f[5] = bf_hi(w.z); f[6] = bf_lo(w.w); f[7] = bf_hi(w.w); }
__device__ __forceinline__ u32x4 pack8(const float (&f)[8]) { u32x4 o; o.x = cvt_pk_bf16(f[0], f[1]); o.y = cvt_pk_bf16(f[2], f[3]); o.z = cvt_pk_bf16(f[4], f[5]); o.w = cvt_pk_bf16(f[6], f[7]); return o; }
__device__ __forceinline__ void pool_elem_phase(const bf16_t* U, bf16_t* P, int vcu, int G, int tid) {
    const int chunk = tid & 127, run = tid >> 7, c0 = 8 * chunk, w = 2 << (c0 >> 8);
    for (int unit = vcu; unit < MTOK / 128; unit += G) {
        const int t0 = unit * 128 + run * 32, seq0 = t0 & ~(SEQ - 1);
        float s[8];
#pragma unroll
        for (int j = 0; j < 8; ++j) s[j] = 0.f;
        for (int tau = t0 - w; tau < t0; ++tau) if (tau >= seq0) { float f[8];     unpack8(*(const u32x4*)(U + (size_t)tau * DM + c0), f);
#pragma unroll
            for (int j = 0; j < 8; ++j) s[j] += f[j]; }
#pragma unroll 1
        for (int tb = t0; tb < t0 + 32; tb += 8) {
            u32x4 cur[8], old[8];
#pragma unroll
            for (int i = 0; i < 8; ++i) { cur[i] = *(const u32x4*)(U + (size_t)(tb + i) * DM + c0);
                const int tl = tb + i - w; old[i] = *(const u32x4*)(U + (size_t)(tl >= seq0 ? tl : seq0) * DM + c0); }
#pragma unroll
            for (int i = 0; i < 8; ++i) { const int t = tb + i; float f[8], o[8]; unpack8(cur[i], f);
#pragma unroll
                for (int j = 0; j < 8; ++j) s[j] += f[j];
                if (t - w >= seq0) { float q[8]; unpack8(old[i], q);
#pragma unroll
                    for (int j = 0; j < 8; ++j) s[j] -= q[j]; }
                const int pos1 = t - seq0 + 1; const float inv = 1.0f / (float)(pos1 < w ? pos1 : w);
#pragma unroll
                for (int j = 0; j < 8; ++j) o[j] = s[j] * inv - f[j];
                *(u32x4*)(P + (size_t)t * DM + c0) = pack8(o); }
        }
    }
}
__device__ __forceinline__ void conv_elem_phase(const bf16_t* BG, const bf16_t* Z, const float* cw  , bf16_t* Aout, int vcu, int G, int tid) {
    const int chunk = tid & 127, run = tid >> 7, c0 = 8 * chunk;
    float w0[8], w1[8], w2[8];
#pragma unroll
    for (int j = 0; j < 8; ++j) { w0[j] = cw[c0 + j]; w1[j] = cw[DM + c0 + j]; w2[j] = cw[2 * DM + c0 + j]; }
    for (int unit = vcu; unit < MTOK / 128; unit += G) {
        const int t0 = unit * 128 + run * 32, seq0 = t0 & ~(SEQ - 1);
        float zm2[8], zm1[8];
#pragma unroll
        for (int j = 0; j < 8; ++j) { zm2[j] = 0.f; zm1[j] = 0.f; }
        if (t0 - 2 >= seq0) unpack8(*(const u32x4*)(Z + (size_t)(t0 - 2) * DM + c0), zm2);
        if (t0 - 1 >= seq0) unpack8(*(const u32x4*)(Z + (size_t)(t0 - 1) * DM + c0), zm1);
#pragma unroll 1
        for (int tb = t0; tb < t0 + 32; tb += 8) {
            u32x4 zr[8], br[8];
#pragma unroll
            for (int i = 0; i < 8; ++i) { zr[i] = *(const u32x4*)(Z + (size_t)(tb + i) * DM + c0); br[i] = *(const u32x4*)(BG + (size_t)(tb + i) * DM + c0); }
#pragma unroll
            for (int i = 0; i < 8; ++i) { float z[8], bg[8], o[8]; unpack8(zr[i], z); unpack8(br[i], bg);
#pragma unroll
                for (int j = 0; j < 8; ++j) { o[j] = bg[j] * (w0[j] * zm2[j] + w1[j] * zm1[j] + w2[j] * z[j]); zm2[j] = zm1[j]; zm1[j] = z[j]; }
                *(u32x4*)(Aout + (size_t)(tb + i) * DM + c0) = pack8(o); }
        }
    }
}

__device__ __forceinline__ int wp_off(int row, int chunk) { return row * 256 + ((chunk ^ (row & 15)) << 4); }
__device__ __forceinline__ void mix_phase(LAS unsigned char* lds, bf16_t* UA, const bf16_t* VT, const float* WS, const float* BS, const float* LNG, const float* LNB, int vcu, int G, int tid, int wid, int lane) {
    LAS unsigned char* WP = lds;
    LAS float* MU = (LAS float*)(lds + 32768); LAS float* RSTD = MU + 128; LAS float* R1 = MU + 256; LAS float* R2 = MU + 384;
    LAS float* PART = (LAS float*)(lds + 36864);
    LAS unsigned char* VS = lds + 36864;
    for (int n = vcu; n < MTOK / 128; n += G) {
        {
            const int cgp = tid >> 4, tl = tid & 15;
            float s[8], q[8];
#pragma unroll
            for (int j = 0; j < 8; ++j) { s[j] = 0.f; q[j] = 0.f; }
#pragma unroll 4
            for (int it = 0; it < GH / 32; ++it) { float f[8]; unpack8(*(const u32x4*)(VT + ((size_t)n * GH + it * 32 + cgp) * 128 + tl * 8), f);
#pragma unroll
                for (int j = 0; j < 8; ++j) { s[j] += f[j]; q[j] += f[j] * f[j]; } }
#pragma unroll
            for (int j = 0; j < 8; ++j) { PART[(cgp * 128 + tl * 8 + j) * 2] = s[j]; PART[(cgp * 128 + tl * 8 + j) * 2 + 1] = q[j]; }
            __syncthreads();
            if (tid < 128) { float S = 0.f, Q = 0.f;
                for (int k = 0; k < 32; ++k) { S += PART[(k * 128 + tid) * 2]; Q += PART[(k * 128 + tid) * 2 + 1]; }
                const float mu = S * (1.0f / GH), var = Q * (1.0f / GH) - mu * mu; MU[tid] = mu; RSTD[tid] = __builtin_amdgcn_rsqf(fmaxf(var, 0.f) + EPS); }
            __syncthreads();
        }
        for (int g = 0; g < 8; ++g) {
            const int fr = lane & 15, fq = lane >> 4, cbase = g * 384 + wid * 48;
            bf16x8 av[4][3];
#pragma unroll
            for (int ks = 0; ks < 4; ++ks)
#pragma unroll
                for (int ct = 0; ct < 3; ++ct) av[ks][ct] = *(const bf16x8*)(VT + ((size_t)n * GH + cbase + ct * 16 + fr) * 128 + ks * 32 + fq * 8);
            {
                const int i = tid >> 2, part = tid & 3;
                const float* wrow = WS + ((size_t)g * 128 + i) * 128 + part * 32;
                float r1 = 0.f, r2 = 0.f;
#pragma unroll
                for (int jj = 0; jj < 32; jj += 8) { const int j0 = part * 32 + jj;
                    f32x4 a = *(const f32x4*)(wrow + jj), b = *(const f32x4*)(wrow + jj + 4);
                    if (i < 64 && j0 >= 64) { a = (f32x4){0.f, 0.f, 0.f, 0.f}; b = a; }
                    const f32x4 ra = *(const LAS f32x4*)(RSTD + j0), rb = *(const LAS f32x4*)(RSTD + j0 + 4), ma = *(const LAS f32x4*)(MU + j0), mb = *(const LAS f32x4*)(MU + j0 + 4);
                    const f32x4 wa = a * ra, wb = b * rb;
                    r1 += (wa[0] * ma[0] + wa[1] * ma[1]) + (wa[2] * ma[2] + wa[3] * ma[3]) + (wb[0] * mb[0] + wb[1] * mb[1]) + (wb[2] * mb[2] + wb[3] * mb[3]);
                    r2 += (a[0] + a[1]) + (a[2] + a[3]) + (b[0] + b[1]) + (b[2] + b[3]);
                    u32x4 o; o.x = cvt_pk_bf16(wa[0], wa[1]); o.y = cvt_pk_bf16(wa[2], wa[3]); o.z = cvt_pk_bf16(wb[0], wb[1]); o.w = cvt_pk_bf16(wb[2], wb[3]);
                    *(LAS u32x4*)(WP + wp_off(i, j0 >> 3)) = o; }
                r1 += __shfl_xor(r1, 1); r1 += __shfl_xor(r1, 2); r2 += __shfl_xor(r2, 1); r2 += __shfl_xor(r2, 2);
                if (part == 0) { R1[i] = r1; R2[i] = r2; }
            }
            __syncthreads();
            f32x4 acc[3][8];
#pragma unroll
            for (int ct = 0; ct < 3; ++ct)
#pragma unroll
                for (int it = 0; it < 8; ++it) acc[ct][it] = (f32x4){0.f, 0.f, 0.f, 0.f};
#pragma unroll
            for (int ks = 0; ks < 4; ++ks) {
#pragma unroll
                for (int it = 0; it < 8; ++it) { const bf16x8 bw = *(const LAS bf16x8*)(WP + wp_off(it * 16 + fr, ks * 4 + fq));
#pragma unroll
                    for (int ct = 0; ct < 3; ++ct) acc[ct][it] = __builtin_amdgcn_mfma_f32_16x16x32_bf16(av[ks][ct], bw, acc[ct][it], 0, 0, 0); }
                __builtin_amdgcn_sched_barrier(0);
            }
#pragma unroll
            for (int ct = 0; ct < 3; ++ct) { const int c4 = cbase + ct * 16 + 4 * fq;
                const f32x4 lg = *(const f32x4*)(LNG + c4), lb = *(const f32x4*)(LNB + c4);
#pragma unroll
                for (int it = 0; it < 8; ++it) { const int i = it * 16 + fr; const float r1 = R1[i], r2 = R2[i], bs = BS[g * 128 + i];
                    const f32x4 vs = lg * (acc[ct][it] - r1) + lb * r2 + bs;
                    u32x2 o; o.x = cvt_pk_bf16(vs[0], vs[1]); o.y = cvt_pk_bf16(vs[2], vs[3]);
                    *(LAS u32x2*)(VS + i * 784 + (wid * 48 + ct * 16 + 4 * fq) * 2) = o; } }
            __syncthreads();
#pragma unroll 4
            for (int c = tid; c < 128 * 48; c += NTHREADS) { const int tok = c / 48, ch8 = c - tok * 48;
                const u32x4 vv = *(const LAS u32x4*)(VS + tok * 784 + ch8 * 16);
                u32x4* up = (u32x4*)(UA + (size_t)(n * 128 + tok) * GH + g * 384 + ch8 * 8); const u32x4 uu = *up;
                u32x4 o; o.x = cvt_pk_bf16(bf_lo(uu.x) * bf_lo(vv.x), bf_hi(uu.x) * bf_hi(vv.x)); o.y = cvt_pk_bf16(bf_lo(uu.y) * bf_lo(vv.y), bf_hi(uu.y) * bf_hi(vv.y));
                o.z = cvt_pk_bf16(bf_lo(uu.z) * bf_lo(vv.z), bf_hi(uu.z) * bf_hi(vv.z)); o.w = cvt_pk_bf16(bf_lo(uu.w) * bf_lo(vv.w), bf_hi(uu.w) * bf_hi(vv.w));
                *up = o; }
            __syncthreads();
        }
    }
}

__device__ __forceinline__ void topk_units(LAS unsigned char* lds, const bf16_t* Q, const bf16_t* KEYS, int* SELI, float* SELW, const pg8::StaticOrder& S, int tid, int wid, int lane) {
    LAS unsigned char* kl = lds;
    LAS float* topv = (LAS float*)(lds + 65536);
    const int p = wid >> 2, sub = wid & 3, tl = lane & 31, hi = lane >> 5;
    int hprev = -1;
#pragma unroll 1
    for (int k = 0; ; k = (k & 1) ? k + 3 : k + 1) {
        pg8::Unit ua, ub; if (!S.next(k, ua)) break;
        const bool hasb = S.next(k + 2, ub);
        const bool pair = hasb && ub.pn == ua.pn;
#pragma unroll 1
        for (int part = 0; part < ((hasb && !pair) ? 2 : 1); ++part) {
            const int h = part ? ub.pn : ua.pn, pm0 = part ? ub.pm : ua.pm, pm1 = ub.pm, ntile = pair ? 4 : 2;
            __syncthreads();
            if (h != hprev) {
                for (int c = tid; c < 4096; c += NTHREADS) { const int row = c >> 4, ch = c & 15;
                    const u32x4 v = *(const u32x4*)(KEYS + ((size_t)h * 256 + row) * 128 + ch * 8);
                    *(LAS u32x4*)(kl + row * 256 + ((ch ^ (row & 15)) << 4)) = v; }
                hprev = h; }
            __syncthreads();
#pragma unroll 1
            for (int t4 = 0; t4 < ntile; ++t4) {
                const int tile = 2 * (t4 < 2 ? pm0 : pm1) + (t4 & 1);
                const bf16_t* qrow = Q + ((size_t)((tile * 8 + h) * 32 + 16 * p + hi) * 128 + sub * 32 + tl) * 8;
                bf16x8 bq[8];
#pragma unroll
                for (int ks = 0; ks < 8; ++ks) bq[ks] = *(const bf16x8*)(qrow + (size_t)ks * 2 * 128 * 8);
                f32x16 acc[4];
#pragma unroll
                for (int kt = 0; kt < 4; ++kt)
#pragma unroll
                    for (int r = 0; r < 16; ++r) acc[kt][r] = 0.f;
#pragma unroll
                for (int ks = 0; ks < 8; ++ks)
#pragma unroll
                    for (int kt = 0; kt < 4; ++kt) { const int row = p * 128 + kt * 32 + tl;
                        const bf16x8 ak = *(const LAS bf16x8*)(kl + row * 256 + (((2 * ks + hi) ^ (row & 15)) << 4));
                        acc[kt] = __builtin_amdgcn_mfma_f32_32x32x16_bf16(ak, bq[ks], acc[kt], 0, 0, 0); }
                float v[64];
#pragma unroll
                for (int kt = 0; kt < 4; ++kt)
#pragma unroll
                    for (int r = 0; r < 16; ++r) { const unsigned key = (unsigned)(kt * 32 + (r & 3) + 8 * (r >> 2) + 4 * hi);
                        v[kt * 16 + r] = __uint_as_float((__float_as_uint(acc[kt][r]) & ~127u) | key); }
                top16_of_64(v);
                float m[16];
#pragma unroll
                for (int i = 0; i < 16; ++i) m[i] = fmaxf(v[i], __shfl_xor(v[15 - i], 32));
                bmerge16_desc<0, 16>(m);
                if (hi == 0) { LAS f32x4* dst = (LAS f32x4*)(topv + ((t4 * 2 + p) * 128 + sub * 32 + tl) * 16);
#pragma unroll
                    for (int i = 0; i < 4; ++i) dst[i] = (f32x4){m[4 * i], m[4 * i + 1], m[4 * i + 2], m[4 * i + 3]}; }
            }
            __syncthreads();
            if (tid < ntile * 128) {
                const int t4 = tid >> 7, tok = tid & 127, tile = 2 * (t4 < 2 ? pm0 : pm1) + (t4 & 1);
                const LAS float* t0 = topv + ((t4 * 2 + 0) * 128 + tok) * 16; const LAS float* t1 = topv + ((t4 * 2 + 1) * 128 + tok) * 16;
                float s0[16], s1[16];
#pragma unroll
                for (int i = 0; i < 4; ++i) { const f32x4 a = *(const LAS f32x4*)(t0 + 4 * i), b = *(const LAS f32x4*)(t1 + 4 * i);
                    s0[4 * i] = a[0]; s0[4 * i + 1] = a[1]; s0[4 * i + 2] = a[2]; s0[4 * i + 3] = a[3]; s1[4 * i] = b[0]; s1[4 * i + 1] = b[1]; s1[4 * i + 2] = b[2]; s1[4 * i + 3] = b[3]; }
                float c[64];
                constexpr int pre[16] = {0, 16, 24, 29, 33, 36, 38, 40, 42, 43, 44, 45, 46, 47, 48, 49};
#pragma unroll
                for (int a = 0; a < 16; ++a)
#pragma unroll
                    for (int b = 0; b < 16; ++b) if ((a + 1) * (b + 1) <= 16) c[pre[a] + b] = __uint_as_float((__float_as_uint(s0[a] + s1[b]) & ~255u) | (unsigned)(a * 16 + b));
#pragma unroll
                for (int i = 50; i < 64; ++i) c[i] = -3.0e38f;
                top16_of_64(c);
                float e[16], sum = 0.f;
#pragma unroll
                for (int kk = 0; kk < 16; ++kk) { e[kk] = __builtin_amdgcn_exp2f((c[kk] - c[0]) * 1.44269504f); sum += e[kk]; }
                const float inv = 1.0f / sum;
                const size_t o = (size_t)(tile * 128 + tok) * NPICK + h * 16;
#pragma unroll
                for (int k4 = 0; k4 < 4; ++k4) { i32x4 ei; f32x4 wv;
#pragma unroll
                    for (int j = 0; j < 4; ++j) { const unsigned code = __float_as_uint(c[4 * k4 + j]) & 255u;
                        const unsigned i1 = __float_as_uint(t0[code >> 4]) & 127u, i2 = __float_as_uint(t1[code & 15u]) & 127u;
                        ei[j] = (int)(i1 * 128u + i2); wv[j] = e[4 * k4 + j] * inv; }
                    *(i32x4*)(SELI + o + 4 * k4) = ei; *(f32x4*)(SELW + o + 4 * k4) = wv; }
            }
        }
    }
    __syncthreads();
}

typedef const unsigned char* cbytes;
template <int CTRL> __device__ __forceinline__ float dpp_f(float v) { return __builtin_bit_cast(float, __builtin_amdgcn_update_dpp(0, __builtin_bit_cast(int, v), CTRL, 0xf, 0xf, false)); }
#define DPP_F(v, ctrl) dpp_f<(ctrl)>(v)
#define PG_IDX(EV, TKN) do { const LAS u32x4* _ip = (const LAS u32x4*)(idxw + (TKN) * 128 + 16 * g8); \
        _Pragma("unroll") for (int q = 0; q < 2; ++q) { const u32x4 _e = _ip[q]; _Pragma("unroll") for (int w = 0; w < 4; ++w) { EV[8 * q + 2 * w] = (int)(_e[w] & 0xffffu); EV[8 * q + 2 * w + 1] = (int)(_e[w] >> 16); } } } while (0)
#define PG_GATHER8(BUF, SL, EV, J0) do { _Pragma("unroll") for (int j = 0; j < 8; ++j) BUF[j] = *(const u32x4*)((SL) + ((unsigned)EV[(J0) + j] * 128u + s8 * 16u)); } while (0)
#define PG_H(HA, HB, IT) do { const int _it = (IT) < 127 ? (IT) : 127; const u32x4* _hp = (const u32x4*)(H + (size_t)(tk0 + (_it & 15)) * DM + (((xg + (_it >> 4)) & 7) * 128) + s8 * 16); HA = _hp[0]; HB = _hp[1]; } while (0)
#define PG_HF(HA, HB) do { hf[0] = (f32x2){bf_lo(HA.x), bf_hi(HA.x)}; hf[1] = (f32x2){bf_lo(HA.y), bf_hi(HA.y)}; hf[2] = (f32x2){bf_lo(HA.z), bf_hi(HA.z)}; hf[3] = (f32x2){bf_lo(HA.w), bf_hi(HA.w)}; \
        hf[4] = (f32x2){bf_lo(HB.x), bf_hi(HB.x)}; hf[5] = (f32x2){bf_lo(HB.y), bf_hi(HB.y)}; hf[6] = (f32x2){bf_lo(HB.z), bf_hi(HB.z)}; hf[7] = (f32x2){bf_lo(HB.w), bf_hi(HB.w)}; } while (0)
#define PG_UCOMP8(BUF, O) do { _Pragma("unroll") for (int j = 0; j < 8; ++j) { const u32x4 u = BUF[j]; \
            f32x2 a = __builtin_amdgcn_cvt_pk_f32_fp8(u.x, false) * hf[0]; a += __builtin_amdgcn_cvt_pk_f32_fp8(u.x, true) * hf[1]; \
            a += __builtin_amdgcn_cvt_pk_f32_fp8(u.y, false) * hf[2]; a += __builtin_amdgcn_cvt_pk_f32_fp8(u.y, true) * hf[3]; \
            a += __builtin_amdgcn_cvt_pk_f32_fp8(u.z, false) * hf[4]; a += __builtin_amdgcn_cvt_pk_f32_fp8(u.z, true) * hf[5]; \
            a += __builtin_amdgcn_cvt_pk_f32_fp8(u.w, false) * hf[6]; a += __builtin_amdgcn_cvt_pk_f32_fp8(u.w, true) * hf[7]; \
            float d = a.x + a.y; d += DPP_F(d, 0xB1); d += DPP_F(d, 0x4E); d += DPP_F(d, 0x141);     \
            O = (s8 == j) ? d : O; } } while (0)
#define PG_VCOMP8(BUF, CV, J0) do { _Pragma("unroll") for (int j = 0; j < 8; ++j) { const u32x4 v = BUF[j]; const float c = CV[(J0) + j]; \
            acc[0] += c * __builtin_amdgcn_cvt_pk_f32_fp8(v.x, false); acc[1] += c * __builtin_amdgcn_cvt_pk_f32_fp8(v.x, true); \
            acc[2] += c * __builtin_amdgcn_cvt_pk_f32_fp8(v.y, false); acc[3] += c * __builtin_amdgcn_cvt_pk_f32_fp8(v.y, true); \
            acc[4] += c * __builtin_amdgcn_cvt_pk_f32_fp8(v.z, false); acc[5] += c * __builtin_amdgcn_cvt_pk_f32_fp8(v.z, true); \
            acc[6] += c * __builtin_amdgcn_cvt_pk_f32_fp8(v.w, false); acc[7] += c * __builtin_amdgcn_cvt_pk_f32_fp8(v.w, true); } } while (0)
#define PG_COEF(CV, TKN) do { const LAS f32x4* _cp = (const LAS f32x4*)(dotw + (TKN) * 128 + 16 * g8); \
        _Pragma("unroll") for (int q = 0; q < 4; ++q) { const f32x4 _c = _cp[q]; CV[4 * q] = _c[0]; CV[4 * q + 1] = _c[1]; CV[4 * q + 2] = _c[2]; CV[4 * q + 3] = _c[3]; } } while (0)
#define PG_COEF8(CV, TKN, J0) do { const LAS f32x4* _cp = (const LAS f32x4*)(dotw + (TKN) * 128 + 16 * g8 + (J0)); \
        const f32x4 _c0 = _cp[0], _c1 = _cp[1]; CV[0] = _c0[0]; CV[1] = _c0[1]; CV[2] = _c0[2]; CV[3] = _c0[3]; CV[4] = _c1[0]; CV[5] = _c1[1]; CV[6] = _c1[2]; CV[7] = _c1[3]; } while (0)
#define PG_XOFFS(IT) ((size_t)(tk0 + ((IT) & 15)) * DM + (((xg + ((IT) >> 4)) & 7) * 128) + xoff)
#define PG_XADDR(IT) (x + PG_XOFFS(IT))
#define PG_XLOAD(XV, YV, IT) do { const size_t _o = PG_XOFFS(IT); XV = *(const f32x2*)(xin + _o); YV = *(const unsigned*)(Y + _o); } while (0)
__device__ __forceinline__ void peer_gather_phase(LAS unsigned char* lds, const bf16_t* H, cbytes TUP, cbytes TVP, const int* SELI, const float* SELW, const unsigned* SC, const float* xin  , const bf16_t* Y  , const float* g1acc  , float* x, const float* gacc, const float* gn_next  , const float* mod_next  , bf16_t* Hout, bool last, int vcu, int G, int wid, int lane) {
    const int g8 = lane >> 3, s8 = lane & 7;
    const bool b3 = (lane & 8) != 0, b4 = (lane & 16) != 0, b5 = (lane & 32) != 0;
    const int xoff = s8 * 16 + 8 * (g8 & 1) + 4 * ((g8 >> 1) & 1) + 2 * (g8 >> 2);
    LAS unsigned short* idxw = (LAS unsigned short*)(lds + wid * 12288);
    LAS float* dotw = (LAS float*)(lds + wid * 12288 + 4096);
    for (int blk = vcu; blk < 256; blk += G) {
        const int xg = blk >> 5, tk0 = blk * 128 + wid * 16;
#pragma unroll 4
        for (int i = 0; i < 16; ++i) { const int e0 = SELI[(size_t)(tk0 + i) * NPICK + lane], e1 = SELI[(size_t)(tk0 + i) * NPICK + 64 + lane];
            idxw[i * 128 + lane] = (unsigned short)e0; idxw[i * 128 + 64 + lane] = (unsigned short)e1; dotw[i * 128 + lane] = 0.f; dotw[i * 128 + 64 + lane] = 0.f; }
        asm volatile("" ::: "memory");
        {
            int ev[16]; u32x4 bufA[8], bufB[8], bufC[8], bufD[8]; u32x4 h0a, h0b, h1a, h1b;
            { cbytes sl0 = TUP + (size_t)(xg & 7) * NEXP * 128;
              PG_IDX(ev, 0); PG_GATHER8(bufA, sl0, ev, 0); PG_GATHER8(bufB, sl0, ev, 8);
              PG_IDX(ev, 1); PG_GATHER8(bufC, sl0, ev, 0); PG_GATHER8(bufD, sl0, ev, 8); }
            PG_H(h0a, h0b, 0); PG_H(h1a, h1b, 1);
#pragma unroll 1
            for (int it = 0; it < 128; it += 2) {
                const int tkn = it & 15, it2 = it + 2 < 127 ? it + 2 : 127, it3 = it + 3 < 127 ? it + 3 : 127;
                cbytes sl2 = TUP + (size_t)((xg + (it2 >> 4)) & 7) * NEXP * 128;
                f32x2 hf[8]; float o0 = 0.f, o1 = 0.f;
                PG_HF(h0a, h0b); PG_IDX(ev, it2 & 15);
                PG_UCOMP8(bufA, o0); __builtin_amdgcn_sched_barrier(0);
                PG_GATHER8(bufA, sl2, ev, 0); __builtin_amdgcn_sched_barrier(0);
                PG_UCOMP8(bufB, o1); __builtin_amdgcn_sched_barrier(0);
                PG_GATHER8(bufB, sl2, ev, 8); PG_H(h0a, h0b, it + 2); __builtin_amdgcn_sched_barrier(0);
                { LAS float* dp = dotw + tkn * 128 + 16 * g8 + s8; dp[0] += o0; dp[8] += o1; }
                o0 = 0.f; o1 = 0.f;
                PG_HF(h1a, h1b); PG_IDX(ev, it3 & 15);
                PG_UCOMP8(bufC, o0); __builtin_amdgcn_sched_barrier(0);
                PG_GATHER8(bufC, sl2, ev, 0); __builtin_amdgcn_sched_barrier(0);
                PG_UCOMP8(bufD, o1); __builtin_amdgcn_sched_barrier(0);
                PG_GATHER8(bufD, sl2, ev, 8); PG_H(h1a, h1b, it + 3); __builtin_amdgcn_sched_barrier(0);
                { LAS float* dp = dotw + (tkn + 1) * 128 + 16 * g8 + s8; dp[0] += o0; dp[8] += o1; }
            }
        }
        asm volatile("" ::: "memory");
#pragma unroll 2
        for (int i = 0; i < 16; ++i) {
#pragma unroll
            for (int hh = 0; hh < 2; ++hh) { const int k = 16 * g8 + s8 + 8 * hh; const int e = idxw[i * 128 + k];
                const float w = SELW[(size_t)(tk0 + i) * NPICK + k]; const unsigned sc = SC[e];
                dotw[i * 128 + k] = w * gelu_tanh(dotw[i * 128 + k] * bf_lo(sc)) * bf_hi(sc); } }
        asm volatile("" ::: "memory");
        {
            const float* gp = gacc + (size_t)(tk0 >> 12) * 6 * DM + xoff;
            const float* g1p = g1acc + (size_t)(tk0 >> 12) * 6 * DM + xoff;
            int ev[16]; u32x4 bufA[8], bufB[8], bufC[8], bufD[8]; float cC[8]; f32x2 x0, x1; unsigned y0, y1;
            { cbytes sl0 = TVP + (size_t)(xg & 7) * NEXP * 128;
              PG_IDX(ev, 0); PG_GATHER8(bufA, sl0, ev, 0); PG_GATHER8(bufB, sl0, ev, 8);
              PG_IDX(ev, 1); PG_GATHER8(bufC, sl0, ev, 0); PG_GATHER8(bufD, sl0, ev, 8); }
            PG_XLOAD(x0, y0, 0); PG_XLOAD(x1, y1, 1);
#define PG_VREDUCE_STORE(XV, YV, IT) do { \
                f32x2 k4[4]; _Pragma("unroll") for (int j = 0; j < 4; ++j) { f32x2 lo = acc[j], hi = acc[4 + j];          \
                    lo.x += DPP_F(lo.x, 0x128); lo.y += DPP_F(lo.y, 0x128); hi.x += DPP_F(hi.x, 0x128); hi.y += DPP_F(hi.y, 0x128); k4[j] = b3 ? hi : lo; } \
                f32x2 k2[2]; _Pragma("unroll") for (int j = 0; j < 2; ++j) { const f32x2 snd = b4 ? k4[j] : k4[2 + j]; k2[j] = b4 ? k4[2 + j] : k4[j]; k2[j].x += __shfl_xor(snd.x, 16); k2[j].y += __shfl_xor(snd.y, 16); } \
                const f32x2 snd = b5 ? k2[0] : k2[1]; f32x2 k1 = b5 ? k2[1] : k2[0]; \
                k1.x += __shfl_xor(snd.x, 32); k1.y += __shfl_xor(snd.y, 32); \
                *(f32x2*)PG_XADDR(IT) = XV + gate1 * (f32x2){bf_lo(YV), bf_hi(YV)} + gate * k1; } while (0)
#pragma unroll 1
            for (int it = 0; it < 128; it += 2) {
                const int it2 = it + 2 < 127 ? it + 2 : 127, it3 = it + 3 < 127 ? it + 3 : 127, sl = (xg + (it >> 4)) & 7;
                cbytes sl2 = TVP + (size_t)((xg + (it2 >> 4)) & 7) * NEXP * 128;
                const f32x2 gate = *(const f32x2*)(gp + sl * 128), gate1 = *(const f32x2*)(g1p + sl * 128);
                f32x2 acc[8];
#pragma unroll
                for (int j = 0; j < 8; ++j) acc[j] = (f32x2){0.f, 0.f};
                PG_COEF8(cC, it & 15, 0); PG_IDX(ev, it2 & 15);
                PG_VCOMP8(bufA, cC, 0); __builtin_amdgcn_sched_barrier(0);
                PG_GATHER8(bufA, sl2, ev, 0); PG_COEF8(cC, it & 15, 8); __builtin_amdgcn_sched_barrier(0);
                PG_VCOMP8(bufB, cC, 0); __builtin_amdgcn_sched_barrier(0);
                PG_GATHER8(bufB, sl2, ev, 8); __builtin_amdgcn_sched_barrier(0);
                PG_VREDUCE_STORE(x0, y0, it);
                PG_XLOAD(x0, y0, it2);
#pragma unroll
                for (int j = 0; j < 8; ++j) acc[j] = (f32x2){0.f, 0.f};
                PG_COEF8(cC, (it + 1) & 15, 0); PG_IDX(ev, it3 & 15);
                PG_VCOMP8(bufC, cC, 0); __builtin_amdgcn_sched_barrier(0);
                PG_GATHER8(bufC, sl2, ev, 0); PG_COEF8(cC, (it + 1) & 15, 8); __builtin_amdgcn_sched_barrier(0);
                PG_VCOMP8(bufD, cC, 0); __builtin_amdgcn_sched_barrier(0);
                PG_GATHER8(bufD, sl2, ev, 8); __builtin_amdgcn_sched_barrier(0);
                PG_VREDUCE_STORE(x1, y1, it + 1);
                PG_XLOAD(x1, y1, it3);
            }
#undef PG_VREDUCE_STORE
        }
        asm volatile("s_waitcnt vmcnt(0)" ::: "memory");
        {
            const int b = tk0 >> 12;
            f32x4 c1[4], shv[4];
#pragma unroll
            for (int j = 0; j < 4; ++j) { const int col = 4 * lane + 256 * j;
                if (last) { c1[j] = *(const f32x4*)(gn_next + col); shv[j] = (f32x4){0.f, 0.f, 0.f, 0.f}; }
                else { c1[j] = *(const f32x4*)(gn_next + col) * (1.0f + *(const f32x4*)(mod_next + (size_t)b * 6 * DM + DM + col)); shv[j] = *(const f32x4*)(mod_next + (size_t)b * 6 * DM + col); } }
#pragma unroll 1
            for (int i0 = 0; i0 < 16; i0 += 4) {
                f32x4 v[4][4]; float ss[4];
#pragma unroll
                for (int rr = 0; rr < 4; ++rr) { const f32x4* xr = (const f32x4*)(x + (size_t)(tk0 + i0 + rr) * DM) + lane;
#pragma unroll
                    for (int j = 0; j < 4; ++j) v[rr][j] = xr[64 * j]; }
#pragma unroll
                for (int rr = 0; rr < 4; ++rr) { float q = 0.f;
#pragma unroll
                    for (int j = 0; j < 4; ++j) q += (v[rr][j][0] * v[rr][j][0] + v[rr][j][1] * v[rr][j][1]) + (v[rr][j][2] * v[rr][j][2] + v[rr][j][3] * v[rr][j][3]);
                    ss[rr] = q; }
#pragma unroll
                for (int o = 1; o < 64; o <<= 1) {
#pragma unroll
                    for (int rr = 0; rr < 4; ++rr) ss[rr] += __shfl_xor(ss[rr], o); }
#pragma unroll
                for (int rr = 0; rr < 4; ++rr) { const int r = tk0 + i0 + rr; const float rstd = __builtin_amdgcn_rsqf(ss[rr] * (1.0f / DM) + EPS);
                    if (last) { f32x4* xr = (f32x4*)(x + (size_t)r * DM) + lane;
#pragma unroll
                        for (int j = 0; j < 4; ++j) xr[64 * j] = v[rr][j] * rstd * c1[j]; }
                    else { u32x2* o8 = (u32x2*)(Hout + (size_t)r * DM) + lane;
#pragma unroll
                        for (int j = 0; j < 4; ++j) { const f32x4 o = v[rr][j] * rstd * c1[j] + shv[j]; u32x2 w; w.x = cvt_pk_bf16(o[0], o[1]); w.y = cvt_pk_bf16(o[2], o[3]); o8[64 * j] = w; } } }
            }
        }
    }
}
#undef PG_IDX
#undef PG_GATHER8
#undef PG_H
#undef PG_HF
#undef PG_UCOMP8
#undef PG_VCOMP8
#undef PG_COEF
#undef PG_COEF8
#undef PG_XADDR
#undef PG_XOFFS
#undef PG_XLOAD

constexpr size_t WS_BAR = 768 * 1024;
#define XB_TMO      128
#define XB_XCNT(j)  (256  + 64 * (j))
#define XB_XSUB(j)  (1280 + 64 * (j))
#define XB_XGEN(j)  (2304 + 64 * (j))
#define XB_TOP      3328
#define XB_TOPGEN   3392
#define XCD_BAR_WORDS 3456
#define XB_SPIN_CAP (1u << 22)
__device__ __forceinline__ unsigned xb_ld(unsigned* p)              { return __hip_atomic_load(p, __ATOMIC_RELAXED, __HIP_MEMORY_SCOPE_AGENT); }
__device__ __forceinline__ unsigned xb_add(unsigned* p, unsigned v) { return __hip_atomic_fetch_add(p, v, __ATOMIC_RELAXED, __HIP_MEMORY_SCOPE_AGENT); }
__device__ __forceinline__ unsigned xb_xcc_id() { return (unsigned)__builtin_amdgcn_s_getreg((3 << 11) | 20) & 0xFu; }
#define XB_SPIN(cond, bar) do { unsigned _sp = 0; while (cond) { __builtin_amdgcn_s_sleep(1); \
    if ((++_sp & 255u) == 0u) { if (xb_ld(&(bar)[XB_TMO])) break; if (_sp > XB_SPIN_CAP) { atomicAdd(&(bar)[XB_TMO], 1u); break; } } } } while (0)
struct XcdBarrier { unsigned* bar; unsigned x; volatile LAS unsigned* st; };
__device__ __forceinline__ void xcd_barrier_complete(unsigned* bar, unsigned x, unsigned& nloc, unsigned& nx) {
    const unsigned G = gridDim.x * gridDim.y * gridDim.z;
    unsigned sum, cnt, mine, sp = 0u;
    for (;;) {
        sum = 0u; cnt = 0u; mine = 0u;
#pragma unroll
        for (unsigned j = 0; j < 16; ++j) { const unsigned c = xb_ld(&bar[XB_XCNT(j)]); sum += c; cnt += (c > 0u) ? 1u : 0u; mine = (j == x) ? c : mine; }
        if (sum == G) break;
        __builtin_amdgcn_s_sleep(1);
        if ((++sp & 255u) == 0u) { if (xb_ld(&bar[XB_TMO])) break; if (sp > XB_SPIN_CAP) { atomicAdd(&bar[XB_TMO], 1u); break; } }
    }
    nloc = mine > 0u ? mine : 1u; nx = cnt > 0u ? cnt : 1u;
}
__device__ __forceinline__ void xcd_barrier(const XcdBarrier& b) {
    asm volatile("s_waitcnt vmcnt(0)" ::: "memory");
    __syncthreads();
    if (threadIdx.x == 0) {
        unsigned* bar = b.bar;
        __builtin_amdgcn_s_waitcnt(0);
        unsigned nloc = b.st[0], nx = b.st[1];
        if (nloc == 0u) { xcd_barrier_complete(bar, b.x, nloc, nx); b.st[0] = nloc; b.st[1] = nx; }
        const unsigned old = xb_add(&bar[XB_XSUB(b.x)], 1u);
        const unsigned gen = old / nloc;
        if (old + 1u == (gen + 1u) * nloc) {
            __builtin_amdgcn_fence(__ATOMIC_RELEASE, "agent");
            asm volatile("s_waitcnt vmcnt(0)" ::: "memory");
            const unsigned og = xb_add(&bar[XB_TOP], 1u);
            const unsigned tg = og / nx;
            if (og + 1u == (tg + 1u) * nx) xb_add(&bar[XB_TOPGEN], 1u);
            else XB_SPIN(xb_ld(&bar[XB_TOPGEN]) == tg, bar);
            __builtin_amdgcn_fence(__ATOMIC_ACQUIRE, "agent");
            xb_add(&bar[XB_XGEN(b.x)], 1u);
            asm volatile("s_waitcnt vmcnt(0)" ::: "memory");
        } else {
            XB_SPIN(xb_ld(&bar[XB_XGEN(b.x)]) == gen, bar);
            __builtin_amdgcn_fence(__ATOMIC_ACQUIRE, "agent");
            asm volatile("s_waitcnt vmcnt(0)" ::: "memory");
        }
    }
    __syncthreads();
}

constexpr int NPHASES = 29;
#ifndef PH_MASK
#define PH_MASK 0xFFFFFF
#endif
#ifndef DUP_MASK
#define DUP_MASK 0
#endif
#ifndef TIME_MASK
#define TIME_MASK 0
#endif
__device__ __forceinline__ int opaque_s(int x) { asm volatile("" : "+s"(x)); return x; }
#define PHM(bit, call) do { if constexpr ((PH_MASK & (bit)) != 0) { if constexpr ((DUP_MASK & (bit)) != 0) { const int _nrep = opaque_s(2); for (int _rep = 0; _rep < _nrep; ++_rep) { call; __syncthreads(); } } else { call; } } } while (0)
__global__ void __launch_bounds__(NTHREADS, 2) trunk_fwd(Args A) {
    extern __shared__ __attribute__((aligned(16))) unsigned char lds_raw[];
    LAS unsigned char* lds = (LAS unsigned char*)lds_raw;
    const int tid0 = threadIdx.x, wid = __builtin_amdgcn_readfirstlane(tid0 >> 6);
    const int G = gridDim.x, bx = blockIdx.x, vcu = (G % 8 == 0) ? (bx % 8) * (G / 8) + bx / 8 : bx;
    const int gw = vcu * 8 + wid, NGW = G * 8;
    const int ph_lo = A.ph_lo, ph_hi = A.ph_hi;
    unsigned long long t_acc = 0;
#if MK_ONE_LAUNCH
    if (tid0 < 2) ((volatile LAS unsigned*)(lds + LDS_XB_OFF))[tid0] = 0u;
    if (bx == 0) { unsigned* b0 = (unsigned*)(A.ws + WS_BAR); for (int i = tid0; i < XCD_BAR_WORDS; i += NTHREADS) b0[i] = 0u; }
#endif

    for (int ph = ph_lo; ph < ph_hi; ++ph) {
        const int tid = opaque(tid0), lane = tid & 63;
        ArgP Ap = (ArgP)__builtin_amdgcn_kernarg_segment_ptr();
        asm volatile("" : "+s"(Ap));
        unsigned char* ws = Ap->ws;
        bf16_t* Hb = (bf16_t*)(ws + WS_H);
        unsigned char* mixb = ws + WS_MIX;
        const float* mod = (const float*)(ws + WS_MOD);
        float* xo = Ap->out;
        int layer, step;
        if (ph < 2) { layer = -1; step = ph; }
        else if (ph < 10) { layer = 0; step = ph - 2; }
        else if (ph < 16) { layer = 1; step = ph - 10 + 1; }
        else if (ph < 22) { layer = 2; step = ph - 16 + 1; }
        else { layer = 3; step = ph - 22 + 1; }
        const int kind = layer % 3, jl = layer / 3;
        unsigned long long t_ph0 = 0; if constexpr (TIME_MASK != 0) t_ph0 = __builtin_amdgcn_s_memrealtime();
        const int nmix = (kind == 0) ? 5 : 4;
        int ptype = 0;
        if (layer < 0) ptype = 1; else if (layer > 3) ptype = 2048; else if (step == 0 || step == nmix) ptype = 2;
        else if (step < nmix) ptype = (step == 1) ? 4 : (step == nmix - 1) ? 32 : (kind == 0 && step == 3) ? 16 : 8;
        else ptype = 64 << (step - nmix - 1);
        const float* macc = mod + (size_t)(layer < 0 ? 0 : (layer > 3 ? 3 : layer)) * BATCH * 6 * DM;
        const float* mbias = Ap->in[I_ADA_B] + (size_t)(layer < 0 ? 0 : (layer > 3 ? 3 : layer)) * 6 * DM;
        const float* xin = (layer == 0) ? Ap->in[I_X] : xo;

        if (layer < 0) {
            if (step == 0) { PHM(1, prologue_phase(Ap, lds, vcu, G, tid, wid, lane)); }
            else { PHM(1, modreduce_phase(Ap, vcu, G, tid)); }
        } else if (layer > 3) {
            PHM(256, final_phase(xo, Ap->in[I_FINAL_G], gw, NGW, lane));
        } else if (step == 0) {
            PHM(2, norm_phase(xin, Ap->in[I_NORM_G] + (size_t)(layer * 2 + 0) * DM, macc, mbias, 0, DM, Hb, gw, NGW, lane));
        } else if (step < nmix) {
            pg8::StaticOrder S;
            if (kind == 0) {
                bf16_t* U = (bf16_t*)mixb; bf16_t* P = (bf16_t*)(mixb + 64 * MiB); bf16_t* Z = (bf16_t*)(mixb + 128 * MiB);
                if (step == 1) { pg8::Gemm g{Hb, (const bf16_t*)(ws + WS_POOL_WIN) + (size_t)jl * DM * DM, MTOK, DM, DM, DM, DM, 0}; S.init(MTOK, DM, G, bx);
                    pg8::EpiBf16<0> E{U, DM}; PHM(0x1000, pg8::gemm_phase(lds, g, S, E)); }
                else if (step == 2) { PHM(8, pool_elem_phase(U, P, vcu, G, tid)); }
                else if (step == 3) { pg8::Gemm g{P, (const bf16_t*)(ws + WS_POOL_WGRP) + (size_t)jl * 4 * 65536, MTOK, DM, 256, DM, 256, 256}; S.init(MTOK, DM, G, bx);
                    pg8::EpiPoolGrp E{Z, Ap->in[I_POOL_SCALE] + (size_t)jl * DM}; PHM(0x2000, pg8::gemm_phase(lds, g, S, E)); }
                else { pg8::Gemm g{Z, (const bf16_t*)(ws + WS_POOL_WOUT) + (size_t)jl * DM * DM, MTOK, DM, DM, DM, DM, 0}; S.init(MTOK, DM, G, bx);
                    pg8::EpiBf16<0> E{(bf16_t*)(mixb + 192 * MiB), DM}; PHM(0x8000, pg8::gemm_phase(lds, g, S, E));   }
            } else if (kind == 1) {
                bf16_t* BG = (bf16_t*)mixb; bf16_t* Z = (bf16_t*)(mixb + 64 * MiB); bf16_t* AA = (bf16_t*)(mixb + 128 * MiB);
                if (step == 1) { pg8::Gemm g{Hb, (const bf16_t*)(ws + WS_CONV_WIN), MTOK, 3 * DM, DM, DM, DM, 0}; S.init(MTOK, 3 * DM, G, bx);
                    pg8::EpiConvIn E{BG, Z}; PHM(0x4000, pg8::gemm_phase(lds, g, S, E)); }
                else if (step == 2) { PHM(16, conv_elem_phase(BG, Z, Ap->in[I_CONV_W], AA, vcu, G, tid)); }
                else { pg8::Gemm g{AA, (const bf16_t*)(ws + WS_CONV_WOUT), MTOK, DM, DM, DM, DM, 0}; S.init(MTOK, DM, G, bx);
                    pg8::EpiBf16<0> E{(bf16_t*)(mixb + 192 * MiB), DM}; PHM(0x8000, pg8::gemm_phase(lds, g, S, E));   }
            } else {
                bf16_t* UA = (bf16_t*)mixb; bf16_t* VT = (bf16_t*)(mixb + 192 * MiB);
                if (step == 1) {
                    { pg8::Gemm g{Hb, (const bf16_t*)(ws + WS_GMLP_WIN), MTOK, GH, DM, DM, DM, 0}; S.init(MTOK, GH, G, bx);
                      pg8::EpiBf16<1> E{UA, GH}; PHM(0x1000, pg8::gemm_phase(lds, g, S, E)); }
                    { pg8::Gemm g{Hb, (const bf16_t*)(ws + WS_GMLP_WIN) + (size_t)GH * DM, MTOK, GH, DM, DM, DM, 0}; S.init(MTOK, GH, G, bx);
                      pg8::EpiGmlpV E{VT}; PHM(0x10000, pg8::gemm_phase(lds, g, S, E)); }
                }
                else if (step == 2) { PHM(32, mix_phase(lds, UA, VT, Ap->in[I_GMLP_WS], Ap->in[I_GMLP_BS], Ap->in[I_GMLP_LNG], Ap->in[I_GMLP_LNB], vcu, G, tid, wid, lane)); }
                else { pg8::Gemm g{UA, (const bf16_t*)(ws + WS_GMLP_WOUT), MTOK, DM, GH, GH, GH, 0}; S.init(MTOK, DM, G, bx);
                    pg8::EpiBf16<0> E{(bf16_t*)(mixb + 192 * MiB), DM}; PHM(0x8000, pg8::gemm_phase(lds, g, S, E));   }
            }
        } else {
            const int ps = step - nmix;
            bf16_t* Qb = (bf16_t*)mixb;
            if (ps == 0) { resnorm_phase(xin, xo, (const bf16_t*)(mixb + 192 * MiB), macc + 2 * DM, Ap->in[I_NORM_G] + (size_t)(layer * 2 + 1) * DM, macc, 3 * DM, 4 * DM, Hb, gw, NGW, lane); }
            else if (ps == 1) { pg8::StaticOrder S; pg8::Gemm g{Hb, (const bf16_t*)(ws + WS_PEER_WQ) + (size_t)layer * DM * 2048, MTOK, 2048, DM, DM, DM, 0}; S.init(MTOK, 2048, G, bx);
                pg8::EpiQT E{Qb}; PHM(0x1000, pg8::gemm_phase(lds, g, S, E));
                asm volatile("s_waitcnt vmcnt(0)" ::: "memory"); __syncthreads();
                PHM(64, topk_units(lds, Qb, (const bf16_t*)(ws + WS_KEYS) + (size_t)layer * 16 * 128 * 128, (int*)(ws + WS_SELI), (float*)(ws + WS_SELW), S, tid, wid, lane)); }
            else { PHM(128, peer_gather_phase(lds, Hb, (cbytes)(ws + WS_TABU) + (size_t)layer * NEXP * DM, (cbytes)(ws + WS_TABV) + (size_t)layer * NEXP * DM, (const int*)(ws + WS_SELI), (const float*)(ws + WS_SELW),
                              (const unsigned*)(ws + WS_SCU) + (size_t)layer * NEXP, xin, (const bf16_t*)(mixb + 192 * MiB), macc + 2 * DM, xo, macc + 5 * DM,
                              layer == 3 ? Ap->in[I_FINAL_G] : Ap->in[I_NORM_G] + (size_t)((layer + 1) * 2) * DM, mod + (size_t)(layer == 3 ? 3 : layer + 1) * BATCH * 6 * DM, Hb, layer == 3, vcu, G, wid, lane)); }
        }
#if MK_ONE_LAUNCH
        if constexpr (TIME_MASK != 0) if (ph + 1 >= ph_hi) { if (ptype & TIME_MASK) t_acc += __builtin_amdgcn_s_memrealtime() - t_ph0; }
        if (ph + 1 < ph_hi) {
            XcdBarrier xbar; xbar.bar = (unsigned*)(Ap->ws + WS_BAR); xbar.x = xb_xcc_id(); xbar.st = (volatile LAS unsigned*)(lds + LDS_XB_OFF);
            if (ph == ph_lo) { cg::this_grid().sync(); if (tid0 == 0) (void)xb_add(&xbar.bar[XB_XCNT(xbar.x)], 1u); }
            else { xcd_barrier(xbar); if constexpr ((DUP_MASK & 0x800) != 0) xcd_barrier(xbar); }
            if constexpr (TIME_MASK != 0) { if (ptype & TIME_MASK) t_acc += __builtin_amdgcn_s_memrealtime() - t_ph0; }
        }
#endif
    }
    if constexpr (TIME_MASK != 0) { const unsigned long long t0 = __builtin_amdgcn_s_memrealtime(); while (__builtin_amdgcn_s_memrealtime() - t0 < 4ull * t_acc) __builtin_amdgcn_s_sleep(8); }
}

extern "C" void kernel_launch(void* const* d_in, const int* in_sizes, int n_in, void* d_out, int out_size, void* d_ws, size_t ws_size, hipStream_t stream) {
    static int grid = 0;
    if (grid == 0) {
        if (n_in != 23 || in_sizes[0] != MTOK * DM || out_size != MTOK * DM || ws_size < WS_END) {
            fprintf(stderr, "kernel_launch: unexpected shapes (n_in %d, in0 %d, out %d, ws %zu; need ws >= %zu); nothing launched\n", n_in, n_in > 0 ? in_sizes[0] : -1, out_size, ws_size, (size_t)WS_END); grid = -1; return; }
        int dev = 0, cus = 0, per_cu = 0;
        if (hipGetDevice(&dev) != hipSuccess || hipDeviceGetAttribute(&cus, hipDeviceAttributeMultiprocessorCount, dev) != hipSuccess) { grid = -1; return; }
        if (hipFuncSetAttribute((const void*)trunk_fwd, hipFuncAttributeMaxDynamicSharedMemorySize, LDS_BYTES) != hipSuccess) { fprintf(stderr, "kernel_launch: hipFuncSetAttribute failed\n"); grid = -1; return; }
        if (hipOccupancyMaxActiveBlocksPerMultiprocessor(&per_cu, (const void*)trunk_fwd, NTHREADS, LDS_BYTES) != hipSuccess || per_cu < 1) { fprintf(stderr, "kernel_launch: occupancy query says %d blocks per CU\n", per_cu); (void)hipGetLastError(); grid = -1; return; }
        grid = cus * (per_cu < 1 ? 1 : 1);
    }
    if (grid < 0) return;
    Args a{};
    for (int i = 0; i < 23; ++i) a.in[i] = (const float*)d_in[i];
    a.out = (float*)d_out; a.ws = (unsigned char*)d_ws;
#if MK_ONE_LAUNCH
    a.ph_lo = 0; a.ph_hi = NPHASES;
    void* args[] = {&a};
    hipError_t e = hipLaunchCooperativeKernel((const void*)trunk_fwd, dim3(grid), dim3(NTHREADS), args, LDS_BYTES, stream);
    if (e != hipSuccess) fprintf(stderr, "cooperative launch failed: %s (grid %d)\n", hipGetErrorString(e), grid);
#else
    for (int ph = 0; ph < NPHASES; ++ph) { a.ph_lo = ph; a.ph_hi = ph + 1; hipLaunchKernelGGL(trunk_fwd, dim3(grid), dim3(NTHREADS), LDS_BYTES, stream, a); }
#endif
}
```

```cpp
#include <hip/hip_runtime.h>
#include <hip/hip_cooperative_groups.h>
#include <cstdio>
#include <cstdint>
namespace cg = cooperative_groups;

#ifndef MK_ONE_LAUNCH
#define MK_ONE_LAUNCH 1
#endif

#define LAS __attribute__((address_space(3)))
typedef unsigned short bf16_t;
typedef short bf16x8 __attribute__((ext_vector_type(8)));
typedef float f32x2 __attribute__((ext_vector_type(2)));
typedef float f32x4 __attribute__((ext_vector_type(4)));
typedef float f32x16 __attribute__((ext_vector_type(16)));
typedef unsigned u32x2 __attribute__((ext_vector_type(2)));
typedef unsigned u32x4 __attribute__((ext_vector_type(4)));
typedef int i32x4 __attribute__((ext_vector_type(4)));
typedef __bf16 bf16x2 __attribute__((ext_vector_type(2)));

constexpr int DM = 1024, BATCH = 8, SEQ = 4096, MTOK = BATCH * SEQ, DEPTH = 4;
constexpr int GH = 3072;
constexpr int NEXP = 16384, NPICK = 128;
constexpr float EPS = 1e-6f;

constexpr size_t MiB = 1u << 20;
constexpr size_t WS_CTL = 0, WS_SCU = 0, WS_SCV = 512 * 1024, WS_MOD = 1 * MiB, ZERO_BYTES = 2 * MiB;
constexpr size_t WS_POOL_WIN = 2 * MiB, WS_POOL_WGRP = 6 * MiB, WS_POOL_WOUT = 7 * MiB;
constexpr size_t WS_CONV_WIN = 11 * MiB, WS_CONV_WOUT = 17 * MiB;
constexpr size_t WS_GMLP_WIN = 19 * MiB, WS_GMLP_WOUT = 31 * MiB;
constexpr size_t WS_PEER_WQ = 37 * MiB, WS_KEYS = 53 * MiB;
constexpr size_t WS_H = 56 * MiB;
constexpr size_t WS_SELI = 120 * MiB, WS_SELW = 136 * MiB;
constexpr size_t WS_TABU = 152 * MiB, WS_TABV = 280 * MiB;
constexpr size_t WS_MIX = 408 * MiB;
constexpr size_t WS_ADAP = 792 * MiB;
constexpr size_t WS_COEF = 804 * MiB;
constexpr size_t WS_WEFF = 820 * MiB;
constexpr size_t WS_WGS = 824 * MiB;
constexpr size_t WS_END = 825 * MiB;

__device__ __forceinline__ unsigned cvt_pk_bf16(float lo, float hi) { unsigned r; asm volatile("v_cvt_pk_bf16_f32 %0, %1, %2" : "=v"(r) : "v"(lo), "v"(hi)); return r; }
__device__ __forceinline__ int opaque(int x) { asm volatile("" : "+v"(x)); return x; }
__device__ __forceinline__ float bf_lo(unsigned w) { return __uint_as_float(w << 16); }
__device__ __forceinline__ float bf_hi(unsigned w) { return __uint_as_float(w & 0xffff0000u); }
__device__ __forceinline__ float gelu_tanh(float x) {
    const float y = x * (1.0f + 0.044715f * x * x);
    const float e = __builtin_amdgcn_exp2f(-2.302208198f * y);
    return x * __builtin_amdgcn_rcpf(1.0f + e);
}
__device__ __forceinline__ float wave_sum_all(float v) {
#pragma unroll
    for (int o = 1; o < 64; o <<= 1) v += __shfl_xor(v, o);
    return v;
}
__device__ __forceinline__ float dot2_bf16(unsigned w, unsigned x, float acc) { return __builtin_amdgcn_fdot2_f32_bf16(__builtin_bit_cast(bf16x2, w), __builtin_bit_cast(bf16x2, x), acc, false); }


__device__ __forceinline__ float dpp_row_shr(float v, int n) {
    const int iv = __builtin_bit_cast(int, v); int r;
    switch (n) { case 1: r = __builtin_amdgcn_update_dpp(0, iv, 0x111, 0xf, 0xf, true); break; case 2: r = __builtin_amdgcn_update_dpp(0, iv, 0x112, 0xf, 0xf, true); break;
                 case 4: r = __builtin_amdgcn_update_dpp(0, iv, 0x114, 0xf, 0xf, true); break; default: r = __builtin_amdgcn_update_dpp(0, iv, 0x118, 0xf, 0xf, true); break; }
    return __builtin_bit_cast(float, r);
}
__device__ __forceinline__ float wave_sum_uniform(float v) {
    v += dpp_row_shr(v, 1); v += dpp_row_shr(v, 2); v += dpp_row_shr(v, 4); v += dpp_row_shr(v, 8);
    v += __builtin_bit_cast(float, __builtin_amdgcn_update_dpp(0, __builtin_bit_cast(int, v), 0x142, 0xa, 0xf, false));
    v += __builtin_bit_cast(float, __builtin_amdgcn_update_dpp(0, __builtin_bit_cast(int, v), 0x143, 0xc, 0xf, false));
    return __uint_as_float(__builtin_amdgcn_readlane(__float_as_uint(v), 63));
}

namespace pg8 {
constexpr int BM = 256, BK = 64, HALF = 128, HTB = HALF * BK * 2, STAGE_BYTES = 8 * HTB, NXCD = 8, WGM = 8;
__device__ __forceinline__ int lds_byte(int r, int c) { const int st = (r >> 4) * 2 + (c >> 5), rr = r & 15, cc = c & 31, ob = rr * 64 + cc * 2; return st * 1024 + (ob ^ (((ob >> 9) & 1) << 5)); }
__device__ __forceinline__ void stage_rc(int b, int& R, int& C) { const int st = b / 1024, sb = b % 1024, swz = sb ^ (((sb >> 9) & 1) << 5); R = (st >> 1) * 16 + swz / 64; C = (st & 1) * 32 + (swz % 64) / 2; }
__device__ __forceinline__ int perm32(int rho) { const int n = rho >> 4, i = rho & 15; return 8 * (i >> 2) + 4 * n + (i & 3); }

struct Unit { int pm, pn; };
struct Gemm { const bf16_t* A; const bf16_t* Bt; int M, N, K, lda, ldb, a_pn_off; };

struct StaticOrder {
    int nM, nN, nwg, G, c;
    __device__ __forceinline__ void init(int M, int N, int G_, int c_) { nM = M / BM; nN = N / BM; nwg = nM * nN; G = G_; c = c_; }
    __device__ __forceinline__ bool next(int i, Unit& u) const {
        const int L = i * G + c; if (L >= nwg) return false;
        int wgid = L; { const int q = nwg / NXCD, r = nwg % NXCD, xcd = wgid % NXCD, off = wgid / NXCD; wgid = (xcd < r ? xcd * (q + 1) : r * (q + 1) + (xcd - r) * q) + off; }
        const int nig = WGM * nN, gid = wgid / nig, fm = gid * WGM, gsz = (nM - fm) < WGM ? (nM - fm) : WGM;
        u.pm = fm + ((wgid % nig) % gsz); u.pn = (wgid % nig) / gsz; return true;
    }
};

template <class Epi>
__device__ __forceinline__ void gemm_phase(LAS unsigned char* lds, const Gemm g, const StaticOrder& S, const Epi& E) {
    const int tid = opaque((int)threadIdx.x), wid = __builtin_amdgcn_readfirstlane(tid >> 6), lane = tid & 63, wr = wid >> 2, wc = wid & 3, fr = lane & 15, fq = lane >> 4;
    int nt = g.K / BK; asm volatile("" : "+s"(nt));
    unsigned voffA[2], voffB[2];
#pragma unroll
    for (int i = 0; i < 2; ++i) { int R, C; stage_rc(tid * 16 + i * 8192, R, C); const int Rb = Epi::PERM ? ((R & ~31) + perm32(R & 31)) : R;
        voffA[i] = (unsigned)(R * g.lda + C) * 2u; voffB[i] = (unsigned)(Rb * g.ldb + C) * 2u; }
    const size_t kstep = (size_t)(BK * 2);
    const size_t hstepA = (size_t)HALF * g.lda * 2, hstepB = (size_t)HALF * g.ldb * 2;
    const size_t tstepA = 2 * hstepA, tstepB = 2 * hstepB;
    const unsigned ldsw = (unsigned)wid * 1024u;
    const int aoff = lds_byte(wr * 64 + fr, fq * 8), boff = lds_byte(wc * 32 + fr, fq * 8);
#define PG8_SA(b, h) (((b) * 2 + (h)) * HTB)
#define PG8_SB(b, h) ((4 + (b) * 2 + (h)) * HTB)
#define PG8_STAGE(bufoff, gbase, voff) do { _Pragma("unroll") for (int _i = 0; _i < 2; ++_i) \
        __builtin_amdgcn_global_load_lds((const unsigned*)((const char*)(gbase) + (voff)[_i]), (LAS unsigned*)(lds + (bufoff) + ldsw + _i * 8192), 16, 0, 0); } while (0)
#define PG8_LDA(dst, b, h) do { _Pragma("unroll") for (int m = 0; m < 4; ++m) _Pragma("unroll") for (int k = 0; k < 2; ++k) dst[m][k] = *(const LAS bf16x8*)(lds + PG8_SA(b, h) + aoff + m * 2048 + k * 1024); } while (0)
#define PG8_LDB(dst, b, h) do { _Pragma("unroll") for (int n = 0; n < 2; ++n) _Pragma("unroll") for (int k = 0; k < 2; ++k) dst[n][k] = *(const LAS bf16x8*)(lds + PG8_SB(b, h) + boff + n * 2048 + k * 1024); } while (0)
#define PG8_MMA(ai, bj, At, Bt) do { __builtin_amdgcn_s_setprio(1); _Pragma("unroll") for (int m = 0; m < 4; ++m) _Pragma("unroll") for (int n = 0; n < 2; ++n) _Pragma("unroll") for (int k = 0; k < 2; ++k) \
        acc[ai][bj][m][n] = Epi::SWAP ? __builtin_amdgcn_mfma_f32_16x16x32_bf16(At[m][k], Bt[n][k], acc[ai][bj][m][n], 0, 0, 0) \
                                      : __builtin_amdgcn_mfma_f32_16x16x32_bf16(Bt[n][k], At[m][k], acc[ai][bj][m][n], 0, 0, 0); __builtin_amdgcn_s_setprio(0); } while (0)
#define PG8_WAIT_V(n) asm volatile("s_waitcnt vmcnt(" #n ")" ::: "memory")
#define PG8_WAIT_L(n) asm volatile("s_waitcnt lgkmcnt(" #n ")" ::: "memory")
#define PG8_BAR __builtin_amdgcn_s_barrier()
#define PG8_SCHED __builtin_amdgcn_sched_barrier(0)
    Unit cur, nxt; int ui = 0;
    if (!S.next(0, cur)) return;
    f32x4 acc[2][2][4][2];
#pragma unroll
    for (int a = 0; a < 2; ++a)
#pragma unroll
        for (int b = 0; b < 2; ++b)
#pragma unroll
            for (int m = 0; m < 4; ++m)
#pragma unroll
                for (int n = 0; n < 2; ++n) acc[a][b][m][n] = (f32x4){0.f, 0.f, 0.f, 0.f};
    bf16x8 At[4][2], B0[2][2], B1[2][2];
    const char* cA = (const char*)g.A + (size_t)cur.pm * tstepA + (size_t)cur.pn * g.a_pn_off * 2; const char* cB = (const char*)g.Bt + (size_t)cur.pn * tstepB;
    PG8_STAGE(PG8_SB(0, 0), cB, voffB); PG8_STAGE(PG8_SB(0, 1), cB + hstepB, voffB); PG8_STAGE(PG8_SA(0, 0), cA, voffA); PG8_STAGE(PG8_SA(0, 1), cA + hstepA, voffA);
    if (wr == 1) PG8_BAR;
    PG8_WAIT_V(2); PG8_BAR;
    PG8_STAGE(PG8_SB(1, 0), cB + kstep, voffB); PG8_STAGE(PG8_SA(1, 0), cA + kstep, voffA); PG8_STAGE(PG8_SB(1, 1), cB + hstepB + kstep, voffB);
    PG8_WAIT_V(6); PG8_BAR;
    for (;;) {
        const bool has_next = S.next(ui + 1, nxt);
        const char* nA = has_next ? (const char*)g.A + (size_t)nxt.pm * tstepA + (size_t)nxt.pn * g.a_pn_off * 2 : cA; const char* nB = has_next ? (const char*)g.Bt + (size_t)nxt.pn * tstepB : cB;
        for (int t = 0; t < nt; t += 2) {
            const bool last = (t == nt - 2);
            const char* a1 = cA + (size_t)(t + 1) * kstep;
            const char* a2 = last ? nA : cA + (size_t)(t + 2) * kstep; const char* b2 = last ? nB : cB + (size_t)(t + 2) * kstep;
            const char* a3 = a2 + kstep; const char* b3 = b2 + kstep;
            PG8_LDB(B0, 0, 0); PG8_LDB(B1, 0, 1); PG8_SCHED; PG8_LDA(At, 0, 0); PG8_STAGE(PG8_SA(1, 1), a1 + hstepA, voffA);
            PG8_WAIT_V(8); PG8_WAIT_L(0); PG8_BAR; PG8_MMA(0, 0, At, B0); PG8_MMA(0, 1, At, B1); PG8_BAR; PG8_SCHED;
            PG8_LDA(At, 0, 1); PG8_STAGE(PG8_SB(0, 0), b2, voffB); PG8_STAGE(PG8_SB(0, 1), b2 + hstepB, voffB); PG8_STAGE(PG8_SA(0, 0), a2, voffA);
            PG8_WAIT_V(8); PG8_WAIT_L(0); PG8_BAR; PG8_MMA(1, 0, At, B0); PG8_MMA(1, 1, At, B1); PG8_BAR; PG8_SCHED;
            PG8_LDB(B0, 1, 0); PG8_LDB(B1, 1, 1); PG8_SCHED; PG8_LDA(At, 1, 0); PG8_STAGE(PG8_SA(0, 1), a2 + hstepA, voffA);
            PG8_WAIT_V(8); PG8_WAIT_L(0); PG8_BAR; PG8_MMA(0, 0, At, B0); PG8_MMA(0, 1, At, B1); PG8_BAR; PG8_SCHED;
            PG8_LDA(At, 1, 1); PG8_STAGE(PG8_SB(1, 0), b3, voffB); PG8_STAGE(PG8_SB(1, 1), b3 + hstepB, voffB); PG8_STAGE(PG8_SA(1, 0), a3, voffA);
            PG8_WAIT_V(8); PG8_WAIT_L(0); PG8_BAR; PG8_MMA(1, 0, At, B0); PG8_MMA(1, 1, At, B1); PG8_BAR; PG8_SCHED;
        }
        { const int l2 = opaque((int)threadIdx.x) & 63; E(acc, cur, wr, wc, l2 & 15, l2 >> 4); }
        if (!has_next) break;
#pragma unroll
        for (int a = 0; a < 2; ++a)
#pragma unroll
            for (int b = 0; b < 2; ++b)
#pragma unroll
                for (int m = 0; m < 4; ++m)
#pragma unroll
                    for (int n = 0; n < 2; ++n) acc[a][b][m][n] = (f32x4){0.f, 0.f, 0.f, 0.f};
        cur = nxt; cA = nA; cB = nB; ++ui;
    }
    PG8_WAIT_V(0);
    if (wr == 0) PG8_BAR;
    PG8_BAR;
#undef PG8_SA
#undef PG8_SB
#undef PG8_STAGE
#undef PG8_LDA
#undef PG8_LDB
#undef PG8_MMA
#undef PG8_WAIT_V
#undef PG8_WAIT_L
#undef PG8_BAR
#undef PG8_SCHED
}

template <int ACT> struct EpiBf16 {
    static constexpr bool PERM = true, SWAP = false;
    bf16_t* O; int ldc;
    __device__ __forceinline__ void operator()(const f32x4 (&acc)[2][2][4][2], const Unit& u, int wr, int wc, int fr, int fq) const {
        const int row0 = u.pm * BM + wr * 64 + fr, col0 = u.pn * BM + wc * 32 + 8 * fq;
#pragma unroll
        for (int ai = 0; ai < 2; ++ai)
#pragma unroll
            for (int m = 0; m < 4; ++m) { bf16_t* rowp = O + (size_t)(row0 + ai * HALF + m * 16) * ldc + col0;
#pragma unroll
                for (int bj = 0; bj < 2; ++bj) { f32x4 v0 = acc[ai][bj][m][0], v1 = acc[ai][bj][m][1];
                    if (ACT == 1) {
#pragma unroll
                        for (int j = 0; j < 4; ++j) { v0[j] = gelu_tanh(v0[j]); v1[j] = gelu_tanh(v1[j]); } }
                    u32x4 w; w.x = cvt_pk_bf16(v0[0], v0[1]); w.y = cvt_pk_bf16(v0[2], v0[3]); w.z = cvt_pk_bf16(v1[0], v1[1]); w.w = cvt_pk_bf16(v1[2], v1[3]);
                    *(u32x4*)(rowp + bj * HALF) = w; } }
    }
};
struct EpiQT {
    static constexpr bool PERM = true, SWAP = false;
    bf16_t* O;
    __device__ __forceinline__ void operator()(const f32x4 (&acc)[2][2][4][2], const Unit& u, int wr, int wc, int fr, int fq) const {
        const int row0 = u.pm * BM + wr * 64 + fr;
#pragma unroll
        for (int ai = 0; ai < 2; ++ai)
#pragma unroll
            for (int m = 0; m < 4; ++m) { const int row = row0 + ai * HALF + m * 16;
                bf16_t* base = O + ((size_t)((row >> 7) * 8 + u.pn) * 32 * 128 + (row & 127)) * 8;
#pragma unroll
                for (int bj = 0; bj < 2; ++bj) { const f32x4 v0 = acc[ai][bj][m][0], v1 = acc[ai][bj][m][1];
                    u32x4 w; w.x = cvt_pk_bf16(v0[0], v0[1]); w.y = cvt_pk_bf16(v0[2], v0[3]); w.z = cvt_pk_bf16(v1[0], v1[1]); w.w = cvt_pk_bf16(v1[2], v1[3]);
                    *(u32x4*)(base + (size_t)(16 * bj + 4 * wc + fq) * 128 * 8) = w; } }
    }
};
struct EpiPoolGrp {
    static constexpr bool PERM = true, SWAP = false;
    bf16_t* O; const float* scale;
    __device__ __forceinline__ void operator()(const f32x4 (&acc)[2][2][4][2], const Unit& u, int wr, int wc, int fr, int fq) const {
        const int row0 = u.pm * BM + wr * 64 + fr, col0 = u.pn * BM + wc * 32 + 8 * fq;
#pragma unroll
        for (int bj = 0; bj < 2; ++bj) {
            const f32x4 s0 = *(const f32x4*)(scale + col0 + bj * HALF), s1 = *(const f32x4*)(scale + col0 + bj * HALF + 4);
#pragma unroll
            for (int ai = 0; ai < 2; ++ai)
#pragma unroll
                for (int m = 0; m < 4; ++m) { bf16_t* rowp = O + (size_t)(row0 + ai * HALF + m * 16) * DM + col0 + bj * HALF;
                    const f32x4 v0 = acc[ai][bj][m][0] * s0, v1 = acc[ai][bj][m][1] * s1;
                    u32x4 w; w.x = cvt_pk_bf16(v0[0], v0[1]); w.y = cvt_pk_bf16(v0[2], v0[3]); w.z = cvt_pk_bf16(v1[0], v1[1]); w.w = cvt_pk_bf16(v1[2], v1[3]);
                    *(u32x4*)rowp = w; }
            asm volatile("" ::: "memory");
        }
    }
};
struct EpiConvIn {
    static constexpr bool PERM = true, SWAP = false;
    bf16_t* BG; bf16_t* Z;
    __device__ __forceinline__ void operator()(const f32x4 (&acc)[2][2][4][2], const Unit& u, int wr, int wc, int fr, int fq) const {
        const int row0 = u.pm * BM + wr * 64 + fr;
        if (u.pn < 4) {
            const int col0 = u.pn * BM + wc * 32 + 8 * fq;
#pragma unroll
            for (int ai = 0; ai < 2; ++ai)
#pragma unroll
                for (int m = 0; m < 4; ++m) { bf16_t* rowp = BG + (size_t)(row0 + ai * HALF + m * 16) * DM + col0;
#pragma unroll
                    for (int bj = 0; bj < 2; ++bj) { const f32x4 v0 = acc[ai][bj][m][0], v1 = acc[ai][bj][m][1];
                        u32x4 w; w.x = cvt_pk_bf16(v0[0], v0[1]); w.y = cvt_pk_bf16(v0[2], v0[3]); w.z = cvt_pk_bf16(v1[0], v1[1]); w.w = cvt_pk_bf16(v1[2], v1[3]);
                        *(u32x4*)(rowp + bj * HALF) = w; } }
        } else {
            const int col0 = (u.pn - 4) * HALF + wc * 32 + 8 * fq;
#pragma unroll
            for (int ai = 0; ai < 2; ++ai)
#pragma unroll
                for (int m = 0; m < 4; ++m) { bf16_t* rowp = Z + (size_t)(row0 + ai * HALF + m * 16) * DM + col0;
                    const f32x4 v0 = acc[ai][0][m][0] * acc[ai][1][m][0], v1 = acc[ai][0][m][1] * acc[ai][1][m][1];
                    u32x4 w; w.x = cvt_pk_bf16(v0[0], v0[1]); w.y = cvt_pk_bf16(v0[2], v0[3]); w.z = cvt_pk_bf16(v1[0], v1[1]); w.w = cvt_pk_bf16(v1[2], v1[3]);
                    *(u32x4*)rowp = w; }
        }
    }
};
struct EpiResid {
    static constexpr bool PERM = false, SWAP = false;
    const float* base; float* out; const float* gacc; const float* gbias;
    __device__ __forceinline__ void operator()(const f32x4 (&acc)[2][2][4][2], const Unit& u, int wr, int wc, int fr, int fq) const {
        const int row0 = u.pm * BM + wr * 64 + fr, col0 = u.pn * BM + wc * 32 + 4 * fq;
        const float* gp = gacc + (size_t)(u.pm >> 4) * (6 * DM);
#pragma unroll
        for (int bj = 0; bj < 2; ++bj)
#pragma unroll
            for (int n = 0; n < 2; ++n) { const int cc = col0 + bj * HALF + n * 16;
                const f32x4 gv = *(const f32x4*)(gp + cc);
#pragma unroll
                for (int ai = 0; ai < 2; ++ai) {
#pragma unroll
                    for (int m = 0; m < 4; ++m) { const size_t off = (size_t)(row0 + ai * HALF + m * 16) * DM + cc;
                        const f32x4 bs = *(const f32x4*)(base + off);
                        *(f32x4*)(out + off) = bs + gv * acc[ai][bj][m][n]; }
                    asm volatile("" ::: "memory"); } }
    }
};
struct EpiGmlpV {
    static constexpr bool PERM = false, SWAP = true;
    bf16_t* VT;
    __device__ __forceinline__ void operator()(const f32x4 (&acc)[2][2][4][2], const Unit& u, int wr, int wc, int fr, int fq) const {
        const int row0 = u.pm * BM + wr * 64 + 4 * fq, col0 = u.pn * BM + wc * 32 + fr;
#pragma unroll
        for (int bj = 0; bj < 2; ++bj)
#pragma unroll
            for (int n = 0; n < 2; ++n) { const int c = col0 + bj * HALF + n * 16;
#pragma unroll
                for (int ai = 0; ai < 2; ++ai)
#pragma unroll
                    for (int m = 0; m < 4; ++m) { const f32x4 v = acc[ai][bj][m][n]; const int r = row0 + ai * HALF + m * 16;
                        u32x2 w; w.x = cvt_pk_bf16(gelu_tanh(v[0]), gelu_tanh(v[1])); w.y = cvt_pk_bf16(gelu_tanh(v[2]), gelu_tanh(v[3]));
                        *(u32x2*)(VT + ((size_t)(r >> 7) * GH + c) * 128 + (r & 127)) = w; } }
    }
};
}

constexpr int RING_BYTES = 131072;
constexpr int LDS_BYTES = 147456;
constexpr int LDS_XB_OFF = LDS_BYTES - 64;
constexpr int NTHREADS = 512;

#define CE_DESC(a, b) do { const float _x = fmaxf(a, b), _y = fminf(a, b); a = _x; b = _y; } while (0)
#define CE_ASC(a, b)  do { const float _x = fminf(a, b), _y = fmaxf(a, b); a = _x; b = _y; } while (0)
template <int OFF, int N>
__device__ __forceinline__ void sort16_desc(float (&v)[N]) {
#pragma unroll
    for (int k = 2; k <= 16; k <<= 1)
#pragma unroll
        for (int j = k >> 1; j > 0; j >>= 1)
#pragma unroll
            for (int i = 0; i < 16; ++i) { const int l = i ^ j; if (l > i) { if ((i & k) == 0) CE_DESC(v[OFF + i], v[OFF + l]); else CE_ASC(v[OFF + i], v[OFF + l]); } }
}
template <int OFF, int N>
__device__ __forceinline__ void bmerge16_desc(float (&v)[N]) {
#pragma unroll
    for (int j = 8; j > 0; j >>= 1)
#pragma unroll
        for (int i = 0; i < 16; ++i) { const int l = i ^ j; if (l > i) CE_DESC(v[OFF + i], v[OFF + l]); }
}
template <int A, int B, int N>
__device__ __forceinline__ void merge_top16(float (&v)[N]) {
#pragma unroll
    for (int i = 0; i < 16; ++i) v[A + i] = fmaxf(v[A + i], v[B + 15 - i]);
    bmerge16_desc<A, N>(v);
}
__device__ __forceinline__ void top16_of_64(float (&v)[64]) {
    sort16_desc<0, 64>(v); sort16_desc<16, 64>(v); sort16_desc<32, 64>(v); sort16_desc<48, 64>(v);
    merge_top16<0, 16, 64>(v); merge_top16<32, 48, 64>(v); merge_top16<0, 32, 64>(v);
}

struct Args { const float* in[23]; float* out; unsigned char* ws; int ph_lo, ph_hi; };
typedef const __attribute__((address_space(4))) Args* ArgP;
enum { I_X = 0, I_C, I_ADA_W, I_ADA_B, I_NORM_G, I_POOL_WIN, I_POOL_WGRP, I_POOL_SCALE, I_POOL_WOUT, I_CONV_WIN, I_CONV_W, I_CONV_WOUT,
       I_GMLP_WIN, I_GMLP_LNG, I_GMLP_LNB, I_GMLP_WS, I_GMLP_BS, I_GMLP_WOUT, I_PEER_WQ, I_PEER_KEYS, I_PEER_U, I_PEER_V, I_FINAL_G };

__device__ __forceinline__ void transpose_item(const float* W, int K, int N, bf16_t* WT, int dst_row0, LAS float* scr, int k0, int n0, int lane) {
#pragma unroll 8
    for (int i = 0; i < 32; ++i) { const int kk = 2 * i + (lane >> 5); scr[kk * 33 + (lane & 31)] = W[(size_t)(k0 + kk) * N + n0 + (lane & 31)]; }
    asm volatile("s_waitcnt lgkmcnt(0)" ::: "memory");
    const int c = lane & 7;
#pragma unroll
    for (int j = 0; j < 4; ++j) { const int n = (lane >> 3) + 8 * j; const LAS float* s = scr + (8 * c) * 33 + n;
        u32x4 o; o.x = cvt_pk_bf16(s[0 * 33], s[1 * 33]); o.y = cvt_pk_bf16(s[2 * 33], s[3 * 33]); o.z = cvt_pk_bf16(s[4 * 33], s[5 * 33]); o.w = cvt_pk_bf16(s[6 * 33], s[7 * 33]);
        *(u32x4*)(WT + (size_t)(dst_row0 + n) * K + k0 + 8 * c) = o; }
    asm volatile("s_waitcnt lgkmcnt(0)" ::: "memory");
}
__device__ __forceinline__ void convert_stream(const float* src, bf16_t* dst, size_t n8, size_t gt, size_t stride) {
    for (size_t i = gt; i < n8; i += stride) {
        const f32x4 a = __builtin_nontemporal_load((const f32x4*)src + 2 * i), b = __builtin_nontemporal_load((const f32x4*)src + 2 * i + 1);
        u32x4 o; o.x = cvt_pk_bf16(a[0], a[1]); o.y = cvt_pk_bf16(a[2], a[3]); o.z = cvt_pk_bf16(b[0], b[1]); o.w = cvt_pk_bf16(b[2], b[3]);
        *((u32x4*)dst + i) = o; }
}
__device__ __forceinline__ void prologue_phase(ArgP Ap, LAS unsigned char* lds, int vcu, int G, int tid, int wid, int lane) {
    unsigned char* ws = Ap->ws;
    const int gw = vcu * 8 + wid, NGW = G * 8;
    LAS float* scr = (LAS float*)(lds + wid * 16384);
    constexpr int NT_ITEMS = 1024 + 256 + 1024 + 1536 + 512 + 3072 + 1536 + 4096;
    for (int it = gw; it < NT_ITEMS; it += NGW) {
        int r = it; const float* src; bf16_t* dst; int K, N, kind = 0;
        if (r < 1024) { const int m = r >> 9; r &= 511; src = Ap->in[I_POOL_WIN] + (size_t)m * DM * DM; dst = (bf16_t*)(ws + WS_POOL_WIN) + (size_t)m * DM * DM; K = DM; N = DM; }
        else if ((r -= 1024) < 256) { const int m = r >> 5; r &= 31; src = Ap->in[I_POOL_WGRP] + (size_t)m * 65536; dst = (bf16_t*)(ws + WS_POOL_WGRP) + (size_t)m * 65536; K = 256; N = 256; }
        else if ((r -= 256) < 1024) { const int m = r >> 9; r &= 511; src = Ap->in[I_POOL_WOUT] + (size_t)m * DM * DM; dst = (bf16_t*)(ws + WS_POOL_WOUT) + (size_t)m * DM * DM; K = DM; N = DM; }
        else if ((r -= 1024) < 1536) { src = Ap->in[I_CONV_WIN]; dst = (bf16_t*)(ws + WS_CONV_WIN); K = DM; N = 3 * DM; kind = 1; }
        else if ((r -= 1536) < 512) { src = Ap->in[I_CONV_WOUT]; dst = (bf16_t*)(ws + WS_CONV_WOUT); K = DM; N = DM; }
        else if ((r -= 512) < 3072) { src = Ap->in[I_GMLP_WIN]; dst = (bf16_t*)(ws + WS_GMLP_WIN); K = DM; N = 2 * GH; }
        else if ((r -= 3072) < 1536) { src = Ap->in[I_GMLP_WOUT]; dst = (bf16_t*)(ws + WS_GMLP_WOUT); K = GH; N = DM; }
        else { r -= 1536; const int m = r >> 10; r &= 1023; src = Ap->in[I_PEER_WQ] + (size_t)m * DM * 2048; dst = (bf16_t*)(ws + WS_PEER_WQ) + (size_t)m * DM * 2048; K = DM; N = 2048; }
        const int nblk = N / 32, kb = r / nblk, nb = r % nblk, n0 = 32 * nb;
        int drow = n0;
        if (kind == 1 && n0 >= DM) { const int xt = n0 >= 2 * DM, ch = n0 - (xt ? 2 * DM : DM); drow = DM + 256 * (ch >> 7) + 128 * xt + (ch & 127); }
        transpose_item(src, K, N, dst, drow, scr, 64 * kb, n0, lane);
    }
    const size_t gt = (size_t)vcu * NTHREADS + tid, stride = (size_t)G * NTHREADS;
    convert_stream(Ap->in[I_PEER_KEYS], (bf16_t*)(ws + WS_KEYS), (size_t)DEPTH * 16 * 128 * 128 / 8, gt, stride);
    for (int row0 = gw * 4; row0 < 2 * DEPTH * NEXP; row0 += NGW * 4) {
        f32x4 v[4][4]; float m[4];
#pragma unroll
        for (int rr = 0; rr < 4; ++rr) { const int row = row0 + rr, tab = row >> 16, lrow = row & 65535;
            const f32x4* src = (const f32x4*)((tab ? Ap->in[I_PEER_V] : Ap->in[I_PEER_U]) + (size_t)lrow * DM) + lane;
#pragma unroll
            for (int j = 0; j < 4; ++j) v[rr][j] = __builtin_nontemporal_load(src + 64 * j); }
#pragma unroll
        for (int rr = 0; rr < 4; ++rr) { float mm = 0.f;
#pragma unroll
            for (int j = 0; j < 4; ++j) mm = fmaxf(fmaxf(mm, fmaxf(fabsf(v[rr][j][0]), fabsf(v[rr][j][1]))), fmaxf(fabsf(v[rr][j][2]), fabsf(v[rr][j][3])));
#pragma unroll
            for (int o = 1; o < 64; o <<= 1) mm = fmaxf(mm, __shfl_xor(mm, o));
            m[rr] = mm; }
#pragma unroll
        for (int rr = 0; rr < 4; ++rr) { const int row = row0 + rr, tab = row >> 16, lrow = row & 65535, l = lrow >> 14, e = lrow & (NEXP - 1);
            const float S = m[rr] > 0.f ? 256.0f / m[rr] : 1.0f;
            unsigned char* dst = ws + (tab ? WS_TABV : WS_TABU);
#pragma unroll
            for (int j = 0; j < 4; ++j) { int pk = __builtin_amdgcn_cvt_pk_fp8_f32(v[rr][j][0] * S, v[rr][j][1] * S, 0, false); pk = __builtin_amdgcn_cvt_pk_fp8_f32(v[rr][j][2] * S, v[rr][j][3] * S, pk, true);
                const int d0 = 256 * j + 4 * lane;
                *(int*)(dst + (((size_t)l * 8 + (d0 >> 7)) * NEXP + e) * 128 + (d0 & 127)) = pk; }
            if (lane == 0) ((unsigned short*)(ws + WS_SCU))[2 * lrow + tab] = (unsigned short)(cvt_pk_bf16(m[rr] > 0.f ? m[rr] * (1.0f / 256.0f) : 1.0f, 0.f) & 0xffffu); }
    }
    for (size_t i = gt; i < (size_t)2 * 4 * 256 * 256 / 8; i += stride) { const size_t idx = i * 8; const int l = (int)(idx >> 18), g = (int)(idx >> 16) & 3, j0 = (int)idx & 255;
        const f32x4 a = *((const f32x4*)Ap->in[I_POOL_WGRP] + 2 * i), b = *((const f32x4*)Ap->in[I_POOL_WGRP] + 2 * i + 1);
        const float* sp = Ap->in[I_POOL_SCALE] + (size_t)l * DM + 256 * g + j0; const f32x4 sa = *(const f32x4*)sp, sb = *(const f32x4*)(sp + 4);
        u32x4 o; o.x = cvt_pk_bf16(a[0] * sa[0], a[1] * sa[1]); o.y = cvt_pk_bf16(a[2] * sa[2], a[3] * sa[3]); o.z = cvt_pk_bf16(b[0] * sb[0], b[1] * sb[1]); o.w = cvt_pk_bf16(b[2] * sb[2], b[3] * sb[3]);
        *((u32x4*)(ws + WS_WGS) + i) = o; }
    __syncthreads();
    LAS float* cond = (LAS float*)lds;
    for (int i = tid; i < BATCH * DM; i += NTHREADS) { const int b = i >> 10, k = i & 1023; const float c = Ap->in[I_C][i]; cond[k * 8 + b] = c * __builtin_amdgcn_rcpf(1.0f + __expf(-c)); }
    __syncthreads();
    float* modp = (float*)(ws + WS_ADAP);
    for (int it = gw; it < DEPTH * 24 * 16; it += NGW) {
        const int l = it / 384, r = it % 384, cgp = r >> 4, kc = r & 15;
        const float* wp = Ap->in[I_ADA_W] + ((size_t)l * DM + kc * 64) * (6 * DM) + cgp * 256 + 4 * lane;
        f32x4 acc[8];
#pragma unroll
        for (int b = 0; b < 8; ++b) acc[b] = (f32x4){0.f, 0.f, 0.f, 0.f};
#pragma unroll 8
        for (int k = 0; k < 64; ++k) { const f32x4 w = __builtin_nontemporal_load((const f32x4*)(wp + (size_t)k * (6 * DM)));
            const f32x4 c0 = *(const LAS f32x4*)(cond + (kc * 64 + k) * 8), c1 = *(const LAS f32x4*)(cond + (kc * 64 + k) * 8 + 4);
            acc[0] += c0[0] * w; acc[1] += c0[1] * w; acc[2] += c0[2] * w; acc[3] += c0[3] * w; acc[4] += c1[0] * w; acc[5] += c1[1] * w; acc[6] += c1[2] * w; acc[7] += c1[3] * w; }
#pragma unroll
        for (int b = 0; b < 8; ++b) *(f32x4*)(modp + (((size_t)kc * DEPTH + l) * 8 + b) * (6 * DM) + cgp * 256 + 4 * lane) = acc[b];
    }
}
__device__ __forceinline__ void modreduce_phase(ArgP Ap, int vcu, int G, int tid) {
    unsigned char* ws = Ap->ws; const float* modp = (const float*)(ws + WS_ADAP); float* mod = (float*)(ws + WS_MOD);
    constexpr int N4 = DEPTH * BATCH * 6 * DM / 4;
    for (int i = vcu * NTHREADS + tid; i < N4; i += G * NTHREADS) {
        const int n4 = i % (6 * DM / 4), l = i / (BATCH * 6 * DM / 4);
        f32x4 a = *((const f32x4*)(Ap->in[I_ADA_B] + (size_t)l * 6 * DM) + n4);
#pragma unroll
        for (int kc = 0; kc < 16; ++kc) a += *((const f32x4*)modp + (size_t)kc * N4 + i);
        *((f32x4*)mod + i) = a; }
}

__device__ __forceinline__ void norm_phase(const float* x, const float* gn, const float* macc  , const float* mbias  , int sh_off, int sc_off, bf16_t* H, int gw, int NGW, int lane) {
    for (int ch = gw; ch < MTOK / 16; ch += NGW) {
        const int row0 = ch * 16, b = row0 >> 12;
        f32x4 c1[4], shv[4];
#pragma unroll
        for (int j = 0; j < 4; ++j) { const int col = 4 * lane + 256 * j;
            const f32x4 sc = *(const f32x4*)(macc + (size_t)b * 6 * DM + sc_off + col);
            c1[j] = *(const f32x4*)(gn + col) * (1.0f + sc);
            shv[j] = *(const f32x4*)(macc + (size_t)b * 6 * DM + sh_off + col); }
        for (int r = row0; r < row0 + 16; ++r) {
            const f32x4* xr = (const f32x4*)(x + (size_t)r * DM) + lane;
            f32x4 v[4]; float ss = 0.f;
#pragma unroll
            for (int j = 0; j < 4; ++j) { v[j] = xr[64 * j]; ss += (v[j][0] * v[j][0] + v[j][1] * v[j][1]) + (v[j][2] * v[j][2] + v[j][3] * v[j][3]); }
            const float rstd = __builtin_amdgcn_rsqf(wave_sum_all(ss) * (1.0f / DM) + EPS);
            u32x2* o8 = (u32x2*)(H + (size_t)r * DM) + lane;
#pragma unroll
            for (int j = 0; j < 4; ++j) { const f32x4 o = v[j] * rstd * c1[j] + shv[j]; u32x2 w; w.x = cvt_pk_bf16(o[0], o[1]); w.y = cvt_pk_bf16(o[2], o[3]); o8[64 * j] = w; }
        }
    }
}
__device__ __forceinline__ void resnorm_phase(const float* xb, float* xo, const bf16_t* Y, const float* gate  , const float* gn, const float* macc, int sh_off, int sc_off, bf16_t* H, int gw, int NGW, int lane) {
    for (int ch = gw; ch < MTOK / 16; ch += NGW) {
        const int row0 = ch * 16, b = row0 >> 12;
        f32x4 c1[4], shv[4], gt[4];
#pragma unroll
        for (int j = 0; j < 4; ++j) { const int col = 4 * lane + 256 * j;
            const f32x4 sc = *(const f32x4*)(macc + (size_t)b * 6 * DM + sc_off + col);
            c1[j] = *(const f32x4*)(gn + col) * (1.0f + sc);
            shv[j] = *(const f32x4*)(macc + (size_t)b * 6 * DM + sh_off + col);
            gt[j] = *(const f32x4*)(gate + (size_t)b * 6 * DM + col); }
        for (int r = row0; r < row0 + 16; ++r) {
            const f32x4* xr = (const f32x4*)(xb + (size_t)r * DM) + lane; const u32x2* yr = (const u32x2*)(Y + (size_t)r * DM) + lane;
            f32x4 v[4]; float ss = 0.f;
#pragma unroll
            for (int j = 0; j < 4; ++j) { const u32x2 y = yr[64 * j]; v[j] = xr[64 * j] + gt[j] * (f32x4){bf_lo(y.x), bf_hi(y.x), bf_lo(y.y), bf_hi(y.y)};
                ss += (v[j][0] * v[j][0] + v[j][1] * v[j][1]) + (v[j][2] * v[j][2] + v[j][3] * v[j][3]); }
            const float rstd = __builtin_amdgcn_rsqf(wave_sum_all(ss) * (1.0f / DM) + EPS);
            u32x2* o8 = (u32x2*)(H + (size_t)r * DM) + lane;
#pragma unroll
            for (int j = 0; j < 4; ++j) { const f32x4 o = v[j] * rstd * c1[j] + shv[j]; u32x2 w; w.x = cvt_pk_bf16(o[0], o[1]); w.y = cvt_pk_bf16(o[2], o[3]); o8[64 * j] = w; }
        }
    }
}
__device__ __forceinline__ void final_phase(float* x, const float* gf, int gw, int NGW, int lane) {
    f32x4 gv[4];
#pragma unroll
    for (int j = 0; j < 4; ++j) gv[j] = *(const f32x4*)(gf + 4 * lane + 256 * j);
    for (int r = gw; r < MTOK; r += NGW) {
        f32x4* xr = (f32x4*)(x + (size_t)r * DM) + lane;
        f32x4 v[4]; float ss = 0.f;
#pragma unroll
        for (int j = 0; j < 4; ++j) { v[j] = xr[64 * j]; ss += (v[j][0] * v[j][0] + v[j][1] * v[j][1]) + (v[j][2] * v[j][2] + v[j][3] * v[j][3]); }
        const float rstd = __builtin_amdgcn_rsqf(wave_sum_all(ss) * (1.0f / DM) + EPS);
#pragma unroll
        for (int j = 0; j < 4; ++j) xr[64 * j] = v[j] * rstd * gv[j];
    }
}

__device__ __forceinline__ void unpack8(const u32x4 w, float (&f)[8]) { f[0] = bf_lo(w.x); f[1] = bf_hi(w.x); f[2] = bf_lo(w.y); f[3] = bf_hi(w.y); f[4] = bf_lo(w.z); f[5] = bf_hi(w.z); f[6] = bf_lo(w.w); f[7] = bf_hi(w.w); }
__device__ __forceinline__ u32x4 pack8(const float (&f)[8]) { u32x4 o; o.x = cvt_pk_bf16(f[0], f[1]); o.y = cvt_pk_bf16(f[2], f[3]); o.z = cvt_pk_bf16(f[4], f[5]); o.w = cvt_pk_bf16(f[6], f[7]); return o; }
__device__ __forceinline__ void pool_elem_phase(const bf16_t* U, bf16_t* P, int vcu, int G, int tid) {
    const int chunk = tid & 127, run = tid >> 7, c0 = 8 * chunk, w = 2 << (c0 >> 8);
    for (int unit = vcu; unit < MTOK / 128; unit += G) {
        const int t0 = unit * 128 + run * 32, seq0 = t0 & ~(SEQ - 1);
        float s[8];
#pragma unroll
        for (int j = 0; j < 8; ++j) s[j] = 0.f;
        for (int tau = t0 - w; tau < t0; ++tau) if (tau >= seq0) { float f[8];     unpack8(*(const u32x4*)(U + (size_t)tau * DM + c0), f);
#pragma unroll
            for (int j = 0; j < 8; ++j) s[j] += f[j]; }
#pragma unroll 1
        for (int tb = t0; tb < t0 + 32; tb += 8) {
            u32x4 cur[8], old[8];
#pragma unroll
            for (int i = 0; i < 8; ++i) { cur[i] = *(const u32x4*)(U + (size_t)(tb + i) * DM + c0);
                const int tl = tb + i - w; old[i] = *(const u32x4*)(U + (size_t)(tl >= seq0 ? tl : seq0) * DM + c0); }
#pragma unroll
            for (int i = 0; i < 8; ++i) { const int t = tb + i; float f[8], o[8]; unpack8(cur[i], f);
#pragma unroll
                for (int j = 0; j < 8; ++j) s[j] += f[j];
                if (t - w >= seq0) { float q[8]; unpack8(old[i], q);
#pragma unroll
                    for (int j = 0; j < 8; ++j) s[j] -= q[j]; }
                const int pos1 = t - seq0 + 1; const float inv = 1.0f / (float)(pos1 < w ? pos1 : w);
#pragma unroll
                for (int j = 0; j < 8; ++j) o[j] = s[j] * inv - f[j];
                *(u32x4*)(P + (size_t)t * DM + c0) = pack8(o); }
        }
    }
}
__device__ __forceinline__ void conv_elem_phase(const bf16_t* BG, const bf16_t* Z, const float* cw  , bf16_t* Aout, int vcu, int G, int tid) {
    const int chunk = tid & 127, run = tid >> 7, c0 = 8 * chunk;
    float w0[8], w1[8], w2[8];
#pragma unroll
    for (int j = 0; j < 8; ++j) { w0[j] = cw[c0 + j]; w1[j] = cw[DM + c0 + j]; w2[j] = cw[2 * DM + c0 + j]; }
    for (int unit = vcu; unit < MTOK / 128; unit += G) {
        const int t0 = unit * 128 + run * 32, seq0 = t0 & ~(SEQ - 1);
        float zm2[8], zm1[8];
#pragma unroll
        for (int j = 0; j < 8; ++j) { zm2[j] = 0.f; zm1[j] = 0.f; }
        if (t0 - 2 >= seq0) unpack8(*(const u32x4*)(Z + (size_t)(t0 - 2) * DM + c0), zm2);
        if (t0 - 1 >= seq0) unpack8(*(const u32x4*)(Z + (size_t)(t0 - 1) * DM + c0), zm1);
#pragma unroll 1
        for (int tb = t0; tb < t0 + 32; tb += 8) {
            u32x4 zr[8], br[8];
#pragma unroll
            for (int i = 0; i < 8; ++i) { zr[i] = *(const u32x4*)(Z + (size_t)(tb + i) * DM + c0); br[i] = *(const u32x4*)(BG + (size_t)(tb + i) * DM + c0); }
#pragma unroll
            for (int i = 0; i < 8; ++i) { float z[8], bg[8], o[8]; unpack8(zr[i], z); unpack8(br[i], bg);
#pragma unroll
                for (int j = 0; j < 8; ++j) { o[j] = bg[j] * (w0[j] * zm2[j] + w1[j] * zm1[j] + w2[j] * z[j]); zm2[j] = zm1[j]; zm1[j] = z[j]; }
                *(u32x4*)(Aout + (size_t)(tb + i) * DM + c0) = pack8(o); }
        }
    }
}

__device__ __forceinline__ int wp_off(int row, int chunk) { return row * 256 + ((chunk ^ (row & 15)) << 4); }
__device__ __forceinline__ void mix_phase(LAS unsigned char* lds, bf16_t* UA, const bf16_t* VT, const float* WS, const float* BS, const float* LNG, const float* LNB, int vcu, int G, int tid, int wid, int lane) {
    LAS unsigned char* WP = lds;
    LAS float* MU = (LAS float*)(lds + 32768); LAS float* RSTD = MU + 128; LAS float* R1 = MU + 256; LAS float* R2 = MU + 384;
    LAS float* PART = (LAS float*)(lds + 36864);
    LAS unsigned char* VS = lds + 36864;
    for (int n = vcu; n < MTOK / 128; n += G) {
        {
            const int cgp = tid >> 4, tl = tid & 15;
            float s[8], q[8];
#pragma unroll
            for (int j = 0; j < 8; ++j) { s[j] = 0.f; q[j] = 0.f; }
#pragma unroll 4
            for (int it = 0; it < GH / 32; ++it) { float f[8]; unpack8(*(const u32x4*)(VT + ((size_t)n * GH + it * 32 + cgp) * 128 + tl * 8), f);
#pragma unroll
                for (int j = 0; j < 8; ++j) { s[j] += f[j]; q[j] += f[j] * f[j]; } }
#pragma unroll
            for (int j = 0; j < 8; ++j) { PART[(cgp * 128 + tl * 8 + j) * 2] = s[j]; PART[(cgp * 128 + tl * 8 + j) * 2 + 1] = q[j]; }
            __syncthreads();
            if (tid < 128) { float S = 0.f, Q = 0.f;
                for (int k = 0; k < 32; ++k) { S += PART[(k * 128 + tid) * 2]; Q += PART[(k * 128 + tid) * 2 + 1]; }
                const float mu = S * (1.0f / GH), var = Q * (1.0f / GH) - mu * mu; MU[tid] = mu; RSTD[tid] = __builtin_amdgcn_rsqf(fmaxf(var, 0.f) + EPS); }
            __syncthreads();
        }
        for (int g = 0; g < 8; ++g) {
            const int fr = lane & 15, fq = lane >> 4, cbase = g * 384 + wid * 48;
            bf16x8 av[4][3];
#pragma unroll
            for (int ks = 0; ks < 4; ++ks)
#pragma unroll
                for (int ct = 0; ct < 3; ++ct) av[ks][ct] = *(const bf16x8*)(VT + ((size_t)n * GH + cbase + ct * 16 + fr) * 128 + ks * 32 + fq * 8);
            {
                const int i = tid >> 2, part = tid & 3;
                const float* wrow = WS + ((size_t)g * 128 + i) * 128 + part * 32;
                float r1 = 0.f, r2 = 0.f;
#pragma unroll
                for (int jj = 0; jj < 32; jj += 8) { const int j0 = part * 32 + jj;
                    f32x4 a = *(const f32x4*)(wrow + jj), b = *(const f32x4*)(wrow + jj + 4);
                    if (i < 64 && j0 >= 64) { a = (f32x4){0.f, 0.f, 0.f, 0.f}; b = a; }
                    const f32x4 ra = *(const LAS f32x4*)(RSTD + j0), rb = *(const LAS f32x4*)(RSTD + j0 + 4), ma = *(const LAS f32x4*)(MU + j0), mb = *(const LAS f32x4*)(MU + j0 + 4);
                    const f32x4 wa = a * ra, wb = b * rb;
                    r1 += (wa[0] * ma[0] + wa[1] * ma[1]) + (wa[2] * ma[2] + wa[3] * ma[3]) + (wb[0] * mb[0] + wb[1] * mb[1]) + (wb[2] * mb[2] + wb[3] * mb[3]);
                    r2 += (a[0] + a[1]) + (a[2] + a[3]) + (b[0] + b[1]) + (b[2] + b[3]);
                    u32x4 o; o.x = cvt_pk_bf16(wa[0], wa[1]); o.y = cvt_pk_bf16(wa[2], wa[3]); o.z = cvt_pk_bf16(wb[0], wb[1]); o.w = cvt_pk_bf16(wb[2], wb[3]);
                    *(LAS u32x4*)(WP + wp_off(i, j0 >> 3)) = o; }
                r1 += __shfl_xor(r1, 1); r1 += __shfl_xor(r1, 2); r2 += __shfl_xor(r2, 1); r2 += __shfl_xor(r2, 2);
                if (part == 0) { R1[i] = r1; R2[i] = r2; }
            }
            __syncthreads();
            f32x4 acc[3][8];
#pragma unroll
            for (int ct = 0; ct < 3; ++ct)
#pragma unroll
                for (int it = 0; it < 8; ++it) acc[ct][it] = (f32x4){0.f, 0.f, 0.f, 0.f};
#pragma unroll
            for (int ks = 0; ks < 4; ++ks) {
#pragma unroll
                for (int it = 0; it < 8; ++it) { const bf16x8 bw = *(const LAS bf16x8*)(WP + wp_off(it * 16 + fr, ks * 4 + fq));
#pragma unroll
                    for (int ct = 0; ct < 3; ++ct) acc[ct][it] = __builtin_amdgcn_mfma_f32_16x16x32_bf16(av[ks][ct], bw, acc[ct][it], 0, 0, 0); }
                __builtin_amdgcn_sched_barrier(0);
            }
#pragma unroll
            for (int ct = 0; ct < 3; ++ct) { const int c4 = cbase + ct * 16 + 4 * fq;
                const f32x4 lg = *(const f32x4*)(LNG + c4), lb = *(const f32x4*)(LNB + c4);
#pragma unroll
                for (int it = 0; it < 8; ++it) { const int i = it * 16 + fr; const float r1 = R1[i], r2 = R2[i], bs = BS[g * 128 + i];
                    const f32x4 vs = lg * (acc[ct][it] - r1) + lb * r2 + bs;
                    u32x2 o; o.x = cvt_pk_bf16(vs[0], vs[1]); o.y = cvt_pk_bf16(vs[2], vs[3]);
                    *(LAS u32x2*)(VS + i * 784 + (wid * 48 + ct * 16 + 4 * fq) * 2) = o; } }
            __syncthreads();
#pragma unroll 4
            for (int c = tid; c < 128 * 48; c += NTHREADS) { const int tok = c / 48, ch8 = c - tok * 48;
                const u32x4 vv = *(const LAS u32x4*)(VS + tok * 784 + ch8 * 16);
                u32x4* up = (u32x4*)(UA + (size_t)(n * 128 + tok) * GH + g * 384 + ch8 * 8); const u32x4 uu = *up;
                u32x4 o; o.x = cvt_pk_bf16(bf_lo(uu.x) * bf_lo(vv.x), bf_hi(uu.x) * bf_hi(vv.x)); o.y = cvt_pk_bf16(bf_lo(uu.y) * bf_lo(vv.y), bf_hi(uu.y) * bf_hi(vv.y));
                o.z = cvt_pk_bf16(bf_lo(uu.z) * bf_lo(vv.z), bf_hi(uu.z) * bf_hi(vv.z)); o.w = cvt_pk_bf16(bf_lo(uu.w) * bf_lo(vv.w), bf_hi(uu.w) * bf_hi(vv.w));
                *up = o; }
            __syncthreads();
        }
    }
}

__device__ __forceinline__ void topk_units(LAS unsigned char* lds, const bf16_t* Q, const bf16_t* KEYS, int* SELI, float* SELW, const pg8::StaticOrder& S, int tid, int wid, int lane) {
    LAS unsigned char* kl = lds;
    LAS float* topv = (LAS float*)(lds + 65536);
    const int p = wid >> 2, sub = wid & 3, tl = lane & 31, hi = lane >> 5;
    int hprev = -1;
#pragma unroll 1
    for (int k = 0; ; k = (k & 1) ? k + 3 : k + 1) {
        pg8::Unit ua, ub; if (!S.next(k, ua)) break;
        const bool hasb = S.next(k + 2, ub);
        const bool pair = hasb && ub.pn == ua.pn;
#pragma unroll 1
        for (int part = 0; part < ((hasb && !pair) ? 2 : 1); ++part) {
            const int h = part ? ub.pn : ua.pn, pm0 = part ? ub.pm : ua.pm, pm1 = ub.pm, ntile = pair ? 4 : 2;
            __syncthreads();
            if (h != hprev) {
                for (int c = tid; c < 4096; c += NTHREADS) { const int row = c >> 4, ch = c & 15;
                    const u32x4 v = *(const u32x4*)(KEYS + ((size_t)h * 256 + row) * 128 + ch * 8);
                    *(LAS u32x4*)(kl + row * 256 + ((ch ^ (row & 15)) << 4)) = v; }
                hprev = h; }
            __syncthreads();
#pragma unroll 1
            for (int t4 = 0; t4 < ntile; ++t4) {
                const int tile = 2 * (t4 < 2 ? pm0 : pm1) + (t4 & 1);
                const bf16_t* qrow = Q + ((size_t)((tile * 8 + h) * 32 + 16 * p + hi) * 128 + sub * 32 + tl) * 8;
                bf16x8 bq[8];
#pragma unroll
                for (int ks = 0; ks < 8; ++ks) bq[ks] = *(const bf16x8*)(qrow + (size_t)ks * 2 * 128 * 8);
                f32x16 acc[4];
#pragma unroll
                for (int kt = 0; kt < 4; ++kt)
#pragma unroll
                    for (int r = 0; r < 16; ++r) acc[kt][r] = 0.f;
#pragma unroll
                for (int ks = 0; ks < 8; ++ks)
#pragma unroll
                    for (int kt = 0; kt < 4; ++kt) { const int row = p * 128 + kt * 32 + tl;
                        const bf16x8 ak = *(const LAS bf16x8*)(kl + row * 256 + (((2 * ks + hi) ^ (row & 15)) << 4));
                        acc[kt] = __builtin_amdgcn_mfma_f32_32x32x16_bf16(ak, bq[ks], acc[kt], 0, 0, 0); }
                float v[64];
#pragma unroll
                for (int kt = 0; kt < 4; ++kt)
#pragma unroll
                    for (int r = 0; r < 16; ++r) { const unsigned key = (unsigned)(kt * 32 + (r & 3) + 8 * (r >> 2) + 4 * hi);
                        v[kt * 16 + r] = __uint_as_float((__float_as_uint(acc[kt][r]) & ~127u) | key); }
                top16_of_64(v);
                float m[16];
#pragma unroll
                for (int i = 0; i < 16; ++i) m[i] = fmaxf(v[i], __shfl_xor(v[15 - i], 32));
                bmerge16_desc<0, 16>(m);
                if (hi == 0) { LAS f32x4* dst = (LAS f32x4*)(topv + ((t4 * 2 + p) * 128 + sub * 32 + tl) * 16);
#pragma unroll
                    for (int i = 0; i < 4; ++i) dst[i] = (f32x4){m[4 * i], m[4 * i + 1], m[4 * i + 2], m[4 * i + 3]}; }
            }
            __syncthreads();
            if (tid < ntile * 128) {
                const int t4 = tid >> 7, tok = tid & 127, tile = 2 * (t4 < 2 ? pm0 : pm1) + (t4 & 1);
                const LAS float* t0 = topv + ((t4 * 2 + 0) * 128 + tok) * 16; const LAS float* t1 = topv + ((t4 * 2 + 1) * 128 + tok) * 16;
                float s0[16], s1[16];
#pragma unroll
                for (int i = 0; i < 4; ++i) { const f32x4 a = *(const LAS f32x4*)(t0 + 4 * i), b = *(const LAS f32x4*)(t1 + 4 * i);
                    s0[4 * i] = a[0]; s0[4 * i + 1] = a[1]; s0[4 * i + 2] = a[2]; s0[4 * i + 3] = a[3]; s1[4 * i] = b[0]; s1[4 * i + 1] = b[1]; s1[4 * i + 2] = b[2]; s1[4 * i + 3] = b[3]; }
                float c[64];
                constexpr int pre[16] = {0, 16, 24, 29, 33, 36, 38, 40, 42, 43, 44, 45, 46, 47, 48, 49};
#pragma unroll
                for (int a = 0; a < 16; ++a)
#pragma unroll
                    for (int b = 0; b < 16; ++b) if ((a + 1) * (b + 1) <= 16) c[pre[a] + b] = __uint_as_float((__float_as_uint(s0[a] + s1[b]) & ~255u) | (unsigned)(a * 16 + b));
#pragma unroll
                for (int i = 50; i < 64; ++i) c[i] = -3.0e38f;
                top16_of_64(c);
                float e[16], sum = 0.f;
#pragma unroll
                for (int kk = 0; kk < 16; ++kk) { e[kk] = __builtin_amdgcn_exp2f((c[kk] - c[0]) * 1.44269504f); sum += e[kk]; }
                const float inv = 1.0f / sum;
                const size_t o = (size_t)(tile * 128 + tok) * NPICK + h * 16;
#pragma unroll
                for (int k4 = 0; k4 < 4; ++k4) { i32x4 ei; f32x4 wv;
#pragma unroll
                    for (int j = 0; j < 4; ++j) { const unsigned code = __float_as_uint(c[4 * k4 + j]) & 255u;
                        const unsigned i1 = __float_as_uint(t0[code >> 4]) & 127u, i2 = __float_as_uint(t1[code & 15u]) & 127u;
                        ei[j] = (int)(i1 * 128u + i2); wv[j] = e[4 * k4 + j] * inv; }
                    *(i32x4*)(SELI + o + 4 * k4) = ei; *(f32x4*)(SELW + o + 4 * k4) = wv; }
            }
        }
    }
    __syncthreads();
}

typedef const unsigned char* cbytes;
template <int CTRL> __device__ __forceinline__ float dpp_f(float v) { return __builtin_bit_cast(float, __builtin_amdgcn_update_dpp(0, __builtin_bit_cast(int, v), CTRL, 0xf, 0xf, false)); }
#define DPP_F(v, ctrl) dpp_f<(ctrl)>(v)
#define PG_IDX(EV, TKN) do { const LAS u32x4* _ip = (const LAS u32x4*)(idxw + (TKN) * 128 + 16 * g8); \
        _Pragma("unroll") for (int q = 0; q < 2; ++q) { const u32x4 _e = _ip[q]; _Pragma("unroll") for (int w = 0; w < 4; ++w) { EV[8 * q + 2 * w] = (int)(_e[w] & 0xffffu); EV[8 * q + 2 * w + 1] = (int)(_e[w] >> 16); } } } while (0)
#define PG_GATHER8(BUF, SL, EV, J0) do { _Pragma("unroll") for (int j = 0; j < 8; ++j) BUF[j] = *(const u32x4*)((SL) + ((unsigned)EV[(J0) + j] * 128u + s8 * 16u)); } while (0)
#define PG_H(HA, HB, IT) do { const int _it = (IT) < 127 ? (IT) : 127; const u32x4* _hp = (const u32x4*)(H + (size_t)(tk0 + (_it & 15)) * DM + (((xg + (_it >> 4)) & 7) * 128) + s8 * 16); HA = _hp[0]; HB = _hp[1]; } while (0)
#define PG_HF(HA, HB) do { hf[0] = (f32x2){bf_lo(HA.x), bf_hi(HA.x)}; hf[1] = (f32x2){bf_lo(HA.y), bf_hi(HA.y)}; hf[2] = (f32x2){bf_lo(HA.z), bf_hi(HA.z)}; hf[3] = (f32x2){bf_lo(HA.w), bf_hi(HA.w)}; \
        hf[4] = (f32x2){bf_lo(HB.x), bf_hi(HB.x)}; hf[5] = (f32x2){bf_lo(HB.y), bf_hi(HB.y)}; hf[6] = (f32x2){bf_lo(HB.z), bf_hi(HB.z)}; hf[7] = (f32x2){bf_lo(HB.w), bf_hi(HB.w)}; } while (0)
#define PG_UCOMP8(BUF, O) do { _Pragma("unroll") for (int j = 0; j < 8; ++j) { const u32x4 u = BUF[j]; \
            f32x2 a = __builtin_amdgcn_cvt_pk_f32_fp8(u.x, false) * hf[0]; a += __builtin_amdgcn_cvt_pk_f32_fp8(u.x, true) * hf[1]; \
            a += __builtin_amdgcn_cvt_pk_f32_fp8(u.y, false) * hf[2]; a += __builtin_amdgcn_cvt_pk_f32_fp8(u.y, true) * hf[3]; \
            a += __builtin_amdgcn_cvt_pk_f32_fp8(u.z, false) * hf[4]; a += __builtin_amdgcn_cvt_pk_f32_fp8(u.z, true) * hf[5]; \
            a += __builtin_amdgcn_cvt_pk_f32_fp8(u.w, false) * hf[6]; a += __builtin_amdgcn_cvt_pk_f32_fp8(u.w, true) * hf[7]; \
            float d = a.x + a.y; d += DPP_F(d, 0xB1); d += DPP_F(d, 0x4E); d += DPP_F(d, 0x141);     \
            O = (s8 == j) ? d : O; } } while (0)
#define PG_VCOMP8(BUF, CV, J0) do { _Pragma("unroll") for (int j = 0; j < 8; ++j) { const u32x4 v = BUF[j]; const float c = CV[(J0) + j]; \
            acc[0] += c * __builtin_amdgcn_cvt_pk_f32_fp8(v.x, false); acc[1] += c * __builtin_amdgcn_cvt_pk_f32_fp8(v.x, true); \
            acc[2] += c * __builtin_amdgcn_cvt_pk_f32_fp8(v.y, false); acc[3] += c * __builtin_amdgcn_cvt_pk_f32_fp8(v.y, true); \
            acc[4] += c * __builtin_amdgcn_cvt_pk_f32_fp8(v.z, false); acc[5] += c * __builtin_amdgcn_cvt_pk_f32_fp8(v.z, true); \
            acc[6] += c * __builtin_amdgcn_cvt_pk_f32_fp8(v.w, false); acc[7] += c * __builtin_amdgcn_cvt_pk_f32_fp8(v.w, true); } } while (0)
#define PG_COEF(CV, TKN) do { const LAS f32x4* _cp = (const LAS f32x4*)(dotw + (TKN) * 128 + 16 * g8); \
        _Pragma("unroll") for (int q = 0; q < 4; ++q) { const f32x4 _c = _cp[q]; CV[4 * q] = _c[0]; CV[4 * q + 1] = _c[1]; CV[4 * q + 2] = _c[2]; CV[4 * q + 3] = _c[3]; } } while (0)
#define PG_COEF8(CV, TKN, J0) do { const LAS f32x4* _cp = (const LAS f32x4*)(dotw + (TKN) * 128 + 16 * g8 + (J0)); \
        const f32x4 _c0 = _cp[0], _c1 = _cp[1]; CV[0] = _c0[0]; CV[1] = _c0[1]; CV[2] = _c0[2]; CV[3] = _c0[3]; CV[4] = _c1[0]; CV[5] = _c1[1]; CV[6] = _c1[2]; CV[7] = _c1[3]; } while (0)
#define PG_XOFFS(IT) ((size_t)(tk0 + ((IT) & 15)) * DM + (((xg + ((IT) >> 4)) & 7) * 128) + xoff)
#define PG_XADDR(IT) (x + PG_XOFFS(IT))
#define PG_XLOAD(XV, YV, IT) do { const size_t _o = PG_XOFFS(IT); XV = *(const f32x2*)(xin + _o); YV = *(const unsigned*)(Y + _o); } while (0)
__device__ __forceinline__ void peer_gather_phase(LAS unsigned char* lds, const bf16_t* H, cbytes TUP, cbytes TVP, const int* SELI, const float* SELW, const unsigned* SC, const float* xin  , const bf16_t* Y  , const float* g1acc  , float* x, const float* gacc, const float* gn_next  , const float* mod_next  , bf16_t* Hout, bool last, int vcu, int G, int wid, int lane) {
    const int g8 = lane >> 3, s8 = lane & 7;
    const bool b3 = (lane & 8) != 0, b4 = (lane & 16) != 0, b5 = (lane & 32) != 0;
    const int xoff = s8 * 16 + 8 * (g8 & 1) + 4 * ((g8 >> 1) & 1) + 2 * (g8 >> 2);
    LAS unsigned short* idxw = (LAS unsigned short*)(lds + wid * 12288);
    LAS float* dotw = (LAS float*)(lds + wid * 12288 + 4096);
    for (int blk = vcu; blk < 256; blk += G) {
        const int xg = blk >> 5, tk0 = blk * 128 + wid * 16;
#pragma unroll 4
        for (int i = 0; i < 16; ++i) { const int e0 = SELI[(size_t)(tk0 + i) * NPICK + lane], e1 = SELI[(size_t)(tk0 + i) * NPICK + 64 + lane];
            idxw[i * 128 + lane] = (unsigned short)e0; idxw[i * 128 + 64 + lane] = (unsigned short)e1; dotw[i * 128 + lane] = 0.f; dotw[i * 128 + 64 + lane] = 0.f; }
        asm volatile("" ::: "memory");
        {
            int ev[16]; u32x4 bufA[8], bufB[8], bufC[8], bufD[8]; u32x4 h0a, h0b, h1a, h1b;
            { cbytes sl0 = TUP + (size_t)(xg & 7) * NEXP * 128;
              PG_IDX(ev, 0); PG_GATHER8(bufA, sl0, ev, 0); PG_GATHER8(bufB, sl0, ev, 8);
              PG_IDX(ev, 1); PG_GATHER8(bufC, sl0, ev, 0); PG_GATHER8(bufD, sl0, ev, 8); }
            PG_H(h0a, h0b, 0); PG_H(h1a, h1b, 1);
#pragma unroll 1
            for (int it = 0; it < 128; it += 2) {
                const int tkn = it & 15, it2 = it + 2 < 127 ? it + 2 : 127, it3 = it + 3 < 127 ? it + 3 : 127;
                cbytes sl2 = TUP + (size_t)((xg + (it2 >> 4)) & 7) * NEXP * 128;
                f32x2 hf[8]; float o0 = 0.f, o1 = 0.f;
                PG_HF(h0a, h0b); PG_IDX(ev, it2 & 15);
                PG_UCOMP8(bufA, o0); __builtin_amdgcn_sched_barrier(0);
                PG_GATHER8(bufA, sl2, ev, 0); __builtin_amdgcn_sched_barrier(0);
                PG_UCOMP8(bufB, o1); __builtin_amdgcn_sched_barrier(0);
                PG_GATHER8(bufB, sl2, ev, 8); PG_H(h0a, h0b, it + 2); __builtin_amdgcn_sched_barrier(0);
                { LAS float* dp = dotw + tkn * 128 + 16 * g8 + s8; dp[0] += o0; dp[8] += o1; }
                o0 = 0.f; o1 = 0.f;
                PG_HF(h1a, h1b); PG_IDX(ev, it3 & 15);
                PG_UCOMP8(bufC, o0); __builtin_amdgcn_sched_barrier(0);
                PG_GATHER8(bufC, sl2, ev, 0); __builtin_amdgcn_sched_barrier(0);
                PG_UCOMP8(bufD, o1); __builtin_amdgcn_sched_barrier(0);
                PG_GATHER8(bufD, sl2, ev, 8); PG_H(h1a, h1b, it + 3); __builtin_amdgcn_sched_barrier(0);
                { LAS float* dp = dotw + (tkn + 1) * 128 + 16 * g8 + s8; dp[0] += o0; dp[8] += o1; }
            }
        }
        asm volatile("" ::: "memory");
#pragma unroll 2
        for (int i = 0; i < 16; ++i) {
#pragma unroll
            for (int hh = 0; hh < 2; ++hh) { const int k = 16 * g8 + s8 + 8 * hh; const int e = idxw[i * 128 + k];
                const float w = SELW[(size_t)(tk0 + i) * NPICK + k]; const unsigned sc = SC[e];
                dotw[i * 128 + k] = w * gelu_tanh(dotw[i * 128 + k] * bf_lo(sc)) * bf_hi(sc); } }
        asm volatile("" ::: "memory");
        {
            const float* gp = gacc + (size_t)(tk0 >> 12) * 6 * DM + xoff;
            const float* g1p = g1acc + (size_t)(tk0 >> 12) * 6 * DM + xoff;
            int ev[16]; u32x4 bufA[8], bufB[8], bufC[8], bufD[8]; float cC[8]; f32x2 x0, x1; unsigned y0, y1;
            { cbytes sl0 = TVP + (size_t)(xg & 7) * NEXP * 128;
              PG_IDX(ev, 0); PG_GATHER8(bufA, sl0, ev, 0); PG_GATHER8(bufB, sl0, ev, 8);
              PG_IDX(ev, 1); PG_GATHER8(bufC, sl0, ev, 0); PG_GATHER8(bufD, sl0, ev, 8); }
            PG_XLOAD(x0, y0, 0); PG_XLOAD(x1, y1, 1);
#define PG_VREDUCE_STORE(XV, YV, IT) do { \
                f32x2 k4[4]; _Pragma("unroll") for (int j = 0; j < 4; ++j) { f32x2 lo = acc[j], hi = acc[4 + j];          \
                    lo.x += DPP_F(lo.x, 0x128); lo.y += DPP_F(lo.y, 0x128); hi.x += DPP_F(hi.x, 0x128); hi.y += DPP_F(hi.y, 0x128); k4[j] = b3 ? hi : lo; } \
                f32x2 k2[2]; _Pragma("unroll") for (int j = 0; j < 2; ++j) { const f32x2 snd = b4 ? k4[j] : k4[2 + j]; k2[j] = b4 ? k4[2 + j] : k4[j]; k2[j].x += __shfl_xor(snd.x, 16); k2[j].y += __shfl_xor(snd.y, 16); } \
                const f32x2 snd = b5 ? k2[0] : k2[1]; f32x2 k1 = b5 ? k2[1] : k2[0]; \
                k1.x += __shfl_xor(snd.x, 32); k1.y += __shfl_xor(snd.y, 32); \
                *(f32x2*)PG_XADDR(IT) = XV + gate1 * (f32x2){bf_lo(YV), bf_hi(YV)} + gate * k1; } while (0)
#pragma unroll 1
            for (int it = 0; it < 128; it += 2) {
                const int it2 = it + 2 < 127 ? it + 2 : 127, it3 = it + 3 < 127 ? it + 3 : 127, sl = (xg + (it >> 4)) & 7;
                cbytes sl2 = TVP + (size_t)((xg + (it2 >> 4)) & 7) * NEXP * 128;
                const f32x2 gate = *(const f32x2*)(gp + sl * 128), gate1 = *(const f32x2*)(g1p + sl * 128);
                f32x2 acc[8];
#pragma unroll
                for (int j = 0; j < 8; ++j) acc[j] = (f32x2){0.f, 0.f};
                PG_COEF8(cC, it & 15, 0); PG_IDX(ev, it2 & 15);
                PG_VCOMP8(bufA, cC, 0); __builtin_amdgcn_sched_barrier(0);
                PG_GATHER8(bufA, sl2, ev, 0); PG_COEF8(cC, it & 15, 8); __builtin_amdgcn_sched_barrier(0);
                PG_VCOMP8(bufB, cC, 0); __builtin_amdgcn_sched_barrier(0);
                PG_GATHER8(bufB, sl2, ev, 8); __builtin_amdgcn_sched_barrier(0);
                PG_VREDUCE_STORE(x0, y0, it);
                PG_XLOAD(x0, y0, it2);
#pragma unroll
                for (int j = 0; j < 8; ++j) acc[j] = (f32x2){0.f, 0.f};
                PG_COEF8(cC, (it + 1) & 15, 0); PG_IDX(ev, it3 & 15);
                PG_VCOMP8(bufC, cC, 0); __builtin_amdgcn_sched_barrier(0);
                PG_GATHER8(bufC, sl2, ev, 0); PG_COEF8(cC, (it + 1) & 15, 8); __builtin_amdgcn_sched_barrier(0);
                PG_VCOMP8(bufD, cC, 0); __builtin_amdgcn_sched_barrier(0);
                PG_GATHER8(bufD, sl2, ev, 8); __builtin_amdgcn_sched_barrier(0);
                PG_VREDUCE_STORE(x1, y1, it + 1);
                PG_XLOAD(x1, y1, it3);
            }
#undef PG_VREDUCE_STORE
        }
        asm volatile("s_waitcnt vmcnt(0)" ::: "memory");
        {
            const int b = tk0 >> 12;
            f32x4 c1[4], shv[4];
#pragma unroll
            for (int j = 0; j < 4; ++j) { const int col = 4 * lane + 256 * j;
                if (last) { c1[j] = *(const f32x4*)(gn_next + col); shv[j] = (f32x4){0.f, 0.f, 0.f, 0.f}; }
                else { c1[j] = *(const f32x4*)(gn_next + col) * (1.0f + *(const f32x4*)(mod_next + (size_t)b * 6 * DM + DM + col)); shv[j] = *(const f32x4*)(mod_next + (size_t)b * 6 * DM + col); } }
#pragma unroll 1
            for (int i0 = 0; i0 < 16; i0 += 4) {
                f32x4 v[4][4]; float ss[4];
#pragma unroll
                for (int rr = 0; rr < 4; ++rr) { const f32x4* xr = (const f32x4*)(x + (size_t)(tk0 + i0 + rr) * DM) + lane;
#pragma unroll
                    for (int j = 0; j < 4; ++j) v[rr][j] = xr[64 * j]; }
#pragma unroll
                for (int rr = 0; rr < 4; ++rr) { float q = 0.f;
#pragma unroll
                    for (int j = 0; j < 4; ++j) q += (v[rr][j][0] * v[rr][j][0] + v[rr][j][1] * v[rr][j][1]) + (v[rr][j][2] * v[rr][j][2] + v[rr][j][3] * v[rr][j][3]);
                    ss[rr] = q; }
#pragma unroll
                for (int o = 1; o < 64; o <<= 1) {
#pragma unroll
                    for (int rr = 0; rr < 4; ++rr) ss[rr] += __shfl_xor(ss[rr], o); }
#pragma unroll
                for (int rr = 0; rr < 4; ++rr) { const int r = tk0 + i0 + rr; const float rstd = __builtin_amdgcn_rsqf(ss[rr] * (1.0f / DM) + EPS);
                    if (last) { f32x4* xr = (f32x4*)(x + (size_t)r * DM) + lane;
#pragma unroll
                        for (int j = 0; j < 4; ++j) xr[64 * j] = v[rr][j] * rstd * c1[j]; }
                    else { u32x2* o8 = (u32x2*)(Hout + (size_t)r * DM) + lane;
#pragma unroll
                        for (int j = 0; j < 4; ++j) { const f32x4 o = v[rr][j] * rstd * c1[j] + shv[j]; u32x2 w; w.x = cvt_pk_bf16(o[0], o[1]); w.y = cvt_pk_bf16(o[2], o[3]); o8[64 * j] = w; } } }
            }
        }
    }
}
#undef PG_IDX
#undef PG_GATHER8
#undef PG_H
#undef PG_HF
#undef PG_UCOMP8
#undef PG_VCOMP8
#undef PG_COEF
#undef PG_COEF8
#undef PG_XADDR
#undef PG_XOFFS
#undef PG_XLOAD

constexpr size_t WS_BAR = 768 * 1024;
#define XB_TMO      128
#define XB_XCNT(j)  (256  + 64 * (j))
#define XB_XSUB(j)  (1280 + 64 * (j))
#define XB_XGEN(j)  (2304 + 64 * (j))
#define XB_TOP      3328
#define XB_TOPGEN   3392
#define XCD_BAR_WORDS 3456
#define XB_SPIN_CAP (1u << 22)
__device__ __forceinline__ unsigned xb_ld(unsigned* p)              { return __hip_atomic_load(p, __ATOMIC_RELAXED, __HIP_MEMORY_SCOPE_AGENT); }
__device__ __forceinline__ unsigned xb_add(unsigned* p, unsigned v) { return __hip_atomic_fetch_add(p, v, __ATOMIC_RELAXED, __HIP_MEMORY_SCOPE_AGENT); }
__device__ __forceinline__ unsigned xb_xcc_id() { return (unsigned)__builtin_amdgcn_s_getreg((3 << 11) | 20) & 0xFu; }
#define XB_SPIN(cond, bar) do { unsigned _sp = 0; while (cond) { __builtin_amdgcn_s_sleep(1); \
    if ((++_sp & 255u) == 0u) { if (xb_ld(&(bar)[XB_TMO])) break; if (_sp > XB_SPIN_CAP) { atomicAdd(&(bar)[XB_TMO], 1u); break; } } } } while (0)
struct XcdBarrier { unsigned* bar; unsigned x; volatile LAS unsigned* st; };
__device__ __forceinline__ void xcd_barrier_complete(unsigned* bar, unsigned x, unsigned& nloc, unsigned& nx) {
    const unsigned G = gridDim.x * gridDim.y * gridDim.z;
    unsigned sum, cnt, mine, sp = 0u;
    for (;;) {
        sum = 0u; cnt = 0u; mine = 0u;
#pragma unroll
        for (unsigned j = 0; j < 16; ++j) { const unsigned c = xb_ld(&bar[XB_XCNT(j)]); sum += c; cnt += (c > 0u) ? 1u : 0u; mine = (j == x) ? c : mine; }
        if (sum == G) break;
        __builtin_amdgcn_s_sleep(1);
        if ((++sp & 255u) == 0u) { if (xb_ld(&bar[XB_TMO])) break; if (sp > XB_SPIN_CAP) { atomicAdd(&bar[XB_TMO], 1u); break; } }
    }
    nloc = mine > 0u ? mine : 1u; nx = cnt > 0u ? cnt : 1u;
}
__device__ __forceinline__ void xcd_barrier(const XcdBarrier& b) {
    asm volatile("s_waitcnt vmcnt(0)" ::: "memory");
    __syncthreads();
    if (threadIdx.x == 0) {
        unsigned* bar = b.bar;
        __builtin_amdgcn_s_waitcnt(0);
        unsigned nloc = b.st[0], nx = b.st[1];
        if (nloc == 0u) { xcd_barrier_complete(bar, b.x, nloc, nx); b.st[0] = nloc; b.st[1] = nx; }
        const unsigned old = xb_add(&bar[XB_XSUB(b.x)], 1u);
        const unsigned gen = old / nloc;
        if (old + 1u == (gen + 1u) * nloc) {
            __builtin_amdgcn_fence(__ATOMIC_RELEASE, "agent");
            asm volatile("s_waitcnt vmcnt(0)" ::: "memory");
            const unsigned og = xb_add(&bar[XB_TOP], 1u);
            const unsigned tg = og / nx;
            if (og + 1u == (tg + 1u) * nx) xb_add(&bar[XB_TOPGEN], 1u);
            else XB_SPIN(xb_ld(&bar[XB_TOPGEN]) == tg, bar);
            __builtin_amdgcn_fence(__ATOMIC_ACQUIRE, "agent");
            xb_add(&bar[XB_XGEN(b.x)], 1u);
            asm volatile("s_waitcnt vmcnt(0)" ::: "memory");
        } else {
            XB_SPIN(xb_ld(&bar[XB_XGEN(b.x)]) == gen, bar);
            __builtin_amdgcn_fence(__ATOMIC_ACQUIRE, "agent");
            asm volatile("s_waitcnt vmcnt(0)" ::: "memory");
        }
    }
    __syncthreads();
}

constexpr int NPHASES = 27;
#ifndef PH_MASK
#define PH_MASK 0xFFFFFF
#endif
#ifndef DUP_MASK
#define DUP_MASK 0
#endif
#ifndef TIME_MASK
#define TIME_MASK 0
#endif
__device__ __forceinline__ int opaque_s(int x) { asm volatile("" : "+s"(x)); return x; }
#define PHM(bit, call) do { if constexpr ((PH_MASK & (bit)) != 0) { if constexpr ((DUP_MASK & (bit)) != 0) { const int _nrep = opaque_s(2); for (int _rep = 0; _rep < _nrep; ++_rep) { call; __syncthreads(); } } else { call; } } } while (0)
__global__ void __launch_bounds__(NTHREADS, 2) trunk_fwd(Args A) {
    extern __shared__ __attribute__((aligned(16))) unsigned char lds_raw[];
    LAS unsigned char* lds = (LAS unsigned char*)lds_raw;
    const int tid0 = threadIdx.x, wid = __builtin_amdgcn_readfirstlane(tid0 >> 6);
    const int G = gridDim.x, bx = blockIdx.x, vcu = (G % 8 == 0) ? (bx % 8) * (G / 8) + bx / 8 : bx;
    const int gw = vcu * 8 + wid, NGW = G * 8;
    const int ph_lo = A.ph_lo, ph_hi = A.ph_hi;
    unsigned long long t_acc = 0;
#if MK_ONE_LAUNCH
    if (tid0 < 2) ((volatile LAS unsigned*)(lds + LDS_XB_OFF))[tid0] = 0u;
    if (bx == 0) { unsigned* b0 = (unsigned*)(A.ws + WS_BAR); for (int i = tid0; i < XCD_BAR_WORDS; i += NTHREADS) b0[i] = 0u; }
#endif

    for (int ph = ph_lo; ph < ph_hi; ++ph) {
        const int tid = opaque(tid0), lane = tid & 63;
        ArgP Ap = (ArgP)__builtin_amdgcn_kernarg_segment_ptr();
        asm volatile("" : "+s"(Ap));
        unsigned char* ws = Ap->ws;
        bf16_t* Hb = (bf16_t*)(ws + WS_H);
        unsigned char* mixb = ws + WS_MIX;
        const float* mod = (const float*)(ws + WS_MOD);
        float* xo = Ap->out;
        int layer, step;
        if (ph < 2) { layer = -1; step = ph; }
        else if (ph < 9) { layer = 0; step = ph - 2; }
        else if (ph < 15) { layer = 1; step = ph - 9 + 1; }
        else if (ph < 21) { layer = 2; step = ph - 15 + 1; }
        else { layer = 3; step = ph - 21 + 1; }
        const int kind = layer % 3, jl = layer / 3;
        unsigned long long t_ph0 = 0; if constexpr (TIME_MASK != 0) t_ph0 = __builtin_amdgcn_s_memrealtime();
        const int nmix = 4;
        int ptype = 0;
        if (layer < 0) ptype = 1; else if (layer > 3) ptype = 2048; else if (step == 0 || step == nmix) ptype = 2;
        else if (step < nmix) ptype = (step == 1) ? 4 : (step == nmix - 1) ? 32 : (kind == 0 && step == 3) ? 16 : 8;
        else ptype = 64 << (step - nmix - 1);
        const float* macc = mod + (size_t)(layer < 0 ? 0 : (layer > 3 ? 3 : layer)) * BATCH * 6 * DM;
        const float* mbias = Ap->in[I_ADA_B] + (size_t)(layer < 0 ? 0 : (layer > 3 ? 3 : layer)) * 6 * DM;
        const float* xin = (layer == 0) ? Ap->in[I_X] : xo;

        if (layer < 0) {
            if (step == 0) { PHM(1, prologue_phase(Ap, lds, vcu, G, tid, wid, lane)); }
            else { PHM(1, modreduce_phase(Ap, vcu, G, tid));
#pragma unroll 1
                for (int pl = 0; pl < 2; ++pl) { pg8::StaticOrder S; pg8::Gemm g{(const bf16_t*)(ws + WS_POOL_WOUT) + (size_t)pl * DM * DM, (const bf16_t*)(ws + WS_WGS) + (size_t)pl * 4 * 65536, DM, DM, 256, DM, 256, 256}; S.init(DM, DM, G, bx);
                    pg8::EpiBf16<0> E{(bf16_t*)(ws + WS_WEFF) + (size_t)pl * DM * DM, DM}; PHM(0x2000, pg8::gemm_phase(lds, g, S, E)); } }
        } else if (layer > 3) {
            PHM(256, final_phase(xo, Ap->in[I_FINAL_G], gw, NGW, lane));
        } else if (step == 0) {
            PHM(2, norm_phase(xin, Ap->in[I_NORM_G] + (size_t)(layer * 2 + 0) * DM, macc, mbias, 0, DM, Hb, gw, NGW, lane));
        } else if (step < nmix) {
            pg8::StaticOrder S;
            if (kind == 0) {
                bf16_t* U = (bf16_t*)mixb; bf16_t* P = (bf16_t*)(mixb + 64 * MiB); bf16_t* Z = (bf16_t*)(mixb + 128 * MiB);
                if (step == 1) { pg8::Gemm g{Hb, (const bf16_t*)(ws + WS_POOL_WIN) + (size_t)jl * DM * DM, MTOK, DM, DM, DM, DM, 0}; S.init(MTOK, DM, G, bx);
                    pg8::EpiBf16<0> E{U, DM}; PHM(0x1000, pg8::gemm_phase(lds, g, S, E)); }
                else if (step == 2) { PHM(8, pool_elem_phase(U, P, vcu, G, tid)); }
                else { pg8::Gemm g{P, (const bf16_t*)(ws + WS_WEFF) + (size_t)jl * DM * DM, MTOK, DM, DM, DM, DM, 0}; S.init(MTOK, DM, G, bx);
                    pg8::EpiBf16<0> E{(bf16_t*)(mixb + 192 * MiB), DM}; PHM(0x8000, pg8::gemm_phase(lds, g, S, E));   }
            } else if (kind == 1) {
                bf16_t* BG = (bf16_t*)mixb; bf16_t* Z = (bf16_t*)(mixb + 64 * MiB); bf16_t* AA = (bf16_t*)(mixb + 128 * MiB);
                if (step == 1) { pg8::Gemm g{Hb, (const bf16_t*)(ws + WS_CONV_WIN), MTOK, 3 * DM, DM, DM, DM, 0}; S.init(MTOK, 3 * DM, G, bx);
                    pg8::EpiConvIn E{BG, Z}; PHM(0x4000, pg8::gemm_phase(lds, g, S, E)); }
                else if (step == 2) { PHM(16, conv_elem_phase(BG, Z, Ap->in[I_CONV_W], AA, vcu, G, tid)); }
                else { pg8::Gemm g{AA, (const bf16_t*)(ws + WS_CONV_WOUT), MTOK, DM, DM, DM, DM, 0}; S.init(MTOK, DM, G, bx);
                    pg8::EpiBf16<0> E{(bf16_t*)(mixb + 192 * MiB), DM}; PHM(0x8000, pg8::gemm_phase(lds, g, S, E));   }
            } else {
                bf16_t* UA = (bf16_t*)mixb; bf16_t* VT = (bf16_t*)(mixb + 192 * MiB);
                if (step == 1) {
                    { pg8::Gemm g{Hb, (const bf16_t*)(ws + WS_GMLP_WIN), MTOK, GH, DM, DM, DM, 0}; S.init(MTOK, GH, G, bx);
                      pg8::EpiBf16<1> E{UA, GH}; PHM(0x1000, pg8::gemm_phase(lds, g, S, E)); }
                    { pg8::Gemm g{Hb, (const bf16_t*)(ws + WS_GMLP_WIN) + (size_t)GH * DM, MTOK, GH, DM, DM, DM, 0}; S.init(MTOK, GH, G, bx);
                      pg8::EpiGmlpV E{VT}; PHM(0x10000, pg8::gemm_phase(lds, g, S, E)); }
                }
                else if (step == 2) { PHM(32, mix_phase(lds, UA, VT, Ap->in[I_GMLP_WS], Ap->in[I_GMLP_BS], Ap->in[I_GMLP_LNG], Ap->in[I_GMLP_LNB], vcu, G, tid, wid, lane)); }
                else { pg8::Gemm g{UA, (const bf16_t*)(ws + WS_GMLP_WOUT), MTOK, DM, GH, GH, GH, 0}; S.init(MTOK, DM, G, bx);
                    pg8::EpiBf16<0> E{(bf16_t*)(mixb + 192 * MiB), DM}; PHM(0x8000, pg8::gemm_phase(lds, g, S, E));   }
            }
        } else {
            const int ps = step - nmix;
            bf16_t* Qb = (bf16_t*)mixb;
            if (ps == 0) { resnorm_phase(xin, xo, (const bf16_t*)(mixb + 192 * MiB), macc + 2 * DM, Ap->in[I_NORM_G] + (size_t)(layer * 2 + 1) * DM, macc, 3 * DM, 4 * DM, Hb, gw, NGW, lane); }
            else if (ps == 1) { pg8::StaticOrder S; pg8::Gemm g{Hb, (const bf16_t*)(ws + WS_PEER_WQ) + (size_t)layer * DM * 2048, MTOK, 2048, DM, DM, DM, 0}; S.init(MTOK, 2048, G, bx);
                pg8::EpiQT E{Qb}; PHM(0x1000, pg8::gemm_phase(lds, g, S, E));
                asm volatile("s_waitcnt vmcnt(0)" ::: "memory"); __syncthreads();
                PHM(64, topk_units(lds, Qb, (const bf16_t*)(ws + WS_KEYS) + (size_t)layer * 16 * 128 * 128, (int*)(ws + WS_SELI), (float*)(ws + WS_SELW), S, tid, wid, lane)); }
            else { PHM(128, peer_gather_phase(lds, Hb, (cbytes)(ws + WS_TABU) + (size_t)layer * NEXP * DM, (cbytes)(ws + WS_TABV) + (size_t)layer * NEXP * DM, (const int*)(ws + WS_SELI), (const float*)(ws + WS_SELW),
                              (const unsigned*)(ws + WS_SCU) + (size_t)layer * NEXP, xin, (const bf16_t*)(mixb + 192 * MiB), macc + 2 * DM, xo, macc + 5 * DM,
                              layer == 3 ? Ap->in[I_FINAL_G] : Ap->in[I_NORM_G] + (size_t)((layer + 1) * 2) * DM, mod + (size_t)(layer == 3 ? 3 : layer + 1) * BATCH * 6 * DM, Hb, layer == 3, vcu, G, wid, lane)); }
        }
#if MK_ONE_LAUNCH
        if constexpr (TIME_MASK != 0) if (ph + 1 >= ph_hi) { if (ptype & TIME_MASK) t_acc += __builtin_amdgcn_s_memrealtime() - t_ph0; }
        if (ph + 1 < ph_hi) {
            XcdBarrier xbar; xbar.bar = (unsigned*)(Ap->ws + WS_BAR); xbar.x = xb_xcc_id(); xbar.st = (volatile LAS unsigned*)(lds + LDS_XB_OFF);
            if (ph == ph_lo) { cg::this_grid().sync(); if (tid0 == 0) (void)xb_add(&xbar.bar[XB_XCNT(xbar.x)], 1u); }
            else { xcd_barrier(xbar); if constexpr ((DUP_MASK & 0x800) != 0) xcd_barrier(xbar); }
            if constexpr (TIME_MASK != 0) { if (ptype & TIME_MASK) t_acc += __builtin_amdgcn_s_memrealtime() - t_ph0; }
        }
#endif
    }
    if constexpr (TIME_MASK != 0) { const unsigned long long t0 = __builtin_amdgcn_s_memrealtime(); while (__builtin_amdgcn_s_memrealtime() - t0 < 4ull * t_acc) __builtin_amdgcn_s_sleep(8); }
}

extern "C" void kernel_launch(void* const* d_in, const int* in_sizes, int n_in, void* d_out, int out_size, void* d_ws, size_t ws_size, hipStream_t stream) {
    static int grid = 0;
    if (grid == 0) {
        if (n_in != 23 || in_sizes[0] != MTOK * DM || out_size != MTOK * DM || ws_size < WS_END) {
            fprintf(stderr, "kernel_launch: unexpected shapes (n_in %d, in0 %d, out %d, ws %zu; need ws >= %zu); nothing launched\n", n_in, n_in > 0 ? in_sizes[0] : -1, out_size, ws_size, (size_t)WS_END); grid = -1; return; }
        int dev = 0, cus = 0, per_cu = 0;
        if (hipGetDevice(&dev) != hipSuccess || hipDeviceGetAttribute(&cus, hipDeviceAttributeMultiprocessorCount, dev) != hipSuccess) { grid = -1; return; }
        if (hipFuncSetAttribute((const void*)trunk_fwd, hipFuncAttributeMaxDynamicSharedMemorySize, LDS_BYTES) != hipSuccess) { fprintf(stderr, "kernel_launch: hipFuncSetAttribute failed\n"); grid = -1; return; }
        if (hipOccupancyMaxActiveBlocksPerMultiprocessor(&per_cu, (const void*)trunk_fwd, NTHREADS, LDS_BYTES) != hipSuccess || per_cu < 1) { fprintf(stderr, "kernel_launch: occupancy query says %d blocks per CU\n", per_cu); (void)hipGetLastError(); grid = -1; return; }
        grid = cus * (per_cu < 1 ? 1 : 1);
    }
    if (grid < 0) return;
    Args a{};
    for (int i = 0; i < 23; ++i) a.in[i] = (const float*)d_in[i];
    a.out = (float*)d_out; a.ws = (unsigned char*)d_ws;
#if MK_ONE_LAUNCH
    a.ph_lo = 0; a.ph_hi = NPHASES;
    void* args[] = {&a};
    hipError_t e = hipLaunchCooperativeKernel((const void*)trunk_fwd, dim3(grid), dim3(NTHREADS), args, LDS_BYTES, stream);
    if (e != hipSuccess) fprintf(stderr, "cooperative launch failed: %s (grid %d)\n", hipGetErrorString(e), grid);
#else
    for (int ph = 0; ph < NPHASES; ++ph) { a.ph_lo = ph; a.ph_hi = ph + 1; hipLaunchKernelGGL(trunk_fwd, dim3(grid), dim3(NTHREADS), LDS_BYTES, stream, a); }
#endif
}
```

```cpp
#include <hip/hip_runtime.h>
#include <hip/hip_cooperative_groups.h>
#include <cstdio>
#include <cstdint>
namespace cg = cooperative_groups;

#ifndef MK_ONE_LAUNCH
#define MK_ONE_LAUNCH 1
#endif

#define LAS __attribute__((address_space(3)))
typedef unsigned short bf16_t;
typedef short bf16x8 __attribute__((ext_vector_type(8)));
typedef float f32x2 __attribute__((ext_vector_type(2)));
typedef float f32x4 __attribute__((ext_vector_type(4)));
typedef float f32x16 __attribute__((ext_vector_type(16)));
typedef unsigned u32x2 __attribute__((ext_vector_type(2)));
typedef unsigned u32x4 __attribute__((ext_vector_type(4)));
typedef int i32x4 __attribute__((ext_vector_type(4)));
typedef __bf16 bf16x2 __attribute__((ext_vector_type(2)));

constexpr int DM = 1024, BATCH = 8, SEQ = 4096, MTOK = BATCH * SEQ, DEPTH = 4;
constexpr int GH = 3072;
constexpr int NEXP = 16384, NPICK = 128;
constexpr float EPS = 1e-6f;

constexpr size_t MiB = 1u << 20;
constexpr size_t WS_CTL = 0, WS_SCU = 0, WS_SCV = 512 * 1024, WS_MOD = 1 * MiB, ZERO_BYTES = 2 * MiB;
constexpr size_t WS_POOL_WIN = 2 * MiB, WS_POOL_WGRP = 6 * MiB, WS_POOL_WOUT = 7 * MiB;
constexpr size_t WS_CONV_WIN = 11 * MiB, WS_CONV_WOUT = 17 * MiB;
constexpr size_t WS_GMLP_WIN = 19 * MiB, WS_GMLP_WOUT = 31 * MiB;
constexpr size_t WS_PEER_WQ = 37 * MiB, WS_KEYS = 53 * MiB;
constexpr size_t WS_H = 56 * MiB;
constexpr size_t WS_SELI = 120 * MiB, WS_SELW = 136 * MiB;
constexpr size_t WS_TABU = 152 * MiB, WS_TABV = 280 * MiB;
constexpr size_t WS_MIX = 408 * MiB;
constexpr size_t WS_ADAP = 792 * MiB;
constexpr size_t WS_COEF = 804 * MiB;
constexpr size_t WS_WEFF = 820 * MiB;
constexpr size_t WS_WGS = 824 * MiB;
constexpr size_t WS_END = 825 * MiB;

__device__ __forceinline__ unsigned cvt_pk_bf16(float lo, float hi) { unsigned r; asm volatile("v_cvt_pk_bf16_f32 %0, %1, %2" : "=v"(r) : "v"(lo), "v"(hi)); return r; }
__device__ __forceinline__ int opaque(int x) { asm volatile("" : "+v"(x)); return x; }
__device__ __forceinline__ float bf_lo(unsigned w) { return __uint_as_float(w << 16); }
__device__ __forceinline__ float bf_hi(unsigned w) { return __uint_as_float(w & 0xffff0000u); }
__device__ __forceinline__ float gelu_tanh(float x) {
    const float y = x * (1.0f + 0.044715f * x * x);
    const float e = __builtin_amdgcn_exp2f(-2.302208198f * y);
    return x * __builtin_amdgcn_rcpf(1.0f + e);
}
__device__ __forceinline__ float wave_sum_all(float v) {
#pragma unroll
    for (int o = 1; o < 64; o <<= 1) v += __shfl_xor(v, o);
    return v;
}
__device__ __forceinline__ float dot2_bf16(unsigned w, unsigned x, float acc) { return __builtin_amdgcn_fdot2_f32_bf16(__builtin_bit_cast(bf16x2, w), __builtin_bit_cast(bf16x2, x), acc, false); }


__device__ __forceinline__ float dpp_row_shr(float v, int n) {
    const int iv = __builtin_bit_cast(int, v); int r;
    switch (n) { case 1: r = __builtin_amdgcn_update_dpp(0, iv, 0x111, 0xf, 0xf, true); break; case 2: r = __builtin_amdgcn_update_dpp(0, iv, 0x112, 0xf, 0xf, true); break;
                 case 4: r = __builtin_amdgcn_update_dpp(0, iv, 0x114, 0xf, 0xf, true); break; default: r = __builtin_amdgcn_update_dpp(0, iv, 0x118, 0xf, 0xf, true); break; }
    return __builtin_bit_cast(float, r);
}
__device__ __forceinline__ float wave_sum_uniform(float v) {
    v += dpp_row_shr(v, 1); v += dpp_row_shr(v, 2); v += dpp_row_shr(v, 4); v += dpp_row_shr(v, 8);
    v += __builtin_bit_cast(float, __builtin_amdgcn_update_dpp(0, __builtin_bit_cast(int, v), 0x142, 0xa, 0xf, false));
    v += __builtin_bit_cast(float, __builtin_amdgcn_update_dpp(0, __builtin_bit_cast(int, v), 0x143, 0xc, 0xf, false));
    return __uint_as_float(__builtin_amdgcn_readlane(__float_as_uint(v), 63));
}

namespace pg8 {
constexpr int BM = 256, BK = 64, HALF = 128, HTB = HALF * BK * 2, STAGE_BYTES = 8 * HTB, NXCD = 8, WGM = 8;
__device__ __forceinline__ int lds_byte(int r, int c) { const int st = (r >> 4) * 2 + (c >> 5), rr = r & 15, cc = c & 31, ob = rr * 64 + cc * 2; return st * 1024 + (ob ^ (((ob >> 9) & 1) << 5)); }
__device__ __forceinline__ void stage_rc(int b, int& R, int& C) { const int st = b / 1024, sb = b % 1024, swz = sb ^ (((sb >> 9) & 1) << 5); R = (st >> 1) * 16 + swz / 64; C = (st & 1) * 32 + (swz % 64) / 2; }
__device__ __forceinline__ int perm32(int rho) { const int n = rho >> 4, i = rho & 15; return 8 * (i >> 2) + 4 * n + (i & 3); }

struct Unit { int pm, pn; };
struct Gemm { const bf16_t* A; const bf16_t* Bt; int M, N, K, lda, ldb, a_pn_off; };

struct StaticOrder {
    int nM, nN, nwg, G, c;
    __device__ __forceinline__ void init(int M, int N, int G_, int c_) { nM = M / BM; nN = N / BM; nwg = nM * nN; G = G_; c = c_; }
    __device__ __forceinline__ bool next(int i, Unit& u) const {
        const int L = i * G + c; if (L >= nwg) return false;
        int wgid = L; { const int q = nwg / NXCD, r = nwg % NXCD, xcd = wgid % NXCD, off = wgid / NXCD; wgid = (xcd < r ? xcd * (q + 1) : r * (q + 1) + (xcd - r) * q) + off; }
        const int nig = WGM * nN, gid = wgid / nig, fm = gid * WGM, gsz = (nM - fm) < WGM ? (nM - fm) : WGM;
        u.pm = fm + ((wgid % nig) % gsz); u.pn = (wgid % nig) / gsz; return true;
    }
};

template <class Epi>
__device__ __forceinline__ void gemm_phase(LAS unsigned char* lds, const Gemm g, const StaticOrder& S, const Epi& E) {
    const int tid = opaque((int)threadIdx.x), wid = __builtin_amdgcn_readfirstlane(tid >> 6), lane = tid & 63, wr = wid >> 2, wc = wid & 3, fr = lane & 15, fq = lane >> 4;
    int nt = g.K / BK; asm volatile("" : "+s"(nt));
    unsigned voffA[2], voffB[2];
#pragma unroll
    for (int i = 0; i < 2; ++i) { int R, C; stage_rc(tid * 16 + i * 8192, R, C); const int Rb = Epi::PERM ? ((R & ~31) + perm32(R & 31)) : R;
        voffA[i] = (unsigned)(R * g.lda + C) * 2u; voffB[i] = (unsigned)(Rb * g.ldb + C) * 2u; }
    const size_t kstep = (size_t)(BK * 2);
    const size_t hstepA = (size_t)HALF * g.lda * 2, hstepB = (size_t)HALF * g.ldb * 2;
    const size_t tstepA = 2 * hstepA, tstepB = 2 * hstepB;
    const unsigned ldsw = (unsigned)wid * 1024u;
    const int aoff = lds_byte(wr * 64 + fr, fq * 8), boff = lds_byte(wc * 32 + fr, fq * 8);
#define PG8_SA(b, h) (((b) * 2 + (h)) * HTB)
#define PG8_SB(b, h) ((4 + (b) * 2 + (h)) * HTB)
#define PG8_STAGE(bufoff, gbase, voff) do { _Pragma("unroll") for (int _i = 0; _i < 2; ++_i) \
        __builtin_amdgcn_global_load_lds((const unsigned*)((const char*)(gbase) + (voff)[_i]), (LAS unsigned*)(lds + (bufoff) + ldsw + _i * 8192), 16, 0, 0); } while (0)
#define PG8_LDA(dst, b, h) do { _Pragma("unroll") for (int m = 0; m < 4; ++m) _Pragma("unroll") for (int k = 0; k < 2; ++k) dst[m][k] = *(const LAS bf16x8*)(lds + PG8_SA(b, h) + aoff + m * 2048 + k * 1024); } while (0)
#define PG8_LDB(dst, b, h) do { _Pragma("unroll") for (int n = 0; n < 2; ++n) _Pragma("unroll") for (int k = 0; k < 2; ++k) dst[n][k] = *(const LAS bf16x8*)(lds + PG8_SB(b, h) + boff + n * 2048 + k * 1024); } while (0)
#define PG8_MMA(ai, bj, At, Bt) do { __builtin_amdgcn_s_setprio(1); _Pragma("unroll") for (int m = 0; m < 4; ++m) _Pragma("unroll") for (int n = 0; n < 2; ++n) _Pragma("unroll") for (int k = 0; k < 2; ++k) \
        acc[ai][bj][m][n] = Epi::SWAP ? __builtin_amdgcn_mfma_f32_16x16x32_bf16(At[m][k], Bt[n][k], acc[ai][bj][m][n], 0, 0, 0) \
                                      : __builtin_amdgcn_mfma_f32_16x16x32_bf16(Bt[n][k], At[m][k], acc[ai][bj][m][n], 0, 0, 0); __builtin_amdgcn_s_setprio(0); } while (0)
#define PG8_WAIT_V(n) asm volatile("s_waitcnt vmcnt(" #n ")" ::: "memory")
#define PG8_WAIT_L(n) asm volatile("s_waitcnt lgkmcnt(" #n ")" ::: "memory")
#define PG8_BAR __builtin_amdgcn_s_barrier()
#define PG8_SCHED __builtin_amdgcn_sched_barrier(0)
    Unit cur, nxt; int ui = 0;
    if (!S.next(0, cur)) return;
    f32x4 acc[2][2][4][2];
#pragma unroll
    for (int a = 0; a < 2; ++a)
#pragma unroll
        for (int b = 0; b < 2; ++b)
#pragma unroll
            for (int m = 0; m < 4; ++m)
#pragma unroll
                for (int n = 0; n < 2; ++n) acc[a][b][m][n] = (f32x4){0.f, 0.f, 0.f, 0.f};
    bf16x8 At[4][2], B0[2][2], B1[2][2];
    const char* cA = (const char*)g.A + (size_t)cur.pm * tstepA + (size_t)cur.pn * g.a_pn_off * 2; const char* cB = (const char*)g.Bt + (size_t)cur.pn * tstepB;
    PG8_STAGE(PG8_SB(0, 0), cB, voffB); PG8_STAGE(PG8_SB(0, 1), cB + hstepB, voffB); PG8_STAGE(PG8_SA(0, 0), cA, voffA); PG8_STAGE(PG8_SA(0, 1), cA + hstepA, voffA);
    if (wr == 1) PG8_BAR;
    PG8_WAIT_V(2); PG8_BAR;
    PG8_STAGE(PG8_SB(1, 0), cB + kstep, voffB); PG8_STAGE(PG8_SA(1, 0), cA + kstep, voffA); PG8_STAGE(PG8_SB(1, 1), cB + hstepB + kstep, voffB);
    PG8_WAIT_V(6); PG8_BAR;
    for (;;) {
        const bool has_next = S.next(ui + 1, nxt);
        const char* nA = has_next ? (const char*)g.A + (size_t)nxt.pm * tstepA + (size_t)nxt.pn * g.a_pn_off * 2 : cA; const char* nB = has_next ? (const char*)g.Bt + (size_t)nxt.pn * tstepB : cB;
        for (int t = 0; t < nt; t += 2) {
            const bool last = (t == nt - 2);
            const char* a1 = cA + (size_t)(t + 1) * kstep;
            const char* a2 = last ? nA : cA + (size_t)(t + 2) * kstep; const char* b2 = last ? nB : cB + (size_t)(t + 2) * kstep;
            const char* a3 = a2 + kstep; const char* b3 = b2 + kstep;
            PG8_LDB(B0, 0, 0); PG8_LDB(B1, 0, 1); PG8_SCHED; PG8_LDA(At, 0, 0); PG8_STAGE(PG8_SA(1, 1), a1 + hstepA, voffA);
            PG8_WAIT_V(8); PG8_WAIT_L(0); PG8_BAR; PG8_MMA(0, 0, At, B0); PG8_MMA(0, 1, At, B1); PG8_BAR; PG8_SCHED;
            PG8_LDA(At, 0, 1); PG8_STAGE(PG8_SB(0, 0), b2, voffB); PG8_STAGE(PG8_SB(0, 1), b2 + hstepB, voffB); PG8_STAGE(PG8_SA(0, 0), a2, voffA);
            PG8_WAIT_V(8); PG8_WAIT_L(0); PG8_BAR; PG8_MMA(1, 0, At, B0); PG8_MMA(1, 1, At, B1); PG8_BAR; PG8_SCHED;
            PG8_LDB(B0, 1, 0); PG8_LDB(B1, 1, 1); PG8_SCHED; PG8_LDA(At, 1, 0); PG8_STAGE(PG8_SA(0, 1), a2 + hstepA, voffA);
            PG8_WAIT_V(8); PG8_WAIT_L(0); PG8_BAR; PG8_MMA(0, 0, At, B0); PG8_MMA(0, 1, At, B1); PG8_BAR; PG8_SCHED;
            PG8_LDA(At, 1, 1); PG8_STAGE(PG8_SB(1, 0), b3, voffB); PG8_STAGE(PG8_SB(1, 1), b3 + hstepB, voffB); PG8_STAGE(PG8_SA(1, 0), a3, voffA);
            PG8_WAIT_V(8); PG8_WAIT_L(0); PG8_BAR; PG8_MMA(1, 0, At, B0); PG8_MMA(1, 1, At, B1); PG8_BAR; PG8_SCHED;
        }
        { const int l2 = opaque((int)threadIdx.x) & 63; E(acc, cur, wr, wc, l2 & 15, l2 >> 4); }
        if (!has_next) break;
#pragma unroll
        for (int a = 0; a < 2; ++a)
#pragma unroll
            for (int b = 0; b < 2; ++b)
#pragma unroll
                for (int m = 0; m < 4; ++m)
#pragma unroll
                    for (int n = 0; n < 2; ++n) acc[a][b][m][n] = (f32x4){0.f, 0.f, 0.f, 0.f};
        cur = nxt; cA = nA; cB = nB; ++ui;
    }
    PG8_WAIT_V(0);
    if (wr == 0) PG8_BAR;
    PG8_BAR;
#undef PG8_SA
#undef PG8_SB
#undef PG8_STAGE
#undef PG8_LDA
#undef PG8_LDB
#undef PG8_MMA
#undef PG8_WAIT_V
#undef PG8_WAIT_L
#undef PG8_BAR
#undef PG8_SCHED
}

template <int ACT> struct EpiBf16 {
    static constexpr bool PERM = true, SWAP = false;
    bf16_t* O; int ldc;
    __device__ __forceinline__ void operator()(const f32x4 (&acc)[2][2][4][2], const Unit& u, int wr, int wc, int fr, int fq) const {
        const int row0 = u.pm * BM + wr * 64 + fr, col0 = u.pn * BM + wc * 32 + 8 * fq;
#pragma unroll
        for (int ai = 0; ai < 2; ++ai)
#pragma unroll
            for (int m = 0; m < 4; ++m) { bf16_t* rowp = O + (size_t)(row0 + ai * HALF + m * 16) * ldc + col0;
#pragma unroll
                for (int bj = 0; bj < 2; ++bj) { f32x4 v0 = acc[ai][bj][m][0], v1 = acc[ai][bj][m][1];
                    if (ACT == 1) {
#pragma unroll
                        for (int j = 0; j < 4; ++j) { v0[j] = gelu_tanh(v0[j]); v1[j] = gelu_tanh(v1[j]); } }
                    u32x4 w; w.x = cvt_pk_bf16(v0[0], v0[1]); w.y = cvt_pk_bf16(v0[2], v0[3]); w.z = cvt_pk_bf16(v1[0], v1[1]); w.w = cvt_pk_bf16(v1[2], v1[3]);
                    *(u32x4*)(rowp + bj * HALF) = w; } }
    }
};
struct EpiQT {
    static constexpr bool PERM = true, SWAP = false;
    bf16_t* O;
    __device__ __forceinline__ void operator()(const f32x4 (&acc)[2][2][4][2], const Unit& u, int wr, int wc, int fr, int fq) const {
        const int row0 = u.pm * BM + wr * 64 + fr;
#pragma unroll
        for (int ai = 0; ai < 2; ++ai)
#pragma unroll
            for (int m = 0; m < 4; ++m) { const int row = row0 + ai * HALF + m * 16;
                bf16_t* base = O + ((size_t)((row >> 7) * 8 + u.pn) * 32 * 128 + (row & 127)) * 8;
#pragma unroll
                for (int bj = 0; bj < 2; ++bj) { const f32x4 v0 = acc[ai][bj][m][0], v1 = acc[ai][bj][m][1];
                    u32x4 w; w.x = cvt_pk_bf16(v0[0], v0[1]); w.y = cvt_pk_bf16(v0[2], v0[3]); w.z = cvt_pk_bf16(v1[0], v1[1]); w.w = cvt_pk_bf16(v1[2], v1[3]);
                    *(u32x4*)(base + (size_t)(16 * bj + 4 * wc + fq) * 128 * 8) = w; } }
    }
};
struct EpiPoolGrp {
    static constexpr bool PERM = true, SWAP = false;
    bf16_t* O; const float* scale;
    __device__ __forceinline__ void operator()(const f32x4 (&acc)[2][2][4][2], const Unit& u, int wr, int wc, int fr, int fq) const {
        const int row0 = u.pm * BM + wr * 64 + fr, col0 = u.pn * BM + wc * 32 + 8 * fq;
#pragma unroll
        for (int bj = 0; bj < 2; ++bj) {
            const f32x4 s0 = *(const f32x4*)(scale + col0 + bj * HALF), s1 = *(const f32x4*)(scale + col0 + bj * HALF + 4);
#pragma unroll
            for (int ai = 0; ai < 2; ++ai)
#pragma unroll
                for (int m = 0; m < 4; ++m) { bf16_t* rowp = O + (size_t)(row0 + ai * HALF + m * 16) * DM + col0 + bj * HALF;
                    const f32x4 v0 = acc[ai][bj][m][0] * s0, v1 = acc[ai][bj][m][1] * s1;
                    u32x4 w; w.x = cvt_pk_bf16(v0[0], v0[1]); w.y = cvt_pk_bf16(v0[2], v0[3]); w.z = cvt_pk_bf16(v1[0], v1[1]); w.w = cvt_pk_bf16(v1[2], v1[3]);
                    *(u32x4*)rowp = w; }
            asm volatile("" ::: "memory");
        }
    }
};
struct EpiConvIn {
    static constexpr bool PERM = true, SWAP = false;
    bf16_t* BG; bf16_t* Z;
    __device__ __forceinline__ void operator()(const f32x4 (&acc)[2][2][4][2], const Unit& u, int wr, int wc, int fr, int fq) const {
        const int row0 = u.pm * BM + wr * 64 + fr;
        if (u.pn < 4) {
            const int col0 = u.pn * BM + wc * 32 + 8 * fq;
#pragma unroll
            for (int ai = 0; ai < 2; ++ai)
#pragma unroll
                for (int m = 0; m < 4; ++m) { bf16_t* rowp = BG + (size_t)(row0 + ai * HALF + m * 16) * DM + col0;
#pragma unroll
                    for (int bj = 0; bj < 2; ++bj) { const f32x4 v0 = acc[ai][bj][m][0], v1 = acc[ai][bj][m][1];
                        u32x4 w; w.x = cvt_pk_bf16(v0[0], v0[1]); w.y = cvt_pk_bf16(v0[2], v0[3]); w.z = cvt_pk_bf16(v1[0], v1[1]); w.w = cvt_pk_bf16(v1[2], v1[3]);
                        *(u32x4*)(rowp + bj * HALF) = w; } }
        } else {
            const int col0 = (u.pn - 4) * HALF + wc * 32 + 8 * fq;
#pragma unroll
            for (int ai = 0; ai < 2; ++ai)
#pragma unroll
                for (int m = 0; m < 4; ++m) { bf16_t* rowp = Z + (size_t)(row0 + ai * HALF + m * 16) * DM + col0;
                    const f32x4 v0 = acc[ai][0][m][0] * acc[ai][1][m][0], v1 = acc[ai][0][m][1] * acc[ai][1][m][1];
                    u32x4 w; w.x = cvt_pk_bf16(v0[0], v0[1]); w.y = cvt_pk_bf16(v0[2], v0[3]); w.z = cvt_pk_bf16(v1[0], v1[1]); w.w = cvt_pk_bf16(v1[2], v1[3]);
                    *(u32x4*)rowp = w; }
        }
    }
};
struct EpiResid {
    static constexpr bool PERM = false, SWAP = false;
    const float* base; float* out; const float* gacc; const float* gbias;
    __device__ __forceinline__ void operator()(const f32x4 (&acc)[2][2][4][2], const Unit& u, int wr, int wc, int fr, int fq) const {
        const int row0 = u.pm * BM + wr * 64 + fr, col0 = u.pn * BM + wc * 32 + 4 * fq;
        const float* gp = gacc + (size_t)(u.pm >> 4) * (6 * DM);
#pragma unroll
        for (int bj = 0; bj < 2; ++bj)
#pragma unroll
            for (int n = 0; n < 2; ++n) { const int cc = col0 + bj * HALF + n * 16;
                const f32x4 gv = *(const f32x4*)(gp + cc);
#pragma unroll
                for (int ai = 0; ai < 2; ++ai) {
#pragma unroll
                    for (int m = 0; m < 4; ++m) { const size_t off = (size_t)(row0 + ai * HALF + m * 16) * DM + cc;
                        const f32x4 bs = *(const f32x4*)(base + off);
                        *(f32x4*)(out + off) = bs + gv * acc[ai][bj][m][n]; }
                    asm volatile("" ::: "memory"); } }
    }
};
struct EpiGmlpV {
    static constexpr bool PERM = false, SWAP = true;
    bf16_t* VT;
    __device__ __forceinline__ void operator()(const f32x4 (&acc)[2][2][4][2], const Unit& u, int wr, int wc, int fr, int fq) const {
        const int row0 = u.pm * BM + wr * 64 + 4 * fq, col0 = u.pn * BM + wc * 32 + fr;
#pragma unroll
        for (int bj = 0; bj < 2; ++bj)
#pragma unroll
            for (int n = 0; n < 2; ++n) { const int c = col0 + bj * HALF + n * 16;
#pragma unroll
                for (int ai = 0; ai < 2; ++ai)
#pragma unroll
                    for (int m = 0; m < 4; ++m) { const f32x4 v = acc[ai][bj][m][n]; const int r = row0 + ai * HALF + m * 16;
                        u32x2 w; w.x = cvt_pk_bf16(gelu_tanh(v[0]), gelu_tanh(v[1])); w.y = cvt_pk_bf16(gelu_tanh(v[2]), gelu_tanh(v[3]));
                        *(u32x2*)(VT + ((size_t)(r >> 7) * GH + c) * 128 + (r & 127)) = w; } }
    }
};
}

constexpr int RING_BYTES = 131072;
constexpr int LDS_BYTES = 147456;
constexpr int LDS_XB_OFF = LDS_BYTES - 64;
constexpr int NTHREADS = 512;

#define CE_DESC(a, b) do { const float _x = fmaxf(a, b), _y = fminf(a, b); a = _x; b = _y; } while (0)
#define CE_ASC(a, b)  do { const float _x = fminf(a, b), _y = fmaxf(a, b); a = _x; b = _y; } while (0)
template <int OFF, int N>
__device__ __forceinline__ void sort16_desc(float (&v)[N]) {
#pragma unroll
    for (int k = 2; k <= 16; k <<= 1)
#pragma unroll
        for (int j = k >> 1; j > 0; j >>= 1)
#pragma unroll
            for (int i = 0; i < 16; ++i) { const int l = i ^ j; if (l > i) { if ((i & k) == 0) CE_DESC(v[OFF + i], v[OFF + l]); else CE_ASC(v[OFF + i], v[OFF + l]); } }
}
template <int OFF, int N>
__device__ __forceinline__ void bmerge16_desc(float (&v)[N]) {
#pragma unroll
    for (int j = 8; j > 0; j >>= 1)
#pragma unroll
        for (int i = 0; i < 16; ++i) { const int l = i ^ j; if (l > i) CE_DESC(v[OFF + i], v[OFF + l]); }
}
template <int A, int B, int N>
__device__ __forceinline__ void merge_top16(float (&v)[N]) {
#pragma unroll
    for (int i = 0; i < 16; ++i) v[A + i] = fmaxf(v[A + i], v[B + 15 - i]);
    bmerge16_desc<A, N>(v);
}
__device__ __forceinline__ void top16_of_64(float (&v)[64]) {
    sort16_desc<0, 64>(v); sort16_desc<16, 64>(v); sort16_desc<32, 64>(v); sort16_desc<48, 64>(v);
    merge_top16<0, 16, 64>(v); merge_top16<32, 48, 64>(v); merge_top16<0, 32, 64>(v);
}

struct Args { const float* in[23]; float* out; unsigned char* ws; int ph_lo, ph_hi; };
typedef const __attribute__((address_space(4))) Args* ArgP;
enum { I_X = 0, I_C, I_ADA_W, I_ADA_B, I_NORM_G, I_POOL_WIN, I_POOL_WGRP, I_POOL_SCALE, I_POOL_WOUT, I_CONV_WIN, I_CONV_W, I_CONV_WOUT,
       I_GMLP_WIN, I_GMLP_LNG, I_GMLP_LNB, I_GMLP_WS, I_GMLP_BS, I_GMLP_WOUT, I_PEER_WQ, I_PEER_KEYS, I_PEER_U, I_PEER_V, I_FINAL_G };

__device__ __forceinline__ void transpose_item(const float* W, int K, int N, bf16_t* WT, int dst_row0, LAS float* scr, int k0, int n0, int lane) {
#pragma unroll 8
    for (int i = 0; i < 32; ++i) { const int kk = 2 * i + (lane >> 5); scr[kk * 33 + (lane & 31)] = W[(size_t)(k0 + kk) * N + n0 + (lane & 31)]; }
    asm volatile("s_waitcnt lgkmcnt(0)" ::: "memory");
    const int c = lane & 7;
#pragma unroll
    for (int j = 0; j < 4; ++j) { const int n = (lane >> 3) + 8 * j; const LAS float* s = scr + (8 * c) * 33 + n;
        u32x4 o; o.x = cvt_pk_bf16(s[0 * 33], s[1 * 33]); o.y = cvt_pk_bf16(s[2 * 33], s[3 * 33]); o.z = cvt_pk_bf16(s[4 * 33], s[5 * 33]); o.w = cvt_pk_bf16(s[6 * 33], s[7 * 33]);
        *(u32x4*)(WT + (size_t)(dst_row0 + n) * K + k0 + 8 * c) = o; }
    asm volatile("s_waitcnt lgkmcnt(0)" ::: "memory");
}
__device__ __forceinline__ void convert_stream(const float* src, bf16_t* dst, size_t n8, size_t gt, size_t stride) {
    for (size_t i = gt; i < n8; i += stride) {
        const f32x4 a = __builtin_nontemporal_load((const f32x4*)src + 2 * i), b = __builtin_nontemporal_load((const f32x4*)src + 2 * i + 1);
        u32x4 o; o.x = cvt_pk_bf16(a[0], a[1]); o.y = cvt_pk_bf16(a[2], a[3]); o.z = cvt_pk_bf16(b[0], b[1]); o.w = cvt_pk_bf16(b[2], b[3]);
        *((u32x4*)dst + i) = o; }
}
__device__ __forceinline__ void prologue_phase(ArgP Ap, LAS unsigned char* lds, int vcu, int G, int tid, int wid, int lane) {
    unsigned char* ws = Ap->ws;
    const int gw = vcu * 8 + wid, NGW = G * 8;
    LAS float* scr = (LAS float*)(lds + wid * 16384);
    constexpr int NT_ITEMS = 1024 + 256 + 1024 + 1536 + 512 + 3072 + 1536 + 4096;
    for (int it = gw; it < NT_ITEMS; it += NGW) {
        int r = it; const float* src; bf16_t* dst; int K, N, kind = 0;
        if (r < 1024) { const int m = r >> 9; r &= 511; src = Ap->in[I_POOL_WIN] + (size_t)m * DM * DM; dst = (bf16_t*)(ws + WS_POOL_WIN) + (size_t)m * DM * DM; K = DM; N = DM; }
        else if ((r -= 1024) < 256) { const int m = r >> 5; r &= 31; src = Ap->in[I_POOL_WGRP] + (size_t)m * 65536; dst = (bf16_t*)(ws + WS_POOL_WGRP) + (size_t)m * 65536; K = 256; N = 256; }
        else if ((r -= 256) < 1024) { const int m = r >> 9; r &= 511; src = Ap->in[I_POOL_WOUT] + (size_t)m * DM * DM; dst = (bf16_t*)(ws + WS_POOL_WOUT) + (size_t)m * DM * DM; K = DM; N = DM; }
        else if ((r -= 1024) < 1536) { src = Ap->in[I_CONV_WIN]; dst = (bf16_t*)(ws + WS_CONV_WIN); K = DM; N = 3 * DM; kind = 1; }
        else if ((r -= 1536) < 512) { src = Ap->in[I_CONV_WOUT]; dst = (bf16_t*)(ws + WS_CONV_WOUT); K = DM; N = DM; }
        else if ((r -= 512) < 3072) { src = Ap->in[I_GMLP_WIN]; dst = (bf16_t*)(ws + WS_GMLP_WIN); K = DM; N = 2 * GH; }
        else if ((r -= 3072) < 1536) { src = Ap->in[I_GMLP_WOUT]; dst = (bf16_t*)(ws + WS_GMLP_WOUT); K = GH; N = DM; }
        else { r -= 1536; const int m = r >> 10; r &= 1023; src = Ap->in[I_PEER_WQ] + (size_t)m * DM * 2048; dst = (bf16_t*)(ws + WS_PEER_WQ) + (size_t)m * DM * 2048; K = DM; N = 2048; }
        const int nblk = N / 32, kb = r / nblk, nb = r % nblk, n0 = 32 * nb;
        int drow = n0;
        if (kind == 1 && n0 >= DM) { const int xt = n0 >= 2 * DM, ch = n0 - (xt ? 2 * DM : DM); drow = DM + 256 * (ch >> 7) + 128 * xt + (ch & 127); }
        transpose_item(src, K, N, dst, drow, scr, 64 * kb, n0, lane);
    }
    const size_t gt = (size_t)vcu * NTHREADS + tid, stride = (size_t)G * NTHREADS;
    convert_stream(Ap->in[I_PEER_KEYS], (bf16_t*)(ws + WS_KEYS), (size_t)DEPTH * 16 * 128 * 128 / 8, gt, stride);
    for (int row0 = gw * 4; row0 < 2 * DEPTH * NEXP; row0 += NGW * 4) {
        f32x4 v[4][4]; float m[4];
#pragma unroll
        for (int rr = 0; rr < 4; ++rr) { const int row = row0 + rr, tab = row >> 16, lrow = row & 65535;
            const f32x4* src = (const f32x4*)((tab ? Ap->in[I_PEER_V] : Ap->in[I_PEER_U]) + (size_t)lrow * DM) + lane;
#pragma unroll
            for (int j = 0; j < 4; ++j) v[rr][j] = __builtin_nontemporal_load(src + 64 * j); }
#pragma unroll
        for (int rr = 0; rr < 4; ++rr) { float mm = 0.f;
#pragma unroll
            for (int j = 0; j < 4; ++j) mm = fmaxf(fmaxf(mm, fmaxf(fabsf(v[rr][j][0]), fabsf(v[rr][j][1]))), fmaxf(fabsf(v[rr][j][2]), fabsf(v[rr][j][3])));
#pragma unroll
            for (int o = 1; o < 64; o <<= 1) mm = fmaxf(mm, __shfl_xor(mm, o));
            m[rr] = mm; }
#pragma unroll
        for (int rr = 0; rr < 4; ++rr) { const int row = row0 + rr, tab = row >> 16, lrow = row & 65535, l = lrow >> 14, e = lrow & (NEXP - 1);
            const float S = m[rr] > 0.f ? 256.0f / m[rr] : 1.0f;
            unsigned char* dst = ws + (tab ? WS_TABV : WS_TABU);
#pragma unroll
            for (int j = 0; j < 4; ++j) { int pk = __builtin_amdgcn_cvt_pk_fp8_f32(v[rr][j][0] * S, v[rr][j][1] * S, 0, false); pk = __builtin_amdgcn_cvt_pk_fp8_f32(v[rr][j][2] * S, v[rr][j][3] * S, pk, true);
                const int d0 = 256 * j + 4 * lane;
                *(int*)(dst + (((size_t)l * 8 + (d0 >> 7)) * NEXP + e) * 128 + (d0 & 127)) = pk; }
            if (lane == 0) ((unsigned short*)(ws + WS_SCU))[2 * lrow + tab] = (unsigned short)(cvt_pk_bf16(m[rr] > 0.f ? m[rr] * (1.0f / 256.0f) : 1.0f, 0.f) & 0xffffu); }
    }
    for (size_t i = gt; i < (size_t)2 * 4 * 256 * 256 / 8; i += stride) { const size_t idx = i * 8; const int l = (int)(idx >> 18), g = (int)(idx >> 16) & 3, j0 = (int)idx & 255;
        const f32x4 a = *((const f32x4*)Ap->in[I_POOL_WGRP] + 2 * i), b = *((const f32x4*)Ap->in[I_POOL_WGRP] + 2 * i + 1);
        const float* sp = Ap->in[I_POOL_SCALE] + (size_t)l * DM + 256 * g + j0; const f32x4 sa = *(const f32x4*)sp, sb = *(const f32x4*)(sp + 4);
        u32x4 o; o.x = cvt_pk_bf16(a[0] * sa[0], a[1] * sa[1]); o.y = cvt_pk_bf16(a[2] * sa[2], a[3] * sa[3]); o.z = cvt_pk_bf16(b[0] * sb[0], b[1] * sb[1]); o.w = cvt_pk_bf16(b[2] * sb[2], b[3] * sb[3]);
        *((u32x4*)(ws + WS_WGS) + i) = o; }
    __syncthreads();
    LAS float* cond = (LAS float*)lds;
    for (int i = tid; i < BATCH * DM; i += NTHREADS) { const int b = i >> 10, k = i & 1023; const float c = Ap->in[I_C][i]; cond[k * 8 + b] = c * __builtin_amdgcn_rcpf(1.0f + __expf(-c)); }
    __syncthreads();
    float* modp = (float*)(ws + WS_ADAP);
    for (int it = gw; it < DEPTH * 24 * 16; it += NGW) {
        const int l = it / 384, r = it % 384, cgp = r >> 4, kc = r & 15;
        const float* wp = Ap->in[I_ADA_W] + ((size_t)l * DM + kc * 64) * (6 * DM) + cgp * 256 + 4 * lane;
        f32x4 acc[8];
#pragma unroll
        for (int b = 0; b < 8; ++b) acc[b] = (f32x4){0.f, 0.f, 0.f, 0.f};
#pragma unroll 8
        for (int k = 0; k < 64; ++k) { const f32x4 w = __builtin_nontemporal_load((const f32x4*)(wp + (size_t)k * (6 * DM)));
            const f32x4 c0 = *(const LAS f32x4*)(cond + (kc * 64 + k) * 8), c1 = *(const LAS f32x4*)(cond + (kc * 64 + k) * 8 + 4);
            acc[0] += c0[0] * w; acc[1] += c0[1] * w; acc[2] += c0[2] * w; acc[3] += c0[3] * w; acc[4] += c1[0] * w; acc[5] += c1[1] * w; acc[6] += c1[2] * w; acc[7] += c1[3] * w; }
#pragma unroll
        for (int b = 0; b < 8; ++b) *(f32x4*)(modp + (((size_t)kc * DEPTH + l) * 8 + b) * (6 * DM) + cgp * 256 + 4 * lane) = acc[b];
    }
}
__device__ __forceinline__ void modreduce_phase(ArgP Ap, int vcu, int G, int tid) {
    unsigned char* ws = Ap->ws; const float* modp = (const float*)(ws + WS_ADAP); float* mod = (float*)(ws + WS_MOD);
    constexpr int N4 = DEPTH * BATCH * 6 * DM / 4;
    for (int i = vcu * NTHREADS + tid; i < N4; i += G * NTHREADS) {
        const int n4 = i % (6 * DM / 4), l = i / (BATCH * 6 * DM / 4);
        f32x4 a = *((const f32x4*)(Ap->in[I_ADA_B] + (size_t)l * 6 * DM) + n4);
#pragma unroll
        for (int kc = 0; kc < 16; ++kc) a += *((const f32x4*)modp + (size_t)kc * N4 + i);
        *((f32x4*)mod + i) = a; }
}

__device__ __forceinline__ void norm_phase(const float* x, const float* gn, const float* macc  , const float* mbias  , int sh_off, int sc_off, bf16_t* H, int gw, int NGW, int lane) {
    for (int ch = gw; ch < MTOK / 16; ch += NGW) {
        const int row0 = ch * 16, b = row0 >> 12;
        f32x4 c1[4], shv[4];
#pragma unroll
        for (int j = 0; j < 4; ++j) { const int col = 4 * lane + 256 * j;
            const f32x4 sc = *(const f32x4*)(macc + (size_t)b * 6 * DM + sc_off + col);
            c1[j] = *(const f32x4*)(gn + col) * (1.0f + sc);
            shv[j] = *(const f32x4*)(macc + (size_t)b * 6 * DM + sh_off + col); }
        for (int r = row0; r < row0 + 16; ++r) {
            const f32x4* xr = (const f32x4*)(x + (size_t)r * DM) + lane;
            f32x4 v[4]; float ss = 0.f;
#pragma unroll
            for (int j = 0; j < 4; ++j) { v[j] = xr[64 * j]; ss += (v[j][0] * v[j][0] + v[j][1] * v[j][1]) + (v[j][2] * v[j][2] + v[j][3] * v[j][3]); }
            const float rstd = __builtin_amdgcn_rsqf(wave_sum_all(ss) * (1.0f / DM) + EPS);
            u32x2* o8 = (u32x2*)(H + (size_t)r * DM) + lane;
#pragma unroll
            for (int j = 0; j < 4; ++j) { const f32x4 o = v[j] * rstd * c1[j] + shv[j]; u32x2 w; w.x = cvt_pk_bf16(o[0], o[1]); w.y = cvt_pk_bf16(o[2], o[3]); o8[64 * j] = w; }
        }
    }
}
__device__ __forceinline__ void resnorm_phase(const float* xf  , const bf16_t* xsi, bf16_t* xso  , const bf16_t* Y, const float* gate  , const float* gn, const float* macc, int sh_off, int sc_off, bf16_t* H, int gw, int NGW, int lane) {
    for (int ch = gw; ch < MTOK / 16; ch += NGW) {
        const int row0 = ch * 16, b = row0 >> 12;
        f32x4 c1[4], shv[4], gt[4];
#pragma unroll
        for (int j = 0; j < 4; ++j) { const int col = 4 * lane + 256 * j;
            const f32x4 sc = *(const f32x4*)(macc + (size_t)b * 6 * DM + sc_off + col);
            c1[j] = *(const f32x4*)(gn + col) * (1.0f + sc);
            shv[j] = *(const f32x4*)(macc + (size_t)b * 6 * DM + sh_off + col);
            gt[j] = *(const f32x4*)(gate + (size_t)b * 6 * DM + col); }
        for (int r = row0; r < row0 + 16; ++r) {
            const u32x2* yr = (const u32x2*)(Y + (size_t)r * DM) + lane;
            f32x4 v[4]; float ss = 0.f;
            if (xf) { const f32x4* xr = (const f32x4*)(xf + (size_t)r * DM) + lane;
#pragma unroll
                for (int j = 0; j < 4; ++j) v[j] = xr[64 * j]; }
            else { const u32x2* xr = (const u32x2*)(xsi + (size_t)r * DM) + lane;
#pragma unroll
                for (int j = 0; j < 4; ++j) { const u32x2 xv = xr[64 * j]; v[j] = (f32x4){bf_lo(xv.x), bf_hi(xv.x), bf_lo(xv.y), bf_hi(xv.y)}; } }
            u32x2* xw = (u32x2*)(xso + (size_t)r * DM) + lane;
#pragma unroll
            for (int j = 0; j < 4; ++j) { const u32x2 y = yr[64 * j]; v[j] += gt[j] * (f32x4){bf_lo(y.x), bf_hi(y.x), bf_lo(y.y), bf_hi(y.y)};
                u32x2 w; w.x = cvt_pk_bf16(v[j][0], v[j][1]); w.y = cvt_pk_bf16(v[j][2], v[j][3]); xw[64 * j] = w;
                ss += (v[j][0] * v[j][0] + v[j][1] * v[j][1]) + (v[j][2] * v[j][2] + v[j][3] * v[j][3]); }
            const float rstd = __builtin_amdgcn_rsqf(wave_sum_all(ss) * (1.0f / DM) + EPS);
            u32x2* o8 = (u32x2*)(H + (size_t)r * DM) + lane;
#pragma unroll
            for (int j = 0; j < 4; ++j) { const f32x4 o = v[j] * rstd * c1[j] + shv[j]; u32x2 w; w.x = cvt_pk_bf16(o[0], o[1]); w.y = cvt_pk_bf16(o[2], o[3]); o8[64 * j] = w; }
        }
    }
}
__device__ __forceinline__ void final_phase(float* x, const float* gf, int gw, int NGW, int lane) {
    f32x4 gv[4];
#pragma unroll
    for (int j = 0; j < 4; ++j) gv[j] = *(const f32x4*)(gf + 4 * lane + 256 * j);
    for (int r = gw; r < MTOK; r += NGW) {
        f32x4* xr = (f32x4*)(x + (size_t)r * DM) + lane;
        f32x4 v[4]; float ss = 0.f;
#pragma unroll
        for (int j = 0; j < 4; ++j) { v[j] = xr[64 * j]; ss += (v[j][0] * v[j][0] + v[j][1] * v[j][1]) + (v[j][2] * v[j][2] + v[j][3] * v[j][3]); }
        const float rstd = __builtin_amdgcn_rsqf(wave_sum_all(ss) * (1.0f / DM) + EPS);
#pragma unroll
        for (int j = 0; j < 4; ++j) xr[64 * j] = v[j] * rstd * gv[j];
    }
}

__device__ __forceinline__ void unpack8(const u32x4 w, float (&f)[8]) { f[0] = bf_lo(w.x); f[1] = bf_hi(w.x); f[2] = bf_lo(w.y); f[3] = bf_hi(w.y); f[4] = bf_lo(w.z); f[5] = bf_hi(w.z); f[6] = bf_lo(w.w); f[7] = bf_hi(w.w); }
__device__ __forceinline__ u32x4 pack8(const float (&f)[8]) { u32x4 o; o.x = cvt_pk_bf16(f[0], f[1]); o.y = cvt_pk_bf16(f[2], f[3]); o.z = cvt_pk_bf16(f[4], f[5]); o.w = cvt_pk_bf16(f[6], f[7]); return o; }
__device__ __forceinline__ void pool_elem_phase(const bf16_t* U, bf16_t* P, int vcu, int G, int tid) {
    const int chunk = tid & 127, run = tid >> 7, c0 = 8 * chunk, w = 2 << (c0 >> 8);
    for (int unit = vcu; unit < MTOK / 128; unit += G) {
        const int t0 = unit * 128 + run * 32, seq0 = t0 & ~(SEQ - 1);
        float s[8];
#pragma unroll
        for (int j = 0; j < 8; ++j) s[j] = 0.f;
        for (int tau = t0 - w; tau < t0; ++tau) if (tau >= seq0) { float f[8];     unpack8(*(const u32x4*)(U + (size_t)tau * DM + c0), f);
#pragma unroll
            for (int j = 0; j < 8; ++j) s[j] += f[j]; }
#pragma unroll 1
        for (int tb = t0; tb < t0 + 32; tb += 8) {
            u32x4 cur[8], old[8];
#pragma unroll
            for (int i = 0; i < 8; ++i) { cur[i] = *(const u32x4*)(U + (size_t)(tb + i) * DM + c0);
                const int tl = tb + i - w; old[i] = *(const u32x4*)(U + (size_t)(tl >= seq0 ? tl : seq0) * DM + c0); }
#pragma unroll
            for (int i = 0; i < 8; ++i) { const int t = tb + i; float f[8], o[8]; unpack8(cur[i], f);
#pragma unroll
                for (int j = 0; j < 8; ++j) s[j] += f[j];
                if (t - w >= seq0) { float q[8]; unpack8(old[i], q);
#pragma unroll
                    for (int j = 0; j < 8; ++j) s[j] -= q[j]; }
                const int pos1 = t - seq0 + 1; const float inv = 1.0f / (float)(pos1 < w ? pos1 : w);
#pragma unroll
                for (int j = 0; j < 8; ++j) o[j] = s[j] * inv - f[j];
                *(u32x4*)(P + (size_t)t * DM + c0) = pack8(o); }
        }
    }
}
__device__ __forceinline__ void conv_elem_phase(const bf16_t* BG, const bf16_t* Z, const float* cw  , bf16_t* Aout, int vcu, int G, int tid) {
    const int chunk = tid & 127, run = tid >> 7, c0 = 8 * chunk;
    float w0[8], w1[8], w2[8];
#pragma unroll
    for (int j = 0; j < 8; ++j) { w0[j] = cw[c0 + j]; w1[j] = cw[DM + c0 + j]; w2[j] = cw[2 * DM + c0 + j]; }
    for (int unit = vcu; unit < MTOK / 128; unit += G) {
        const int t0 = unit * 128 + run * 32, seq0 = t0 & ~(SEQ - 1);
        float zm2[8], zm1[8];
#pragma unroll
        for (int j = 0; j < 8; ++j) { zm2[j] = 0.f; zm1[j] = 0.f; }
        if (t0 - 2 >= seq0) unpack8(*(const u32x4*)(Z + (size_t)(t0 - 2) * DM + c0), zm2);
        if (t0 - 1 >= seq0) unpack8(*(const u32x4*)(Z + (size_t)(t0 - 1) * DM + c0), zm1);
#pragma unroll 1
        for (int tb = t0; tb < t0 + 32; tb += 8) {
            u32x4 zr[8], br[8];
#pragma unroll
            for (int i = 0; i < 8; ++i) { zr[i] = *(const u32x4*)(Z + (size_t)(tb + i) * DM + c0); br[i] = *(const u32x4*)(BG + (size_t)(tb + i) * DM + c0); }
#pragma unroll
            for (int i = 0; i < 8; ++i) { float z[8], bg[8], o[8]; unpack8(zr[i], z); unpack8(br[i], bg);
#pragma unroll
                for (int j = 0; j < 8; ++j) { o[j] = bg[j] * (w0[j] * zm2[j] + w1[j] * zm1[j] + w2[j] * z[j]); zm2[j] = zm1[j]; zm1[j] = z[j]; }
                *(u32x4*)(Aout + (size_t)(tb + i) * DM + c0) = pack8(o); }
        }
    }
}

__device__ __forceinline__ int wp_off(int row, int chunk) { return row * 256 + ((chunk ^ (row & 15)) << 4); }
__device__ __forceinline__ void mix_phase(LAS unsigned char* lds, bf16_t* UA, const bf16_t* VT, const float* WS, const float* BS, const float* LNG, const float* LNB, int vcu, int G, int tid, int wid, int lane) {
    LAS unsigned char* WP = lds;
    LAS float* MU = (LAS float*)(lds + 32768); LAS float* RSTD = MU + 128; LAS float* R1 = MU + 256; LAS float* R2 = MU + 384;
    LAS float* PART = (LAS float*)(lds + 36864);
    LAS unsigned char* VS = lds + 36864;
    for (int n = vcu; n < MTOK / 128; n += G) {
        {
            const int cgp = tid >> 4, tl = tid & 15;
            float s[8], q[8];
#pragma unroll
            for (int j = 0; j < 8; ++j) { s[j] = 0.f; q[j] = 0.f; }
#pragma unroll 4
            for (int it = 0; it < GH / 32; ++it) { float f[8]; unpack8(*(const u32x4*)(VT + ((size_t)n * GH + it * 32 + cgp) * 128 + tl * 8), f);
#pragma unroll
                for (int j = 0; j < 8; ++j) { s[j] += f[j]; q[j] += f[j] * f[j]; } }
#pragma unroll
            for (int j = 0; j < 8; ++j) { PART[(cgp * 128 + tl * 8 + j) * 2] = s[j]; PART[(cgp * 128 + tl * 8 + j) * 2 + 1] = q[j]; }
            __syncthreads();
            if (tid < 128) { float S = 0.f, Q = 0.f;
                for (int k = 0; k < 32; ++k) { S += PART[(k * 128 + tid) * 2]; Q += PART[(k * 128 + tid) * 2 + 1]; }
                const float mu = S * (1.0f / GH), var = Q * (1.0f / GH) - mu * mu; MU[tid] = mu; RSTD[tid] = __builtin_amdgcn_rsqf(fmaxf(var, 0.f) + EPS); }
            __syncthreads();
        }
        for (int g = 0; g < 8; ++g) {
            const int fr = lane & 15, fq = lane >> 4, cbase = g * 384 + wid * 48;
            bf16x8 av[4][3];
#pragma unroll
            for (int ks = 0; ks < 4; ++ks)
#pragma unroll
                for (int ct = 0; ct < 3; ++ct) av[ks][ct] = *(const bf16x8*)(VT + ((size_t)n * GH + cbase + ct * 16 + fr) * 128 + ks * 32 + fq * 8);
            {
                const int i = tid >> 2, part = tid & 3;
                const float* wrow = WS + ((size_t)g * 128 + i) * 128 + part * 32;
                float r1 = 0.f, r2 = 0.f;
#pragma unroll
                for (int jj = 0; jj < 32; jj += 8) { const int j0 = part * 32 + jj;
                    f32x4 a = *(const f32x4*)(wrow + jj), b = *(const f32x4*)(wrow + jj + 4);
                    if (i < 64 && j0 >= 64) { a = (f32x4){0.f, 0.f, 0.f, 0.f}; b = a; }
                    const f32x4 ra = *(const LAS f32x4*)(RSTD + j0), rb = *(const LAS f32x4*)(RSTD + j0 + 4), ma = *(const LAS f32x4*)(MU + j0), mb = *(const LAS f32x4*)(MU + j0 + 4);
                    const f32x4 wa = a * ra, wb = b * rb;
                    r1 += (wa[0] * ma[0] + wa[1] * ma[1]) + (wa[2] * ma[2] + wa[3] * ma[3]) + (wb[0] * mb[0] + wb[1] * mb[1]) + (wb[2] * mb[2] + wb[3] * mb[3]);
                    r2 += (a[0] + a[1]) + (a[2] + a[3]) + (b[0] + b[1]) + (b[2] + b[3]);
                    u32x4 o; o.x = cvt_pk_bf16(wa[0], wa[1]); o.y = cvt_pk_bf16(wa[2], wa[3]); o.z = cvt_pk_bf16(wb[0], wb[1]); o.w = cvt_pk_bf16(wb[2], wb[3]);
                    *(LAS u32x4*)(WP + wp_off(i, j0 >> 3)) = o; }
                r1 += __shfl_xor(r1, 1); r1 += __shfl_xor(r1, 2); r2 += __shfl_xor(r2, 1); r2 += __shfl_xor(r2, 2);
                if (part == 0) { R1[i] = r1; R2[i] = r2; }
            }
            __syncthreads();
            f32x4 acc[3][8];
#pragma unroll
            for (int ct = 0; ct < 3; ++ct)
#pragma unroll
                for (int it = 0; it < 8; ++it) acc[ct][it] = (f32x4){0.f, 0.f, 0.f, 0.f};
#pragma unroll
            for (int ks = 0; ks < 4; ++ks) {
#pragma unroll
                for (int it = 0; it < 8; ++it) { const bf16x8 bw = *(const LAS bf16x8*)(WP + wp_off(it * 16 + fr, ks * 4 + fq));
#pragma unroll
                    for (int ct = 0; ct < 3; ++ct) acc[ct][it] = __builtin_amdgcn_mfma_f32_16x16x32_bf16(av[ks][ct], bw, acc[ct][it], 0, 0, 0); }
                __builtin_amdgcn_sched_barrier(0);
            }
#pragma unroll
            for (int ct = 0; ct < 3; ++ct) { const int c4 = cbase + ct * 16 + 4 * fq;
                const f32x4 lg = *(const f32x4*)(LNG + c4), lb = *(const f32x4*)(LNB + c4);
#pragma unroll
                for (int it = 0; it < 8; ++it) { const int i = it * 16 + fr; const float r1 = R1[i], r2 = R2[i], bs = BS[g * 128 + i];
                    const f32x4 vs = lg * (acc[ct][it] - r1) + lb * r2 + bs;
                    u32x2 o; o.x = cvt_pk_bf16(vs[0], vs[1]); o.y = cvt_pk_bf16(vs[2], vs[3]);
                    *(LAS u32x2*)(VS + i * 784 + (wid * 48 + ct * 16 + 4 * fq) * 2) = o; } }
            __syncthreads();
#pragma unroll 4
            for (int c = tid; c < 128 * 48; c += NTHREADS) { const int tok = c / 48, ch8 = c - tok * 48;
                const u32x4 vv = *(const LAS u32x4*)(VS + tok * 784 + ch8 * 16);
                u32x4* up = (u32x4*)(UA + (size_t)(n * 128 + tok) * GH + g * 384 + ch8 * 8); const u32x4 uu = *up;
                u32x4 o; o.x = cvt_pk_bf16(bf_lo(uu.x) * bf_lo(vv.x), bf_hi(uu.x) * bf_hi(vv.x)); o.y = cvt_pk_bf16(bf_lo(uu.y) * bf_lo(vv.y), bf_hi(uu.y) * bf_hi(vv.y));
                o.z = cvt_pk_bf16(bf_lo(uu.z) * bf_lo(vv.z), bf_hi(uu.z) * bf_hi(vv.z)); o.w = cvt_pk_bf16(bf_lo(uu.w) * bf_lo(vv.w), bf_hi(uu.w) * bf_hi(vv.w));
                *up = o; }
            __syncthreads();
        }
    }
}

__device__ __forceinline__ void topk_units(LAS unsigned char* lds, const bf16_t* Q, const bf16_t* KEYS, int* SELI, float* SELW, const pg8::StaticOrder& S, int tid, int wid, int lane) {
    LAS unsigned char* kl = lds;
    LAS float* topv = (LAS float*)(lds + 65536);
    const int p = wid >> 2, sub = wid & 3, tl = lane & 31, hi = lane >> 5;
    int hprev = -1;
#pragma unroll 1
    for (int k = 0; ; k = (k & 1) ? k + 3 : k + 1) {
        pg8::Unit ua, ub; if (!S.next(k, ua)) break;
        const bool hasb = S.next(k + 2, ub);
        const bool pair = hasb && ub.pn == ua.pn;
#pragma unroll 1
        for (int part = 0; part < ((hasb && !pair) ? 2 : 1); ++part) {
            const int h = part ? ub.pn : ua.pn, pm0 = part ? ub.pm : ua.pm, pm1 = ub.pm, ntile = pair ? 4 : 2;
            __syncthreads();
            if (h != hprev) {
                for (int c = tid; c < 4096; c += NTHREADS) { const int row = c >> 4, ch = c & 15;
                    const u32x4 v = *(const u32x4*)(KEYS + ((size_t)h * 256 + row) * 128 + ch * 8);
                    *(LAS u32x4*)(kl + row * 256 + ((ch ^ (row & 15)) << 4)) = v; }
                hprev = h; }
            __syncthreads();
#pragma unroll 1
            for (int t4 = 0; t4 < ntile; ++t4) {
                const int tile = 2 * (t4 < 2 ? pm0 : pm1) + (t4 & 1);
                const bf16_t* qrow = Q + ((size_t)((tile * 8 + h) * 32 + 16 * p + hi) * 128 + sub * 32 + tl) * 8;
                bf16x8 bq[8];
#pragma unroll
                for (int ks = 0; ks < 8; ++ks) bq[ks] = *(const bf16x8*)(qrow + (size_t)ks * 2 * 128 * 8);
                f32x16 acc[4];
#pragma unroll
                for (int kt = 0; kt < 4; ++kt)
#pragma unroll
                    for (int r = 0; r < 16; ++r) acc[kt][r] = 0.f;
#pragma unroll
                for (int ks = 0; ks < 8; ++ks)
#pragma unroll
                    for (int kt = 0; kt < 4; ++kt) { const int row = p * 128 + kt * 32 + tl;
                        const bf16x8 ak = *(const LAS bf16x8*)(kl + row * 256 + (((2 * ks + hi) ^ (row & 15)) << 4));
                        acc[kt] = __builtin_amdgcn_mfma_f32_32x32x16_bf16(ak, bq[ks], acc[kt], 0, 0, 0); }
                float v[64];
#pragma unroll
                for (int kt = 0; kt < 4; ++kt)
#pragma unroll
                    for (int r = 0; r < 16; ++r) { const unsigned key = (unsigned)(kt * 32 + (r & 3) + 8 * (r >> 2) + 4 * hi);
                        v[kt * 16 + r] = __uint_as_float((__float_as_uint(acc[kt][r]) & ~127u) | key); }
                top16_of_64(v);
                float m[16];
#pragma unroll
                for (int i = 0; i < 16; ++i) m[i] = fmaxf(v[i], __shfl_xor(v[15 - i], 32));
                bmerge16_desc<0, 16>(m);
                if (hi == 0) { LAS f32x4* dst = (LAS f32x4*)(topv + ((t4 * 2 + p) * 128 + sub * 32 + tl) * 16);
#pragma unroll
                    for (int i = 0; i < 4; ++i) dst[i] = (f32x4){m[4 * i], m[4 * i + 1], m[4 * i + 2], m[4 * i + 3]}; }
            }
            __syncthreads();
            if (tid < ntile * 128) {
                const int t4 = tid >> 7, tok = tid & 127, tile = 2 * (t4 < 2 ? pm0 : pm1) + (t4 & 1);
                const LAS float* t0 = topv + ((t4 * 2 + 0) * 128 + tok) * 16; const LAS float* t1 = topv + ((t4 * 2 + 1) * 128 + tok) * 16;
                float s0[16], s1[16];
#pragma unroll
                for (int i = 0; i < 4; ++i) { const f32x4 a = *(const LAS f32x4*)(t0 + 4 * i), b = *(const LAS f32x4*)(t1 + 4 * i);
                    s0[4 * i] = a[0]; s0[4 * i + 1] = a[1]; s0[4 * i + 2] = a[2]; s0[4 * i + 3] = a[3]; s1[4 * i] = b[0]; s1[4 * i + 1] = b[1]; s1[4 * i + 2] = b[2]; s1[4 * i + 3] = b[3]; }
                float c[64];
                constexpr int pre[16] = {0, 16, 24, 29, 33, 36, 38, 40, 42, 43, 44, 45, 46, 47, 48, 49};
#pragma unroll
                for (int a = 0; a < 16; ++a)
#pragma unroll
                    for (int b = 0; b < 16; ++b) if ((a + 1) * (b + 1) <= 16) c[pre[a] + b] = __uint_as_float((__float_as_uint(s0[a] + s1[b]) & ~255u) | (unsigned)(a * 16 + b));
#pragma unroll
                for (int i = 50; i < 64; ++i) c[i] = -3.0e38f;
                top16_of_64(c);
                float e[16], sum = 0.f;
#pragma unroll
                for (int kk = 0; kk < 16; ++kk) { e[kk] = __builtin_amdgcn_exp2f((c[kk] - c[0]) * 1.44269504f); sum += e[kk]; }
                const float inv = 1.0f / sum;
                const size_t o = (size_t)(tile * 128 + tok) * NPICK + h * 16;
#pragma unroll
                for (int k4 = 0; k4 < 4; ++k4) { i32x4 ei; f32x4 wv;
#pragma unroll
                    for (int j = 0; j < 4; ++j) { const unsigned code = __float_as_uint(c[4 * k4 + j]) & 255u;
                        const unsigned i1 = __float_as_uint(t0[code >> 4]) & 127u, i2 = __float_as_uint(t1[code & 15u]) & 127u;
                        ei[j] = (int)(i1 * 128u + i2); wv[j] = e[4 * k4 + j] * inv; }
                    *(i32x4*)(SELI + o + 4 * k4) = ei; *(f32x4*)(SELW + o + 4 * k4) = wv; }
            }
        }
    }
    __syncthreads();
}

typedef const unsigned char* cbytes;
template <int CTRL> __device__ __forceinline__ float dpp_f(float v) { return __builtin_bit_cast(float, __builtin_amdgcn_update_dpp(0, __builtin_bit_cast(int, v), CTRL, 0xf, 0xf, false)); }
#define DPP_F(v, ctrl) dpp_f<(ctrl)>(v)
#define PG_IDX(EV, TKN) do { const LAS u32x4* _ip = (const LAS u32x4*)(idxw + (TKN) * 128 + 16 * g8); \
        _Pragma("unroll") for (int q = 0; q < 2; ++q) { const u32x4 _e = _ip[q]; _Pragma("unroll") for (int w = 0; w < 4; ++w) { EV[8 * q + 2 * w] = (int)(_e[w] & 0xffffu); EV[8 * q + 2 * w + 1] = (int)(_e[w] >> 16); } } } while (0)
#define PG_GATHER8(BUF, SL, EV, J0) do { _Pragma("unroll") for (int j = 0; j < 8; ++j) BUF[j] = *(const u32x4*)((SL) + ((unsigned)EV[(J0) + j] * 128u + s8 * 16u)); } while (0)
#define PG_H(HA, HB, IT) do { const int _it = (IT) < 127 ? (IT) : 127; const u32x4* _hp = (const u32x4*)(H + (size_t)(tk0 + (_it & 15)) * DM + (((xg + (_it >> 4)) & 7) * 128) + s8 * 16); HA = _hp[0]; HB = _hp[1]; } while (0)
#define PG_HF(HA, HB) do { hf[0] = (f32x2){bf_lo(HA.x), bf_hi(HA.x)}; hf[1] = (f32x2){bf_lo(HA.y), bf_hi(HA.y)}; hf[2] = (f32x2){bf_lo(HA.z), bf_hi(HA.z)}; hf[3] = (f32x2){bf_lo(HA.w), bf_hi(HA.w)}; \
        hf[4] = (f32x2){bf_lo(HB.x), bf_hi(HB.x)}; hf[5] = (f32x2){bf_lo(HB.y), bf_hi(HB.y)}; hf[6] = (f32x2){bf_lo(HB.z), bf_hi(HB.z)}; hf[7] = (f32x2){bf_lo(HB.w), bf_hi(HB.w)}; } while (0)
#define PG_UCOMP8(BUF, O) do { _Pragma("unroll") for (int j = 0; j < 8; ++j) { const u32x4 u = BUF[j]; \
            f32x2 a = __builtin_amdgcn_cvt_pk_f32_fp8(u.x, false) * hf[0]; a += __builtin_amdgcn_cvt_pk_f32_fp8(u.x, true) * hf[1]; \
            a += __builtin_amdgcn_cvt_pk_f32_fp8(u.y, false) * hf[2]; a += __builtin_amdgcn_cvt_pk_f32_fp8(u.y, true) * hf[3]; \
            a += __builtin_amdgcn_cvt_pk_f32_fp8(u.z, false) * hf[4]; a += __builtin_amdgcn_cvt_pk_f32_fp8(u.z, true) * hf[5]; \
            a += __builtin_amdgcn_cvt_pk_f32_fp8(u.w, false) * hf[6]; a += __builtin_amdgcn_cvt_pk_f32_fp8(u.w, true) * hf[7]; \
            float d = a.x + a.y; d += DPP_F(d, 0xB1); d += DPP_F(d, 0x4E); d += DPP_F(d, 0x141);     \
            O = (s8 == j) ? d : O; } } while (0)
#define PG_VCOMP8(BUF, CV, J0) do { _Pragma("unroll") for (int j = 0; j < 8; ++j) { const u32x4 v = BUF[j]; const float c = CV[(J0) + j]; \
            acc[0] += c * __builtin_amdgcn_cvt_pk_f32_fp8(v.x, false); acc[1] += c * __builtin_amdgcn_cvt_pk_f32_fp8(v.x, true); \
            acc[2] += c * __builtin_amdgcn_cvt_pk_f32_fp8(v.y, false); acc[3] += c * __builtin_amdgcn_cvt_pk_f32_fp8(v.y, true); \
            acc[4] += c * __builtin_amdgcn_cvt_pk_f32_fp8(v.z, false); acc[5] += c * __builtin_amdgcn_cvt_pk_f32_fp8(v.z, true); \
            acc[6] += c * __builtin_amdgcn_cvt_pk_f32_fp8(v.w, false); acc[7] += c * __builtin_amdgcn_cvt_pk_f32_fp8(v.w, true); } } while (0)
#define PG_COEF(CV, TKN) do { const LAS f32x4* _cp = (const LAS f32x4*)(dotw + (TKN) * 128 + 16 * g8); \
        _Pragma("unroll") for (int q = 0; q < 4; ++q) { const f32x4 _c = _cp[q]; CV[4 * q] = _c[0]; CV[4 * q + 1] = _c[1]; CV[4 * q + 2] = _c[2]; CV[4 * q + 3] = _c[3]; } } while (0)
#define PG_COEF8(CV, TKN, J0) do { const LAS f32x4* _cp = (const LAS f32x4*)(dotw + (TKN) * 128 + 16 * g8 + (J0)); \
        const f32x4 _c0 = _cp[0], _c1 = _cp[1]; CV[0] = _c0[0]; CV[1] = _c0[1]; CV[2] = _c0[2]; CV[3] = _c0[3]; CV[4] = _c1[0]; CV[5] = _c1[1]; CV[6] = _c1[2]; CV[7] = _c1[3]; } while (0)
#define PG_XOFFS(IT) ((size_t)(tk0 + ((IT) & 15)) * DM + (((xg + ((IT) >> 4)) & 7) * 128) + xoff)
#define PG_XADDR(IT) (x + PG_XOFFS(IT))
#define PG_XLOAD(XV, IT) do { XV = *(const unsigned*)PG_XADDR(IT); } while (0)
__device__ __forceinline__ void peer_gather_phase(LAS unsigned char* lds, const bf16_t* H, cbytes TUP, cbytes TVP, const int* SELI, const float* SELW, const unsigned* SC, bf16_t* x  , float* outf  , const float* gacc, const float* gn_next  , const float* mod_next  , bf16_t* Hout, bool last, int vcu, int G, int wid, int lane) {
    const int g8 = lane >> 3, s8 = lane & 7;
    const bool b3 = (lane & 8) != 0, b4 = (lane & 16) != 0, b5 = (lane & 32) != 0;
    const int xoff = s8 * 16 + 8 * (g8 & 1) + 4 * ((g8 >> 1) & 1) + 2 * (g8 >> 2);
    LAS unsigned short* idxw = (LAS unsigned short*)(lds + wid * 12288);
    LAS float* dotw = (LAS float*)(lds + wid * 12288 + 4096);
    for (int blk = vcu; blk < 256; blk += G) {
        const int xg = blk >> 5, tk0 = blk * 128 + wid * 16;
#pragma unroll 4
        for (int i = 0; i < 16; ++i) { const int e0 = SELI[(size_t)(tk0 + i) * NPICK + lane], e1 = SELI[(size_t)(tk0 + i) * NPICK + 64 + lane];
            idxw[i * 128 + lane] = (unsigned short)e0; idxw[i * 128 + 64 + lane] = (unsigned short)e1; dotw[i * 128 + lane] = 0.f; dotw[i * 128 + 64 + lane] = 0.f; }
        asm volatile("" ::: "memory");
        {
            int ev[16]; u32x4 bufA[8], bufB[8], bufC[8], bufD[8]; u32x4 h0a, h0b, h1a, h1b;
            { cbytes sl0 = TUP + (size_t)(xg & 7) * NEXP * 128;
              PG_IDX(ev, 0); PG_GATHER8(bufA, sl0, ev, 0); PG_GATHER8(bufB, sl0, ev, 8);
              PG_IDX(ev, 1); PG_GATHER8(bufC, sl0, ev, 0); PG_GATHER8(bufD, sl0, ev, 8); }
            PG_H(h0a, h0b, 0); PG_H(h1a, h1b, 1);
#pragma unroll 1
            for (int it = 0; it < 128; it += 2) {
                const int tkn = it & 15, it2 = it + 2 < 127 ? it + 2 : 127, it3 = it + 3 < 127 ? it + 3 : 127;
                cbytes sl2 = TUP + (size_t)((xg + (it2 >> 4)) & 7) * NEXP * 128;
                f32x2 hf[8]; float o0 = 0.f, o1 = 0.f;
                PG_HF(h0a, h0b); PG_IDX(ev, it2 & 15);
                PG_UCOMP8(bufA, o0); __builtin_amdgcn_sched_barrier(0);
                PG_GATHER8(bufA, sl2, ev, 0); __builtin_amdgcn_sched_barrier(0);
                PG_UCOMP8(bufB, o1); __builtin_amdgcn_sched_barrier(0);
                PG_GATHER8(bufB, sl2, ev, 8); PG_H(h0a, h0b, it + 2); __builtin_amdgcn_sched_barrier(0);
                { LAS float* dp = dotw + tkn * 128 + 16 * g8 + s8; dp[0] += o0; dp[8] += o1; }
                o0 = 0.f; o1 = 0.f;
                PG_HF(h1a, h1b); PG_IDX(ev, it3 & 15);
                PG_UCOMP8(bufC, o0); __builtin_amdgcn_sched_barrier(0);
                PG_GATHER8(bufC, sl2, ev, 0); __builtin_amdgcn_sched_barrier(0);
                PG_UCOMP8(bufD, o1); __builtin_amdgcn_sched_barrier(0);
                PG_GATHER8(bufD, sl2, ev, 8); PG_H(h1a, h1b, it + 3); __builtin_amdgcn_sched_barrier(0);
                { LAS float* dp = dotw + (tkn + 1) * 128 + 16 * g8 + s8; dp[0] += o0; dp[8] += o1; }
            }
        }
        asm volatile("" ::: "memory");
#pragma unroll 2
        for (int i = 0; i < 16; ++i) {
#pragma unroll
            for (int hh = 0; hh < 2; ++hh) { const int k = 16 * g8 + s8 + 8 * hh; const int e = idxw[i * 128 + k];
                const float w = SELW[(size_t)(tk0 + i) * NPICK + k]; const unsigned sc = SC[e];
                dotw[i * 128 + k] = w * gelu_tanh(dotw[i * 128 + k] * bf_lo(sc)) * bf_hi(sc); } }
        asm volatile("" ::: "memory");
        {
            const float* gp = gacc + (size_t)(tk0 >> 12) * 6 * DM + xoff;
            int ev[16]; u32x4 bufA[8], bufB[8], bufC[8], bufD[8]; float cC[8]; unsigned x0, x1;
            { cbytes sl0 = TVP + (size_t)(xg & 7) * NEXP * 128;
              PG_IDX(ev, 0); PG_GATHER8(bufA, sl0, ev, 0); PG_GATHER8(bufB, sl0, ev, 8);
              PG_IDX(ev, 1); PG_GATHER8(bufC, sl0, ev, 0); PG_GATHER8(bufD, sl0, ev, 8); }
            PG_XLOAD(x0, 0); PG_XLOAD(x1, 1);
#define PG_VREDUCE_STORE(XV, IT) do { \
                f32x2 k4[4]; _Pragma("unroll") for (int j = 0; j < 4; ++j) { f32x2 lo = acc[j], hi = acc[4 + j];          \
                    lo.x += DPP_F(lo.x, 0x128); lo.y += DPP_F(lo.y, 0x128); hi.x += DPP_F(hi.x, 0x128); hi.y += DPP_F(hi.y, 0x128); k4[j] = b3 ? hi : lo; } \
                f32x2 k2[2]; _Pragma("unroll") for (int j = 0; j < 2; ++j) { const f32x2 snd = b4 ? k4[j] : k4[2 + j]; k2[j] = b4 ? k4[2 + j] : k4[j]; k2[j].x += __shfl_xor(snd.x, 16); k2[j].y += __shfl_xor(snd.y, 16); } \
                const f32x2 snd = b5 ? k2[0] : k2[1]; f32x2 k1 = b5 ? k2[1] : k2[0]; \
                k1.x += __shfl_xor(snd.x, 32); k1.y += __shfl_xor(snd.y, 32); \
                *(unsigned*)PG_XADDR(IT) = cvt_pk_bf16(bf_lo(XV) + gate.x * k1.x, bf_hi(XV) + gate.y * k1.y); } while (0)
#pragma unroll 1
            for (int it = 0; it < 128; it += 2) {
                const int it2 = it + 2 < 127 ? it + 2 : 127, it3 = it + 3 < 127 ? it + 3 : 127, sl = (xg + (it >> 4)) & 7;
                cbytes sl2 = TVP + (size_t)((xg + (it2 >> 4)) & 7) * NEXP * 128;
                const f32x2 gate = *(const f32x2*)(gp + sl * 128);
                f32x2 acc[8];
#pragma unroll
                for (int j = 0; j < 8; ++j) acc[j] = (f32x2){0.f, 0.f};
                PG_COEF8(cC, it & 15, 0); PG_IDX(ev, it2 & 15);
                PG_VCOMP8(bufA, cC, 0); __builtin_amdgcn_sched_barrier(0);
                PG_GATHER8(bufA, sl2, ev, 0); PG_COEF8(cC, it & 15, 8); __builtin_amdgcn_sched_barrier(0);
                PG_VCOMP8(bufB, cC, 0); __builtin_amdgcn_sched_barrier(0);
                PG_GATHER8(bufB, sl2, ev, 8); __builtin_amdgcn_sched_barrier(0);
                PG_VREDUCE_STORE(x0, it);
                PG_XLOAD(x0, it2);
#pragma unroll
                for (int j = 0; j < 8; ++j) acc[j] = (f32x2){0.f, 0.f};
                PG_COEF8(cC, (it + 1) & 15, 0); PG_IDX(ev, it3 & 15);
                PG_VCOMP8(bufC, cC, 0); __builtin_amdgcn_sched_barrier(0);
                PG_GATHER8(bufC, sl2, ev, 0); PG_COEF8(cC, (it + 1) & 15, 8); __builtin_amdgcn_sched_barrier(0);
                PG_VCOMP8(bufD, cC, 0); __builtin_amdgcn_sched_barrier(0);
                PG_GATHER8(bufD, sl2, ev, 8); __builtin_amdgcn_sched_barrier(0);
                PG_VREDUCE_STORE(x1, it + 1);
                PG_XLOAD(x1, it3);
            }
#undef PG_VREDUCE_STORE
        }
        asm volatile("s_waitcnt vmcnt(0)" ::: "memory");
        {
            const int b = tk0 >> 12;
            f32x4 c1[4], shv[4];
#pragma unroll
            for (int j = 0; j < 4; ++j) { const int col = 4 * lane + 256 * j;
                if (last) { c1[j] = *(const f32x4*)(gn_next + col); shv[j] = (f32x4){0.f, 0.f, 0.f, 0.f}; }
                else { c1[j] = *(const f32x4*)(gn_next + col) * (1.0f + *(const f32x4*)(mod_next + (size_t)b * 6 * DM + DM + col)); shv[j] = *(const f32x4*)(mod_next + (size_t)b * 6 * DM + col); } }
#pragma unroll 1
            for (int i0 = 0; i0 < 16; i0 += 4) {
                f32x4 v[4][4]; float ss[4];
#pragma unroll
                for (int rr = 0; rr < 4; ++rr) { const u32x2* xr = (const u32x2*)(x + (size_t)(tk0 + i0 + rr) * DM) + lane;
#pragma unroll
                    for (int j = 0; j < 4; ++j) { const u32x2 xv = xr[64 * j]; v[rr][j] = (f32x4){bf_lo(xv.x), bf_hi(xv.x), bf_lo(xv.y), bf_hi(xv.y)}; } }
#pragma unroll
                for (int rr = 0; rr < 4; ++rr) { float q = 0.f;
#pragma unroll
                    for (int j = 0; j < 4; ++j) q += (v[rr][j][0] * v[rr][j][0] + v[rr][j][1] * v[rr][j][1]) + (v[rr][j][2] * v[rr][j][2] + v[rr][j][3] * v[rr][j][3]);
                    ss[rr] = q; }
#pragma unroll
                for (int o = 1; o < 64; o <<= 1) {
#pragma unroll
                    for (int rr = 0; rr < 4; ++rr) ss[rr] += __shfl_xor(ss[rr], o); }
#pragma unroll
                for (int rr = 0; rr < 4; ++rr) { const int r = tk0 + i0 + rr; const float rstd = __builtin_amdgcn_rsqf(ss[rr] * (1.0f / DM) + EPS);
                    if (last) { f32x4* xr = (f32x4*)(outf + (size_t)r * DM) + lane;
#pragma unroll
                        for (int j = 0; j < 4; ++j) xr[64 * j] = v[rr][j] * rstd * c1[j]; }
                    else { u32x2* o8 = (u32x2*)(Hout + (size_t)r * DM) + lane;
#pragma unroll
                        for (int j = 0; j < 4; ++j) { const f32x4 o = v[rr][j] * rstd * c1[j] + shv[j]; u32x2 w; w.x = cvt_pk_bf16(o[0], o[1]); w.y = cvt_pk_bf16(o[2], o[3]); o8[64 * j] = w; } } }
            }
        }
    }
}
#undef PG_IDX
#undef PG_GATHER8
#undef PG_H
#undef PG_HF
#undef PG_UCOMP8
#undef PG_VCOMP8
#undef PG_COEF
#undef PG_COEF8
#undef PG_XADDR
#undef PG_XOFFS
#undef PG_XLOAD

constexpr size_t WS_BAR = 768 * 1024;
#define XB_TMO      128
#define XB_XCNT(j)  (256  + 64 * (j))
#define XB_XSUB(j)  (1280 + 64 * (j))
#define XB_XGEN(j)  (2304 + 64 * (j))
#define XB_TOP      3328
#define XB_TOPGEN   3392
#define XCD_BAR_WORDS 3456
#define XB_SPIN_CAP (1u << 22)
__device__ __forceinline__ unsigned xb_ld(unsigned* p)              { return __hip_atomic_load(p, __ATOMIC_RELAXED, __HIP_MEMORY_SCOPE_AGENT); }
__device__ __forceinline__ unsigned xb_add(unsigned* p, unsigned v) { return __hip_atomic_fetch_add(p, v, __ATOMIC_RELAXED, __HIP_MEMORY_SCOPE_AGENT); }
__device__ __forceinline__ unsigned xb_xcc_id() { return (unsigned)__builtin_amdgcn_s_getreg((3 << 11) | 20) & 0xFu; }
#define XB_SPIN(cond, bar) do { unsigned _sp = 0; while (cond) { __builtin_amdgcn_s_sleep(1); \
    if ((++_sp & 255u) == 0u) { if (xb_ld(&(bar)[XB_TMO])) break; if (_sp > XB_SPIN_CAP) { atomicAdd(&(bar)[XB_TMO], 1u); break; } } } } while (0)
struct XcdBarrier { unsigned* bar; unsigned x; volatile LAS unsigned* st; };
__device__ __forceinline__ void xcd_barrier_complete(unsigned* bar, unsigned x, unsigned& nloc, unsigned& nx) {
    const unsigned G = gridDim.x * gridDim.y * gridDim.z;
    unsigned sum, cnt, mine, sp = 0u;
    for (;;) {
        sum = 0u; cnt = 0u; mine = 0u;
#pragma unroll
        for (unsigned j = 0; j < 16; ++j) { const unsigned c = xb_ld(&bar[XB_XCNT(j)]); sum += c; cnt += (c > 0u) ? 1u : 0u; mine = (j == x) ? c : mine; }
        if (sum == G) break;
        __builtin_amdgcn_s_sleep(1);
        if ((++sp & 255u) == 0u) { if (xb_ld(&bar[XB_TMO])) break; if (sp > XB_SPIN_CAP) { atomicAdd(&bar[XB_TMO], 1u); break; } }
    }
    nloc = mine > 0u ? mine : 1u; nx = cnt > 0u ? cnt : 1u;
}
__device__ __forceinline__ void xcd_barrier(const XcdBarrier& b) {
    asm volatile("s_waitcnt vmcnt(0)" ::: "memory");
    __syncthreads();
    if (threadIdx.x == 0) {
        unsigned* bar = b.bar;
        __builtin_amdgcn_s_waitcnt(0);
        unsigned nloc = b.st[0], nx = b.st[1];
        if (nloc == 0u) { xcd_barrier_complete(bar, b.x, nloc, nx); b.st[0] = nloc; b.st[1] = nx; }
        const unsigned old = xb_add(&bar[XB_XSUB(b.x)], 1u);
        const unsigned gen = old / nloc;
        if (old + 1u == (gen + 1u) * nloc) {
            __builtin_amdgcn_fence(__ATOMIC_RELEASE, "agent");
            asm volatile("s_waitcnt vmcnt(0)" ::: "memory");
            const unsigned og = xb_add(&bar[XB_TOP], 1u);
            const unsigned tg = og / nx;
            if (og + 1u == (tg + 1u) * nx) xb_add(&bar[XB_TOPGEN], 1u);
            else XB_SPIN(xb_ld(&bar[XB_TOPGEN]) == tg, bar);
            __builtin_amdgcn_fence(__ATOMIC_ACQUIRE, "agent");
            xb_add(&bar[XB_XGEN(b.x)], 1u);
            asm volatile("s_waitcnt vmcnt(0)" ::: "memory");
        } else {
            XB_SPIN(xb_ld(&bar[XB_XGEN(b.x)]) == gen, bar);
            __builtin_amdgcn_fence(__ATOMIC_ACQUIRE, "agent");
            asm volatile("s_waitcnt vmcnt(0)" ::: "memory");
        }
    }
    __syncthreads();
}

constexpr int NPHASES = 27;
#ifndef PH_MASK
#define PH_MASK 0xFFFFFF
#endif
#ifndef DUP_MASK
#define DUP_MASK 0
#endif
#ifndef TIME_MASK
#define TIME_MASK 0
#endif
__device__ __forceinline__ int opaque_s(int x) { asm volatile("" : "+s"(x)); return x; }
#define PHM(bit, call) do { if constexpr ((PH_MASK & (bit)) != 0) { if constexpr ((DUP_MASK & (bit)) != 0) { const int _nrep = opaque_s(2); for (int _rep = 0; _rep < _nrep; ++_rep) { call; __syncthreads(); } } else { call; } } } while (0)
__global__ void __launch_bounds__(NTHREADS, 2) trunk_fwd(Args A) {
    extern __shared__ __attribute__((aligned(16))) unsigned char lds_raw[];
    LAS unsigned char* lds = (LAS unsigned char*)lds_raw;
    const int tid0 = threadIdx.x, wid = __builtin_amdgcn_readfirstlane(tid0 >> 6);
    const int G = gridDim.x, bx = blockIdx.x, vcu = (G % 8 == 0) ? (bx % 8) * (G / 8) + bx / 8 : bx;
    const int gw = vcu * 8 + wid, NGW = G * 8;
    const int ph_lo = A.ph_lo, ph_hi = A.ph_hi;
    unsigned long long t_acc = 0;
#if MK_ONE_LAUNCH
    if (tid0 < 2) ((volatile LAS unsigned*)(lds + LDS_XB_OFF))[tid0] = 0u;
    if (bx == 0) { unsigned* b0 = (unsigned*)(A.ws + WS_BAR); for (int i = tid0; i < XCD_BAR_WORDS; i += NTHREADS) b0[i] = 0u; }
#endif

    for (int ph = ph_lo; ph < ph_hi; ++ph) {
        const int tid = opaque(tid0), lane = tid & 63;
        ArgP Ap = (ArgP)__builtin_amdgcn_kernarg_segment_ptr();
        asm volatile("" : "+s"(Ap));
        unsigned char* ws = Ap->ws;
        bf16_t* Hb = (bf16_t*)(ws + WS_H);
        unsigned char* mixb = ws + WS_MIX;
        const float* mod = (const float*)(ws + WS_MOD);
        float* xo = Ap->out;
        int layer, step;
        if (ph < 2) { layer = -1; step = ph; }
        else if (ph < 9) { layer = 0; step = ph - 2; }
        else if (ph < 15) { layer = 1; step = ph - 9 + 1; }
        else if (ph < 21) { layer = 2; step = ph - 15 + 1; }
        else { layer = 3; step = ph - 21 + 1; }
        const int kind = layer % 3, jl = layer / 3;
        unsigned long long t_ph0 = 0; if constexpr (TIME_MASK != 0) t_ph0 = __builtin_amdgcn_s_memrealtime();
        const int nmix = 4;
        int ptype = 0;
        if (layer < 0) ptype = 1; else if (layer > 3) ptype = 2048; else if (step == 0 || step == nmix) ptype = 2;
        else if (step < nmix) ptype = (step == 1) ? 4 : (step == nmix - 1) ? 32 : (kind == 0 && step == 3) ? 16 : 8;
        else ptype = 64 << (step - nmix - 1);
        const float* macc = mod + (size_t)(layer < 0 ? 0 : (layer > 3 ? 3 : layer)) * BATCH * 6 * DM;
        const float* mbias = Ap->in[I_ADA_B] + (size_t)(layer < 0 ? 0 : (layer > 3 ? 3 : layer)) * 6 * DM;
        const float* xin = (layer == 0) ? Ap->in[I_X] : xo;

        if (layer < 0) {
            if (step == 0) { PHM(1, prologue_phase(Ap, lds, vcu, G, tid, wid, lane)); }
            else { PHM(1, modreduce_phase(Ap, vcu, G, tid));
#pragma unroll 1
                for (int pl = 0; pl < 2; ++pl) { pg8::StaticOrder S; pg8::Gemm g{(const bf16_t*)(ws + WS_POOL_WOUT) + (size_t)pl * DM * DM, (const bf16_t*)(ws + WS_WGS) + (size_t)pl * 4 * 65536, DM, DM, 256, DM, 256, 256}; S.init(DM, DM, G, bx);
                    pg8::EpiBf16<0> E{(bf16_t*)(ws + WS_WEFF) + (size_t)pl * DM * DM, DM}; PHM(0x2000, pg8::gemm_phase(lds, g, S, E)); } }
        } else if (layer > 3) {
            PHM(256, final_phase(xo, Ap->in[I_FINAL_G], gw, NGW, lane));
        } else if (step == 0) {
            PHM(2, norm_phase(xin, Ap->in[I_NORM_G] + (size_t)(layer * 2 + 0) * DM, macc, mbias, 0, DM, Hb, gw, NGW, lane));
        } else if (step < nmix) {
            pg8::StaticOrder S;
            if (kind == 0) {
                bf16_t* U = (bf16_t*)mixb; bf16_t* P = (bf16_t*)(mixb + 64 * MiB); bf16_t* Z = (bf16_t*)(mixb + 128 * MiB);
                if (step == 1) { pg8::Gemm g{Hb, (const bf16_t*)(ws + WS_POOL_WIN) + (size_t)jl * DM * DM, MTOK, DM, DM, DM, DM, 0}; S.init(MTOK, DM, G, bx);
                    pg8::EpiBf16<0> E{U, DM}; PHM(0x1000, pg8::gemm_phase(lds, g, S, E)); }
                else if (step == 2) { PHM(8, pool_elem_phase(U, P, vcu, G, tid)); }
                else { pg8::Gemm g{P, (const bf16_t*)(ws + WS_WEFF) + (size_t)jl * DM * DM, MTOK, DM, DM, DM, DM, 0}; S.init(MTOK, DM, G, bx);
                    pg8::EpiBf16<0> E{(bf16_t*)(mixb + 192 * MiB), DM}; PHM(0x8000, pg8::gemm_phase(lds, g, S, E));   }
            } else if (kind == 1) {
                bf16_t* BG = (bf16_t*)mixb; bf16_t* Z = (bf16_t*)(mixb + 64 * MiB); bf16_t* AA = (bf16_t*)(mixb + 128 * MiB);
                if (step == 1) { pg8::Gemm g{Hb, (const bf16_t*)(ws + WS_CONV_WIN), MTOK, 3 * DM, DM, DM, DM, 0}; S.init(MTOK, 3 * DM, G, bx);
                    pg8::EpiConvIn E{BG, Z}; PHM(0x4000, pg8::gemm_phase(lds, g, S, E)); }
                else if (step == 2) { PHM(16, conv_elem_phase(BG, Z, Ap->in[I_CONV_W], AA, vcu, G, tid)); }
                else { pg8::Gemm g{AA, (const bf16_t*)(ws + WS_CONV_WOUT), MTOK, DM, DM, DM, DM, 0}; S.init(MTOK, DM, G, bx);
                    pg8::EpiBf16<0> E{(bf16_t*)(mixb + 192 * MiB), DM}; PHM(0x8000, pg8::gemm_phase(lds, g, S, E));   }
            } else {
                bf16_t* UA = (bf16_t*)mixb; bf16_t* VT = (bf16_t*)(mixb + 192 * MiB);
                if (step == 1) {
                    { pg8::Gemm g{Hb, (const bf16_t*)(ws + WS_GMLP_WIN), MTOK, GH, DM, DM, DM, 0}; S.init(MTOK, GH, G, bx);
                      pg8::EpiBf16<1> E{UA, GH}; PHM(0x1000, pg8::gemm_phase(lds, g, S, E)); }
                    { pg8::Gemm g{Hb, (const bf16_t*)(ws + WS_GMLP_WIN) + (size_t)GH * DM, MTOK, GH, DM, DM, DM, 0}; S.init(MTOK, GH, G, bx);
                      pg8::EpiGmlpV E{VT}; PHM(0x10000, pg8::gemm_phase(lds, g, S, E)); }
                }
                else if (step == 2) { PHM(32, mix_phase(lds, UA, VT, Ap->in[I_GMLP_WS], Ap->in[I_GMLP_BS], Ap->in[I_GMLP_LNG], Ap->in[I_GMLP_LNB], vcu, G, tid, wid, lane)); }
                else { pg8::Gemm g{UA, (const bf16_t*)(ws + WS_GMLP_WOUT), MTOK, DM, GH, GH, GH, 0}; S.init(MTOK, DM, G, bx);
                    pg8::EpiBf16<0> E{(bf16_t*)(mixb + 192 * MiB), DM}; PHM(0x8000, pg8::gemm_phase(lds, g, S, E));   }
            }
        } else {
            const int ps = step - nmix;
            bf16_t* Qb = (bf16_t*)mixb;
            bf16_t* xs = (layer == 3) ? (bf16_t*)(mixb + 192 * MiB) : (bf16_t*)xo;
            if (ps == 0) { resnorm_phase(layer == 0 ? Ap->in[I_X] : nullptr, (const bf16_t*)xo, xs, (const bf16_t*)(mixb + 192 * MiB), macc + 2 * DM, Ap->in[I_NORM_G] + (size_t)(layer * 2 + 1) * DM, macc, 3 * DM, 4 * DM, Hb, gw, NGW, lane); }
            else if (ps == 1) { pg8::StaticOrder S; pg8::Gemm g{Hb, (const bf16_t*)(ws + WS_PEER_WQ) + (size_t)layer * DM * 2048, MTOK, 2048, DM, DM, DM, 0}; S.init(MTOK, 2048, G, bx);
                pg8::EpiQT E{Qb}; PHM(0x1000, pg8::gemm_phase(lds, g, S, E));
                asm volatile("s_waitcnt vmcnt(0)" ::: "memory"); __syncthreads();
                PHM(64, topk_units(lds, Qb, (const bf16_t*)(ws + WS_KEYS) + (size_t)layer * 16 * 128 * 128, (int*)(ws + WS_SELI), (float*)(ws + WS_SELW), S, tid, wid, lane)); }
            else { PHM(128, peer_gather_phase(lds, Hb, (cbytes)(ws + WS_TABU) + (size_t)layer * NEXP * DM, (cbytes)(ws + WS_TABV) + (size_t)layer * NEXP * DM, (const int*)(ws + WS_SELI), (const float*)(ws + WS_SELW),
                              (const unsigned*)(ws + WS_SCU) + (size_t)layer * NEXP, xs, xo, macc + 5 * DM,
                              layer == 3 ? Ap->in[I_FINAL_G] : Ap->in[I_NORM_G] + (size_t)((layer + 1) * 2) * DM, mod + (size_t)(layer == 3 ? 3 : layer + 1) * BATCH * 6 * DM, Hb, layer == 3, vcu, G, wid, lane)); }
        }
#if MK_ONE_LAUNCH
        if constexpr (TIME_MASK != 0) if (ph + 1 >= ph_hi) { if (ptype & TIME_MASK) t_acc += __builtin_amdgcn_s_memrealtime() - t_ph0; }
        if (ph + 1 < ph_hi) {
            XcdBarrier xbar; xbar.bar = (unsigned*)(Ap->ws + WS_BAR); xbar.x = xb_xcc_id(); xbar.st = (volatile LAS unsigned*)(lds + LDS_XB_OFF);
            if (ph == ph_lo) { cg::this_grid().sync(); if (tid0 == 0) (void)xb_add(&xbar.bar[XB_XCNT(xbar.x)], 1u); }
            else { xcd_barrier(xbar); if constexpr ((DUP_MASK & 0x800) != 0) xcd_barrier(xbar); }
            if constexpr (TIME_MASK != 0) { if (ptype & TIME_MASK) t_acc += __builtin_amdgcn_s_memrealtime() - t_ph0; }
        }
#endif
    }
    if constexpr (TIME_MASK != 0) { const unsigned long long t0 = __builtin_amdgcn_s_memrealtime(); while (__builtin_amdgcn_s_memrealtime() - t0 < 4ull * t_acc) __builtin_amdgcn_s_sleep(8); }
}

extern "C" void kernel_launch(void* const* d_in, const int* in_sizes, int n_in, void* d_out, int out_size, void* d_ws, size_t ws_size, hipStream_t stream) {
    static int grid = 0;
    if (grid == 0) {
        if (n_in != 23 || in_sizes[0] != MTOK * DM || out_size != MTOK * DM || ws_size < WS_END) {
            fprintf(stderr, "kernel_launch: unexpected shapes (n_in %d, in0 %d, out %d, ws %zu; need ws >= %zu); nothing launched\n", n_in, n_in > 0 ? in_sizes[0] : -1, out_size, ws_size, (size_t)WS_END); grid = -1; return; }
        int dev = 0, cus = 0, per_cu = 0;
        if (hipGetDevice(&dev) != hipSuccess || hipDeviceGetAttribute(&cus, hipDeviceAttributeMultiprocessorCount, dev) != hipSuccess) { grid = -1; return; }
        if (hipFuncSetAttribute((const void*)trunk_fwd, hipFuncAttributeMaxDynamicSharedMemorySize, LDS_BYTES) != hipSuccess) { fprintf(stderr, "kernel_launch: hipFuncSetAttribute failed\n"); grid = -1; return; }
        if (hipOccupancyMaxActiveBlocksPerMultiprocessor(&per_cu, (const void*)trunk_fwd, NTHREADS, LDS_BYTES) != hipSuccess || per_cu < 1) { fprintf(stderr, "kernel_launch: occupancy query says %d blocks per CU\n", per_cu); (void)hipGetLastError(); grid = -1; return; }
        grid = cus * (per_cu < 1 ? 1 : 1);
    }
    if (grid < 0) return;
    Args a{};
    for (int i = 0; i < 23; ++i) a.in[i] = (const float*)d_in[i];
    a.out = (float*)d_out; a.ws = (unsigned char*)d_ws;
#if MK_ONE_LAUNCH
    a.ph_lo = 0; a.ph_hi = NPHASES;
    void* args[] = {&a};
    hipError_t e = hipLaunchCooperativeKernel((const void*)trunk_fwd, dim3(grid), dim3(NTHREADS), args, LDS_BYTES, stream);
    if (e != hipSuccess) fprintf(stderr, "cooperative launch failed: %s (grid %d)\n", hipGetErrorString(e), grid);
#else
    for (int ph = 0; ph < NPHASES; ++ph) { a.ph_lo = ph; a.ph_hi = ph + 1; hipLaunchKernelGGL(trunk_fwd, dim3(grid), dim3(NTHREADS), LDS_BYTES, stream, a); }
#endif
}
```

```cpp
#include <hip/hip_runtime.h>
#include <hip/hip_cooperative_groups.h>
#include <cstdio>
#include <cstdint>
namespace cg = cooperative_groups;

#ifndef MK_ONE_LAUNCH
#define MK_ONE_LAUNCH 1
#endif

#define LAS __attribute__((address_space(3)))
typedef unsigned short bf16_t;
typedef short bf16x8 __attribute__((ext_vector_type(8)));
typedef float f32x2 __attribute__((ext_vector_type(2)));
typedef float f32x4 __attribute__((ext_vector_type(4)));
typedef float f32x16 __attribute__((ext_vector_type(16)));
typedef unsigned u32x2 __attribute__((ext_vector_type(2)));
typedef unsigned u32x4 __attribute__((ext_vector_type(4)));
typedef int i32x4 __attribute__((ext_vector_type(4)));
typedef int i32x8 __attribute__((ext_vector_type(8)));
typedef __bf16 bf16x2 __attribute__((ext_vector_type(2)));

constexpr int DM = 1024, BATCH = 8, SEQ = 4096, MTOK = BATCH * SEQ, DEPTH = 4;
constexpr int GH = 3072;
constexpr int NEXP = 16384, NPICK = 128;
constexpr float EPS = 1e-6f;

constexpr size_t MiB = 1u << 20;
constexpr size_t WS_CTL = 0, WS_SCU = 0, WS_SCV = 512 * 1024, WS_MOD = 1 * MiB, ZERO_BYTES = 2 * MiB;
constexpr size_t WS_POOL_WIN = 2 * MiB, WS_POOL_WGRP = 6 * MiB, WS_POOL_WOUT = 7 * MiB;
constexpr size_t WS_CONV_WIN = 11 * MiB, WS_CONV_WOUT = 17 * MiB;
constexpr size_t WS_GMLP_WIN = 19 * MiB, WS_GMLP_WOUT = 31 * MiB;
constexpr size_t WS_PEER_WQ = 37 * MiB, WS_KEYS = 53 * MiB;
constexpr size_t WS_H = 56 * MiB;
constexpr size_t WS_SELI = 120 * MiB, WS_SELW = 136 * MiB;
constexpr size_t WS_TABU = 152 * MiB, WS_TABV = 280 * MiB;
constexpr size_t WS_MIX = 408 * MiB;
constexpr size_t WS_ADAP = 792 * MiB;
constexpr size_t WS_COEF = 804 * MiB;
constexpr size_t WS_WEFF = 820 * MiB;
constexpr size_t WS_WGS = 824 * MiB;
constexpr size_t WS_END = 825 * MiB;

__device__ __forceinline__ unsigned cvt_pk_bf16(float lo, float hi) { unsigned r; asm volatile("v_cvt_pk_bf16_f32 %0, %1, %2" : "=v"(r) : "v"(lo), "v"(hi)); return r; }
__device__ __forceinline__ int opaque(int x) { asm volatile("" : "+v"(x)); return x; }
__device__ __forceinline__ float bf_lo(unsigned w) { return __uint_as_float(w << 16); }
__device__ __forceinline__ float bf_hi(unsigned w) { return __uint_as_float(w & 0xffff0000u); }
__device__ __forceinline__ float gelu_tanh(float x) {
    const float y = x * (1.0f + 0.044715f * x * x);
    const float e = __builtin_amdgcn_exp2f(-2.302208198f * y);
    return x * __builtin_amdgcn_rcpf(1.0f + e);
}
__device__ __forceinline__ float wave_sum_all(float v) {
#pragma unroll
    for (int o = 1; o < 64; o <<= 1) v += __shfl_xor(v, o);
    return v;
}
__device__ __forceinline__ float dot2_bf16(unsigned w, unsigned x, float acc) { return __builtin_amdgcn_fdot2_f32_bf16(__builtin_bit_cast(bf16x2, w), __builtin_bit_cast(bf16x2, x), acc, false); }


__device__ __forceinline__ float dpp_row_shr(float v, int n) {
    const int iv = __builtin_bit_cast(int, v); int r;
    switch (n) { case 1: r = __builtin_amdgcn_update_dpp(0, iv, 0x111, 0xf, 0xf, true); break; case 2: r = __builtin_amdgcn_update_dpp(0, iv, 0x112, 0xf, 0xf, true); break;
                 case 4: r = __builtin_amdgcn_update_dpp(0, iv, 0x114, 0xf, 0xf, true); break; default: r = __builtin_amdgcn_update_dpp(0, iv, 0x118, 0xf, 0xf, true); break; }
    return __builtin_bit_cast(float, r);
}
__device__ __forceinline__ float wave_sum_uniform(float v) {
    v += dpp_row_shr(v, 1); v += dpp_row_shr(v, 2); v += dpp_row_shr(v, 4); v += dpp_row_shr(v, 8);
    v += __builtin_bit_cast(float, __builtin_amdgcn_update_dpp(0, __builtin_bit_cast(int, v), 0x142, 0xa, 0xf, false));
    v += __builtin_bit_cast(float, __builtin_amdgcn_update_dpp(0, __builtin_bit_cast(int, v), 0x143, 0xc, 0xf, false));
    return __uint_as_float(__builtin_amdgcn_readlane(__float_as_uint(v), 63));
}

namespace pg8 {
constexpr int BM = 256, BK = 64, HALF = 128, HTB = HALF * BK * 2, STAGE_BYTES = 8 * HTB, NXCD = 8, WGM = 8;
__device__ __forceinline__ int lds_byte(int r, int c) { const int st = (r >> 4) * 2 + (c >> 5), rr = r & 15, cc = c & 31, ob = rr * 64 + cc * 2; return st * 1024 + (ob ^ (((ob >> 9) & 1) << 5)); }
__device__ __forceinline__ void stage_rc(int b, int& R, int& C) { const int st = b / 1024, sb = b % 1024, swz = sb ^ (((sb >> 9) & 1) << 5); R = (st >> 1) * 16 + swz / 64; C = (st & 1) * 32 + (swz % 64) / 2; }
__device__ __forceinline__ int perm32(int rho) { const int n = rho >> 4, i = rho & 15; return 8 * (i >> 2) + 4 * n + (i & 3); }

struct Unit { int pm, pn; };
struct Gemm { const bf16_t* A; const bf16_t* Bt; int M, N, K, lda, ldb, a_pn_off; };

struct StaticOrder {
    int nM, nN, nwg, G, c;
    __device__ __forceinline__ void init(int M, int N, int G_, int c_) { nM = M / BM; nN = N / BM; nwg = nM * nN; G = G_; c = c_; }
    __device__ __forceinline__ bool next(int i, Unit& u) const {
        const int L = i * G + c; if (L >= nwg) return false;
        int wgid = L; { const int q = nwg / NXCD, r = nwg % NXCD, xcd = wgid % NXCD, off = wgid / NXCD; wgid = (xcd < r ? xcd * (q + 1) : r * (q + 1) + (xcd - r) * q) + off; }
        const int nig = WGM * nN, gid = wgid / nig, fm = gid * WGM, gsz = (nM - fm) < WGM ? (nM - fm) : WGM;
        u.pm = fm + ((wgid % nig) % gsz); u.pn = (wgid % nig) / gsz; return true;
    }
};

template <class Epi>
__device__ __forceinline__ void gemm_phase(LAS unsigned char* lds, const Gemm g, const StaticOrder& S, const Epi& E) {
    const int tid = opaque((int)threadIdx.x), wid = __builtin_amdgcn_readfirstlane(tid >> 6), lane = tid & 63, wr = wid >> 2, wc = wid & 3, fr = lane & 15, fq = lane >> 4;
    int nt = g.K / BK; asm volatile("" : "+s"(nt));
    unsigned voffA[2], voffB[2];
#pragma unroll
    for (int i = 0; i < 2; ++i) { int R, C; stage_rc(tid * 16 + i * 8192, R, C); const int Rb = Epi::PERM ? ((R & ~31) + perm32(R & 31)) : R;
        voffA[i] = (unsigned)(R * g.lda + C) * 2u; voffB[i] = (unsigned)(Rb * g.ldb + C) * 2u; }
    const size_t kstep = (size_t)(BK * 2);
    const size_t hstepA = (size_t)HALF * g.lda * 2, hstepB = (size_t)HALF * g.ldb * 2;
    const size_t tstepA = 2 * hstepA, tstepB = 2 * hstepB;
    const unsigned ldsw = (unsigned)wid * 1024u;
    const int aoff = lds_byte(wr * 64 + fr, fq * 8), boff = lds_byte(wc * 32 + fr, fq * 8);
#define PG8_SA(b, h) (((b) * 2 + (h)) * HTB)
#define PG8_SB(b, h) ((4 + (b) * 2 + (h)) * HTB)
#define PG8_STAGE(bufoff, gbase, voff) do { _Pragma("unroll") for (int _i = 0; _i < 2; ++_i) \
        __builtin_amdgcn_global_load_lds((const unsigned*)((const char*)(gbase) + (voff)[_i]), (LAS unsigned*)(lds + (bufoff) + ldsw + _i * 8192), 16, 0, 0); } while (0)
#define PG8_LDA(dst, b, h) do { _Pragma("unroll") for (int m = 0; m < 4; ++m) _Pragma("unroll") for (int k = 0; k < 2; ++k) dst[m][k] = *(const LAS bf16x8*)(lds + PG8_SA(b, h) + aoff + m * 2048 + k * 1024); } while (0)
#define PG8_LDB(dst, b, h) do { _Pragma("unroll") for (int n = 0; n < 2; ++n) _Pragma("unroll") for (int k = 0; k < 2; ++k) dst[n][k] = *(const LAS bf16x8*)(lds + PG8_SB(b, h) + boff + n * 2048 + k * 1024); } while (0)
#define PG8_MMA(ai, bj, At, Bt) do { __builtin_amdgcn_s_setprio(1); _Pragma("unroll") for (int m = 0; m < 4; ++m) _Pragma("unroll") for (int n = 0; n < 2; ++n) _Pragma("unroll") for (int k = 0; k < 2; ++k) \
        acc[ai][bj][m][n] = Epi::SWAP ? __builtin_amdgcn_mfma_f32_16x16x32_bf16(At[m][k], Bt[n][k], acc[ai][bj][m][n], 0, 0, 0) \
                                      : __builtin_amdgcn_mfma_f32_16x16x32_bf16(Bt[n][k], At[m][k], acc[ai][bj][m][n], 0, 0, 0); __builtin_amdgcn_s_setprio(0); } while (0)
#define PG8_WAIT_V(n) asm volatile("s_waitcnt vmcnt(" #n ")" ::: "memory")
#define PG8_WAIT_L(n) asm volatile("s_waitcnt lgkmcnt(" #n ")" ::: "memory")
#define PG8_BAR __builtin_amdgcn_s_barrier()
#define PG8_SCHED __builtin_amdgcn_sched_barrier(0)
    Unit cur, nxt; int ui = 0;
    if (!S.next(0, cur)) return;
    f32x4 acc[2][2][4][2];
#pragma unroll
    for (int a = 0; a < 2; ++a)
#pragma unroll
        for (int b = 0; b < 2; ++b)
#pragma unroll
            for (int m = 0; m < 4; ++m)
#pragma unroll
                for (int n = 0; n < 2; ++n) acc[a][b][m][n] = (f32x4){0.f, 0.f, 0.f, 0.f};
    bf16x8 At[4][2], B0[2][2], B1[2][2];
    const char* cA = (const char*)g.A + (size_t)cur.pm * tstepA + (size_t)cur.pn * g.a_pn_off * 2; const char* cB = (const char*)g.Bt + (size_t)cur.pn * tstepB;
    PG8_STAGE(PG8_SB(0, 0), cB, voffB); PG8_STAGE(PG8_SB(0, 1), cB + hstepB, voffB); PG8_STAGE(PG8_SA(0, 0), cA, voffA); PG8_STAGE(PG8_SA(0, 1), cA + hstepA, voffA);
    if (wr == 1) PG8_BAR;
    PG8_WAIT_V(2); PG8_BAR;
    PG8_STAGE(PG8_SB(1, 0), cB + kstep, voffB); PG8_STAGE(PG8_SA(1, 0), cA + kstep, voffA); PG8_STAGE(PG8_SB(1, 1), cB + hstepB + kstep, voffB);
    PG8_WAIT_V(6); PG8_BAR;
    for (;;) {
        const bool has_next = S.next(ui + 1, nxt);
        const char* nA = has_next ? (const char*)g.A + (size_t)nxt.pm * tstepA + (size_t)nxt.pn * g.a_pn_off * 2 : cA; const char* nB = has_next ? (const char*)g.Bt + (size_t)nxt.pn * tstepB : cB;
        for (int t = 0; t < nt; t += 2) {
            const bool last = (t == nt - 2);
            const char* a1 = cA + (size_t)(t + 1) * kstep;
            const char* a2 = last ? nA : cA + (size_t)(t + 2) * kstep; const char* b2 = last ? nB : cB + (size_t)(t + 2) * kstep;
            const char* a3 = a2 + kstep; const char* b3 = b2 + kstep;
            PG8_LDB(B0, 0, 0); PG8_LDB(B1, 0, 1); PG8_SCHED; PG8_LDA(At, 0, 0); PG8_STAGE(PG8_SA(1, 1), a1 + hstepA, voffA);
            PG8_WAIT_V(8); PG8_WAIT_L(0); PG8_BAR; PG8_MMA(0, 0, At, B0); PG8_MMA(0, 1, At, B1); PG8_BAR; PG8_SCHED;
            PG8_LDA(At, 0, 1); PG8_STAGE(PG8_SB(0, 0), b2, voffB); PG8_STAGE(PG8_SB(0, 1), b2 + hstepB, voffB); PG8_STAGE(PG8_SA(0, 0), a2, voffA);
            PG8_WAIT_V(8); PG8_WAIT_L(0); PG8_BAR; PG8_MMA(1, 0, At, B0); PG8_MMA(1, 1, At, B1); PG8_BAR; PG8_SCHED;
            PG8_LDB(B0, 1, 0); PG8_LDB(B1, 1, 1); PG8_SCHED; PG8_LDA(At, 1, 0); PG8_STAGE(PG8_SA(0, 1), a2 + hstepA, voffA);
            PG8_WAIT_V(8); PG8_WAIT_L(0); PG8_BAR; PG8_MMA(0, 0, At, B0); PG8_MMA(0, 1, At, B1); PG8_BAR; PG8_SCHED;
            PG8_LDA(At, 1, 1); PG8_STAGE(PG8_SB(1, 0), b3, voffB); PG8_STAGE(PG8_SB(1, 1), b3 + hstepB, voffB); PG8_STAGE(PG8_SA(1, 0), a3, voffA);
            PG8_WAIT_V(8); PG8_WAIT_L(0); PG8_BAR; PG8_MMA(1, 0, At, B0); PG8_MMA(1, 1, At, B1); PG8_BAR; PG8_SCHED;
        }
        { const int l2 = opaque((int)threadIdx.x) & 63; E(acc, cur, wr, wc, l2 & 15, l2 >> 4); }
        if (!has_next) break;
#pragma unroll
        for (int a = 0; a < 2; ++a)
#pragma unroll
            for (int b = 0; b < 2; ++b)
#pragma unroll
                for (int m = 0; m < 4; ++m)
#pragma unroll
                    for (int n = 0; n < 2; ++n) acc[a][b][m][n] = (f32x4){0.f, 0.f, 0.f, 0.f};
        cur = nxt; cA = nA; cB = nB; ++ui;
    }
    PG8_WAIT_V(0);
    if (wr == 0) PG8_BAR;
    PG8_BAR;
#undef PG8_SA
#undef PG8_SB
#undef PG8_STAGE
#undef PG8_LDA
#undef PG8_LDB
#undef PG8_MMA
#undef PG8_WAIT_V
#undef PG8_WAIT_L
#undef PG8_BAR
#undef PG8_SCHED
}

template <int ACT> struct EpiBf16 {
    static constexpr bool PERM = true, SWAP = false;
    bf16_t* O; int ldc;
    __device__ __forceinline__ void operator()(const f32x4 (&acc)[2][2][4][2], const Unit& u, int wr, int wc, int fr, int fq) const {
        const int row0 = u.pm * BM + wr * 64 + fr, col0 = u.pn * BM + wc * 32 + 8 * fq;
#pragma unroll
        for (int ai = 0; ai < 2; ++ai)
#pragma unroll
            for (int m = 0; m < 4; ++m) { bf16_t* rowp = O + (size_t)(row0 + ai * HALF + m * 16) * ldc + col0;
#pragma unroll
                for (int bj = 0; bj < 2; ++bj) { f32x4 v0 = acc[ai][bj][m][0], v1 = acc[ai][bj][m][1];
                    if (ACT == 1) {
#pragma unroll
                        for (int j = 0; j < 4; ++j) { v0[j] = gelu_tanh(v0[j]); v1[j] = gelu_tanh(v1[j]); } }
                    u32x4 w; w.x = cvt_pk_bf16(v0[0], v0[1]); w.y = cvt_pk_bf16(v0[2], v0[3]); w.z = cvt_pk_bf16(v1[0], v1[1]); w.w = cvt_pk_bf16(v1[2], v1[3]);
                    *(u32x4*)(rowp + bj * HALF) = w; } }
    }
};
struct EpiQT {
    static constexpr bool PERM = true, SWAP = false;
    bf16_t* O;
    __device__ __forceinline__ void operator()(const f32x4 (&acc)[2][2][4][2], const Unit& u, int wr, int wc, int fr, int fq) const {
        const int row0 = u.pm * BM + wr * 64 + fr;
#pragma unroll
        for (int ai = 0; ai < 2; ++ai)
#pragma unroll
            for (int m = 0; m < 4; ++m) { const int row = row0 + ai * HALF + m * 16;
                bf16_t* base = O + ((size_t)((row >> 7) * 8 + u.pn) * 32 * 128 + (row & 127)) * 8;
#pragma unroll
                for (int bj = 0; bj < 2; ++bj) { const f32x4 v0 = acc[ai][bj][m][0], v1 = acc[ai][bj][m][1];
                    u32x4 w; w.x = cvt_pk_bf16(v0[0], v0[1]); w.y = cvt_pk_bf16(v0[2], v0[3]); w.z = cvt_pk_bf16(v1[0], v1[1]); w.w = cvt_pk_bf16(v1[2], v1[3]);
                    *(u32x4*)(base + (size_t)(16 * bj + 4 * wc + fq) * 128 * 8) = w; } }
    }
};
struct EpiPoolGrp {
    static constexpr bool PERM = true, SWAP = false;
    bf16_t* O; const float* scale;
    __device__ __forceinline__ void operator()(const f32x4 (&acc)[2][2][4][2], const Unit& u, int wr, int wc, int fr, int fq) const {
        const int row0 = u.pm * BM + wr * 64 + fr, col0 = u.pn * BM + wc * 32 + 8 * fq;
#pragma unroll
        for (int bj = 0; bj < 2; ++bj) {
            const f32x4 s0 = *(const f32x4*)(scale + col0 + bj * HALF), s1 = *(const f32x4*)(scale + col0 + bj * HALF + 4);
#pragma unroll
            for (int ai = 0; ai < 2; ++ai)
#pragma unroll
                for (int m = 0; m < 4; ++m) { bf16_t* rowp = O + (size_t)(row0 + ai * HALF + m * 16) * DM + col0 + bj * HALF;
                    const f32x4 v0 = acc[ai][bj][m][0] * s0, v1 = acc[ai][bj][m][1] * s1;
                    u32x4 w; w.x = cvt_pk_bf16(v0[0], v0[1]); w.y = cvt_pk_bf16(v0[2], v0[3]); w.z = cvt_pk_bf16(v1[0], v1[1]); w.w = cvt_pk_bf16(v1[2], v1[3]);
                    *(u32x4*)rowp = w; }
            asm volatile("" ::: "memory");
        }
    }
};
struct EpiConvIn {
    static constexpr bool PERM = true, SWAP = false;
    bf16_t* BG; bf16_t* Z;
    __device__ __forceinline__ void operator()(const f32x4 (&acc)[2][2][4][2], const Unit& u, int wr, int wc, int fr, int fq) const {
        const int row0 = u.pm * BM + wr * 64 + fr;
        if (u.pn < 4) {
            const int col0 = u.pn * BM + wc * 32 + 8 * fq;
#pragma unroll
            for (int ai = 0; ai < 2; ++ai)
#pragma unroll
                for (int m = 0; m < 4; ++m) { bf16_t* rowp = BG + (size_t)(row0 + ai * HALF + m * 16) * DM + col0;
#pragma unroll
                    for (int bj = 0; bj < 2; ++bj) { const f32x4 v0 = acc[ai][bj][m][0], v1 = acc[ai][bj][m][1];
                        u32x4 w; w.x = cvt_pk_bf16(v0[0], v0[1]); w.y = cvt_pk_bf16(v0[2], v0[3]); w.z = cvt_pk_bf16(v1[0], v1[1]); w.w = cvt_pk_bf16(v1[2], v1[3]);
                        *(u32x4*)(rowp + bj * HALF) = w; } }
        } else {
            const int col0 = (u.pn - 4) * HALF + wc * 32 + 8 * fq;
#pragma unroll
            for (int ai = 0; ai < 2; ++ai)
#pragma unroll
                for (int m = 0; m < 4; ++m) { bf16_t* rowp = Z + (size_t)(row0 + ai * HALF + m * 16) * DM + col0;
                    const f32x4 v0 = acc[ai][0][m][0] * acc[ai][1][m][0], v1 = acc[ai][0][m][1] * acc[ai][1][m][1];
                    u32x4 w; w.x = cvt_pk_bf16(v0[0], v0[1]); w.y = cvt_pk_bf16(v0[2], v0[3]); w.z = cvt_pk_bf16(v1[0], v1[1]); w.w = cvt_pk_bf16(v1[2], v1[3]);
                    *(u32x4*)rowp = w; }
        }
    }
};
struct EpiResid {
    static constexpr bool PERM = false, SWAP = false;
    const float* base; float* out; const float* gacc; const float* gbias;
    __device__ __forceinline__ void operator()(const f32x4 (&acc)[2][2][4][2], const Unit& u, int wr, int wc, int fr, int fq) const {
        const int row0 = u.pm * BM + wr * 64 + fr, col0 = u.pn * BM + wc * 32 + 4 * fq;
        const float* gp = gacc + (size_t)(u.pm >> 4) * (6 * DM);
#pragma unroll
        for (int bj = 0; bj < 2; ++bj)
#pragma unroll
            for (int n = 0; n < 2; ++n) { const int cc = col0 + bj * HALF + n * 16;
                const f32x4 gv = *(const f32x4*)(gp + cc);
#pragma unroll
                for (int ai = 0; ai < 2; ++ai) {
#pragma unroll
                    for (int m = 0; m < 4; ++m) { const size_t off = (size_t)(row0 + ai * HALF + m * 16) * DM + cc;
                        const f32x4 bs = *(const f32x4*)(base + off);
                        *(f32x4*)(out + off) = bs + gv * acc[ai][bj][m][n]; }
                    asm volatile("" ::: "memory"); } }
    }
};
struct EpiGmlpV {
    static constexpr bool PERM = false, SWAP = true;
    bf16_t* VT;
    __device__ __forceinline__ void operator()(const f32x4 (&acc)[2][2][4][2], const Unit& u, int wr, int wc, int fr, int fq) const {
        const int row0 = u.pm * BM + wr * 64 + 4 * fq, col0 = u.pn * BM + wc * 32 + fr;
#pragma unroll
        for (int bj = 0; bj < 2; ++bj)
#pragma unroll
            for (int n = 0; n < 2; ++n) { const int c = col0 + bj * HALF + n * 16;
#pragma unroll
                for (int ai = 0; ai < 2; ++ai)
#pragma unroll
                    for (int m = 0; m < 4; ++m) { const f32x4 v = acc[ai][bj][m][n]; const int r = row0 + ai * HALF + m * 16;
                        u32x2 w; w.x = cvt_pk_bf16(gelu_tanh(v[0]), gelu_tanh(v[1])); w.y = cvt_pk_bf16(gelu_tanh(v[2]), gelu_tanh(v[3]));
                        *(u32x2*)(VT + ((size_t)(r >> 7) * GH + c) * 128 + (r & 127)) = w; } }
    }
};
}

constexpr int RING_BYTES = 131072;
constexpr int LDS_BYTES = 147456;
constexpr int LDS_XB_OFF = LDS_BYTES - 64;
constexpr int NTHREADS = 512;

#define CE_DESC(a, b) do { const float _x = fmaxf(a, b), _y = fminf(a, b); a = _x; b = _y; } while (0)
#define CE_ASC(a, b)  do { const float _x = fminf(a, b), _y = fmaxf(a, b); a = _x; b = _y; } while (0)
template <int OFF, int N>
__device__ __forceinline__ void sort16_desc(float (&v)[N]) {
#pragma unroll
    for (int k = 2; k <= 16; k <<= 1)
#pragma unroll
        for (int j = k >> 1; j > 0; j >>= 1)
#pragma unroll
            for (int i = 0; i < 16; ++i) { const int l = i ^ j; if (l > i) { if ((i & k) == 0) CE_DESC(v[OFF + i], v[OFF + l]); else CE_ASC(v[OFF + i], v[OFF + l]); } }
}
template <int OFF, int N>
__device__ __forceinline__ void bmerge16_desc(float (&v)[N]) {
#pragma unroll
    for (int j = 8; j > 0; j >>= 1)
#pragma unroll
        for (int i = 0; i < 16; ++i) { const int l = i ^ j; if (l > i) CE_DESC(v[OFF + i], v[OFF + l]); }
}
template <int A, int B, int N>
__device__ __forceinline__ void merge_top16(float (&v)[N]) {
#pragma unroll
    for (int i = 0; i < 16; ++i) v[A + i] = fmaxf(v[A + i], v[B + 15 - i]);
    bmerge16_desc<A, N>(v);
}
__device__ __forceinline__ void top16_of_64(float (&v)[64]) {
    sort16_desc<0, 64>(v); sort16_desc<16, 64>(v); sort16_desc<32, 64>(v); sort16_desc<48, 64>(v);
    merge_top16<0, 16, 64>(v); merge_top16<32, 48, 64>(v); merge_top16<0, 32, 64>(v);
}

struct Args { const float* in[23]; float* out; unsigned char* ws; int ph_lo, ph_hi; };
typedef const __attribute__((address_space(4))) Args* ArgP;
enum { I_X = 0, I_C, I_ADA_W, I_ADA_B, I_NORM_G, I_POOL_WIN, I_POOL_WGRP, I_POOL_SCALE, I_POOL_WOUT, I_CONV_WIN, I_CONV_W, I_CONV_WOUT,
       I_GMLP_WIN, I_GMLP_LNG, I_GMLP_LNB, I_GMLP_WS, I_GMLP_BS, I_GMLP_WOUT, I_PEER_WQ, I_PEER_KEYS, I_PEER_U, I_PEER_V, I_FINAL_G };

__device__ __forceinline__ void transpose_item(const float* W, int K, int N, bf16_t* WT, int dst_row0, LAS float* scr, int k0, int n0, int lane) {
#pragma unroll 8
    for (int i = 0; i < 32; ++i) { const int kk = 2 * i + (lane >> 5); scr[kk * 33 + (lane & 31)] = W[(size_t)(k0 + kk) * N + n0 + (lane & 31)]; }
    asm volatile("s_waitcnt lgkmcnt(0)" ::: "memory");
    const int c = lane & 7;
#pragma unroll
    for (int j = 0; j < 4; ++j) { const int n = (lane >> 3) + 8 * j; const LAS float* s = scr + (8 * c) * 33 + n;
        u32x4 o; o.x = cvt_pk_bf16(s[0 * 33], s[1 * 33]); o.y = cvt_pk_bf16(s[2 * 33], s[3 * 33]); o.z = cvt_pk_bf16(s[4 * 33], s[5 * 33]); o.w = cvt_pk_bf16(s[6 * 33], s[7 * 33]);
        *(u32x4*)(WT + (size_t)(dst_row0 + n) * K + k0 + 8 * c) = o; }
    asm volatile("s_waitcnt lgkmcnt(0)" ::: "memory");
}
__device__ __forceinline__ void convert_stream(const float* src, bf16_t* dst, size_t n8, size_t gt, size_t stride) {
    for (size_t i = gt; i < n8; i += stride) {
        const f32x4 a = __builtin_nontemporal_load((const f32x4*)src + 2 * i), b = __builtin_nontemporal_load((const f32x4*)src + 2 * i + 1);
        u32x4 o; o.x = cvt_pk_bf16(a[0], a[1]); o.y = cvt_pk_bf16(a[2], a[3]); o.z = cvt_pk_bf16(b[0], b[1]); o.w = cvt_pk_bf16(b[2], b[3]);
        *((u32x4*)dst + i) = o; }
}
__device__ __forceinline__ unsigned e2m1_code(float a) { const float aa = fabsf(a);
    const unsigned c = (aa > 0.25f ? 1u : 0u) + (aa > 0.75f ? 1u : 0u) + (aa > 1.25f ? 1u : 0u) + (aa > 1.75f ? 1u : 0u) + (aa > 2.5f ? 1u : 0u) + (aa > 3.5f ? 1u : 0u) + (aa > 5.0f ? 1u : 0u);
    return c | ((__builtin_bit_cast(unsigned, a) >> 28) & 8u); }
__device__ __forceinline__ void prologue_phase(ArgP Ap, LAS unsigned char* lds, int vcu, int G, int tid, int wid, int lane) {
    unsigned char* ws = Ap->ws;
    const int gw = vcu * 8 + wid, NGW = G * 8;
    LAS float* scr = (LAS float*)(lds + wid * 16384);
    constexpr int NT_ITEMS = 1024 + 256 + 1024 + 1536 + 512 + 3072 + 1536 + 4096;
    for (int it = gw; it < NT_ITEMS; it += NGW) {
        int r = it; const float* src; bf16_t* dst; int K, N, kind = 0;
        if (r < 1024) { const int m = r >> 9; r &= 511; src = Ap->in[I_POOL_WIN] + (size_t)m * DM * DM; dst = (bf16_t*)(ws + WS_POOL_WIN) + (size_t)m * DM * DM; K = DM; N = DM; }
        else if ((r -= 1024) < 256) { const int m = r >> 5; r &= 31; src = Ap->in[I_POOL_WGRP] + (size_t)m * 65536; dst = (bf16_t*)(ws + WS_POOL_WGRP) + (size_t)m * 65536; K = 256; N = 256; }
        else if ((r -= 256) < 1024) { const int m = r >> 9; r &= 511; src = Ap->in[I_POOL_WOUT] + (size_t)m * DM * DM; dst = (bf16_t*)(ws + WS_POOL_WOUT) + (size_t)m * DM * DM; K = DM; N = DM; }
        else if ((r -= 1024) < 1536) { src = Ap->in[I_CONV_WIN]; dst = (bf16_t*)(ws + WS_CONV_WIN); K = DM; N = 3 * DM; kind = 1; }
        else if ((r -= 1536) < 512) { src = Ap->in[I_CONV_WOUT]; dst = (bf16_t*)(ws + WS_CONV_WOUT); K = DM; N = DM; }
        else if ((r -= 512) < 3072) { src = Ap->in[I_GMLP_WIN]; dst = (bf16_t*)(ws + WS_GMLP_WIN); K = DM; N = 2 * GH; }
        else if ((r -= 3072) < 1536) { src = Ap->in[I_GMLP_WOUT]; dst = (bf16_t*)(ws + WS_GMLP_WOUT); K = GH; N = DM; }
        else { r -= 1536; const int m = r >> 10; r &= 1023; src = Ap->in[I_PEER_WQ] + (size_t)m * DM * 2048; dst = (bf16_t*)(ws + WS_PEER_WQ) + (size_t)m * DM * 2048; K = DM; N = 2048; }
        const int nblk = N / 32, kb = r / nblk, nb = r % nblk, n0 = 32 * nb;
        int drow = n0;
        if (kind == 1 && n0 >= DM) { const int xt = n0 >= 2 * DM, ch = n0 - (xt ? 2 * DM : DM); drow = DM + 256 * (ch >> 7) + 128 * xt + (ch & 127); }
        transpose_item(src, K, N, dst, drow, scr, 64 * kb, n0, lane);
    }
    const size_t gt = (size_t)vcu * NTHREADS + tid, stride = (size_t)G * NTHREADS;
    convert_stream(Ap->in[I_PEER_KEYS], (bf16_t*)(ws + WS_KEYS), (size_t)DEPTH * 16 * 128 * 128 / 8, gt, stride);
    for (int row0 = gw * 4; row0 < 2 * DEPTH * NEXP; row0 += NGW * 4) {
        f32x4 v[4][4]; float m[4];
#pragma unroll
        for (int rr = 0; rr < 4; ++rr) { const int row = row0 + rr, tab = row >> 16, lrow = row & 65535;
            const f32x4* src = (const f32x4*)((tab ? Ap->in[I_PEER_V] : Ap->in[I_PEER_U]) + (size_t)lrow * DM) + lane;
#pragma unroll
            for (int j = 0; j < 4; ++j) v[rr][j] = __builtin_nontemporal_load(src + 64 * j); }
#pragma unroll
        for (int rr = 0; rr < 4; ++rr) { float mm = 0.f;
#pragma unroll
            for (int j = 0; j < 4; ++j) mm = fmaxf(fmaxf(mm, fmaxf(fabsf(v[rr][j][0]), fabsf(v[rr][j][1]))), fmaxf(fabsf(v[rr][j][2]), fabsf(v[rr][j][3])));
#pragma unroll
            for (int o = 1; o < 64; o <<= 1) mm = fmaxf(mm, __shfl_xor(mm, o));
            m[rr] = mm; }
#pragma unroll
        for (int rr = 0; rr < 4; ++rr) { const int row = row0 + rr, tab = row >> 16, lrow = row & 65535, l = lrow >> 14, e = lrow & (NEXP - 1);
            if (tab) {
                const float S = m[rr] > 0.f ? 256.0f / m[rr] : 1.0f;
#pragma unroll
                for (int j = 0; j < 4; ++j) { int pk = __builtin_amdgcn_cvt_pk_fp8_f32(v[rr][j][0] * S, v[rr][j][1] * S, 0, false); pk = __builtin_amdgcn_cvt_pk_fp8_f32(v[rr][j][2] * S, v[rr][j][3] * S, pk, true);
                    const int d0 = 256 * j + 4 * lane;
                    *(int*)(ws + WS_TABV + (((size_t)l * 8 + (d0 >> 7)) * NEXP + e) * 128 + (d0 & 127)) = pk; }
            } else {
                const float S = m[rr] > 0.f ? (6.0f / 0.9f) / m[rr] : 1.0f;
#pragma unroll
                for (int j = 0; j < 4; ++j) { unsigned pk = e2m1_code(v[rr][j][0] * S) | (e2m1_code(v[rr][j][1] * S) << 4) | (e2m1_code(v[rr][j][2] * S) << 8) | (e2m1_code(v[rr][j][3] * S) << 12);
                    pk |= (unsigned)__shfl_xor((int)pk, 1) << 16;
                    if (!(lane & 1)) *(unsigned*)(ws + WS_TABU + (((size_t)l * 4 + j) * NEXP + e) * 128 + 2 * lane) = pk; }
            }
            if (lane == 0) ((unsigned short*)(ws + WS_SCU))[2 * lrow + tab] = (unsigned short)(cvt_pk_bf16(m[rr] > 0.f ? m[rr] * (tab ? 1.0f / 256.0f : 0.9f / 6.0f) : 1.0f, 0.f) & 0xffffu); }
    }
    for (size_t i = gt; i < (size_t)2 * 4 * 256 * 256 / 8; i += stride) { const size_t idx = i * 8; const int l = (int)(idx >> 18), g = (int)(idx >> 16) & 3, j0 = (int)idx & 255;
        const f32x4 a = *((const f32x4*)Ap->in[I_POOL_WGRP] + 2 * i), b = *((const f32x4*)Ap->in[I_POOL_WGRP] + 2 * i + 1);
        const float* sp = Ap->in[I_POOL_SCALE] + (size_t)l * DM + 256 * g + j0; const f32x4 sa = *(const f32x4*)sp, sb = *(const f32x4*)(sp + 4);
        u32x4 o; o.x = cvt_pk_bf16(a[0] * sa[0], a[1] * sa[1]); o.y = cvt_pk_bf16(a[2] * sa[2], a[3] * sa[3]); o.z = cvt_pk_bf16(b[0] * sb[0], b[1] * sb[1]); o.w = cvt_pk_bf16(b[2] * sb[2], b[3] * sb[3]);
        *((u32x4*)(ws + WS_WGS) + i) = o; }
    __syncthreads();
    LAS float* cond = (LAS float*)lds;
    for (int i = tid; i < BATCH * DM; i += NTHREADS) { const int b = i >> 10, k = i & 1023; const float c = Ap->in[I_C][i]; cond[k * 8 + b] = c * __builtin_amdgcn_rcpf(1.0f + __expf(-c)); }
    __syncthreads();
    float* modp = (float*)(ws + WS_ADAP);
    for (int it = gw; it < DEPTH * 24 * 16; it += NGW) {
        const int l = it / 384, r = it % 384, cgp = r >> 4, kc = r & 15;
        const float* wp = Ap->in[I_ADA_W] + ((size_t)l * DM + kc * 64) * (6 * DM) + cgp * 256 + 4 * lane;
        f32x4 acc[8];
#pragma unroll
        for (int b = 0; b < 8; ++b) acc[b] = (f32x4){0.f, 0.f, 0.f, 0.f};
#pragma unroll 8
        for (int k = 0; k < 64; ++k) { const f32x4 w = __builtin_nontemporal_load((const f32x4*)(wp + (size_t)k * (6 * DM)));
            const f32x4 c0 = *(const LAS f32x4*)(cond + (kc * 64 + k) * 8), c1 = *(const LAS f32x4*)(cond + (kc * 64 + k) * 8 + 4);
            acc[0] += c0[0] * w; acc[1] += c0[1] * w; acc[2] += c0[2] * w; acc[3] += c0[3] * w; acc[4] += c1[0] * w; acc[5] += c1[1] * w; acc[6] += c1[2] * w; acc[7] += c1[3] * w; }
#pragma unroll
        for (int b = 0; b < 8; ++b) *(f32x4*)(modp + (((size_t)kc * DEPTH + l) * 8 + b) * (6 * DM) + cgp * 256 + 4 * lane) = acc[b];
    }
}
__device__ __forceinline__ void modreduce_phase(ArgP Ap, int vcu, int G, int tid) {
    unsigned char* ws = Ap->ws; const float* modp = (const float*)(ws + WS_ADAP); float* mod = (float*)(ws + WS_MOD);
    constexpr int N4 = DEPTH * BATCH * 6 * DM / 4;
    for (int i = vcu * NTHREADS + tid; i < N4; i += G * NTHREADS) {
        const int n4 = i % (6 * DM / 4), l = i / (BATCH * 6 * DM / 4);
        f32x4 a = *((const f32x4*)(Ap->in[I_ADA_B] + (size_t)l * 6 * DM) + n4);
#pragma unroll
        for (int kc = 0; kc < 16; ++kc) a += *((const f32x4*)modp + (size_t)kc * N4 + i);
        *((f32x4*)mod + i) = a; }
}

__device__ __forceinline__ void norm_phase(const float* x, const float* gn, const float* macc  , const float* mbias  , int sh_off, int sc_off, bf16_t* H, int gw, int NGW, int lane) {
    for (int ch = gw; ch < MTOK / 16; ch += NGW) {
        const int row0 = ch * 16, b = row0 >> 12;
        f32x4 c1[4], shv[4];
#pragma unroll
        for (int j = 0; j < 4; ++j) { const int col = 4 * lane + 256 * j;
            const f32x4 sc = *(const f32x4*)(macc + (size_t)b * 6 * DM + sc_off + col);
            c1[j] = *(const f32x4*)(gn + col) * (1.0f + sc);
            shv[j] = *(const f32x4*)(macc + (size_t)b * 6 * DM + sh_off + col); }
        for (int r = row0; r < row0 + 16; ++r) {
            const f32x4* xr = (const f32x4*)(x + (size_t)r * DM) + lane;
            f32x4 v[4]; float ss = 0.f;
#pragma unroll
            for (int j = 0; j < 4; ++j) { v[j] = xr[64 * j]; ss += (v[j][0] * v[j][0] + v[j][1] * v[j][1]) + (v[j][2] * v[j][2] + v[j][3] * v[j][3]); }
            const float rstd = __builtin_amdgcn_rsqf(wave_sum_all(ss) * (1.0f / DM) + EPS);
            u32x2* o8 = (u32x2*)(H + (size_t)r * DM) + lane;
#pragma unroll
            for (int j = 0; j < 4; ++j) { const f32x4 o = v[j] * rstd * c1[j] + shv[j]; u32x2 w; w.x = cvt_pk_bf16(o[0], o[1]); w.y = cvt_pk_bf16(o[2], o[3]); o8[64 * j] = w; }
        }
    }
}
__device__ __forceinline__ void resnorm_phase(const float* xf  , const bf16_t* xsi, bf16_t* xso  , const bf16_t* Y, const float* gate  , const float* gn, const float* macc, int sh_off, int sc_off, bf16_t* H, unsigned char* H8  , int gw, int NGW, int lane) {
    for (int ch = gw; ch < MTOK / 16; ch += NGW) {
        const int row0 = ch * 16, b = row0 >> 12;
        f32x4 c1[4], shv[4], gt[4];
#pragma unroll
        for (int j = 0; j < 4; ++j) { const int col = 4 * lane + 256 * j;
            const f32x4 sc = *(const f32x4*)(macc + (size_t)b * 6 * DM + sc_off + col);
            c1[j] = *(const f32x4*)(gn + col) * (1.0f + sc);
            shv[j] = *(const f32x4*)(macc + (size_t)b * 6 * DM + sh_off + col);
            gt[j] = *(const f32x4*)(gate + (size_t)b * 6 * DM + col); }
        for (int r = row0; r < row0 + 16; ++r) {
            const u32x2* yr = (const u32x2*)(Y + (size_t)r * DM) + lane;
            f32x4 v[4]; float ss = 0.f;
            if (xf) { const f32x4* xr = (const f32x4*)(xf + (size_t)r * DM) + lane;
#pragma unroll
                for (int j = 0; j < 4; ++j) v[j] = xr[64 * j]; }
            else { const u32x2* xr = (const u32x2*)(xsi + (size_t)r * DM) + lane;
#pragma unroll
                for (int j = 0; j < 4; ++j) { const u32x2 xv = xr[64 * j]; v[j] = (f32x4){bf_lo(xv.x), bf_hi(xv.x), bf_lo(xv.y), bf_hi(xv.y)}; } }
            u32x2* xw = (u32x2*)(xso + (size_t)r * DM) + lane;
#pragma unroll
            for (int j = 0; j < 4; ++j) { const u32x2 y = yr[64 * j]; v[j] += gt[j] * (f32x4){bf_lo(y.x), bf_hi(y.x), bf_lo(y.y), bf_hi(y.y)};
                u32x2 w; w.x = cvt_pk_bf16(v[j][0], v[j][1]); w.y = cvt_pk_bf16(v[j][2], v[j][3]); xw[64 * j] = w;
                ss += (v[j][0] * v[j][0] + v[j][1] * v[j][1]) + (v[j][2] * v[j][2] + v[j][3] * v[j][3]); }
            const float rstd = __builtin_amdgcn_rsqf(wave_sum_all(ss) * (1.0f / DM) + EPS);
            u32x2* o8 = (u32x2*)(H + (size_t)r * DM) + lane; int* q8 = (int*)(H8 + (size_t)r * DM) + lane;
#pragma unroll
            for (int j = 0; j < 4; ++j) { const f32x4 o = v[j] * rstd * c1[j] + shv[j]; u32x2 w; w.x = cvt_pk_bf16(o[0], o[1]); w.y = cvt_pk_bf16(o[2], o[3]); o8[64 * j] = w;
                int pk = __builtin_amdgcn_cvt_pk_fp8_f32(o[0], o[1], 0, false); pk = __builtin_amdgcn_cvt_pk_fp8_f32(o[2], o[3], pk, true); q8[64 * j] = pk; }
        }
    }
}
__device__ __forceinline__ void final_phase(float* x, const float* gf, int gw, int NGW, int lane) {
    f32x4 gv[4];
#pragma unroll
    for (int j = 0; j < 4; ++j) gv[j] = *(const f32x4*)(gf + 4 * lane + 256 * j);
    for (int r = gw; r < MTOK; r += NGW) {
        f32x4* xr = (f32x4*)(x + (size_t)r * DM) + lane;
        f32x4 v[4]; float ss = 0.f;
#pragma unroll
        for (int j = 0; j < 4; ++j) { v[j] = xr[64 * j]; ss += (v[j][0] * v[j][0] + v[j][1] * v[j][1]) + (v[j][2] * v[j][2] + v[j][3] * v[j][3]); }
        const float rstd = __builtin_amdgcn_rsqf(wave_sum_all(ss) * (1.0f / DM) + EPS);
#pragma unroll
        for (int j = 0; j < 4; ++j) xr[64 * j] = v[j] * rstd * gv[j];
    }
}

__device__ __forceinline__ void unpack8(const u32x4 w, float (&f)[8]) { f[0] = bf_lo(w.x); f[1] = bf_hi(w.x); f[2] = bf_lo(w.y); f[3] = bf_hi(w.y); f[4] = bf_lo(w.z); f[5] = bf_hi(w.z); f[6] = bf_lo(w.w); f[7] = bf_hi(w.w); }
__device__ __forceinline__ u32x4 pack8(const float (&f)[8]) { u32x4 o; o.x = cvt_pk_bf16(f[0], f[1]); o.y = cvt_pk_bf16(f[2], f[3]); o.z = cvt_pk_bf16(f[4], f[5]); o.w = cvt_pk_bf16(f[6], f[7]); return o; }
__device__ __forceinline__ void pool_elem_phase(const bf16_t* U, bf16_t* P, int vcu, int G, int tid) {
    const int chunk = tid & 127, run = tid >> 7, c0 = 8 * chunk, w = 2 << (c0 >> 8);
    for (int unit = vcu; unit < MTOK / 128; unit += G) {
        const int t0 = unit * 128 + run * 32, seq0 = t0 & ~(SEQ - 1);
        float s[8];
#pragma unroll
        for (int j = 0; j < 8; ++j) s[j] = 0.f;
        for (int tau = t0 - w; tau < t0; ++tau) if (tau >= seq0) { float f[8];     unpack8(*(const u32x4*)(U + (size_t)tau * DM + c0), f);
#pragma unroll
            for (int j = 0; j < 8; ++j) s[j] += f[j]; }
#pragma unroll 1
        for (int tb = t0; tb < t0 + 32; tb += 8) {
            u32x4 cur[8], old[8];
#pragma unroll
            for (int i = 0; i < 8; ++i) { cur[i] = *(const u32x4*)(U + (size_t)(tb + i) * DM + c0);
                const int tl = tb + i - w; old[i] = *(const u32x4*)(U + (size_t)(tl >= seq0 ? tl : seq0) * DM + c0); }
#pragma unroll
            for (int i = 0; i < 8; ++i) { const int t = tb + i; float f[8], o[8]; unpack8(cur[i], f);
#pragma unroll
                for (int j = 0; j < 8; ++j) s[j] += f[j];
                if (t - w >= seq0) { float q[8]; unpack8(old[i], q);
#pragma unroll
                    for (int j = 0; j < 8; ++j) s[j] -= q[j]; }
                const int pos1 = t - seq0 + 1; const float inv = 1.0f / (float)(pos1 < w ? pos1 : w);
#pragma unroll
                for (int j = 0; j < 8; ++j) o[j] = s[j] * inv - f[j];
                *(u32x4*)(P + (size_t)t * DM + c0) = pack8(o); }
        }
    }
}
__device__ __forceinline__ void conv_elem_phase(const bf16_t* BG, const bf16_t* Z, const float* cw  , bf16_t* Aout, int vcu, int G, int tid) {
    const int chunk = tid & 127, run = tid >> 7, c0 = 8 * chunk;
    float w0[8], w1[8], w2[8];
#pragma unroll
    for (int j = 0; j < 8; ++j) { w0[j] = cw[c0 + j]; w1[j] = cw[DM + c0 + j]; w2[j] = cw[2 * DM + c0 + j]; }
    for (int unit = vcu; unit < MTOK / 128; unit += G) {
        const int t0 = unit * 128 + run * 32, seq0 = t0 & ~(SEQ - 1);
        float zm2[8], zm1[8];
#pragma unroll
        for (int j = 0; j < 8; ++j) { zm2[j] = 0.f; zm1[j] = 0.f; }
        if (t0 - 2 >= seq0) unpack8(*(const u32x4*)(Z + (size_t)(t0 - 2) * DM + c0), zm2);
        if (t0 - 1 >= seq0) unpack8(*(const u32x4*)(Z + (size_t)(t0 - 1) * DM + c0), zm1);
#pragma unroll 1
        for (int tb = t0; tb < t0 + 32; tb += 8) {
            u32x4 zr[8], br[8];
#pragma unroll
            for (int i = 0; i < 8; ++i) { zr[i] = *(const u32x4*)(Z + (size_t)(tb + i) * DM + c0); br[i] = *(const u32x4*)(BG + (size_t)(tb + i) * DM + c0); }
#pragma unroll
            for (int i = 0; i < 8; ++i) { float z[8], bg[8], o[8]; unpack8(zr[i], z); unpack8(br[i], bg);
#pragma unroll
                for (int j = 0; j < 8; ++j) { o[j] = bg[j] * (w0[j] * zm2[j] + w1[j] * zm1[j] + w2[j] * z[j]); zm2[j] = zm1[j]; zm1[j] = z[j]; }
                *(u32x4*)(Aout + (size_t)(tb + i) * DM + c0) = pack8(o); }
        }
    }
}

__device__ __forceinline__ int wp_off(int row, int chunk) { return row * 256 + ((chunk ^ (row & 15)) << 4); }
__device__ __forceinline__ void mix_phase(LAS unsigned char* lds, bf16_t* UA, const bf16_t* VT, const float* WS, const float* BS, const float* LNG, const float* LNB, int vcu, int G, int tid, int wid, int lane) {
    LAS unsigned char* WP = lds;
    LAS float* MU = (LAS float*)(lds + 32768); LAS float* RSTD = MU + 128; LAS float* R1 = MU + 256; LAS float* R2 = MU + 384;
    LAS float* PART = (LAS float*)(lds + 36864);
    LAS unsigned char* VS = lds + 36864;
    for (int n = vcu; n < MTOK / 128; n += G) {
        {
            const int cgp = tid >> 4, tl = tid & 15;
            float s[8], q[8];
#pragma unroll
            for (int j = 0; j < 8; ++j) { s[j] = 0.f; q[j] = 0.f; }
#pragma unroll 4
            for (int it = 0; it < GH / 32; ++it) { float f[8]; unpack8(*(const u32x4*)(VT + ((size_t)n * GH + it * 32 + cgp) * 128 + tl * 8), f);
#pragma unroll
                for (int j = 0; j < 8; ++j) { s[j] += f[j]; q[j] += f[j] * f[j]; } }
#pragma unroll
            for (int j = 0; j < 8; ++j) { PART[(cgp * 128 + tl * 8 + j) * 2] = s[j]; PART[(cgp * 128 + tl * 8 + j) * 2 + 1] = q[j]; }
            __syncthreads();
            if (tid < 128) { float S = 0.f, Q = 0.f;
                for (int k = 0; k < 32; ++k) { S += PART[(k * 128 + tid) * 2]; Q += PART[(k * 128 + tid) * 2 + 1]; }
                const float mu = S * (1.0f / GH), var = Q * (1.0f / GH) - mu * mu; MU[tid] = mu; RSTD[tid] = __builtin_amdgcn_rsqf(fmaxf(var, 0.f) + EPS); }
            __syncthreads();
        }
        for (int g = 0; g < 8; ++g) {
            const int fr = lane & 15, fq = lane >> 4, cbase = g * 384 + wid * 48;
            bf16x8 av[4][3];
#pragma unroll
            for (int ks = 0; ks < 4; ++ks)
#pragma unroll
                for (int ct = 0; ct < 3; ++ct) av[ks][ct] = *(const bf16x8*)(VT + ((size_t)n * GH + cbase + ct * 16 + fr) * 128 + ks * 32 + fq * 8);
            {
                const int i = tid >> 2, part = tid & 3;
                const float* wrow = WS + ((size_t)g * 128 + i) * 128 + part * 32;
                float r1 = 0.f, r2 = 0.f;
#pragma unroll
                for (int jj = 0; jj < 32; jj += 8) { const int j0 = part * 32 + jj;
                    f32x4 a = *(const f32x4*)(wrow + jj), b = *(const f32x4*)(wrow + jj + 4);
                    if (i < 64 && j0 >= 64) { a = (f32x4){0.f, 0.f, 0.f, 0.f}; b = a; }
                    const f32x4 ra = *(const LAS f32x4*)(RSTD + j0), rb = *(const LAS f32x4*)(RSTD + j0 + 4), ma = *(const LAS f32x4*)(MU + j0), mb = *(const LAS f32x4*)(MU + j0 + 4);
                    const f32x4 wa = a * ra, wb = b * rb;
                    r1 += (wa[0] * ma[0] + wa[1] * ma[1]) + (wa[2] * ma[2] + wa[3] * ma[3]) + (wb[0] * mb[0] + wb[1] * mb[1]) + (wb[2] * mb[2] + wb[3] * mb[3]);
                    r2 += (a[0] + a[1]) + (a[2] + a[3]) + (b[0] + b[1]) + (b[2] + b[3]);
                    u32x4 o; o.x = cvt_pk_bf16(wa[0], wa[1]); o.y = cvt_pk_bf16(wa[2], wa[3]); o.z = cvt_pk_bf16(wb[0], wb[1]); o.w = cvt_pk_bf16(wb[2], wb[3]);
                    *(LAS u32x4*)(WP + wp_off(i, j0 >> 3)) = o; }
                r1 += __shfl_xor(r1, 1); r1 += __shfl_xor(r1, 2); r2 += __shfl_xor(r2, 1); r2 += __shfl_xor(r2, 2);
                if (part == 0) { R1[i] = r1; R2[i] = r2; }
            }
            __syncthreads();
            f32x4 acc[3][8];
#pragma unroll
            for (int ct = 0; ct < 3; ++ct)
#pragma unroll
                for (int it = 0; it < 8; ++it) acc[ct][it] = (f32x4){0.f, 0.f, 0.f, 0.f};
#pragma unroll
            for (int ks = 0; ks < 4; ++ks) {
#pragma unroll
                for (int it = 0; it < 8; ++it) { const bf16x8 bw = *(const LAS bf16x8*)(WP + wp_off(it * 16 + fr, ks * 4 + fq));
#pragma unroll
                    for (int ct = 0; ct < 3; ++ct) acc[ct][it] = __builtin_amdgcn_mfma_f32_16x16x32_bf16(av[ks][ct], bw, acc[ct][it], 0, 0, 0); }
                __builtin_amdgcn_sched_barrier(0);
            }
#pragma unroll
            for (int ct = 0; ct < 3; ++ct) { const int c4 = cbase + ct * 16 + 4 * fq;
                const f32x4 lg = *(const f32x4*)(LNG + c4), lb = *(const f32x4*)(LNB + c4);
#pragma unroll
                for (int it = 0; it < 8; ++it) { const int i = it * 16 + fr; const float r1 = R1[i], r2 = R2[i], bs = BS[g * 128 + i];
                    const f32x4 vs = lg * (acc[ct][it] - r1) + lb * r2 + bs;
                    u32x2 o; o.x = cvt_pk_bf16(vs[0], vs[1]); o.y = cvt_pk_bf16(vs[2], vs[3]);
                    *(LAS u32x2*)(VS + i * 784 + (wid * 48 + ct * 16 + 4 * fq) * 2) = o; } }
            __syncthreads();
#pragma unroll 4
            for (int c = tid; c < 128 * 48; c += NTHREADS) { const int tok = c / 48, ch8 = c - tok * 48;
                const u32x4 vv = *(const LAS u32x4*)(VS + tok * 784 + ch8 * 16);
                u32x4* up = (u32x4*)(UA + (size_t)(n * 128 + tok) * GH + g * 384 + ch8 * 8); const u32x4 uu = *up;
                u32x4 o; o.x = cvt_pk_bf16(bf_lo(uu.x) * bf_lo(vv.x), bf_hi(uu.x) * bf_hi(vv.x)); o.y = cvt_pk_bf16(bf_lo(uu.y) * bf_lo(vv.y), bf_hi(uu.y) * bf_hi(vv.y));
                o.z = cvt_pk_bf16(bf_lo(uu.z) * bf_lo(vv.z), bf_hi(uu.z) * bf_hi(vv.z)); o.w = cvt_pk_bf16(bf_lo(uu.w) * bf_lo(vv.w), bf_hi(uu.w) * bf_hi(vv.w));
                *up = o; }
            __syncthreads();
        }
    }
}

__device__ __forceinline__ void topk_units(LAS unsigned char* lds, const bf16_t* Q, const bf16_t* KEYS, int* SELI, float* SELW, const pg8::StaticOrder& S, int tid, int wid, int lane) {
    LAS unsigned char* kl = lds;
    LAS float* topv = (LAS float*)(lds + 65536);
    const int p = wid >> 2, sub = wid & 3, tl = lane & 31, hi = lane >> 5;
    int hprev = -1;
#pragma unroll 1
    for (int k = 0; ; k = (k & 1) ? k + 3 : k + 1) {
        pg8::Unit ua, ub; if (!S.next(k, ua)) break;
        const bool hasb = S.next(k + 2, ub);
        const bool pair = hasb && ub.pn == ua.pn;
#pragma unroll 1
        for (int part = 0; part < ((hasb && !pair) ? 2 : 1); ++part) {
            const int h = part ? ub.pn : ua.pn, pm0 = part ? ub.pm : ua.pm, pm1 = ub.pm, ntile = pair ? 4 : 2;
            __syncthreads();
            if (h != hprev) {
                for (int c = tid; c < 4096; c += NTHREADS) { const int row = c >> 4, ch = c & 15;
                    const u32x4 v = *(const u32x4*)(KEYS + ((size_t)h * 256 + row) * 128 + ch * 8);
                    *(LAS u32x4*)(kl + row * 256 + ((ch ^ (row & 15)) << 4)) = v; }
                hprev = h; }
            __syncthreads();
#pragma unroll 1
            for (int t4 = 0; t4 < ntile; ++t4) {
                const int tile = 2 * (t4 < 2 ? pm0 : pm1) + (t4 & 1);
                const bf16_t* qrow = Q + ((size_t)((tile * 8 + h) * 32 + 16 * p + hi) * 128 + sub * 32 + tl) * 8;
                bf16x8 bq[8];
#pragma unroll
                for (int ks = 0; ks < 8; ++ks) bq[ks] = *(const bf16x8*)(qrow + (size_t)ks * 2 * 128 * 8);
                f32x16 acc[4];
#pragma unroll
                for (int kt = 0; kt < 4; ++kt)
#pragma unroll
                    for (int r = 0; r < 16; ++r) acc[kt][r] = 0.f;
#pragma unroll
                for (int ks = 0; ks < 8; ++ks)
#pragma unroll
                    for (int kt = 0; kt < 4; ++kt) { const int row = p * 128 + kt * 32 + tl;
                        const bf16x8 ak = *(const LAS bf16x8*)(kl + row * 256 + (((2 * ks + hi) ^ (row & 15)) << 4));
                        acc[kt] = __builtin_amdgcn_mfma_f32_32x32x16_bf16(ak, bq[ks], acc[kt], 0, 0, 0); }
                float v[64];
#pragma unroll
                for (int kt = 0; kt < 4; ++kt)
#pragma unroll
                    for (int r = 0; r < 16; ++r) { const unsigned key = (unsigned)(kt * 32 + (r & 3) + 8 * (r >> 2) + 4 * hi);
                        v[kt * 16 + r] = __uint_as_float((__float_as_uint(acc[kt][r]) & ~127u) | key); }
                top16_of_64(v);
                float m[16];
#pragma unroll
                for (int i = 0; i < 16; ++i) m[i] = fmaxf(v[i], __shfl_xor(v[15 - i], 32));
                bmerge16_desc<0, 16>(m);
                if (hi == 0) { LAS f32x4* dst = (LAS f32x4*)(topv + ((t4 * 2 + p) * 128 + sub * 32 + tl) * 16);
#pragma unroll
                    for (int i = 0; i < 4; ++i) dst[i] = (f32x4){m[4 * i], m[4 * i + 1], m[4 * i + 2], m[4 * i + 3]}; }
            }
            __syncthreads();
            if (tid < ntile * 128) {
                const int t4 = tid >> 7, tok = tid & 127, tile = 2 * (t4 < 2 ? pm0 : pm1) + (t4 & 1);
                const LAS float* t0 = topv + ((t4 * 2 + 0) * 128 + tok) * 16; const LAS float* t1 = topv + ((t4 * 2 + 1) * 128 + tok) * 16;
                float s0[16], s1[16];
#pragma unroll
                for (int i = 0; i < 4; ++i) { const f32x4 a = *(const LAS f32x4*)(t0 + 4 * i), b = *(const LAS f32x4*)(t1 + 4 * i);
                    s0[4 * i] = a[0]; s0[4 * i + 1] = a[1]; s0[4 * i + 2] = a[2]; s0[4 * i + 3] = a[3]; s1[4 * i] = b[0]; s1[4 * i + 1] = b[1]; s1[4 * i + 2] = b[2]; s1[4 * i + 3] = b[3]; }
                float c[64];
                constexpr int pre[16] = {0, 16, 24, 29, 33, 36, 38, 40, 42, 43, 44, 45, 46, 47, 48, 49};
#pragma unroll
                for (int a = 0; a < 16; ++a)
#pragma unroll
                    for (int b = 0; b < 16; ++b) if ((a + 1) * (b + 1) <= 16) c[pre[a] + b] = __uint_as_float((__float_as_uint(s0[a] + s1[b]) & ~255u) | (unsigned)(a * 16 + b));
#pragma unroll
                for (int i = 50; i < 64; ++i) c[i] = -3.0e38f;
                top16_of_64(c);
                float e[16], sum = 0.f;
#pragma unroll
                for (int kk = 0; kk < 16; ++kk) { e[kk] = __builtin_amdgcn_exp2f((c[kk] - c[0]) * 1.44269504f); sum += e[kk]; }
                const float inv = 1.0f / sum;
                const size_t o = (size_t)(tile * 128 + tok) * NPICK + h * 16;
#pragma unroll
                for (int k4 = 0; k4 < 4; ++k4) { i32x4 ei; f32x4 wv;
#pragma unroll
                    for (int j = 0; j < 4; ++j) { const unsigned code = __float_as_uint(c[4 * k4 + j]) & 255u;
                        const unsigned i1 = __float_as_uint(t0[code >> 4]) & 127u, i2 = __float_as_uint(t1[code & 15u]) & 127u;
                        ei[j] = (int)(i1 * 128u + i2); wv[j] = e[4 * k4 + j] * inv; }
                    *(i32x4*)(SELI + o + 4 * k4) = ei; *(f32x4*)(SELW + o + 4 * k4) = wv; }
            }
        }
    }
    __syncthreads();
}

typedef const unsigned char* cbytes;
template <int CTRL> __device__ __forceinline__ float dpp_f(float v) { return __builtin_bit_cast(float, __builtin_amdgcn_update_dpp(0, __builtin_bit_cast(int, v), CTRL, 0xf, 0xf, false)); }
#define DPP_F(v, ctrl) dpp_f<(ctrl)>(v)
#define PG_IDX(EV, TKN) do { const LAS u32x4* _ip = (const LAS u32x4*)(idxw + (TKN) * 128 + 16 * g8); \
        _Pragma("unroll") for (int q = 0; q < 2; ++q) { const u32x4 _e = _ip[q]; _Pragma("unroll") for (int w = 0; w < 4; ++w) { EV[8 * q + 2 * w] = (int)(_e[w] & 0xffffu); EV[8 * q + 2 * w + 1] = (int)(_e[w] >> 16); } } } while (0)
#define PG_GATHER8(BUF, SL, EV, J0) do { _Pragma("unroll") for (int j = 0; j < 8; ++j) BUF[j] = *(const u32x4*)((SL) + ((unsigned)EV[(J0) + j] * 128u + s8 * 16u)); } while (0)
#define PGU_IDX(EV, TKN) do { const u32x4 _e = *(const LAS u32x4*)(idxw + (TKN) * 128 + 8 * r16); \
        _Pragma("unroll") for (int w = 0; w < 4; ++w) { EV[2 * w] = (int)(_e[w] & 0xffffu); EV[2 * w + 1] = (int)(_e[w] >> 16); } } while (0)
#define PGU_GATHER4(BUF, SL, EV, G0) do { _Pragma("unroll") for (int j = 0; j < 4; ++j) { cbytes _p = (SL) + ((unsigned)EV[(G0) + j] * 128u + c4 * 16u); BUF[2 * j] = *(const u32x4*)_p; BUF[2 * j + 1] = *(const u32x4*)(_p + 64); } } while (0)
#define PGU_HB(HB, IT) do { const int _it = (IT) < 63 ? (IT) : 63; const u32x4* _hp = (const u32x4*)(H8 + (size_t)(tk0 + (_it & 15)) * DM + (((xg + (_it >> 4)) & 3) * 256) + c4 * 16); \
        HB[0] = _hp[0]; HB[1] = _hp[4]; HB[2] = _hp[8]; HB[3] = _hp[12]; } while (0)
#define PGU_MMA4(BUF, HB, DD) do { const i32x8 _b0 = {(int)HB[0].x, (int)HB[0].y, (int)HB[0].z, (int)HB[0].w, (int)HB[1].x, (int)HB[1].y, (int)HB[1].z, (int)HB[1].w}; \
        const i32x8 _b1 = {(int)HB[2].x, (int)HB[2].y, (int)HB[2].z, (int)HB[2].w, (int)HB[3].x, (int)HB[3].y, (int)HB[3].z, (int)HB[3].w}; \
        _Pragma("unroll") for (int j = 0; j < 4; ++j) { const u32x4 _u0 = BUF[2 * j], _u1 = BUF[2 * j + 1]; \
            const i32x8 _a0 = {(int)_u0.x, (int)_u0.y, (int)_u0.z, (int)_u0.w, 0, 0, 0, 0}, _a1 = {(int)_u1.x, (int)_u1.y, (int)_u1.z, (int)_u1.w, 0, 0, 0, 0}; \
            DD[j] = __builtin_amdgcn_mfma_scale_f32_16x16x128_f8f6f4(_a0, _b0, DD[j], 4, 0, 0, 0, 0, 0); \
            DD[j] = __builtin_amdgcn_mfma_scale_f32_16x16x128_f8f6f4(_a1, _b1, DD[j], 4, 0, 0, 0, 0, 0); } } while (0)
#define PGU_ZERO4(DD) do { _Pragma("unroll") for (int g = 0; g < 4; ++g) DD[g] = (f32x4){0.f, 0.f, 0.f, 0.f}; } while (0)
#define PGU_DOTS(DD, TKN, HALF_) do { if (r16 == 0) { LAS f32x4* _dp = (LAS f32x4*)(dotw + (TKN) * 128 + 32 * c4) + (HALF_); \
        _Pragma("unroll") for (int j = 0; j < 4; ++j) _dp[2 * j] += (f32x4){DD[0][j], DD[1][j], DD[2][j], DD[3][j]}; } } while (0)
#define PG_VCOMP8(BUF, CV, J0) do { _Pragma("unroll") for (int j = 0; j < 8; ++j) { const u32x4 v = BUF[j]; const float c = CV[(J0) + j]; \
            acc[0] += c * __builtin_amdgcn_cvt_pk_f32_fp8(v.x, false); acc[1] += c * __builtin_amdgcn_cvt_pk_f32_fp8(v.x, true); \
            acc[2] += c * __builtin_amdgcn_cvt_pk_f32_fp8(v.y, false); acc[3] += c * __builtin_amdgcn_cvt_pk_f32_fp8(v.y, true); \
            acc[4] += c * __builtin_amdgcn_cvt_pk_f32_fp8(v.z, false); acc[5] += c * __builtin_amdgcn_cvt_pk_f32_fp8(v.z, true); \
            acc[6] += c * __builtin_amdgcn_cvt_pk_f32_fp8(v.w, false); acc[7] += c * __builtin_amdgcn_cvt_pk_f32_fp8(v.w, true); } } while (0)
#define PG_COEF(CV, TKN) do { const LAS f32x4* _cp = (const LAS f32x4*)(dotw + (TKN) * 128 + 16 * g8); \
        _Pragma("unroll") for (int q = 0; q < 4; ++q) { const f32x4 _c = _cp[q]; CV[4 * q] = _c[0]; CV[4 * q + 1] = _c[1]; CV[4 * q + 2] = _c[2]; CV[4 * q + 3] = _c[3]; } } while (0)
#define PG_COEF8(CV, TKN, J0) do { const LAS f32x4* _cp = (const LAS f32x4*)(dotw + (TKN) * 128 + 16 * g8 + (J0)); \
        const f32x4 _c0 = _cp[0], _c1 = _cp[1]; CV[0] = _c0[0]; CV[1] = _c0[1]; CV[2] = _c0[2]; CV[3] = _c0[3]; CV[4] = _c1[0]; CV[5] = _c1[1]; CV[6] = _c1[2]; CV[7] = _c1[3]; } while (0)
#define PG_XOFFS(IT) ((size_t)(tk0 + ((IT) & 15)) * DM + (((xg + ((IT) >> 4)) & 7) * 128) + xoff)
#define PG_XADDR(IT) (x + PG_XOFFS(IT))
#define PG_XLOAD(XV, IT) do { XV = *(const unsigned*)PG_XADDR(IT); } while (0)
__device__ __forceinline__ void peer_gather_phase(LAS unsigned char* lds, const unsigned char* H8  , cbytes TUP, cbytes TVP, const int* SELI, const float* SELW, const unsigned* SC, bf16_t* x  , float* outf  , const float* gacc, const float* gn_next  , const float* mod_next  , bf16_t* Hout, bool last, int vcu, int G, int wid, int lane) {
    const int g8 = lane >> 3, s8 = lane & 7, r16 = lane & 15, c4 = lane >> 4;
    const bool b3 = (lane & 8) != 0, b4 = (lane & 16) != 0, b5 = (lane & 32) != 0;
    const int xoff = s8 * 16 + 8 * (g8 & 1) + 4 * ((g8 >> 1) & 1) + 2 * (g8 >> 2);
    LAS unsigned short* idxw = (LAS unsigned short*)(lds + wid * 12288);
    LAS float* dotw = (LAS float*)(lds + wid * 12288 + 4096);
    for (int blk = vcu; blk < 256; blk += G) {
        const int xg = blk >> 5, tk0 = blk * 128 + wid * 16;
#pragma unroll 4
        for (int i = 0; i < 16; ++i) { const int e0 = SELI[(size_t)(tk0 + i) * NPICK + lane], e1 = SELI[(size_t)(tk0 + i) * NPICK + 64 + lane];
            idxw[i * 128 + lane] = (unsigned short)e0; idxw[i * 128 + 64 + lane] = (unsigned short)e1; dotw[i * 128 + lane] = 0.f; dotw[i * 128 + 64 + lane] = 0.f; }
        asm volatile("" ::: "memory");
        {
            int ev[8]; u32x4 bufA[8], bufB[8], bufC[8], bufD[8]; u32x4 hb0[4], hb1[4];
            { cbytes sl0 = TUP + (size_t)(xg & 3) * NEXP * 128;
              PGU_IDX(ev, 0); PGU_GATHER4(bufA, sl0, ev, 0); PGU_GATHER4(bufB, sl0, ev, 4);
              PGU_IDX(ev, 1); PGU_GATHER4(bufC, sl0, ev, 0); PGU_GATHER4(bufD, sl0, ev, 4); }
            PGU_HB(hb0, 0); PGU_HB(hb1, 1);
#pragma unroll 1
            for (int it = 0; it < 64; it += 2) {
                const int tkn = it & 15, it2 = it + 2 < 63 ? it + 2 : 63, it3 = it + 3 < 63 ? it + 3 : 63;
                cbytes sl2 = TUP + (size_t)((xg + (it2 >> 4)) & 3) * NEXP * 128;
                f32x4 dd[4];
                PGU_ZERO4(dd); PGU_IDX(ev, it2 & 15);
                PGU_MMA4(bufA, hb0, dd); __builtin_amdgcn_sched_barrier(0);
                PGU_GATHER4(bufA, sl2, ev, 0); __builtin_amdgcn_sched_barrier(0);
                PGU_DOTS(dd, tkn, 0); PGU_ZERO4(dd);
                PGU_MMA4(bufB, hb0, dd); __builtin_amdgcn_sched_barrier(0);
                PGU_GATHER4(bufB, sl2, ev, 4); PGU_HB(hb0, it + 2); __builtin_amdgcn_sched_barrier(0);
                PGU_DOTS(dd, tkn, 1); PGU_ZERO4(dd);
                PGU_IDX(ev, it3 & 15);
                PGU_MMA4(bufC, hb1, dd); __builtin_amdgcn_sched_barrier(0);
                PGU_GATHER4(bufC, sl2, ev, 0); __builtin_amdgcn_sched_barrier(0);
                PGU_DOTS(dd, tkn + 1, 0); PGU_ZERO4(dd);
                PGU_MMA4(bufD, hb1, dd); __builtin_amdgcn_sched_barrier(0);
                PGU_GATHER4(bufD, sl2, ev, 4); PGU_HB(hb1, it + 3); __builtin_amdgcn_sched_barrier(0);
                PGU_DOTS(dd, tkn + 1, 1);
            }
        }
        asm volatile("" ::: "memory");
#pragma unroll 2
        for (int i = 0; i < 16; ++i) {
#pragma unroll
            for (int hh = 0; hh < 2; ++hh) { const int k = 16 * g8 + s8 + 8 * hh; const int e = idxw[i * 128 + k];
                const float w = SELW[(size_t)(tk0 + i) * NPICK + k]; const unsigned sc = SC[e];
                dotw[i * 128 + k] = w * gelu_tanh(dotw[i * 128 + k] * bf_lo(sc)) * bf_hi(sc); } }
        asm volatile("" ::: "memory");
        {
            const float* gp = gacc + (size_t)(tk0 >> 12) * 6 * DM + xoff;
            int ev[16]; u32x4 bufA[8], bufB[8], bufC[8], bufD[8]; float cC[8]; unsigned x0, x1;
            { cbytes sl0 = TVP + (size_t)(xg & 7) * NEXP * 128;
              PG_IDX(ev, 0); PG_GATHER8(bufA, sl0, ev, 0); PG_GATHER8(bufB, sl0, ev, 8);
              PG_IDX(ev, 1); PG_GATHER8(bufC, sl0, ev, 0); PG_GATHER8(bufD, sl0, ev, 8); }
            PG_XLOAD(x0, 0); PG_XLOAD(x1, 1);
#define PG_VREDUCE_STORE(XV, IT) do { \
                f32x2 k4[4]; _Pragma("unroll") for (int j = 0; j < 4; ++j) { f32x2 lo = acc[j], hi = acc[4 + j];          \
                    lo.x += DPP_F(lo.x, 0x128); lo.y += DPP_F(lo.y, 0x128); hi.x += DPP_F(hi.x, 0x128); hi.y += DPP_F(hi.y, 0x128); k4[j] = b3 ? hi : lo; } \
                f32x2 k2[2]; _Pragma("unroll") for (int j = 0; j < 2; ++j) { const f32x2 snd = b4 ? k4[j] : k4[2 + j]; k2[j] = b4 ? k4[2 + j] : k4[j]; k2[j].x += __shfl_xor(snd.x, 16); k2[j].y += __shfl_xor(snd.y, 16); } \
                const f32x2 snd = b5 ? k2[0] : k2[1]; f32x2 k1 = b5 ? k2[1] : k2[0]; \
                k1.x += __shfl_xor(snd.x, 32); k1.y += __shfl_xor(snd.y, 32); \
                *(unsigned*)PG_XADDR(IT) = cvt_pk_bf16(bf_lo(XV) + gate.x * k1.x, bf_hi(XV) + gate.y * k1.y); } while (0)
#pragma unroll 1
            for (int it = 0; it < 128; it += 2) {
                const int it2 = it + 2 < 127 ? it + 2 : 127, it3 = it + 3 < 127 ? it + 3 : 127, sl = (xg + (it >> 4)) & 7;
                cbytes sl2 = TVP + (size_t)((xg + (it2 >> 4)) & 7) * NEXP * 128;
                const f32x2 gate = *(const f32x2*)(gp + sl * 128);
                f32x2 acc[8];
#pragma unroll
                for (int j = 0; j < 8; ++j) acc[j] = (f32x2){0.f, 0.f};
                PG_COEF8(cC, it & 15, 0); PG_IDX(ev, it2 & 15);
                PG_VCOMP8(bufA, cC, 0); __builtin_amdgcn_sched_barrier(0);
                PG_GATHER8(bufA, sl2, ev, 0); PG_COEF8(cC, it & 15, 8); __builtin_amdgcn_sched_barrier(0);
                PG_VCOMP8(bufB, cC, 0); __builtin_amdgcn_sched_barrier(0);
                PG_GATHER8(bufB, sl2, ev, 8); __builtin_amdgcn_sched_barrier(0);
                PG_VREDUCE_STORE(x0, it);
                PG_XLOAD(x0, it2);
#pragma unroll
                for (int j = 0; j < 8; ++j) acc[j] = (f32x2){0.f, 0.f};
                PG_COEF8(cC, (it + 1) & 15, 0); PG_IDX(ev, it3 & 15);
                PG_VCOMP8(bufC, cC, 0); __builtin_amdgcn_sched_barrier(0);
                PG_GATHER8(bufC, sl2, ev, 0); PG_COEF8(cC, (it + 1) & 15, 8); __builtin_amdgcn_sched_barrier(0);
                PG_VCOMP8(bufD, cC, 0); __builtin_amdgcn_sched_barrier(0);
                PG_GATHER8(bufD, sl2, ev, 8); __builtin_amdgcn_sched_barrier(0);
                PG_VREDUCE_STORE(x1, it + 1);
                PG_XLOAD(x1, it3);
            }
#undef PG_VREDUCE_STORE
        }
        asm volatile("s_waitcnt vmcnt(0)" ::: "memory");
        {
            const int b = tk0 >> 12;
            f32x4 c1[4], shv[4];
#pragma unroll
            for (int j = 0; j < 4; ++j) { const int col = 4 * lane + 256 * j;
                if (last) { c1[j] = *(const f32x4*)(gn_next + col); shv[j] = (f32x4){0.f, 0.f, 0.f, 0.f}; }
                else { c1[j] = *(const f32x4*)(gn_next + col) * (1.0f + *(const f32x4*)(mod_next + (size_t)b * 6 * DM + DM + col)); shv[j] = *(const f32x4*)(mod_next + (size_t)b * 6 * DM + col); } }
#pragma unroll 1
            for (int i0 = 0; i0 < 16; i0 += 4) {
                f32x4 v[4][4]; float ss[4];
#pragma unroll
                for (int rr = 0; rr < 4; ++rr) { const u32x2* xr = (const u32x2*)(x + (size_t)(tk0 + i0 + rr) * DM) + lane;
#pragma unroll
                    for (int j = 0; j < 4; ++j) { const u32x2 xv = xr[64 * j]; v[rr][j] = (f32x4){bf_lo(xv.x), bf_hi(xv.x), bf_lo(xv.y), bf_hi(xv.y)}; } }
#pragma unroll
                for (int rr = 0; rr < 4; ++rr) { float q = 0.f;
#pragma unroll
                    for (int j = 0; j < 4; ++j) q += (v[rr][j][0] * v[rr][j][0] + v[rr][j][1] * v[rr][j][1]) + (v[rr][j][2] * v[rr][j][2] + v[rr][j][3] * v[rr][j][3]);
                    ss[rr] = q; }
#pragma unroll
                for (int o = 1; o < 64; o <<= 1) {
#pragma unroll
                    for (int rr = 0; rr < 4; ++rr) ss[rr] += __shfl_xor(ss[rr], o); }
#pragma unroll
                for (int rr = 0; rr < 4; ++rr) { const int r = tk0 + i0 + rr; const float rstd = __builtin_amdgcn_rsqf(ss[rr] * (1.0f / DM) + EPS);
                    if (last) { f32x4* xr = (f32x4*)(outf + (size_t)r * DM) + lane;
#pragma unroll
                        for (int j = 0; j < 4; ++j) xr[64 * j] = v[rr][j] * rstd * c1[j]; }
                    else { u32x2* o8 = (u32x2*)(Hout + (size_t)r * DM) + lane;
#pragma unroll
                        for (int j = 0; j < 4; ++j) { const f32x4 o = v[rr][j] * rstd * c1[j] + shv[j]; u32x2 w; w.x = cvt_pk_bf16(o[0], o[1]); w.y = cvt_pk_bf16(o[2], o[3]); o8[64 * j] = w; } } }
            }
        }
    }
}
#undef PG_IDX
#undef PG_GATHER8
#undef PGU_IDX
#undef PGU_GATHER4
#undef PGU_HB
#undef PGU_MMA4
#undef PGU_DOTS
#undef PGU_ZERO4
#undef PG_VCOMP8
#undef PG_COEF
#undef PG_COEF8
#undef PG_XADDR
#undef PG_XOFFS
#undef PG_XLOAD

constexpr size_t WS_BAR = 768 * 1024;
#define XB_TMO      128
#define XB_XCNT(j)  (256  + 64 * (j))
#define XB_XSUB(j)  (1280 + 64 * (j))
#define XB_XGEN(j)  (2304 + 64 * (j))
#define XB_TOP      3328
#define XB_TOPGEN   3392
#define XCD_BAR_WORDS 3456
#define XB_SPIN_CAP (1u << 22)
__device__ __forceinline__ unsigned xb_ld(unsigned* p)              { return __hip_atomic_load(p, __ATOMIC_RELAXED, __HIP_MEMORY_SCOPE_AGENT); }
__device__ __forceinline__ unsigned xb_add(unsigned* p, unsigned v) { return __hip_atomic_fetch_add(p, v, __ATOMIC_RELAXED, __HIP_MEMORY_SCOPE_AGENT); }
__device__ __forceinline__ unsigned xb_xcc_id() { return (unsigned)__builtin_amdgcn_s_getreg((3 << 11) | 20) & 0xFu; }
#define XB_SPIN(cond, bar) do { unsigned _sp = 0; while (cond) { __builtin_amdgcn_s_sleep(1); \
    if ((++_sp & 255u) == 0u) { if (xb_ld(&(bar)[XB_TMO])) break; if (_sp > XB_SPIN_CAP) { atomicAdd(&(bar)[XB_TMO], 1u); break; } } } } while (0)
struct XcdBarrier { unsigned* bar; unsigned x; volatile LAS unsigned* st; };
__device__ __forceinline__ void xcd_barrier_complete(unsigned* bar, unsigned x, unsigned& nloc, unsigned& nx) {
    const unsigned G = gridDim.x * gridDim.y * gridDim.z;
    unsigned sum, cnt, mine, sp = 0u;
    for (;;) {
        sum = 0u; cnt = 0u; mine = 0u;
#pragma unroll
        for (unsigned j = 0; j < 16; ++j) { const unsigned c = xb_ld(&bar[XB_XCNT(j)]); sum += c; cnt += (c > 0u) ? 1u : 0u; mine = (j == x) ? c : mine; }
        if (sum == G) break;
        __builtin_amdgcn_s_sleep(1);
        if ((++sp & 255u) == 0u) { if (xb_ld(&bar[XB_TMO])) break; if (sp > XB_SPIN_CAP) { atomicAdd(&bar[XB_TMO], 1u); break; } }
    }
    nloc = mine > 0u ? mine : 1u; nx = cnt > 0u ? cnt : 1u;
}
__device__ __forceinline__ void xcd_barrier(const XcdBarrier& b) {
    asm volatile("s_waitcnt vmcnt(0)" ::: "memory");
    __syncthreads();
    if (threadIdx.x == 0) {
        unsigned* bar = b.bar;
        __builtin_amdgcn_s_waitcnt(0);
        unsigned nloc = b.st[0], nx = b.st[1];
        if (nloc == 0u) { xcd_barrier_complete(bar, b.x, nloc, nx); b.st[0] = nloc; b.st[1] = nx; }
        const unsigned old = xb_add(&bar[XB_XSUB(b.x)], 1u);
        const unsigned gen = old / nloc;
        if (old + 1u == (gen + 1u) * nloc) {
            __builtin_amdgcn_fence(__ATOMIC_RELEASE, "agent");
            asm volatile("s_waitcnt vmcnt(0)" ::: "memory");
            const unsigned og = xb_add(&bar[XB_TOP], 1u);
            const unsigned tg = og / nx;
            if (og + 1u == (tg + 1u) * nx) xb_add(&bar[XB_TOPGEN], 1u);
            else XB_SPIN(xb_ld(&bar[XB_TOPGEN]) == tg, bar);
            __builtin_amdgcn_fence(__ATOMIC_ACQUIRE, "agent");
            xb_add(&bar[XB_XGEN(b.x)], 1u);
            asm volatile("s_waitcnt vmcnt(0)" ::: "memory");
        } else {
            XB_SPIN(xb_ld(&bar[XB_XGEN(b.x)]) == gen, bar);
            __builtin_amdgcn_fence(__ATOMIC_ACQUIRE, "agent");
            asm volatile("s_waitcnt vmcnt(0)" ::: "memory");
        }
    }
    __syncthreads();
}

constexpr int NPHASES = 27;
#ifndef PH_MASK
#define PH_MASK 0xFFFFFF
#endif
#ifndef DUP_MASK
#define DUP_MASK 0
#endif
#ifndef TIME_MASK
#define TIME_MASK 0
#endif
__device__ __forceinline__ int opaque_s(int x) { asm volatile("" : "+s"(x)); return x; }
#define PHM(bit, call) do { if constexpr ((PH_MASK & (bit)) != 0) { if constexpr ((DUP_MASK & (bit)) != 0) { const int _nrep = opaque_s(2); for (int _rep = 0; _rep < _nrep; ++_rep) { call; __syncthreads(); } } else { call; } } } while (0)
__global__ void __launch_bounds__(NTHREADS, 2) trunk_fwd(Args A) {
    extern __shared__ __attribute__((aligned(16))) unsigned char lds_raw[];
    LAS unsigned char* lds = (LAS unsigned char*)lds_raw;
    const int tid0 = threadIdx.x, wid = __builtin_amdgcn_readfirstlane(tid0 >> 6);
    const int G = gridDim.x, bx = blockIdx.x, vcu = (G % 8 == 0) ? (bx % 8) * (G / 8) + bx / 8 : bx;
    const int gw = vcu * 8 + wid, NGW = G * 8;
    const int ph_lo = A.ph_lo, ph_hi = A.ph_hi;
    unsigned long long t_acc = 0;
#if MK_ONE_LAUNCH
    if (tid0 < 2) ((volatile LAS unsigned*)(lds + LDS_XB_OFF))[tid0] = 0u;
    if (bx == 0) { unsigned* b0 = (unsigned*)(A.ws + WS_BAR); for (int i = tid0; i < XCD_BAR_WORDS; i += NTHREADS) b0[i] = 0u; }
#endif

    for (int ph = ph_lo; ph < ph_hi; ++ph) {
        const int tid = opaque(tid0), lane = tid & 63;
        ArgP Ap = (ArgP)__builtin_amdgcn_kernarg_segment_ptr();
        asm volatile("" : "+s"(Ap));
        unsigned char* ws = Ap->ws;
        bf16_t* Hb = (bf16_t*)(ws + WS_H);
        unsigned char* mixb = ws + WS_MIX;
        const float* mod = (const float*)(ws + WS_MOD);
        float* xo = Ap->out;
        int layer, step;
        if (ph < 2) { layer = -1; step = ph; }
        else if (ph < 9) { layer = 0; step = ph - 2; }
        else if (ph < 15) { layer = 1; step = ph - 9 + 1; }
        else if (ph < 21) { layer = 2; step = ph - 15 + 1; }
        else { layer = 3; step = ph - 21 + 1; }
        const int kind = layer % 3, jl = layer / 3;
        unsigned long long t_ph0 = 0; if constexpr (TIME_MASK != 0) t_ph0 = __builtin_amdgcn_s_memrealtime();
        const int nmix = 4;
        int ptype = 0;
        if (layer < 0) ptype = 1; else if (layer > 3) ptype = 2048; else if (step == 0 || step == nmix) ptype = 2;
        else if (step < nmix) ptype = (step == 1) ? 4 : (step == nmix - 1) ? 32 : (kind == 0 && step == 3) ? 16 : 8;
        else ptype = 64 << (step - nmix - 1);
        const float* macc = mod + (size_t)(layer < 0 ? 0 : (layer > 3 ? 3 : layer)) * BATCH * 6 * DM;
        const float* mbias = Ap->in[I_ADA_B] + (size_t)(layer < 0 ? 0 : (layer > 3 ? 3 : layer)) * 6 * DM;
        const float* xin = (layer == 0) ? Ap->in[I_X] : xo;

        if (layer < 0) {
            if (step == 0) { PHM(1, prologue_phase(Ap, lds, vcu, G, tid, wid, lane)); }
            else { PHM(1, modreduce_phase(Ap, vcu, G, tid));
#pragma unroll 1
                for (int pl = 0; pl < 2; ++pl) { pg8::StaticOrder S; pg8::Gemm g{(const bf16_t*)(ws + WS_POOL_WOUT) + (size_t)pl * DM * DM, (const bf16_t*)(ws + WS_WGS) + (size_t)pl * 4 * 65536, DM, DM, 256, DM, 256, 256}; S.init(DM, DM, G, bx);
                    pg8::EpiBf16<0> E{(bf16_t*)(ws + WS_WEFF) + (size_t)pl * DM * DM, DM}; PHM(0x2000, pg8::gemm_phase(lds, g, S, E)); } }
        } else if (layer > 3) {
            PHM(256, final_phase(xo, Ap->in[I_FINAL_G], gw, NGW, lane));
        } else if (step == 0) {
            PHM(2, norm_phase(xin, Ap->in[I_NORM_G] + (size_t)(layer * 2 + 0) * DM, macc, mbias, 0, DM, Hb, gw, NGW, lane));
        } else if (step < nmix) {
            pg8::StaticOrder S;
            if (kind == 0) {
                bf16_t* U = (bf16_t*)mixb; bf16_t* P = (bf16_t*)(mixb + 64 * MiB); bf16_t* Z = (bf16_t*)(mixb + 128 * MiB);
                if (step == 1) { pg8::Gemm g{Hb, (const bf16_t*)(ws + WS_POOL_WIN) + (size_t)jl * DM * DM, MTOK, DM, DM, DM, DM, 0}; S.init(MTOK, DM, G, bx);
                    pg8::EpiBf16<0> E{U, DM}; PHM(0x1000, pg8::gemm_phase(lds, g, S, E)); }
                else if (step == 2) { PHM(8, pool_elem_phase(U, P, vcu, G, tid)); }
                else { pg8::Gemm g{P, (const bf16_t*)(ws + WS_WEFF) + (size_t)jl * DM * DM, MTOK, DM, DM, DM, DM, 0}; S.init(MTOK, DM, G, bx);
                    pg8::EpiBf16<0> E{(bf16_t*)(mixb + 192 * MiB), DM}; PHM(0x8000, pg8::gemm_phase(lds, g, S, E));   }
            } else if (kind == 1) {
                bf16_t* BG = (bf16_t*)mixb; bf16_t* Z = (bf16_t*)(mixb + 64 * MiB); bf16_t* AA = (bf16_t*)(mixb + 128 * MiB);
                if (step == 1) { pg8::Gemm g{Hb, (const bf16_t*)(ws + WS_CONV_WIN), MTOK, 3 * DM, DM, DM, DM, 0}; S.init(MTOK, 3 * DM, G, bx);
                    pg8::EpiConvIn E{BG, Z}; PHM(0x4000, pg8::gemm_phase(lds, g, S, E)); }
                else if (step == 2) { PHM(16, conv_elem_phase(BG, Z, Ap->in[I_CONV_W], AA, vcu, G, tid)); }
                else { pg8::Gemm g{AA, (const bf16_t*)(ws + WS_CONV_WOUT), MTOK, DM, DM, DM, DM, 0}; S.init(MTOK, DM, G, bx);
                    pg8::EpiBf16<0> E{(bf16_t*)(mixb + 192 * MiB), DM}; PHM(0x8000, pg8::gemm_phase(lds, g, S, E));   }
            } else {
                bf16_t* UA = (bf16_t*)mixb; bf16_t* VT = (bf16_t*)(mixb + 192 * MiB);
                if (step == 1) {
                    { pg8::Gemm g{Hb, (const bf16_t*)(ws + WS_GMLP_WIN), MTOK, GH, DM, DM, DM, 0}; S.init(MTOK, GH, G, bx);
                      pg8::EpiBf16<1> E{UA, GH}; PHM(0x1000, pg8::gemm_phase(lds, g, S, E)); }
                    { pg8::Gemm g{Hb, (const bf16_t*)(ws + WS_GMLP_WIN) + (size_t)GH * DM, MTOK, GH, DM, DM, DM, 0}; S.init(MTOK, GH, G, bx);
                      pg8::EpiGmlpV E{VT}; PHM(0x10000, pg8::gemm_phase(lds, g, S, E)); }
                }
                else if (step == 2) { PHM(32, mix_phase(lds, UA, VT, Ap->in[I_GMLP_WS], Ap->in[I_GMLP_BS], Ap->in[I_GMLP_LNG], Ap->in[I_GMLP_LNB], vcu, G, tid, wid, lane)); }
                else { pg8::Gemm g{UA, (const bf16_t*)(ws + WS_GMLP_WOUT), MTOK, DM, GH, GH, GH, 0}; S.init(MTOK, DM, G, bx);
                    pg8::EpiBf16<0> E{(bf16_t*)(mixb + 192 * MiB), DM}; PHM(0x8000, pg8::gemm_phase(lds, g, S, E));   }
            }
        } else {
            const int ps = step - nmix;
            bf16_t* Qb = (bf16_t*)mixb;
            bf16_t* xs = (layer == 3) ? (bf16_t*)(mixb + 192 * MiB) : (bf16_t*)xo;
            if (ps == 0) { resnorm_phase(layer == 0 ? Ap->in[I_X] : nullptr, (const bf16_t*)xo, xs, (const bf16_t*)(mixb + 192 * MiB), macc + 2 * DM, Ap->in[I_NORM_G] + (size_t)(layer * 2 + 1) * DM, macc, 3 * DM, 4 * DM, Hb, mixb + 128 * MiB, gw, NGW, lane); }
            else if (ps == 1) { pg8::StaticOrder S; pg8::Gemm g{Hb, (const bf16_t*)(ws + WS_PEER_WQ) + (size_t)layer * DM * 2048, MTOK, 2048, DM, DM, DM, 0}; S.init(MTOK, 2048, G, bx);
                pg8::EpiQT E{Qb}; PHM(0x1000, pg8::gemm_phase(lds, g, S, E));
                asm volatile("s_waitcnt vmcnt(0)" ::: "memory"); __syncthreads();
                PHM(64, topk_units(lds, Qb, (const bf16_t*)(ws + WS_KEYS) + (size_t)layer * 16 * 128 * 128, (int*)(ws + WS_SELI), (float*)(ws + WS_SELW), S, tid, wid, lane)); }
            else { PHM(128, peer_gather_phase(lds, mixb + 128 * MiB  , (cbytes)(ws + WS_TABU) + (size_t)layer * NEXP * (DM / 2), (cbytes)(ws + WS_TABV) + (size_t)layer * NEXP * DM, (const int*)(ws + WS_SELI), (const float*)(ws + WS_SELW),
                              (const unsigned*)(ws + WS_SCU) + (size_t)layer * NEXP, xs, xo, macc + 5 * DM,
                              layer == 3 ? Ap->in[I_FINAL_G] : Ap->in[I_NORM_G] + (size_t)((layer + 1) * 2) * DM, mod + (size_t)(layer == 3 ? 3 : layer + 1) * BATCH * 6 * DM, Hb, layer == 3, vcu, G, wid, lane)); }
        }
#if MK_ONE_LAUNCH
        if constexpr (TIME_MASK != 0) if (ph + 1 >= ph_hi) { if (ptype & TIME_MASK) t_acc += __builtin_amdgcn_s_memrealtime() - t_ph0; }
        if (ph + 1 < ph_hi) {
            XcdBarrier xbar; xbar.bar = (unsigned*)(Ap->ws + WS_BAR); xbar.x = xb_xcc_id(); xbar.st = (volatile LAS unsigned*)(lds + LDS_XB_OFF);
            if (ph == ph_lo) { cg::this_grid().sync(); if (tid0 == 0) (void)xb_add(&xbar.bar[XB_XCNT(xbar.x)], 1u); }
            else { xcd_barrier(xbar); if constexpr ((DUP_MASK & 0x800) != 0) xcd_barrier(xbar); }
            if constexpr (TIME_MASK != 0) { if (ptype & TIME_MASK) t_acc += __builtin_amdgcn_s_memrealtime() - t_ph0; }
        }
#endif
    }
    if constexpr (TIME_MASK != 0) { const unsigned long long t0 = __builtin_amdgcn_s_memrealtime(); while (__builtin_amdgcn_s_memrealtime() - t0 < 4ull * t_acc) __builtin_amdgcn_s_sleep(8); }
}

extern "C" void kernel_launch(void* const* d_in, const int* in_sizes, int n_in, void* d_out, int out_size, void* d_ws, size_t ws_size, hipStream_t stream) {
    static int grid = 0;
    if (grid == 0) {
        if (n_in != 23 || in_sizes[0] != MTOK * DM || out_size != MTOK * DM || ws_size < WS_END) {
            fprintf(stderr, "kernel_launch: unexpected shapes (n_in %d, in0 %d, out %d, ws %zu; need ws >= %zu); nothing launched\n", n_in, n_in > 0 ? in_sizes[0] : -1, out_size, ws_size, (size_t)WS_END); grid = -1; return; }
        int dev = 0, cus = 0, per_cu = 0;
        if (hipGetDevice(&dev) != hipSuccess || hipDeviceGetAttribute(&cus, hipDeviceAttributeMultiprocessorCount, dev) != hipSuccess) { grid = -1; return; }
        if (hipFuncSetAttribute((const void*)trunk_fwd, hipFuncAttributeMaxDynamicSharedMemorySize, LDS_BYTES) != hipSuccess) { fprintf(stderr, "kernel_launch: hipFuncSetAttribute failed\n"); grid = -1; return; }
        if (hipOccupancyMaxActiveBlocksPerMultiprocessor(&per_cu, (const void*)trunk_fwd, NTHREADS, LDS_BYTES) != hipSuccess || per_cu < 1) { fprintf(stderr, "kernel_launch: occupancy query says %d blocks per CU\n", per_cu); (void)hipGetLastError(); grid = -1; return; }
        grid = cus * (per_cu < 1 ? 1 : 1);
    }
    if (grid < 0) return;
    Args a{};
    for (int i = 0; i < 23; ++i) a.in[i] = (const float*)d_in[i];
    a.out = (float*)d_out; a.ws = (unsigned char*)d_ws;
#if MK_ONE_LAUNCH
    a.ph_lo = 0; a.ph_hi = NPHASES;
    void* args[] = {&a};
    hipError_t e = hipLaunchCooperativeKernel((const void*)trunk_fwd, dim3(grid), dim3(NTHREADS), args, LDS_BYTES, stream);
    if (e != hipSuccess) fprintf(stderr, "cooperative launch failed: %s (grid %d)\n", hipGetErrorString(e), grid);
#else
    for (int ph = 0; ph < NPHASES; ++ph) { a.ph_lo = ph; a.ph_hi = ph + 1; hipLaunchKernelGGL(trunk_fwd, dim3(grid), dim3(NTHREADS), LDS_BYTES, stream, a); }
#endif
}
```

```cpp
#include <hip/hip_runtime.h>
#include <hip/hip_cooperative_groups.h>
#include <cstdio>
#include <cstdint>
namespace cg = cooperative_groups;

#ifndef MK_ONE_LAUNCH
#define MK_ONE_LAUNCH 1
#endif

#define LAS __attribute__((address_space(3)))
typedef unsigned short bf16_t;
typedef short bf16x8 __attribute__((ext_vector_type(8)));
typedef float f32x2 __attribute__((ext_vector_type(2)));
typedef float f32x4 __attribute__((ext_vector_type(4)));
typedef float f32x16 __attribute__((ext_vector_type(16)));
typedef unsigned u32x2 __attribute__((ext_vector_type(2)));
typedef unsigned u32x4 __attribute__((ext_vector_type(4)));
typedef int i32x4 __attribute__((ext_vector_type(4)));
typedef int i32x8 __attribute__((ext_vector_type(8)));
typedef __bf16 bf16x2 __attribute__((ext_vector_type(2)));

constexpr int DM = 1024, BATCH = 8, SEQ = 4096, MTOK = BATCH * SEQ, DEPTH = 4;
constexpr int GH = 3072;
constexpr int NEXP = 16384, NPICK = 128;
constexpr float EPS = 1e-6f;

constexpr size_t MiB = 1u << 20;
constexpr size_t WS_CTL = 0, WS_SCU = 0, WS_SCV = 512 * 1024, WS_MOD = 1 * MiB, ZERO_BYTES = 2 * MiB;
constexpr size_t WS_POOL_WIN = 2 * MiB, WS_POOL_WGRP = 6 * MiB, WS_POOL_WOUT = 7 * MiB;
constexpr size_t WS_CONV_WIN = 11 * MiB, WS_CONV_WOUT = 17 * MiB;
constexpr size_t WS_GMLP_WIN = 19 * MiB, WS_GMLP_WOUT = 31 * MiB;
constexpr size_t WS_PEER_WQ = 37 * MiB, WS_KEYS = 53 * MiB;
constexpr size_t WS_H = 56 * MiB;
constexpr size_t WS_SELI = 120 * MiB, WS_SELW = 136 * MiB;
constexpr size_t WS_TABU = 152 * MiB, WS_TABV = 280 * MiB;
constexpr size_t WS_MIX = 408 * MiB;
constexpr size_t WS_ADAP = 792 * MiB;
constexpr size_t WS_COEF = 804 * MiB;
constexpr size_t WS_WEFF = 820 * MiB;
constexpr size_t WS_WGS = 824 * MiB;
constexpr size_t WS_END = 825 * MiB;

__device__ __forceinline__ unsigned cvt_pk_bf16(float lo, float hi) { unsigned r; asm volatile("v_cvt_pk_bf16_f32 %0, %1, %2" : "=v"(r) : "v"(lo), "v"(hi)); return r; }
__device__ __forceinline__ int opaque(int x) { asm volatile("" : "+v"(x)); return x; }
__device__ __forceinline__ float bf_lo(unsigned w) { return __uint_as_float(w << 16); }
__device__ __forceinline__ float bf_hi(unsigned w) { return __uint_as_float(w & 0xffff0000u); }
__device__ __forceinline__ float gelu_tanh(float x) {
    const float y = x * (1.0f + 0.044715f * x * x);
    const float e = __builtin_amdgcn_exp2f(-2.302208198f * y);
    return x * __builtin_amdgcn_rcpf(1.0f + e);
}
__device__ __forceinline__ float wave_sum_all(float v) {
#pragma unroll
    for (int o = 1; o < 64; o <<= 1) v += __shfl_xor(v, o);
    return v;
}
__device__ __forceinline__ float dot2_bf16(unsigned w, unsigned x, float acc) { return __builtin_amdgcn_fdot2_f32_bf16(__builtin_bit_cast(bf16x2, w), __builtin_bit_cast(bf16x2, x), acc, false); }


__device__ __forceinline__ float dpp_row_shr(float v, int n) {
    const int iv = __builtin_bit_cast(int, v); int r;
    switch (n) { case 1: r = __builtin_amdgcn_update_dpp(0, iv, 0x111, 0xf, 0xf, true); break; case 2: r = __builtin_amdgcn_update_dpp(0, iv, 0x112, 0xf, 0xf, true); break;
                 case 4: r = __builtin_amdgcn_update_dpp(0, iv, 0x114, 0xf, 0xf, true); break; default: r = __builtin_amdgcn_update_dpp(0, iv, 0x118, 0xf, 0xf, true); break; }
    return __builtin_bit_cast(float, r);
}
__device__ __forceinline__ float wave_sum_uniform(float v) {
    v += dpp_row_shr(v, 1); v += dpp_row_shr(v, 2); v += dpp_row_shr(v, 4); v += dpp_row_shr(v, 8);
    v += __builtin_bit_cast(float, __builtin_amdgcn_update_dpp(0, __builtin_bit_cast(int, v), 0x142, 0xa, 0xf, false));
    v += __builtin_bit_cast(float, __builtin_amdgcn_update_dpp(0, __builtin_bit_cast(int, v), 0x143, 0xc, 0xf, false));
    return __uint_as_float(__builtin_amdgcn_readlane(__float_as_uint(v), 63));
}

namespace pg8 {
constexpr int BM = 256, BK = 64, HALF = 128, HTB = HALF * BK * 2, STAGE_BYTES = 8 * HTB, NXCD = 8, WGM = 8;
__device__ __forceinline__ int lds_byte(int r, int c) { const int st = (r >> 4) * 2 + (c >> 5), rr = r & 15, cc = c & 31, ob = rr * 64 + cc * 2; return st * 1024 + (ob ^ (((ob >> 9) & 1) << 5)); }
__device__ __forceinline__ void stage_rc(int b, int& R, int& C) { const int st = b / 1024, sb = b % 1024, swz = sb ^ (((sb >> 9) & 1) << 5); R = (st >> 1) * 16 + swz / 64; C = (st & 1) * 32 + (swz % 64) / 2; }
__device__ __forceinline__ int perm32(int rho) { const int n = rho >> 4, i = rho & 15; return 8 * (i >> 2) + 4 * n + (i & 3); }

struct Unit { int pm, pn; };
struct Gemm { const bf16_t* A; const bf16_t* Bt; int M, N, K, lda, ldb, a_pn_off; };

struct StaticOrder {
    int nM, nN, nwg, G, c;
    __device__ __forceinline__ void init(int M, int N, int G_, int c_) { nM = M / BM; nN = N / BM; nwg = nM * nN; G = G_; c = c_; }
    __device__ __forceinline__ bool next(int i, Unit& u) const {
        const int L = i * G + c; if (L >= nwg) return false;
        int wgid = L; { const int q = nwg / NXCD, r = nwg % NXCD, xcd = wgid % NXCD, off = wgid / NXCD; wgid = (xcd < r ? xcd * (q + 1) : r * (q + 1) + (xcd - r) * q) + off; }
        const int nig = WGM * nN, gid = wgid / nig, fm = gid * WGM, gsz = (nM - fm) < WGM ? (nM - fm) : WGM;
        u.pm = fm + ((wgid % nig) % gsz); u.pn = (wgid % nig) / gsz; return true;
    }
};

template <class Epi>
__device__ __forceinline__ void gemm_phase(LAS unsigned char* lds, const Gemm g, const StaticOrder& S, const Epi& E) {
    const int tid = opaque((int)threadIdx.x), wid = __builtin_amdgcn_readfirstlane(tid >> 6), lane = tid & 63, wr = wid >> 2, wc = wid & 3, fr = lane & 15, fq = lane >> 4;
    int nt = g.K / BK; asm volatile("" : "+s"(nt));
    unsigned voffA[2], voffB[2];
#pragma unroll
    for (int i = 0; i < 2; ++i) { int R, C; stage_rc(tid * 16 + i * 8192, R, C); const int Rb = Epi::PERM ? ((R & ~31) + perm32(R & 31)) : R;
        voffA[i] = (unsigned)(R * g.lda + C) * 2u; voffB[i] = (unsigned)(Rb * g.ldb + C) * 2u; }
    const size_t kstep = (size_t)(BK * 2);
    const size_t hstepA = (size_t)HALF * g.lda * 2, hstepB = (size_t)HALF * g.ldb * 2;
    const size_t tstepA = 2 * hstepA, tstepB = 2 * hstepB;
    const unsigned ldsw = (unsigned)wid * 1024u;
    const int aoff = lds_byte(wr * 64 + fr, fq * 8), boff = lds_byte(wc * 32 + fr, fq * 8);
#define PG8_SA(b, h) (((b) * 2 + (h)) * HTB)
#define PG8_SB(b, h) ((4 + (b) * 2 + (h)) * HTB)
#define PG8_STAGE(bufoff, gbase, voff) do { _Pragma("unroll") for (int _i = 0; _i < 2; ++_i) \
        __builtin_amdgcn_global_load_lds((const unsigned*)((const char*)(gbase) + (voff)[_i]), (LAS unsigned*)(lds + (bufoff) + ldsw + _i * 8192), 16, 0, 0); } while (0)
#define PG8_LDA(dst, b, h) do { _Pragma("unroll") for (int m = 0; m < 4; ++m) _Pragma("unroll") for (int k = 0; k < 2; ++k) dst[m][k] = *(const LAS bf16x8*)(lds + PG8_SA(b, h) + aoff + m * 2048 + k * 1024); } while (0)
#define PG8_LDB(dst, b, h) do { _Pragma("unroll") for (int n = 0; n < 2; ++n) _Pragma("unroll") for (int k = 0; k < 2; ++k) dst[n][k] = *(const LAS bf16x8*)(lds + PG8_SB(b, h) + boff + n * 2048 + k * 1024); } while (0)
#define PG8_MMA(ai, bj, At, Bt) do { __builtin_amdgcn_s_setprio(1); _Pragma("unroll") for (int m = 0; m < 4; ++m) _Pragma("unroll") for (int n = 0; n < 2; ++n) _Pragma("unroll") for (int k = 0; k < 2; ++k) \
        acc[ai][bj][m][n] = Epi::SWAP ? __builtin_amdgcn_mfma_f32_16x16x32_bf16(At[m][k], Bt[n][k], acc[ai][bj][m][n], 0, 0, 0) \
                                      : __builtin_amdgcn_mfma_f32_16x16x32_bf16(Bt[n][k], At[m][k], acc[ai][bj][m][n], 0, 0, 0); __builtin_amdgcn_s_setprio(0); } while (0)
#define PG8_WAIT_V(n) asm volatile("s_waitcnt vmcnt(" #n ")" ::: "memory")
#define PG8_WAIT_L(n) asm volatile("s_waitcnt lgkmcnt(" #n ")" ::: "memory")
#define PG8_BAR __builtin_amdgcn_s_barrier()
#define PG8_SCHED __builtin_amdgcn_sched_barrier(0)
    Unit cur, nxt; int ui = 0;
    if (!S.next(0, cur)) return;
    f32x4 acc[2][2][4][2];
#pragma unroll
    for (int a = 0; a < 2; ++a)
#pragma unroll
        for (int b = 0; b < 2; ++b)
#pragma unroll
            for (int m = 0; m < 4; ++m)
#pragma unroll
                for (int n = 0; n < 2; ++n) acc[a][b][m][n] = (f32x4){0.f, 0.f, 0.f, 0.f};
    bf16x8 At[4][2], B0[2][2], B1[2][2];
    const char* cA = (const char*)g.A + (size_t)cur.pm * tstepA + (size_t)cur.pn * g.a_pn_off * 2; const char* cB = (const char*)g.Bt + (size_t)cur.pn * tstepB;
    PG8_STAGE(PG8_SB(0, 0), cB, voffB); PG8_STAGE(PG8_SB(0, 1), cB + hstepB, voffB); PG8_STAGE(PG8_SA(0, 0), cA, voffA); PG8_STAGE(PG8_SA(0, 1), cA + hstepA, voffA);
    if (wr == 1) PG8_BAR;
    PG8_WAIT_V(2); PG8_BAR;
    PG8_STAGE(PG8_SB(1, 0), cB + kstep, voffB); PG8_STAGE(PG8_SA(1, 0), cA + kstep, voffA); PG8_STAGE(PG8_SB(1, 1), cB + hstepB + kstep, voffB);
    PG8_WAIT_V(6); PG8_BAR;
    for (;;) {
        const bool has_next = S.next(ui + 1, nxt);
        const char* nA = has_next ? (const char*)g.A + (size_t)nxt.pm * tstepA + (size_t)nxt.pn * g.a_pn_off * 2 : cA; const char* nB = has_next ? (const char*)g.Bt + (size_t)nxt.pn * tstepB : cB;
        for (int t = 0; t < nt; t += 2) {
            const bool last = (t == nt - 2);
            const char* a1 = cA + (size_t)(t + 1) * kstep;
            const char* a2 = last ? nA : cA + (size_t)(t + 2) * kstep; const char* b2 = last ? nB : cB + (size_t)(t + 2) * kstep;
            const char* a3 = a2 + kstep; const char* b3 = b2 + kstep;
            PG8_LDB(B0, 0, 0); PG8_LDB(B1, 0, 1); PG8_SCHED; PG8_LDA(At, 0, 0); PG8_STAGE(PG8_SA(1, 1), a1 + hstepA, voffA);
            PG8_WAIT_V(8); PG8_WAIT_L(0); PG8_BAR; PG8_MMA(0, 0, At, B0); PG8_MMA(0, 1, At, B1); PG8_BAR; PG8_SCHED;
            PG8_LDA(At, 0, 1); PG8_STAGE(PG8_SB(0, 0), b2, voffB); PG8_STAGE(PG8_SB(0, 1), b2 + hstepB, voffB); PG8_STAGE(PG8_SA(0, 0), a2, voffA);
            PG8_WAIT_V(8); PG8_WAIT_L(0); PG8_BAR; PG8_MMA(1, 0, At, B0); PG8_MMA(1, 1, At, B1); PG8_BAR; PG8_SCHED;
            PG8_LDB(B0, 1, 0); PG8_LDB(B1, 1, 1); PG8_SCHED; PG8_LDA(At, 1, 0); PG8_STAGE(PG8_SA(0, 1), a2 + hstepA, voffA);
            PG8_WAIT_V(8); PG8_WAIT_L(0); PG8_BAR; PG8_MMA(0, 0, At, B0); PG8_MMA(0, 1, At, B1); PG8_BAR; PG8_SCHED;
            PG8_LDA(At, 1, 1); PG8_STAGE(PG8_SB(1, 0), b3, voffB); PG8_STAGE(PG8_SB(1, 1), b3 + hstepB, voffB); PG8_STAGE(PG8_SA(1, 0), a3, voffA);
            PG8_WAIT_V(8); PG8_WAIT_L(0); PG8_BAR; PG8_MMA(1, 0, At, B0); PG8_MMA(1, 1, At, B1); PG8_BAR; PG8_SCHED;
        }
        { const int l2 = opaque((int)threadIdx.x) & 63; E(acc, cur, wr, wc, l2 & 15, l2 >> 4); }
        if (!has_next) break;
#pragma unroll
        for (int a = 0; a < 2; ++a)
#pragma unroll
            for (int b = 0; b < 2; ++b)
#pragma unroll
                for (int m = 0; m < 4; ++m)
#pragma unroll
                    for (int n = 0; n < 2; ++n) acc[a][b][m][n] = (f32x4){0.f, 0.f, 0.f, 0.f};
        cur = nxt; cA = nA; cB = nB; ++ui;
    }
    PG8_WAIT_V(0);
    if (wr == 0) PG8_BAR;
    PG8_BAR;
#undef PG8_SA
#undef PG8_SB
#undef PG8_STAGE
#undef PG8_LDA
#undef PG8_LDB
#undef PG8_MMA
#undef PG8_WAIT_V
#undef PG8_WAIT_L
#undef PG8_BAR
#undef PG8_SCHED
}

template <int ACT> struct EpiBf16 {
    static constexpr bool PERM = true, SWAP = false;
    bf16_t* O; int ldc;
    __device__ __forceinline__ void operator()(const f32x4 (&acc)[2][2][4][2], const Unit& u, int wr, int wc, int fr, int fq) const {
        const int row0 = u.pm * BM + wr * 64 + fr, col0 = u.pn * BM + wc * 32 + 8 * fq;
#pragma unroll
        for (int ai = 0; ai < 2; ++ai)
#pragma unroll
            for (int m = 0; m < 4; ++m) { bf16_t* rowp = O + (size_t)(row0 + ai * HALF + m * 16) * ldc + col0;
#pragma unroll
                for (int bj = 0; bj < 2; ++bj) { f32x4 v0 = acc[ai][bj][m][0], v1 = acc[ai][bj][m][1];
                    if (ACT == 1) {
#pragma unroll
                        for (int j = 0; j < 4; ++j) { v0[j] = gelu_tanh(v0[j]); v1[j] = gelu_tanh(v1[j]); } }
                    u32x4 w; w.x = cvt_pk_bf16(v0[0], v0[1]); w.y = cvt_pk_bf16(v0[2], v0[3]); w.z = cvt_pk_bf16(v1[0], v1[1]); w.w = cvt_pk_bf16(v1[2], v1[3]);
                    *(u32x4*)(rowp + bj * HALF) = w; } }
    }
};
struct EpiQT {
    static constexpr bool PERM = true, SWAP = false;
    bf16_t* O;
    __device__ __forceinline__ void operator()(const f32x4 (&acc)[2][2][4][2], const Unit& u, int wr, int wc, int fr, int fq) const {
        const int row0 = u.pm * BM + wr * 64 + fr;
#pragma unroll
        for (int ai = 0; ai < 2; ++ai)
#pragma unroll
            for (int m = 0; m < 4; ++m) { const int row = row0 + ai * HALF + m * 16;
                bf16_t* base = O + ((size_t)((row >> 7) * 8 + u.pn) * 32 * 128 + (row & 127)) * 8;
#pragma unroll
                for (int bj = 0; bj < 2; ++bj) { const f32x4 v0 = acc[ai][bj][m][0], v1 = acc[ai][bj][m][1];
                    u32x4 w; w.x = cvt_pk_bf16(v0[0], v0[1]); w.y = cvt_pk_bf16(v0[2], v0[3]); w.z = cvt_pk_bf16(v1[0], v1[1]); w.w = cvt_pk_bf16(v1[2], v1[3]);
                    *(u32x4*)(base + (size_t)(16 * bj + 4 * wc + fq) * 128 * 8) = w; } }
    }
};
struct EpiPoolGrp {
    static constexpr bool PERM = true, SWAP = false;
    bf16_t* O; const float* scale;
    __device__ __forceinline__ void operator()(const f32x4 (&acc)[2][2][4][2], const Unit& u, int wr, int wc, int fr, int fq) const {
        const int row0 = u.pm * BM + wr * 64 + fr, col0 = u.pn * BM + wc * 32 + 8 * fq;
#pragma unroll
        for (int bj = 0; bj < 2; ++bj) {
            const f32x4 s0 = *(const f32x4*)(scale + col0 + bj * HALF), s1 = *(const f32x4*)(scale + col0 + bj * HALF + 4);
#pragma unroll
            for (int ai = 0; ai < 2; ++ai)
#pragma unroll
                for (int m = 0; m < 4; ++m) { bf16_t* rowp = O + (size_t)(row0 + ai * HALF + m * 16) * DM + col0 + bj * HALF;
                    const f32x4 v0 = acc[ai][bj][m][0] * s0, v1 = acc[ai][bj][m][1] * s1;
                    u32x4 w; w.x = cvt_pk_bf16(v0[0], v0[1]); w.y = cvt_pk_bf16(v0[2], v0[3]); w.z = cvt_pk_bf16(v1[0], v1[1]); w.w = cvt_pk_bf16(v1[2], v1[3]);
                    *(u32x4*)rowp = w; }
            asm volatile("" ::: "memory");
        }
    }
};
struct EpiConvIn {
    static constexpr bool PERM = true, SWAP = false;
    bf16_t* BG; bf16_t* Z;
    __device__ __forceinline__ void operator()(const f32x4 (&acc)[2][2][4][2], const Unit& u, int wr, int wc, int fr, int fq) const {
        const int row0 = u.pm * BM + wr * 64 + fr;
        if (u.pn < 4) {
            const int col0 = u.pn * BM + wc * 32 + 8 * fq;
#pragma unroll
            for (int ai = 0; ai < 2; ++ai)
#pragma unroll
                for (int m = 0; m < 4; ++m) { bf16_t* rowp = BG + (size_t)(row0 + ai * HALF + m * 16) * DM + col0;
#pragma unroll
                    for (int bj = 0; bj < 2; ++bj) { const f32x4 v0 = acc[ai][bj][m][0], v1 = acc[ai][bj][m][1];
                        u32x4 w; w.x = cvt_pk_bf16(v0[0], v0[1]); w.y = cvt_pk_bf16(v0[2], v0[3]); w.z = cvt_pk_bf16(v1[0], v1[1]); w.w = cvt_pk_bf16(v1[2], v1[3]);
                        *(u32x4*)(rowp + bj * HALF) = w; } }
        } else {
            const int col0 = (u.pn - 4) * HALF + wc * 32 + 8 * fq;
#pragma unroll
            for (int ai = 0; ai < 2; ++ai)
#pragma unroll
                for (int m = 0; m < 4; ++m) { bf16_t* rowp = Z + (size_t)(row0 + ai * HALF + m * 16) * DM + col0;
                    const f32x4 v0 = acc[ai][0][m][0] * acc[ai][1][m][0], v1 = acc[ai][0][m][1] * acc[ai][1][m][1];
                    u32x4 w; w.x = cvt_pk_bf16(v0[0], v0[1]); w.y = cvt_pk_bf16(v0[2], v0[3]); w.z = cvt_pk_bf16(v1[0], v1[1]); w.w = cvt_pk_bf16(v1[2], v1[3]);
                    *(u32x4*)rowp = w; }
        }
    }
};
struct EpiResid {
    static constexpr bool PERM = false, SWAP = false;
    const float* base; float* out; const float* gacc; const float* gbias;
    __device__ __forceinline__ void operator()(const f32x4 (&acc)[2][2][4][2], const Unit& u, int wr, int wc, int fr, int fq) const {
        const int row0 = u.pm * BM + wr * 64 + fr, col0 = u.pn * BM + wc * 32 + 4 * fq;
        const float* gp = gacc + (size_t)(u.pm >> 4) * (6 * DM);
#pragma unroll
        for (int bj = 0; bj < 2; ++bj)
#pragma unroll
            for (int n = 0; n < 2; ++n) { const int cc = col0 + bj * HALF + n * 16;
                const f32x4 gv = *(const f32x4*)(gp + cc);
#pragma unroll
                for (int ai = 0; ai < 2; ++ai) {
#pragma unroll
                    for (int m = 0; m < 4; ++m) { const size_t off = (size_t)(row0 + ai * HALF + m * 16) * DM + cc;
                        const f32x4 bs = *(const f32x4*)(base + off);
                        *(f32x4*)(out + off) = bs + gv * acc[ai][bj][m][n]; }
                    asm volatile("" ::: "memory"); } }
    }
};
struct EpiGmlpV {
    static constexpr bool PERM = false, SWAP = true;
    bf16_t* VT;
    __device__ __forceinline__ void operator()(const f32x4 (&acc)[2][2][4][2], const Unit& u, int wr, int wc, int fr, int fq) const {
        const int row0 = u.pm * BM + wr * 64 + 4 * fq, col0 = u.pn * BM + wc * 32 + fr;
#pragma unroll
        for (int bj = 0; bj < 2; ++bj)
#pragma unroll
            for (int n = 0; n < 2; ++n) { const int c = col0 + bj * HALF + n * 16;
#pragma unroll
                for (int ai = 0; ai < 2; ++ai)
#pragma unroll
                    for (int m = 0; m < 4; ++m) { const f32x4 v = acc[ai][bj][m][n]; const int r = row0 + ai * HALF + m * 16;
                        u32x2 w; w.x = cvt_pk_bf16(gelu_tanh(v[0]), gelu_tanh(v[1])); w.y = cvt_pk_bf16(gelu_tanh(v[2]), gelu_tanh(v[3]));
                        *(u32x2*)(VT + ((size_t)(r >> 7) * GH + c) * 128 + (r & 127)) = w; } }
    }
};
}

constexpr int RING_BYTES = 131072;
constexpr int LDS_BYTES = 147456;
constexpr int LDS_XB_OFF = LDS_BYTES - 64;
constexpr int NTHREADS = 512;

#define CE_DESC(a, b) do { const float _x = fmaxf(a, b), _y = fminf(a, b); a = _x; b = _y; } while (0)
#define CE_ASC(a, b)  do { const float _x = fminf(a, b), _y = fmaxf(a, b); a = _x; b = _y; } while (0)
template <int OFF, int N>
__device__ __forceinline__ void sort16_desc(float (&v)[N]) {
#pragma unroll
    for (int k = 2; k <= 16; k <<= 1)
#pragma unroll
        for (int j = k >> 1; j > 0; j >>= 1)
#pragma unroll
            for (int i = 0; i < 16; ++i) { const int l = i ^ j; if (l > i) { if ((i & k) == 0) CE_DESC(v[OFF + i], v[OFF + l]); else CE_ASC(v[OFF + i], v[OFF + l]); } }
}
template <int OFF, int N>
__device__ __forceinline__ void bmerge16_desc(float (&v)[N]) {
#pragma unroll
    for (int j = 8; j > 0; j >>= 1)
#pragma unroll
        for (int i = 0; i < 16; ++i) { const int l = i ^ j; if (l > i) CE_DESC(v[OFF + i], v[OFF + l]); }
}
template <int A, int B, int N>
__device__ __forceinline__ void merge_top16(float (&v)[N]) {
#pragma unroll
    for (int i = 0; i < 16; ++i) v[A + i] = fmaxf(v[A + i], v[B + 15 - i]);
    bmerge16_desc<A, N>(v);
}
__device__ __forceinline__ void top16_of_64(float (&v)[64]) {
    sort16_desc<0, 64>(v); sort16_desc<16, 64>(v); sort16_desc<32, 64>(v); sort16_desc<48, 64>(v);
    merge_top16<0, 16, 64>(v); merge_top16<32, 48, 64>(v); merge_top16<0, 32, 64>(v);
}

struct Args { const float* in[23]; float* out; unsigned char* ws; int ph_lo, ph_hi; };
typedef const __attribute__((address_space(4))) Args* ArgP;
enum { I_X = 0, I_C, I_ADA_W, I_ADA_B, I_NORM_G, I_POOL_WIN, I_POOL_WGRP, I_POOL_SCALE, I_POOL_WOUT, I_CONV_WIN, I_CONV_W, I_CONV_WOUT,
       I_GMLP_WIN, I_GMLP_LNG, I_GMLP_LNB, I_GMLP_WS, I_GMLP_BS, I_GMLP_WOUT, I_PEER_WQ, I_PEER_KEYS, I_PEER_U, I_PEER_V, I_FINAL_G };

__device__ __forceinline__ void transpose_item(const float* W, int K, int N, bf16_t* WT, int dst_row0, LAS float* scr, int k0, int n0, int lane) {
#pragma unroll 8
    for (int i = 0; i < 32; ++i) { const int kk = 2 * i + (lane >> 5); scr[kk * 33 + (lane & 31)] = W[(size_t)(k0 + kk) * N + n0 + (lane & 31)]; }
    asm volatile("s_waitcnt lgkmcnt(0)" ::: "memory");
    const int c = lane & 7;
#pragma unroll
    for (int j = 0; j < 4; ++j) { const int n = (lane >> 3) + 8 * j; const LAS float* s = scr + (8 * c) * 33 + n;
        u32x4 o; o.x = cvt_pk_bf16(s[0 * 33], s[1 * 33]); o.y = cvt_pk_bf16(s[2 * 33], s[3 * 33]); o.z = cvt_pk_bf16(s[4 * 33], s[5 * 33]); o.w = cvt_pk_bf16(s[6 * 33], s[7 * 33]);
        *(u32x4*)(WT + (size_t)(dst_row0 + n) * K + k0 + 8 * c) = o; }
    asm volatile("s_waitcnt lgkmcnt(0)" ::: "memory");
}
__device__ __forceinline__ void convert_stream(const float* src, bf16_t* dst, size_t n8, size_t gt, size_t stride) {
    for (size_t i = gt; i < n8; i += stride) {
        const f32x4 a = __builtin_nontemporal_load((const f32x4*)src + 2 * i), b = __builtin_nontemporal_load((const f32x4*)src + 2 * i + 1);
        u32x4 o; o.x = cvt_pk_bf16(a[0], a[1]); o.y = cvt_pk_bf16(a[2], a[3]); o.z = cvt_pk_bf16(b[0], b[1]); o.w = cvt_pk_bf16(b[2], b[3]);
        *((u32x4*)dst + i) = o; }
}
__device__ __forceinline__ unsigned e2m1_code(float a) { const float aa = fabsf(a);
    const unsigned c = (aa > 0.25f ? 1u : 0u) + (aa > 0.75f ? 1u : 0u) + (aa > 1.25f ? 1u : 0u) + (aa > 1.75f ? 1u : 0u) + (aa > 2.5f ? 1u : 0u) + (aa > 3.5f ? 1u : 0u) + (aa > 5.0f ? 1u : 0u);
    return c | ((__builtin_bit_cast(unsigned, a) >> 28) & 8u); }
__device__ __forceinline__ void prologue_phase(ArgP Ap, LAS unsigned char* lds, int vcu, int G, int tid, int wid, int lane) {
    unsigned char* ws = Ap->ws;
    const int gw = vcu * 8 + wid, NGW = G * 8;
    LAS float* scr = (LAS float*)(lds + wid * 16384);
    constexpr int NT_ITEMS = 1024 + 256 + 1024 + 1536 + 512 + 3072 + 1536 + 4096;
    for (int it = gw; it < NT_ITEMS; it += NGW) {
        int r = it; const float* src; bf16_t* dst; int K, N, kind = 0;
        if (r < 1024) { const int m = r >> 9; r &= 511; src = Ap->in[I_POOL_WIN] + (size_t)m * DM * DM; dst = (bf16_t*)(ws + WS_POOL_WIN) + (size_t)m * DM * DM; K = DM; N = DM; }
        else if ((r -= 1024) < 256) { const int m = r >> 5; r &= 31; src = Ap->in[I_POOL_WGRP] + (size_t)m * 65536; dst = (bf16_t*)(ws + WS_POOL_WGRP) + (size_t)m * 65536; K = 256; N = 256; }
        else if ((r -= 256) < 1024) { const int m = r >> 9; r &= 511; src = Ap->in[I_POOL_WOUT] + (size_t)m * DM * DM; dst = (bf16_t*)(ws + WS_POOL_WOUT) + (size_t)m * DM * DM; K = DM; N = DM; }
        else if ((r -= 1024) < 1536) { src = Ap->in[I_CONV_WIN]; dst = (bf16_t*)(ws + WS_CONV_WIN); K = DM; N = 3 * DM; kind = 1; }
        else if ((r -= 1536) < 512) { src = Ap->in[I_CONV_WOUT]; dst = (bf16_t*)(ws + WS_CONV_WOUT); K = DM; N = DM; }
        else if ((r -= 512) < 3072) { src = Ap->in[I_GMLP_WIN]; dst = (bf16_t*)(ws + WS_GMLP_WIN); K = DM; N = 2 * GH; }
        else if ((r -= 3072) < 1536) { src = Ap->in[I_GMLP_WOUT]; dst = (bf16_t*)(ws + WS_GMLP_WOUT); K = GH; N = DM; }
        else { r -= 1536; const int m = r >> 10; r &= 1023; src = Ap->in[I_PEER_WQ] + (size_t)m * DM * 2048; dst = (bf16_t*)(ws + WS_PEER_WQ) + (size_t)m * DM * 2048; K = DM; N = 2048; }
        const int nblk = N / 32, kb = r / nblk, nb = r % nblk, n0 = 32 * nb;
        int drow = n0;
        if (kind == 1 && n0 >= DM) { const int xt = n0 >= 2 * DM, ch = n0 - (xt ? 2 * DM : DM); drow = DM + 256 * (ch >> 7) + 128 * xt + (ch & 127); }
        transpose_item(src, K, N, dst, drow, scr, 64 * kb, n0, lane);
    }
    const size_t gt = (size_t)vcu * NTHREADS + tid, stride = (size_t)G * NTHREADS;
    convert_stream(Ap->in[I_PEER_KEYS], (bf16_t*)(ws + WS_KEYS), (size_t)DEPTH * 16 * 128 * 128 / 8, gt, stride);
    for (int row0 = gw * 4; row0 < 2 * DEPTH * NEXP; row0 += NGW * 4) {
        f32x4 v[4][4]; float m[4];
#pragma unroll
        for (int rr = 0; rr < 4; ++rr) { const int row = row0 + rr, tab = row >> 16, lrow = row & 65535;
            const f32x4* src = (const f32x4*)((tab ? Ap->in[I_PEER_V] : Ap->in[I_PEER_U]) + (size_t)lrow * DM) + lane;
#pragma unroll
            for (int j = 0; j < 4; ++j) v[rr][j] = __builtin_nontemporal_load(src + 64 * j); }
#pragma unroll
        for (int rr = 0; rr < 4; ++rr) { float mm = 0.f;
#pragma unroll
            for (int j = 0; j < 4; ++j) mm = fmaxf(fmaxf(mm, fmaxf(fabsf(v[rr][j][0]), fabsf(v[rr][j][1]))), fmaxf(fabsf(v[rr][j][2]), fabsf(v[rr][j][3])));
#pragma unroll
            for (int o = 1; o < 64; o <<= 1) mm = fmaxf(mm, __shfl_xor(mm, o));
            m[rr] = mm; }
#pragma unroll
        for (int rr = 0; rr < 4; ++rr) { const int row = row0 + rr, tab = row >> 16, lrow = row & 65535, l = lrow >> 14, e = lrow & (NEXP - 1);
            if (tab) {
                const float S = m[rr] > 0.f ? 256.0f / m[rr] : 1.0f;
#pragma unroll
                for (int j = 0; j < 4; ++j) { int pk = __builtin_amdgcn_cvt_pk_fp8_f32(v[rr][j][0] * S, v[rr][j][1] * S, 0, false); pk = __builtin_amdgcn_cvt_pk_fp8_f32(v[rr][j][2] * S, v[rr][j][3] * S, pk, true);
                    const int d0 = 256 * j + 4 * lane;
                    *(int*)(ws + WS_TABV + (((size_t)l * 8 + (d0 >> 7)) * NEXP + e) * 128 + (d0 & 127)) = pk; }
            } else {
                const float S = m[rr] > 0.f ? (6.0f / 0.9f) / m[rr] : 1.0f;
#pragma unroll
                for (int j = 0; j < 4; ++j) { unsigned pk = e2m1_code(v[rr][j][0] * S) | (e2m1_code(v[rr][j][1] * S) << 4) | (e2m1_code(v[rr][j][2] * S) << 8) | (e2m1_code(v[rr][j][3] * S) << 12);
                    pk |= (unsigned)__shfl_xor((int)pk, 1) << 16;
                    if (!(lane & 1)) *(unsigned*)(ws + WS_TABU + (((size_t)l * 4 + j) * NEXP + e) * 128 + 2 * lane) = pk; }
            }
            if (lane == 0) ((unsigned short*)(ws + WS_SCU))[2 * lrow + tab] = (unsigned short)(cvt_pk_bf16(m[rr] > 0.f ? m[rr] * (tab ? 1.0f / 256.0f : 0.9f / 6.0f) : 1.0f, 0.f) & 0xffffu); }
    }
    for (size_t i = gt; i < (size_t)2 * 4 * 256 * 256 / 8; i += stride) { const size_t idx = i * 8; const int l = (int)(idx >> 18), g = (int)(idx >> 16) & 3, j0 = (int)idx & 255;
        const f32x4 a = *((const f32x4*)Ap->in[I_POOL_WGRP] + 2 * i), b = *((const f32x4*)Ap->in[I_POOL_WGRP] + 2 * i + 1);
        const float* sp = Ap->in[I_POOL_SCALE] + (size_t)l * DM + 256 * g + j0; const f32x4 sa = *(const f32x4*)sp, sb = *(const f32x4*)(sp + 4);
        u32x4 o; o.x = cvt_pk_bf16(a[0] * sa[0], a[1] * sa[1]); o.y = cvt_pk_bf16(a[2] * sa[2], a[3] * sa[3]); o.z = cvt_pk_bf16(b[0] * sb[0], b[1] * sb[1]); o.w = cvt_pk_bf16(b[2] * sb[2], b[3] * sb[3]);
        *((u32x4*)(ws + WS_WGS) + i) = o; }
    __syncthreads();
    LAS float* cond = (LAS float*)lds;
    for (int i = tid; i < BATCH * DM; i += NTHREADS) { const int b = i >> 10, k = i & 1023; const float c = Ap->in[I_C][i]; cond[k * 8 + b] = c * __builtin_amdgcn_rcpf(1.0f + __expf(-c)); }
    __syncthreads();
    float* modp = (float*)(ws + WS_ADAP);
    for (int it = gw; it < DEPTH * 24 * 16; it += NGW) {
        const int l = it / 384, r = it % 384, cgp = r >> 4, kc = r & 15;
        const float* wp = Ap->in[I_ADA_W] + ((size_t)l * DM + kc * 64) * (6 * DM) + cgp * 256 + 4 * lane;
        f32x4 acc[8];
#pragma unroll
        for (int b = 0; b < 8; ++b) acc[b] = (f32x4){0.f, 0.f, 0.f, 0.f};
#pragma unroll 8
        for (int k = 0; k < 64; ++k) { const f32x4 w = __builtin_nontemporal_load((const f32x4*)(wp + (size_t)k * (6 * DM)));
            const f32x4 c0 = *(const LAS f32x4*)(cond + (kc * 64 + k) * 8), c1 = *(const LAS f32x4*)(cond + (kc * 64 + k) * 8 + 4);
            acc[0] += c0[0] * w; acc[1] += c0[1] * w; acc[2] += c0[2] * w; acc[3] += c0[3] * w; acc[4] += c1[0] * w; acc[5] += c1[1] * w; acc[6] += c1[2] * w; acc[7] += c1[3] * w; }
#pragma unroll
        for (int b = 0; b < 8; ++b) *(f32x4*)(modp + (((size_t)kc * DEPTH + l) * 8 + b) * (6 * DM) + cgp * 256 + 4 * lane) = acc[b];
    }
}
__device__ __forceinline__ void modreduce_phase(ArgP Ap, int vcu, int G, int tid) {
    unsigned char* ws = Ap->ws; const float* modp = (const float*)(ws + WS_ADAP); float* mod = (float*)(ws + WS_MOD);
    constexpr int N4 = DEPTH * BATCH * 6 * DM / 4;
    for (int i = vcu * NTHREADS + tid; i < N4; i += G * NTHREADS) {
        const int n4 = i % (6 * DM / 4), l = i / (BATCH * 6 * DM / 4);
        f32x4 a = *((const f32x4*)(Ap->in[I_ADA_B] + (size_t)l * 6 * DM) + n4);
#pragma unroll
        for (int kc = 0; kc < 16; ++kc) a += *((const f32x4*)modp + (size_t)kc * N4 + i);
        *((f32x4*)mod + i) = a; }
}

__device__ __forceinline__ void norm_phase(const float* x, const float* gn, const float* macc  , const float* mbias  , int sh_off, int sc_off, bf16_t* H, int gw, int NGW, int lane) {
    for (int ch = gw; ch < MTOK / 16; ch += NGW) {
        const int row0 = ch * 16, b = row0 >> 12;
        f32x4 c1[4], shv[4];
#pragma unroll
        for (int j = 0; j < 4; ++j) { const int col = 4 * lane + 256 * j;
            const f32x4 sc = *(const f32x4*)(macc + (size_t)b * 6 * DM + sc_off + col);
            c1[j] = *(const f32x4*)(gn + col) * (1.0f + sc);
            shv[j] = *(const f32x4*)(macc + (size_t)b * 6 * DM + sh_off + col); }
        for (int r = row0; r < row0 + 16; ++r) {
            const f32x4* xr = (const f32x4*)(x + (size_t)r * DM) + lane;
            f32x4 v[4]; float ss = 0.f;
#pragma unroll
            for (int j = 0; j < 4; ++j) { v[j] = xr[64 * j]; ss += (v[j][0] * v[j][0] + v[j][1] * v[j][1]) + (v[j][2] * v[j][2] + v[j][3] * v[j][3]); }
            const float rstd = __builtin_amdgcn_rsqf(wave_sum_all(ss) * (1.0f / DM) + EPS);
            u32x2* o8 = (u32x2*)(H + (size_t)r * DM) + lane;
#pragma unroll
            for (int j = 0; j < 4; ++j) { const f32x4 o = v[j] * rstd * c1[j] + shv[j]; u32x2 w; w.x = cvt_pk_bf16(o[0], o[1]); w.y = cvt_pk_bf16(o[2], o[3]); o8[64 * j] = w; }
        }
    }
}
__device__ __forceinline__ void resnorm_phase(const float* xf  , const bf16_t* xsi, bf16_t* xso  , const bf16_t* Y, const float* gate  , const float* gn, const float* macc, int sh_off, int sc_off, bf16_t* H, unsigned char* H8  , int gw, int NGW, int lane) {
    for (int ch = gw; ch < MTOK / 16; ch += NGW) {
        const int row0 = ch * 16, b = row0 >> 12;
        f32x4 c1[4], shv[4], gt[4];
#pragma unroll
        for (int j = 0; j < 4; ++j) { const int col = 4 * lane + 256 * j;
            const f32x4 sc = *(const f32x4*)(macc + (size_t)b * 6 * DM + sc_off + col);
            c1[j] = *(const f32x4*)(gn + col) * (1.0f + sc);
            shv[j] = *(const f32x4*)(macc + (size_t)b * 6 * DM + sh_off + col);
            gt[j] = *(const f32x4*)(gate + (size_t)b * 6 * DM + col); }
        for (int r = row0; r < row0 + 16; ++r) {
            const u32x2* yr = (const u32x2*)(Y + (size_t)r * DM) + lane;
            f32x4 v[4]; float ss = 0.f;
            if (xf) { const f32x4* xr = (const f32x4*)(xf + (size_t)r * DM) + lane;
#pragma unroll
                for (int j = 0; j < 4; ++j) v[j] = xr[64 * j]; }
            else { const u32x2* xr = (const u32x2*)(xsi + (size_t)r * DM) + lane;
#pragma unroll
                for (int j = 0; j < 4; ++j) { const u32x2 xv = xr[64 * j]; v[j] = (f32x4){bf_lo(xv.x), bf_hi(xv.x), bf_lo(xv.y), bf_hi(xv.y)}; } }
            u32x2* xw = (u32x2*)(xso + (size_t)r * DM) + lane;
#pragma unroll
            for (int j = 0; j < 4; ++j) { const u32x2 y = yr[64 * j]; v[j] += gt[j] * (f32x4){bf_lo(y.x), bf_hi(y.x), bf_lo(y.y), bf_hi(y.y)};
                u32x2 w; w.x = cvt_pk_bf16(v[j][0], v[j][1]); w.y = cvt_pk_bf16(v[j][2], v[j][3]); xw[64 * j] = w;
                ss += (v[j][0] * v[j][0] + v[j][1] * v[j][1]) + (v[j][2] * v[j][2] + v[j][3] * v[j][3]); }
            const float rstd = __builtin_amdgcn_rsqf(wave_sum_all(ss) * (1.0f / DM) + EPS);
            u32x2* o8 = (u32x2*)(H + (size_t)r * DM) + lane; int* q8 = (int*)(H8 + (size_t)r * DM) + lane;
#pragma unroll
            for (int j = 0; j < 4; ++j) { const f32x4 o = v[j] * rstd * c1[j] + shv[j]; u32x2 w; w.x = cvt_pk_bf16(o[0], o[1]); w.y = cvt_pk_bf16(o[2], o[3]); o8[64 * j] = w;
                int pk = __builtin_amdgcn_cvt_pk_fp8_f32(o[0], o[1], 0, false); pk = __builtin_amdgcn_cvt_pk_fp8_f32(o[2], o[3], pk, true); q8[64 * j] = pk; }
        }
    }
}
__device__ __forceinline__ void final_phase(float* x, const float* gf, int gw, int NGW, int lane) {
    f32x4 gv[4];
#pragma unroll
    for (int j = 0; j < 4; ++j) gv[j] = *(const f32x4*)(gf + 4 * lane + 256 * j);
    for (int r = gw; r < MTOK; r += NGW) {
        f32x4* xr = (f32x4*)(x + (size_t)r * DM) + lane;
        f32x4 v[4]; float ss = 0.f;
#pragma unroll
        for (int j = 0; j < 4; ++j) { v[j] = xr[64 * j]; ss += (v[j][0] * v[j][0] + v[j][1] * v[j][1]) + (v[j][2] * v[j][2] + v[j][3] * v[j][3]); }
        const float rstd = __builtin_amdgcn_rsqf(wave_sum_all(ss) * (1.0f / DM) + EPS);
#pragma unroll
        for (int j = 0; j < 4; ++j) xr[64 * j] = v[j] * rstd * gv[j];
    }
}

__device__ __forceinline__ void unpack8(const u32x4 w, float (&f)[8]) { f[0] = bf_lo(w.x); f[1] = bf_hi(w.x); f[2] = bf_lo(w.y); f[3] = bf_hi(w.y); f[4] = bf_lo(w.z); f[5] = bf_hi(w.z); f[6] = bf_lo(w.w); f[7] = bf_hi(w.w); }
__device__ __forceinline__ u32x4 pack8(const float (&f)[8]) { u32x4 o; o.x = cvt_pk_bf16(f[0], f[1]); o.y = cvt_pk_bf16(f[2], f[3]); o.z = cvt_pk_bf16(f[4], f[5]); o.w = cvt_pk_bf16(f[6], f[7]); return o; }
__device__ __forceinline__ void pool_elem_phase(const bf16_t* U, bf16_t* P, int vcu, int G, int tid) {
    const int chunk = tid & 127, run = tid >> 7, c0 = 8 * chunk, w = 2 << (c0 >> 8);
    for (int unit = vcu; unit < MTOK / 128; unit += G) {
        const int t0 = unit * 128 + run * 32, seq0 = t0 & ~(SEQ - 1);
        float s[8];
#pragma unroll
        for (int j = 0; j < 8; ++j) s[j] = 0.f;
        for (int tau = t0 - w; tau < t0; ++tau) if (tau >= seq0) { float f[8];     unpack8(*(const u32x4*)(U + (size_t)tau * DM + c0), f);
#pragma unroll
            for (int j = 0; j < 8; ++j) s[j] += f[j]; }
#pragma unroll 1
        for (int tb = t0; tb < t0 + 32; tb += 8) {
            u32x4 cur[8], old[8];
#pragma unroll
            for (int i = 0; i < 8; ++i) { cur[i] = *(const u32x4*)(U + (size_t)(tb + i) * DM + c0);
                const int tl = tb + i - w; old[i] = *(const u32x4*)(U + (size_t)(tl >= seq0 ? tl : seq0) * DM + c0); }
#pragma unroll
            for (int i = 0; i < 8; ++i) { const int t = tb + i; float f[8], o[8]; unpack8(cur[i], f);
#pragma unroll
                for (int j = 0; j < 8; ++j) s[j] += f[j];
                if (t - w >= seq0) { float q[8]; unpack8(old[i], q);
#pragma unroll
                    for (int j = 0; j < 8; ++j) s[j] -= q[j]; }
                const int pos1 = t - seq0 + 1; const float inv = 1.0f / (float)(pos1 < w ? pos1 : w);
#pragma unroll
                for (int j = 0; j < 8; ++j) o[j] = s[j] * inv - f[j];
                *(u32x4*)(P + (size_t)t * DM + c0) = pack8(o); }
        }
    }
}
__device__ __forceinline__ void conv_elem_phase(const bf16_t* BG, const bf16_t* Z, const float* cw  , bf16_t* Aout, int vcu, int G, int tid) {
    const int chunk = tid & 127, run = tid >> 7, c0 = 8 * chunk;
    float w0[8], w1[8], w2[8];
#pragma unroll
    for (int j = 0; j < 8; ++j) { w0[j] = cw[c0 + j]; w1[j] = cw[DM + c0 + j]; w2[j] = cw[2 * DM + c0 + j]; }
    for (int unit = vcu; unit < MTOK / 128; unit += G) {
        const int t0 = unit * 128 + run * 32, seq0 = t0 & ~(SEQ - 1);
        float zm2[8], zm1[8];
#pragma unroll
        for (int j = 0; j < 8; ++j) { zm2[j] = 0.f; zm1[j] = 0.f; }
        if (t0 - 2 >= seq0) unpack8(*(const u32x4*)(Z + (size_t)(t0 - 2) * DM + c0), zm2);
        if (t0 - 1 >= seq0) unpack8(*(const u32x4*)(Z + (size_t)(t0 - 1) * DM + c0), zm1);
#pragma unroll 1
        for (int tb = t0; tb < t0 + 32; tb += 8) {
            u32x4 zr[8], br[8];
#pragma unroll
            for (int i = 0; i < 8; ++i) { zr[i] = *(const u32x4*)(Z + (size_t)(tb + i) * DM + c0); br[i] = *(const u32x4*)(BG + (size_t)(tb + i) * DM + c0); }
#pragma unroll
            for (int i = 0; i < 8; ++i) { float z[8], bg[8], o[8]; unpack8(zr[i], z); unpack8(br[i], bg);
#pragma unroll
                for (int j = 0; j < 8; ++j) { o[j] = bg[j] * (w0[j] * zm2[j] + w1[j] * zm1[j] + w2[j] * z[j]); zm2[j] = zm1[j]; zm1[j] = z[j]; }
                *(u32x4*)(Aout + (size_t)(tb + i) * DM + c0) = pack8(o); }
        }
    }
}

__device__ __forceinline__ int wp_off(int row, int chunk) { return row * 256 + ((chunk ^ (row & 15)) << 4); }
__device__ __forceinline__ void mix_phase(LAS unsigned char* lds, bf16_t* UA, const bf16_t* VT, const float* WS, const float* BS, const float* LNG, const float* LNB, int vcu, int G, int tid, int wid, int lane) {
    LAS unsigned char* WP = lds;
    LAS float* MU = (LAS float*)(lds + 32768); LAS float* RSTD = MU + 128; LAS float* R1 = MU + 256; LAS float* R2 = MU + 384;
    LAS float* PART = (LAS float*)(lds + 36864);
    LAS unsigned char* VS = lds + 36864;
    for (int n = vcu; n < MTOK / 128; n += G) {
        {
            const int cgp = tid >> 4, tl = tid & 15;
            float s[8], q[8];
#pragma unroll
            for (int j = 0; j < 8; ++j) { s[j] = 0.f; q[j] = 0.f; }
#pragma unroll 4
            for (int it = 0; it < GH / 32; ++it) { float f[8]; unpack8(*(const u32x4*)(VT + ((size_t)n * GH + it * 32 + cgp) * 128 + tl * 8), f);
#pragma unroll
                for (int j = 0; j < 8; ++j) { s[j] += f[j]; q[j] += f[j] * f[j]; } }
#pragma unroll
            for (int j = 0; j < 8; ++j) { PART[(cgp * 128 + tl * 8 + j) * 2] = s[j]; PART[(cgp * 128 + tl * 8 + j) * 2 + 1] = q[j]; }
            __syncthreads();
            if (tid < 128) { float S = 0.f, Q = 0.f;
                for (int k = 0; k < 32; ++k) { S += PART[(k * 128 + tid) * 2]; Q += PART[(k * 128 + tid) * 2 + 1]; }
                const float mu = S * (1.0f / GH), var = Q * (1.0f / GH) - mu * mu; MU[tid] = mu; RSTD[tid] = __builtin_amdgcn_rsqf(fmaxf(var, 0.f) + EPS); }
            __syncthreads();
        }
        for (int g = 0; g < 8; ++g) {
            const int fr = lane & 15, fq = lane >> 4, cbase = g * 384 + wid * 48;
            bf16x8 av[4][3];
#pragma unroll
            for (int ks = 0; ks < 4; ++ks)
#pragma unroll
                for (int ct = 0; ct < 3; ++ct) av[ks][ct] = *(const bf16x8*)(VT + ((size_t)n * GH + cbase + ct * 16 + fr) * 128 + ks * 32 + fq * 8);
            {
                const int i = tid >> 2, part = tid & 3;
                const float* wrow = WS + ((size_t)g * 128 + i) * 128 + part * 32;
                float r1 = 0.f, r2 = 0.f;
#pragma unroll
                for (int jj = 0; jj < 32; jj += 8) { const int j0 = part * 32 + jj;
                    f32x4 a = *(const f32x4*)(wrow + jj), b = *(const f32x4*)(wrow + jj + 4);
                    if (i < 64 && j0 >= 64) { a = (f32x4){0.f, 0.f, 0.f, 0.f}; b = a; }
                    const f32x4 ra = *(const LAS f32x4*)(RSTD + j0), rb = *(const LAS f32x4*)(RSTD + j0 + 4), ma = *(const LAS f32x4*)(MU + j0), mb = *(const LAS f32x4*)(MU + j0 + 4);
                    const f32x4 wa = a * ra, wb = b * rb;
                    r1 += (wa[0] * ma[0] + wa[1] * ma[1]) + (wa[2] * ma[2] + wa[3] * ma[3]) + (wb[0] * mb[0] + wb[1] * mb[1]) + (wb[2] * mb[2] + wb[3] * mb[3]);
                    r2 += (a[0] + a[1]) + (a[2] + a[3]) + (b[0] + b[1]) + (b[2] + b[3]);
                    u32x4 o; o.x = cvt_pk_bf16(wa[0], wa[1]); o.y = cvt_pk_bf16(wa[2], wa[3]); o.z = cvt_pk_bf16(wb[0], wb[1]); o.w = cvt_pk_bf16(wb[2], wb[3]);
                    *(LAS u32x4*)(WP + wp_off(i, j0 >> 3)) = o; }
                r1 += __shfl_xor(r1, 1); r1 += __shfl_xor(r1, 2); r2 += __shfl_xor(r2, 1); r2 += __shfl_xor(r2, 2);
                if (part == 0) { R1[i] = r1; R2[i] = r2; }
            }
            __syncthreads();
            f32x4 acc[3][8];
#pragma unroll
            for (int ct = 0; ct < 3; ++ct)
#pragma unroll
                for (int it = 0; it < 8; ++it) acc[ct][it] = (f32x4){0.f, 0.f, 0.f, 0.f};
#pragma unroll
            for (int ks = 0; ks < 4; ++ks) {
#pragma unroll
                for (int it = 0; it < 8; ++it) { const bf16x8 bw = *(const LAS bf16x8*)(WP + wp_off(it * 16 + fr, ks * 4 + fq));
#pragma unroll
                    for (int ct = 0; ct < 3; ++ct) acc[ct][it] = __builtin_amdgcn_mfma_f32_16x16x32_bf16(av[ks][ct], bw, acc[ct][it], 0, 0, 0); }
                __builtin_amdgcn_sched_barrier(0);
            }
#pragma unroll
            for (int ct = 0; ct < 3; ++ct) { const int c4 = cbase + ct * 16 + 4 * fq;
                const f32x4 lg = *(const f32x4*)(LNG + c4), lb = *(const f32x4*)(LNB + c4);
#pragma unroll
                for (int it = 0; it < 8; ++it) { const int i = it * 16 + fr; const float r1 = R1[i], r2 = R2[i], bs = BS[g * 128 + i];
                    const f32x4 vs = lg * (acc[ct][it] - r1) + lb * r2 + bs;
                    u32x2 o; o.x = cvt_pk_bf16(vs[0], vs[1]); o.y = cvt_pk_bf16(vs[2], vs[3]);
                    *(LAS u32x2*)(VS + i * 784 + (wid * 48 + ct * 16 + 4 * fq) * 2) = o; } }
            __syncthreads();
#pragma unroll 4
            for (int c = tid; c < 128 * 48; c += NTHREADS) { const int tok = c / 48, ch8 = c - tok * 48;
                const u32x4 vv = *(const LAS u32x4*)(VS + tok * 784 + ch8 * 16);
                u32x4* up = (u32x4*)(UA + (size_t)(n * 128 + tok) * GH + g * 384 + ch8 * 8); const u32x4 uu = *up;
                u32x4 o; o.x = cvt_pk_bf16(bf_lo(uu.x) * bf_lo(vv.x), bf_hi(uu.x) * bf_hi(vv.x)); o.y = cvt_pk_bf16(bf_lo(uu.y) * bf_lo(vv.y), bf_hi(uu.y) * bf_hi(vv.y));
                o.z = cvt_pk_bf16(bf_lo(uu.z) * bf_lo(vv.z), bf_hi(uu.z) * bf_hi(vv.z)); o.w = cvt_pk_bf16(bf_lo(uu.w) * bf_lo(vv.w), bf_hi(uu.w) * bf_hi(vv.w));
                *up = o; }
            __syncthreads();
        }
    }
}

__device__ __forceinline__ void topk_units(LAS unsigned char* lds, const bf16_t* Q, const bf16_t* KEYS, int* SELI, float* SELW, const pg8::StaticOrder& S, int tid, int wid, int lane) {
    LAS unsigned char* kl = lds;
    LAS float* topv = (LAS float*)(lds + 65536);
    const int p = wid >> 2, sub = wid & 3, tl = lane & 31, hi = lane >> 5;
    int hprev = -1;
#pragma unroll 1
    for (int k = 0; ; k = (k & 1) ? k + 3 : k + 1) {
        pg8::Unit ua, ub; if (!S.next(k, ua)) break;
        const bool hasb = S.next(k + 2, ub);
        const bool pair = hasb && ub.pn == ua.pn;
#pragma unroll 1
        for (int part = 0; part < ((hasb && !pair) ? 2 : 1); ++part) {
            const int h = part ? ub.pn : ua.pn, pm0 = part ? ub.pm : ua.pm, pm1 = ub.pm, ntile = pair ? 4 : 2;
            __syncthreads();
            if (h != hprev) {
                for (int c = tid; c < 4096; c += NTHREADS) { const int row = c >> 4, ch = c & 15;
                    const u32x4 v = *(const u32x4*)(KEYS + ((size_t)h * 256 + row) * 128 + ch * 8);
                    *(LAS u32x4*)(kl + row * 256 + ((ch ^ (row & 15)) << 4)) = v; }
                hprev = h; }
            __syncthreads();
#pragma unroll 1
            for (int t4 = 0; t4 < ntile; ++t4) {
                const int tile = 2 * (t4 < 2 ? pm0 : pm1) + (t4 & 1);
                const bf16_t* qrow = Q + ((size_t)((tile * 8 + h) * 32 + 16 * p + hi) * 128 + sub * 32 + tl) * 8;
                bf16x8 bq[8];
#pragma unroll
                for (int ks = 0; ks < 8; ++ks) bq[ks] = *(const bf16x8*)(qrow + (size_t)ks * 2 * 128 * 8);
                f32x16 acc[4];
#pragma unroll
                for (int kt = 0; kt < 4; ++kt)
#pragma unroll
                    for (int r = 0; r < 16; ++r) acc[kt][r] = 0.f;
#pragma unroll
                for (int ks = 0; ks < 8; ++ks)
#pragma unroll
                    for (int kt = 0; kt < 4; ++kt) { const int row = p * 128 + kt * 32 + tl;
                        const bf16x8 ak = *(const LAS bf16x8*)(kl + row * 256 + (((2 * ks + hi) ^ (row & 15)) << 4));
                        acc[kt] = __builtin_amdgcn_mfma_f32_32x32x16_bf16(ak, bq[ks], acc[kt], 0, 0, 0); }
                float v[64];
#pragma unroll
                for (int kt = 0; kt < 4; ++kt)
#pragma unroll
                    for (int r = 0; r < 16; ++r) { const unsigned key = (unsigned)(kt * 32 + (r & 3) + 8 * (r >> 2) + 4 * hi);
                        v[kt * 16 + r] = __uint_as_float((__float_as_uint(acc[kt][r]) & ~127u) | key); }
                top16_of_64(v);
                float m[16];
#pragma unroll
                for (int i = 0; i < 16; ++i) m[i] = fmaxf(v[i], __shfl_xor(v[15 - i], 32));
                bmerge16_desc<0, 16>(m);
                if (hi == 0) { LAS f32x4* dst = (LAS f32x4*)(topv + ((t4 * 2 + p) * 128 + sub * 32 + tl) * 16);
#pragma unroll
                    for (int i = 0; i < 4; ++i) dst[i] = (f32x4){m[4 * i], m[4 * i + 1], m[4 * i + 2], m[4 * i + 3]}; }
            }
            __syncthreads();
            if (tid < ntile * 128) {
                const int t4 = tid >> 7, tok = tid & 127, tile = 2 * (t4 < 2 ? pm0 : pm1) + (t4 & 1);
                const LAS float* t0 = topv + ((t4 * 2 + 0) * 128 + tok) * 16; const LAS float* t1 = topv + ((t4 * 2 + 1) * 128 + tok) * 16;
                float s0[16], s1[16];
#pragma unroll
                for (int i = 0; i < 4; ++i) { const f32x4 a = *(const LAS f32x4*)(t0 + 4 * i), b = *(const LAS f32x4*)(t1 + 4 * i);
                    s0[4 * i] = a[0]; s0[4 * i + 1] = a[1]; s0[4 * i + 2] = a[2]; s0[4 * i + 3] = a[3]; s1[4 * i] = b[0]; s1[4 * i + 1] = b[1]; s1[4 * i + 2] = b[2]; s1[4 * i + 3] = b[3]; }
                float c[64];
                constexpr int pre[16] = {0, 16, 24, 29, 33, 36, 38, 40, 42, 43, 44, 45, 46, 47, 48, 49};
#pragma unroll
                for (int a = 0; a < 16; ++a)
#pragma unroll
                    for (int b = 0; b < 16; ++b) if ((a + 1) * (b + 1) <= 16) c[pre[a] + b] = __uint_as_float((__float_as_uint(s0[a] + s1[b]) & ~255u) | (unsigned)(a * 16 + b));
#pragma unroll
                for (int i = 50; i < 64; ++i) c[i] = -3.0e38f;
                top16_of_64(c);
                float e[16], sum = 0.f;
#pragma unroll
                for (int kk = 0; kk < 16; ++kk) { e[kk] = __builtin_amdgcn_exp2f((c[kk] - c[0]) * 1.44269504f); sum += e[kk]; }
                const float inv = 1.0f / sum;
                const size_t o = (size_t)(tile * 128 + tok) * NPICK + h * 16;
#pragma unroll
                for (int k4 = 0; k4 < 4; ++k4) { i32x4 ei; f32x4 wv;
#pragma unroll
                    for (int j = 0; j < 4; ++j) { const unsigned code = __float_as_uint(c[4 * k4 + j]) & 255u;
                        const unsigned i1 = __float_as_uint(t0[code >> 4]) & 127u, i2 = __float_as_uint(t1[code & 15u]) & 127u;
                        ei[j] = (int)(i1 * 128u + i2); wv[j] = e[4 * k4 + j] * inv; }
                    *(i32x4*)(SELI + o + 4 * k4) = ei; *(f32x4*)(SELW + o + 4 * k4) = wv; }
            }
        }
    }
    __syncthreads();
}

typedef const unsigned char* cbytes;
#ifndef DUP_MASK
#define DUP_MASK 0
#endif
template <int CTRL> __device__ __forceinline__ float dpp_f(float v) { return __builtin_bit_cast(float, __builtin_amdgcn_update_dpp(0, __builtin_bit_cast(int, v), CTRL, 0xf, 0xf, false)); }
#define DPP_F(v, ctrl) dpp_f<(ctrl)>(v)
#define PG_IDX(EV, TKN) do { const LAS u32x4* _ip = (const LAS u32x4*)(idxw + (TKN) * 128 + 16 * g8); \
        _Pragma("unroll") for (int q = 0; q < 2; ++q) { const u32x4 _e = _ip[q]; _Pragma("unroll") for (int w = 0; w < 4; ++w) { EV[8 * q + 2 * w] = (int)(_e[w] & 0xffffu); EV[8 * q + 2 * w + 1] = (int)(_e[w] >> 16); } } } while (0)
#define PG_GATHER8(BUF, SL, EV, J0) do { _Pragma("unroll") for (int j = 0; j < 8; ++j) BUF[j] = *(const u32x4*)((SL) + ((unsigned)EV[(J0) + j] * 128u + s8 * 16u)); } while (0)
#define PGU_IDX(EV, TKN) do { const LAS u32x4* _ip = (const LAS u32x4*)(idxw + (TKN) * 128 + 16 * slotA); \
        _Pragma("unroll") for (int q = 0; q < 2; ++q) { const u32x4 _e = _ip[q]; _Pragma("unroll") for (int w = 0; w < 4; ++w) { EV[8 * q + 2 * w] = (int)(_e[w] & 0xffffu); EV[8 * q + 2 * w + 1] = (int)(_e[w] >> 16); } } } while (0)
#define PGU_GATHER8(BUF, SL, EV, M0) do { _Pragma("unroll") for (int j = 0; j < 8; ++j) BUF[j] = *(const u32x4*)((SL) + ((unsigned)EV[4 * (((M0) + j) & 3) + (((M0) + j) >> 2)] * 128u + pieceA * 16u)); } while (0)
#define PGU_HB(HR, IT) do { const int _it = (IT) < 63 ? (IT) : 63; HR = *(const u32x4*)(H8 + (size_t)(tk0 + (_it & 15)) * DM + (((xg + (_it >> 4)) & 3) * 256) + hoffB); } while (0)
#define PGU_MMA8(BUF, HR, ACC, M0) do { const i32x8 _b = {blo ? (int)HR.x : 0, blo ? (int)HR.y : 0, blo ? (int)HR.z : 0, blo ? (int)HR.w : 0, bhi ? (int)HR.x : 0, bhi ? (int)HR.y : 0, bhi ? (int)HR.z : 0, bhi ? (int)HR.w : 0}; \
        _Pragma("unroll") for (int j = 0; j < 8; ++j) { const u32x4 _u = BUF[j]; const i32x8 _a = {(int)_u.x, (int)_u.y, (int)_u.z, (int)_u.w, 0, 0, 0, 0}; \
            const f32x4 _d = __builtin_amdgcn_mfma_scale_f32_16x16x128_f8f6f4(_a, _b, (f32x4){0.f, 0.f, 0.f, 0.f}, 4, 0, 0, 0, 0, 0); \
            float _v = i4 == 0 ? _d[0] : i4 == 1 ? _d[1] : i4 == 2 ? _d[2] : _d[3]; _v += DPP_F(_v, 0xB1); _v += DPP_F(_v, 0x4E); \
            ACC[((M0) + j) >> 2] = (i4 == (((M0) + j) & 3)) ? _v : ACC[((M0) + j) >> 2]; } } while (0)
#define PGU_DOTS(ACC, TKN) do { if (n16 < 8) { LAS f32x4* _dp = (LAS f32x4*)(dotw + (TKN) * 128 + 32 * c4 + 4 * n16); *_dp += ACC; } } while (0)
#define PG_VCOMP8(BUF, CV, J0) do { _Pragma("unroll") for (int j = 0; j < 8; ++j) { const u32x4 v = BUF[j]; const float c = CV[(J0) + j]; \
            acc[0] += c * __builtin_amdgcn_cvt_pk_f32_fp8(v.x, false); acc[1] += c * __builtin_amdgcn_cvt_pk_f32_fp8(v.x, true); \
            acc[2] += c * __builtin_amdgcn_cvt_pk_f32_fp8(v.y, false); acc[3] += c * __builtin_amdgcn_cvt_pk_f32_fp8(v.y, true); \
            acc[4] += c * __builtin_amdgcn_cvt_pk_f32_fp8(v.z, false); acc[5] += c * __builtin_amdgcn_cvt_pk_f32_fp8(v.z, true); \
            acc[6] += c * __builtin_amdgcn_cvt_pk_f32_fp8(v.w, false); acc[7] += c * __builtin_amdgcn_cvt_pk_f32_fp8(v.w, true); } } while (0)
#define PG_COEF(CV, TKN) do { const LAS f32x4* _cp = (const LAS f32x4*)(dotw + (TKN) * 128 + 16 * g8); \
        _Pragma("unroll") for (int q = 0; q < 4; ++q) { const f32x4 _c = _cp[q]; CV[4 * q] = _c[0]; CV[4 * q + 1] = _c[1]; CV[4 * q + 2] = _c[2]; CV[4 * q + 3] = _c[3]; } } while (0)
#define PG_COEF8(CV, TKN, J0) do { const LAS f32x4* _cp = (const LAS f32x4*)(dotw + (TKN) * 128 + 16 * g8 + (J0)); \
        const f32x4 _c0 = _cp[0], _c1 = _cp[1]; CV[0] = _c0[0]; CV[1] = _c0[1]; CV[2] = _c0[2]; CV[3] = _c0[3]; CV[4] = _c1[0]; CV[5] = _c1[1]; CV[6] = _c1[2]; CV[7] = _c1[3]; } while (0)
#define PG_XOFFS(IT) ((size_t)(tk0 + ((IT) & 15)) * DM + (((xg + ((IT) >> 4)) & 7) * 128) + xoff)
#define PG_XADDR(IT) (x + PG_XOFFS(IT))
#define PG_XLOAD(XV, IT) do { XV = *(const unsigned*)PG_XADDR(IT); } while (0)
__device__ __forceinline__ void peer_gather_phase(LAS unsigned char* lds, const unsigned char* H8  , cbytes TUP, cbytes TVP, const int* SELI, const float* SELW, const unsigned* SC, bf16_t* x  , float* outf  , const float* gacc, const float* gn_next  , const float* mod_next  , bf16_t* Hout, bool last, int vcu, int G, int wid, int lane) {
    const int g8 = lane >> 3, s8 = lane & 7, n16 = lane & 15, c4 = lane >> 4, i4 = lane & 3, slotA = 2 * ((lane >> 2) & 3) + (c4 >> 1), pieceA = 4 * (c4 & 1) + i4, hoffB = 128 * (c4 >> 1) + 32 * i4 + 16 * (c4 & 1);
    const bool blo = n16 < 4, bhi = n16 >= 4 && n16 < 8;
    const bool b3 = (lane & 8) != 0, b4 = (lane & 16) != 0, b5 = (lane & 32) != 0;
    const int xoff = s8 * 16 + 8 * (g8 & 1) + 4 * ((g8 >> 1) & 1) + 2 * (g8 >> 2);
    LAS unsigned short* idxw = (LAS unsigned short*)(lds + wid * 12288);
    LAS float* dotw = (LAS float*)(lds + wid * 12288 + 4096);
    for (int blk = vcu; blk < 256; blk += G) {
        const int xg = blk >> 5, tk0 = blk * 128 + wid * 16;
        const int nrep_u = (DUP_MASK & 0x20000) ? opaque(2) : 1;
#pragma unroll 1
        for (int rep_u = 0; rep_u < nrep_u; ++rep_u) {
#pragma unroll 4
        for (int i = 0; i < 16; ++i) { const int e0 = SELI[(size_t)(tk0 + i) * NPICK + lane], e1 = SELI[(size_t)(tk0 + i) * NPICK + 64 + lane];
            idxw[i * 128 + lane] = (unsigned short)e0; idxw[i * 128 + 64 + lane] = (unsigned short)e1; dotw[i * 128 + lane] = 0.f; dotw[i * 128 + 64 + lane] = 0.f; }
        asm volatile("" ::: "memory");
        {
            int ev[16]; u32x4 bufA[8], bufB[8], bufC[8], bufD[8]; u32x4 hr0, hr1;
            { cbytes sl0 = TUP + (size_t)(xg & 3) * NEXP * 128;
              PGU_IDX(ev, 0); PGU_GATHER8(bufA, sl0, ev, 0); PGU_GATHER8(bufB, sl0, ev, 8);
              PGU_IDX(ev, 1); PGU_GATHER8(bufC, sl0, ev, 0); PGU_GATHER8(bufD, sl0, ev, 8); }
            PGU_HB(hr0, 0); PGU_HB(hr1, 1);
#pragma unroll 1
            for (int it = 0; it < 64; it += 2) {
                const int tkn = it & 15, it2 = it + 2 < 63 ? it + 2 : 63, it3 = it + 3 < 63 ? it + 3 : 63;
                cbytes sl2 = TUP + (size_t)((xg + (it2 >> 4)) & 3) * NEXP * 128;
                f32x4 acc4 = {0.f, 0.f, 0.f, 0.f};
                PGU_IDX(ev, it2 & 15);
                PGU_MMA8(bufA, hr0, acc4, 0); __builtin_amdgcn_sched_barrier(0);
                PGU_GATHER8(bufA, sl2, ev, 0); __builtin_amdgcn_sched_barrier(0);
                PGU_MMA8(bufB, hr0, acc4, 8); __builtin_amdgcn_sched_barrier(0);
                PGU_GATHER8(bufB, sl2, ev, 8); PGU_HB(hr0, it + 2); __builtin_amdgcn_sched_barrier(0);
                PGU_DOTS(acc4, tkn);
                acc4 = (f32x4){0.f, 0.f, 0.f, 0.f};
                PGU_IDX(ev, it3 & 15);
                PGU_MMA8(bufC, hr1, acc4, 0); __builtin_amdgcn_sched_barrier(0);
                PGU_GATHER8(bufC, sl2, ev, 0); __builtin_amdgcn_sched_barrier(0);
                PGU_MMA8(bufD, hr1, acc4, 8); __builtin_amdgcn_sched_barrier(0);
                PGU_GATHER8(bufD, sl2, ev, 8); PGU_HB(hr1, it + 3); __builtin_amdgcn_sched_barrier(0);
                PGU_DOTS(acc4, tkn + 1);
            }
        }
        asm volatile("" ::: "memory");
        }
#pragma unroll 2
        for (int i = 0; i < 16; ++i) {
#pragma unroll
            for (int hh = 0; hh < 2; ++hh) { const int k = 16 * g8 + s8 + 8 * hh; const int e = idxw[i * 128 + k];
                const float w = SELW[(size_t)(tk0 + i) * NPICK + k]; const unsigned sc = SC[e];
                dotw[i * 128 + k] = w * gelu_tanh(dotw[i * 128 + k] * bf_lo(sc)) * bf_hi(sc); } }
        asm volatile("" ::: "memory");
        {
            const float* gp = gacc + (size_t)(tk0 >> 12) * 6 * DM + xoff;
            int ev[16]; u32x4 bufA[8], bufB[8], bufC[8], bufD[8]; float cC[8]; unsigned x0, x1;
            { cbytes sl0 = TVP + (size_t)(xg & 7) * NEXP * 128;
              PG_IDX(ev, 0); PG_GATHER8(bufA, sl0, ev, 0); PG_GATHER8(bufB, sl0, ev, 8);
              PG_IDX(ev, 1); PG_GATHER8(bufC, sl0, ev, 0); PG_GATHER8(bufD, sl0, ev, 8); }
            PG_XLOAD(x0, 0); PG_XLOAD(x1, 1);
#define PG_VREDUCE_STORE(XV, IT) do { \
                f32x2 k4[4]; _Pragma("unroll") for (int j = 0; j < 4; ++j) { f32x2 lo = acc[j], hi = acc[4 + j];          \
                    lo.x += DPP_F(lo.x, 0x128); lo.y += DPP_F(lo.y, 0x128); hi.x += DPP_F(hi.x, 0x128); hi.y += DPP_F(hi.y, 0x128); k4[j] = b3 ? hi : lo; } \
                f32x2 k2[2]; _Pragma("unroll") for (int j = 0; j < 2; ++j) { const f32x2 snd = b4 ? k4[j] : k4[2 + j]; k2[j] = b4 ? k4[2 + j] : k4[j]; k2[j].x += __shfl_xor(snd.x, 16); k2[j].y += __shfl_xor(snd.y, 16); } \
                const f32x2 snd = b5 ? k2[0] : k2[1]; f32x2 k1 = b5 ? k2[1] : k2[0]; \
                k1.x += __shfl_xor(snd.x, 32); k1.y += __shfl_xor(snd.y, 32); \
                *(unsigned*)PG_XADDR(IT) = cvt_pk_bf16(bf_lo(XV) + gate.x * k1.x, bf_hi(XV) + gate.y * k1.y); } while (0)
#pragma unroll 1
            for (int it = 0; it < 128; it += 2) {
                const int it2 = it + 2 < 127 ? it + 2 : 127, it3 = it + 3 < 127 ? it + 3 : 127, sl = (xg + (it >> 4)) & 7;
                cbytes sl2 = TVP + (size_t)((xg + (it2 >> 4)) & 7) * NEXP * 128;
                const f32x2 gate = *(const f32x2*)(gp + sl * 128);
                f32x2 acc[8];
#pragma unroll
                for (int j = 0; j < 8; ++j) acc[j] = (f32x2){0.f, 0.f};
                PG_COEF8(cC, it & 15, 0); PG_IDX(ev, it2 & 15);
                PG_VCOMP8(bufA, cC, 0); __builtin_amdgcn_sched_barrier(0);
                PG_GATHER8(bufA, sl2, ev, 0); PG_COEF8(cC, it & 15, 8); __builtin_amdgcn_sched_barrier(0);
                PG_VCOMP8(bufB, cC, 0); __builtin_amdgcn_sched_barrier(0);
                PG_GATHER8(bufB, sl2, ev, 8); __builtin_amdgcn_sched_barrier(0);
                PG_VREDUCE_STORE(x0, it);
                PG_XLOAD(x0, it2);
#pragma unroll
                for (int j = 0; j < 8; ++j) acc[j] = (f32x2){0.f, 0.f};
                PG_COEF8(cC, (it + 1) & 15, 0); PG_IDX(ev, it3 & 15);
                PG_VCOMP8(bufC, cC, 0); __builtin_amdgcn_sched_barrier(0);
                PG_GATHER8(bufC, sl2, ev, 0); PG_COEF8(cC, (it + 1) & 15, 8); __builtin_amdgcn_sched_barrier(0);
                PG_VCOMP8(bufD, cC, 0); __builtin_amdgcn_sched_barrier(0);
                PG_GATHER8(bufD, sl2, ev, 8); __builtin_amdgcn_sched_barrier(0);
                PG_VREDUCE_STORE(x1, it + 1);
                PG_XLOAD(x1, it3);
            }
#undef PG_VREDUCE_STORE
        }
        asm volatile("s_waitcnt vmcnt(0)" ::: "memory");
        {
            const int b = tk0 >> 12;
            f32x4 c1[4], shv[4];
#pragma unroll
            for (int j = 0; j < 4; ++j) { const int col = 4 * lane + 256 * j;
                if (last) { c1[j] = *(const f32x4*)(gn_next + col); shv[j] = (f32x4){0.f, 0.f, 0.f, 0.f}; }
                else { c1[j] = *(const f32x4*)(gn_next + col) * (1.0f + *(const f32x4*)(mod_next + (size_t)b * 6 * DM + DM + col)); shv[j] = *(const f32x4*)(mod_next + (size_t)b * 6 * DM + col); } }
#pragma unroll 1
            for (int i0 = 0; i0 < 16; i0 += 4) {
                f32x4 v[4][4]; float ss[4];
#pragma unroll
                for (int rr = 0; rr < 4; ++rr) { const u32x2* xr = (const u32x2*)(x + (size_t)(tk0 + i0 + rr) * DM) + lane;
#pragma unroll
                    for (int j = 0; j < 4; ++j) { const u32x2 xv = xr[64 * j]; v[rr][j] = (f32x4){bf_lo(xv.x), bf_hi(xv.x), bf_lo(xv.y), bf_hi(xv.y)}; } }
#pragma unroll
                for (int rr = 0; rr < 4; ++rr) { float q = 0.f;
#pragma unroll
                    for (int j = 0; j < 4; ++j) q += (v[rr][j][0] * v[rr][j][0] + v[rr][j][1] * v[rr][j][1]) + (v[rr][j][2] * v[rr][j][2] + v[rr][j][3] * v[rr][j][3]);
                    ss[rr] = q; }
#pragma unroll
                for (int o = 1; o < 64; o <<= 1) {
#pragma unroll
                    for (int rr = 0; rr < 4; ++rr) ss[rr] += __shfl_xor(ss[rr], o); }
#pragma unroll
                for (int rr = 0; rr < 4; ++rr) { const int r = tk0 + i0 + rr; const float rstd = __builtin_amdgcn_rsqf(ss[rr] * (1.0f / DM) + EPS);
                    if (last) { f32x4* xr = (f32x4*)(outf + (size_t)r * DM) + lane;
#pragma unroll
                        for (int j = 0; j < 4; ++j) xr[64 * j] = v[rr][j] * rstd * c1[j]; }
                    else { u32x2* o8 = (u32x2*)(Hout + (size_t)r * DM) + lane;
#pragma unroll
                        for (int j = 0; j < 4; ++j) { const f32x4 o = v[rr][j] * rstd * c1[j] + shv[j]; u32x2 w; w.x = cvt_pk_bf16(o[0], o[1]); w.y = cvt_pk_bf16(o[2], o[3]); o8[64 * j] = w; } } }
            }
        }
    }
}
#undef PG_IDX
#undef PG_GATHER8
#undef PGU_IDX
#undef PGU_GATHER8
#undef PGU_HB
#undef PGU_MMA8
#undef PGU_DOTS
#undef PG_VCOMP8
#undef PG_COEF
#undef PG_COEF8
#undef PG_XADDR
#undef PG_XOFFS
#undef PG_XLOAD

constexpr size_t WS_BAR = 768 * 1024;
#define XB_TMO      128
#define XB_XCNT(j)  (256  + 64 * (j))
#define XB_XSUB(j)  (1280 + 64 * (j))
#define XB_XGEN(j)  (2304 + 64 * (j))
#define XB_TOP      3328
#define XB_TOPGEN   3392
#define XCD_BAR_WORDS 3456
#define XB_SPIN_CAP (1u << 22)
__device__ __forceinline__ unsigned xb_ld(unsigned* p)              { return __hip_atomic_load(p, __ATOMIC_RELAXED, __HIP_MEMORY_SCOPE_AGENT); }
__device__ __forceinline__ unsigned xb_add(unsigned* p, unsigned v) { return __hip_atomic_fetch_add(p, v, __ATOMIC_RELAXED, __HIP_MEMORY_SCOPE_AGENT); }
__device__ __forceinline__ unsigned xb_xcc_id() { return (unsigned)__builtin_amdgcn_s_getreg((3 << 11) | 20) & 0xFu; }
#define XB_SPIN(cond, bar) do { unsigned _sp = 0; while (cond) { __builtin_amdgcn_s_sleep(1); \
    if ((++_sp & 255u) == 0u) { if (xb_ld(&(bar)[XB_TMO])) break; if (_sp > XB_SPIN_CAP) { atomicAdd(&(bar)[XB_TMO], 1u); break; } } } } while (0)
struct XcdBarrier { unsigned* bar; unsigned x; volatile LAS unsigned* st; };
__device__ __forceinline__ void xcd_barrier_complete(unsigned* bar, unsigned x, unsigned& nloc, unsigned& nx) {
    const unsigned G = gridDim.x * gridDim.y * gridDim.z;
    unsigned sum, cnt, mine, sp = 0u;
    for (;;) {
        sum = 0u; cnt = 0u; mine = 0u;
#pragma unroll
        for (unsigned j = 0; j < 16; ++j) { const unsigned c = xb_ld(&bar[XB_XCNT(j)]); sum += c; cnt += (c > 0u) ? 1u : 0u; mine = (j == x) ? c : mine; }
        if (sum == G) break;
        __builtin_amdgcn_s_sleep(1);
        if ((++sp & 255u) == 0u) { if (xb_ld(&bar[XB_TMO])) break; if (sp > XB_SPIN_CAP) { atomicAdd(&bar[XB_TMO], 1u); break; } }
    }
    nloc = mine > 0u ? mine : 1u; nx = cnt > 0u ? cnt : 1u;
}
__device__ __forceinline__ void xcd_barrier(const XcdBarrier& b) {
    asm volatile("s_waitcnt vmcnt(0)" ::: "memory");
    __syncthreads();
    if (threadIdx.x == 0) {
        unsigned* bar = b.bar;
        __builtin_amdgcn_s_waitcnt(0);
        unsigned nloc = b.st[0], nx = b.st[1];
        if (nloc == 0u) { xcd_barrier_complete(bar, b.x, nloc, nx); b.st[0] = nloc; b.st[1] = nx; }
        const unsigned old = xb_add(&bar[XB_XSUB(b.x)], 1u);
        const unsigned gen = old / nloc;
        if (old + 1u == (gen + 1u) * nloc) {
            __builtin_amdgcn_fence(__ATOMIC_RELEASE, "agent");
            asm volatile("s_waitcnt vmcnt(0)" ::: "memory");
            const unsigned og = xb_add(&bar[XB_TOP], 1u);
            const unsigned tg = og / nx;
            if (og + 1u == (tg + 1u) * nx) xb_add(&bar[XB_TOPGEN], 1u);
            else XB_SPIN(xb_ld(&bar[XB_TOPGEN]) == tg, bar);
            __builtin_amdgcn_fence(__ATOMIC_ACQUIRE, "agent");
            xb_add(&bar[XB_XGEN(b.x)], 1u);
            asm volatile("s_waitcnt vmcnt(0)" ::: "memory");
        } else {
            XB_SPIN(xb_ld(&bar[XB_XGEN(b.x)]) == gen, bar);
            __builtin_amdgcn_fence(__ATOMIC_ACQUIRE, "agent");
            asm volatile("s_waitcnt vmcnt(0)" ::: "memory");
        }
    }
    __syncthreads();
}

constexpr int NPHASES = 27;
#ifndef PH_MASK
#define PH_MASK 0xFFFFFF
#endif
#ifndef DUP_MASK
#define DUP_MASK 0
#endif
#ifndef TIME_MASK
#define TIME_MASK 0
#endif
__device__ __forceinline__ int opaque_s(int x) { asm volatile("" : "+s"(x)); return x; }
#define PHM(bit, call) do { if constexpr ((PH_MASK & (bit)) != 0) { if constexpr ((DUP_MASK & (bit)) != 0) { const int _nrep = opaque_s(2); for (int _rep = 0; _rep < _nrep; ++_rep) { call; __syncthreads(); } } else { call; } } } while (0)
__global__ void __launch_bounds__(NTHREADS, 2) trunk_fwd(Args A) {
    extern __shared__ __attribute__((aligned(16))) unsigned char lds_raw[];
    LAS unsigned char* lds = (LAS unsigned char*)lds_raw;
    const int tid0 = threadIdx.x, wid = __builtin_amdgcn_readfirstlane(tid0 >> 6);
    const int G = gridDim.x, bx = blockIdx.x, vcu = (G % 8 == 0) ? (bx % 8) * (G / 8) + bx / 8 : bx;
    const int gw = vcu * 8 + wid, NGW = G * 8;
    const int ph_lo = A.ph_lo, ph_hi = A.ph_hi;
    unsigned long long t_acc = 0;
#if MK_ONE_LAUNCH
    if (tid0 < 2) ((volatile LAS unsigned*)(lds + LDS_XB_OFF))[tid0] = 0u;
    if (bx == 0) { unsigned* b0 = (unsigned*)(A.ws + WS_BAR); for (int i = tid0; i < XCD_BAR_WORDS; i += NTHREADS) b0[i] = 0u; }
#endif

    for (int ph = ph_lo; ph < ph_hi; ++ph) {
        const int tid = opaque(tid0), lane = tid & 63;
        ArgP Ap = (ArgP)__builtin_amdgcn_kernarg_segment_ptr();
        asm volatile("" : "+s"(Ap));
        unsigned char* ws = Ap->ws;
        bf16_t* Hb = (bf16_t*)(ws + WS_H);
        unsigned char* mixb = ws + WS_MIX;
        const float* mod = (const float*)(ws + WS_MOD);
        float* xo = Ap->out;
        int layer, step;
        if (ph < 2) { layer = -1; step = ph; }
        else if (ph < 9) { layer = 0; step = ph - 2; }
        else if (ph < 15) { layer = 1; step = ph - 9 + 1; }
        else if (ph < 21) { layer = 2; step = ph - 15 + 1; }
        else { layer = 3; step = ph - 21 + 1; }
        const int kind = layer % 3, jl = layer / 3;
        unsigned long long t_ph0 = 0; if constexpr (TIME_MASK != 0) t_ph0 = __builtin_amdgcn_s_memrealtime();
        const int nmix = 4;
        int ptype = 0;
        if (layer < 0) ptype = 1; else if (layer > 3) ptype = 2048; else if (step == 0 || step == nmix) ptype = 2;
        else if (step < nmix) ptype = (step == 1) ? 4 : (step == nmix - 1) ? 32 : (kind == 0 && step == 3) ? 16 : 8;
        else ptype = 64 << (step - nmix - 1);
        const float* macc = mod + (size_t)(layer < 0 ? 0 : (layer > 3 ? 3 : layer)) * BATCH * 6 * DM;
        const float* mbias = Ap->in[I_ADA_B] + (size_t)(layer < 0 ? 0 : (layer > 3 ? 3 : layer)) * 6 * DM;
        const float* xin = (layer == 0) ? Ap->in[I_X] : xo;

        if (layer < 0) {
            if (step == 0) { PHM(1, prologue_phase(Ap, lds, vcu, G, tid, wid, lane)); }
            else { PHM(1, modreduce_phase(Ap, vcu, G, tid));
#pragma unroll 1
                for (int pl = 0; pl < 2; ++pl) { pg8::StaticOrder S; pg8::Gemm g{(const bf16_t*)(ws + WS_POOL_WOUT) + (size_t)pl * DM * DM, (const bf16_t*)(ws + WS_WGS) + (size_t)pl * 4 * 65536, DM, DM, 256, DM, 256, 256}; S.init(DM, DM, G, bx);
                    pg8::EpiBf16<0> E{(bf16_t*)(ws + WS_WEFF) + (size_t)pl * DM * DM, DM}; PHM(0x2000, pg8::gemm_phase(lds, g, S, E)); } }
        } else if (layer > 3) {
            PHM(256, final_phase(xo, Ap->in[I_FINAL_G], gw, NGW, lane));
        } else if (step == 0) {
            PHM(2, norm_phase(xin, Ap->in[I_NORM_G] + (size_t)(layer * 2 + 0) * DM, macc, mbias, 0, DM, Hb, gw, NGW, lane));
        } else if (step < nmix) {
            pg8::StaticOrder S;
            if (kind == 0) {
                bf16_t* U = (bf16_t*)mixb; bf16_t* P = (bf16_t*)(mixb + 64 * MiB); bf16_t* Z = (bf16_t*)(mixb + 128 * MiB);
                if (step == 1) { pg8::Gemm g{Hb, (const bf16_t*)(ws + WS_POOL_WIN) + (size_t)jl * DM * DM, MTOK, DM, DM, DM, DM, 0}; S.init(MTOK, DM, G, bx);
                    pg8::EpiBf16<0> E{U, DM}; PHM(0x1000, pg8::gemm_phase(lds, g, S, E)); }
                else if (step == 2) { PHM(8, pool_elem_phase(U, P, vcu, G, tid)); }
                else { pg8::Gemm g{P, (const bf16_t*)(ws + WS_WEFF) + (size_t)jl * DM * DM, MTOK, DM, DM, DM, DM, 0}; S.init(MTOK, DM, G, bx);
                    pg8::EpiBf16<0> E{(bf16_t*)(mixb + 192 * MiB), DM}; PHM(0x8000, pg8::gemm_phase(lds, g, S, E));   }
            } else if (kind == 1) {
                bf16_t* BG = (bf16_t*)mixb; bf16_t* Z = (bf16_t*)(mixb + 64 * MiB); bf16_t* AA = (bf16_t*)(mixb + 128 * MiB);
                if (step == 1) { pg8::Gemm g{Hb, (const bf16_t*)(ws + WS_CONV_WIN), MTOK, 3 * DM, DM, DM, DM, 0}; S.init(MTOK, 3 * DM, G, bx);
                    pg8::EpiConvIn E{BG, Z}; PHM(0x4000, pg8::gemm_phase(lds, g, S, E)); }
                else if (step == 2) { PHM(16, conv_elem_phase(BG, Z, Ap->in[I_CONV_W], AA, vcu, G, tid)); }
                else { pg8::Gemm g{AA, (const bf16_t*)(ws + WS_CONV_WOUT), MTOK, DM, DM, DM, DM, 0}; S.init(MTOK, DM, G, bx);
                    pg8::EpiBf16<0> E{(bf16_t*)(mixb + 192 * MiB), DM}; PHM(0x8000, pg8::gemm_phase(lds, g, S, E));   }
            } else {
                bf16_t* UA = (bf16_t*)mixb; bf16_t* VT = (bf16_t*)(mixb + 192 * MiB);
                if (step == 1) {
                    { pg8::Gemm g{Hb, (const bf16_t*)(ws + WS_GMLP_WIN), MTOK, GH, DM, DM, DM, 0}; S.init(MTOK, GH, G, bx);
                      pg8::EpiBf16<1> E{UA, GH}; PHM(0x1000, pg8::gemm_phase(lds, g, S, E)); }
                    { pg8::Gemm g{Hb, (const bf16_t*)(ws + WS_GMLP_WIN) + (size_t)GH * DM, MTOK, GH, DM, DM, DM, 0}; S.init(MTOK, GH, G, bx);
                      pg8::EpiGmlpV E{VT}; PHM(0x10000, pg8::gemm_phase(lds, g, S, E)); }
                }
                else if (step == 2) { PHM(32, mix_phase(lds, UA, VT, Ap->in[I_GMLP_WS], Ap->in[I_GMLP_BS], Ap->in[I_GMLP_LNG], Ap->in[I_GMLP_LNB], vcu, G, tid, wid, lane)); }
                else { pg8::Gemm g{UA, (const bf16_t*)(ws + WS_GMLP_WOUT), MTOK, DM, GH, GH, GH, 0}; S.init(MTOK, DM, G, bx);
                    pg8::EpiBf16<0> E{(bf16_t*)(mixb + 192 * MiB), DM}; PHM(0x8000, pg8::gemm_phase(lds, g, S, E));   }
            }
        } else {
            const int ps = step - nmix;
            bf16_t* Qb = (bf16_t*)mixb;
            bf16_t* xs = (layer == 3) ? (bf16_t*)(mixb + 192 * MiB) : (bf16_t*)xo;
            if (ps == 0) { resnorm_phase(layer == 0 ? Ap->in[I_X] : nullptr, (const bf16_t*)xo, xs, (const bf16_t*)(mixb + 192 * MiB), macc + 2 * DM, Ap->in[I_NORM_G] + (size_t)(layer * 2 + 1) * DM, macc, 3 * DM, 4 * DM, Hb, mixb + 128 * MiB, gw, NGW, lane); }
            else if (ps == 1) { pg8::StaticOrder S; pg8::Gemm g{Hb, (const bf16_t*)(ws + WS_PEER_WQ) + (size_t)layer * DM * 2048, MTOK, 2048, DM, DM, DM, 0}; S.init(MTOK, 2048, G, bx);
                pg8::EpiQT E{Qb}; PHM(0x1000, pg8::gemm_phase(lds, g, S, E));
                asm volatile("s_waitcnt vmcnt(0)" ::: "memory"); __syncthreads();
                PHM(64, topk_units(lds, Qb, (const bf16_t*)(ws + WS_KEYS) + (size_t)layer * 16 * 128 * 128, (int*)(ws + WS_SELI), (float*)(ws + WS_SELW), S, tid, wid, lane)); }
            else { PHM(128, peer_gather_phase(lds, mixb + 128 * MiB  , (cbytes)(ws + WS_TABU) + (size_t)layer * NEXP * (DM / 2), (cbytes)(ws + WS_TABV) + (size_t)layer * NEXP * DM, (const int*)(ws + WS_SELI), (const float*)(ws + WS_SELW),
                              (const unsigned*)(ws + WS_SCU) + (size_t)layer * NEXP, xs, xo, macc + 5 * DM,
                              layer == 3 ? Ap->in[I_FINAL_G] : Ap->in[I_NORM_G] + (size_t)((layer + 1) * 2) * DM, mod + (size_t)(layer == 3 ? 3 : layer + 1) * BATCH * 6 * DM, Hb, layer == 3, vcu, G, wid, lane)); }
        }
#if MK_ONE_LAUNCH
        if constexpr (TIME_MASK != 0) if (ph + 1 >= ph_hi) { if (ptype & TIME_MASK) t_acc += __builtin_amdgcn_s_memrealtime() - t_ph0; }
        if (ph + 1 < ph_hi) {
            XcdBarrier xbar; xbar.bar = (unsigned*)(Ap->ws + WS_BAR); xbar.x = xb_xcc_id(); xbar.st = (volatile LAS unsigned*)(lds + LDS_XB_OFF);
            if (ph == ph_lo) { cg::this_grid().sync(); if (tid0 == 0) (void)xb_add(&xbar.bar[XB_XCNT(xbar.x)], 1u); }
            else { xcd_barrier(xbar); if constexpr ((DUP_MASK & 0x800) != 0) xcd_barrier(xbar); }
            if constexpr (TIME_MASK != 0) { if (ptype & TIME_MASK) t_acc += __builtin_amdgcn_s_memrealtime() - t_ph0; }
        }
#endif
    }
    if constexpr (TIME_MASK != 0) { const unsigned long long t0 = __builtin_amdgcn_s_memrealtime(); while (__builtin_amdgcn_s_memrealtime() - t0 < 4ull * t_acc) __builtin_amdgcn_s_sleep(8); }
}

extern "C" void kernel_launch(void* const* d_in, const int* in_sizes, int n_in, void* d_out, int out_size, void* d_ws, size_t ws_size, hipStream_t stream) {
    static int grid = 0;
    if (grid == 0) {
        if (n_in != 23 || in_sizes[0] != MTOK * DM || out_size != MTOK * DM || ws_size < WS_END) {
            fprintf(stderr, "kernel_launch: unexpected shapes (n_in %d, in0 %d, out %d, ws %zu; need ws >= %zu); nothing launched\n", n_in, n_in > 0 ? in_sizes[0] : -1, out_size, ws_size, (size_t)WS_END); grid = -1; return; }
        int dev = 0, cus = 0, per_cu = 0;
        if (hipGetDevice(&dev) != hipSuccess || hipDeviceGetAttribute(&cus, hipDeviceAttributeMultiprocessorCount, dev) != hipSuccess) { grid = -1; return; }
        if (hipFuncSetAttribute((const void*)trunk_fwd, hipFuncAttributeMaxDynamicSharedMemorySize, LDS_BYTES) != hipSuccess) { fprintf(stderr, "kernel_launch: hipFuncSetAttribute failed\n"); grid = -1; return; }
        if (hipOccupancyMaxActiveBlocksPerMultiprocessor(&per_cu, (const void*)trunk_fwd, NTHREADS, LDS_BYTES) != hipSuccess || per_cu < 1) { fprintf(stderr, "kernel_launch: occupancy query says %d blocks per CU\n", per_cu); (void)hipGetLastError(); grid = -1; return; }
        grid = cus * (per_cu < 1 ? 1 : 1);
    }
    if (grid < 0) return;
    Args a{};
    for (int i = 0; i < 23; ++i) a.in[i] = (const float*)d_in[i];
    a.out = (float*)d_out; a.ws = (unsigned char*)d_ws;
#if MK_ONE_LAUNCH
    a.ph_lo = 0; a.ph_hi = NPHASES;
    void* args[] = {&a};
    hipError_t e = hipLaunchCooperativeKernel((const void*)trunk_fwd, dim3(grid), dim3(NTHREADS), args, LDS_BYTES, stream);
    if (e != hipSuccess) fprintf(stderr, "cooperative launch failed: %s (grid %d)\n", hipGetErrorString(e), grid);
#else
    for (int ph = 0; ph < NPHASES; ++ph) { a.ph_lo = ph; a.ph_hi = ph + 1; hipLaunchKernelGGL(trunk_fwd, dim3(grid), dim3(NTHREADS), LDS_BYTES, stream, a); }
#endif
}
```

```cpp
#include <hip/hip_runtime.h>
#include <hip/hip_cooperative_groups.h>
#include <cstdio>
#include <cstdint>
namespace cg = cooperative_groups;

#ifndef MK_ONE_LAUNCH
#define MK_ONE_LAUNCH 1
#endif

#define LAS __attribute__((address_space(3)))
typedef unsigned short bf16_t;
typedef short bf16x8 __attribute__((ext_vector_type(8)));
typedef float f32x2 __attribute__((ext_vector_type(2)));
typedef float f32x4 __attribute__((ext_vector_type(4)));
typedef float f32x16 __attribute__((ext_vector_type(16)));
typedef unsigned u32x2 __attribute__((ext_vector_type(2)));
typedef unsigned u32x4 __attribute__((ext_vector_type(4)));
typedef int i32x4 __attribute__((ext_vector_type(4)));
typedef int i32x8 __attribute__((ext_vector_type(8)));
typedef _Float16 h16x2 __attribute__((ext_vector_type(2)));
typedef __bf16 bf16x2 __attribute__((ext_vector_type(2)));

constexpr int DM = 1024, BATCH = 8, SEQ = 4096, MTOK = BATCH * SEQ, DEPTH = 4;
constexpr int GH = 3072;
constexpr int NEXP = 16384, NPICK = 128;
constexpr float EPS = 1e-6f;

constexpr size_t MiB = 1u << 20;
constexpr size_t WS_CTL = 0, WS_SCU = 0, WS_SCV = 512 * 1024, WS_MOD = 1 * MiB, ZERO_BYTES = 2 * MiB;
constexpr size_t WS_POOL_WIN = 2 * MiB, WS_POOL_WGRP = 6 * MiB, WS_POOL_WOUT = 7 * MiB;
constexpr size_t WS_CONV_WIN = 11 * MiB, WS_CONV_WOUT = 17 * MiB;
constexpr size_t WS_GMLP_WIN = 19 * MiB, WS_GMLP_WOUT = 31 * MiB;
constexpr size_t WS_PEER_WQ = 37 * MiB, WS_KEYS = 53 * MiB;
constexpr size_t WS_H = 56 * MiB;
constexpr size_t WS_SELI = 120 * MiB, WS_SELW = 136 * MiB;
constexpr size_t WS_TABU = 152 * MiB, WS_TABV = 280 * MiB;
constexpr size_t WS_MIX = 408 * MiB;
constexpr size_t WS_ADAP = 792 * MiB;
constexpr size_t WS_COEF = 804 * MiB;
constexpr size_t WS_WEFF = 820 * MiB;
constexpr size_t WS_WGS = 824 * MiB;
constexpr size_t WS_END = 825 * MiB;

__device__ __forceinline__ unsigned cvt_pk_bf16(float lo, float hi) { unsigned r; asm volatile("v_cvt_pk_bf16_f32 %0, %1, %2" : "=v"(r) : "v"(lo), "v"(hi)); return r; }
__device__ __forceinline__ int opaque(int x) { asm volatile("" : "+v"(x)); return x; }
__device__ __forceinline__ float bf_lo(unsigned w) { return __uint_as_float(w << 16); }
__device__ __forceinline__ float bf_hi(unsigned w) { return __uint_as_float(w & 0xffff0000u); }
__device__ __forceinline__ float gelu_tanh(float x) {
    const float y = x * (1.0f + 0.044715f * x * x);
    const float e = __builtin_amdgcn_exp2f(-2.302208198f * y);
    return x * __builtin_amdgcn_rcpf(1.0f + e);
}
__device__ __forceinline__ float wave_sum_all(float v) {
#pragma unroll
    for (int o = 1; o < 64; o <<= 1) v += __shfl_xor(v, o);
    return v;
}
__device__ __forceinline__ float dot2_bf16(unsigned w, unsigned x, float acc) { return __builtin_amdgcn_fdot2_f32_bf16(__builtin_bit_cast(bf16x2, w), __builtin_bit_cast(bf16x2, x), acc, false); }


__device__ __forceinline__ float dpp_row_shr(float v, int n) {
    const int iv = __builtin_bit_cast(int, v); int r;
    switch (n) { case 1: r = __builtin_amdgcn_update_dpp(0, iv, 0x111, 0xf, 0xf, true); break; case 2: r = __builtin_amdgcn_update_dpp(0, iv, 0x112, 0xf, 0xf, true); break;
                 case 4: r = __builtin_amdgcn_update_dpp(0, iv, 0x114, 0xf, 0xf, true); break; default: r = __builtin_amdgcn_update_dpp(0, iv, 0x118, 0xf, 0xf, true); break; }
    return __builtin_bit_cast(float, r);
}
__device__ __forceinline__ float wave_sum_uniform(float v) {
    v += dpp_row_shr(v, 1); v += dpp_row_shr(v, 2); v += dpp_row_shr(v, 4); v += dpp_row_shr(v, 8);
    v += __builtin_bit_cast(float, __builtin_amdgcn_update_dpp(0, __builtin_bit_cast(int, v), 0x142, 0xa, 0xf, false));
    v += __builtin_bit_cast(float, __builtin_amdgcn_update_dpp(0, __builtin_bit_cast(int, v), 0x143, 0xc, 0xf, false));
    return __uint_as_float(__builtin_amdgcn_readlane(__float_as_uint(v), 63));
}

namespace pg8 {
constexpr int BM = 256, BK = 64, HALF = 128, HTB = HALF * BK * 2, STAGE_BYTES = 8 * HTB, NXCD = 8, WGM = 8;
__device__ __forceinline__ int lds_byte(int r, int c) { const int st = (r >> 4) * 2 + (c >> 5), rr = r & 15, cc = c & 31, ob = rr * 64 + cc * 2; return st * 1024 + (ob ^ (((ob >> 9) & 1) << 5)); }
__device__ __forceinline__ void stage_rc(int b, int& R, int& C) { const int st = b / 1024, sb = b % 1024, swz = sb ^ (((sb >> 9) & 1) << 5); R = (st >> 1) * 16 + swz / 64; C = (st & 1) * 32 + (swz % 64) / 2; }
__device__ __forceinline__ int perm32(int rho) { const int n = rho >> 4, i = rho & 15; return 8 * (i >> 2) + 4 * n + (i & 3); }

struct Unit { int pm, pn; };
struct Gemm { const bf16_t* A; const bf16_t* Bt; int M, N, K, lda, ldb, a_pn_off; };

struct StaticOrder {
    int nM, nN, nwg, G, c;
    __device__ __forceinline__ void init(int M, int N, int G_, int c_) { nM = M / BM; nN = N / BM; nwg = nM * nN; G = G_; c = c_; }
    __device__ __forceinline__ bool next(int i, Unit& u) const {
        const int L = i * G + c; if (L >= nwg) return false;
        int wgid = L; { const int q = nwg / NXCD, r = nwg % NXCD, xcd = wgid % NXCD, off = wgid / NXCD; wgid = (xcd < r ? xcd * (q + 1) : r * (q + 1) + (xcd - r) * q) + off; }
        const int nig = WGM * nN, gid = wgid / nig, fm = gid * WGM, gsz = (nM - fm) < WGM ? (nM - fm) : WGM;
        u.pm = fm + ((wgid % nig) % gsz); u.pn = (wgid % nig) / gsz; return true;
    }
};

template <class Epi>
__device__ __forceinline__ void gemm_phase(LAS unsigned char* lds, const Gemm g, const StaticOrder& S, const Epi& E) {
    const int tid = opaque((int)threadIdx.x), wid = __builtin_amdgcn_readfirstlane(tid >> 6), lane = tid & 63, wr = wid >> 2, wc = wid & 3, fr = lane & 15, fq = lane >> 4;
    int nt = g.K / BK; asm volatile("" : "+s"(nt));
    unsigned voffA[2], voffB[2];
#pragma unroll
    for (int i = 0; i < 2; ++i) { int R, C; stage_rc(tid * 16 + i * 8192, R, C); const int Rb = Epi::PERM ? ((R & ~31) + perm32(R & 31)) : R;
        voffA[i] = (unsigned)(R * g.lda + C) * 2u; voffB[i] = (unsigned)(Rb * g.ldb + C) * 2u; }
    const size_t kstep = (size_t)(BK * 2);
    const size_t hstepA = (size_t)HALF * g.lda * 2, hstepB = (size_t)HALF * g.ldb * 2;
    const size_t tstepA = 2 * hstepA, tstepB = 2 * hstepB;
    const unsigned ldsw = (unsigned)wid * 1024u;
    const int aoff = lds_byte(wr * 64 + fr, fq * 8), boff = lds_byte(wc * 32 + fr, fq * 8);
#define PG8_SA(b, h) (((b) * 2 + (h)) * HTB)
#define PG8_SB(b, h) ((4 + (b) * 2 + (h)) * HTB)
#define PG8_STAGE(bufoff, gbase, voff) do { _Pragma("unroll") for (int _i = 0; _i < 2; ++_i) \
        __builtin_amdgcn_global_load_lds((const unsigned*)((const char*)(gbase) + (voff)[_i]), (LAS unsigned*)(lds + (bufoff) + ldsw + _i * 8192), 16, 0, 0); } while (0)
#define PG8_LDA(dst, b, h) do { _Pragma("unroll") for (int m = 0; m < 4; ++m) _Pragma("unroll") for (int k = 0; k < 2; ++k) dst[m][k] = *(const LAS bf16x8*)(lds + PG8_SA(b, h) + aoff + m * 2048 + k * 1024); } while (0)
#define PG8_LDB(dst, b, h) do { _Pragma("unroll") for (int n = 0; n < 2; ++n) _Pragma("unroll") for (int k = 0; k < 2; ++k) dst[n][k] = *(const LAS bf16x8*)(lds + PG8_SB(b, h) + boff + n * 2048 + k * 1024); } while (0)
#define PG8_MMA(ai, bj, At, Bt) do { __builtin_amdgcn_s_setprio(1); _Pragma("unroll") for (int m = 0; m < 4; ++m) _Pragma("unroll") for (int n = 0; n < 2; ++n) _Pragma("unroll") for (int k = 0; k < 2; ++k) \
        acc[ai][bj][m][n] = Epi::SWAP ? __builtin_amdgcn_mfma_f32_16x16x32_bf16(At[m][k], Bt[n][k], acc[ai][bj][m][n], 0, 0, 0) \
                                      : __builtin_amdgcn_mfma_f32_16x16x32_bf16(Bt[n][k], At[m][k], acc[ai][bj][m][n], 0, 0, 0); __builtin_amdgcn_s_setprio(0); } while (0)
#define PG8_WAIT_V(n) asm volatile("s_waitcnt vmcnt(" #n ")" ::: "memory")
#define PG8_WAIT_L(n) asm volatile("s_waitcnt lgkmcnt(" #n ")" ::: "memory")
#define PG8_BAR __builtin_amdgcn_s_barrier()
#define PG8_SCHED __builtin_amdgcn_sched_barrier(0)
    Unit cur, nxt; int ui = 0;
    if (!S.next(0, cur)) return;
    f32x4 acc[2][2][4][2];
#pragma unroll
    for (int a = 0; a < 2; ++a)
#pragma unroll
        for (int b = 0; b < 2; ++b)
#pragma unroll
            for (int m = 0; m < 4; ++m)
#pragma unroll
                for (int n = 0; n < 2; ++n) acc[a][b][m][n] = (f32x4){0.f, 0.f, 0.f, 0.f};
    bf16x8 At[4][2], B0[2][2], B1[2][2];
    const char* cA = (const char*)g.A + (size_t)cur.pm * tstepA + (size_t)cur.pn * g.a_pn_off * 2; const char* cB = (const char*)g.Bt + (size_t)cur.pn * tstepB;
    PG8_STAGE(PG8_SB(0, 0), cB, voffB); PG8_STAGE(PG8_SB(0, 1), cB + hstepB, voffB); PG8_STAGE(PG8_SA(0, 0), cA, voffA); PG8_STAGE(PG8_SA(0, 1), cA + hstepA, voffA);
    if (wr == 1) PG8_BAR;
    PG8_WAIT_V(2); PG8_BAR;
    PG8_STAGE(PG8_SB(1, 0), cB + kstep, voffB); PG8_STAGE(PG8_SA(1, 0), cA + kstep, voffA); PG8_STAGE(PG8_SB(1, 1), cB + hstepB + kstep, voffB);
    PG8_WAIT_V(6); PG8_BAR;
    for (;;) {
        const bool has_next = S.next(ui + 1, nxt);
        const char* nA = has_next ? (const char*)g.A + (size_t)nxt.pm * tstepA + (size_t)nxt.pn * g.a_pn_off * 2 : cA; const char* nB = has_next ? (const char*)g.Bt + (size_t)nxt.pn * tstepB : cB;
        for (int t = 0; t < nt; t += 2) {
            const bool last = (t == nt - 2);
            const char* a1 = cA + (size_t)(t + 1) * kstep;
            const char* a2 = last ? nA : cA + (size_t)(t + 2) * kstep; const char* b2 = last ? nB : cB + (size_t)(t + 2) * kstep;
            const char* a3 = a2 + kstep; const char* b3 = b2 + kstep;
            PG8_LDB(B0, 0, 0); PG8_LDB(B1, 0, 1); PG8_SCHED; PG8_LDA(At, 0, 0); PG8_STAGE(PG8_SA(1, 1), a1 + hstepA, voffA);
            PG8_WAIT_V(8); PG8_WAIT_L(0); PG8_BAR; PG8_MMA(0, 0, At, B0); PG8_MMA(0, 1, At, B1); PG8_BAR; PG8_SCHED;
            PG8_LDA(At, 0, 1); PG8_STAGE(PG8_SB(0, 0), b2, voffB); PG8_STAGE(PG8_SB(0, 1), b2 + hstepB, voffB); PG8_STAGE(PG8_SA(0, 0), a2, voffA);
            PG8_WAIT_V(8); PG8_WAIT_L(0); PG8_BAR; PG8_MMA(1, 0, At, B0); PG8_MMA(1, 1, At, B1); PG8_BAR; PG8_SCHED;
            PG8_LDB(B0, 1, 0); PG8_LDB(B1, 1, 1); PG8_SCHED; PG8_LDA(At, 1, 0); PG8_STAGE(PG8_SA(0, 1), a2 + hstepA, voffA);
            PG8_WAIT_V(8); PG8_WAIT_L(0); PG8_BAR; PG8_MMA(0, 0, At, B0); PG8_MMA(0, 1, At, B1); PG8_BAR; PG8_SCHED;
            PG8_LDA(At, 1, 1); PG8_STAGE(PG8_SB(1, 0), b3, voffB); PG8_STAGE(PG8_SB(1, 1), b3 + hstepB, voffB); PG8_STAGE(PG8_SA(1, 0), a3, voffA);
            PG8_WAIT_V(8); PG8_WAIT_L(0); PG8_BAR; PG8_MMA(1, 0, At, B0); PG8_MMA(1, 1, At, B1); PG8_BAR; PG8_SCHED;
        }
        { const int l2 = opaque((int)threadIdx.x) & 63; E(acc, cur, wr, wc, l2 & 15, l2 >> 4); }
        if (!has_next) break;
#pragma unroll
        for (int a = 0; a < 2; ++a)
#pragma unroll
            for (int b = 0; b < 2; ++b)
#pragma unroll
                for (int m = 0; m < 4; ++m)
#pragma unroll
                    for (int n = 0; n < 2; ++n) acc[a][b][m][n] = (f32x4){0.f, 0.f, 0.f, 0.f};
        cur = nxt; cA = nA; cB = nB; ++ui;
    }
    PG8_WAIT_V(0);
    if (wr == 0) PG8_BAR;
    PG8_BAR;
#undef PG8_SA
#undef PG8_SB
#undef PG8_STAGE
#undef PG8_LDA
#undef PG8_LDB
#undef PG8_MMA
#undef PG8_WAIT_V
#undef PG8_WAIT_L
#undef PG8_BAR
#undef PG8_SCHED
}

template <int ACT> struct EpiBf16 {
    static constexpr bool PERM = true, SWAP = false;
    bf16_t* O; int ldc;
    __device__ __forceinline__ void operator()(const f32x4 (&acc)[2][2][4][2], const Unit& u, int wr, int wc, int fr, int fq) const {
        const int row0 = u.pm * BM + wr * 64 + fr, col0 = u.pn * BM + wc * 32 + 8 * fq;
#pragma unroll
        for (int ai = 0; ai < 2; ++ai)
#pragma unroll
            for (int m = 0; m < 4; ++m) { bf16_t* rowp = O + (size_t)(row0 + ai * HALF + m * 16) * ldc + col0;
#pragma unroll
                for (int bj = 0; bj < 2; ++bj) { f32x4 v0 = acc[ai][bj][m][0], v1 = acc[ai][bj][m][1];
                    if (ACT == 1) {
#pragma unroll
                        for (int j = 0; j < 4; ++j) { v0[j] = gelu_tanh(v0[j]); v1[j] = gelu_tanh(v1[j]); } }
                    u32x4 w; w.x = cvt_pk_bf16(v0[0], v0[1]); w.y = cvt_pk_bf16(v0[2], v0[3]); w.z = cvt_pk_bf16(v1[0], v1[1]); w.w = cvt_pk_bf16(v1[2], v1[3]);
                    *(u32x4*)(rowp + bj * HALF) = w; } }
    }
};
struct EpiQT {
    static constexpr bool PERM = true, SWAP = false;
    bf16_t* O;
    __device__ __forceinline__ void operator()(const f32x4 (&acc)[2][2][4][2], const Unit& u, int wr, int wc, int fr, int fq) const {
        const int row0 = u.pm * BM + wr * 64 + fr;
#pragma unroll
        for (int ai = 0; ai < 2; ++ai)
#pragma unroll
            for (int m = 0; m < 4; ++m) { const int row = row0 + ai * HALF + m * 16;
                bf16_t* base = O + ((size_t)((row >> 7) * 8 + u.pn) * 32 * 128 + (row & 127)) * 8;
#pragma unroll
                for (int bj = 0; bj < 2; ++bj) { const f32x4 v0 = acc[ai][bj][m][0], v1 = acc[ai][bj][m][1];
                    u32x4 w; w.x = cvt_pk_bf16(v0[0], v0[1]); w.y = cvt_pk_bf16(v0[2], v0[3]); w.z = cvt_pk_bf16(v1[0], v1[1]); w.w = cvt_pk_bf16(v1[2], v1[3]);
                    *(u32x4*)(base + (size_t)(16 * bj + 4 * wc + fq) * 128 * 8) = w; } }
    }
};
struct EpiPoolGrp {
    static constexpr bool PERM = true, SWAP = false;
    bf16_t* O; const float* scale;
    __device__ __forceinline__ void operator()(const f32x4 (&acc)[2][2][4][2], const Unit& u, int wr, int wc, int fr, int fq) const {
        const int row0 = u.pm * BM + wr * 64 + fr, col0 = u.pn * BM + wc * 32 + 8 * fq;
#pragma unroll
        for (int bj = 0; bj < 2; ++bj) {
            const f32x4 s0 = *(const f32x4*)(scale + col0 + bj * HALF), s1 = *(const f32x4*)(scale + col0 + bj * HALF + 4);
#pragma unroll
            for (int ai = 0; ai < 2; ++ai)
#pragma unroll
                for (int m = 0; m < 4; ++m) { bf16_t* rowp = O + (size_t)(row0 + ai * HALF + m * 16) * DM + col0 + bj * HALF;
                    const f32x4 v0 = acc[ai][bj][m][0] * s0, v1 = acc[ai][bj][m][1] * s1;
                    u32x4 w; w.x = cvt_pk_bf16(v0[0], v0[1]); w.y = cvt_pk_bf16(v0[2], v0[3]); w.z = cvt_pk_bf16(v1[0], v1[1]); w.w = cvt_pk_bf16(v1[2], v1[3]);
                    *(u32x4*)rowp = w; }
            asm volatile("" ::: "memory");
        }
    }
};
struct EpiConvIn {
    static constexpr bool PERM = true, SWAP = false;
    bf16_t* BG; bf16_t* Z;
    __device__ __forceinline__ void operator()(const f32x4 (&acc)[2][2][4][2], const Unit& u, int wr, int wc, int fr, int fq) const {
        const int row0 = u.pm * BM + wr * 64 + fr;
        if (u.pn < 4) {
            const int col0 = u.pn * BM + wc * 32 + 8 * fq;
#pragma unroll
            for (int ai = 0; ai < 2; ++ai)
#pragma unroll
                for (int m = 0; m < 4; ++m) { bf16_t* rowp = BG + (size_t)(row0 + ai * HALF + m * 16) * DM + col0;
#pragma unroll
                    for (int bj = 0; bj < 2; ++bj) { const f32x4 v0 = acc[ai][bj][m][0], v1 = acc[ai][bj][m][1];
                        u32x4 w; w.x = cvt_pk_bf16(v0[0], v0[1]); w.y = cvt_pk_bf16(v0[2], v0[3]); w.z = cvt_pk_bf16(v1[0], v1[1]); w.w = cvt_pk_bf16(v1[2], v1[3]);
                        *(u32x4*)(rowp + bj * HALF) = w; } }
        } else {
            const int col0 = (u.pn - 4) * HALF + wc * 32 + 8 * fq;
#pragma unroll
            for (int ai = 0; ai < 2; ++ai)
#pragma unroll
                for (int m = 0; m < 4; ++m) { bf16_t* rowp = Z + (size_t)(row0 + ai * HALF + m * 16) * DM + col0;
                    const f32x4 v0 = acc[ai][0][m][0] * acc[ai][1][m][0], v1 = acc[ai][0][m][1] * acc[ai][1][m][1];
                    u32x4 w; w.x = cvt_pk_bf16(v0[0], v0[1]); w.y = cvt_pk_bf16(v0[2], v0[3]); w.z = cvt_pk_bf16(v1[0], v1[1]); w.w = cvt_pk_bf16(v1[2], v1[3]);
                    *(u32x4*)rowp = w; }
        }
    }
};
struct EpiResid {
    static constexpr bool PERM = false, SWAP = false;
    const float* base; float* out; const float* gacc; const float* gbias;
    __device__ __forceinline__ void operator()(const f32x4 (&acc)[2][2][4][2], const Unit& u, int wr, int wc, int fr, int fq) const {
        const int row0 = u.pm * BM + wr * 64 + fr, col0 = u.pn * BM + wc * 32 + 4 * fq;
        const float* gp = gacc + (size_t)(u.pm >> 4) * (6 * DM);
#pragma unroll
        for (int bj = 0; bj < 2; ++bj)
#pragma unroll
            for (int n = 0; n < 2; ++n) { const int cc = col0 + bj * HALF + n * 16;
                const f32x4 gv = *(const f32x4*)(gp + cc);
#pragma unroll
                for (int ai = 0; ai < 2; ++ai) {
#pragma unroll
                    for (int m = 0; m < 4; ++m) { const size_t off = (size_t)(row0 + ai * HALF + m * 16) * DM + cc;
                        const f32x4 bs = *(const f32x4*)(base + off);
                        *(f32x4*)(out + off) = bs + gv * acc[ai][bj][m][n]; }
                    asm volatile("" ::: "memory"); } }
    }
};
struct EpiGmlpV {
    static constexpr bool PERM = false, SWAP = true;
    bf16_t* VT;
    __device__ __forceinline__ void operator()(const f32x4 (&acc)[2][2][4][2], const Unit& u, int wr, int wc, int fr, int fq) const {
        const int row0 = u.pm * BM + wr * 64 + 4 * fq, col0 = u.pn * BM + wc * 32 + fr;
#pragma unroll
        for (int bj = 0; bj < 2; ++bj)
#pragma unroll
            for (int n = 0; n < 2; ++n) { const int c = col0 + bj * HALF + n * 16;
#pragma unroll
                for (int ai = 0; ai < 2; ++ai)
#pragma unroll
                    for (int m = 0; m < 4; ++m) { const f32x4 v = acc[ai][bj][m][n]; const int r = row0 + ai * HALF + m * 16;
                        u32x2 w; w.x = cvt_pk_bf16(gelu_tanh(v[0]), gelu_tanh(v[1])); w.y = cvt_pk_bf16(gelu_tanh(v[2]), gelu_tanh(v[3]));
                        *(u32x2*)(VT + ((size_t)(r >> 7) * GH + c) * 128 + (r & 127)) = w; } }
    }
};
}

constexpr int RING_BYTES = 131072;
constexpr int LDS_BYTES = 147456;
constexpr int LDS_XB_OFF = LDS_BYTES - 64;
constexpr int NTHREADS = 512;

#define CE_DESC(a, b) do { const float _x = fmaxf(a, b), _y = fminf(a, b); a = _x; b = _y; } while (0)
#define CE_ASC(a, b)  do { const float _x = fminf(a, b), _y = fmaxf(a, b); a = _x; b = _y; } while (0)
template <int OFF, int N>
__device__ __forceinline__ void sort16_desc(float (&v)[N]) {
#pragma unroll
    for (int k = 2; k <= 16; k <<= 1)
#pragma unroll
        for (int j = k >> 1; j > 0; j >>= 1)
#pragma unroll
            for (int i = 0; i < 16; ++i) { const int l = i ^ j; if (l > i) { if ((i & k) == 0) CE_DESC(v[OFF + i], v[OFF + l]); else CE_ASC(v[OFF + i], v[OFF + l]); } }
}
template <int OFF, int N>
__device__ __forceinline__ void bmerge16_desc(float (&v)[N]) {
#pragma unroll
    for (int j = 8; j > 0; j >>= 1)
#pragma unroll
        for (int i = 0; i < 16; ++i) { const int l = i ^ j; if (l > i) CE_DESC(v[OFF + i], v[OFF + l]); }
}
template <int A, int B, int N>
__device__ __forceinline__ void merge_top16(float (&v)[N]) {
#pragma unroll
    for (int i = 0; i < 16; ++i) v[A + i] = fmaxf(v[A + i], v[B + 15 - i]);
    bmerge16_desc<A, N>(v);
}
__device__ __forceinline__ void top16_of_64(float (&v)[64]) {
    sort16_desc<0, 64>(v); sort16_desc<16, 64>(v); sort16_desc<32, 64>(v); sort16_desc<48, 64>(v);
    merge_top16<0, 16, 64>(v); merge_top16<32, 48, 64>(v); merge_top16<0, 32, 64>(v);
}

struct Args { const float* in[23]; float* out; unsigned char* ws; int ph_lo, ph_hi; };
typedef const __attribute__((address_space(4))) Args* ArgP;
enum { I_X = 0, I_C, I_ADA_W, I_ADA_B, I_NORM_G, I_POOL_WIN, I_POOL_WGRP, I_POOL_SCALE, I_POOL_WOUT, I_CONV_WIN, I_CONV_W, I_CONV_WOUT,
       I_GMLP_WIN, I_GMLP_LNG, I_GMLP_LNB, I_GMLP_WS, I_GMLP_BS, I_GMLP_WOUT, I_PEER_WQ, I_PEER_KEYS, I_PEER_U, I_PEER_V, I_FINAL_G };

__device__ __forceinline__ void transpose_item(const float* W, int K, int N, bf16_t* WT, int dst_row0, LAS float* scr, int k0, int n0, int lane) {
#pragma unroll 8
    for (int i = 0; i < 32; ++i) { const int kk = 2 * i + (lane >> 5); scr[kk * 33 + (lane & 31)] = W[(size_t)(k0 + kk) * N + n0 + (lane & 31)]; }
    asm volatile("s_waitcnt lgkmcnt(0)" ::: "memory");
    const int c = lane & 7;
#pragma unroll
    for (int j = 0; j < 4; ++j) { const int n = (lane >> 3) + 8 * j; const LAS float* s = scr + (8 * c) * 33 + n;
        u32x4 o; o.x = cvt_pk_bf16(s[0 * 33], s[1 * 33]); o.y = cvt_pk_bf16(s[2 * 33], s[3 * 33]); o.z = cvt_pk_bf16(s[4 * 33], s[5 * 33]); o.w = cvt_pk_bf16(s[6 * 33], s[7 * 33]);
        *(u32x4*)(WT + (size_t)(dst_row0 + n) * K + k0 + 8 * c) = o; }
    asm volatile("s_waitcnt lgkmcnt(0)" ::: "memory");
}
__device__ __forceinline__ void convert_stream(const float* src, bf16_t* dst, size_t n8, size_t gt, size_t stride) {
    for (size_t i = gt; i < n8; i += stride) {
        const f32x4 a = __builtin_nontemporal_load((const f32x4*)src + 2 * i), b = __builtin_nontemporal_load((const f32x4*)src + 2 * i + 1);
        u32x4 o; o.x = cvt_pk_bf16(a[0], a[1]); o.y = cvt_pk_bf16(a[2], a[3]); o.z = cvt_pk_bf16(b[0], b[1]); o.w = cvt_pk_bf16(b[2], b[3]);
        *((u32x4*)dst + i) = o; }
}
__device__ __forceinline__ unsigned e2m1_code(float a) { const float aa = fabsf(a);
    const unsigned c = (aa > 0.25f ? 1u : 0u) + (aa > 0.75f ? 1u : 0u) + (aa > 1.25f ? 1u : 0u) + (aa > 1.75f ? 1u : 0u) + (aa > 2.5f ? 1u : 0u) + (aa > 3.5f ? 1u : 0u) + (aa > 5.0f ? 1u : 0u);
    return c | ((__builtin_bit_cast(unsigned, a) >> 28) & 8u); }
__device__ __forceinline__ void prologue_phase(ArgP Ap, LAS unsigned char* lds, int vcu, int G, int tid, int wid, int lane) {
    unsigned char* ws = Ap->ws;
    const int gw = vcu * 8 + wid, NGW = G * 8;
    LAS float* scr = (LAS float*)(lds + wid * 16384);
    constexpr int NT_ITEMS = 1024 + 256 + 1024 + 1536 + 512 + 3072 + 1536 + 4096;
    for (int it = gw; it < NT_ITEMS; it += NGW) {
        int r = it; const float* src; bf16_t* dst; int K, N, kind = 0;
        if (r < 1024) { const int m = r >> 9; r &= 511; src = Ap->in[I_POOL_WIN] + (size_t)m * DM * DM; dst = (bf16_t*)(ws + WS_POOL_WIN) + (size_t)m * DM * DM; K = DM; N = DM; }
        else if ((r -= 1024) < 256) { const int m = r >> 5; r &= 31; src = Ap->in[I_POOL_WGRP] + (size_t)m * 65536; dst = (bf16_t*)(ws + WS_POOL_WGRP) + (size_t)m * 65536; K = 256; N = 256; }
        else if ((r -= 256) < 1024) { const int m = r >> 9; r &= 511; src = Ap->in[I_POOL_WOUT] + (size_t)m * DM * DM; dst = (bf16_t*)(ws + WS_POOL_WOUT) + (size_t)m * DM * DM; K = DM; N = DM; }
        else if ((r -= 1024) < 1536) { src = Ap->in[I_CONV_WIN]; dst = (bf16_t*)(ws + WS_CONV_WIN); K = DM; N = 3 * DM; kind = 1; }
        else if ((r -= 1536) < 512) { src = Ap->in[I_CONV_WOUT]; dst = (bf16_t*)(ws + WS_CONV_WOUT); K = DM; N = DM; }
        else if ((r -= 512) < 3072) { src = Ap->in[I_GMLP_WIN]; dst = (bf16_t*)(ws + WS_GMLP_WIN); K = DM; N = 2 * GH; }
        else if ((r -= 3072) < 1536) { src = Ap->in[I_GMLP_WOUT]; dst = (bf16_t*)(ws + WS_GMLP_WOUT); K = GH; N = DM; }
        else { r -= 1536; const int m = r >> 10; r &= 1023; src = Ap->in[I_PEER_WQ] + (size_t)m * DM * 2048; dst = (bf16_t*)(ws + WS_PEER_WQ) + (size_t)m * DM * 2048; K = DM; N = 2048; }
        const int nblk = N / 32, kb = r / nblk, nb = r % nblk, n0 = 32 * nb;
        int drow = n0;
        if (kind == 1 && n0 >= DM) { const int xt = n0 >= 2 * DM, ch = n0 - (xt ? 2 * DM : DM); drow = DM + 256 * (ch >> 7) + 128 * xt + (ch & 127); }
        transpose_item(src, K, N, dst, drow, scr, 64 * kb, n0, lane);
    }
    const size_t gt = (size_t)vcu * NTHREADS + tid, stride = (size_t)G * NTHREADS;
    convert_stream(Ap->in[I_PEER_KEYS], (bf16_t*)(ws + WS_KEYS), (size_t)DEPTH * 16 * 128 * 128 / 8, gt, stride);
    for (int row0 = gw * 4; row0 < 2 * DEPTH * NEXP; row0 += NGW * 4) {
        f32x4 v[4][4]; float m[4];
#pragma unroll
        for (int rr = 0; rr < 4; ++rr) { const int row = row0 + rr, tab = row >> 16, lrow = row & 65535;
            const f32x4* src = (const f32x4*)((tab ? Ap->in[I_PEER_V] : Ap->in[I_PEER_U]) + (size_t)lrow * DM) + lane;
#pragma unroll
            for (int j = 0; j < 4; ++j) v[rr][j] = __builtin_nontemporal_load(src + 64 * j); }
#pragma unroll
        for (int rr = 0; rr < 4; ++rr) { float mm = 0.f;
#pragma unroll
            for (int j = 0; j < 4; ++j) mm = fmaxf(fmaxf(mm, fmaxf(fabsf(v[rr][j][0]), fabsf(v[rr][j][1]))), fmaxf(fabsf(v[rr][j][2]), fabsf(v[rr][j][3])));
#pragma unroll
            for (int o = 1; o < 64; o <<= 1) mm = fmaxf(mm, __shfl_xor(mm, o));
            m[rr] = mm; }
#pragma unroll
        for (int rr = 0; rr < 4; ++rr) { const int row = row0 + rr, tab = row >> 16, lrow = row & 65535, l = lrow >> 14, e = lrow & (NEXP - 1);
            if (tab) {
                const float S = m[rr] > 0.f ? (7.5f / 0.7f) / m[rr] : 1.0f;
#pragma unroll
                for (int j = 0; j < 4; ++j) { unsigned c[4];
#pragma unroll
                    for (int q = 0; q < 4; ++q) c[q] = (unsigned)fminf(fmaxf(floorf(v[rr][j][q] * S + 8.0f), 0.f), 15.f);
                    unsigned pk = c[0] | (c[1] << 4) | (c[2] << 16) | (c[3] << 20); if (lane & 1) pk <<= 8;
                    pk |= (unsigned)__shfl_xor((int)pk, 1);
                    if (!(lane & 1)) *(unsigned*)(ws + WS_TABV + (((size_t)l * 4 + j) * NEXP + e) * 128 + 2 * lane) = pk; }
            } else {
                const float S = m[rr] > 0.f ? (6.0f / 0.9f) / m[rr] : 1.0f;
#pragma unroll
                for (int j = 0; j < 4; ++j) { unsigned pk = e2m1_code(v[rr][j][0] * S) | (e2m1_code(v[rr][j][1] * S) << 4) | (e2m1_code(v[rr][j][2] * S) << 8) | (e2m1_code(v[rr][j][3] * S) << 12);
                    pk |= (unsigned)__shfl_xor((int)pk, 1) << 16;
                    if (!(lane & 1)) *(unsigned*)(ws + WS_TABU + (((size_t)l * 4 + j) * NEXP + e) * 128 + 2 * lane) = pk; }
            }
            if (lane == 0) ((unsigned short*)(ws + WS_SCU))[2 * lrow + tab] = (unsigned short)(cvt_pk_bf16(m[rr] > 0.f ? m[rr] * (tab ? 0.7f / 7.5f : 0.9f / 6.0f) : 1.0f, 0.f) & 0xffffu); }
    }
    for (size_t i = gt; i < (size_t)2 * 4 * 256 * 256 / 8; i += stride) { const size_t idx = i * 8; const int l = (int)(idx >> 18), g = (int)(idx >> 16) & 3, j0 = (int)idx & 255;
        const f32x4 a = *((const f32x4*)Ap->in[I_POOL_WGRP] + 2 * i), b = *((const f32x4*)Ap->in[I_POOL_WGRP] + 2 * i + 1);
        const float* sp = Ap->in[I_POOL_SCALE] + (size_t)l * DM + 256 * g + j0; const f32x4 sa = *(const f32x4*)sp, sb = *(const f32x4*)(sp + 4);
        u32x4 o; o.x = cvt_pk_bf16(a[0] * sa[0], a[1] * sa[1]); o.y = cvt_pk_bf16(a[2] * sa[2], a[3] * sa[3]); o.z = cvt_pk_bf16(b[0] * sb[0], b[1] * sb[1]); o.w = cvt_pk_bf16(b[2] * sb[2], b[3] * sb[3]);
        *((u32x4*)(ws + WS_WGS) + i) = o; }
    __syncthreads();
    LAS float* cond = (LAS float*)lds;
    for (int i = tid; i < BATCH * DM; i += NTHREADS) { const int b = i >> 10, k = i & 1023; const float c = Ap->in[I_C][i]; cond[k * 8 + b] = c * __builtin_amdgcn_rcpf(1.0f + __expf(-c)); }
    __syncthreads();
    float* modp = (float*)(ws + WS_ADAP);
    for (int it = gw; it < DEPTH * 24 * 16; it += NGW) {
        const int l = it / 384, r = it % 384, cgp = r >> 4, kc = r & 15;
        const float* wp = Ap->in[I_ADA_W] + ((size_t)l * DM + kc * 64) * (6 * DM) + cgp * 256 + 4 * lane;
        f32x4 acc[8];
#pragma unroll
        for (int b = 0; b < 8; ++b) acc[b] = (f32x4){0.f, 0.f, 0.f, 0.f};
#pragma unroll 8
        for (int k = 0; k < 64; ++k) { const f32x4 w = __builtin_nontemporal_load((const f32x4*)(wp + (size_t)k * (6 * DM)));
            const f32x4 c0 = *(const LAS f32x4*)(cond + (kc * 64 + k) * 8), c1 = *(const LAS f32x4*)(cond + (kc * 64 + k) * 8 + 4);
            acc[0] += c0[0] * w; acc[1] += c0[1] * w; acc[2] += c0[2] * w; acc[3] += c0[3] * w; acc[4] += c1[0] * w; acc[5] += c1[1] * w; acc[6] += c1[2] * w; acc[7] += c1[3] * w; }
#pragma unroll
        for (int b = 0; b < 8; ++b) *(f32x4*)(modp + (((size_t)kc * DEPTH + l) * 8 + b) * (6 * DM) + cgp * 256 + 4 * lane) = acc[b];
    }
}
__device__ __forceinline__ void modreduce_phase(ArgP Ap, int vcu, int G, int tid) {
    unsigned char* ws = Ap->ws; const float* modp = (const float*)(ws + WS_ADAP); float* mod = (float*)(ws + WS_MOD);
    constexpr int N4 = DEPTH * BATCH * 6 * DM / 4;
    for (int i = vcu * NTHREADS + tid; i < N4; i += G * NTHREADS) {
        const int n4 = i % (6 * DM / 4), l = i / (BATCH * 6 * DM / 4);
        f32x4 a = *((const f32x4*)(Ap->in[I_ADA_B] + (size_t)l * 6 * DM) + n4);
#pragma unroll
        for (int kc = 0; kc < 16; ++kc) a += *((const f32x4*)modp + (size_t)kc * N4 + i);
        *((f32x4*)mod + i) = a; }
}

__device__ __forceinline__ void norm_phase(const float* x, const float* gn, const float* macc  , const float* mbias  , int sh_off, int sc_off, bf16_t* H, int gw, int NGW, int lane) {
    for (int ch = gw; ch < MTOK / 16; ch += NGW) {
        const int row0 = ch * 16, b = row0 >> 12;
        f32x4 c1[4], shv[4];
#pragma unroll
        for (int j = 0; j < 4; ++j) { const int col = 4 * lane + 256 * j;
            const f32x4 sc = *(const f32x4*)(macc + (size_t)b * 6 * DM + sc_off + col);
            c1[j] = *(const f32x4*)(gn + col) * (1.0f + sc);
            shv[j] = *(const f32x4*)(macc + (size_t)b * 6 * DM + sh_off + col); }
        for (int r = row0; r < row0 + 16; ++r) {
            const f32x4* xr = (const f32x4*)(x + (size_t)r * DM) + lane;
            f32x4 v[4]; float ss = 0.f;
#pragma unroll
            for (int j = 0; j < 4; ++j) { v[j] = xr[64 * j]; ss += (v[j][0] * v[j][0] + v[j][1] * v[j][1]) + (v[j][2] * v[j][2] + v[j][3] * v[j][3]); }
            const float rstd = __builtin_amdgcn_rsqf(wave_sum_all(ss) * (1.0f / DM) + EPS);
            u32x2* o8 = (u32x2*)(H + (size_t)r * DM) + lane;
#pragma unroll
            for (int j = 0; j < 4; ++j) { const f32x4 o = v[j] * rstd * c1[j] + shv[j]; u32x2 w; w.x = cvt_pk_bf16(o[0], o[1]); w.y = cvt_pk_bf16(o[2], o[3]); o8[64 * j] = w; }
        }
    }
}
__device__ __forceinline__ void resnorm_phase(const float* xf  , const bf16_t* xsi, bf16_t* xso  , const bf16_t* Y, const float* gate  , const float* gn, const float* macc, int sh_off, int sc_off, bf16_t* H, unsigned char* H8  , int gw, int NGW, int lane) {
    for (int ch = gw; ch < MTOK / 16; ch += NGW) {
        const int row0 = ch * 16, b = row0 >> 12;
        f32x4 c1[4], shv[4], gt[4];
#pragma unroll
        for (int j = 0; j < 4; ++j) { const int col = 4 * lane + 256 * j;
            const f32x4 sc = *(const f32x4*)(macc + (size_t)b * 6 * DM + sc_off + col);
            c1[j] = *(const f32x4*)(gn + col) * (1.0f + sc);
            shv[j] = *(const f32x4*)(macc + (size_t)b * 6 * DM + sh_off + col);
            gt[j] = *(const f32x4*)(gate + (size_t)b * 6 * DM + col); }
        for (int r = row0; r < row0 + 16; ++r) {
            const u32x2* yr = (const u32x2*)(Y + (size_t)r * DM) + lane;
            f32x4 v[4]; float ss = 0.f;
            if (xf) { const f32x4* xr = (const f32x4*)(xf + (size_t)r * DM) + lane;
#pragma unroll
                for (int j = 0; j < 4; ++j) v[j] = xr[64 * j]; }
            else { const u32x2* xr = (const u32x2*)(xsi + (size_t)r * DM) + lane;
#pragma unroll
                for (int j = 0; j < 4; ++j) { const u32x2 xv = xr[64 * j]; v[j] = (f32x4){bf_lo(xv.x), bf_hi(xv.x), bf_lo(xv.y), bf_hi(xv.y)}; } }
            u32x2* xw = (u32x2*)(xso + (size_t)r * DM) + lane;
#pragma unroll
            for (int j = 0; j < 4; ++j) { const u32x2 y = yr[64 * j]; v[j] += gt[j] * (f32x4){bf_lo(y.x), bf_hi(y.x), bf_lo(y.y), bf_hi(y.y)};
                u32x2 w; w.x = cvt_pk_bf16(v[j][0], v[j][1]); w.y = cvt_pk_bf16(v[j][2], v[j][3]); xw[64 * j] = w;
                ss += (v[j][0] * v[j][0] + v[j][1] * v[j][1]) + (v[j][2] * v[j][2] + v[j][3] * v[j][3]); }
            const float rstd = __builtin_amdgcn_rsqf(wave_sum_all(ss) * (1.0f / DM) + EPS);
            u32x2* o8 = (u32x2*)(H + (size_t)r * DM) + lane; int* q8 = (int*)(H8 + (size_t)r * DM) + lane;
#pragma unroll
            for (int j = 0; j < 4; ++j) { const f32x4 o = v[j] * rstd * c1[j] + shv[j]; u32x2 w; w.x = cvt_pk_bf16(o[0], o[1]); w.y = cvt_pk_bf16(o[2], o[3]); o8[64 * j] = w;
                int pk = __builtin_amdgcn_cvt_pk_fp8_f32(o[0], o[1], 0, false); pk = __builtin_amdgcn_cvt_pk_fp8_f32(o[2], o[3], pk, true); q8[64 * j] = pk; }
        }
    }
}
__device__ __forceinline__ void final_phase(float* x, const float* gf, int gw, int NGW, int lane) {
    f32x4 gv[4];
#pragma unroll
    for (int j = 0; j < 4; ++j) gv[j] = *(const f32x4*)(gf + 4 * lane + 256 * j);
    for (int r = gw; r < MTOK; r += NGW) {
        f32x4* xr = (f32x4*)(x + (size_t)r * DM) + lane;
        f32x4 v[4]; float ss = 0.f;
#pragma unroll
        for (int j = 0; j < 4; ++j) { v[j] = xr[64 * j]; ss += (v[j][0] * v[j][0] + v[j][1] * v[j][1]) + (v[j][2] * v[j][2] + v[j][3] * v[j][3]); }
        const float rstd = __builtin_amdgcn_rsqf(wave_sum_all(ss) * (1.0f / DM) + EPS);
#pragma unroll
        for (int j = 0; j < 4; ++j) xr[64 * j] = v[j] * rstd * gv[j];
    }
}

__device__ __forceinline__ void unpack8(const u32x4 w, float (&f)[8]) { f[0] = bf_lo(w.x); f[1] = bf_hi(w.x); f[2] = bf_lo(w.y); f[3] = bf_hi(w.y); f[4] = bf_lo(w.z); f[5] = bf_hi(w.z); f[6] = bf_lo(w.w); f[7] = bf_hi(w.w); }
__device__ __forceinline__ u32x4 pack8(const float (&f)[8]) { u32x4 o; o.x = cvt_pk_bf16(f[0], f[1]); o.y = cvt_pk_bf16(f[2], f[3]); o.z = cvt_pk_bf16(f[4], f[5]); o.w = cvt_pk_bf16(f[6], f[7]); return o; }
__device__ __forceinline__ void pool_elem_phase(const bf16_t* U, bf16_t* P, int vcu, int G, int tid) {
    const int chunk = tid & 127, run = tid >> 7, c0 = 8 * chunk, w = 2 << (c0 >> 8);
    for (int unit = vcu; unit < MTOK / 128; unit += G) {
        const int t0 = unit * 128 + run * 32, seq0 = t0 & ~(SEQ - 1);
        float s[8];
#pragma unroll
        for (int j = 0; j < 8; ++j) s[j] = 0.f;
        for (int tau = t0 - w; tau < t0; ++tau) if (tau >= seq0) { float f[8];     unpack8(*(const u32x4*)(U + (size_t)tau * DM + c0), f);
#pragma unroll
            for (int j = 0; j < 8; ++j) s[j] += f[j]; }
#pragma unroll 1
        for (int tb = t0; tb < t0 + 32; tb += 8) {
            u32x4 cur[8], old[8];
#pragma unroll
            for (int i = 0; i < 8; ++i) { cur[i] = *(const u32x4*)(U + (size_t)(tb + i) * DM + c0);
                const int tl = tb + i - w; old[i] = *(const u32x4*)(U + (size_t)(tl >= seq0 ? tl : seq0) * DM + c0); }
#pragma unroll
            for (int i = 0; i < 8; ++i) { const int t = tb + i; float f[8], o[8]; unpack8(cur[i], f);
#pragma unroll
                for (int j = 0; j < 8; ++j) s[j] += f[j];
                if (t - w >= seq0) { float q[8]; unpack8(old[i], q);
#pragma unroll
                    for (int j = 0; j < 8; ++j) s[j] -= q[j]; }
                const int pos1 = t - seq0 + 1; const float inv = 1.0f / (float)(pos1 < w ? pos1 : w);
#pragma unroll
                for (int j = 0; j < 8; ++j) o[j] = s[j] * inv - f[j];
                *(u32x4*)(P + (size_t)t * DM + c0) = pack8(o); }
        }
    }
}
__device__ __forceinline__ void conv_elem_phase(const bf16_t* BG, const bf16_t* Z, const float* cw  , bf16_t* Aout, int vcu, int G, int tid) {
    const int chunk = tid & 127, run = tid >> 7, c0 = 8 * chunk;
    float w0[8], w1[8], w2[8];
#pragma unroll
    for (int j = 0; j < 8; ++j) { w0[j] = cw[c0 + j]; w1[j] = cw[DM + c0 + j]; w2[j] = cw[2 * DM + c0 + j]; }
    for (int unit = vcu; unit < MTOK / 128; unit += G) {
        const int t0 = unit * 128 + run * 32, seq0 = t0 & ~(SEQ - 1);
        float zm2[8], zm1[8];
#pragma unroll
        for (int j = 0; j < 8; ++j) { zm2[j] = 0.f; zm1[j] = 0.f; }
        if (t0 - 2 >= seq0) unpack8(*(const u32x4*)(Z + (size_t)(t0 - 2) * DM + c0), zm2);
        if (t0 - 1 >= seq0) unpack8(*(const u32x4*)(Z + (size_t)(t0 - 1) * DM + c0), zm1);
#pragma unroll 1
        for (int tb = t0; tb < t0 + 32; tb += 8) {
            u32x4 zr[8], br[8];
#pragma unroll
            for (int i = 0; i < 8; ++i) { zr[i] = *(const u32x4*)(Z + (size_t)(tb + i) * DM + c0); br[i] = *(const u32x4*)(BG + (size_t)(tb + i) * DM + c0); }
#pragma unroll
            for (int i = 0; i < 8; ++i) { float z[8], bg[8], o[8]; unpack8(zr[i], z); unpack8(br[i], bg);
#pragma unroll
                for (int j = 0; j < 8; ++j) { o[j] = bg[j] * (w0[j] * zm2[j] + w1[j] * zm1[j] + w2[j] * z[j]); zm2[j] = zm1[j]; zm1[j] = z[j]; }
                *(u32x4*)(Aout + (size_t)(tb + i) * DM + c0) = pack8(o); }
        }
    }
}

__device__ __forceinline__ int wp_off(int row, int chunk) { return row * 256 + ((chunk ^ (row & 15)) << 4); }
__device__ __forceinline__ void mix_phase(LAS unsigned char* lds, bf16_t* UA, const bf16_t* VT, const float* WS, const float* BS, const float* LNG, const float* LNB, int vcu, int G, int tid, int wid, int lane) {
    LAS unsigned char* WP = lds;
    LAS float* MU = (LAS float*)(lds + 32768); LAS float* RSTD = MU + 128; LAS float* R1 = MU + 256; LAS float* R2 = MU + 384;
    LAS float* PART = (LAS float*)(lds + 36864);
    LAS unsigned char* VS = lds + 36864;
    for (int n = vcu; n < MTOK / 128; n += G) {
        {
            const int cgp = tid >> 4, tl = tid & 15;
            float s[8], q[8];
#pragma unroll
            for (int j = 0; j < 8; ++j) { s[j] = 0.f; q[j] = 0.f; }
#pragma unroll 4
            for (int it = 0; it < GH / 32; ++it) { float f[8]; unpack8(*(const u32x4*)(VT + ((size_t)n * GH + it * 32 + cgp) * 128 + tl * 8), f);
#pragma unroll
                for (int j = 0; j < 8; ++j) { s[j] += f[j]; q[j] += f[j] * f[j]; } }
#pragma unroll
            for (int j = 0; j < 8; ++j) { PART[(cgp * 128 + tl * 8 + j) * 2] = s[j]; PART[(cgp * 128 + tl * 8 + j) * 2 + 1] = q[j]; }
            __syncthreads();
            if (tid < 128) { float S = 0.f, Q = 0.f;
                for (int k = 0; k < 32; ++k) { S += PART[(k * 128 + tid) * 2]; Q += PART[(k * 128 + tid) * 2 + 1]; }
                const float mu = S * (1.0f / GH), var = Q * (1.0f / GH) - mu * mu; MU[tid] = mu; RSTD[tid] = __builtin_amdgcn_rsqf(fmaxf(var, 0.f) + EPS); }
            __syncthreads();
        }
        for (int g = 0; g < 8; ++g) {
            const int fr = lane & 15, fq = lane >> 4, cbase = g * 384 + wid * 48;
            bf16x8 av[4][3];
#pragma unroll
            for (int ks = 0; ks < 4; ++ks)
#pragma unroll
                for (int ct = 0; ct < 3; ++ct) av[ks][ct] = *(const bf16x8*)(VT + ((size_t)n * GH + cbase + ct * 16 + fr) * 128 + ks * 32 + fq * 8);
            {
                const int i = tid >> 2, part = tid & 3;
                const float* wrow = WS + ((size_t)g * 128 + i) * 128 + part * 32;
                float r1 = 0.f, r2 = 0.f;
#pragma unroll
                for (int jj = 0; jj < 32; jj += 8) { const int j0 = part * 32 + jj;
                    f32x4 a = *(const f32x4*)(wrow + jj), b = *(const f32x4*)(wrow + jj + 4);
                    if (i < 64 && j0 >= 64) { a = (f32x4){0.f, 0.f, 0.f, 0.f}; b = a; }
                    const f32x4 ra = *(const LAS f32x4*)(RSTD + j0), rb = *(const LAS f32x4*)(RSTD + j0 + 4), ma = *(const LAS f32x4*)(MU + j0), mb = *(const LAS f32x4*)(MU + j0 + 4);
                    const f32x4 wa = a * ra, wb = b * rb;
                    r1 += (wa[0] * ma[0] + wa[1] * ma[1]) + (wa[2] * ma[2] + wa[3] * ma[3]) + (wb[0] * mb[0] + wb[1] * mb[1]) + (wb[2] * mb[2] + wb[3] * mb[3]);
                    r2 += (a[0] + a[1]) + (a[2] + a[3]) + (b[0] + b[1]) + (b[2] + b[3]);
                    u32x4 o; o.x = cvt_pk_bf16(wa[0], wa[1]); o.y = cvt_pk_bf16(wa[2], wa[3]); o.z = cvt_pk_bf16(wb[0], wb[1]); o.w = cvt_pk_bf16(wb[2], wb[3]);
                    *(LAS u32x4*)(WP + wp_off(i, j0 >> 3)) = o; }
                r1 += __shfl_xor(r1, 1); r1 += __shfl_xor(r1, 2); r2 += __shfl_xor(r2, 1); r2 += __shfl_xor(r2, 2);
                if (part == 0) { R1[i] = r1; R2[i] = r2; }
            }
            __syncthreads();
            f32x4 acc[3][8];
#pragma unroll
            for (int ct = 0; ct < 3; ++ct)
#pragma unroll
                for (int it = 0; it < 8; ++it) acc[ct][it] = (f32x4){0.f, 0.f, 0.f, 0.f};
#pragma unroll
            for (int ks = 0; ks < 4; ++ks) {
#pragma unroll
                for (int it = 0; it < 8; ++it) { const bf16x8 bw = *(const LAS bf16x8*)(WP + wp_off(it * 16 + fr, ks * 4 + fq));
#pragma unroll
                    for (int ct = 0; ct < 3; ++ct) acc[ct][it] = __builtin_amdgcn_mfma_f32_16x16x32_bf16(av[ks][ct], bw, acc[ct][it], 0, 0, 0); }
                __builtin_amdgcn_sched_barrier(0);
            }
#pragma unroll
            for (int ct = 0; ct < 3; ++ct) { const int c4 = cbase + ct * 16 + 4 * fq;
                const f32x4 lg = *(const f32x4*)(LNG + c4), lb = *(const f32x4*)(LNB + c4);
#pragma unroll
                for (int it = 0; it < 8; ++it) { const int i = it * 16 + fr; const float r1 = R1[i], r2 = R2[i], bs = BS[g * 128 + i];
                    const f32x4 vs = lg * (acc[ct][it] - r1) + lb * r2 + bs;
                    u32x2 o; o.x = cvt_pk_bf16(vs[0], vs[1]); o.y = cvt_pk_bf16(vs[2], vs[3]);
                    *(LAS u32x2*)(VS + i * 784 + (wid * 48 + ct * 16 + 4 * fq) * 2) = o; } }
            __syncthreads();
#pragma unroll 4
            for (int c = tid; c < 128 * 48; c += NTHREADS) { const int tok = c / 48, ch8 = c - tok * 48;
                const u32x4 vv = *(const LAS u32x4*)(VS + tok * 784 + ch8 * 16);
                u32x4* up = (u32x4*)(UA + (size_t)(n * 128 + tok) * GH + g * 384 + ch8 * 8); const u32x4 uu = *up;
                u32x4 o; o.x = cvt_pk_bf16(bf_lo(uu.x) * bf_lo(vv.x), bf_hi(uu.x) * bf_hi(vv.x)); o.y = cvt_pk_bf16(bf_lo(uu.y) * bf_lo(vv.y), bf_hi(uu.y) * bf_hi(vv.y));
                o.z = cvt_pk_bf16(bf_lo(uu.z) * bf_lo(vv.z), bf_hi(uu.z) * bf_hi(vv.z)); o.w = cvt_pk_bf16(bf_lo(uu.w) * bf_lo(vv.w), bf_hi(uu.w) * bf_hi(vv.w));
                *up = o; }
            __syncthreads();
        }
    }
}

__device__ __forceinline__ void topk_units(LAS unsigned char* lds, const bf16_t* Q, const bf16_t* KEYS, int* SELI, float* SELW, const pg8::StaticOrder& S, int tid, int wid, int lane) {
    LAS unsigned char* kl = lds;
    LAS float* topv = (LAS float*)(lds + 65536);
    const int p = wid >> 2, sub = wid & 3, tl = lane & 31, hi = lane >> 5;
    int hprev = -1;
#pragma unroll 1
    for (int k = 0; ; k = (k & 1) ? k + 3 : k + 1) {
        pg8::Unit ua, ub; if (!S.next(k, ua)) break;
        const bool hasb = S.next(k + 2, ub);
        const bool pair = hasb && ub.pn == ua.pn;
#pragma unroll 1
        for (int part = 0; part < ((hasb && !pair) ? 2 : 1); ++part) {
            const int h = part ? ub.pn : ua.pn, pm0 = part ? ub.pm : ua.pm, pm1 = ub.pm, ntile = pair ? 4 : 2;
            __syncthreads();
            if (h != hprev) {
                for (int c = tid; c < 4096; c += NTHREADS) { const int row = c >> 4, ch = c & 15;
                    const u32x4 v = *(const u32x4*)(KEYS + ((size_t)h * 256 + row) * 128 + ch * 8);
                    *(LAS u32x4*)(kl + row * 256 + ((ch ^ (row & 15)) << 4)) = v; }
                hprev = h; }
            __syncthreads();
#pragma unroll 1
            for (int t4 = 0; t4 < ntile; ++t4) {
                const int tile = 2 * (t4 < 2 ? pm0 : pm1) + (t4 & 1);
                const bf16_t* qrow = Q + ((size_t)((tile * 8 + h) * 32 + 16 * p + hi) * 128 + sub * 32 + tl) * 8;
                bf16x8 bq[8];
#pragma unroll
                for (int ks = 0; ks < 8; ++ks) bq[ks] = *(const bf16x8*)(qrow + (size_t)ks * 2 * 128 * 8);
                f32x16 acc[4];
#pragma unroll
                for (int kt = 0; kt < 4; ++kt)
#pragma unroll
                    for (int r = 0; r < 16; ++r) acc[kt][r] = 0.f;
#pragma unroll
                for (int ks = 0; ks < 8; ++ks)
#pragma unroll
                    for (int kt = 0; kt < 4; ++kt) { const int row = p * 128 + kt * 32 + tl;
                        const bf16x8 ak = *(const LAS bf16x8*)(kl + row * 256 + (((2 * ks + hi) ^ (row & 15)) << 4));
                        acc[kt] = __builtin_amdgcn_mfma_f32_32x32x16_bf16(ak, bq[ks], acc[kt], 0, 0, 0); }
                float v[64];
#pragma unroll
                for (int kt = 0; kt < 4; ++kt)
#pragma unroll
                    for (int r = 0; r < 16; ++r) { const unsigned key = (unsigned)(kt * 32 + (r & 3) + 8 * (r >> 2) + 4 * hi);
                        v[kt * 16 + r] = __uint_as_float((__float_as_uint(acc[kt][r]) & ~127u) | key); }
                top16_of_64(v);
                float m[16];
#pragma unroll
                for (int i = 0; i < 16; ++i) m[i] = fmaxf(v[i], __shfl_xor(v[15 - i], 32));
                bmerge16_desc<0, 16>(m);
                if (hi == 0) { LAS f32x4* dst = (LAS f32x4*)(topv + ((t4 * 2 + p) * 128 + sub * 32 + tl) * 16);
#pragma unroll
                    for (int i = 0; i < 4; ++i) dst[i] = (f32x4){m[4 * i], m[4 * i + 1], m[4 * i + 2], m[4 * i + 3]}; }
            }
            __syncthreads();
            if (tid < ntile * 128) {
                const int t4 = tid >> 7, tok = tid & 127, tile = 2 * (t4 < 2 ? pm0 : pm1) + (t4 & 1);
                const LAS float* t0 = topv + ((t4 * 2 + 0) * 128 + tok) * 16; const LAS float* t1 = topv + ((t4 * 2 + 1) * 128 + tok) * 16;
                float s0[16], s1[16];
#pragma unroll
                for (int i = 0; i < 4; ++i) { const f32x4 a = *(const LAS f32x4*)(t0 + 4 * i), b = *(const LAS f32x4*)(t1 + 4 * i);
                    s0[4 * i] = a[0]; s0[4 * i + 1] = a[1]; s0[4 * i + 2] = a[2]; s0[4 * i + 3] = a[3]; s1[4 * i] = b[0]; s1[4 * i + 1] = b[1]; s1[4 * i + 2] = b[2]; s1[4 * i + 3] = b[3]; }
                float c[64];
                constexpr int pre[16] = {0, 16, 24, 29, 33, 36, 38, 40, 42, 43, 44, 45, 46, 47, 48, 49};
#pragma unroll
                for (int a = 0; a < 16; ++a)
#pragma unroll
                    for (int b = 0; b < 16; ++b) if ((a + 1) * (b + 1) <= 16) c[pre[a] + b] = __uint_as_float((__float_as_uint(s0[a] + s1[b]) & ~255u) | (unsigned)(a * 16 + b));
#pragma unroll
                for (int i = 50; i < 64; ++i) c[i] = -3.0e38f;
                top16_of_64(c);
                float e[16], sum = 0.f;
#pragma unroll
                for (int kk = 0; kk < 16; ++kk) { e[kk] = __builtin_amdgcn_exp2f((c[kk] - c[0]) * 1.44269504f); sum += e[kk]; }
                const float inv = 1.0f / sum;
                const size_t o = (size_t)(tile * 128 + tok) * NPICK + h * 16;
#pragma unroll
                for (int k4 = 0; k4 < 4; ++k4) { i32x4 ei; f32x4 wv;
#pragma unroll
                    for (int j = 0; j < 4; ++j) { const unsigned code = __float_as_uint(c[4 * k4 + j]) & 255u;
                        const unsigned i1 = __float_as_uint(t0[code >> 4]) & 127u, i2 = __float_as_uint(t1[code & 15u]) & 127u;
                        ei[j] = (int)(i1 * 128u + i2); wv[j] = e[4 * k4 + j] * inv; }
                    *(i32x4*)(SELI + o + 4 * k4) = ei; *(f32x4*)(SELW + o + 4 * k4) = wv; }
            }
        }
    }
    __syncthreads();
}

typedef const unsigned char* cbytes;
#ifndef DUP_MASK
#define DUP_MASK 0
#endif
template <int CTRL> __device__ __forceinline__ float dpp_f(float v) { return __builtin_bit_cast(float, __builtin_amdgcn_update_dpp(0, __builtin_bit_cast(int, v), CTRL, 0xf, 0xf, false)); }
#define DPP_F(v, ctrl) dpp_f<(ctrl)>(v)
#define PG_IDX(EV, TKN) do { const LAS u32x4* _ip = (const LAS u32x4*)(idxw + (TKN) * 128 + 16 * g8); \
        _Pragma("unroll") for (int q = 0; q < 2; ++q) { const u32x4 _e = _ip[q]; _Pragma("unroll") for (int w = 0; w < 4; ++w) { EV[8 * q + 2 * w] = (int)(_e[w] & 0xffffu); EV[8 * q + 2 * w + 1] = (int)(_e[w] >> 16); } } } while (0)
#define PG_GATHER8(BUF, SL, EV, J0) do { _Pragma("unroll") for (int j = 0; j < 8; ++j) BUF[j] = *(const u32x4*)((SL) + ((unsigned)EV[(J0) + j] * 128u + s8 * 16u)); } while (0)
#define PGU_IDX(EV, TKN) do { const LAS u32x4* _ip = (const LAS u32x4*)(idxw + (TKN) * 128 + 16 * slotA); \
        _Pragma("unroll") for (int q = 0; q < 2; ++q) { const u32x4 _e = _ip[q]; _Pragma("unroll") for (int w = 0; w < 4; ++w) { EV[8 * q + 2 * w] = (int)(_e[w] & 0xffffu); EV[8 * q + 2 * w + 1] = (int)(_e[w] >> 16); } } } while (0)
#define PGU_GATHER8(BUF, SL, EV, M0) do { _Pragma("unroll") for (int j = 0; j < 8; ++j) BUF[j] = *(const u32x4*)((SL) + ((unsigned)EV[4 * (((M0) + j) & 3) + (((M0) + j) >> 2)] * 128u + pieceA * 16u)); } while (0)
#define PGU_HB(HR, IT) do { const int _it = (IT) < 63 ? (IT) : 63; HR = *(const u32x4*)(H8 + (size_t)(tk0 + (_it & 15)) * DM + (((xg + (_it >> 4)) & 3) * 256) + hoffB); } while (0)
#define PGU_MMA8(BUF, HR, ACC, M0) do { const i32x8 _b = {blo ? (int)HR.x : 0, blo ? (int)HR.y : 0, blo ? (int)HR.z : 0, blo ? (int)HR.w : 0, bhi ? (int)HR.x : 0, bhi ? (int)HR.y : 0, bhi ? (int)HR.z : 0, bhi ? (int)HR.w : 0}; \
        _Pragma("unroll") for (int j = 0; j < 8; ++j) { const u32x4 _u = BUF[j]; const i32x8 _a = {(int)_u.x, (int)_u.y, (int)_u.z, (int)_u.w, 0, 0, 0, 0}; \
            const f32x4 _d = __builtin_amdgcn_mfma_scale_f32_16x16x128_f8f6f4(_a, _b, (f32x4){0.f, 0.f, 0.f, 0.f}, 4, 0, 0, 0, 0, 0); \
            float _v = i4 == 0 ? _d[0] : i4 == 1 ? _d[1] : i4 == 2 ? _d[2] : _d[3]; _v += DPP_F(_v, 0xB1); _v += DPP_F(_v, 0x4E); \
            ACC[((M0) + j) >> 2] = (i4 == (((M0) + j) & 3)) ? _v : ACC[((M0) + j) >> 2]; } } while (0)
#define PGU_DOTS(ACC, TKN) do { if (n16 < 8) { LAS f32x4* _dp = (LAS f32x4*)(dotw + (TKN) * 128 + 32 * c4 + 4 * n16); *_dp += ACC; } } while (0)
#define PG_VCOMP8(BUF, CV, J0) do { _Pragma("unroll") for (int j = 0; j < 8; ++j) { const u32x4 v = BUF[j]; const float c = CV[(J0) + j]; \
            acc[0] += c * __builtin_amdgcn_cvt_pk_f32_fp8(v.x, false); acc[1] += c * __builtin_amdgcn_cvt_pk_f32_fp8(v.x, true); \
            acc[2] += c * __builtin_amdgcn_cvt_pk_f32_fp8(v.y, false); acc[3] += c * __builtin_amdgcn_cvt_pk_f32_fp8(v.y, true); \
            acc[4] += c * __builtin_amdgcn_cvt_pk_f32_fp8(v.z, false); acc[5] += c * __builtin_amdgcn_cvt_pk_f32_fp8(v.z, true); \
            acc[6] += c * __builtin_amdgcn_cvt_pk_f32_fp8(v.w, false); acc[7] += c * __builtin_amdgcn_cvt_pk_f32_fp8(v.w, true); } } while (0)
#define PG_COEF(CV, TKN) do { const LAS f32x4* _cp = (const LAS f32x4*)(dotw + (TKN) * 128 + 16 * g8); \
        _Pragma("unroll") for (int q = 0; q < 4; ++q) { const f32x4 _c = _cp[q]; CV[4 * q] = _c[0]; CV[4 * q + 1] = _c[1]; CV[4 * q + 2] = _c[2]; CV[4 * q + 3] = _c[3]; } } while (0)
#define PG_COEF8(CV, TKN, J0) do { const LAS f32x4* _cp = (const LAS f32x4*)(dotw + (TKN) * 128 + 16 * g8 + (J0)); \
        const f32x4 _c0 = _cp[0], _c1 = _cp[1]; CV[0] = _c0[0]; CV[1] = _c0[1]; CV[2] = _c0[2]; CV[3] = _c0[3]; CV[4] = _c1[0]; CV[5] = _c1[1]; CV[6] = _c1[2]; CV[7] = _c1[3]; } while (0)
#define PG_XOFFS(IT) ((size_t)(tk0 + ((IT) & 15)) * DM + (((xg + ((IT) >> 4)) & 7) * 128) + xoff)
#define PG_XADDR(IT) (x + PG_XOFFS(IT))
#define PG_XLOAD(XV, IT) do { XV = *(const unsigned*)PG_XADDR(IT); } while (0)
__device__ __forceinline__ void peer_gather_phase(LAS unsigned char* lds, const unsigned char* H8  , cbytes TUP, cbytes TVP, const int* SELI, const float* SELW, const unsigned* SC, bf16_t* x  , float* outf  , const float* gacc, const float* gn_next  , const float* mod_next  , bf16_t* Hout, bool last, int vcu, int G, int wid, int lane) {
    const int g8 = lane >> 3, s8 = lane & 7, n16 = lane & 15, c4 = lane >> 4, i4 = lane & 3, slotA = 2 * ((lane >> 2) & 3) + (c4 >> 1), pieceA = 4 * (c4 & 1) + i4, hoffB = 128 * (c4 >> 1) + 32 * i4 + 16 * (c4 & 1);
    const bool blo = n16 < 4, bhi = n16 >= 4 && n16 < 8;
    const bool b3 = (lane & 8) != 0, b4 = (lane & 16) != 0, b5 = (lane & 32) != 0;
    const int xoff = s8 * 16 + 8 * (g8 & 1) + 4 * ((g8 >> 1) & 1) + 2 * (g8 >> 2);
    LAS unsigned short* idxw = (LAS unsigned short*)(lds + wid * 12288);
    LAS float* csw = (LAS float*)(lds + 98304 + wid * 64);
    LAS float* dotw = (LAS float*)(lds + wid * 12288 + 4096);
    for (int blk = vcu; blk < 256; blk += G) {
        const int xg = blk >> 5, tk0 = blk * 128 + wid * 16;
        const int nrep_u = (DUP_MASK & 0x20000) ? opaque(2) : 1;
#pragma unroll 1
        for (int rep_u = 0; rep_u < nrep_u; ++rep_u) {
#pragma unroll 4
        for (int i = 0; i < 16; ++i) { const int e0 = SELI[(size_t)(tk0 + i) * NPICK + lane], e1 = SELI[(size_t)(tk0 + i) * NPICK + 64 + lane];
            idxw[i * 128 + lane] = (unsigned short)e0; idxw[i * 128 + 64 + lane] = (unsigned short)e1; dotw[i * 128 + lane] = 0.f; dotw[i * 128 + 64 + lane] = 0.f; }
        asm volatile("" ::: "memory");
        {
            int ev[16]; u32x4 bufA[8], bufB[8], bufC[8], bufD[8]; u32x4 hr0, hr1;
            { cbytes sl0 = TUP + (size_t)(xg & 3) * NEXP * 128;
              PGU_IDX(ev, 0); PGU_GATHER8(bufA, sl0, ev, 0); PGU_GATHER8(bufB, sl0, ev, 8);
              PGU_IDX(ev, 1); PGU_GATHER8(bufC, sl0, ev, 0); PGU_GATHER8(bufD, sl0, ev, 8); }
            PGU_HB(hr0, 0); PGU_HB(hr1, 1);
#pragma unroll 1
            for (int it = 0; it < 64; it += 2) {
                const int tkn = it & 15, it2 = it + 2 < 63 ? it + 2 : 63, it3 = it + 3 < 63 ? it + 3 : 63;
                cbytes sl2 = TUP + (size_t)((xg + (it2 >> 4)) & 3) * NEXP * 128;
                f32x4 acc4 = {0.f, 0.f, 0.f, 0.f};
                PGU_IDX(ev, it2 & 15);
                PGU_MMA8(bufA, hr0, acc4, 0); __builtin_amdgcn_sched_barrier(0);
                PGU_GATHER8(bufA, sl2, ev, 0); __builtin_amdgcn_sched_barrier(0);
                PGU_MMA8(bufB, hr0, acc4, 8); __builtin_amdgcn_sched_barrier(0);
                PGU_GATHER8(bufB, sl2, ev, 8); PGU_HB(hr0, it + 2); __builtin_amdgcn_sched_barrier(0);
                PGU_DOTS(acc4, tkn);
                acc4 = (f32x4){0.f, 0.f, 0.f, 0.f};
                PGU_IDX(ev, it3 & 15);
                PGU_MMA8(bufC, hr1, acc4, 0); __builtin_amdgcn_sched_barrier(0);
                PGU_GATHER8(bufC, sl2, ev, 0); __builtin_amdgcn_sched_barrier(0);
                PGU_MMA8(bufD, hr1, acc4, 8); __builtin_amdgcn_sched_barrier(0);
                PGU_GATHER8(bufD, sl2, ev, 8); PGU_HB(hr1, it + 3); __builtin_amdgcn_sched_barrier(0);
                PGU_DOTS(acc4, tkn + 1);
            }
        }
        asm volatile("" ::: "memory");
        }
#pragma unroll 2
        for (int i = 0; i < 16; ++i) {
            float csum = 0.f;
#pragma unroll
            for (int hh = 0; hh < 2; ++hh) { const int k = 16 * g8 + s8 + 8 * hh; const int e = idxw[i * 128 + k];
                const float w = SELW[(size_t)(tk0 + i) * NPICK + k]; const unsigned sc = SC[e];
                const float cf = w * gelu_tanh(dotw[i * 128 + k] * bf_lo(sc)) * bf_hi(sc); csum += cf;
                const float cl = fminf(fmaxf(cf, -15.0f), 15.0f);
                ((LAS unsigned*)dotw)[i * 128 + k] = __builtin_bit_cast(unsigned, __builtin_amdgcn_cvt_pkrtz(cl * 4096.0f, cl * 256.0f)); }
            csum = wave_sum_all(csum); if (lane == 0) csw[i] = csum; }
        asm volatile("" ::: "memory");
        {
            const int xoffv = 32 * s8 + 16 * (g8 & 1) + 8 * ((g8 >> 1) & 1) + 4 * (g8 >> 2);
            const float* gp = gacc + (size_t)(tk0 >> 12) * 6 * DM + xoffv;
            int ev[16]; u32x4 bufA[8], bufB[8], bufC[8], bufD[8]; unsigned cC[8]; u32x2 x0, x1;
#define PGV_XADDR(IT) (x + (size_t)(tk0 + ((IT) & 15)) * DM + (((xg + ((IT) >> 4)) & 3) * 256) + xoffv)
#define PGV_COEF8(CV, TKN, J0) do { const LAS u32x4* _cp = (const LAS u32x4*)((LAS unsigned*)dotw + (TKN) * 128 + 16 * g8 + (J0)); \
        const u32x4 _c0 = _cp[0], _c1 = _cp[1]; CV[0] = _c0[0]; CV[1] = _c0[1]; CV[2] = _c0[2]; CV[3] = _c0[3]; CV[4] = _c1[0]; CV[5] = _c1[1]; CV[6] = _c1[2]; CV[7] = _c1[3]; } while (0)
#define PGV_COMP8(BUF, CV) do { _Pragma("unroll") for (int j = 0; j < 8; ++j) { const u32x4 _v = BUF[j]; const h16x2 _c = __builtin_bit_cast(h16x2, CV[j]); const h16x2 _cl = {_c.x, _c.x}, _ch = {_c.y, _c.y}; \
            _Pragma("unroll") for (int w = 0; w < 4; ++w) { const unsigned _x = _v[w], _y = _x >> 8; \
                acc[4 * w + 0] = __builtin_elementwise_fma(__builtin_bit_cast(h16x2, _x & 0x000F000Fu), _cl, acc[4 * w + 0]); \
                acc[4 * w + 1] = __builtin_elementwise_fma(__builtin_bit_cast(h16x2, _x & 0x00F000F0u), _ch, acc[4 * w + 1]); \
                acc[4 * w + 2] = __builtin_elementwise_fma(__builtin_bit_cast(h16x2, _y & 0x000F000Fu), _cl, acc[4 * w + 2]); \
                acc[4 * w + 3] = __builtin_elementwise_fma(__builtin_bit_cast(h16x2, _y & 0x00F000F0u), _ch, acc[4 * w + 3]); } } } while (0)
#define PGV_ADD(A, B) (__builtin_bit_cast(unsigned, __builtin_bit_cast(h16x2, (A)) + __builtin_bit_cast(h16x2, (B))))
#define PGV_REDUCE_STORE(XV, IT) do { unsigned k8[8]; \
                _Pragma("unroll") for (int j = 0; j < 8; ++j) { const unsigned lo = __builtin_bit_cast(unsigned, acc[j]), hi = __builtin_bit_cast(unsigned, acc[8 + j]); \
                    const unsigned snd = b3 ? lo : hi, kp = b3 ? hi : lo; k8[j] = PGV_ADD(kp, (unsigned)__builtin_amdgcn_update_dpp(0, (int)snd, 0x128, 0xf, 0xf, false)); } \
                unsigned k4[4]; _Pragma("unroll") for (int j = 0; j < 4; ++j) { const unsigned snd = b4 ? k8[j] : k8[4 + j], kp = b4 ? k8[4 + j] : k8[j]; k4[j] = PGV_ADD(kp, (unsigned)__shfl_xor((int)snd, 16)); } \
                unsigned k2[2]; _Pragma("unroll") for (int j = 0; j < 2; ++j) { const unsigned snd = b5 ? k4[j] : k4[2 + j], kp = b5 ? k4[2 + j] : k4[j]; k2[j] = PGV_ADD(kp, (unsigned)__shfl_xor((int)snd, 32)); } \
                const h16x2 _a = __builtin_bit_cast(h16x2, k2[0]), _b = __builtin_bit_cast(h16x2, k2[1]); const float _off = 7.5f * csw[(IT) & 15]; \
                const f32x4 _o = (f32x4){(float)_a.x, (float)_b.x, (float)_a.y, (float)_b.y} * 4096.0f - _off; \
                const f32x4 _xn = (f32x4){bf_lo(XV.x), bf_hi(XV.x), bf_lo(XV.y), bf_hi(XV.y)} + gate * _o; \
                u32x2 _w; _w.x = cvt_pk_bf16(_xn[0], _xn[1]); _w.y = cvt_pk_bf16(_xn[2], _xn[3]); *(u32x2*)PGV_XADDR(IT) = _w; } while (0)
            { cbytes sl0 = TVP + (size_t)(xg & 3) * NEXP * 128;
              PG_IDX(ev, 0); PG_GATHER8(bufA, sl0, ev, 0); PG_GATHER8(bufB, sl0, ev, 8);
              PG_IDX(ev, 1); PG_GATHER8(bufC, sl0, ev, 0); PG_GATHER8(bufD, sl0, ev, 8); }
            x0 = *(const u32x2*)PGV_XADDR(0); x1 = *(const u32x2*)PGV_XADDR(1);
#pragma unroll 1
            for (int it = 0; it < 64; it += 2) {
                const int it2 = it + 2 < 63 ? it + 2 : 63, it3 = it + 3 < 63 ? it + 3 : 63, sl = (xg + (it >> 4)) & 3;
                cbytes sl2 = TVP + (size_t)((xg + (it2 >> 4)) & 3) * NEXP * 128;
                const f32x4 gate = *(const f32x4*)(gp + sl * 256);
                h16x2 acc[16];
#pragma unroll
                for (int j = 0; j < 16; ++j) acc[j] = (h16x2){(_Float16)0.f, (_Float16)0.f};
                PGV_COEF8(cC, it & 15, 0); PG_IDX(ev, it2 & 15);
                PGV_COMP8(bufA, cC); __builtin_amdgcn_sched_barrier(0);
                PG_GATHER8(bufA, sl2, ev, 0); PGV_COEF8(cC, it & 15, 8); __builtin_amdgcn_sched_barrier(0);
                PGV_COMP8(bufB, cC); __builtin_amdgcn_sched_barrier(0);
                PG_GATHER8(bufB, sl2, ev, 8); __builtin_amdgcn_sched_barrier(0);
                PGV_REDUCE_STORE(x0, it);
                x0 = *(const u32x2*)PGV_XADDR(it2);
#pragma unroll
                for (int j = 0; j < 16; ++j) acc[j] = (h16x2){(_Float16)0.f, (_Float16)0.f};
                PGV_COEF8(cC, (it + 1) & 15, 0); PG_IDX(ev, it3 & 15);
                PGV_COMP8(bufC, cC); __builtin_amdgcn_sched_barrier(0);
                PG_GATHER8(bufC, sl2, ev, 0); PGV_COEF8(cC, (it + 1) & 15, 8); __builtin_amdgcn_sched_barrier(0);
                PGV_COMP8(bufD, cC); __builtin_amdgcn_sched_barrier(0);
                PG_GATHER8(bufD, sl2, ev, 8); __builtin_amdgcn_sched_barrier(0);
                PGV_REDUCE_STORE(x1, it + 1);
                x1 = *(const u32x2*)PGV_XADDR(it3);
            }
#undef PGV_XADDR
#undef PGV_COEF8
#undef PGV_COMP8
#undef PGV_ADD
#undef PGV_REDUCE_STORE
        }
        asm volatile("s_waitcnt vmcnt(0)" ::: "memory");
        {
            const int b = tk0 >> 12;
            f32x4 c1[4], shv[4];
#pragma unroll
            for (int j = 0; j < 4; ++j) { const int col = 4 * lane + 256 * j;
                if (last) { c1[j] = *(const f32x4*)(gn_next + col); shv[j] = (f32x4){0.f, 0.f, 0.f, 0.f}; }
                else { c1[j] = *(const f32x4*)(gn_next + col) * (1.0f + *(const f32x4*)(mod_next + (size_t)b * 6 * DM + DM + col)); shv[j] = *(const f32x4*)(mod_next + (size_t)b * 6 * DM + col); } }
#pragma unroll 1
            for (int i0 = 0; i0 < 16; i0 += 4) {
                f32x4 v[4][4]; float ss[4];
#pragma unroll
                for (int rr = 0; rr < 4; ++rr) { const u32x2* xr = (const u32x2*)(x + (size_t)(tk0 + i0 + rr) * DM) + lane;
#pragma unroll
                    for (int j = 0; j < 4; ++j) { const u32x2 xv = xr[64 * j]; v[rr][j] = (f32x4){bf_lo(xv.x), bf_hi(xv.x), bf_lo(xv.y), bf_hi(xv.y)}; } }
#pragma unroll
                for (int rr = 0; rr < 4; ++rr) { float q = 0.f;
#pragma unroll
                    for (int j = 0; j < 4; ++j) q += (v[rr][j][0] * v[rr][j][0] + v[rr][j][1] * v[rr][j][1]) + (v[rr][j][2] * v[rr][j][2] + v[rr][j][3] * v[rr][j][3]);
                    ss[rr] = q; }
#pragma unroll
                for (int o = 1; o < 64; o <<= 1) {
#pragma unroll
                    for (int rr = 0; rr < 4; ++rr) ss[rr] += __shfl_xor(ss[rr], o); }
#pragma unroll
                for (int rr = 0; rr < 4; ++rr) { const int r = tk0 + i0 + rr; const float rstd = __builtin_amdgcn_rsqf(ss[rr] * (1.0f / DM) + EPS);
                    if (last) { f32x4* xr = (f32x4*)(outf + (size_t)r * DM) + lane;
#pragma unroll
                        for (int j = 0; j < 4; ++j) xr[64 * j] = v[rr][j] * rstd * c1[j]; }
                    else { u32x2* o8 = (u32x2*)(Hout + (size_t)r * DM) + lane;
#pragma unroll
                        for (int j = 0; j < 4; ++j) { const f32x4 o = v[rr][j] * rstd * c1[j] + shv[j]; u32x2 w; w.x = cvt_pk_bf16(o[0], o[1]); w.y = cvt_pk_bf16(o[2], o[3]); o8[64 * j] = w; } } }
            }
        }
    }
}
#undef PG_IDX
#undef PG_GATHER8
#undef PGU_IDX
#undef PGU_GATHER8
#undef PGU_HB
#undef PGU_MMA8
#undef PGU_DOTS
#undef PG_VCOMP8
#undef PG_COEF
#undef PG_COEF8
#undef PG_XADDR
#undef PG_XOFFS
#undef PG_XLOAD

constexpr size_t WS_BAR = 768 * 1024;
#define XB_TMO      128
#define XB_XCNT(j)  (256  + 64 * (j))
#define XB_XSUB(j)  (1280 + 64 * (j))
#define XB_XGEN(j)  (2304 + 64 * (j))
#define XB_TOP      3328
#define XB_TOPGEN   3392
#define XCD_BAR_WORDS 3456
#define XB_SPIN_CAP (1u << 22)
__device__ __forceinline__ unsigned xb_ld(unsigned* p)              { return __hip_atomic_load(p, __ATOMIC_RELAXED, __HIP_MEMORY_SCOPE_AGENT); }
__device__ __forceinline__ unsigned xb_add(unsigned* p, unsigned v) { return __hip_atomic_fetch_add(p, v, __ATOMIC_RELAXED, __HIP_MEMORY_SCOPE_AGENT); }
__device__ __forceinline__ unsigned xb_xcc_id() { return (unsigned)__builtin_amdgcn_s_getreg((3 << 11) | 20) & 0xFu; }
#define XB_SPIN(cond, bar) do { unsigned _sp = 0; while (cond) { __builtin_amdgcn_s_sleep(1); \
    if ((++_sp & 255u) == 0u) { if (xb_ld(&(bar)[XB_TMO])) break; if (_sp > XB_SPIN_CAP) { atomicAdd(&(bar)[XB_TMO], 1u); break; } } } } while (0)
struct XcdBarrier { unsigned* bar; unsigned x; volatile LAS unsigned* st; };
__device__ __forceinline__ void xcd_barrier_complete(unsigned* bar, unsigned x, unsigned& nloc, unsigned& nx) {
    const unsigned G = gridDim.x * gridDim.y * gridDim.z;
    unsigned sum, cnt, mine, sp = 0u;
    for (;;) {
        sum = 0u; cnt = 0u; mine = 0u;
#pragma unroll
        for (unsigned j = 0; j < 16; ++j) { const unsigned c = xb_ld(&bar[XB_XCNT(j)]); sum += c; cnt += (c > 0u) ? 1u : 0u; mine = (j == x) ? c : mine; }
        if (sum == G) break;
        __builtin_amdgcn_s_sleep(1);
        if ((++sp & 255u) == 0u) { if (xb_ld(&bar[XB_TMO])) break; if (sp > XB_SPIN_CAP) { atomicAdd(&bar[XB_TMO], 1u); break; } }
    }
    nloc = mine > 0u ? mine : 1u; nx = cnt > 0u ? cnt : 1u;
}
__device__ __forceinline__ void xcd_barrier(const XcdBarrier& b) {
    asm volatile("s_waitcnt vmcnt(0)" ::: "memory");
    __syncthreads();
    if (threadIdx.x == 0) {
        unsigned* bar = b.bar;
        __builtin_amdgcn_s_waitcnt(0);
        unsigned nloc = b.st[0], nx = b.st[1];
        if (nloc == 0u) { xcd_barrier_complete(bar, b.x, nloc, nx); b.st[0] = nloc; b.st[1] = nx; }
        const unsigned old = xb_add(&bar[XB_XSUB(b.x)], 1u);
        const unsigned gen = old / nloc;
        if (old + 1u == (gen + 1u) * nloc) {
            __builtin_amdgcn_fence(__ATOMIC_RELEASE, "agent");
            asm volatile("s_waitcnt vmcnt(0)" ::: "memory");
            const unsigned og = xb_add(&bar[XB_TOP], 1u);
            const unsigned tg = og / nx;
            if (og + 1u == (tg + 1u) * nx) xb_add(&bar[XB_TOPGEN], 1u);
            else XB_SPIN(xb_ld(&bar[XB_TOPGEN]) == tg, bar);
            __builtin_amdgcn_fence(__ATOMIC_ACQUIRE, "agent");
            xb_add(&bar[XB_XGEN(b.x)], 1u);
            asm volatile("s_waitcnt vmcnt(0)" ::: "memory");
        } else {
            XB_SPIN(xb_ld(&bar[XB_XGEN(b.x)]) == gen, bar);
            __builtin_amdgcn_fence(__ATOMIC_ACQUIRE, "agent");
            asm volatile("s_waitcnt vmcnt(0)" ::: "memory");
        }
    }
    __syncthreads();
}

constexpr int NPHASES = 27;
#ifndef PH_MASK
#define PH_MASK 0xFFFFFF
#endif
#ifndef DUP_MASK
#define DUP_MASK 0
#endif
#ifndef TIME_MASK
#define TIME_MASK 0
#endif
__device__ __forceinline__ int opaque_s(int x) { asm volatile("" : "+s"(x)); return x; }
#define PHM(bit, call) do { if constexpr ((PH_MASK & (bit)) != 0) { if constexpr ((DUP_MASK & (bit)) != 0) { const int _nrep = opaque_s(2); for (int _rep = 0; _rep < _nrep; ++_rep) { call; __syncthreads(); } } else { call; } } } while (0)
__global__ void __launch_bounds__(NTHREADS, 2) trunk_fwd(Args A) {
    extern __shared__ __attribute__((aligned(16))) unsigned char lds_raw[];
    LAS unsigned char* lds = (LAS unsigned char*)lds_raw;
    const int tid0 = threadIdx.x, wid = __builtin_amdgcn_readfirstlane(tid0 >> 6);
    const int G = gridDim.x, bx = blockIdx.x, vcu = (G % 8 == 0) ? (bx % 8) * (G / 8) + bx / 8 : bx;
    const int gw = vcu * 8 + wid, NGW = G * 8;
    const int ph_lo = A.ph_lo, ph_hi = A.ph_hi;
    unsigned long long t_acc = 0;
#if MK_ONE_LAUNCH
    if (tid0 < 2) ((volatile LAS unsigned*)(lds + LDS_XB_OFF))[tid0] = 0u;
    if (bx == 0) { unsigned* b0 = (unsigned*)(A.ws + WS_BAR); for (int i = tid0; i < XCD_BAR_WORDS; i += NTHREADS) b0[i] = 0u; }
#endif

    for (int ph = ph_lo; ph < ph_hi; ++ph) {
        const int tid = opaque(tid0), lane = tid & 63;
        ArgP Ap = (ArgP)__builtin_amdgcn_kernarg_segment_ptr();
        asm volatile("" : "+s"(Ap));
        unsigned char* ws = Ap->ws;
        bf16_t* Hb = (bf16_t*)(ws + WS_H);
        unsigned char* mixb = ws + WS_MIX;
        const float* mod = (const float*)(ws + WS_MOD);
        float* xo = Ap->out;
        int layer, step;
        if (ph < 2) { layer = -1; step = ph; }
        else if (ph < 9) { layer = 0; step = ph - 2; }
        else if (ph < 15) { layer = 1; step = ph - 9 + 1; }
        else if (ph < 21) { layer = 2; step = ph - 15 + 1; }
        else { layer = 3; step = ph - 21 + 1; }
        const int kind = layer % 3, jl = layer / 3;
        unsigned long long t_ph0 = 0; if constexpr (TIME_MASK != 0) t_ph0 = __builtin_amdgcn_s_memrealtime();
        const int nmix = 4;
        int ptype = 0;
        if (layer < 0) ptype = 1; else if (layer > 3) ptype = 2048; else if (step == 0 || step == nmix) ptype = 2;
        else if (step < nmix) ptype = (step == 1) ? 4 : (step == nmix - 1) ? 32 : (kind == 0 && step == 3) ? 16 : 8;
        else ptype = 64 << (step - nmix - 1);
        const float* macc = mod + (size_t)(layer < 0 ? 0 : (layer > 3 ? 3 : layer)) * BATCH * 6 * DM;
        const float* mbias = Ap->in[I_ADA_B] + (size_t)(layer < 0 ? 0 : (layer > 3 ? 3 : layer)) * 6 * DM;
        const float* xin = (layer == 0) ? Ap->in[I_X] : xo;

        if (layer < 0) {
            if (step == 0) { PHM(1, prologue_phase(Ap, lds, vcu, G, tid, wid, lane)); }
            else { PHM(1, modreduce_phase(Ap, vcu, G, tid));
#pragma unroll 1
                for (int pl = 0; pl < 2; ++pl) { pg8::StaticOrder S; pg8::Gemm g{(const bf16_t*)(ws + WS_POOL_WOUT) + (size_t)pl * DM * DM, (const bf16_t*)(ws + WS_WGS) + (size_t)pl * 4 * 65536, DM, DM, 256, DM, 256, 256}; S.init(DM, DM, G, bx);
                    pg8::EpiBf16<0> E{(bf16_t*)(ws + WS_WEFF) + (size_t)pl * DM * DM, DM}; PHM(0x2000, pg8::gemm_phase(lds, g, S, E)); } }
        } else if (layer > 3) {
            PHM(256, final_phase(xo, Ap->in[I_FINAL_G], gw, NGW, lane));
        } else if (step == 0) {
            PHM(2, norm_phase(xin, Ap->in[I_NORM_G] + (size_t)(layer * 2 + 0) * DM, macc, mbias, 0, DM, Hb, gw, NGW, lane));
        } else if (step < nmix) {
            pg8::StaticOrder S;
            if (kind == 0) {
                bf16_t* U = (bf16_t*)mixb; bf16_t* P = (bf16_t*)(mixb + 64 * MiB); bf16_t* Z = (bf16_t*)(mixb + 128 * MiB);
                if (step == 1) { pg8::Gemm g{Hb, (const bf16_t*)(ws + WS_POOL_WIN) + (size_t)jl * DM * DM, MTOK, DM, DM, DM, DM, 0}; S.init(MTOK, DM, G, bx);
                    pg8::EpiBf16<0> E{U, DM}; PHM(0x1000, pg8::gemm_phase(lds, g, S, E)); }
                else if (step == 2) { PHM(8, pool_elem_phase(U, P, vcu, G, tid)); }
                else { pg8::Gemm g{P, (const bf16_t*)(ws + WS_WEFF) + (size_t)jl * DM * DM, MTOK, DM, DM, DM, DM, 0}; S.init(MTOK, DM, G, bx);
                    pg8::EpiBf16<0> E{(bf16_t*)(mixb + 192 * MiB), DM}; PHM(0x8000, pg8::gemm_phase(lds, g, S, E));   }
            } else if (kind == 1) {
                bf16_t* BG = (bf16_t*)mixb; bf16_t* Z = (bf16_t*)(mixb + 64 * MiB); bf16_t* AA = (bf16_t*)(mixb + 128 * MiB);
                if (step == 1) { pg8::Gemm g{Hb, (const bf16_t*)(ws + WS_CONV_WIN), MTOK, 3 * DM, DM, DM, DM, 0}; S.init(MTOK, 3 * DM, G, bx);
                    pg8::EpiConvIn E{BG, Z}; PHM(0x4000, pg8::gemm_phase(lds, g, S, E)); }
                else if (step == 2) { PHM(16, conv_elem_phase(BG, Z, Ap->in[I_CONV_W], AA, vcu, G, tid)); }
                else { pg8::Gemm g{AA, (const bf16_t*)(ws + WS_CONV_WOUT), MTOK, DM, DM, DM, DM, 0}; S.init(MTOK, DM, G, bx);
                    pg8::EpiBf16<0> E{(bf16_t*)(mixb + 192 * MiB), DM}; PHM(0x8000, pg8::gemm_phase(lds, g, S, E));   }
            } else {
                bf16_t* UA = (bf16_t*)mixb; bf16_t* VT = (bf16_t*)(mixb + 192 * MiB);
                if (step == 1) {
                    { pg8::Gemm g{Hb, (const bf16_t*)(ws + WS_GMLP_WIN), MTOK, GH, DM, DM, DM, 0}; S.init(MTOK, GH, G, bx);
                      pg8::EpiBf16<1> E{UA, GH}; PHM(0x1000, pg8::gemm_phase(lds, g, S, E)); }
                    { pg8::Gemm g{Hb, (const bf16_t*)(ws + WS_GMLP_WIN) + (size_t)GH * DM, MTOK, GH, DM, DM, DM, 0}; S.init(MTOK, GH, G, bx);
                      pg8::EpiGmlpV E{VT}; PHM(0x10000, pg8::gemm_phase(lds, g, S, E)); }
                }
                else if (step == 2) { PHM(32, mix_phase(lds, UA, VT, Ap->in[I_GMLP_WS], Ap->in[I_GMLP_BS], Ap->in[I_GMLP_LNG], Ap->in[I_GMLP_LNB], vcu, G, tid, wid, lane)); }
                else { pg8::Gemm g{UA, (const bf16_t*)(ws + WS_GMLP_WOUT), MTOK, DM, GH, GH, GH, 0}; S.init(MTOK, DM, G, bx);
                    pg8::EpiBf16<0> E{(bf16_t*)(mixb + 192 * MiB), DM}; PHM(0x8000, pg8::gemm_phase(lds, g, S, E));   }
            }
        } else {
            const int ps = step - nmix;
            bf16_t* Qb = (bf16_t*)mixb;
            bf16_t* xs = (layer == 3) ? (bf16_t*)(mixb + 192 * MiB) : (bf16_t*)xo;
            if (ps == 0) { resnorm_phase(layer == 0 ? Ap->in[I_X] : nullptr, (const bf16_t*)xo, xs, (const bf16_t*)(mixb + 192 * MiB), macc + 2 * DM, Ap->in[I_NORM_G] + (size_t)(layer * 2 + 1) * DM, macc, 3 * DM, 4 * DM, Hb, mixb + 128 * MiB, gw, NGW, lane); }
            else if (ps == 1) { pg8::StaticOrder S; pg8::Gemm g{Hb, (const bf16_t*)(ws + WS_PEER_WQ) + (size_t)layer * DM * 2048, MTOK, 2048, DM, DM, DM, 0}; S.init(MTOK, 2048, G, bx);
                pg8::EpiQT E{Qb}; PHM(0x1000, pg8::gemm_phase(lds, g, S, E));
                asm volatile("s_waitcnt vmcnt(0)" ::: "memory"); __syncthreads();
                PHM(64, topk_units(lds, Qb, (const bf16_t*)(ws + WS_KEYS) + (size_t)layer * 16 * 128 * 128, (int*)(ws + WS_SELI), (float*)(ws + WS_SELW), S, tid, wid, lane)); }
            else { PHM(128, peer_gather_phase(lds, mixb + 128 * MiB  , (cbytes)(ws + WS_TABU) + (size_t)layer * NEXP * (DM / 2), (cbytes)(ws + WS_TABV) + (size_t)layer * NEXP * (DM / 2), (const int*)(ws + WS_SELI), (const float*)(ws + WS_SELW),
                              (const unsigned*)(ws + WS_SCU) + (size_t)layer * NEXP, xs, xo, macc + 5 * DM,
                              layer == 3 ? Ap->in[I_FINAL_G] : Ap->in[I_NORM_G] + (size_t)((layer + 1) * 2) * DM, mod + (size_t)(layer == 3 ? 3 : layer + 1) * BATCH * 6 * DM, Hb, layer == 3, vcu, G, wid, lane)); }
        }
#if MK_ONE_LAUNCH
        if constexpr (TIME_MASK != 0) if (ph + 1 >= ph_hi) { if (ptype & TIME_MASK) t_acc += __builtin_amdgcn_s_memrealtime() - t_ph0; }
        if (ph + 1 < ph_hi) {
            XcdBarrier xbar; xbar.bar = (unsigned*)(Ap->ws + WS_BAR); xbar.x = xb_xcc_id(); xbar.st = (volatile LAS unsigned*)(lds + LDS_XB_OFF);
            if (ph == ph_lo) { cg::this_grid().sync(); if (tid0 == 0) (void)xb_add(&xbar.bar[XB_XCNT(xbar.x)], 1u); }
            else { xcd_barrier(xbar); if constexpr ((DUP_MASK & 0x800) != 0) xcd_barrier(xbar); }
            if constexpr (TIME_MASK != 0) { if (ptype & TIME_MASK) t_acc += __builtin_amdgcn_s_memrealtime() - t_ph0; }
        }
#endif
    }
    if constexpr (TIME_MASK != 0) { const unsigned long long t0 = __builtin_amdgcn_s_memrealtime(); while (__builtin_amdgcn_s_memrealtime() - t0 < 4ull * t_acc) __builtin_amdgcn_s_sleep(8); }
}

extern "C" void kernel_launch(void* const* d_in, const int* in_sizes, int n_in, void* d_out, int out_size, void* d_ws, size_t ws_size, hipStream_t stream) {
    static int grid = 0;
    if (grid == 0) {
        if (n_in != 23 || in_sizes[0] != MTOK * DM || out_size != MTOK * DM || ws_size < WS_END) {
            fprintf(stderr, "kernel_launch: unexpected shapes (n_in %d, in0 %d, out %d, ws %zu; need ws >= %zu); nothing launched\n", n_in, n_in > 0 ? in_sizes[0] : -1, out_size, ws_size, (size_t)WS_END); grid = -1; return; }
        int dev = 0, cus = 0, per_cu = 0;
        if (hipGetDevice(&dev) != hipSuccess || hipDeviceGetAttribute(&cus, hipDeviceAttributeMultiprocessorCount, dev) != hipSuccess) { grid = -1; return; }
        if (hipFuncSetAttribute((const void*)trunk_fwd, hipFuncAttributeMaxDynamicSharedMemorySize, LDS_BYTES) != hipSuccess) { fprintf(stderr, "kernel_launch: hipFuncSetAttribute failed\n"); grid = -1; return; }
        if (hipOccupancyMaxActiveBlocksPerMultiprocessor(&per_cu, (const void*)trunk_fwd, NTHREADS, LDS_BYTES) != hipSuccess || per_cu < 1) { fprintf(stderr, "kernel_launch: occupancy query says %d blocks per CU\n", per_cu); (void)hipGetLastError(); grid = -1; return; }
        grid = cus * (per_cu < 1 ? 1 : 1);
    }
    if (grid < 0) return;
    Args a{};
    for (int i = 0; i < 23; ++i) a.in[i] = (const float*)d_in[i];
    a.out = (float*)d_out; a.ws = (unsigned char*)d_ws;
#if MK_ONE_LAUNCH
    a.ph_lo = 0; a.ph_hi = NPHASES;
    void* args[] = {&a};
    hipError_t e = hipLaunchCooperativeKernel((const void*)trunk_fwd, dim3(grid), dim3(NTHREADS), args, LDS_BYTES, stream);
    if (e != hipSuccess) fprintf(stderr, "cooperative launch failed: %s (grid %d)\n", hipGetErrorString(e), grid);
#else
    for (int ph = 0; ph < NPHASES; ++ph) { a.ph_lo = ph; a.ph_hi = ph + 1; hipLaunchKernelGGL(trunk_fwd, dim3(grid), dim3(NTHREADS), LDS_BYTES, stream, a); }
#endif
}
```

```cpp
#include <hip/hip_runtime.h>
#include <hip/hip_cooperative_groups.h>
#include <cstdio>
#include <cstdint>
namespace cg = cooperative_groups;

#ifndef MK_ONE_LAUNCH
#define MK_ONE_LAUNCH 1
#endif

#define LAS __attribute__((address_space(3)))
typedef unsigned short bf16_t;
typedef short bf16x8 __attribute__((ext_vector_type(8)));
typedef float f32x2 __attribute__((ext_vector_type(2)));
typedef float f32x4 __attribute__((ext_vector_type(4)));
typedef float f32x16 __attribute__((ext_vector_type(16)));
typedef unsigned u32x2 __attribute__((ext_vector_type(2)));
typedef unsigned u32x4 __attribute__((ext_vector_type(4)));
typedef int i32x4 __attribute__((ext_vector_type(4)));
typedef int i32x8 __attribute__((ext_vector_type(8)));
typedef _Float16 h16x2 __attribute__((ext_vector_type(2)));
typedef __bf16 bf16x2 __attribute__((ext_vector_type(2)));

constexpr int DM = 1024, BATCH = 8, SEQ = 4096, MTOK = BATCH * SEQ, DEPTH = 4;
constexpr int GH = 3072;
constexpr int NEXP = 16384, NPICK = 128;
constexpr float EPS = 1e-6f;

constexpr size_t MiB = 1u << 20;
constexpr size_t WS_CTL = 0, WS_SCU = 0, WS_SCV = 512 * 1024, WS_MOD = 1 * MiB, ZERO_BYTES = 2 * MiB;
constexpr size_t WS_POOL_WIN = 2 * MiB, WS_POOL_WGRP = 6 * MiB, WS_POOL_WOUT = 7 * MiB;
constexpr size_t WS_CONV_WIN = 11 * MiB, WS_CONV_WOUT = 17 * MiB;
constexpr size_t WS_GMLP_WIN = 19 * MiB, WS_GMLP_WOUT = 31 * MiB;
constexpr size_t WS_PEER_WQ = 37 * MiB, WS_KEYS = 53 * MiB;
constexpr size_t WS_H = 56 * MiB;
constexpr size_t WS_SELI = 120 * MiB, WS_SELW = 136 * MiB;
constexpr size_t WS_TABU = 152 * MiB, WS_TABV = 280 * MiB;
constexpr size_t WS_MIX = 408 * MiB;
constexpr size_t WS_ADAP = 792 * MiB;
constexpr size_t WS_COEF = 804 * MiB;
constexpr size_t WS_WEFF = 820 * MiB;
constexpr size_t WS_WGS = 824 * MiB;
constexpr size_t WS_END = 825 * MiB;

__device__ __forceinline__ unsigned cvt_pk_bf16(float lo, float hi) { unsigned r; asm volatile("v_cvt_pk_bf16_f32 %0, %1, %2" : "=v"(r) : "v"(lo), "v"(hi)); return r; }
__device__ __forceinline__ int opaque(int x) { asm volatile("" : "+v"(x)); return x; }
__device__ __forceinline__ float bf_lo(unsigned w) { return __uint_as_float(w << 16); }
__device__ __forceinline__ float bf_hi(unsigned w) { return __uint_as_float(w & 0xffff0000u); }
__device__ __forceinline__ float gelu_tanh(float x) {
    const float y = x * (1.0f + 0.044715f * x * x);
    const float e = __builtin_amdgcn_exp2f(-2.302208198f * y);
    return x * __builtin_amdgcn_rcpf(1.0f + e);
}
__device__ __forceinline__ float wave_sum_all(float v) {
#pragma unroll
    for (int o = 1; o < 64; o <<= 1) v += __shfl_xor(v, o);
    return v;
}
__device__ __forceinline__ float dot2_bf16(unsigned w, unsigned x, float acc) { return __builtin_amdgcn_fdot2_f32_bf16(__builtin_bit_cast(bf16x2, w), __builtin_bit_cast(bf16x2, x), acc, false); }


__device__ __forceinline__ float dpp_row_shr(float v, int n) {
    const int iv = __builtin_bit_cast(int, v); int r;
    switch (n) { case 1: r = __builtin_amdgcn_update_dpp(0, iv, 0x111, 0xf, 0xf, true); break; case 2: r = __builtin_amdgcn_update_dpp(0, iv, 0x112, 0xf, 0xf, true); break;
                 case 4: r = __builtin_amdgcn_update_dpp(0, iv, 0x114, 0xf, 0xf, true); break; default: r = __builtin_amdgcn_update_dpp(0, iv, 0x118, 0xf, 0xf, true); break; }
    return __builtin_bit_cast(float, r);
}
__device__ __forceinline__ float wave_sum_uniform(float v) {
    v += dpp_row_shr(v, 1); v += dpp_row_shr(v, 2); v += dpp_row_shr(v, 4); v += dpp_row_shr(v, 8);
    v += __builtin_bit_cast(float, __builtin_amdgcn_update_dpp(0, __builtin_bit_cast(int, v), 0x142, 0xa, 0xf, false));
    v += __builtin_bit_cast(float, __builtin_amdgcn_update_dpp(0, __builtin_bit_cast(int, v), 0x143, 0xc, 0xf, false));
    return __uint_as_float(__builtin_amdgcn_readlane(__float_as_uint(v), 63));
}

namespace pg8 {
constexpr int BM = 256, BK = 64, HALF = 128, HTB = HALF * BK * 2, STAGE_BYTES = 8 * HTB, NXCD = 8, WGM = 8;
__device__ __forceinline__ int lds_byte(int r, int c) { const int st = (r >> 4) * 2 + (c >> 5), rr = r & 15, cc = c & 31, ob = rr * 64 + cc * 2; return st * 1024 + (ob ^ (((ob >> 9) & 1) << 5)); }
__device__ __forceinline__ void stage_rc(int b, int& R, int& C) { const int st = b / 1024, sb = b % 1024, swz = sb ^ (((sb >> 9) & 1) << 5); R = (st >> 1) * 16 + swz / 64; C = (st & 1) * 32 + (swz % 64) / 2; }
__device__ __forceinline__ int perm32(int rho) { const int n = rho >> 4, i = rho & 15; return 8 * (i >> 2) + 4 * n + (i & 3); }

struct Unit { int pm, pn; };
struct Gemm { const bf16_t* A; const bf16_t* Bt; int M, N, K, lda, ldb, a_pn_off; };

struct StaticOrder {
    int nM, nN, nwg, G, c;
    __device__ __forceinline__ void init(int M, int N, int G_, int c_) { nM = M / BM; nN = N / BM; nwg = nM * nN; G = G_; c = c_; }
    __device__ __forceinline__ bool next(int i, Unit& u) const {
        const int L = i * G + c; if (L >= nwg) return false;
        int wgid = L; { const int q = nwg / NXCD, r = nwg % NXCD, xcd = wgid % NXCD, off = wgid / NXCD; wgid = (xcd < r ? xcd * (q + 1) : r * (q + 1) + (xcd - r) * q) + off; }
        const int nig = WGM * nN, gid = wgid / nig, fm = gid * WGM, gsz = (nM - fm) < WGM ? (nM - fm) : WGM;
        u.pm = fm + ((wgid % nig) % gsz); u.pn = (wgid % nig) / gsz; return true;
    }
};

template <class Epi>
__device__ __forceinline__ void gemm_phase(LAS unsigned char* lds, const Gemm g, const StaticOrder& S, const Epi& E) {
    const int tid = opaque((int)threadIdx.x), wid = __builtin_amdgcn_readfirstlane(tid >> 6), lane = tid & 63, wr = wid >> 2, wc = wid & 3, fr = lane & 15, fq = lane >> 4;
    int nt = g.K / BK; asm volatile("" : "+s"(nt));
    unsigned voffA[2], voffB[2];
#pragma unroll
    for (int i = 0; i < 2; ++i) { int R, C; stage_rc(tid * 16 + i * 8192, R, C); const int Rb = Epi::PERM ? ((R & ~31) + perm32(R & 31)) : R;
        voffA[i] = (unsigned)(R * g.lda + C) * 2u; voffB[i] = (unsigned)(Rb * g.ldb + C) * 2u; }
    const size_t kstep = (size_t)(BK * 2);
    const size_t hstepA = (size_t)HALF * g.lda * 2, hstepB = (size_t)HALF * g.ldb * 2;
    const size_t tstepA = 2 * hstepA, tstepB = 2 * hstepB;
    const unsigned ldsw = (unsigned)wid * 1024u;
    const int aoff = lds_byte(wr * 64 + fr, fq * 8), boff = lds_byte(wc * 32 + fr, fq * 8);
#define PG8_SA(b, h) (((b) * 2 + (h)) * HTB)
#define PG8_SB(b, h) ((4 + (b) * 2 + (h)) * HTB)
#define PG8_STAGE(bufoff, gbase, voff) do { _Pragma("unroll") for (int _i = 0; _i < 2; ++_i) \
        __builtin_amdgcn_global_load_lds((const unsigned*)((const char*)(gbase) + (voff)[_i]), (LAS unsigned*)(lds + (bufoff) + ldsw + _i * 8192), 16, 0, 0); } while (0)
#define PG8_LDA(dst, b, h) do { _Pragma("unroll") for (int m = 0; m < 4; ++m) _Pragma("unroll") for (int k = 0; k < 2; ++k) dst[m][k] = *(const LAS bf16x8*)(lds + PG8_SA(b, h) + aoff + m * 2048 + k * 1024); } while (0)
#define PG8_LDB(dst, b, h) do { _Pragma("unroll") for (int n = 0; n < 2; ++n) _Pragma("unroll") for (int k = 0; k < 2; ++k) dst[n][k] = *(const LAS bf16x8*)(lds + PG8_SB(b, h) + boff + n * 2048 + k * 1024); } while (0)
#define PG8_MMA(ai, bj, At, Bt) do { __builtin_amdgcn_s_setprio(1); _Pragma("unroll") for (int m = 0; m < 4; ++m) _Pragma("unroll") for (int n = 0; n < 2; ++n) _Pragma("unroll") for (int k = 0; k < 2; ++k) \
        acc[ai][bj][m][n] = Epi::SWAP ? __builtin_amdgcn_mfma_f32_16x16x32_bf16(At[m][k], Bt[n][k], acc[ai][bj][m][n], 0, 0, 0) \
                                      : __builtin_amdgcn_mfma_f32_16x16x32_bf16(Bt[n][k], At[m][k], acc[ai][bj][m][n], 0, 0, 0); __builtin_amdgcn_s_setprio(0); } while (0)
#define PG8_WAIT_V(n) asm volatile("s_waitcnt vmcnt(" #n ")" ::: "memory")
#define PG8_WAIT_L(n) asm volatile("s_waitcnt lgkmcnt(" #n ")" ::: "memory")
#define PG8_BAR __builtin_amdgcn_s_barrier()
#define PG8_SCHED __builtin_amdgcn_sched_barrier(0)
    Unit cur, nxt; int ui = 0;
    if (!S.next(0, cur)) return;
    f32x4 acc[2][2][4][2];
#pragma unroll
    for (int a = 0; a < 2; ++a)
#pragma unroll
        for (int b = 0; b < 2; ++b)
#pragma unroll
            for (int m = 0; m < 4; ++m)
#pragma unroll
                for (int n = 0; n < 2; ++n) acc[a][b][m][n] = (f32x4){0.f, 0.f, 0.f, 0.f};
    bf16x8 At[4][2], B0[2][2], B1[2][2];
    const char* cA = (const char*)g.A + (size_t)cur.pm * tstepA + (size_t)cur.pn * g.a_pn_off * 2; const char* cB = (const char*)g.Bt + (size_t)cur.pn * tstepB;
    PG8_STAGE(PG8_SB(0, 0), cB, voffB); PG8_STAGE(PG8_SB(0, 1), cB + hstepB, voffB); PG8_STAGE(PG8_SA(0, 0), cA, voffA); PG8_STAGE(PG8_SA(0, 1), cA + hstepA, voffA);
    if (wr == 1) PG8_BAR;
    PG8_WAIT_V(2); PG8_BAR;
    PG8_STAGE(PG8_SB(1, 0), cB + kstep, voffB); PG8_STAGE(PG8_SA(1, 0), cA + kstep, voffA); PG8_STAGE(PG8_SB(1, 1), cB + hstepB + kstep, voffB);
    PG8_WAIT_V(6); PG8_BAR;
    for (;;) {
        const bool has_next = S.next(ui + 1, nxt);
        const char* nA = has_next ? (const char*)g.A + (size_t)nxt.pm * tstepA + (size_t)nxt.pn * g.a_pn_off * 2 : cA; const char* nB = has_next ? (const char*)g.Bt + (size_t)nxt.pn * tstepB : cB;
        for (int t = 0; t < nt; t += 2) {
            const bool last = (t == nt - 2);
            const char* a1 = cA + (size_t)(t + 1) * kstep;
            const char* a2 = last ? nA : cA + (size_t)(t + 2) * kstep; const char* b2 = last ? nB : cB + (size_t)(t + 2) * kstep;
            const char* a3 = a2 + kstep; const char* b3 = b2 + kstep;
            PG8_LDB(B0, 0, 0); PG8_LDB(B1, 0, 1); PG8_SCHED; PG8_LDA(At, 0, 0); PG8_STAGE(PG8_SA(1, 1), a1 + hstepA, voffA);
            PG8_WAIT_V(8); PG8_WAIT_L(0); PG8_BAR; PG8_MMA(0, 0, At, B0); PG8_MMA(0, 1, At, B1); PG8_BAR; PG8_SCHED;
            PG8_LDA(At, 0, 1); PG8_STAGE(PG8_SB(0, 0), b2, voffB); PG8_STAGE(PG8_SB(0, 1), b2 + hstepB, voffB); PG8_STAGE(PG8_SA(0, 0), a2, voffA);
            PG8_WAIT_V(8); PG8_WAIT_L(0); PG8_BAR; PG8_MMA(1, 0, At, B0); PG8_MMA(1, 1, At, B1); PG8_BAR; PG8_SCHED;
            PG8_LDB(B0, 1, 0); PG8_LDB(B1, 1, 1); PG8_SCHED; PG8_LDA(At, 1, 0); PG8_STAGE(PG8_SA(0, 1), a2 + hstepA, voffA);
            PG8_WAIT_V(8); PG8_WAIT_L(0); PG8_BAR; PG8_MMA(0, 0, At, B0); PG8_MMA(0, 1, At, B1); PG8_BAR; PG8_SCHED;
            PG8_LDA(At, 1, 1); PG8_STAGE(PG8_SB(1, 0), b3, voffB); PG8_STAGE(PG8_SB(1, 1), b3 + hstepB, voffB); PG8_STAGE(PG8_SA(1, 0), a3, voffA);
            PG8_WAIT_V(8); PG8_WAIT_L(0); PG8_BAR; PG8_MMA(1, 0, At, B0); PG8_MMA(1, 1, At, B1); PG8_BAR; PG8_SCHED;
        }
        { const int l2 = opaque((int)threadIdx.x) & 63; E(acc, cur, wr, wc, l2 & 15, l2 >> 4); }
        if (!has_next) break;
#pragma unroll
        for (int a = 0; a < 2; ++a)
#pragma unroll
            for (int b = 0; b < 2; ++b)
#pragma unroll
                for (int m = 0; m < 4; ++m)
#pragma unroll
                    for (int n = 0; n < 2; ++n) acc[a][b][m][n] = (f32x4){0.f, 0.f, 0.f, 0.f};
        cur = nxt; cA = nA; cB = nB; ++ui;
    }
    PG8_WAIT_V(0);
    if (wr == 0) PG8_BAR;
    PG8_BAR;
#undef PG8_SA
#undef PG8_SB
#undef PG8_STAGE
#undef PG8_LDA
#undef PG8_LDB
#undef PG8_MMA
#undef PG8_WAIT_V
#undef PG8_WAIT_L
#undef PG8_BAR
#undef PG8_SCHED
}

template <int ACT> struct EpiBf16 {
    static constexpr bool PERM = true, SWAP = false;
    bf16_t* O; int ldc;
    __device__ __forceinline__ void operator()(const f32x4 (&acc)[2][2][4][2], const Unit& u, int wr, int wc, int fr, int fq) const {
        const int row0 = u.pm * BM + wr * 64 + fr, col0 = u.pn * BM + wc * 32 + 8 * fq;
#pragma unroll
        for (int ai = 0; ai < 2; ++ai)
#pragma unroll
            for (int m = 0; m < 4; ++m) { bf16_t* rowp = O + (size_t)(row0 + ai * HALF + m * 16) * ldc + col0;
#pragma unroll
                for (int bj = 0; bj < 2; ++bj) { f32x4 v0 = acc[ai][bj][m][0], v1 = acc[ai][bj][m][1];
                    if (ACT == 1) {
#pragma unroll
                        for (int j = 0; j < 4; ++j) { v0[j] = gelu_tanh(v0[j]); v1[j] = gelu_tanh(v1[j]); } }
                    u32x4 w; w.x = cvt_pk_bf16(v0[0], v0[1]); w.y = cvt_pk_bf16(v0[2], v0[3]); w.z = cvt_pk_bf16(v1[0], v1[1]); w.w = cvt_pk_bf16(v1[2], v1[3]);
                    *(u32x4*)(rowp + bj * HALF) = w; } }
    }
};
struct EpiQT {
    static constexpr bool PERM = true, SWAP = false;
    bf16_t* O;
    __device__ __forceinline__ void operator()(const f32x4 (&acc)[2][2][4][2], const Unit& u, int wr, int wc, int fr, int fq) const {
        const int row0 = u.pm * BM + wr * 64 + fr;
#pragma unroll
        for (int ai = 0; ai < 2; ++ai)
#pragma unroll
            for (int m = 0; m < 4; ++m) { const int row = row0 + ai * HALF + m * 16;
                bf16_t* base = O + ((size_t)((row >> 7) * 8 + u.pn) * 32 * 128 + (row & 127)) * 8;
#pragma unroll
                for (int bj = 0; bj < 2; ++bj) { const f32x4 v0 = acc[ai][bj][m][0], v1 = acc[ai][bj][m][1];
                    u32x4 w; w.x = cvt_pk_bf16(v0[0], v0[1]); w.y = cvt_pk_bf16(v0[2], v0[3]); w.z = cvt_pk_bf16(v1[0], v1[1]); w.w = cvt_pk_bf16(v1[2], v1[3]);
                    *(u32x4*)(base + (size_t)(16 * bj + 4 * wc + fq) * 128 * 8) = w; } }
    }
};
struct EpiPoolGrp {
    static constexpr bool PERM = true, SWAP = false;
    bf16_t* O; const float* scale;
    __device__ __forceinline__ void operator()(const f32x4 (&acc)[2][2][4][2], const Unit& u, int wr, int wc, int fr, int fq) const {
        const int row0 = u.pm * BM + wr * 64 + fr, col0 = u.pn * BM + wc * 32 + 8 * fq;
#pragma unroll
        for (int bj = 0; bj < 2; ++bj) {
            const f32x4 s0 = *(const f32x4*)(scale + col0 + bj * HALF), s1 = *(const f32x4*)(scale + col0 + bj * HALF + 4);
#pragma unroll
            for (int ai = 0; ai < 2; ++ai)
#pragma unroll
                for (int m = 0; m < 4; ++m) { bf16_t* rowp = O + (size_t)(row0 + ai * HALF + m * 16) * DM + col0 + bj * HALF;
                    const f32x4 v0 = acc[ai][bj][m][0] * s0, v1 = acc[ai][bj][m][1] * s1;
                    u32x4 w; w.x = cvt_pk_bf16(v0[0], v0[1]); w.y = cvt_pk_bf16(v0[2], v0[3]); w.z = cvt_pk_bf16(v1[0], v1[1]); w.w = cvt_pk_bf16(v1[2], v1[3]);
                    *(u32x4*)rowp = w; }
            asm volatile("" ::: "memory");
        }
    }
};
struct EpiConvIn {
    static constexpr bool PERM = true, SWAP = false;
    bf16_t* BG; bf16_t* Z;
    __device__ __forceinline__ void operator()(const f32x4 (&acc)[2][2][4][2], const Unit& u, int wr, int wc, int fr, int fq) const {
        const int row0 = u.pm * BM + wr * 64 + fr;
        if (u.pn < 4) {
            const int col0 = u.pn * BM + wc * 32 + 8 * fq;
#pragma unroll
            for (int ai = 0; ai < 2; ++ai)
#pragma unroll
                for (int m = 0; m < 4; ++m) { bf16_t* rowp = BG + (size_t)(row0 + ai * HALF + m * 16) * DM + col0;
#pragma unroll
                    for (int bj = 0; bj < 2; ++bj) { const f32x4 v0 = acc[ai][bj][m][0], v1 = acc[ai][bj][m][1];
                        u32x4 w; w.x = cvt_pk_bf16(v0[0], v0[1]); w.y = cvt_pk_bf16(v0[2], v0[3]); w.z = cvt_pk_bf16(v1[0], v1[1]); w.w = cvt_pk_bf16(v1[2], v1[3]);
                        *(u32x4*)(rowp + bj * HALF) = w; } }
        } else {
            const int col0 = (u.pn - 4) * HALF + wc * 32 + 8 * fq;
#pragma unroll
            for (int ai = 0; ai < 2; ++ai)
#pragma unroll
                for (int m = 0; m < 4; ++m) { bf16_t* rowp = Z + (size_t)(row0 + ai * HALF + m * 16) * DM + col0;
                    const f32x4 v0 = acc[ai][0][m][0] * acc[ai][1][m][0], v1 = acc[ai][0][m][1] * acc[ai][1][m][1];
                    u32x4 w; w.x = cvt_pk_bf16(v0[0], v0[1]); w.y = cvt_pk_bf16(v0[2], v0[3]); w.z = cvt_pk_bf16(v1[0], v1[1]); w.w = cvt_pk_bf16(v1[2], v1[3]);
                    *(u32x4*)rowp = w; }
        }
    }
};
struct EpiResid {
    static constexpr bool PERM = false, SWAP = false;
    const float* base; float* out; const float* gacc; const float* gbias;
    __device__ __forceinline__ void operator()(const f32x4 (&acc)[2][2][4][2], const Unit& u, int wr, int wc, int fr, int fq) const {
        const int row0 = u.pm * BM + wr * 64 + fr, col0 = u.pn * BM + wc * 32 + 4 * fq;
        const float* gp = gacc + (size_t)(u.pm >> 4) * (6 * DM);
#pragma unroll
        for (int bj = 0; bj < 2; ++bj)
#pragma unroll
            for (int n = 0; n < 2; ++n) { const int cc = col0 + bj * HALF + n * 16;
                const f32x4 gv = *(const f32x4*)(gp + cc);
#pragma unroll
                for (int ai = 0; ai < 2; ++ai) {
#pragma unroll
                    for (int m = 0; m < 4; ++m) { const size_t off = (size_t)(row0 + ai * HALF + m * 16) * DM + cc;
                        const f32x4 bs = *(const f32x4*)(base + off);
                        *(f32x4*)(out + off) = bs + gv * acc[ai][bj][m][n]; }
                    asm volatile("" ::: "memory"); } }
    }
};
struct EpiGmlpV {
    static constexpr bool PERM = false, SWAP = true;
    bf16_t* VT;
    __device__ __forceinline__ void operator()(const f32x4 (&acc)[2][2][4][2], const Unit& u, int wr, int wc, int fr, int fq) const {
        const int row0 = u.pm * BM + wr * 64 + 4 * fq, col0 = u.pn * BM + wc * 32 + fr;
#pragma unroll
        for (int bj = 0; bj < 2; ++bj)
#pragma unroll
            for (int n = 0; n < 2; ++n) { const int c = col0 + bj * HALF + n * 16;
#pragma unroll
                for (int ai = 0; ai < 2; ++ai)
#pragma unroll
                    for (int m = 0; m < 4; ++m) { const f32x4 v = acc[ai][bj][m][n]; const int r = row0 + ai * HALF + m * 16;
                        u32x2 w; w.x = cvt_pk_bf16(gelu_tanh(v[0]), gelu_tanh(v[1])); w.y = cvt_pk_bf16(gelu_tanh(v[2]), gelu_tanh(v[3]));
                        *(u32x2*)(VT + ((size_t)(r >> 7) * GH + c) * 128 + (r & 127)) = w; } }
    }
};
}

constexpr int RING_BYTES = 131072;
constexpr int LDS_BYTES = 147456;
constexpr int LDS_XB_OFF = LDS_BYTES - 64;
constexpr int NTHREADS = 512;

#define CE_DESC(a, b) do { const float _x = fmaxf(a, b), _y = fminf(a, b); a = _x; b = _y; } while (0)
#define CE_ASC(a, b)  do { const float _x = fminf(a, b), _y = fmaxf(a, b); a = _x; b = _y; } while (0)
template <int OFF, int N>
__device__ __forceinline__ void sort16_desc(float (&v)[N]) {
#pragma unroll
    for (int k = 2; k <= 16; k <<= 1)
#pragma unroll
        for (int j = k >> 1; j > 0; j >>= 1)
#pragma unroll
            for (int i = 0; i < 16; ++i) { const int l = i ^ j; if (l > i) { if ((i & k) == 0) CE_DESC(v[OFF + i], v[OFF + l]); else CE_ASC(v[OFF + i], v[OFF + l]); } }
}
template <int OFF, int N>
__device__ __forceinline__ void bmerge16_desc(float (&v)[N]) {
#pragma unroll
    for (int j = 8; j > 0; j >>= 1)
#pragma unroll
        for (int i = 0; i < 16; ++i) { const int l = i ^ j; if (l > i) CE_DESC(v[OFF + i], v[OFF + l]); }
}
template <int A, int B, int N>
__device__ __forceinline__ void merge_top16(float (&v)[N]) {
#pragma unroll
    for (int i = 0; i < 16; ++i) v[A + i] = fmaxf(v[A + i], v[B + 15 - i]);
    bmerge16_desc<A, N>(v);
}
__device__ __forceinline__ void top16_of_64(float (&v)[64]) {
    sort16_desc<0, 64>(v); sort16_desc<16, 64>(v); sort16_desc<32, 64>(v); sort16_desc<48, 64>(v);
    merge_top16<0, 16, 64>(v); merge_top16<32, 48, 64>(v); merge_top16<0, 32, 64>(v);
}

struct Args { const float* in[23]; float* out; unsigned char* ws; int ph_lo, ph_hi; };
typedef const __attribute__((address_space(4))) Args* ArgP;
enum { I_X = 0, I_C, I_ADA_W, I_ADA_B, I_NORM_G, I_POOL_WIN, I_POOL_WGRP, I_POOL_SCALE, I_POOL_WOUT, I_CONV_WIN, I_CONV_W, I_CONV_WOUT,
       I_GMLP_WIN, I_GMLP_LNG, I_GMLP_LNB, I_GMLP_WS, I_GMLP_BS, I_GMLP_WOUT, I_PEER_WQ, I_PEER_KEYS, I_PEER_U, I_PEER_V, I_FINAL_G };

__device__ __forceinline__ void transpose_item(const float* W, int K, int N, bf16_t* WT, int dst_row0, LAS float* scr, int k0, int n0, int lane) {
#pragma unroll 8
    for (int i = 0; i < 32; ++i) { const int kk = 2 * i + (lane >> 5); scr[kk * 33 + (lane & 31)] = W[(size_t)(k0 + kk) * N + n0 + (lane & 31)]; }
    asm volatile("s_waitcnt lgkmcnt(0)" ::: "memory");
    const int c = lane & 7;
#pragma unroll
    for (int j = 0; j < 4; ++j) { const int n = (lane >> 3) + 8 * j; const LAS float* s = scr + (8 * c) * 33 + n;
        u32x4 o; o.x = cvt_pk_bf16(s[0 * 33], s[1 * 33]); o.y = cvt_pk_bf16(s[2 * 33], s[3 * 33]); o.z = cvt_pk_bf16(s[4 * 33], s[5 * 33]); o.w = cvt_pk_bf16(s[6 * 33], s[7 * 33]);
        *(u32x4*)(WT + (size_t)(dst_row0 + n) * K + k0 + 8 * c) = o; }
    asm volatile("s_waitcnt lgkmcnt(0)" ::: "memory");
}
__device__ __forceinline__ void convert_stream(const float* src, bf16_t* dst, size_t n8, size_t gt, size_t stride) {
    for (size_t i = gt; i < n8; i += stride) {
        const f32x4 a = __builtin_nontemporal_load((const f32x4*)src + 2 * i), b = __builtin_nontemporal_load((const f32x4*)src + 2 * i + 1);
        u32x4 o; o.x = cvt_pk_bf16(a[0], a[1]); o.y = cvt_pk_bf16(a[2], a[3]); o.z = cvt_pk_bf16(b[0], b[1]); o.w = cvt_pk_bf16(b[2], b[3]);
        *((u32x4*)dst + i) = o; }
}
__device__ __forceinline__ unsigned e2m1_code(float a) { const float aa = fabsf(a);
    const unsigned c = (aa > 0.25f ? 1u : 0u) + (aa > 0.75f ? 1u : 0u) + (aa > 1.25f ? 1u : 0u) + (aa > 1.75f ? 1u : 0u) + (aa > 2.5f ? 1u : 0u) + (aa > 3.5f ? 1u : 0u) + (aa > 5.0f ? 1u : 0u);
    return c | ((__builtin_bit_cast(unsigned, a) >> 28) & 8u); }
__device__ __forceinline__ void prologue_phase(ArgP Ap, LAS unsigned char* lds, int vcu, int G, int tid, int wid, int lane) {
    unsigned char* ws = Ap->ws;
    const int gw = vcu * 8 + wid, NGW = G * 8;
    LAS float* scr = (LAS float*)(lds + wid * 16384);
    constexpr int NT_ITEMS = 1024 + 256 + 1024 + 1536 + 512 + 3072 + 1536 + 4096;
    for (int it = gw; it < NT_ITEMS; it += NGW) {
        int r = it; const float* src; bf16_t* dst; int K, N, kind = 0;
        if (r < 1024) { const int m = r >> 9; r &= 511; src = Ap->in[I_POOL_WIN] + (size_t)m * DM * DM; dst = (bf16_t*)(ws + WS_POOL_WIN) + (size_t)m * DM * DM; K = DM; N = DM; }
        else if ((r -= 1024) < 256) { const int m = r >> 5; r &= 31; src = Ap->in[I_POOL_WGRP] + (size_t)m * 65536; dst = (bf16_t*)(ws + WS_POOL_WGRP) + (size_t)m * 65536; K = 256; N = 256; }
        else if ((r -= 256) < 1024) { const int m = r >> 9; r &= 511; src = Ap->in[I_POOL_WOUT] + (size_t)m * DM * DM; dst = (bf16_t*)(ws + WS_POOL_WOUT) + (size_t)m * DM * DM; K = DM; N = DM; }
        else if ((r -= 1024) < 1536) { src = Ap->in[I_CONV_WIN]; dst = (bf16_t*)(ws + WS_CONV_WIN); K = DM; N = 3 * DM; kind = 1; }
        else if ((r -= 1536) < 512) { src = Ap->in[I_CONV_WOUT]; dst = (bf16_t*)(ws + WS_CONV_WOUT); K = DM; N = DM; }
        else if ((r -= 512) < 3072) { src = Ap->in[I_GMLP_WIN]; dst = (bf16_t*)(ws + WS_GMLP_WIN); K = DM; N = 2 * GH; }
        else if ((r -= 3072) < 1536) { src = Ap->in[I_GMLP_WOUT]; dst = (bf16_t*)(ws + WS_GMLP_WOUT); K = GH; N = DM; }
        else { r -= 1536; const int m = r >> 10; r &= 1023; src = Ap->in[I_PEER_WQ] + (size_t)m * DM * 2048; dst = (bf16_t*)(ws + WS_PEER_WQ) + (size_t)m * DM * 2048; K = DM; N = 2048; }
        const int nblk = N / 32, kb = r / nblk, nb = r % nblk, n0 = 32 * nb;
        int drow = n0;
        if (kind == 1 && n0 >= DM) { const int xt = n0 >= 2 * DM, ch = n0 - (xt ? 2 * DM : DM); drow = DM + 256 * (ch >> 7) + 128 * xt + (ch & 127); }
        transpose_item(src, K, N, dst, drow, scr, 64 * kb, n0, lane);
    }
    const size_t gt = (size_t)vcu * NTHREADS + tid, stride = (size_t)G * NTHREADS;
    convert_stream(Ap->in[I_PEER_KEYS], (bf16_t*)(ws + WS_KEYS), (size_t)DEPTH * 16 * 128 * 128 / 8, gt, stride);
    for (int row0 = gw * 4; row0 < 2 * DEPTH * NEXP; row0 += NGW * 4) {
        f32x4 v[4][4]; float m[4];
#pragma unroll
        for (int rr = 0; rr < 4; ++rr) { const int row = row0 + rr, tab = row >> 16, lrow = row & 65535;
            const f32x4* src = (const f32x4*)((tab ? Ap->in[I_PEER_V] : Ap->in[I_PEER_U]) + (size_t)lrow * DM) + lane;
#pragma unroll
            for (int j = 0; j < 4; ++j) v[rr][j] = __builtin_nontemporal_load(src + 64 * j); }
#pragma unroll
        for (int rr = 0; rr < 4; ++rr) { float mm = 0.f;
#pragma unroll
            for (int j = 0; j < 4; ++j) mm = fmaxf(fmaxf(mm, fmaxf(fabsf(v[rr][j][0]), fabsf(v[rr][j][1]))), fmaxf(fabsf(v[rr][j][2]), fabsf(v[rr][j][3])));
#pragma unroll
            for (int o = 1; o < 64; o <<= 1) mm = fmaxf(mm, __shfl_xor(mm, o));
            m[rr] = mm; }
#pragma unroll
        for (int rr = 0; rr < 4; ++rr) { const int row = row0 + rr, tab = row >> 16, lrow = row & 65535, l = lrow >> 14, e = lrow & (NEXP - 1);
            if (tab) {
                const float S = m[rr] > 0.f ? (7.5f / 0.7f) / m[rr] : 1.0f;
#pragma unroll
                for (int j = 0; j < 4; ++j) { unsigned c[4];
#pragma unroll
                    for (int q = 0; q < 4; ++q) c[q] = (unsigned)fminf(fmaxf(floorf(v[rr][j][q] * S + 8.0f), 0.f), 15.f);
                    unsigned pk = c[0] | (c[1] << 4) | (c[2] << 16) | (c[3] << 20); if (lane & 1) pk <<= 8;
                    pk |= (unsigned)__shfl_xor((int)pk, 1);
                    if (!(lane & 1)) *(unsigned*)(ws + WS_TABV + (((size_t)l * 4 + j) * NEXP + e) * 128 + 2 * lane) = pk; }
            } else {
                const float S = m[rr] > 0.f ? (6.0f / 0.9f) / m[rr] : 1.0f;
#pragma unroll
                for (int j = 0; j < 4; ++j) { unsigned pk = e2m1_code(v[rr][j][0] * S) | (e2m1_code(v[rr][j][1] * S) << 4) | (e2m1_code(v[rr][j][2] * S) << 8) | (e2m1_code(v[rr][j][3] * S) << 12);
                    pk |= (unsigned)__shfl_xor((int)pk, 1) << 16;
                    if (!(lane & 1)) *(unsigned*)(ws + WS_TABU + (((size_t)l * 4 + j) * NEXP + e) * 128 + 2 * lane) = pk; }
            }
            if (lane == 0) ((unsigned short*)(ws + WS_SCU))[2 * lrow + tab] = (unsigned short)(cvt_pk_bf16(m[rr] > 0.f ? m[rr] * (tab ? 0.7f / 7.5f : 0.9f / 6.0f) : 1.0f, 0.f) & 0xffffu); }
    }
    for (size_t i = gt; i < (size_t)2 * 4 * 256 * 256 / 8; i += stride) { const size_t idx = i * 8; const int l = (int)(idx >> 18), g = (int)(idx >> 16) & 3, j0 = (int)idx & 255;
        const f32x4 a = *((const f32x4*)Ap->in[I_POOL_WGRP] + 2 * i), b = *((const f32x4*)Ap->in[I_POOL_WGRP] + 2 * i + 1);
        const float* sp = Ap->in[I_POOL_SCALE] + (size_t)l * DM + 256 * g + j0; const f32x4 sa = *(const f32x4*)sp, sb = *(const f32x4*)(sp + 4);
        u32x4 o; o.x = cvt_pk_bf16(a[0] * sa[0], a[1] * sa[1]); o.y = cvt_pk_bf16(a[2] * sa[2], a[3] * sa[3]); o.z = cvt_pk_bf16(b[0] * sb[0], b[1] * sb[1]); o.w = cvt_pk_bf16(b[2] * sb[2], b[3] * sb[3]);
        *((u32x4*)(ws + WS_WGS) + i) = o; }
    __syncthreads();
    LAS float* cond = (LAS float*)lds;
    for (int i = tid; i < BATCH * DM; i += NTHREADS) { const int b = i >> 10, k = i & 1023; const float c = Ap->in[I_C][i]; cond[k * 8 + b] = c * __builtin_amdgcn_rcpf(1.0f + __expf(-c)); }
    __syncthreads();
    float* modp = (float*)(ws + WS_ADAP);
    for (int it = gw; it < DEPTH * 24 * 16; it += NGW) {
        const int l = it / 384, r = it % 384, cgp = r >> 4, kc = r & 15;
        const float* wp = Ap->in[I_ADA_W] + ((size_t)l * DM + kc * 64) * (6 * DM) + cgp * 256 + 4 * lane;
        f32x4 acc[8];
#pragma unroll
        for (int b = 0; b < 8; ++b) acc[b] = (f32x4){0.f, 0.f, 0.f, 0.f};
#pragma unroll 8
        for (int k = 0; k < 64; ++k) { const f32x4 w = __builtin_nontemporal_load((const f32x4*)(wp + (size_t)k * (6 * DM)));
            const f32x4 c0 = *(const LAS f32x4*)(cond + (kc * 64 + k) * 8), c1 = *(const LAS f32x4*)(cond + (kc * 64 + k) * 8 + 4);
            acc[0] += c0[0] * w; acc[1] += c0[1] * w; acc[2] += c0[2] * w; acc[3] += c0[3] * w; acc[4] += c1[0] * w; acc[5] += c1[1] * w; acc[6] += c1[2] * w; acc[7] += c1[3] * w; }
#pragma unroll
        for (int b = 0; b < 8; ++b) *(f32x4*)(modp + (((size_t)kc * DEPTH + l) * 8 + b) * (6 * DM) + cgp * 256 + 4 * lane) = acc[b];
    }
}
__device__ __forceinline__ void modreduce_phase(ArgP Ap, int vcu, int G, int tid) {
    unsigned char* ws = Ap->ws; const float* modp = (const float*)(ws + WS_ADAP); float* mod = (float*)(ws + WS_MOD);
    constexpr int N4 = DEPTH * BATCH * 6 * DM / 4;
    for (int i = vcu * NTHREADS + tid; i < N4; i += G * NTHREADS) {
        const int n4 = i % (6 * DM / 4), l = i / (BATCH * 6 * DM / 4);
        f32x4 a = *((const f32x4*)(Ap->in[I_ADA_B] + (size_t)l * 6 * DM) + n4);
#pragma unroll
        for (int kc = 0; kc < 16; ++kc) a += *((const f32x4*)modp + (size_t)kc * N4 + i);
        *((f32x4*)mod + i) = a; }
}

__device__ __forceinline__ void norm_phase(const float* x, const float* gn, const float* macc  , const float* mbias  , int sh_off, int sc_off, bf16_t* H, int gw, int NGW, int lane) {
    for (int ch = gw; ch < MTOK / 16; ch += NGW) {
        const int row0 = ch * 16, b = row0 >> 12;
        f32x4 c1[4], shv[4];
#pragma unroll
        for (int j = 0; j < 4; ++j) { const int col = 4 * lane + 256 * j;
            const f32x4 sc = *(const f32x4*)(macc + (size_t)b * 6 * DM + sc_off + col);
            c1[j] = *(const f32x4*)(gn + col) * (1.0f + sc);
            shv[j] = *(const f32x4*)(macc + (size_t)b * 6 * DM + sh_off + col); }
        for (int r = row0; r < row0 + 16; ++r) {
            const f32x4* xr = (const f32x4*)(x + (size_t)r * DM) + lane;
            f32x4 v[4]; float ss = 0.f;
#pragma unroll
            for (int j = 0; j < 4; ++j) { v[j] = xr[64 * j]; ss += (v[j][0] * v[j][0] + v[j][1] * v[j][1]) + (v[j][2] * v[j][2] + v[j][3] * v[j][3]); }
            const float rstd = __builtin_amdgcn_rsqf(wave_sum_all(ss) * (1.0f / DM) + EPS);
            u32x2* o8 = (u32x2*)(H + (size_t)r * DM) + lane;
#pragma unroll
            for (int j = 0; j < 4; ++j) { const f32x4 o = v[j] * rstd * c1[j] + shv[j]; u32x2 w; w.x = cvt_pk_bf16(o[0], o[1]); w.y = cvt_pk_bf16(o[2], o[3]); o8[64 * j] = w; }
        }
    }
}
__device__ __forceinline__ void resnorm_phase(const float* xf  , const bf16_t* xsi, bf16_t* xso  , const bf16_t* Y, const float* gate  , const float* gn, const float* macc, int sh_off, int sc_off, bf16_t* H, unsigned char* H8  , int gw, int NGW, int lane) {
    for (int ch = gw; ch < MTOK / 16; ch += NGW) {
        const int row0 = ch * 16, b = row0 >> 12;
        f32x4 c1[4], shv[4], gt[4];
#pragma unroll
        for (int j = 0; j < 4; ++j) { const int col = 4 * lane + 256 * j;
            const f32x4 sc = *(const f32x4*)(macc + (size_t)b * 6 * DM + sc_off + col);
            c1[j] = *(const f32x4*)(gn + col) * (1.0f + sc);
            shv[j] = *(const f32x4*)(macc + (size_t)b * 6 * DM + sh_off + col);
            gt[j] = *(const f32x4*)(gate + (size_t)b * 6 * DM + col); }
#pragma unroll 1
        for (int r0 = row0; r0 < row0 + 16; r0 += 4) {
            u32x2 yv[4][4]; f32x4 v[4][4];
#pragma unroll
            for (int rr = 0; rr < 4; ++rr) { const u32x2* yr = (const u32x2*)(Y + (size_t)(r0 + rr) * DM) + lane;
#pragma unroll
                for (int j = 0; j < 4; ++j) yv[rr][j] = yr[64 * j]; }
            if (xf) {
#pragma unroll
                for (int rr = 0; rr < 4; ++rr) { const f32x4* xr = (const f32x4*)(xf + (size_t)(r0 + rr) * DM) + lane;
#pragma unroll
                    for (int j = 0; j < 4; ++j) v[rr][j] = xr[64 * j]; } }
            else { u32x2 xv[4][4];
#pragma unroll
                for (int rr = 0; rr < 4; ++rr) { const u32x2* xr = (const u32x2*)(xsi + (size_t)(r0 + rr) * DM) + lane;
#pragma unroll
                    for (int j = 0; j < 4; ++j) xv[rr][j] = xr[64 * j]; }
#pragma unroll
                for (int rr = 0; rr < 4; ++rr)
#pragma unroll
                    for (int j = 0; j < 4; ++j) v[rr][j] = (f32x4){bf_lo(xv[rr][j].x), bf_hi(xv[rr][j].x), bf_lo(xv[rr][j].y), bf_hi(xv[rr][j].y)}; }
            float ss[4];
#pragma unroll
            for (int rr = 0; rr < 4; ++rr) { float q = 0.f;
#pragma unroll
                for (int j = 0; j < 4; ++j) { const u32x2 y = yv[rr][j]; v[rr][j] += gt[j] * (f32x4){bf_lo(y.x), bf_hi(y.x), bf_lo(y.y), bf_hi(y.y)};
                    q += (v[rr][j][0] * v[rr][j][0] + v[rr][j][1] * v[rr][j][1]) + (v[rr][j][2] * v[rr][j][2] + v[rr][j][3] * v[rr][j][3]); }
                ss[rr] = q; }
#pragma unroll
            for (int o = 1; o < 64; o <<= 1) {
#pragma unroll
                for (int rr = 0; rr < 4; ++rr) ss[rr] += __shfl_xor(ss[rr], o); }
#pragma unroll
            for (int rr = 0; rr < 4; ++rr) { const int r = r0 + rr; const float rstd = __builtin_amdgcn_rsqf(ss[rr] * (1.0f / DM) + EPS);
                u32x2* xw = (u32x2*)(xso + (size_t)r * DM) + lane; u32x2* o8 = (u32x2*)(H + (size_t)r * DM) + lane; int* q8 = (int*)(H8 + (size_t)r * DM) + lane;
#pragma unroll
                for (int j = 0; j < 4; ++j) { u32x2 w; w.x = cvt_pk_bf16(v[rr][j][0], v[rr][j][1]); w.y = cvt_pk_bf16(v[rr][j][2], v[rr][j][3]); xw[64 * j] = w;
                    const f32x4 o = v[rr][j] * rstd * c1[j] + shv[j]; w.x = cvt_pk_bf16(o[0], o[1]); w.y = cvt_pk_bf16(o[2], o[3]); o8[64 * j] = w;
                    int pk = __builtin_amdgcn_cvt_pk_fp8_f32(o[0], o[1], 0, false); pk = __builtin_amdgcn_cvt_pk_fp8_f32(o[2], o[3], pk, true); q8[64 * j] = pk; } }
        }
    }
}
__device__ __forceinline__ void final_phase(float* x, const float* gf, int gw, int NGW, int lane) {
    f32x4 gv[4];
#pragma unroll
    for (int j = 0; j < 4; ++j) gv[j] = *(const f32x4*)(gf + 4 * lane + 256 * j);
    for (int r = gw; r < MTOK; r += NGW) {
        f32x4* xr = (f32x4*)(x + (size_t)r * DM) + lane;
        f32x4 v[4]; float ss = 0.f;
#pragma unroll
        for (int j = 0; j < 4; ++j) { v[j] = xr[64 * j]; ss += (v[j][0] * v[j][0] + v[j][1] * v[j][1]) + (v[j][2] * v[j][2] + v[j][3] * v[j][3]); }
        const float rstd = __builtin_amdgcn_rsqf(wave_sum_all(ss) * (1.0f / DM) + EPS);
#pragma unroll
        for (int j = 0; j < 4; ++j) xr[64 * j] = v[j] * rstd * gv[j];
    }
}

__device__ __forceinline__ void unpack8(const u32x4 w, float (&f)[8]) { f[0] = bf_lo(w.x); f[1] = bf_hi(w.x); f[2] = bf_lo(w.y); f[3] = bf_hi(w.y); f[4] = bf_lo(w.z); f[5] = bf_hi(w.z); f[6] = bf_lo(w.w); f[7] = bf_hi(w.w); }
__device__ __forceinline__ u32x4 pack8(const float (&f)[8]) { u32x4 o; o.x = cvt_pk_bf16(f[0], f[1]); o.y = cvt_pk_bf16(f[2], f[3]); o.z = cvt_pk_bf16(f[4], f[5]); o.w = cvt_pk_bf16(f[6], f[7]); return o; }
__device__ __forceinline__ void pool_elem_phase(const bf16_t* U, bf16_t* P, int vcu, int G, int tid) {
    const int chunk = tid & 127, run = tid >> 7, c0 = 8 * chunk, w = 2 << (c0 >> 8);
    for (int unit = vcu; unit < MTOK / 128; unit += G) {
        const int t0 = unit * 128 + run * 32, seq0 = t0 & ~(SEQ - 1);
        float s[8];
#pragma unroll
        for (int j = 0; j < 8; ++j) s[j] = 0.f;
        for (int tau = t0 - w; tau < t0; ++tau) if (tau >= seq0) { float f[8];     unpack8(*(const u32x4*)(U + (size_t)tau * DM + c0), f);
#pragma unroll
            for (int j = 0; j < 8; ++j) s[j] += f[j]; }
#pragma unroll 1
        for (int tb = t0; tb < t0 + 32; tb += 8) {
            u32x4 cur[8], old[8];
#pragma unroll
            for (int i = 0; i < 8; ++i) { cur[i] = *(const u32x4*)(U + (size_t)(tb + i) * DM + c0);
                const int tl = tb + i - w; old[i] = *(const u32x4*)(U + (size_t)(tl >= seq0 ? tl : seq0) * DM + c0); }
#pragma unroll
            for (int i = 0; i < 8; ++i) { const int t = tb + i; float f[8], o[8]; unpack8(cur[i], f);
#pragma unroll
                for (int j = 0; j < 8; ++j) s[j] += f[j];
                if (t - w >= seq0) { float q[8]; unpack8(old[i], q);
#pragma unroll
                    for (int j = 0; j < 8; ++j) s[j] -= q[j]; }
                const int pos1 = t - seq0 + 1; const float inv = 1.0f / (float)(pos1 < w ? pos1 : w);
#pragma unroll
                for (int j = 0; j < 8; ++j) o[j] = s[j] * inv - f[j];
                *(u32x4*)(P + (size_t)t * DM + c0) = pack8(o); }
        }
    }
}
__device__ __forceinline__ void conv_elem_phase(const bf16_t* BG, const bf16_t* Z, const float* cw  , bf16_t* Aout, int vcu, int G, int tid) {
    const int chunk = tid & 127, run = tid >> 7, c0 = 8 * chunk;
    float w0[8], w1[8], w2[8];
#pragma unroll
    for (int j = 0; j < 8; ++j) { w0[j] = cw[c0 + j]; w1[j] = cw[DM + c0 + j]; w2[j] = cw[2 * DM + c0 + j]; }
    for (int unit = vcu; unit < MTOK / 128; unit += G) {
        const int t0 = unit * 128 + run * 32, seq0 = t0 & ~(SEQ - 1);
        float zm2[8], zm1[8];
#pragma unroll
        for (int j = 0; j < 8; ++j) { zm2[j] = 0.f; zm1[j] = 0.f; }
        if (t0 - 2 >= seq0) unpack8(*(const u32x4*)(Z + (size_t)(t0 - 2) * DM + c0), zm2);
        if (t0 - 1 >= seq0) unpack8(*(const u32x4*)(Z + (size_t)(t0 - 1) * DM + c0), zm1);
#pragma unroll 1
        for (int tb = t0; tb < t0 + 32; tb += 8) {
            u32x4 zr[8], br[8];
#pragma unroll
            for (int i = 0; i < 8; ++i) { zr[i] = *(const u32x4*)(Z + (size_t)(tb + i) * DM + c0); br[i] = *(const u32x4*)(BG + (size_t)(tb + i) * DM + c0); }
#pragma unroll
            for (int i = 0; i < 8; ++i) { float z[8], bg[8], o[8]; unpack8(zr[i], z); unpack8(br[i], bg);
#pragma unroll
                for (int j = 0; j < 8; ++j) { o[j] = bg[j] * (w0[j] * zm2[j] + w1[j] * zm1[j] + w2[j] * z[j]); zm2[j] = zm1[j]; zm1[j] = z[j]; }
                *(u32x4*)(Aout + (size_t)(tb + i) * DM + c0) = pack8(o); }
        }
    }
}

__device__ __forceinline__ int wp_off(int row, int chunk) { return row * 256 + ((chunk ^ (row & 15)) << 4); }
__device__ __forceinline__ void mix_phase(LAS unsigned char* lds, bf16_t* UA, const bf16_t* VT, const float* WS, const float* BS, const float* LNG, const float* LNB, int vcu, int G, int tid, int wid, int lane) {
    LAS unsigned char* WP = lds;
    LAS float* MU = (LAS float*)(lds + 32768); LAS float* RSTD = MU + 128; LAS float* R1 = MU + 256; LAS float* R2 = MU + 384;
    LAS float* PART = (LAS float*)(lds + 36864);
    LAS unsigned char* VS = lds + 36864;
    for (int n = vcu; n < MTOK / 128; n += G) {
        {
            const int cgp = tid >> 4, tl = tid & 15;
            float s[8], q[8];
#pragma unroll
            for (int j = 0; j < 8; ++j) { s[j] = 0.f; q[j] = 0.f; }
#pragma unroll 4
            for (int it = 0; it < GH / 32; ++it) { float f[8]; unpack8(*(const u32x4*)(VT + ((size_t)n * GH + it * 32 + cgp) * 128 + tl * 8), f);
#pragma unroll
                for (int j = 0; j < 8; ++j) { s[j] += f[j]; q[j] += f[j] * f[j]; } }
#pragma unroll
            for (int j = 0; j < 8; ++j) { PART[(cgp * 128 + tl * 8 + j) * 2] = s[j]; PART[(cgp * 128 + tl * 8 + j) * 2 + 1] = q[j]; }
            __syncthreads();
            if (tid < 128) { float S = 0.f, Q = 0.f;
                for (int k = 0; k < 32; ++k) { S += PART[(k * 128 + tid) * 2]; Q += PART[(k * 128 + tid) * 2 + 1]; }
                const float mu = S * (1.0f / GH), var = Q * (1.0f / GH) - mu * mu; MU[tid] = mu; RSTD[tid] = __builtin_amdgcn_rsqf(fmaxf(var, 0.f) + EPS); }
            __syncthreads();
        }
        for (int g = 0; g < 8; ++g) {
            const int fr = lane & 15, fq = lane >> 4, cbase = g * 384 + wid * 48;
            bf16x8 av[4][3];
#pragma unroll
            for (int ks = 0; ks < 4; ++ks)
#pragma unroll
                for (int ct = 0; ct < 3; ++ct) av[ks][ct] = *(const bf16x8*)(VT + ((size_t)n * GH + cbase + ct * 16 + fr) * 128 + ks * 32 + fq * 8);
            {
                const int i = tid >> 2, part = tid & 3;
                const float* wrow = WS + ((size_t)g * 128 + i) * 128 + part * 32;
                float r1 = 0.f, r2 = 0.f;
#pragma unroll
                for (int jj = 0; jj < 32; jj += 8) { const int j0 = part * 32 + jj;
                    f32x4 a = *(const f32x4*)(wrow + jj), b = *(const f32x4*)(wrow + jj + 4);
                    if (i < 64 && j0 >= 64) { a = (f32x4){0.f, 0.f, 0.f, 0.f}; b = a; }
                    const f32x4 ra = *(const LAS f32x4*)(RSTD + j0), rb = *(const LAS f32x4*)(RSTD + j0 + 4), ma = *(const LAS f32x4*)(MU + j0), mb = *(const LAS f32x4*)(MU + j0 + 4);
                    const f32x4 wa = a * ra, wb = b * rb;
                    r1 += (wa[0] * ma[0] + wa[1] * ma[1]) + (wa[2] * ma[2] + wa[3] * ma[3]) + (wb[0] * mb[0] + wb[1] * mb[1]) + (wb[2] * mb[2] + wb[3] * mb[3]);
                    r2 += (a[0] + a[1]) + (a[2] + a[3]) + (b[0] + b[1]) + (b[2] + b[3]);
                    u32x4 o; o.x = cvt_pk_bf16(wa[0], wa[1]); o.y = cvt_pk_bf16(wa[2], wa[3]); o.z = cvt_pk_bf16(wb[0], wb[1]); o.w = cvt_pk_bf16(wb[2], wb[3]);
                    *(LAS u32x4*)(WP + wp_off(i, j0 >> 3)) = o; }
                r1 += __shfl_xor(r1, 1); r1 += __shfl_xor(r1, 2); r2 += __shfl_xor(r2, 1); r2 += __shfl_xor(r2, 2);
                if (part == 0) { R1[i] = r1; R2[i] = r2; }
            }
            __syncthreads();
            f32x4 acc[3][8];
#pragma unroll
            for (int ct = 0; ct < 3; ++ct)
#pragma unroll
                for (int it = 0; it < 8; ++it) acc[ct][it] = (f32x4){0.f, 0.f, 0.f, 0.f};
#pragma unroll
            for (int ks = 0; ks < 4; ++ks) {
#pragma unroll
                for (int it = 0; it < 8; ++it) { const bf16x8 bw = *(const LAS bf16x8*)(WP + wp_off(it * 16 + fr, ks * 4 + fq));
#pragma unroll
                    for (int ct = 0; ct < 3; ++ct) acc[ct][it] = __builtin_amdgcn_mfma_f32_16x16x32_bf16(av[ks][ct], bw, acc[ct][it], 0, 0, 0); }
                __builtin_amdgcn_sched_barrier(0);
            }
#pragma unroll
            for (int ct = 0; ct < 3; ++ct) { const int c4 = cbase + ct * 16 + 4 * fq;
                const f32x4 lg = *(const f32x4*)(LNG + c4), lb = *(const f32x4*)(LNB + c4);
#pragma unroll
                for (int it = 0; it < 8; ++it) { const int i = it * 16 + fr; const float r1 = R1[i], r2 = R2[i], bs = BS[g * 128 + i];
                    const f32x4 vs = lg * (acc[ct][it] - r1) + lb * r2 + bs;
                    u32x2 o; o.x = cvt_pk_bf16(vs[0], vs[1]); o.y = cvt_pk_bf16(vs[2], vs[3]);
                    *(LAS u32x2*)(VS + i * 784 + (wid * 48 + ct * 16 + 4 * fq) * 2) = o; } }
            __syncthreads();
#pragma unroll 4
            for (int c = tid; c < 128 * 48; c += NTHREADS) { const int tok = c / 48, ch8 = c - tok * 48;
                const u32x4 vv = *(const LAS u32x4*)(VS + tok * 784 + ch8 * 16);
                u32x4* up = (u32x4*)(UA + (size_t)(n * 128 + tok) * GH + g * 384 + ch8 * 8); const u32x4 uu = *up;
                u32x4 o; o.x = cvt_pk_bf16(bf_lo(uu.x) * bf_lo(vv.x), bf_hi(uu.x) * bf_hi(vv.x)); o.y = cvt_pk_bf16(bf_lo(uu.y) * bf_lo(vv.y), bf_hi(uu.y) * bf_hi(vv.y));
                o.z = cvt_pk_bf16(bf_lo(uu.z) * bf_lo(vv.z), bf_hi(uu.z) * bf_hi(vv.z)); o.w = cvt_pk_bf16(bf_lo(uu.w) * bf_lo(vv.w), bf_hi(uu.w) * bf_hi(vv.w));
                *up = o; }
            __syncthreads();
        }
    }
}

__device__ __forceinline__ void topk_units(LAS unsigned char* lds, const bf16_t* Q, const bf16_t* KEYS, int* SELI, float* SELW, const pg8::StaticOrder& S, int tid, int wid, int lane) {
    LAS unsigned char* kl = lds;
    LAS float* topv = (LAS float*)(lds + 65536);
    const int p = wid >> 2, sub = wid & 3, tl = lane & 31, hi = lane >> 5;
    int hprev = -1;
#pragma unroll 1
    for (int k = 0; ; k = (k & 1) ? k + 3 : k + 1) {
        pg8::Unit ua, ub; if (!S.next(k, ua)) break;
        const bool hasb = S.next(k + 2, ub);
        const bool pair = hasb && ub.pn == ua.pn;
#pragma unroll 1
        for (int part = 0; part < ((hasb && !pair) ? 2 : 1); ++part) {
            const int h = part ? ub.pn : ua.pn, pm0 = part ? ub.pm : ua.pm, pm1 = ub.pm, ntile = pair ? 4 : 2;
            __syncthreads();
            if (h != hprev) {
                for (int c = tid; c < 4096; c += NTHREADS) { const int row = c >> 4, ch = c & 15;
                    const u32x4 v = *(const u32x4*)(KEYS + ((size_t)h * 256 + row) * 128 + ch * 8);
                    *(LAS u32x4*)(kl + row * 256 + ((ch ^ (row & 15)) << 4)) = v; }
                hprev = h; }
            __syncthreads();
#pragma unroll 1
            for (int t4 = 0; t4 < ntile; ++t4) {
                const int tile = 2 * (t4 < 2 ? pm0 : pm1) + (t4 & 1);
                const bf16_t* qrow = Q + ((size_t)((tile * 8 + h) * 32 + 16 * p + hi) * 128 + sub * 32 + tl) * 8;
                bf16x8 bq[8];
#pragma unroll
                for (int ks = 0; ks < 8; ++ks) bq[ks] = *(const bf16x8*)(qrow + (size_t)ks * 2 * 128 * 8);
                f32x16 acc[4];
#pragma unroll
                for (int kt = 0; kt < 4; ++kt)
#pragma unroll
                    for (int r = 0; r < 16; ++r) acc[kt][r] = 0.f;
#pragma unroll
                for (int ks = 0; ks < 8; ++ks)
#pragma unroll
                    for (int kt = 0; kt < 4; ++kt) { const int row = p * 128 + kt * 32 + tl;
                        const bf16x8 ak = *(const LAS bf16x8*)(kl + row * 256 + (((2 * ks + hi) ^ (row & 15)) << 4));
                        acc[kt] = __builtin_amdgcn_mfma_f32_32x32x16_bf16(ak, bq[ks], acc[kt], 0, 0, 0); }
                float v[64];
#pragma unroll
                for (int kt = 0; kt < 4; ++kt)
#pragma unroll
                    for (int r = 0; r < 16; ++r) { const unsigned key = (unsigned)(kt * 32 + (r & 3) + 8 * (r >> 2) + 4 * hi);
                        v[kt * 16 + r] = __uint_as_float((__float_as_uint(acc[kt][r]) & ~127u) | key); }
                top16_of_64(v);
                float m[16];
#pragma unroll
                for (int i = 0; i < 16; ++i) m[i] = fmaxf(v[i], __shfl_xor(v[15 - i], 32));
                bmerge16_desc<0, 16>(m);
                if (hi == 0) { LAS f32x4* dst = (LAS f32x4*)(topv + ((t4 * 2 + p) * 128 + sub * 32 + tl) * 16);
#pragma unroll
                    for (int i = 0; i < 4; ++i) dst[i] = (f32x4){m[4 * i], m[4 * i + 1], m[4 * i + 2], m[4 * i + 3]}; }
            }
            __syncthreads();
            if (tid < ntile * 128) {
                const int t4 = tid >> 7, tok = tid & 127, tile = 2 * (t4 < 2 ? pm0 : pm1) + (t4 & 1);
                const LAS float* t0 = topv + ((t4 * 2 + 0) * 128 + tok) * 16; const LAS float* t1 = topv + ((t4 * 2 + 1) * 128 + tok) * 16;
                float s0[16], s1[16];
#pragma unroll
                for (int i = 0; i < 4; ++i) { const f32x4 a = *(const LAS f32x4*)(t0 + 4 * i), b = *(const LAS f32x4*)(t1 + 4 * i);
                    s0[4 * i] = a[0]; s0[4 * i + 1] = a[1]; s0[4 * i + 2] = a[2]; s0[4 * i + 3] = a[3]; s1[4 * i] = b[0]; s1[4 * i + 1] = b[1]; s1[4 * i + 2] = b[2]; s1[4 * i + 3] = b[3]; }
                float c[64];
                constexpr int pre[16] = {0, 16, 24, 29, 33, 36, 38, 40, 42, 43, 44, 45, 46, 47, 48, 49};
#pragma unroll
                for (int a = 0; a < 16; ++a)
#pragma unroll
                    for (int b = 0; b < 16; ++b) if ((a + 1) * (b + 1) <= 16) c[pre[a] + b] = __uint_as_float((__float_as_uint(s0[a] + s1[b]) & ~255u) | (unsigned)(a * 16 + b));
#pragma unroll
                for (int i = 50; i < 64; ++i) c[i] = -3.0e38f;
                top16_of_64(c);
                float e[16], sum = 0.f;
#pragma unroll
                for (int kk = 0; kk < 16; ++kk) { e[kk] = __builtin_amdgcn_exp2f((c[kk] - c[0]) * 1.44269504f); sum += e[kk]; }
                const float inv = 1.0f / sum;
                const size_t o = (size_t)(tile * 128 + tok) * NPICK + h * 16;
#pragma unroll
                for (int k4 = 0; k4 < 4; ++k4) { i32x4 ei; f32x4 wv;
#pragma unroll
                    for (int j = 0; j < 4; ++j) { const unsigned code = __float_as_uint(c[4 * k4 + j]) & 255u;
                        const unsigned i1 = __float_as_uint(t0[code >> 4]) & 127u, i2 = __float_as_uint(t1[code & 15u]) & 127u;
                        ei[j] = (int)(i1 * 128u + i2); wv[j] = e[4 * k4 + j] * inv; }
                    *(i32x4*)(SELI + o + 4 * k4) = ei; *(f32x4*)(SELW + o + 4 * k4) = wv; }
            }
        }
    }
    __syncthreads();
}

typedef const unsigned char* cbytes;
#ifndef DUP_MASK
#define DUP_MASK 0
#endif
template <int CTRL> __device__ __forceinline__ float dpp_f(float v) { return __builtin_bit_cast(float, __builtin_amdgcn_update_dpp(0, __builtin_bit_cast(int, v), CTRL, 0xf, 0xf, false)); }
#define DPP_F(v, ctrl) dpp_f<(ctrl)>(v)
#define PG_IDX(EV, TKN) do { const LAS u32x4* _ip = (const LAS u32x4*)(idxw + (TKN) * 128 + 16 * g8); \
        _Pragma("unroll") for (int q = 0; q < 2; ++q) { const u32x4 _e = _ip[q]; _Pragma("unroll") for (int w = 0; w < 4; ++w) { EV[8 * q + 2 * w] = (int)(_e[w] & 0xffffu); EV[8 * q + 2 * w + 1] = (int)(_e[w] >> 16); } } } while (0)
#define PG_GATHER8(BUF, SL, EV, J0) do { _Pragma("unroll") for (int j = 0; j < 8; ++j) BUF[j] = *(const u32x4*)((SL) + ((unsigned)EV[(J0) + j] * 128u + s8 * 16u)); } while (0)
#define PGU_IDX(EV, TKN) do { const LAS u32x4* _ip = (const LAS u32x4*)(idxw + (TKN) * 128 + 16 * slotA); \
        _Pragma("unroll") for (int q = 0; q < 2; ++q) { const u32x4 _e = _ip[q]; _Pragma("unroll") for (int w = 0; w < 4; ++w) { EV[8 * q + 2 * w] = (int)(_e[w] & 0xffffu); EV[8 * q + 2 * w + 1] = (int)(_e[w] >> 16); } } } while (0)
#define PGU_GATHER8(BUF, SL, EV, M0) do { _Pragma("unroll") for (int j = 0; j < 8; ++j) BUF[j] = *(const u32x4*)((SL) + ((unsigned)EV[4 * (((M0) + j) & 3) + (((M0) + j) >> 2)] * 128u + pieceA * 16u)); } while (0)
#define PGU_HB(HR, IT) do { const int _it = (IT) < 63 ? (IT) : 63; HR = *(const u32x4*)(H8 + (size_t)(tk0 + (_it & 15)) * DM + (((xg + (_it >> 4)) & 3) * 256) + hoffB); } while (0)
#define PGU_MMA8(BUF, HR, ACC, M0) do { const i32x8 _b = {blo ? (int)HR.x : 0, blo ? (int)HR.y : 0, blo ? (int)HR.z : 0, blo ? (int)HR.w : 0, bhi ? (int)HR.x : 0, bhi ? (int)HR.y : 0, bhi ? (int)HR.z : 0, bhi ? (int)HR.w : 0}; \
        _Pragma("unroll") for (int j = 0; j < 8; ++j) { const u32x4 _u = BUF[j]; const i32x8 _a = {(int)_u.x, (int)_u.y, (int)_u.z, (int)_u.w, 0, 0, 0, 0}; \
            const f32x4 _d = __builtin_amdgcn_mfma_scale_f32_16x16x128_f8f6f4(_a, _b, (f32x4){0.f, 0.f, 0.f, 0.f}, 4, 0, 0, 0, 0, 0); \
            float _v = i4 == 0 ? _d[0] : i4 == 1 ? _d[1] : i4 == 2 ? _d[2] : _d[3]; _v += DPP_F(_v, 0xB1); _v += DPP_F(_v, 0x4E); \
            ACC[((M0) + j) >> 2] = (i4 == (((M0) + j) & 3)) ? _v : ACC[((M0) + j) >> 2]; } } while (0)
#define PGU_DOTS(ACC, TKN) do { if (n16 < 8) { LAS f32x4* _dp = (LAS f32x4*)(dotw + (TKN) * 128 + 32 * c4 + 4 * n16); *_dp += ACC; } } while (0)
#define PG_VCOMP8(BUF, CV, J0) do { _Pragma("unroll") for (int j = 0; j < 8; ++j) { const u32x4 v = BUF[j]; const float c = CV[(J0) + j]; \
            acc[0] += c * __builtin_amdgcn_cvt_pk_f32_fp8(v.x, false); acc[1] += c * __builtin_amdgcn_cvt_pk_f32_fp8(v.x, true); \
            acc[2] += c * __builtin_amdgcn_cvt_pk_f32_fp8(v.y, false); acc[3] += c * __builtin_amdgcn_cvt_pk_f32_fp8(v.y, true); \
            acc[4] += c * __builtin_amdgcn_cvt_pk_f32_fp8(v.z, false); acc[5] += c * __builtin_amdgcn_cvt_pk_f32_fp8(v.z, true); \
            acc[6] += c * __builtin_amdgcn_cvt_pk_f32_fp8(v.w, false); acc[7] += c * __builtin_amdgcn_cvt_pk_f32_fp8(v.w, true); } } while (0)
#define PG_COEF(CV, TKN) do { const LAS f32x4* _cp = (const LAS f32x4*)(dotw + (TKN) * 128 + 16 * g8); \
        _Pragma("unroll") for (int q = 0; q < 4; ++q) { const f32x4 _c = _cp[q]; CV[4 * q] = _c[0]; CV[4 * q + 1] = _c[1]; CV[4 * q + 2] = _c[2]; CV[4 * q + 3] = _c[3]; } } while (0)
#define PG_COEF8(CV, TKN, J0) do { const LAS f32x4* _cp = (const LAS f32x4*)(dotw + (TKN) * 128 + 16 * g8 + (J0)); \
        const f32x4 _c0 = _cp[0], _c1 = _cp[1]; CV[0] = _c0[0]; CV[1] = _c0[1]; CV[2] = _c0[2]; CV[3] = _c0[3]; CV[4] = _c1[0]; CV[5] = _c1[1]; CV[6] = _c1[2]; CV[7] = _c1[3]; } while (0)
#define PG_XOFFS(IT) ((size_t)(tk0 + ((IT) & 15)) * DM + (((xg + ((IT) >> 4)) & 7) * 128) + xoff)
#define PG_XADDR(IT) (x + PG_XOFFS(IT))
#define PG_XLOAD(XV, IT) do { XV = *(const unsigned*)PG_XADDR(IT); } while (0)
__device__ __forceinline__ void peer_gather_phase(LAS unsigned char* lds, const unsigned char* H8  , cbytes TUP, cbytes TVP, const int* SELI, const float* SELW, const unsigned* SC, bf16_t* x  , float* outf  , const float* gacc, const float* gn_next  , const float* mod_next  , bf16_t* Hout, bool last, int vcu, int G, int wid, int lane) {
    const int g8 = lane >> 3, s8 = lane & 7, n16 = lane & 15, c4 = lane >> 4, i4 = lane & 3, slotA = 2 * ((lane >> 2) & 3) + (c4 >> 1), pieceA = 4 * (c4 & 1) + i4, hoffB = 128 * (c4 >> 1) + 32 * i4 + 16 * (c4 & 1);
    const bool blo = n16 < 4, bhi = n16 >= 4 && n16 < 8;
    const bool b3 = (lane & 8) != 0, b4 = (lane & 16) != 0, b5 = (lane & 32) != 0;
    const int xoff = s8 * 16 + 8 * (g8 & 1) + 4 * ((g8 >> 1) & 1) + 2 * (g8 >> 2);
    LAS unsigned short* idxw = (LAS unsigned short*)(lds + wid * 12288);
    LAS float* csw = (LAS float*)(lds + 98304 + wid * 64);
    LAS float* dotw = (LAS float*)(lds + wid * 12288 + 4096);
    for (int blk = vcu; blk < 256; blk += G) {
        const int xg = blk >> 5, tk0 = blk * 128 + wid * 16;
        const int nrep_u = (DUP_MASK & 0x20000) ? opaque(2) : 1;
#pragma unroll 1
        for (int rep_u = 0; rep_u < nrep_u; ++rep_u) {
#pragma unroll 4
        for (int i = 0; i < 16; ++i) { const int e0 = SELI[(size_t)(tk0 + i) * NPICK + lane], e1 = SELI[(size_t)(tk0 + i) * NPICK + 64 + lane];
            idxw[i * 128 + lane] = (unsigned short)e0; idxw[i * 128 + 64 + lane] = (unsigned short)e1; dotw[i * 128 + lane] = 0.f; dotw[i * 128 + 64 + lane] = 0.f; }
        asm volatile("" ::: "memory");
        {
            int ev[16]; u32x4 bufA[8], bufB[8], bufC[8], bufD[8]; u32x4 hr0, hr1;
            { cbytes sl0 = TUP + (size_t)(xg & 3) * NEXP * 128;
              PGU_IDX(ev, 0); PGU_GATHER8(bufA, sl0, ev, 0); PGU_GATHER8(bufB, sl0, ev, 8);
              PGU_IDX(ev, 1); PGU_GATHER8(bufC, sl0, ev, 0); PGU_GATHER8(bufD, sl0, ev, 8); }
            PGU_HB(hr0, 0); PGU_HB(hr1, 1);
#pragma unroll 1
            for (int it = 0; it < 64; it += 2) {
                const int tkn = it & 15, it2 = it + 2 < 63 ? it + 2 : 63, it3 = it + 3 < 63 ? it + 3 : 63;
                cbytes sl2 = TUP + (size_t)((xg + (it2 >> 4)) & 3) * NEXP * 128;
                f32x4 acc4 = {0.f, 0.f, 0.f, 0.f};
                PGU_IDX(ev, it2 & 15);
                PGU_MMA8(bufA, hr0, acc4, 0); __builtin_amdgcn_sched_barrier(0);
                PGU_GATHER8(bufA, sl2, ev, 0); __builtin_amdgcn_sched_barrier(0);
                PGU_MMA8(bufB, hr0, acc4, 8); __builtin_amdgcn_sched_barrier(0);
                PGU_GATHER8(bufB, sl2, ev, 8); PGU_HB(hr0, it + 2); __builtin_amdgcn_sched_barrier(0);
                PGU_DOTS(acc4, tkn);
                acc4 = (f32x4){0.f, 0.f, 0.f, 0.f};
                PGU_IDX(ev, it3 & 15);
                PGU_MMA8(bufC, hr1, acc4, 0); __builtin_amdgcn_sched_barrier(0);
                PGU_GATHER8(bufC, sl2, ev, 0); __builtin_amdgcn_sched_barrier(0);
                PGU_MMA8(bufD, hr1, acc4, 8); __builtin_amdgcn_sched_barrier(0);
                PGU_GATHER8(bufD, sl2, ev, 8); PGU_HB(hr1, it + 3); __builtin_amdgcn_sched_barrier(0);
                PGU_DOTS(acc4, tkn + 1);
            }
        }
        asm volatile("" ::: "memory");
        }
#pragma unroll 2
        for (int i = 0; i < 16; ++i) {
            float csum = 0.f;
#pragma unroll
            for (int hh = 0; hh < 2; ++hh) { const int k = 16 * g8 + s8 + 8 * hh; const int e = idxw[i * 128 + k];
                const float w = SELW[(size_t)(tk0 + i) * NPICK + k]; const unsigned sc = SC[e];
                const float cf = w * gelu_tanh(dotw[i * 128 + k] * bf_lo(sc)) * bf_hi(sc); csum += cf;
                const float cl = fminf(fmaxf(cf, -15.0f), 15.0f);
                ((LAS unsigned*)dotw)[i * 128 + k] = __builtin_bit_cast(unsigned, __builtin_amdgcn_cvt_pkrtz(cl * 4096.0f, cl * 256.0f)); }
            csum = wave_sum_all(csum); if (lane == 0) csw[i] = csum; }
        asm volatile("" ::: "memory");
        {
            const int xoffv = 32 * s8 + 16 * (g8 & 1) + 8 * ((g8 >> 1) & 1) + 4 * (g8 >> 2);
            const float* gp = gacc + (size_t)(tk0 >> 12) * 6 * DM + xoffv;
            int ev[16]; u32x4 bufA[8], bufB[8], bufC[8], bufD[8]; unsigned cC[8]; u32x2 x0, x1;
#define PGV_XADDR(IT) (x + (size_t)(tk0 + ((IT) & 15)) * DM + (((xg + ((IT) >> 4)) & 3) * 256) + xoffv)
#define PGV_COEF8(CV, TKN, J0) do { const LAS u32x4* _cp = (const LAS u32x4*)((LAS unsigned*)dotw + (TKN) * 128 + 16 * g8 + (J0)); \
        const u32x4 _c0 = _cp[0], _c1 = _cp[1]; CV[0] = _c0[0]; CV[1] = _c0[1]; CV[2] = _c0[2]; CV[3] = _c0[3]; CV[4] = _c1[0]; CV[5] = _c1[1]; CV[6] = _c1[2]; CV[7] = _c1[3]; } while (0)
#define PGV_COMP8(BUF, CV) do { _Pragma("unroll") for (int j = 0; j < 8; ++j) { const u32x4 _v = BUF[j]; const h16x2 _c = __builtin_bit_cast(h16x2, CV[j]); const h16x2 _cl = {_c.x, _c.x}, _ch = {_c.y, _c.y}; \
            _Pragma("unroll") for (int w = 0; w < 4; ++w) { const unsigned _x = _v[w], _y = _x >> 8; \
                acc[4 * w + 0] = __builtin_elementwise_fma(__builtin_bit_cast(h16x2, _x & 0x000F000Fu), _cl, acc[4 * w + 0]); \
                acc[4 * w + 1] = __builtin_elementwise_fma(__builtin_bit_cast(h16x2, _x & 0x00F000F0u), _ch, acc[4 * w + 1]); \
                acc[4 * w + 2] = __builtin_elementwise_fma(__builtin_bit_cast(h16x2, _y & 0x000F000Fu), _cl, acc[4 * w + 2]); \
                acc[4 * w + 3] = __builtin_elementwise_fma(__builtin_bit_cast(h16x2, _y & 0x00F000F0u), _ch, acc[4 * w + 3]); } } } while (0)
#define PGV_ADD(A, B) (__builtin_bit_cast(unsigned, __builtin_bit_cast(h16x2, (A)) + __builtin_bit_cast(h16x2, (B))))
#define PGV_REDUCE_STORE(XV, IT) do { unsigned k8[8]; \
                _Pragma("unroll") for (int j = 0; j < 8; ++j) { const unsigned lo = __builtin_bit_cast(unsigned, acc[j]), hi = __builtin_bit_cast(unsigned, acc[8 + j]); \
                    const unsigned snd = b3 ? lo : hi, kp = b3 ? hi : lo; k8[j] = PGV_ADD(kp, (unsigned)__builtin_amdgcn_update_dpp(0, (int)snd, 0x128, 0xf, 0xf, false)); } \
                unsigned k4[4]; _Pragma("unroll") for (int j = 0; j < 4; ++j) { const unsigned snd = b4 ? k8[j] : k8[4 + j], kp = b4 ? k8[4 + j] : k8[j]; k4[j] = PGV_ADD(kp, (unsigned)__shfl_xor((int)snd, 16)); } \
                unsigned k2[2]; _Pragma("unroll") for (int j = 0; j < 2; ++j) { const unsigned snd = b5 ? k4[j] : k4[2 + j], kp = b5 ? k4[2 + j] : k4[j]; k2[j] = PGV_ADD(kp, (unsigned)__shfl_xor((int)snd, 32)); } \
                const h16x2 _a = __builtin_bit_cast(h16x2, k2[0]), _b = __builtin_bit_cast(h16x2, k2[1]); const float _off = 7.5f * csw[(IT) & 15]; \
                const f32x4 _o = (f32x4){(float)_a.x, (float)_b.x, (float)_a.y, (float)_b.y} * 4096.0f - _off; \
                const f32x4 _xn = (f32x4){bf_lo(XV.x), bf_hi(XV.x), bf_lo(XV.y), bf_hi(XV.y)} + gate * _o; \
                u32x2 _w; _w.x = cvt_pk_bf16(_xn[0], _xn[1]); _w.y = cvt_pk_bf16(_xn[2], _xn[3]); *(u32x2*)PGV_XADDR(IT) = _w; } while (0)
            { cbytes sl0 = TVP + (size_t)(xg & 3) * NEXP * 128;
              PG_IDX(ev, 0); PG_GATHER8(bufA, sl0, ev, 0); PG_GATHER8(bufB, sl0, ev, 8);
              PG_IDX(ev, 1); PG_GATHER8(bufC, sl0, ev, 0); PG_GATHER8(bufD, sl0, ev, 8); }
            x0 = *(const u32x2*)PGV_XADDR(0); x1 = *(const u32x2*)PGV_XADDR(1);
#pragma unroll 1
            for (int it = 0; it < 64; it += 2) {
                const int it2 = it + 2 < 63 ? it + 2 : 63, it3 = it + 3 < 63 ? it + 3 : 63, sl = (xg + (it >> 4)) & 3;
                cbytes sl2 = TVP + (size_t)((xg + (it2 >> 4)) & 3) * NEXP * 128;
                const f32x4 gate = *(const f32x4*)(gp + sl * 256);
                h16x2 acc[16];
#pragma unroll
                for (int j = 0; j < 16; ++j) acc[j] = (h16x2){(_Float16)0.f, (_Float16)0.f};
                PGV_COEF8(cC, it & 15, 0); PG_IDX(ev, it2 & 15);
                PGV_COMP8(bufA, cC); __builtin_amdgcn_sched_barrier(0);
                PG_GATHER8(bufA, sl2, ev, 0); PGV_COEF8(cC, it & 15, 8); __builtin_amdgcn_sched_barrier(0);
                PGV_COMP8(bufB, cC); __builtin_amdgcn_sched_barrier(0);
                PG_GATHER8(bufB, sl2, ev, 8); __builtin_amdgcn_sched_barrier(0);
                PGV_REDUCE_STORE(x0, it);
                x0 = *(const u32x2*)PGV_XADDR(it2);
#pragma unroll
                for (int j = 0; j < 16; ++j) acc[j] = (h16x2){(_Float16)0.f, (_Float16)0.f};
                PGV_COEF8(cC, (it + 1) & 15, 0); PG_IDX(ev, it3 & 15);
                PGV_COMP8(bufC, cC); __builtin_amdgcn_sched_barrier(0);
                PG_GATHER8(bufC, sl2, ev, 0); PGV_COEF8(cC, (it + 1) & 15, 8); __builtin_amdgcn_sched_barrier(0);
                PGV_COMP8(bufD, cC); __builtin_amdgcn_sched_barrier(0);
                PG_GATHER8(bufD, sl2, ev, 8); __builtin_amdgcn_sched_barrier(0);
                PGV_REDUCE_STORE(x1, it + 1);
                x1 = *(const u32x2*)PGV_XADDR(it3);
            }
#undef PGV_XADDR
#undef PGV_COEF8
#undef PGV_COMP8
#undef PGV_ADD
#undef PGV_REDUCE_STORE
        }
        asm volatile("s_waitcnt vmcnt(0)" ::: "memory");
        {
            const int b = tk0 >> 12;
            f32x4 c1[4], shv[4];
#pragma unroll
            for (int j = 0; j < 4; ++j) { const int col = 4 * lane + 256 * j;
                if (last) { c1[j] = *(const f32x4*)(gn_next + col); shv[j] = (f32x4){0.f, 0.f, 0.f, 0.f}; }
                else { c1[j] = *(const f32x4*)(gn_next + col) * (1.0f + *(const f32x4*)(mod_next + (size_t)b * 6 * DM + DM + col)); shv[j] = *(const f32x4*)(mod_next + (size_t)b * 6 * DM + col); } }
#pragma unroll 1
            for (int i0 = 0; i0 < 16; i0 += 4) {
                f32x4 v[4][4]; float ss[4];
#pragma unroll
                for (int rr = 0; rr < 4; ++rr) { const u32x2* xr = (const u32x2*)(x + (size_t)(tk0 + i0 + rr) * DM) + lane;
#pragma unroll
                    for (int j = 0; j < 4; ++j) { const u32x2 xv = xr[64 * j]; v[rr][j] = (f32x4){bf_lo(xv.x), bf_hi(xv.x), bf_lo(xv.y), bf_hi(xv.y)}; } }
#pragma unroll
                for (int rr = 0; rr < 4; ++rr) { float q = 0.f;
#pragma unroll
                    for (int j = 0; j < 4; ++j) q += (v[rr][j][0] * v[rr][j][0] + v[rr][j][1] * v[rr][j][1]) + (v[rr][j][2] * v[rr][j][2] + v[rr][j][3] * v[rr][j][3]);
                    ss[rr] = q; }
#pragma unroll
                for (int o = 1; o < 64; o <<= 1) {
#pragma unroll
                    for (int rr = 0; rr < 4; ++rr) ss[rr] += __shfl_xor(ss[rr], o); }
#pragma unroll
                for (int rr = 0; rr < 4; ++rr) { const int r = tk0 + i0 + rr; const float rstd = __builtin_amdgcn_rsqf(ss[rr] * (1.0f / DM) + EPS);
                    if (last) { f32x4* xr = (f32x4*)(outf + (size_t)r * DM) + lane;
#pragma unroll
                        for (int j = 0; j < 4; ++j) xr[64 * j] = v[rr][j] * rstd * c1[j]; }
                    else { u32x2* o8 = (u32x2*)(Hout + (size_t)r * DM) + lane;
#pragma unroll
                        for (int j = 0; j < 4; ++j) { const f32x4 o = v[rr][j] * rstd * c1[j] + shv[j]; u32x2 w; w.x = cvt_pk_bf16(o[0], o[1]); w.y = cvt_pk_bf16(o[2], o[3]); o8[64 * j] = w; } } }
            }
        }
    }
}
#undef PG_IDX
#undef PG_GATHER8
#undef PGU_IDX
#undef PGU_GATHER8
#undef PGU_HB
#undef PGU_MMA8
#undef PGU_DOTS
#undef PG_VCOMP8
#undef PG_COEF
#undef PG_COEF8
#undef PG_XADDR
#undef PG_XOFFS
#undef PG_XLOAD

constexpr size_t WS_BAR = 768 * 1024;
#define XB_TMO      128
#define XB_XCNT(j)  (256  + 64 * (j))
#define XB_XSUB(j)  (1280 + 64 * (j))
#define XB_XGEN(j)  (2304 + 64 * (j))
#define XB_TOP      3328
#define XB_TOPGEN   3392
#define XCD_BAR_WORDS 3456
#define XB_SPIN_CAP (1u << 22)
__device__ __forceinline__ unsigned xb_ld(unsigned* p)              { return __hip_atomic_load(p, __ATOMIC_RELAXED, __HIP_MEMORY_SCOPE_AGENT); }
__device__ __forceinline__ unsigned xb_add(unsigned* p, unsigned v) { return __hip_atomic_fetch_add(p, v, __ATOMIC_RELAXED, __HIP_MEMORY_SCOPE_AGENT); }
__device__ __forceinline__ unsigned xb_xcc_id() { return (unsigned)__builtin_amdgcn_s_getreg((3 << 11) | 20) & 0xFu; }
#define XB_SPIN(cond, bar) do { unsigned _sp = 0; while (cond) { __builtin_amdgcn_s_sleep(1); \
    if ((++_sp & 255u) == 0u) { if (xb_ld(&(bar)[XB_TMO])) break; if (_sp > XB_SPIN_CAP) { atomicAdd(&(bar)[XB_TMO], 1u); break; } } } } while (0)
struct XcdBarrier { unsigned* bar; unsigned x; volatile LAS unsigned* st; };
__device__ __forceinline__ void xcd_barrier_complete(unsigned* bar, unsigned x, unsigned& nloc, unsigned& nx) {
    const unsigned G = gridDim.x * gridDim.y * gridDim.z;
    unsigned sum, cnt, mine, sp = 0u;
    for (;;) {
        sum = 0u; cnt = 0u; mine = 0u;
#pragma unroll
        for (unsigned j = 0; j < 16; ++j) { const unsigned c = xb_ld(&bar[XB_XCNT(j)]); sum += c; cnt += (c > 0u) ? 1u : 0u; mine = (j == x) ? c : mine; }
        if (sum == G) break;
        __builtin_amdgcn_s_sleep(1);
        if ((++sp & 255u) == 0u) { if (xb_ld(&bar[XB_TMO])) break; if (sp > XB_SPIN_CAP) { atomicAdd(&bar[XB_TMO], 1u); break; } }
    }
    nloc = mine > 0u ? mine : 1u; nx = cnt > 0u ? cnt : 1u;
}
__device__ __forceinline__ void xcd_barrier(const XcdBarrier& b) {
    asm volatile("s_waitcnt vmcnt(0)" ::: "memory");
    __syncthreads();
    if (threadIdx.x == 0) {
        unsigned* bar = b.bar;
        __builtin_amdgcn_s_waitcnt(0);
        unsigned nloc = b.st[0], nx = b.st[1];
        if (nloc == 0u) { xcd_barrier_complete(bar, b.x, nloc, nx); b.st[0] = nloc; b.st[1] = nx; }
        const unsigned old = xb_add(&bar[XB_XSUB(b.x)], 1u);
        const unsigned gen = old / nloc;
        if (old + 1u == (gen + 1u) * nloc) {
            __builtin_amdgcn_fence(__ATOMIC_RELEASE, "agent");
            asm volatile("s_waitcnt vmcnt(0)" ::: "memory");
            const unsigned og = xb_add(&bar[XB_TOP], 1u);
            const unsigned tg = og / nx;
            if (og + 1u == (tg + 1u) * nx) xb_add(&bar[XB_TOPGEN], 1u);
            else XB_SPIN(xb_ld(&bar[XB_TOPGEN]) == tg, bar);
            __builtin_amdgcn_fence(__ATOMIC_ACQUIRE, "agent");
            xb_add(&bar[XB_XGEN(b.x)], 1u);
            asm volatile("s_waitcnt vmcnt(0)" ::: "memory");
        } else {
            XB_SPIN(xb_ld(&bar[XB_XGEN(b.x)]) == gen, bar);
            __builtin_amdgcn_fence(__ATOMIC_ACQUIRE, "agent");
            asm volatile("s_waitcnt vmcnt(0)" ::: "memory");
        }
    }
    __syncthreads();
}

constexpr int NPHASES = 27;
#ifndef PH_MASK
#define PH_MASK 0xFFFFFF
#endif
#ifndef DUP_MASK
#define DUP_MASK 0
#endif
#ifndef TIME_MASK
#define TIME_MASK 0
#endif
__device__ __forceinline__ int opaque_s(int x) { asm volatile("" : "+s"(x)); return x; }
#define PHM(bit, call) do { if constexpr ((PH_MASK & (bit)) != 0) { if constexpr ((DUP_MASK & (bit)) != 0) { const int _nrep = opaque_s(2); for (int _rep = 0; _rep < _nrep; ++_rep) { call; __syncthreads(); } } else { call; } } } while (0)
__global__ void __launch_bounds__(NTHREADS, 2) trunk_fwd(Args A) {
    extern __shared__ __attribute__((aligned(16))) unsigned char lds_raw[];
    LAS unsigned char* lds = (LAS unsigned char*)lds_raw;
    const int tid0 = threadIdx.x, wid = __builtin_amdgcn_readfirstlane(tid0 >> 6);
    const int G = gridDim.x, bx = blockIdx.x, vcu = (G % 8 == 0) ? (bx % 8) * (G / 8) + bx / 8 : bx;
    const int gw = vcu * 8 + wid, NGW = G * 8;
    const int ph_lo = A.ph_lo, ph_hi = A.ph_hi;
    unsigned long long t_acc = 0;
#if MK_ONE_LAUNCH
    if (tid0 < 2) ((volatile LAS unsigned*)(lds + LDS_XB_OFF))[tid0] = 0u;
    if (bx == 0) { unsigned* b0 = (unsigned*)(A.ws + WS_BAR); for (int i = tid0; i < XCD_BAR_WORDS; i += NTHREADS) b0[i] = 0u; }
#endif

    for (int ph = ph_lo; ph < ph_hi; ++ph) {
        const int tid = opaque(tid0), lane = tid & 63;
        ArgP Ap = (ArgP)__builtin_amdgcn_kernarg_segment_ptr();
        asm volatile("" : "+s"(Ap));
        unsigned char* ws = Ap->ws;
        bf16_t* Hb = (bf16_t*)(ws + WS_H);
        unsigned char* mixb = ws + WS_MIX;
        const float* mod = (const float*)(ws + WS_MOD);
        float* xo = Ap->out;
        int layer, step;
        if (ph < 2) { layer = -1; step = ph; }
        else if (ph < 9) { layer = 0; step = ph - 2; }
        else if (ph < 15) { layer = 1; step = ph - 9 + 1; }
        else if (ph < 21) { layer = 2; step = ph - 15 + 1; }
        else { layer = 3; step = ph - 21 + 1; }
        const int kind = layer % 3, jl = layer / 3;
        unsigned long long t_ph0 = 0; if constexpr (TIME_MASK != 0) t_ph0 = __builtin_amdgcn_s_memrealtime();
        const int nmix = 4;
        int ptype = 0;
        if (layer < 0) ptype = 1; else if (layer > 3) ptype = 2048; else if (step == 0 || step == nmix) ptype = 2;
        else if (step < nmix) ptype = (step == 1) ? 4 : (step == nmix - 1) ? 32 : (kind == 0 && step == 3) ? 16 : 8;
        else ptype = 64 << (step - nmix - 1);
        const float* macc = mod + (size_t)(layer < 0 ? 0 : (layer > 3 ? 3 : layer)) * BATCH * 6 * DM;
        const float* mbias = Ap->in[I_ADA_B] + (size_t)(layer < 0 ? 0 : (layer > 3 ? 3 : layer)) * 6 * DM;
        const float* xin = (layer == 0) ? Ap->in[I_X] : xo;

        if (layer < 0) {
            if (step == 0) { PHM(1, prologue_phase(Ap, lds, vcu, G, tid, wid, lane)); }
            else { PHM(1, modreduce_phase(Ap, vcu, G, tid));
#pragma unroll 1
                for (int pl = 0; pl < 2; ++pl) { pg8::StaticOrder S; pg8::Gemm g{(const bf16_t*)(ws + WS_POOL_WOUT) + (size_t)pl * DM * DM, (const bf16_t*)(ws + WS_WGS) + (size_t)pl * 4 * 65536, DM, DM, 256, DM, 256, 256}; S.init(DM, DM, G, bx);
                    pg8::EpiBf16<0> E{(bf16_t*)(ws + WS_WEFF) + (size_t)pl * DM * DM, DM}; PHM(0x2000, pg8::gemm_phase(lds, g, S, E)); } }
        } else if (layer > 3) {
            PHM(256, final_phase(xo, Ap->in[I_FINAL_G], gw, NGW, lane));
        } else if (step == 0) {
            PHM(2, norm_phase(xin, Ap->in[I_NORM_G] + (size_t)(layer * 2 + 0) * DM, macc, mbias, 0, DM, Hb, gw, NGW, lane));
        } else if (step < nmix) {
            pg8::StaticOrder S;
            if (kind == 0) {
                bf16_t* U = (bf16_t*)mixb; bf16_t* P = (bf16_t*)(mixb + 64 * MiB); bf16_t* Z = (bf16_t*)(mixb + 128 * MiB);
                if (step == 1) { pg8::Gemm g{Hb, (const bf16_t*)(ws + WS_POOL_WIN) + (size_t)jl * DM * DM, MTOK, DM, DM, DM, DM, 0}; S.init(MTOK, DM, G, bx);
                    pg8::EpiBf16<0> E{U, DM}; PHM(0x1000, pg8::gemm_phase(lds, g, S, E)); }
                else if (step == 2) { PHM(8, pool_elem_phase(U, P, vcu, G, tid)); }
                else { pg8::Gemm g{P, (const bf16_t*)(ws + WS_WEFF) + (size_t)jl * DM * DM, MTOK, DM, DM, DM, DM, 0}; S.init(MTOK, DM, G, bx);
                    pg8::EpiBf16<0> E{(bf16_t*)(mixb + 192 * MiB), DM}; PHM(0x8000, pg8::gemm_phase(lds, g, S, E));   }
            } else if (kind == 1) {
                bf16_t* BG = (bf16_t*)mixb; bf16_t* Z = (bf16_t*)(mixb + 64 * MiB); bf16_t* AA = (bf16_t*)(mixb + 128 * MiB);
                if (step == 1) { pg8::Gemm g{Hb, (const bf16_t*)(ws + WS_CONV_WIN), MTOK, 3 * DM, DM, DM, DM, 0}; S.init(MTOK, 3 * DM, G, bx);
                    pg8::EpiConvIn E{BG, Z}; PHM(0x4000, pg8::gemm_phase(lds, g, S, E)); }
                else if (step == 2) { PHM(16, conv_elem_phase(BG, Z, Ap->in[I_CONV_W], AA, vcu, G, tid)); }
                else { pg8::Gemm g{AA, (const bf16_t*)(ws + WS_CONV_WOUT), MTOK, DM, DM, DM, DM, 0}; S.init(MTOK, DM, G, bx);
                    pg8::EpiBf16<0> E{(bf16_t*)(mixb + 192 * MiB), DM}; PHM(0x8000, pg8::gemm_phase(lds, g, S, E));   }
            } else {
                bf16_t* UA = (bf16_t*)mixb; bf16_t* VT = (bf16_t*)(mixb + 192 * MiB);
                if (step == 1) {
                    { pg8::Gemm g{Hb, (const bf16_t*)(ws + WS_GMLP_WIN), MTOK, GH, DM, DM, DM, 0}; S.init(MTOK, GH, G, bx);
                      pg8::EpiBf16<1> E{UA, GH}; PHM(0x1000, pg8::gemm_phase(lds, g, S, E)); }
                    { pg8::Gemm g{Hb, (const bf16_t*)(ws + WS_GMLP_WIN) + (size_t)GH * DM, MTOK, GH, DM, DM, DM, 0}; S.init(MTOK, GH, G, bx);
                      pg8::EpiGmlpV E{VT}; PHM(0x10000, pg8::gemm_phase(lds, g, S, E)); }
                }
                else if (step == 2) { PHM(32, mix_phase(lds, UA, VT, Ap->in[I_GMLP_WS], Ap->in[I_GMLP_BS], Ap->in[I_GMLP_LNG], Ap->in[I_GMLP_LNB], vcu, G, tid, wid, lane)); }
                else { pg8::Gemm g{UA, (const bf16_t*)(ws + WS_GMLP_WOUT), MTOK, DM, GH, GH, GH, 0}; S.init(MTOK, DM, G, bx);
                    pg8::EpiBf16<0> E{(bf16_t*)(mixb + 192 * MiB), DM}; PHM(0x8000, pg8::gemm_phase(lds, g, S, E));   }
            }
        } else {
            const int ps = step - nmix;
            bf16_t* Qb = (bf16_t*)mixb;
            bf16_t* xs = (layer == 3) ? (bf16_t*)(mixb + 192 * MiB) : (bf16_t*)xo;
            if (ps == 0) { resnorm_phase(layer == 0 ? Ap->in[I_X] : nullptr, (const bf16_t*)xo, xs, (const bf16_t*)(mixb + 192 * MiB), macc + 2 * DM, Ap->in[I_NORM_G] + (size_t)(layer * 2 + 1) * DM, macc, 3 * DM, 4 * DM, Hb, mixb + 128 * MiB, gw, NGW, lane); }
            else if (ps == 1) { pg8::StaticOrder S; pg8::Gemm g{Hb, (const bf16_t*)(ws + WS_PEER_WQ) + (size_t)layer * DM * 2048, MTOK, 2048, DM, DM, DM, 0}; S.init(MTOK, 2048, G, bx);
                pg8::EpiQT E{Qb}; PHM(0x1000, pg8::gemm_phase(lds, g, S, E));
                asm volatile("s_waitcnt vmcnt(0)" ::: "memory"); __syncthreads();
                PHM(64, topk_units(lds, Qb, (const bf16_t*)(ws + WS_KEYS) + (size_t)layer * 16 * 128 * 128, (int*)(ws + WS_SELI), (float*)(ws + WS_SELW), S, tid, wid, lane)); }
            else { PHM(128, peer_gather_phase(lds, mixb + 128 * MiB  , (cbytes)(ws + WS_TABU) + (size_t)layer * NEXP * (DM / 2), (cbytes)(ws + WS_TABV) + (size_t)layer * NEXP * (DM / 2), (const int*)(ws + WS_SELI), (const float*)(ws + WS_SELW),
                              (const unsigned*)(ws + WS_SCU) + (size_t)layer * NEXP, xs, xo, macc + 5 * DM,
                              layer == 3 ? Ap->in[I_FINAL_G] : Ap->in[I_NORM_G] + (size_t)((layer + 1) * 2) * DM, mod + (size_t)(layer == 3 ? 3 : layer + 1) * BATCH * 6 * DM, Hb, layer == 3, vcu, G, wid, lane)); }
        }
#if MK_ONE_LAUNCH
        if constexpr (TIME_MASK != 0) if (ph + 1 >= ph_hi) { if (ptype & TIME_MASK) t_acc += __builtin_amdgcn_s_memrealtime() - t_ph0; }
        if (ph + 1 < ph_hi) {
            XcdBarrier xbar; xbar.bar = (unsigned*)(Ap->ws + WS_BAR); xbar.x = xb_xcc_id(); xbar.st = (volatile LAS unsigned*)(lds + LDS_XB_OFF);
            if (ph == ph_lo) { cg::this_grid().sync(); if (tid0 == 0) (void)xb_add(&xbar.bar[XB_XCNT(xbar.x)], 1u); }
            else { xcd_barrier(xbar); if constexpr ((DUP_MASK & 0x800) != 0) xcd_barrier(xbar); }
            if constexpr (TIME_MASK != 0) { if (ptype & TIME_MASK) t_acc += __builtin_amdgcn_s_memrealtime() - t_ph0; }
        }
#endif
    }
    if constexpr (TIME_MASK != 0) { const unsigned long long t0 = __builtin_amdgcn_s_memrealtime(); while (__builtin_amdgcn_s_memrealtime() - t0 < 4ull * t_acc) __builtin_amdgcn_s_sleep(8); }
}

extern "C" void kernel_launch(void* const* d_in, const int* in_sizes, int n_in, void* d_out, int out_size, void* d_ws, size_t ws_size, hipStream_t stream) {
    static int grid = 0;
    if (grid == 0) {
        if (n_in != 23 || in_sizes[0] != MTOK * DM || out_size != MTOK * DM || ws_size < WS_END) {
            fprintf(stderr, "kernel_launch: unexpected shapes (n_in %d, in0 %d, out %d, ws %zu; need ws >= %zu); nothing launched\n", n_in, n_in > 0 ? in_sizes[0] : -1, out_size, ws_size, (size_t)WS_END); grid = -1; return; }
        int dev = 0, cus = 0, per_cu = 0;
        if (hipGetDevice(&dev) != hipSuccess || hipDeviceGetAttribute(&cus, hipDeviceAttributeMultiprocessorCount, dev) != hipSuccess) { grid = -1; return; }
        if (hipFuncSetAttribute((const void*)trunk_fwd, hipFuncAttributeMaxDynamicSharedMemorySize, LDS_BYTES) != hipSuccess) { fprintf(stderr, "kernel_launch: hipFuncSetAttribute failed\n"); grid = -1; return; }
        if (hipOccupancyMaxActiveBlocksPerMultiprocessor(&per_cu, (const void*)trunk_fwd, NTHREADS, LDS_BYTES) != hipSuccess || per_cu < 1) { fprintf(stderr, "kernel_launch: occupancy query says %d blocks per CU\n", per_cu); (void)hipGetLastError(); grid = -1; return; }
        grid = cus * (per_cu < 1 ? 1 : 1);
    }
    if (grid < 0) return;
    Args a{};
    for (int i = 0; i < 23; ++i) a.in[i] = (const float*)d_in[i];
    a.out = (float*)d_out; a.ws = (unsigned char*)d_ws;
#if MK_ONE_LAUNCH
    a.ph_lo = 0; a.ph_hi = NPHASES;
    void* args[] = {&a};
    hipError_t e = hipLaunchCooperativeKernel((const void*)trunk_fwd, dim3(grid), dim3(NTHREADS), args, LDS_BYTES, stream);
    if (e != hipSuccess) fprintf(stderr, "cooperative launch failed: %s (grid %d)\n", hipGetErrorString(e), grid);
#else
    for (int ph = 0; ph < NPHASES; ++ph) { a.ph_lo = ph; a.ph_hi = ph + 1; hipLaunchKernelGGL(trunk_fwd, dim3(grid), dim3(NTHREADS), LDS_BYTES, stream, a); }
#endif
}
```

```cpp
#include <hip/hip_runtime.h>
#include <hip/hip_cooperative_groups.h>
#include <cstdio>
#include <cstdint>
namespace cg = cooperative_groups;

#ifndef MK_ONE_LAUNCH
#define MK_ONE_LAUNCH 1
#endif

#define LAS __attribute__((address_space(3)))
typedef unsigned short bf16_t;
typedef short bf16x8 __attribute__((ext_vector_type(8)));
typedef float f32x2 __attribute__((ext_vector_type(2)));
typedef float f32x4 __attribute__((ext_vector_type(4)));
typedef float f32x16 __attribute__((ext_vector_type(16)));
typedef unsigned u32x2 __attribute__((ext_vector_type(2)));
typedef unsigned u32x4 __attribute__((ext_vector_type(4)));
typedef int i32x4 __attribute__((ext_vector_type(4)));
typedef int i32x8 __attribute__((ext_vector_type(8)));
typedef _Float16 h16x2 __attribute__((ext_vector_type(2)));
typedef __bf16 bf16x2 __attribute__((ext_vector_type(2)));

constexpr int DM = 1024, BATCH = 8, SEQ = 4096, MTOK = BATCH * SEQ, DEPTH = 4;
constexpr int GH = 3072;
constexpr int NEXP = 16384, NPICK = 128;
constexpr float EPS = 1e-6f;

constexpr size_t MiB = 1u << 20;
constexpr size_t WS_CTL = 0, WS_SCU = 0, WS_SCV = 512 * 1024, WS_MOD = 1 * MiB, ZERO_BYTES = 2 * MiB;
constexpr size_t WS_POOL_WIN = 2 * MiB, WS_POOL_WGRP = 6 * MiB, WS_POOL_WOUT = 7 * MiB;
constexpr size_t WS_CONV_WIN = 11 * MiB, WS_CONV_WOUT = 17 * MiB;
constexpr size_t WS_GMLP_WIN = 19 * MiB, WS_GMLP_WOUT = 31 * MiB;
constexpr size_t WS_PEER_WQ = 37 * MiB, WS_KEYS = 53 * MiB;
constexpr size_t WS_H = 56 * MiB;
constexpr size_t WS_SELI = 120 * MiB, WS_SELW = 136 * MiB;
constexpr size_t WS_TABU = 152 * MiB, WS_TABV = 280 * MiB;
constexpr size_t WS_MIX = 408 * MiB;
constexpr size_t WS_ADAP = 792 * MiB;
constexpr size_t WS_COEF = 804 * MiB;
constexpr size_t WS_WEFF = 820 * MiB;
constexpr size_t WS_WGS = 824 * MiB;
constexpr size_t WS_END = 825 * MiB;

__device__ __forceinline__ unsigned cvt_pk_bf16(float lo, float hi) { unsigned r; asm volatile("v_cvt_pk_bf16_f32 %0, %1, %2" : "=v"(r) : "v"(lo), "v"(hi)); return r; }
__device__ __forceinline__ int opaque(int x) { asm volatile("" : "+v"(x)); return x; }
__device__ __forceinline__ float bf_lo(unsigned w) { return __uint_as_float(w << 16); }
__device__ __forceinline__ float bf_hi(unsigned w) { return __uint_as_float(w & 0xffff0000u); }
__device__ __forceinline__ float gelu_tanh(float x) {
    const float y = x * (1.0f + 0.044715f * x * x);
    const float e = __builtin_amdgcn_exp2f(-2.302208198f * y);
    return x * __builtin_amdgcn_rcpf(1.0f + e);
}
__device__ __forceinline__ float wave_sum_all(float v) {
#pragma unroll
    for (int o = 1; o < 64; o <<= 1) v += __shfl_xor(v, o);
    return v;
}
__device__ __forceinline__ float dot2_bf16(unsigned w, unsigned x, float acc) { return __builtin_amdgcn_fdot2_f32_bf16(__builtin_bit_cast(bf16x2, w), __builtin_bit_cast(bf16x2, x), acc, false); }


__device__ __forceinline__ float dpp_row_shr(float v, int n) {
    const int iv = __builtin_bit_cast(int, v); int r;
    switch (n) { case 1: r = __builtin_amdgcn_update_dpp(0, iv, 0x111, 0xf, 0xf, true); break; case 2: r = __builtin_amdgcn_update_dpp(0, iv, 0x112, 0xf, 0xf, true); break;
                 case 4: r = __builtin_amdgcn_update_dpp(0, iv, 0x114, 0xf, 0xf, true); break; default: r = __builtin_amdgcn_update_dpp(0, iv, 0x118, 0xf, 0xf, true); break; }
    return __builtin_bit_cast(float, r);
}
__device__ __forceinline__ float wave_sum_uniform(float v) {
    v += dpp_row_shr(v, 1); v += dpp_row_shr(v, 2); v += dpp_row_shr(v, 4); v += dpp_row_shr(v, 8);
    v += __builtin_bit_cast(float, __builtin_amdgcn_update_dpp(0, __builtin_bit_cast(int, v), 0x142, 0xa, 0xf, false));
    v += __builtin_bit_cast(float, __builtin_amdgcn_update_dpp(0, __builtin_bit_cast(int, v), 0x143, 0xc, 0xf, false));
    return __uint_as_float(__builtin_amdgcn_readlane(__float_as_uint(v), 63));
}

namespace pg8 {
constexpr int BM = 256, BK = 64, HALF = 128, HTB = HALF * BK * 2, STAGE_BYTES = 8 * HTB, NXCD = 8, WGM = 8;
__device__ __forceinline__ int lds_byte(int r, int c) { const int st = (r >> 4) * 2 + (c >> 5), rr = r & 15, cc = c & 31, ob = rr * 64 + cc * 2; return st * 1024 + (ob ^ (((ob >> 9) & 1) << 5)); }
__device__ __forceinline__ void stage_rc(int b, int& R, int& C) { const int st = b / 1024, sb = b % 1024, swz = sb ^ (((sb >> 9) & 1) << 5); R = (st >> 1) * 16 + swz / 64; C = (st & 1) * 32 + (swz % 64) / 2; }
__device__ __forceinline__ int perm32(int rho) { const int n = rho >> 4, i = rho & 15; return 8 * (i >> 2) + 4 * n + (i & 3); }

struct Unit { int pm, pn; };
struct Gemm { const bf16_t* A; const bf16_t* Bt; int M, N, K, lda, ldb, a_pn_off; };

struct StaticOrder {
    int nM, nN, nwg, G, c;
    __device__ __forceinline__ void init(int M, int N, int G_, int c_) { nM = M / BM; nN = N / BM; nwg = nM * nN; G = G_; c = c_; }
    __device__ __forceinline__ bool next(int i, Unit& u) const {
        const int L = i * G + c; if (L >= nwg) return false;
        int wgid = L; { const int q = nwg / NXCD, r = nwg % NXCD, xcd = wgid % NXCD, off = wgid / NXCD; wgid = (xcd < r ? xcd * (q + 1) : r * (q + 1) + (xcd - r) * q) + off; }
        const int nig = WGM * nN, gid = wgid / nig, fm = gid * WGM, gsz = (nM - fm) < WGM ? (nM - fm) : WGM;
        u.pm = fm + ((wgid % nig) % gsz); u.pn = (wgid % nig) / gsz; return true;
    }
};

template <class Epi>
__device__ __forceinline__ void gemm_phase(LAS unsigned char* lds, const Gemm g, const StaticOrder& S, const Epi& E) {
    const int tid = opaque((int)threadIdx.x), wid = __builtin_amdgcn_readfirstlane(tid >> 6), lane = tid & 63, wr = wid >> 2, wc = wid & 3, fr = lane & 15, fq = lane >> 4;
    int nt = g.K / BK; asm volatile("" : "+s"(nt));
    unsigned voffA[2], voffB[2];
#pragma unroll
    for (int i = 0; i < 2; ++i) { int R, C; stage_rc(tid * 16 + i * 8192, R, C); const int Rb = Epi::PERM ? ((R & ~31) + perm32(R & 31)) : R;
        voffA[i] = (unsigned)(R * g.lda + C) * 2u; voffB[i] = (unsigned)(Rb * g.ldb + C) * 2u; }
    const size_t kstep = (size_t)(BK * 2);
    const size_t hstepA = (size_t)HALF * g.lda * 2, hstepB = (size_t)HALF * g.ldb * 2;
    const size_t tstepA = 2 * hstepA, tstepB = 2 * hstepB;
    const unsigned ldsw = (unsigned)wid * 1024u;
    const int aoff = lds_byte(wr * 64 + fr, fq * 8), boff = lds_byte(wc * 32 + fr, fq * 8);
#define PG8_SA(b, h) (((b) * 2 + (h)) * HTB)
#define PG8_SB(b, h) ((4 + (b) * 2 + (h)) * HTB)
#define PG8_STAGE(bufoff, gbase, voff) do { _Pragma("unroll") for (int _i = 0; _i < 2; ++_i) \
        __builtin_amdgcn_global_load_lds((const unsigned*)((const char*)(gbase) + (voff)[_i]), (LAS unsigned*)(lds + (bufoff) + ldsw + _i * 8192), 16, 0, 0); } while (0)
#define PG8_LDA(dst, b, h) do { _Pragma("unroll") for (int m = 0; m < 4; ++m) _Pragma("unroll") for (int k = 0; k < 2; ++k) dst[m][k] = *(const LAS bf16x8*)(lds + PG8_SA(b, h) + aoff + m * 2048 + k * 1024); } while (0)
#define PG8_LDB(dst, b, h) do { _Pragma("unroll") for (int n = 0; n < 2; ++n) _Pragma("unroll") for (int k = 0; k < 2; ++k) dst[n][k] = *(const LAS bf16x8*)(lds + PG8_SB(b, h) + boff + n * 2048 + k * 1024); } while (0)
#define PG8_MMA(ai, bj, At, Bt) do { __builtin_amdgcn_s_setprio(1); _Pragma("unroll") for (int m = 0; m < 4; ++m) _Pragma("unroll") for (int n = 0; n < 2; ++n) _Pragma("unroll") for (int k = 0; k < 2; ++k) \
        acc[ai][bj][m][n] = Epi::SWAP ? __builtin_amdgcn_mfma_f32_16x16x32_bf16(At[m][k], Bt[n][k], acc[ai][bj][m][n], 0, 0, 0) \
                                      : __builtin_amdgcn_mfma_f32_16x16x32_bf16(Bt[n][k], At[m][k], acc[ai][bj][m][n], 0, 0, 0); __builtin_amdgcn_s_setprio(0); } while (0)
#define PG8_WAIT_V(n) asm volatile("s_waitcnt vmcnt(" #n ")" ::: "memory")
#define PG8_WAIT_L(n) asm volatile("s_waitcnt lgkmcnt(" #n ")" ::: "memory")
#define PG8_BAR __builtin_amdgcn_s_barrier()
#define PG8_SCHED __builtin_amdgcn_sched_barrier(0)
    Unit cur, nxt; int ui = 0;
    if (!S.next(0, cur)) return;
    f32x4 acc[2][2][4][2];
#pragma unroll
    for (int a = 0; a < 2; ++a)
#pragma unroll
        for (int b = 0; b < 2; ++b)
#pragma unroll
            for (int m = 0; m < 4; ++m)
#pragma unroll
                for (int n = 0; n < 2; ++n) acc[a][b][m][n] = (f32x4){0.f, 0.f, 0.f, 0.f};
    bf16x8 At[4][2], B0[2][2], B1[2][2];
    const char* cA = (const char*)g.A + (size_t)cur.pm * tstepA + (size_t)cur.pn * g.a_pn_off * 2; const char* cB = (const char*)g.Bt + (size_t)cur.pn * tstepB;
    PG8_STAGE(PG8_SB(0, 0), cB, voffB); PG8_STAGE(PG8_SB(0, 1), cB + hstepB, voffB); PG8_STAGE(PG8_SA(0, 0), cA, voffA); PG8_STAGE(PG8_SA(0, 1), cA + hstepA, voffA);
    if (wr == 1) PG8_BAR;
    PG8_WAIT_V(2); PG8_BAR;
    PG8_STAGE(PG8_SB(1, 0), cB + kstep, voffB); PG8_STAGE(PG8_SA(1, 0), cA + kstep, voffA); PG8_STAGE(PG8_SB(1, 1), cB + hstepB + kstep, voffB);
    PG8_WAIT_V(6); PG8_BAR;
    for (;;) {
        const bool has_next = S.next(ui + 1, nxt);
        const char* nA = has_next ? (const char*)g.A + (size_t)nxt.pm * tstepA + (size_t)nxt.pn * g.a_pn_off * 2 : cA; const char* nB = has_next ? (const char*)g.Bt + (size_t)nxt.pn * tstepB : cB;
        for (int t = 0; t < nt; t += 2) {
            const bool last = (t == nt - 2);
            const char* a1 = cA + (size_t)(t + 1) * kstep;
            const char* a2 = last ? nA : cA + (size_t)(t + 2) * kstep; const char* b2 = last ? nB : cB + (size_t)(t + 2) * kstep;
            const char* a3 = a2 + kstep; const char* b3 = b2 + kstep;
            PG8_LDB(B0, 0, 0); PG8_LDB(B1, 0, 1); PG8_SCHED; PG8_LDA(At, 0, 0); PG8_STAGE(PG8_SA(1, 1), a1 + hstepA, voffA);
            PG8_WAIT_V(8); PG8_WAIT_L(0); PG8_BAR; PG8_MMA(0, 0, At, B0); PG8_MMA(0, 1, At, B1); PG8_BAR; PG8_SCHED;
            PG8_LDA(At, 0, 1); PG8_STAGE(PG8_SB(0, 0), b2, voffB); PG8_STAGE(PG8_SB(0, 1), b2 + hstepB, voffB); PG8_STAGE(PG8_SA(0, 0), a2, voffA);
            PG8_WAIT_V(8); PG8_WAIT_L(0); PG8_BAR; PG8_MMA(1, 0, At, B0); PG8_MMA(1, 1, At, B1); PG8_BAR; PG8_SCHED;
            PG8_LDB(B0, 1, 0); PG8_LDB(B1, 1, 1); PG8_SCHED; PG8_LDA(At, 1, 0); PG8_STAGE(PG8_SA(0, 1), a2 + hstepA, voffA);
            PG8_WAIT_V(8); PG8_WAIT_L(0); PG8_BAR; PG8_MMA(0, 0, At, B0); PG8_MMA(0, 1, At, B1); PG8_BAR; PG8_SCHED;
            PG8_LDA(At, 1, 1); PG8_STAGE(PG8_SB(1, 0), b3, voffB); PG8_STAGE(PG8_SB(1, 1), b3 + hstepB, voffB); PG8_STAGE(PG8_SA(1, 0), a3, voffA);
            PG8_WAIT_V(8); PG8_WAIT_L(0); PG8_BAR; PG8_MMA(1, 0, At, B0); PG8_MMA(1, 1, At, B1); PG8_BAR; PG8_SCHED;
        }
        { const int l2 = opaque((int)threadIdx.x) & 63; E(acc, cur, wr, wc, l2 & 15, l2 >> 4); }
        if (!has_next) break;
#pragma unroll
        for (int a = 0; a < 2; ++a)
#pragma unroll
            for (int b = 0; b < 2; ++b)
#pragma unroll
                for (int m = 0; m < 4; ++m)
#pragma unroll
                    for (int n = 0; n < 2; ++n) acc[a][b][m][n] = (f32x4){0.f, 0.f, 0.f, 0.f};
        cur = nxt; cA = nA; cB = nB; ++ui;
    }
    PG8_WAIT_V(0);
    if (wr == 0) PG8_BAR;
    PG8_BAR;
#undef PG8_SA
#undef PG8_SB
#undef PG8_STAGE
#undef PG8_LDA
#undef PG8_LDB
#undef PG8_MMA
#undef PG8_WAIT_V
#undef PG8_WAIT_L
#undef PG8_BAR
#undef PG8_SCHED
}

template <int ACT> struct EpiBf16 {
    static constexpr bool PERM = true, SWAP = false;
    bf16_t* O; int ldc;
    __device__ __forceinline__ void operator()(const f32x4 (&acc)[2][2][4][2], const Unit& u, int wr, int wc, int fr, int fq) const {
        const int row0 = u.pm * BM + wr * 64 + fr, col0 = u.pn * BM + wc * 32 + 8 * fq;
#pragma unroll
        for (int ai = 0; ai < 2; ++ai)
#pragma unroll
            for (int m = 0; m < 4; ++m) { bf16_t* rowp = O + (size_t)(row0 + ai * HALF + m * 16) * ldc + col0;
#pragma unroll
                for (int bj = 0; bj < 2; ++bj) { f32x4 v0 = acc[ai][bj][m][0], v1 = acc[ai][bj][m][1];
                    if (ACT == 1) {
#pragma unroll
                        for (int j = 0; j < 4; ++j) { v0[j] = gelu_tanh(v0[j]); v1[j] = gelu_tanh(v1[j]); } }
                    u32x4 w; w.x = cvt_pk_bf16(v0[0], v0[1]); w.y = cvt_pk_bf16(v0[2], v0[3]); w.z = cvt_pk_bf16(v1[0], v1[1]); w.w = cvt_pk_bf16(v1[2], v1[3]);
                    *(u32x4*)(rowp + bj * HALF) = w; } }
    }
};
struct EpiQT {
    static constexpr bool PERM = true, SWAP = false;
    bf16_t* O;
    __device__ __forceinline__ void operator()(const f32x4 (&acc)[2][2][4][2], const Unit& u, int wr, int wc, int fr, int fq) const {
        const int row0 = u.pm * BM + wr * 64 + fr;
#pragma unroll
        for (int ai = 0; ai < 2; ++ai)
#pragma unroll
            for (int m = 0; m < 4; ++m) { const int row = row0 + ai * HALF + m * 16;
                bf16_t* base = O + ((size_t)((row >> 7) * 8 + u.pn) * 32 * 128 + (row & 127)) * 8;
#pragma unroll
                for (int bj = 0; bj < 2; ++bj) { const f32x4 v0 = acc[ai][bj][m][0], v1 = acc[ai][bj][m][1];
                    u32x4 w; w.x = cvt_pk_bf16(v0[0], v0[1]); w.y = cvt_pk_bf16(v0[2], v0[3]); w.z = cvt_pk_bf16(v1[0], v1[1]); w.w = cvt_pk_bf16(v1[2], v1[3]);
                    *(u32x4*)(base + (size_t)(16 * bj + 4 * wc + fq) * 128 * 8) = w; } }
    }
};
struct EpiPoolGrp {
    static constexpr bool PERM = true, SWAP = false;
    bf16_t* O; const float* scale;
    __device__ __forceinline__ void operator()(const f32x4 (&acc)[2][2][4][2], const Unit& u, int wr, int wc, int fr, int fq) const {
        const int row0 = u.pm * BM + wr * 64 + fr, col0 = u.pn * BM + wc * 32 + 8 * fq;
#pragma unroll
        for (int bj = 0; bj < 2; ++bj) {
            const f32x4 s0 = *(const f32x4*)(scale + col0 + bj * HALF), s1 = *(const f32x4*)(scale + col0 + bj * HALF + 4);
#pragma unroll
            for (int ai = 0; ai < 2; ++ai)
#pragma unroll
                for (int m = 0; m < 4; ++m) { bf16_t* rowp = O + (size_t)(row0 + ai * HALF + m * 16) * DM + col0 + bj * HALF;
                    const f32x4 v0 = acc[ai][bj][m][0] * s0, v1 = acc[ai][bj][m][1] * s1;
                    u32x4 w; w.x = cvt_pk_bf16(v0[0], v0[1]); w.y = cvt_pk_bf16(v0[2], v0[3]); w.z = cvt_pk_bf16(v1[0], v1[1]); w.w = cvt_pk_bf16(v1[2], v1[3]);
                    *(u32x4*)rowp = w; }
            asm volatile("" ::: "memory");
        }
    }
};
struct EpiConvIn {
    static constexpr bool PERM = true, SWAP = false;
    bf16_t* BG; bf16_t* Z;
    __device__ __forceinline__ void operator()(const f32x4 (&acc)[2][2][4][2], const Unit& u, int wr, int wc, int fr, int fq) const {
        const int row0 = u.pm * BM + wr * 64 + fr;
        if (u.pn < 4) {
            const int col0 = u.pn * BM + wc * 32 + 8 * fq;
#pragma unroll
            for (int ai = 0; ai < 2; ++ai)
#pragma unroll
                for (int m = 0; m < 4; ++m) { bf16_t* rowp = BG + (size_t)(row0 + ai * HALF + m * 16) * DM + col0;
#pragma unroll
                    for (int bj = 0; bj < 2; ++bj) { const f32x4 v0 = acc[ai][bj][m][0], v1 = acc[ai][bj][m][1];
                        u32x4 w; w.x = cvt_pk_bf16(v0[0], v0[1]); w.y = cvt_pk_bf16(v0[2], v0[3]); w.z = cvt_pk_bf16(v1[0], v1[1]); w.w = cvt_pk_bf16(v1[2], v1[3]);
                        *(u32x4*)(rowp + bj * HALF) = w; } }
        } else {
            const int col0 = (u.pn - 4) * HALF + wc * 32 + 8 * fq;
#pragma unroll
            for (int ai = 0; ai < 2; ++ai)
#pragma unroll
                for (int m = 0; m < 4; ++m) { bf16_t* rowp = Z + (size_t)(row0 + ai * HALF + m * 16) * DM + col0;
                    const f32x4 v0 = acc[ai][0][m][0] * acc[ai][1][m][0], v1 = acc[ai][0][m][1] * acc[ai][1][m][1];
                    u32x4 w; w.x = cvt_pk_bf16(v0[0], v0[1]); w.y = cvt_pk_bf16(v0[2], v0[3]); w.z = cvt_pk_bf16(v1[0], v1[1]); w.w = cvt_pk_bf16(v1[2], v1[3]);
                    *(u32x4*)rowp = w; }
        }
    }
};
struct EpiResid {
    static constexpr bool PERM = false, SWAP = false;
    const float* base; float* out; const float* gacc; const float* gbias;
    __device__ __forceinline__ void operator()(const f32x4 (&acc)[2][2][4][2], const Unit& u, int wr, int wc, int fr, int fq) const {
        const int row0 = u.pm * BM + wr * 64 + fr, col0 = u.pn * BM + wc * 32 + 4 * fq;
        const float* gp = gacc + (size_t)(u.pm >> 4) * (6 * DM);
#pragma unroll
        for (int bj = 0; bj < 2; ++bj)
#pragma unroll
            for (int n = 0; n < 2; ++n) { const int cc = col0 + bj * HALF + n * 16;
                const f32x4 gv = *(const f32x4*)(gp + cc);
#pragma unroll
                for (int ai = 0; ai < 2; ++ai) {
#pragma unroll
                    for (int m = 0; m < 4; ++m) { const size_t off = (size_t)(row0 + ai * HALF + m * 16) * DM + cc;
                        const f32x4 bs = *(const f32x4*)(base + off);
                        *(f32x4*)(out + off) = bs + gv * acc[ai][bj][m][n]; }
                    asm volatile("" ::: "memory"); } }
    }
};
struct EpiGmlpV {
    static constexpr bool PERM = false, SWAP = true;
    bf16_t* VT;
    __device__ __forceinline__ void operator()(const f32x4 (&acc)[2][2][4][2], const Unit& u, int wr, int wc, int fr, int fq) const {
        const int row0 = u.pm * BM + wr * 64 + 4 * fq, col0 = u.pn * BM + wc * 32 + fr;
#pragma unroll
        for (int bj = 0; bj < 2; ++bj)
#pragma unroll
            for (int n = 0; n < 2; ++n) { const int c = col0 + bj * HALF + n * 16;
#pragma unroll
                for (int ai = 0; ai < 2; ++ai)
#pragma unroll
                    for (int m = 0; m < 4; ++m) { const f32x4 v = acc[ai][bj][m][n]; const int r = row0 + ai * HALF + m * 16;
                        u32x2 w; w.x = cvt_pk_bf16(gelu_tanh(v[0]), gelu_tanh(v[1])); w.y = cvt_pk_bf16(gelu_tanh(v[2]), gelu_tanh(v[3]));
                        *(u32x2*)(VT + ((size_t)(r >> 7) * GH + c) * 128 + (r & 127)) = w; } }
    }
};
}

constexpr int RING_BYTES = 131072;
constexpr int LDS_BYTES = 147456;
constexpr int LDS_XB_OFF = LDS_BYTES - 64;
constexpr int NTHREADS = 512;

#define CE_DESC(a, b) do { const float _x = fmaxf(a, b), _y = fminf(a, b); a = _x; b = _y; } while (0)
#define CE_ASC(a, b)  do { const float _x = fminf(a, b), _y = fmaxf(a, b); a = _x; b = _y; } while (0)
template <int OFF, int N>
__device__ __forceinline__ void sort16_desc(float (&v)[N]) {
#pragma unroll
    for (int k = 2; k <= 16; k <<= 1)
#pragma unroll
        for (int j = k >> 1; j > 0; j >>= 1)
#pragma unroll
            for (int i = 0; i < 16; ++i) { const int l = i ^ j; if (l > i) { if ((i & k) == 0) CE_DESC(v[OFF + i], v[OFF + l]); else CE_ASC(v[OFF + i], v[OFF + l]); } }
}
template <int OFF, int N>
__device__ __forceinline__ void bmerge16_desc(float (&v)[N]) {
#pragma unroll
    for (int j = 8; j > 0; j >>= 1)
#pragma unroll
        for (int i = 0; i < 16; ++i) { const int l = i ^ j; if (l > i) CE_DESC(v[OFF + i], v[OFF + l]); }
}
template <int A, int B, int N>
__device__ __forceinline__ void merge_top16(float (&v)[N]) {
#pragma unroll
    for (int i = 0; i < 16; ++i) v[A + i] = fmaxf(v[A + i], v[B + 15 - i]);
    bmerge16_desc<A, N>(v);
}
__device__ __forceinline__ void top16_of_64(float (&v)[64]) {
    sort16_desc<0, 64>(v); sort16_desc<16, 64>(v); sort16_desc<32, 64>(v); sort16_desc<48, 64>(v);
    merge_top16<0, 16, 64>(v); merge_top16<32, 48, 64>(v); merge_top16<0, 32, 64>(v);
}

struct Args { const float* in[23]; float* out; unsigned char* ws; int ph_lo, ph_hi; };
typedef const __attribute__((address_space(4))) Args* ArgP;
enum { I_X = 0, I_C, I_ADA_W, I_ADA_B, I_NORM_G, I_POOL_WIN, I_POOL_WGRP, I_POOL_SCALE, I_POOL_WOUT, I_CONV_WIN, I_CONV_W, I_CONV_WOUT,
       I_GMLP_WIN, I_GMLP_LNG, I_GMLP_LNB, I_GMLP_WS, I_GMLP_BS, I_GMLP_WOUT, I_PEER_WQ, I_PEER_KEYS, I_PEER_U, I_PEER_V, I_FINAL_G };

__device__ __forceinline__ void transpose_item(const float* W, int K, int N, bf16_t* WT, int dst_row0, LAS float* scr, int k0, int n0, int lane) {
#pragma unroll 8
    for (int i = 0; i < 32; ++i) { const int kk = 2 * i + (lane >> 5); scr[kk * 33 + (lane & 31)] = W[(size_t)(k0 + kk) * N + n0 + (lane & 31)]; }
    asm volatile("s_waitcnt lgkmcnt(0)" ::: "memory");
    const int c = lane & 7;
#pragma unroll
    for (int j = 0; j < 4; ++j) { const int n = (lane >> 3) + 8 * j; const LAS float* s = scr + (8 * c) * 33 + n;
        u32x4 o; o.x = cvt_pk_bf16(s[0 * 33], s[1 * 33]); o.y = cvt_pk_bf16(s[2 * 33], s[3 * 33]); o.z = cvt_pk_bf16(s[4 * 33], s[5 * 33]); o.w = cvt_pk_bf16(s[6 * 33], s[7 * 33]);
        *(u32x4*)(WT + (size_t)(dst_row0 + n) * K + k0 + 8 * c) = o; }
    asm volatile("s_waitcnt lgkmcnt(0)" ::: "memory");
}
__device__ __forceinline__ void convert_stream(const float* src, bf16_t* dst, size_t n8, size_t gt, size_t stride) {
    for (size_t i = gt; i < n8; i += stride) {
        const f32x4 a = __builtin_nontemporal_load((const f32x4*)src + 2 * i), b = __builtin_nontemporal_load((const f32x4*)src + 2 * i + 1);
        u32x4 o; o.x = cvt_pk_bf16(a[0], a[1]); o.y = cvt_pk_bf16(a[2], a[3]); o.z = cvt_pk_bf16(b[0], b[1]); o.w = cvt_pk_bf16(b[2], b[3]);
        *((u32x4*)dst + i) = o; }
}
__device__ __forceinline__ unsigned e2m1_code(float a) { const float aa = fabsf(a);
    const unsigned c = (aa > 0.25f ? 1u : 0u) + (aa > 0.75f ? 1u : 0u) + (aa > 1.25f ? 1u : 0u) + (aa > 1.75f ? 1u : 0u) + (aa > 2.5f ? 1u : 0u) + (aa > 3.5f ? 1u : 0u) + (aa > 5.0f ? 1u : 0u);
    return c | ((__builtin_bit_cast(unsigned, a) >> 28) & 8u); }
__device__ __forceinline__ void prologue_phase(ArgP Ap, LAS unsigned char* lds, int vcu, int G, int tid, int wid, int lane) {
    unsigned char* ws = Ap->ws;
    const int gw = vcu * 8 + wid, NGW = G * 8;
    LAS float* scr = (LAS float*)(lds + wid * 16384);
    constexpr int NT_ITEMS = 1024 + 256 + 1024 + 1536 + 512 + 3072 + 1536 + 4096;
    for (int it = gw; it < NT_ITEMS; it += NGW) {
        int r = it; const float* src; bf16_t* dst; int K, N, kind = 0;
        if (r < 1024) { const int m = r >> 9; r &= 511; src = Ap->in[I_POOL_WIN] + (size_t)m * DM * DM; dst = (bf16_t*)(ws + WS_POOL_WIN) + (size_t)m * DM * DM; K = DM; N = DM; }
        else if ((r -= 1024) < 256) { const int m = r >> 5; r &= 31; src = Ap->in[I_POOL_WGRP] + (size_t)m * 65536; dst = (bf16_t*)(ws + WS_POOL_WGRP) + (size_t)m * 65536; K = 256; N = 256; }
        else if ((r -= 256) < 1024) { const int m = r >> 9; r &= 511; src = Ap->in[I_POOL_WOUT] + (size_t)m * DM * DM; dst = (bf16_t*)(ws + WS_POOL_WOUT) + (size_t)m * DM * DM; K = DM; N = DM; }
        else if ((r -= 1024) < 1536) { src = Ap->in[I_CONV_WIN]; dst = (bf16_t*)(ws + WS_CONV_WIN); K = DM; N = 3 * DM; kind = 1; }
        else if ((r -= 1536) < 512) { src = Ap->in[I_CONV_WOUT]; dst = (bf16_t*)(ws + WS_CONV_WOUT); K = DM; N = DM; }
        else if ((r -= 512) < 3072) { src = Ap->in[I_GMLP_WIN]; dst = (bf16_t*)(ws + WS_GMLP_WIN); K = DM; N = 2 * GH; }
        else if ((r -= 3072) < 1536) { src = Ap->in[I_GMLP_WOUT]; dst = (bf16_t*)(ws + WS_GMLP_WOUT); K = GH; N = DM; }
        else { r -= 1536; const int m = r >> 10; r &= 1023; src = Ap->in[I_PEER_WQ] + (size_t)m * DM * 2048; dst = (bf16_t*)(ws + WS_PEER_WQ) + (size_t)m * DM * 2048; K = DM; N = 2048; }
        const int nblk = N / 32, kb = r / nblk, nb = r % nblk, n0 = 32 * nb;
        int drow = n0;
        if (kind == 1 && n0 >= DM) { const int xt = n0 >= 2 * DM, ch = n0 - (xt ? 2 * DM : DM); drow = DM + 256 * (ch >> 7) + 128 * xt + (ch & 127); }
        transpose_item(src, K, N, dst, drow, scr, 64 * kb, n0, lane);
    }
    const size_t gt = (size_t)vcu * NTHREADS + tid, stride = (size_t)G * NTHREADS;
    convert_stream(Ap->in[I_PEER_KEYS], (bf16_t*)(ws + WS_KEYS), (size_t)DEPTH * 16 * 128 * 128 / 8, gt, stride);
    for (int row0 = gw * 4; row0 < 2 * DEPTH * NEXP; row0 += NGW * 4) {
        f32x4 v[4][4]; float m[4];
#pragma unroll
        for (int rr = 0; rr < 4; ++rr) { const int row = row0 + rr, tab = row >> 16, lrow = row & 65535;
            const f32x4* src = (const f32x4*)((tab ? Ap->in[I_PEER_V] : Ap->in[I_PEER_U]) + (size_t)lrow * DM) + lane;
#pragma unroll
            for (int j = 0; j < 4; ++j) v[rr][j] = __builtin_nontemporal_load(src + 64 * j); }
#pragma unroll
        for (int rr = 0; rr < 4; ++rr) { float mm = 0.f;
#pragma unroll
            for (int j = 0; j < 4; ++j) mm = fmaxf(fmaxf(mm, fmaxf(fabsf(v[rr][j][0]), fabsf(v[rr][j][1]))), fmaxf(fabsf(v[rr][j][2]), fabsf(v[rr][j][3])));
#pragma unroll
            for (int o = 1; o < 64; o <<= 1) mm = fmaxf(mm, __shfl_xor(mm, o));
            m[rr] = mm; }
#pragma unroll
        for (int rr = 0; rr < 4; ++rr) { const int row = row0 + rr, tab = row >> 16, lrow = row & 65535, l = lrow >> 14, e = lrow & (NEXP - 1);
            if (tab) {
                const float S = m[rr] > 0.f ? (7.5f / 0.7f) / m[rr] : 1.0f;
#pragma unroll
                for (int j = 0; j < 4; ++j) { unsigned c[4];
#pragma unroll
                    for (int q = 0; q < 4; ++q) c[q] = (unsigned)fminf(fmaxf(floorf(v[rr][j][q] * S + 8.0f), 0.f), 15.f);
                    unsigned pk = c[0] | (c[1] << 4) | (c[2] << 16) | (c[3] << 20); if (lane & 1) pk <<= 8;
                    pk |= (unsigned)__shfl_xor((int)pk, 1);
                    if (!(lane & 1)) *(unsigned*)(ws + WS_TABV + (((size_t)l * 4 + j) * NEXP + e) * 128 + 2 * lane) = pk; }
            } else {
                const float S = m[rr] > 0.f ? (6.0f / 0.9f) / m[rr] : 1.0f;
#pragma unroll
                for (int j = 0; j < 4; ++j) { unsigned pk = e2m1_code(v[rr][j][0] * S) | (e2m1_code(v[rr][j][1] * S) << 4) | (e2m1_code(v[rr][j][2] * S) << 8) | (e2m1_code(v[rr][j][3] * S) << 12);
                    pk |= (unsigned)__shfl_xor((int)pk, 1) << 16;
                    if (!(lane & 1)) *(unsigned*)(ws + WS_TABU + (((size_t)l * 4 + j) * NEXP + e) * 128 + 2 * lane) = pk; }
            }
            if (lane == 0) ((unsigned short*)(ws + WS_SCU))[2 * lrow + tab] = (unsigned short)(cvt_pk_bf16(m[rr] > 0.f ? m[rr] * (tab ? 0.7f / 7.5f : 0.9f / 6.0f) : 1.0f, 0.f) & 0xffffu); }
    }
    for (size_t i = gt; i < (size_t)2 * 4 * 256 * 256 / 8; i += stride) { const size_t idx = i * 8; const int l = (int)(idx >> 18), g = (int)(idx >> 16) & 3, j0 = (int)idx & 255;
        const f32x4 a = *((const f32x4*)Ap->in[I_POOL_WGRP] + 2 * i), b = *((const f32x4*)Ap->in[I_POOL_WGRP] + 2 * i + 1);
        const float* sp = Ap->in[I_POOL_SCALE] + (size_t)l * DM + 256 * g + j0; const f32x4 sa = *(const f32x4*)sp, sb = *(const f32x4*)(sp + 4);
        u32x4 o; o.x = cvt_pk_bf16(a[0] * sa[0], a[1] * sa[1]); o.y = cvt_pk_bf16(a[2] * sa[2], a[3] * sa[3]); o.z = cvt_pk_bf16(b[0] * sb[0], b[1] * sb[1]); o.w = cvt_pk_bf16(b[2] * sb[2], b[3] * sb[3]);
        *((u32x4*)(ws + WS_WGS) + i) = o; }
    __syncthreads();
    LAS float* cond = (LAS float*)lds;
    for (int i = tid; i < BATCH * DM; i += NTHREADS) { const int b = i >> 10, k = i & 1023; const float c = Ap->in[I_C][i]; cond[k * 8 + b] = c * __builtin_amdgcn_rcpf(1.0f + __expf(-c)); }
    __syncthreads();
    float* modp = (float*)(ws + WS_ADAP);
    for (int it = gw; it < DEPTH * 24 * 16; it += NGW) {
        const int l = it / 384, r = it % 384, cgp = r >> 4, kc = r & 15;
        const float* wp = Ap->in[I_ADA_W] + ((size_t)l * DM + kc * 64) * (6 * DM) + cgp * 256 + 4 * lane;
        f32x4 acc[8];
#pragma unroll
        for (int b = 0; b < 8; ++b) acc[b] = (f32x4){0.f, 0.f, 0.f, 0.f};
#pragma unroll 8
        for (int k = 0; k < 64; ++k) { const f32x4 w = __builtin_nontemporal_load((const f32x4*)(wp + (size_t)k * (6 * DM)));
            const f32x4 c0 = *(const LAS f32x4*)(cond + (kc * 64 + k) * 8), c1 = *(const LAS f32x4*)(cond + (kc * 64 + k) * 8 + 4);
            acc[0] += c0[0] * w; acc[1] += c0[1] * w; acc[2] += c0[2] * w; acc[3] += c0[3] * w; acc[4] += c1[0] * w; acc[5] += c1[1] * w; acc[6] += c1[2] * w; acc[7] += c1[3] * w; }
#pragma unroll
        for (int b = 0; b < 8; ++b) *(f32x4*)(modp + (((size_t)kc * DEPTH + l) * 8 + b) * (6 * DM) + cgp * 256 + 4 * lane) = acc[b];
    }
}
__device__ __forceinline__ void modreduce_phase(ArgP Ap, int vcu, int G, int tid) {
    unsigned char* ws = Ap->ws; const float* modp = (const float*)(ws + WS_ADAP); float* mod = (float*)(ws + WS_MOD);
    constexpr int N4 = DEPTH * BATCH * 6 * DM / 4;
    for (int i = vcu * NTHREADS + tid; i < N4; i += G * NTHREADS) {
        const int n4 = i % (6 * DM / 4), l = i / (BATCH * 6 * DM / 4);
        f32x4 a = *((const f32x4*)(Ap->in[I_ADA_B] + (size_t)l * 6 * DM) + n4);
#pragma unroll
        for (int kc = 0; kc < 16; ++kc) a += *((const f32x4*)modp + (size_t)kc * N4 + i);
        *((f32x4*)mod + i) = a; }
}

__device__ __forceinline__ void norm_phase(const float* x, const float* gn, const float* macc  , const float* mbias  , int sh_off, int sc_off, bf16_t* H, int gw, int NGW, int lane) {
    for (int ch = gw; ch < MTOK / 16; ch += NGW) {
        const int row0 = ch * 16, b = row0 >> 12;
        f32x4 c1[4], shv[4];
#pragma unroll
        for (int j = 0; j < 4; ++j) { const int col = 4 * lane + 256 * j;
            const f32x4 sc = *(const f32x4*)(macc + (size_t)b * 6 * DM + sc_off + col);
            c1[j] = *(const f32x4*)(gn + col) * (1.0f + sc);
            shv[j] = *(const f32x4*)(macc + (size_t)b * 6 * DM + sh_off + col); }
        for (int r = row0; r < row0 + 16; ++r) {
            const f32x4* xr = (const f32x4*)(x + (size_t)r * DM) + lane;
            f32x4 v[4]; float ss = 0.f;
#pragma unroll
            for (int j = 0; j < 4; ++j) { v[j] = xr[64 * j]; ss += (v[j][0] * v[j][0] + v[j][1] * v[j][1]) + (v[j][2] * v[j][2] + v[j][3] * v[j][3]); }
            const float rstd = __builtin_amdgcn_rsqf(wave_sum_all(ss) * (1.0f / DM) + EPS);
            u32x2* o8 = (u32x2*)(H + (size_t)r * DM) + lane;
#pragma unroll
            for (int j = 0; j < 4; ++j) { const f32x4 o = v[j] * rstd * c1[j] + shv[j]; u32x2 w; w.x = cvt_pk_bf16(o[0], o[1]); w.y = cvt_pk_bf16(o[2], o[3]); o8[64 * j] = w; }
        }
    }
}
__device__ __forceinline__ void resnorm_phase(const float* xf  , const bf16_t* xsi, bf16_t* xso  , const bf16_t* Y, const float* gate  , const float* gn, const float* macc, int sh_off, int sc_off, bf16_t* H, int gw, int NGW, int lane) {
    for (int ch = gw; ch < MTOK / 16; ch += NGW) {
        const int row0 = ch * 16, b = row0 >> 12;
        f32x4 c1[4], shv[4], gt[4];
#pragma unroll
        for (int j = 0; j < 4; ++j) { const int col = 4 * lane + 256 * j;
            const f32x4 sc = *(const f32x4*)(macc + (size_t)b * 6 * DM + sc_off + col);
            c1[j] = *(const f32x4*)(gn + col) * (1.0f + sc);
            shv[j] = *(const f32x4*)(macc + (size_t)b * 6 * DM + sh_off + col);
            gt[j] = *(const f32x4*)(gate + (size_t)b * 6 * DM + col); }
#pragma unroll 1
        for (int r0 = row0; r0 < row0 + 16; r0 += 4) {
            u32x2 yv[4][4]; f32x4 v[4][4];
#pragma unroll
            for (int rr = 0; rr < 4; ++rr) { const u32x2* yr = (const u32x2*)(Y + (size_t)(r0 + rr) * DM) + lane;
#pragma unroll
                for (int j = 0; j < 4; ++j) yv[rr][j] = yr[64 * j]; }
            if (xf) {
#pragma unroll
                for (int rr = 0; rr < 4; ++rr) { const f32x4* xr = (const f32x4*)(xf + (size_t)(r0 + rr) * DM) + lane;
#pragma unroll
                    for (int j = 0; j < 4; ++j) v[rr][j] = xr[64 * j]; } }
            else { u32x2 xv[4][4];
#pragma unroll
                for (int rr = 0; rr < 4; ++rr) { const u32x2* xr = (const u32x2*)(xsi + (size_t)(r0 + rr) * DM) + lane;
#pragma unroll
                    for (int j = 0; j < 4; ++j) xv[rr][j] = xr[64 * j]; }
#pragma unroll
                for (int rr = 0; rr < 4; ++rr)
#pragma unroll
                    for (int j = 0; j < 4; ++j) v[rr][j] = (f32x4){bf_lo(xv[rr][j].x), bf_hi(xv[rr][j].x), bf_lo(xv[rr][j].y), bf_hi(xv[rr][j].y)}; }
            float ss[4];
#pragma unroll
            for (int rr = 0; rr < 4; ++rr) { float q = 0.f;
#pragma unroll
                for (int j = 0; j < 4; ++j) { const u32x2 y = yv[rr][j]; v[rr][j] += gt[j] * (f32x4){bf_lo(y.x), bf_hi(y.x), bf_lo(y.y), bf_hi(y.y)};
                    q += (v[rr][j][0] * v[rr][j][0] + v[rr][j][1] * v[rr][j][1]) + (v[rr][j][2] * v[rr][j][2] + v[rr][j][3] * v[rr][j][3]); }
                ss[rr] = q; }
#pragma unroll
            for (int o = 1; o < 64; o <<= 1) {
#pragma unroll
                for (int rr = 0; rr < 4; ++rr) ss[rr] += __shfl_xor(ss[rr], o); }
#pragma unroll
            for (int rr = 0; rr < 4; ++rr) { const int r = r0 + rr; const float rstd = __builtin_amdgcn_rsqf(ss[rr] * (1.0f / DM) + EPS);
                u32x2* xw = (u32x2*)(xso + (size_t)r * DM) + lane; u32x2* o8 = (u32x2*)(H + (size_t)r * DM) + lane;
#pragma unroll
                for (int j = 0; j < 4; ++j) { u32x2 w; w.x = cvt_pk_bf16(v[rr][j][0], v[rr][j][1]); w.y = cvt_pk_bf16(v[rr][j][2], v[rr][j][3]); xw[64 * j] = w;
                    const f32x4 o = v[rr][j] * rstd * c1[j] + shv[j]; w.x = cvt_pk_bf16(o[0], o[1]); w.y = cvt_pk_bf16(o[2], o[3]); o8[64 * j] = w; } }
        }
    }
}
__device__ __forceinline__ void final_phase(float* x, const float* gf, int gw, int NGW, int lane) {
    f32x4 gv[4];
#pragma unroll
    for (int j = 0; j < 4; ++j) gv[j] = *(const f32x4*)(gf + 4 * lane + 256 * j);
    for (int r = gw; r < MTOK; r += NGW) {
        f32x4* xr = (f32x4*)(x + (size_t)r * DM) + lane;
        f32x4 v[4]; float ss = 0.f;
#pragma unroll
        for (int j = 0; j < 4; ++j) { v[j] = xr[64 * j]; ss += (v[j][0] * v[j][0] + v[j][1] * v[j][1]) + (v[j][2] * v[j][2] + v[j][3] * v[j][3]); }
        const float rstd = __builtin_amdgcn_rsqf(wave_sum_all(ss) * (1.0f / DM) + EPS);
#pragma unroll
        for (int j = 0; j < 4; ++j) xr[64 * j] = v[j] * rstd * gv[j];
    }
}

__device__ __forceinline__ void unpack8(const u32x4 w, float (&f)[8]) { f[0] = bf_lo(w.x); f[1] = bf_hi(w.x); f[2] = bf_lo(w.y); f[3] = bf_hi(w.y); f[4] = bf_lo(w.z); f[5] = bf_hi(w.z); f[6] = bf_lo(w.w); f[7] = bf_hi(w.w); }
__device__ __forceinline__ u32x4 pack8(const float (&f)[8]) { u32x4 o; o.x = cvt_pk_bf16(f[0], f[1]); o.y = cvt_pk_bf16(f[2], f[3]); o.z = cvt_pk_bf16(f[4], f[5]); o.w = cvt_pk_bf16(f[6], f[7]); return o; }
__device__ __forceinline__ void pool_elem_phase(const bf16_t* U, bf16_t* P, int vcu, int G, int tid) {
    const int chunk = tid & 127, run = tid >> 7, c0 = 8 * chunk, w = 2 << (c0 >> 8);
    for (int unit = vcu; unit < MTOK / 128; unit += G) {
        const int t0 = unit * 128 + run * 32, seq0 = t0 & ~(SEQ - 1);
        float s[8];
#pragma unroll
        for (int j = 0; j < 8; ++j) s[j] = 0.f;
        for (int tau = t0 - w; tau < t0; ++tau) if (tau >= seq0) { float f[8];     unpack8(*(const u32x4*)(U + (size_t)tau * DM + c0), f);
#pragma unroll
            for (int j = 0; j < 8; ++j) s[j] += f[j]; }
#pragma unroll 1
        for (int tb = t0; tb < t0 + 32; tb += 8) {
            u32x4 cur[8], old[8];
#pragma unroll
            for (int i = 0; i < 8; ++i) { cur[i] = *(const u32x4*)(U + (size_t)(tb + i) * DM + c0);
                const int tl = tb + i - w; old[i] = *(const u32x4*)(U + (size_t)(tl >= seq0 ? tl : seq0) * DM + c0); }
#pragma unroll
            for (int i = 0; i < 8; ++i) { const int t = tb + i; float f[8], o[8]; unpack8(cur[i], f);
#pragma unroll
                for (int j = 0; j < 8; ++j) s[j] += f[j];
                if (t - w >= seq0) { float q[8]; unpack8(old[i], q);
#pragma unroll
                    for (int j = 0; j < 8; ++j) s[j] -= q[j]; }
                const int pos1 = t - seq0 + 1; const float inv = 1.0f / (float)(pos1 < w ? pos1 : w);
#pragma unroll
                for (int j = 0; j < 8; ++j) o[j] = s[j] * inv - f[j];
                *(u32x4*)(P + (size_t)t * DM + c0) = pack8(o); }
        }
    }
}
__device__ __forceinline__ void conv_elem_phase(const bf16_t* BG, const bf16_t* Z, const float* cw  , bf16_t* Aout, int vcu, int G, int tid) {
    const int chunk = tid & 127, run = tid >> 7, c0 = 8 * chunk;
    float w0[8], w1[8], w2[8];
#pragma unroll
    for (int j = 0; j < 8; ++j) { w0[j] = cw[c0 + j]; w1[j] = cw[DM + c0 + j]; w2[j] = cw[2 * DM + c0 + j]; }
    for (int unit = vcu; unit < MTOK / 128; unit += G) {
        const int t0 = unit * 128 + run * 32, seq0 = t0 & ~(SEQ - 1);
        float zm2[8], zm1[8];
#pragma unroll
        for (int j = 0; j < 8; ++j) { zm2[j] = 0.f; zm1[j] = 0.f; }
        if (t0 - 2 >= seq0) unpack8(*(const u32x4*)(Z + (size_t)(t0 - 2) * DM + c0), zm2);
        if (t0 - 1 >= seq0) unpack8(*(const u32x4*)(Z + (size_t)(t0 - 1) * DM + c0), zm1);
#pragma unroll 1
        for (int tb = t0; tb < t0 + 32; tb += 8) {
            u32x4 zr[8], br[8];
#pragma unroll
            for (int i = 0; i < 8; ++i) { zr[i] = *(const u32x4*)(Z + (size_t)(tb + i) * DM + c0); br[i] = *(const u32x4*)(BG + (size_t)(tb + i) * DM + c0); }
#pragma unroll
            for (int i = 0; i < 8; ++i) { float z[8], bg[8], o[8]; unpack8(zr[i], z); unpack8(br[i], bg);
#pragma unroll
                for (int j = 0; j < 8; ++j) { o[j] = bg[j] * (w0[j] * zm2[j] + w1[j] * zm1[j] + w2[j] * z[j]); zm2[j] = zm1[j]; zm1[j] = z[j]; }
                *(u32x4*)(Aout + (size_t)(tb + i) * DM + c0) = pack8(o); }
        }
    }
}

__device__ __forceinline__ int wp_off(int row, int chunk) { return row * 256 + ((chunk ^ (row & 15)) << 4); }
__device__ __forceinline__ void mix_phase(LAS unsigned char* lds, bf16_t* UA, const bf16_t* VT, const float* WS, const float* BS, const float* LNG, const float* LNB, int vcu, int G, int tid, int wid, int lane) {
    LAS unsigned char* WP = lds;
    LAS float* MU = (LAS float*)(lds + 32768); LAS float* RSTD = MU + 128; LAS float* R1 = MU + 256; LAS float* R2 = MU + 384;
    LAS float* PART = (LAS float*)(lds + 36864);
    LAS unsigned char* VS = lds + 36864;
    for (int n = vcu; n < MTOK / 128; n += G) {
        {
            const int cgp = tid >> 4, tl = tid & 15;
            float s[8], q[8];
#pragma unroll
            for (int j = 0; j < 8; ++j) { s[j] = 0.f; q[j] = 0.f; }
#pragma unroll 4
            for (int it = 0; it < GH / 32; ++it) { float f[8]; unpack8(*(const u32x4*)(VT + ((size_t)n * GH + it * 32 + cgp) * 128 + tl * 8), f);
#pragma unroll
                for (int j = 0; j < 8; ++j) { s[j] += f[j]; q[j] += f[j] * f[j]; } }
#pragma unroll
            for (int j = 0; j < 8; ++j) { PART[(cgp * 128 + tl * 8 + j) * 2] = s[j]; PART[(cgp * 128 + tl * 8 + j) * 2 + 1] = q[j]; }
            __syncthreads();
            if (tid < 128) { float S = 0.f, Q = 0.f;
                for (int k = 0; k < 32; ++k) { S += PART[(k * 128 + tid) * 2]; Q += PART[(k * 128 + tid) * 2 + 1]; }
                const float mu = S * (1.0f / GH), var = Q * (1.0f / GH) - mu * mu; MU[tid] = mu; RSTD[tid] = __builtin_amdgcn_rsqf(fmaxf(var, 0.f) + EPS); }
            __syncthreads();
        }
        for (int g = 0; g < 8; ++g) {
            const int fr = lane & 15, fq = lane >> 4, cbase = g * 384 + wid * 48;
            bf16x8 av[4][3];
#pragma unroll
            for (int ks = 0; ks < 4; ++ks)
#pragma unroll
                for (int ct = 0; ct < 3; ++ct) av[ks][ct] = *(const bf16x8*)(VT + ((size_t)n * GH + cbase + ct * 16 + fr) * 128 + ks * 32 + fq * 8);
            {
                const int i = tid >> 2, part = tid & 3;
                const float* wrow = WS + ((size_t)g * 128 + i) * 128 + part * 32;
                float r1 = 0.f, r2 = 0.f;
#pragma unroll
                for (int jj = 0; jj < 32; jj += 8) { const int j0 = part * 32 + jj;
                    f32x4 a = *(const f32x4*)(wrow + jj), b = *(const f32x4*)(wrow + jj + 4);
                    if (i < 64 && j0 >= 64) { a = (f32x4){0.f, 0.f, 0.f, 0.f}; b = a; }
                    const f32x4 ra = *(const LAS f32x4*)(RSTD + j0), rb = *(const LAS f32x4*)(RSTD + j0 + 4), ma = *(const LAS f32x4*)(MU + j0), mb = *(const LAS f32x4*)(MU + j0 + 4);
                    const f32x4 wa = a * ra, wb = b * rb;
                    r1 += (wa[0] * ma[0] + wa[1] * ma[1]) + (wa[2] * ma[2] + wa[3] * ma[3]) + (wb[0] * mb[0] + wb[1] * mb[1]) + (wb[2] * mb[2] + wb[3] * mb[3]);
                    r2 += (a[0] + a[1]) + (a[2] + a[3]) + (b[0] + b[1]) + (b[2] + b[3]);
                    u32x4 o; o.x = cvt_pk_bf16(wa[0], wa[1]); o.y = cvt_pk_bf16(wa[2], wa[3]); o.z = cvt_pk_bf16(wb[0], wb[1]); o.w = cvt_pk_bf16(wb[2], wb[3]);
                    *(LAS u32x4*)(WP + wp_off(i, j0 >> 3)) = o; }
                r1 += __shfl_xor(r1, 1); r1 += __shfl_xor(r1, 2); r2 += __shfl_xor(r2, 1); r2 += __shfl_xor(r2, 2);
                if (part == 0) { R1[i] = r1; R2[i] = r2; }
            }
            __syncthreads();
            f32x4 acc[3][8];
#pragma unroll
            for (int ct = 0; ct < 3; ++ct)
#pragma unroll
                for (int it = 0; it < 8; ++it) acc[ct][it] = (f32x4){0.f, 0.f, 0.f, 0.f};
#pragma unroll
            for (int ks = 0; ks < 4; ++ks) {
#pragma unroll
                for (int it = 0; it < 8; ++it) { const bf16x8 bw = *(const LAS bf16x8*)(WP + wp_off(it * 16 + fr, ks * 4 + fq));
#pragma unroll
                    for (int ct = 0; ct < 3; ++ct) acc[ct][it] = __builtin_amdgcn_mfma_f32_16x16x32_bf16(av[ks][ct], bw, acc[ct][it], 0, 0, 0); }
                __builtin_amdgcn_sched_barrier(0);
            }
#pragma unroll
            for (int ct = 0; ct < 3; ++ct) { const int c4 = cbase + ct * 16 + 4 * fq;
                const f32x4 lg = *(const f32x4*)(LNG + c4), lb = *(const f32x4*)(LNB + c4);
#pragma unroll
                for (int it = 0; it < 8; ++it) { const int i = it * 16 + fr; const float r1 = R1[i], r2 = R2[i], bs = BS[g * 128 + i];
                    const f32x4 vs = lg * (acc[ct][it] - r1) + lb * r2 + bs;
                    u32x2 o; o.x = cvt_pk_bf16(vs[0], vs[1]); o.y = cvt_pk_bf16(vs[2], vs[3]);
                    *(LAS u32x2*)(VS + i * 784 + (wid * 48 + ct * 16 + 4 * fq) * 2) = o; } }
            __syncthreads();
#pragma unroll 4
            for (int c = tid; c < 128 * 48; c += NTHREADS) { const int tok = c / 48, ch8 = c - tok * 48;
                const u32x4 vv = *(const LAS u32x4*)(VS + tok * 784 + ch8 * 16);
                u32x4* up = (u32x4*)(UA + (size_t)(n * 128 + tok) * GH + g * 384 + ch8 * 8); const u32x4 uu = *up;
                u32x4 o; o.x = cvt_pk_bf16(bf_lo(uu.x) * bf_lo(vv.x), bf_hi(uu.x) * bf_hi(vv.x)); o.y = cvt_pk_bf16(bf_lo(uu.y) * bf_lo(vv.y), bf_hi(uu.y) * bf_hi(vv.y));
                o.z = cvt_pk_bf16(bf_lo(uu.z) * bf_lo(vv.z), bf_hi(uu.z) * bf_hi(vv.z)); o.w = cvt_pk_bf16(bf_lo(uu.w) * bf_lo(vv.w), bf_hi(uu.w) * bf_hi(vv.w));
                *up = o; }
            __syncthreads();
        }
    }
}

__device__ __forceinline__ void topk_units(LAS unsigned char* lds, const bf16_t* Q, const bf16_t* KEYS, int* SELI, float* SELW, const pg8::StaticOrder& S, int tid, int wid, int lane) {
    LAS unsigned char* kl = lds;
    LAS float* topv = (LAS float*)(lds + 65536);
    const int p = wid >> 2, sub = wid & 3, tl = lane & 31, hi = lane >> 5;
    int hprev = -1;
#pragma unroll 1
    for (int k = 0; ; k = (k & 1) ? k + 3 : k + 1) {
        pg8::Unit ua, ub; if (!S.next(k, ua)) break;
        const bool hasb = S.next(k + 2, ub);
        const bool pair = hasb && ub.pn == ua.pn;
#pragma unroll 1
        for (int part = 0; part < ((hasb && !pair) ? 2 : 1); ++part) {
            const int h = part ? ub.pn : ua.pn, pm0 = part ? ub.pm : ua.pm, pm1 = ub.pm, ntile = pair ? 4 : 2;
            __syncthreads();
            if (h != hprev) {
                for (int c = tid; c < 4096; c += NTHREADS) { const int row = c >> 4, ch = c & 15;
                    const u32x4 v = *(const u32x4*)(KEYS + ((size_t)h * 256 + row) * 128 + ch * 8);
                    *(LAS u32x4*)(kl + row * 256 + ((ch ^ (row & 15)) << 4)) = v; }
                hprev = h; }
            __syncthreads();
#pragma unroll 1
            for (int t4 = 0; t4 < ntile; ++t4) {
                const int tile = 2 * (t4 < 2 ? pm0 : pm1) + (t4 & 1);
                const bf16_t* qrow = Q + ((size_t)((tile * 8 + h) * 32 + 16 * p + hi) * 128 + sub * 32 + tl) * 8;
                bf16x8 bq[8];
#pragma unroll
                for (int ks = 0; ks < 8; ++ks) bq[ks] = *(const bf16x8*)(qrow + (size_t)ks * 2 * 128 * 8);
                f32x16 acc[4];
#pragma unroll
                for (int kt = 0; kt < 4; ++kt)
#pragma unroll
                    for (int r = 0; r < 16; ++r) acc[kt][r] = 0.f;
#pragma unroll
                for (int ks = 0; ks < 8; ++ks)
#pragma unroll
                    for (int kt = 0; kt < 4; ++kt) { const int row = p * 128 + kt * 32 + tl;
                        const bf16x8 ak = *(const LAS bf16x8*)(kl + row * 256 + (((2 * ks + hi) ^ (row & 15)) << 4));
                        acc[kt] = __builtin_amdgcn_mfma_f32_32x32x16_bf16(ak, bq[ks], acc[kt], 0, 0, 0); }
                float v[64];
#pragma unroll
                for (int kt = 0; kt < 4; ++kt)
#pragma unroll
                    for (int r = 0; r < 16; ++r) { const unsigned key = (unsigned)(kt * 32 + (r & 3) + 8 * (r >> 2) + 4 * hi);
                        v[kt * 16 + r] = __uint_as_float((__float_as_uint(acc[kt][r]) & ~127u) | key); }
                top16_of_64(v);
                float m[16];
#pragma unroll
                for (int i = 0; i < 16; ++i) m[i] = fmaxf(v[i], __shfl_xor(v[15 - i], 32));
                bmerge16_desc<0, 16>(m);
                if (hi == 0) { LAS f32x4* dst = (LAS f32x4*)(topv + ((t4 * 2 + p) * 128 + sub * 32 + tl) * 16);
#pragma unroll
                    for (int i = 0; i < 4; ++i) dst[i] = (f32x4){m[4 * i], m[4 * i + 1], m[4 * i + 2], m[4 * i + 3]}; }
            }
            __syncthreads();
            if (tid < ntile * 128) {
                const int t4 = tid >> 7, tok = tid & 127, tile = 2 * (t4 < 2 ? pm0 : pm1) + (t4 & 1);
                const LAS float* t0 = topv + ((t4 * 2 + 0) * 128 + tok) * 16; const LAS float* t1 = topv + ((t4 * 2 + 1) * 128 + tok) * 16;
                float s0[16], s1[16];
#pragma unroll
                for (int i = 0; i < 4; ++i) { const f32x4 a = *(const LAS f32x4*)(t0 + 4 * i), b = *(const LAS f32x4*)(t1 + 4 * i);
                    s0[4 * i] = a[0]; s0[4 * i + 1] = a[1]; s0[4 * i + 2] = a[2]; s0[4 * i + 3] = a[3]; s1[4 * i] = b[0]; s1[4 * i + 1] = b[1]; s1[4 * i + 2] = b[2]; s1[4 * i + 3] = b[3]; }
                float c[64];
                constexpr int pre[16] = {0, 16, 24, 29, 33, 36, 38, 40, 42, 43, 44, 45, 46, 47, 48, 49};
#pragma unroll
                for (int a = 0; a < 16; ++a)
#pragma unroll
                    for (int b = 0; b < 16; ++b) if ((a + 1) * (b + 1) <= 16) c[pre[a] + b] = __uint_as_float((__float_as_uint(s0[a] + s1[b]) & ~255u) | (unsigned)(a * 16 + b));
#pragma unroll
                for (int i = 50; i < 64; ++i) c[i] = -3.0e38f;
                top16_of_64(c);
                float e[16], sum = 0.f;
#pragma unroll
                for (int kk = 0; kk < 16; ++kk) { e[kk] = __builtin_amdgcn_exp2f((c[kk] - c[0]) * 1.44269504f); sum += e[kk]; }
                const float inv = 1.0f / sum;
                const size_t o = (size_t)(tile * 128 + tok) * NPICK + h * 16;
#pragma unroll
                for (int k4 = 0; k4 < 4; ++k4) { i32x4 ei; f32x4 wv;
#pragma unroll
                    for (int j = 0; j < 4; ++j) { const unsigned code = __float_as_uint(c[4 * k4 + j]) & 255u;
                        const unsigned i1 = __float_as_uint(t0[code >> 4]) & 127u, i2 = __float_as_uint(t1[code & 15u]) & 127u;
                        ei[j] = (int)(i1 * 128u + i2); wv[j] = e[4 * k4 + j] * inv; }
                    *(i32x4*)(SELI + o + 4 * k4) = ei; *(f32x4*)(SELW + o + 4 * k4) = wv; }
            }
        }
    }
    __syncthreads();
}

typedef const unsigned char* cbytes;
#ifndef DUP_MASK
#define DUP_MASK 0
#endif
template <int CTRL> __device__ __forceinline__ float dpp_f(float v) { return __builtin_bit_cast(float, __builtin_amdgcn_update_dpp(0, __builtin_bit_cast(int, v), CTRL, 0xf, 0xf, false)); }
#define DPP_F(v, ctrl) dpp_f<(ctrl)>(v)
#define PG_IDX(EV, TKN) do { const LAS u32x4* _ip = (const LAS u32x4*)(idxw + (TKN) * 128 + 16 * g8); \
        _Pragma("unroll") for (int q = 0; q < 2; ++q) { const u32x4 _e = _ip[q]; _Pragma("unroll") for (int w = 0; w < 4; ++w) { EV[8 * q + 2 * w] = (int)(_e[w] & 0xffffu); EV[8 * q + 2 * w + 1] = (int)(_e[w] >> 16); } } } while (0)
#define PG_GATHER8(BUF, SL, EV, J0) do { _Pragma("unroll") for (int j = 0; j < 8; ++j) BUF[j] = *(const u32x4*)((SL) + ((unsigned)EV[(J0) + j] * 128u + s8 * 16u)); } while (0)
#define PGU_IDX(EV, TKN) do { const LAS u32x4* _ip = (const LAS u32x4*)(idxw + (TKN) * 128 + 16 * slotA); \
        _Pragma("unroll") for (int q = 0; q < 2; ++q) { const u32x4 _e = _ip[q]; _Pragma("unroll") for (int w = 0; w < 4; ++w) { EV[8 * q + 2 * w] = (int)(_e[w] & 0xffffu); EV[8 * q + 2 * w + 1] = (int)(_e[w] >> 16); } } } while (0)
#define PGU_GATHER8(BUF, SL, EV, M0) do { _Pragma("unroll") for (int j = 0; j < 8; ++j) BUF[j] = *(const u32x4*)((SL) + ((unsigned)EV[4 * (((M0) + j) & 3) + (((M0) + j) >> 2)] * 128u + pieceA * 16u)); } while (0)
#define PGU_HB(HR, IT) do { const int _it = (IT) < 63 ? (IT) : 63; const u32x4* _hp = (const u32x4*)(H + (size_t)(tk0 + (_it & 15)) * DM + (((xg + (_it >> 4)) & 3) * 256) + hoffB); HR[0] = _hp[0]; HR[1] = _hp[1]; } while (0)
#define PGU_CVT8(W0, W1) __builtin_amdgcn_cvt_pk_fp8_f32(bf_lo(W1), bf_hi(W1), __builtin_amdgcn_cvt_pk_fp8_f32(bf_lo(W0), bf_hi(W0), 0, false), true)
#define PGU_BOP(BV, HR) do { const int _q0 = PGU_CVT8(HR[0].x, HR[0].y), _q1 = PGU_CVT8(HR[0].z, HR[0].w), _q2 = PGU_CVT8(HR[1].x, HR[1].y), _q3 = PGU_CVT8(HR[1].z, HR[1].w); \
        BV = (i32x8){blo ? _q0 : 0, blo ? _q1 : 0, blo ? _q2 : 0, blo ? _q3 : 0, bhi ? _q0 : 0, bhi ? _q1 : 0, bhi ? _q2 : 0, bhi ? _q3 : 0}; } while (0)
#define PGU_MMA8(BUF, _b, ACC, M0) do { \
        _Pragma("unroll") for (int j = 0; j < 8; ++j) { const u32x4 _u = BUF[j]; const i32x8 _a = {(int)_u.x, (int)_u.y, (int)_u.z, (int)_u.w, 0, 0, 0, 0}; \
            const f32x4 _d = __builtin_amdgcn_mfma_scale_f32_16x16x128_f8f6f4(_a, _b, (f32x4){0.f, 0.f, 0.f, 0.f}, 4, 0, 0, 0, 0, 0); \
            float _v = i4 == 0 ? _d[0] : i4 == 1 ? _d[1] : i4 == 2 ? _d[2] : _d[3]; _v += DPP_F(_v, 0xB1); _v += DPP_F(_v, 0x4E); \
            ACC[((M0) + j) >> 2] = (i4 == (((M0) + j) & 3)) ? _v : ACC[((M0) + j) >> 2]; } } while (0)
#define PGU_DOTS(ACC, TKN) do { if (n16 < 8) { LAS f32x4* _dp = (LAS f32x4*)(dotw + (TKN) * 128 + 32 * c4 + 4 * n16); *_dp += ACC; } } while (0)
#define PG_VCOMP8(BUF, CV, J0) do { _Pragma("unroll") for (int j = 0; j < 8; ++j) { const u32x4 v = BUF[j]; const float c = CV[(J0) + j]; \
            acc[0] += c * __builtin_amdgcn_cvt_pk_f32_fp8(v.x, false); acc[1] += c * __builtin_amdgcn_cvt_pk_f32_fp8(v.x, true); \
            acc[2] += c * __builtin_amdgcn_cvt_pk_f32_fp8(v.y, false); acc[3] += c * __builtin_amdgcn_cvt_pk_f32_fp8(v.y, true); \
            acc[4] += c * __builtin_amdgcn_cvt_pk_f32_fp8(v.z, false); acc[5] += c * __builtin_amdgcn_cvt_pk_f32_fp8(v.z, true); \
            acc[6] += c * __builtin_amdgcn_cvt_pk_f32_fp8(v.w, false); acc[7] += c * __builtin_amdgcn_cvt_pk_f32_fp8(v.w, true); } } while (0)
#define PG_COEF(CV, TKN) do { const LAS f32x4* _cp = (const LAS f32x4*)(dotw + (TKN) * 128 + 16 * g8); \
        _Pragma("unroll") for (int q = 0; q < 4; ++q) { const f32x4 _c = _cp[q]; CV[4 * q] = _c[0]; CV[4 * q + 1] = _c[1]; CV[4 * q + 2] = _c[2]; CV[4 * q + 3] = _c[3]; } } while (0)
#define PG_COEF8(CV, TKN, J0) do { const LAS f32x4* _cp = (const LAS f32x4*)(dotw + (TKN) * 128 + 16 * g8 + (J0)); \
        const f32x4 _c0 = _cp[0], _c1 = _cp[1]; CV[0] = _c0[0]; CV[1] = _c0[1]; CV[2] = _c0[2]; CV[3] = _c0[3]; CV[4] = _c1[0]; CV[5] = _c1[1]; CV[6] = _c1[2]; CV[7] = _c1[3]; } while (0)
#define PG_XOFFS(IT) ((size_t)(tk0 + ((IT) & 15)) * DM + (((xg + ((IT) >> 4)) & 7) * 128) + xoff)
#define PG_XADDR(IT) (x + PG_XOFFS(IT))
#define PG_XLOAD(XV, IT) do { XV = *(const unsigned*)PG_XADDR(IT); } while (0)
__device__ __forceinline__ void peer_gather_phase(LAS unsigned char* lds, const bf16_t* H, cbytes TUP, cbytes TVP, const int* SELI, const float* SELW, const unsigned* SC, bf16_t* x  , float* outf  , const float* gacc, const float* gn_next  , const float* mod_next  , bf16_t* Hout, bool last, int vcu, int G, int wid, int lane) {
    const int g8 = lane >> 3, s8 = lane & 7, n16 = lane & 15, c4 = lane >> 4, i4 = lane & 3, slotA = 2 * ((lane >> 2) & 3) + (c4 >> 1), pieceA = 4 * (c4 & 1) + i4, hoffB = 128 * (c4 >> 1) + 32 * i4 + 16 * (c4 & 1);
    const bool blo = n16 < 4, bhi = n16 >= 4 && n16 < 8;
    const bool b3 = (lane & 8) != 0, b4 = (lane & 16) != 0, b5 = (lane & 32) != 0;
    const int xoff = s8 * 16 + 8 * (g8 & 1) + 4 * ((g8 >> 1) & 1) + 2 * (g8 >> 2);
    LAS unsigned short* idxw = (LAS unsigned short*)(lds + wid * 12288);
    LAS float* csw = (LAS float*)(lds + 98304 + wid * 64);
    LAS float* dotw = (LAS float*)(lds + wid * 12288 + 4096);
    for (int blk = vcu; blk < 256; blk += G) {
        const int xg = blk >> 5, tk0 = blk * 128 + wid * 16;
        const int nrep_u = (DUP_MASK & 0x20000) ? opaque(2) : 1;
#pragma unroll 1
        for (int rep_u = 0; rep_u < nrep_u; ++rep_u) {
#pragma unroll 4
        for (int i = 0; i < 16; ++i) { const int e0 = SELI[(size_t)(tk0 + i) * NPICK + lane], e1 = SELI[(size_t)(tk0 + i) * NPICK + 64 + lane];
            idxw[i * 128 + lane] = (unsigned short)e0; idxw[i * 128 + 64 + lane] = (unsigned short)e1; dotw[i * 128 + lane] = 0.f; dotw[i * 128 + 64 + lane] = 0.f; }
        asm volatile("" ::: "memory");
        {
            int ev[16]; u32x4 bufA[8], bufB[8], bufC[8], bufD[8]; u32x4 hr0[2], hr1[2]; i32x8 bop;
            { cbytes sl0 = TUP + (size_t)(xg & 3) * NEXP * 128;
              PGU_IDX(ev, 0); PGU_GATHER8(bufA, sl0, ev, 0); PGU_GATHER8(bufB, sl0, ev, 8);
              PGU_IDX(ev, 1); PGU_GATHER8(bufC, sl0, ev, 0); PGU_GATHER8(bufD, sl0, ev, 8); }
            PGU_HB(hr0, 0); PGU_HB(hr1, 1);
#pragma unroll 1
            for (int it = 0; it < 64; it += 2) {
                const int tkn = it & 15, it2 = it + 2 < 63 ? it + 2 : 63, it3 = it + 3 < 63 ? it + 3 : 63;
                cbytes sl2 = TUP + (size_t)((xg + (it2 >> 4)) & 3) * NEXP * 128;
                f32x4 acc4 = {0.f, 0.f, 0.f, 0.f};
                PGU_IDX(ev, it2 & 15); PGU_BOP(bop, hr0);
                PGU_MMA8(bufA, bop, acc4, 0); __builtin_amdgcn_sched_barrier(0);
                PGU_GATHER8(bufA, sl2, ev, 0); __builtin_amdgcn_sched_barrier(0);
                PGU_MMA8(bufB, bop, acc4, 8); __builtin_amdgcn_sched_barrier(0);
                PGU_GATHER8(bufB, sl2, ev, 8); PGU_HB(hr0, it + 2); __builtin_amdgcn_sched_barrier(0);
                PGU_DOTS(acc4, tkn);
                acc4 = (f32x4){0.f, 0.f, 0.f, 0.f};
                PGU_IDX(ev, it3 & 15); PGU_BOP(bop, hr1);
                PGU_MMA8(bufC, bop, acc4, 0); __builtin_amdgcn_sched_barrier(0);
                PGU_GATHER8(bufC, sl2, ev, 0); __builtin_amdgcn_sched_barrier(0);
                PGU_MMA8(bufD, bop, acc4, 8); __builtin_amdgcn_sched_barrier(0);
                PGU_GATHER8(bufD, sl2, ev, 8); PGU_HB(hr1, it + 3); __builtin_amdgcn_sched_barrier(0);
                PGU_DOTS(acc4, tkn + 1);
            }
        }
        asm volatile("" ::: "memory");
        }
#pragma unroll 2
        for (int i = 0; i < 16; ++i) {
            float csum = 0.f;
#pragma unroll
            for (int hh = 0; hh < 2; ++hh) { const int k = 16 * g8 + s8 + 8 * hh; const int e = idxw[i * 128 + k];
                const float w = SELW[(size_t)(tk0 + i) * NPICK + k]; const unsigned sc = SC[e];
                const float cf = w * gelu_tanh(dotw[i * 128 + k] * bf_lo(sc)) * bf_hi(sc); csum += cf;
                const float cl = fminf(fmaxf(cf, -15.0f), 15.0f);
                ((LAS unsigned*)dotw)[i * 128 + k] = __builtin_bit_cast(unsigned, __builtin_amdgcn_cvt_pkrtz(cl * 4096.0f, cl * 256.0f)); }
            csum = wave_sum_all(csum); if (lane == 0) csw[i] = csum; }
        asm volatile("" ::: "memory");
        {
            const int xoffv = 32 * s8 + 16 * (g8 & 1) + 8 * ((g8 >> 1) & 1) + 4 * (g8 >> 2);
            const float* gp = gacc + (size_t)(tk0 >> 12) * 6 * DM + xoffv;
            int ev[16]; u32x4 bufA[8], bufB[8], bufC[8], bufD[8]; unsigned cC[8]; u32x2 x0, x1;
#define PGV_XADDR(IT) (x + (size_t)(tk0 + ((IT) & 15)) * DM + (((xg + ((IT) >> 4)) & 3) * 256) + xoffv)
#define PGV_COEF8(CV, TKN, J0) do { const LAS u32x4* _cp = (const LAS u32x4*)((LAS unsigned*)dotw + (TKN) * 128 + 16 * g8 + (J0)); \
        const u32x4 _c0 = _cp[0], _c1 = _cp[1]; CV[0] = _c0[0]; CV[1] = _c0[1]; CV[2] = _c0[2]; CV[3] = _c0[3]; CV[4] = _c1[0]; CV[5] = _c1[1]; CV[6] = _c1[2]; CV[7] = _c1[3]; } while (0)
#define PGV_COMP8(BUF, CV) do { _Pragma("unroll") for (int j = 0; j < 8; ++j) { const u32x4 _v = BUF[j]; const h16x2 _c = __builtin_bit_cast(h16x2, CV[j]); const h16x2 _cl = {_c.x, _c.x}, _ch = {_c.y, _c.y}; \
            _Pragma("unroll") for (int w = 0; w < 4; ++w) { const unsigned _x = _v[w], _y = _x >> 8; \
                acc[4 * w + 0] = __builtin_elementwise_fma(__builtin_bit_cast(h16x2, _x & 0x000F000Fu), _cl, acc[4 * w + 0]); \
                acc[4 * w + 1] = __builtin_elementwise_fma(__builtin_bit_cast(h16x2, _x & 0x00F000F0u), _ch, acc[4 * w + 1]); \
                acc[4 * w + 2] = __builtin_elementwise_fma(__builtin_bit_cast(h16x2, _y & 0x000F000Fu), _cl, acc[4 * w + 2]); \
                acc[4 * w + 3] = __builtin_elementwise_fma(__builtin_bit_cast(h16x2, _y & 0x00F000F0u), _ch, acc[4 * w + 3]); } } } while (0)
#define PGV_ADD(A, B) (__builtin_bit_cast(unsigned, __builtin_bit_cast(h16x2, (A)) + __builtin_bit_cast(h16x2, (B))))
#define PGV_REDUCE_STORE(XV, IT) do { unsigned k8[8]; \
                _Pragma("unroll") for (int j = 0; j < 8; ++j) { const unsigned lo = __builtin_bit_cast(unsigned, acc[j]), hi = __builtin_bit_cast(unsigned, acc[8 + j]); \
                    const unsigned snd = b3 ? lo : hi, kp = b3 ? hi : lo; k8[j] = PGV_ADD(kp, (unsigned)__builtin_amdgcn_update_dpp(0, (int)snd, 0x128, 0xf, 0xf, false)); } \
                unsigned k4[4]; _Pragma("unroll") for (int j = 0; j < 4; ++j) { const unsigned snd = b4 ? k8[j] : k8[4 + j], kp = b4 ? k8[4 + j] : k8[j]; k4[j] = PGV_ADD(kp, (unsigned)__shfl_xor((int)snd, 16)); } \
                unsigned k2[2]; _Pragma("unroll") for (int j = 0; j < 2; ++j) { const unsigned snd = b5 ? k4[j] : k4[2 + j], kp = b5 ? k4[2 + j] : k4[j]; k2[j] = PGV_ADD(kp, (unsigned)__shfl_xor((int)snd, 32)); } \
                const h16x2 _a = __builtin_bit_cast(h16x2, k2[0]), _b = __builtin_bit_cast(h16x2, k2[1]); const float _off = 7.5f * csw[(IT) & 15]; \
                const f32x4 _o = (f32x4){(float)_a.x, (float)_b.x, (float)_a.y, (float)_b.y} * 4096.0f - _off; \
                const f32x4 _xn = (f32x4){bf_lo(XV.x), bf_hi(XV.x), bf_lo(XV.y), bf_hi(XV.y)} + gate * _o; \
                u32x2 _w; _w.x = cvt_pk_bf16(_xn[0], _xn[1]); _w.y = cvt_pk_bf16(_xn[2], _xn[3]); *(u32x2*)PGV_XADDR(IT) = _w; } while (0)
            { cbytes sl0 = TVP + (size_t)(xg & 3) * NEXP * 128;
              PG_IDX(ev, 0); PG_GATHER8(bufA, sl0, ev, 0); PG_GATHER8(bufB, sl0, ev, 8);
              PG_IDX(ev, 1); PG_GATHER8(bufC, sl0, ev, 0); PG_GATHER8(bufD, sl0, ev, 8); }
            x0 = *(const u32x2*)PGV_XADDR(0); x1 = *(const u32x2*)PGV_XADDR(1);
#pragma unroll 1
            for (int it = 0; it < 64; it += 2) {
                const int it2 = it + 2 < 63 ? it + 2 : 63, it3 = it + 3 < 63 ? it + 3 : 63, sl = (xg + (it >> 4)) & 3;
                cbytes sl2 = TVP + (size_t)((xg + (it2 >> 4)) & 3) * NEXP * 128;
                const f32x4 gate = *(const f32x4*)(gp + sl * 256);
                h16x2 acc[16];
#pragma unroll
                for (int j = 0; j < 16; ++j) acc[j] = (h16x2){(_Float16)0.f, (_Float16)0.f};
                PGV_COEF8(cC, it & 15, 0); PG_IDX(ev, it2 & 15);
                PGV_COMP8(bufA, cC); __builtin_amdgcn_sched_barrier(0);
                PG_GATHER8(bufA, sl2, ev, 0); PGV_COEF8(cC, it & 15, 8); __builtin_amdgcn_sched_barrier(0);
                PGV_COMP8(bufB, cC); __builtin_amdgcn_sched_barrier(0);
                PG_GATHER8(bufB, sl2, ev, 8); __builtin_amdgcn_sched_barrier(0);
                PGV_REDUCE_STORE(x0, it);
                x0 = *(const u32x2*)PGV_XADDR(it2);
#pragma unroll
                for (int j = 0; j < 16; ++j) acc[j] = (h16x2){(_Float16)0.f, (_Float16)0.f};
                PGV_COEF8(cC, (it + 1) & 15, 0); PG_IDX(ev, it3 & 15);
                PGV_COMP8(bufC, cC); __builtin_amdgcn_sched_barrier(0);
                PG_GATHER8(bufC, sl2, ev, 0); PGV_COEF8(cC, (it + 1) & 15, 8); __builtin_amdgcn_sched_barrier(0);
                PGV_COMP8(bufD, cC); __builtin_amdgcn_sched_barrier(0);
                PG_GATHER8(bufD, sl2, ev, 8); __builtin_amdgcn_sched_barrier(0);
                PGV_REDUCE_STORE(x1, it + 1);
                x1 = *(const u32x2*)PGV_XADDR(it3);
            }
#undef PGV_XADDR
#undef PGV_COEF8
#undef PGV_COMP8
#undef PGV_ADD
#undef PGV_REDUCE_STORE
        }
        asm volatile("s_waitcnt vmcnt(0)" ::: "memory");
        {
            const int b = tk0 >> 12;
            f32x4 c1[4], shv[4];
#pragma unroll
            for (int j = 0; j < 4; ++j) { const int col = 4 * lane + 256 * j;
                if (last) { c1[j] = *(const f32x4*)(gn_next + col); shv[j] = (f32x4){0.f, 0.f, 0.f, 0.f}; }
                else { c1[j] = *(const f32x4*)(gn_next + col) * (1.0f + *(const f32x4*)(mod_next + (size_t)b * 6 * DM + DM + col)); shv[j] = *(const f32x4*)(mod_next + (size_t)b * 6 * DM + col); } }
#pragma unroll 1
            for (int i0 = 0; i0 < 16; i0 += 4) {
                f32x4 v[4][4]; float ss[4];
#pragma unroll
                for (int rr = 0; rr < 4; ++rr) { const u32x2* xr = (const u32x2*)(x + (size_t)(tk0 + i0 + rr) * DM) + lane;
#pragma unroll
                    for (int j = 0; j < 4; ++j) { const u32x2 xv = xr[64 * j]; v[rr][j] = (f32x4){bf_lo(xv.x), bf_hi(xv.x), bf_lo(xv.y), bf_hi(xv.y)}; } }
#pragma unroll
                for (int rr = 0; rr < 4; ++rr) { float q = 0.f;
#pragma unroll
                    for (int j = 0; j < 4; ++j) q += (v[rr][j][0] * v[rr][j][0] + v[rr][j][1] * v[rr][j][1]) + (v[rr][j][2] * v[rr][j][2] + v[rr][j][3] * v[rr][j][3]);
                    ss[rr] = q; }
#pragma unroll
                for (int o = 1; o < 64; o <<= 1) {
#pragma unroll
                    for (int rr = 0; rr < 4; ++rr) ss[rr] += __shfl_xor(ss[rr], o); }
#pragma unroll
                for (int rr = 0; rr < 4; ++rr) { const int r = tk0 + i0 + rr; const float rstd = __builtin_amdgcn_rsqf(ss[rr] * (1.0f / DM) + EPS);
                    if (last) { f32x4* xr = (f32x4*)(outf + (size_t)r * DM) + lane;
#pragma unroll
                        for (int j = 0; j < 4; ++j) xr[64 * j] = v[rr][j] * rstd * c1[j]; }
                    else { u32x2* o8 = (u32x2*)(Hout + (size_t)r * DM) + lane;
#pragma unroll
                        for (int j = 0; j < 4; ++j) { const f32x4 o = v[rr][j] * rstd * c1[j] + shv[j]; u32x2 w; w.x = cvt_pk_bf16(o[0], o[1]); w.y = cvt_pk_bf16(o[2], o[3]); o8[64 * j] = w; } } }
            }
        }
    }
}
#undef PG_IDX
#undef PG_GATHER8
#undef PGU_IDX
#undef PGU_GATHER8
#undef PGU_HB
#undef PGU_CVT8
#undef PGU_BOP
#undef PGU_MMA8
#undef PGU_DOTS
#undef PG_VCOMP8
#undef PG_COEF
#undef PG_COEF8
#undef PG_XADDR
#undef PG_XOFFS
#undef PG_XLOAD

constexpr size_t WS_BAR = 768 * 1024;
#define XB_TMO      128
#define XB_XCNT(j)  (256  + 64 * (j))
#define XB_XSUB(j)  (1280 + 64 * (j))
#define XB_XGEN(j)  (2304 + 64 * (j))
#define XB_TOP      3328
#define XB_TOPGEN   3392
#define XCD_BAR_WORDS 3456
#define XB_SPIN_CAP (1u << 22)
__device__ __forceinline__ unsigned xb_ld(unsigned* p)              { return __hip_atomic_load(p, __ATOMIC_RELAXED, __HIP_MEMORY_SCOPE_AGENT); }
__device__ __forceinline__ unsigned xb_add(unsigned* p, unsigned v) { return __hip_atomic_fetch_add(p, v, __ATOMIC_RELAXED, __HIP_MEMORY_SCOPE_AGENT); }
__device__ __forceinline__ unsigned xb_xcc_id() { return (unsigned)__builtin_amdgcn_s_getreg((3 << 11) | 20) & 0xFu; }
#define XB_SPIN(cond, bar) do { unsigned _sp = 0; while (cond) { __builtin_amdgcn_s_sleep(1); \
    if ((++_sp & 255u) == 0u) { if (xb_ld(&(bar)[XB_TMO])) break; if (_sp > XB_SPIN_CAP) { atomicAdd(&(bar)[XB_TMO], 1u); break; } } } } while (0)
struct XcdBarrier { unsigned* bar; unsigned x; volatile LAS unsigned* st; };
__device__ __forceinline__ void xcd_barrier_complete(unsigned* bar, unsigned x, unsigned& nloc, unsigned& nx) {
    const unsigned G = gridDim.x * gridDim.y * gridDim.z;
    unsigned sum, cnt, mine, sp = 0u;
    for (;;) {
        sum = 0u; cnt = 0u; mine = 0u;
#pragma unroll
        for (unsigned j = 0; j < 16; ++j) { const unsigned c = xb_ld(&bar[XB_XCNT(j)]); sum += c; cnt += (c > 0u) ? 1u : 0u; mine = (j == x) ? c : mine; }
        if (sum == G) break;
        __builtin_amdgcn_s_sleep(1);
        if ((++sp & 255u) == 0u) { if (xb_ld(&bar[XB_TMO])) break; if (sp > XB_SPIN_CAP) { atomicAdd(&bar[XB_TMO], 1u); break; } }
    }
    nloc = mine > 0u ? mine : 1u; nx = cnt > 0u ? cnt : 1u;
}
__device__ __forceinline__ void xcd_barrier(const XcdBarrier& b) {
    asm volatile("s_waitcnt vmcnt(0)" ::: "memory");
    __syncthreads();
    if (threadIdx.x == 0) {
        unsigned* bar = b.bar;
        __builtin_amdgcn_s_waitcnt(0);
        unsigned nloc = b.st[0], nx = b.st[1];
        if (nloc == 0u) { xcd_barrier_complete(bar, b.x, nloc, nx); b.st[0] = nloc; b.st[1] = nx; }
        const unsigned old = xb_add(&bar[XB_XSUB(b.x)], 1u);
        const unsigned gen = old / nloc;
        if (old + 1u == (gen + 1u) * nloc) {
            __builtin_amdgcn_fence(__ATOMIC_RELEASE, "agent");
            asm volatile("s_waitcnt vmcnt(0)" ::: "memory");
            const unsigned og = xb_add(&bar[XB_TOP], 1u);
            const unsigned tg = og / nx;
            if (og + 1u == (tg + 1u) * nx) xb_add(&bar[XB_TOPGEN], 1u);
            else XB_SPIN(xb_ld(&bar[XB_TOPGEN]) == tg, bar);
            __builtin_amdgcn_fence(__ATOMIC_ACQUIRE, "agent");
            xb_add(&bar[XB_XGEN(b.x)], 1u);
            asm volatile("s_waitcnt vmcnt(0)" ::: "memory");
        } else {
            XB_SPIN(xb_ld(&bar[XB_XGEN(b.x)]) == gen, bar);
            __builtin_amdgcn_fence(__ATOMIC_ACQUIRE, "agent");
            asm volatile("s_waitcnt vmcnt(0)" ::: "memory");
        }
    }
    __syncthreads();
}

constexpr int NPHASES = 27;
#ifndef PH_MASK
#define PH_MASK 0xFFFFFF
#endif
#ifndef DUP_MASK
#define DUP_MASK 0
#endif
#ifndef TIME_MASK
#define TIME_MASK 0
#endif
__device__ __forceinline__ int opaque_s(int x) { asm volatile("" : "+s"(x)); return x; }
#define PHM(bit, call) do { if constexpr ((PH_MASK & (bit)) != 0) { if constexpr ((DUP_MASK & (bit)) != 0) { const int _nrep = opaque_s(2); for (int _rep = 0; _rep < _nrep; ++_rep) { call; __syncthreads(); } } else { call; } } } while (0)
__global__ void __launch_bounds__(NTHREADS, 2) trunk_fwd(Args A) {
    extern __shared__ __attribute__((aligned(16))) unsigned char lds_raw[];
    LAS unsigned char* lds = (LAS unsigned char*)lds_raw;
    const int tid0 = threadIdx.x, wid = __builtin_amdgcn_readfirstlane(tid0 >> 6);
    const int G = gridDim.x, bx = blockIdx.x, vcu = (G % 8 == 0) ? (bx % 8) * (G / 8) + bx / 8 : bx;
    const int gw = vcu * 8 + wid, NGW = G * 8;
    const int ph_lo = A.ph_lo, ph_hi = A.ph_hi;
    unsigned long long t_acc = 0;
#if MK_ONE_LAUNCH
    if (tid0 < 2) ((volatile LAS unsigned*)(lds + LDS_XB_OFF))[tid0] = 0u;
    if (bx == 0) { unsigned* b0 = (unsigned*)(A.ws + WS_BAR); for (int i = tid0; i < XCD_BAR_WORDS; i += NTHREADS) b0[i] = 0u; }
#endif

    for (int ph = ph_lo; ph < ph_hi; ++ph) {
        const int tid = opaque(tid0), lane = tid & 63;
        ArgP Ap = (ArgP)__builtin_amdgcn_kernarg_segment_ptr();
        asm volatile("" : "+s"(Ap));
        unsigned char* ws = Ap->ws;
        bf16_t* Hb = (bf16_t*)(ws + WS_H);
        unsigned char* mixb = ws + WS_MIX;
        const float* mod = (const float*)(ws + WS_MOD);
        float* xo = Ap->out;
        int layer, step;
        if (ph < 2) { layer = -1; step = ph; }
        else if (ph < 9) { layer = 0; step = ph - 2; }
        else if (ph < 15) { layer = 1; step = ph - 9 + 1; }
        else if (ph < 21) { layer = 2; step = ph - 15 + 1; }
        else { layer = 3; step = ph - 21 + 1; }
        const int kind = layer % 3, jl = layer / 3;
        unsigned long long t_ph0 = 0; if constexpr (TIME_MASK != 0) t_ph0 = __builtin_amdgcn_s_memrealtime();
        const int nmix = 4;
        int ptype = 0;
        if (layer < 0) ptype = 1; else if (layer > 3) ptype = 2048; else if (step == 0 || step == nmix) ptype = 2;
        else if (step < nmix) ptype = (step == 1) ? 4 : (step == nmix - 1) ? 32 : (kind == 0 && step == 3) ? 16 : 8;
        else ptype = 64 << (step - nmix - 1);
        const float* macc = mod + (size_t)(layer < 0 ? 0 : (layer > 3 ? 3 : layer)) * BATCH * 6 * DM;
        const float* mbias = Ap->in[I_ADA_B] + (size_t)(layer < 0 ? 0 : (layer > 3 ? 3 : layer)) * 6 * DM;
        const float* xin = (layer == 0) ? Ap->in[I_X] : xo;

        if (layer < 0) {
            if (step == 0) { PHM(1, prologue_phase(Ap, lds, vcu, G, tid, wid, lane)); }
            else { PHM(1, modreduce_phase(Ap, vcu, G, tid));
#pragma unroll 1
                for (int pl = 0; pl < 2; ++pl) { pg8::StaticOrder S; pg8::Gemm g{(const bf16_t*)(ws + WS_POOL_WOUT) + (size_t)pl * DM * DM, (const bf16_t*)(ws + WS_WGS) + (size_t)pl * 4 * 65536, DM, DM, 256, DM, 256, 256}; S.init(DM, DM, G, bx);
                    pg8::EpiBf16<0> E{(bf16_t*)(ws + WS_WEFF) + (size_t)pl * DM * DM, DM}; PHM(0x2000, pg8::gemm_phase(lds, g, S, E)); } }
        } else if (layer > 3) {
            PHM(256, final_phase(xo, Ap->in[I_FINAL_G], gw, NGW, lane));
        } else if (step == 0) {
            PHM(2, norm_phase(xin, Ap->in[I_NORM_G] + (size_t)(layer * 2 + 0) * DM, macc, mbias, 0, DM, Hb, gw, NGW, lane));
        } else if (step < nmix) {
            pg8::StaticOrder S;
            if (kind == 0) {
                bf16_t* U = (bf16_t*)mixb; bf16_t* P = (bf16_t*)(mixb + 64 * MiB); bf16_t* Z = (bf16_t*)(mixb + 128 * MiB);
                if (step == 1) { pg8::Gemm g{Hb, (const bf16_t*)(ws + WS_POOL_WIN) + (size_t)jl * DM * DM, MTOK, DM, DM, DM, DM, 0}; S.init(MTOK, DM, G, bx);
                    pg8::EpiBf16<0> E{U, DM}; PHM(0x1000, pg8::gemm_phase(lds, g, S, E)); }
                else if (step == 2) { PHM(8, pool_elem_phase(U, P, vcu, G, tid)); }
                else { pg8::Gemm g{P, (const bf16_t*)(ws + WS_WEFF) + (size_t)jl * DM * DM, MTOK, DM, DM, DM, DM, 0}; S.init(MTOK, DM, G, bx);
                    pg8::EpiBf16<0> E{(bf16_t*)(mixb + 192 * MiB), DM}; PHM(0x8000, pg8::gemm_phase(lds, g, S, E));   }
            } else if (kind == 1) {
                bf16_t* BG = (bf16_t*)mixb; bf16_t* Z = (bf16_t*)(mixb + 64 * MiB); bf16_t* AA = (bf16_t*)(mixb + 128 * MiB);
                if (step == 1) { pg8::Gemm g{Hb, (const bf16_t*)(ws + WS_CONV_WIN), MTOK, 3 * DM, DM, DM, DM, 0}; S.init(MTOK, 3 * DM, G, bx);
                    pg8::EpiConvIn E{BG, Z}; PHM(0x4000, pg8::gemm_phase(lds, g, S, E)); }
                else if (step == 2) { PHM(16, conv_elem_phase(BG, Z, Ap->in[I_CONV_W], AA, vcu, G, tid)); }
                else { pg8::Gemm g{AA, (const bf16_t*)(ws + WS_CONV_WOUT), MTOK, DM, DM, DM, DM, 0}; S.init(MTOK, DM, G, bx);
                    pg8::EpiBf16<0> E{(bf16_t*)(mixb + 192 * MiB), DM}; PHM(0x8000, pg8::gemm_phase(lds, g, S, E));   }
            } else {
                bf16_t* UA = (bf16_t*)mixb; bf16_t* VT = (bf16_t*)(mixb + 192 * MiB);
                if (step == 1) {
                    { pg8::Gemm g{Hb, (const bf16_t*)(ws + WS_GMLP_WIN), MTOK, GH, DM, DM, DM, 0}; S.init(MTOK, GH, G, bx);
                      pg8::EpiBf16<1> E{UA, GH}; PHM(0x1000, pg8::gemm_phase(lds, g, S, E)); }
                    { pg8::Gemm g{Hb, (const bf16_t*)(ws + WS_GMLP_WIN) + (size_t)GH * DM, MTOK, GH, DM, DM, DM, 0}; S.init(MTOK, GH, G, bx);
                      pg8::EpiGmlpV E{VT}; PHM(0x10000, pg8::gemm_phase(lds, g, S, E)); }
                }
                else if (step == 2) { PHM(32, mix_phase(lds, UA, VT, Ap->in[I_GMLP_WS], Ap->in[I_GMLP_BS], Ap->in[I_GMLP_LNG], Ap->in[I_GMLP_LNB], vcu, G, tid, wid, lane)); }
                else { pg8::Gemm g{UA, (const bf16_t*)(ws + WS_GMLP_WOUT), MTOK, DM, GH, GH, GH, 0}; S.init(MTOK, DM, G, bx);
                    pg8::EpiBf16<0> E{(bf16_t*)(mixb + 192 * MiB), DM}; PHM(0x8000, pg8::gemm_phase(lds, g, S, E));   }
            }
        } else {
            const int ps = step - nmix;
            bf16_t* Qb = (bf16_t*)mixb;
            bf16_t* xs = (layer == 3) ? (bf16_t*)(mixb + 192 * MiB) : (bf16_t*)xo;
            if (ps == 0) { resnorm_phase(layer == 0 ? Ap->in[I_X] : nullptr, (const bf16_t*)xo, xs, (const bf16_t*)(mixb + 192 * MiB), macc + 2 * DM, Ap->in[I_NORM_G] + (size_t)(layer * 2 + 1) * DM, macc, 3 * DM, 4 * DM, Hb, gw, NGW, lane); }
            else if (ps == 1) { pg8::StaticOrder S; pg8::Gemm g{Hb, (const bf16_t*)(ws + WS_PEER_WQ) + (size_t)layer * DM * 2048, MTOK, 2048, DM, DM, DM, 0}; S.init(MTOK, 2048, G, bx);
                pg8::EpiQT E{Qb}; PHM(0x1000, pg8::gemm_phase(lds, g, S, E));
                asm volatile("s_waitcnt vmcnt(0)" ::: "memory"); __syncthreads();
                PHM(64, topk_units(lds, Qb, (const bf16_t*)(ws + WS_KEYS) + (size_t)layer * 16 * 128 * 128, (int*)(ws + WS_SELI), (float*)(ws + WS_SELW), S, tid, wid, lane)); }
            else { PHM(128, peer_gather_phase(lds, Hb, (cbytes)(ws + WS_TABU) + (size_t)layer * NEXP * (DM / 2), (cbytes)(ws + WS_TABV) + (size_t)layer * NEXP * (DM / 2), (const int*)(ws + WS_SELI), (const float*)(ws + WS_SELW),
                              (const unsigned*)(ws + WS_SCU) + (size_t)layer * NEXP, xs, xo, macc + 5 * DM,
                              layer == 3 ? Ap->in[I_FINAL_G] : Ap->in[I_NORM_G] + (size_t)((layer + 1) * 2) * DM, mod + (size_t)(layer == 3 ? 3 : layer + 1) * BATCH * 6 * DM, Hb, layer == 3, vcu, G, wid, lane)); }
        }
#if MK_ONE_LAUNCH
        if constexpr (TIME_MASK != 0) if (ph + 1 >= ph_hi) { if (ptype & TIME_MASK) t_acc += __builtin_amdgcn_s_memrealtime() - t_ph0; }
        if (ph + 1 < ph_hi) {
            XcdBarrier xbar; xbar.bar = (unsigned*)(Ap->ws + WS_BAR); xbar.x = xb_xcc_id(); xbar.st = (volatile LAS unsigned*)(lds + LDS_XB_OFF);
            if (ph == ph_lo) { cg::this_grid().sync(); if (tid0 == 0) (void)xb_add(&xbar.bar[XB_XCNT(xbar.x)], 1u); }
            else { xcd_barrier(xbar); if constexpr ((DUP_MASK & 0x800) != 0) xcd_barrier(xbar); }
            if constexpr (TIME_MASK != 0) { if (ptype & TIME_MASK) t_acc += __builtin_amdgcn_s_memrealtime() - t_ph0; }
        }
#endif
    }
    if constexpr (TIME_MASK != 0) { const unsigned long long t0 = __builtin_amdgcn_s_memrealtime(); while (__builtin_amdgcn_s_memrealtime() - t0 < 4ull * t_acc) __builtin_amdgcn_s_sleep(8); }
}

extern "C" void kernel_launch(void* const* d_in, const int* in_sizes, int n_in, void* d_out, int out_size, void* d_ws, size_t ws_size, hipStream_t stream) {
    static int grid = 0;
    if (grid == 0) {
        if (n_in != 23 || in_sizes[0] != MTOK * DM || out_size != MTOK * DM || ws_size < WS_END) {
            fprintf(stderr, "kernel_launch: unexpected shapes (n_in %d, in0 %d, out %d, ws %zu; need ws >= %zu); nothing launched\n", n_in, n_in > 0 ? in_sizes[0] : -1, out_size, ws_size, (size_t)WS_END); grid = -1; return; }
        int dev = 0, cus = 0, per_cu = 0;
        if (hipGetDevice(&dev) != hipSuccess || hipDeviceGetAttribute(&cus, hipDeviceAttributeMultiprocessorCount, dev) != hipSuccess) { grid = -1; return; }
        if (hipFuncSetAttribute((const void*)trunk_fwd, hipFuncAttributeMaxDynamicSharedMemorySize, LDS_BYTES) != hipSuccess) { fprintf(stderr, "kernel_launch: hipFuncSetAttribute failed\n"); grid = -1; return; }
        if (hipOccupancyMaxActiveBlocksPerMultiprocessor(&per_cu, (const void*)trunk_fwd, NTHREADS, LDS_BYTES) != hipSuccess || per_cu < 1) { fprintf(stderr, "kernel_launch: occupancy query says %d blocks per CU\n", per_cu); (void)hipGetLastError(); grid = -1; return; }
        grid = cus * (per_cu < 1 ? 1 : 1);
    }
    if (grid < 0) return;
    Args a{};
    for (int i = 0; i < 23; ++i) a.in[i] = (const float*)d_in[i];
    a.out = (float*)d_out; a.ws = (unsigned char*)d_ws;
#if MK_ONE_LAUNCH
    a.ph_lo = 0; a.ph_hi = NPHASES;
    void* args[] = {&a};
    hipError_t e = hipLaunchCooperativeKernel((const void*)trunk_fwd, dim3(grid), dim3(NTHREADS), args, LDS_BYTES, stream);
    if (e != hipSuccess) fprintf(stderr, "cooperative launch failed: %s (grid %d)\n", hipGetErrorString(e), grid);
#else
    for (int ph = 0; ph < NPHASES; ++ph) { a.ph_lo = ph; a.ph_hi = ph + 1; hipLaunchKernelGGL(trunk_fwd, dim3(grid), dim3(NTHREADS), LDS_BYTES, stream, a); }
#endif
}
```

```cpp
#include <hip/hip_runtime.h>
#include <hip/hip_cooperative_groups.h>
#include <cstdio>
#include <cstdint>
namespace cg = cooperative_groups;

#ifndef MK_ONE_LAUNCH
#define MK_ONE_LAUNCH 1
#endif

#define LAS __attribute__((address_space(3)))
typedef unsigned short bf16_t;
typedef short bf16x8 __attribute__((ext_vector_type(8)));
typedef float f32x2 __attribute__((ext_vector_type(2)));
typedef float f32x4 __attribute__((ext_vector_type(4)));
typedef float f32x16 __attribute__((ext_vector_type(16)));
typedef unsigned u32x2 __attribute__((ext_vector_type(2)));
typedef unsigned u32x4 __attribute__((ext_vector_type(4)));
typedef int i32x4 __attribute__((ext_vector_type(4)));
typedef int i32x8 __attribute__((ext_vector_type(8)));
typedef _Float16 h16x2 __attribute__((ext_vector_type(2)));
typedef __bf16 bf16x2 __attribute__((ext_vector_type(2)));

constexpr int DM = 1024, BATCH = 8, SEQ = 4096, MTOK = BATCH * SEQ, DEPTH = 4;
constexpr int GH = 3072;
constexpr int NEXP = 16384, NPICK = 128;
constexpr float EPS = 1e-6f;

constexpr size_t MiB = 1u << 20;
constexpr size_t WS_CTL = 0, WS_SCU = 0, WS_SCV = 512 * 1024, WS_MOD = 1 * MiB, ZERO_BYTES = 2 * MiB;
constexpr size_t WS_POOL_WIN = 2 * MiB, WS_POOL_WGRP = 6 * MiB, WS_POOL_WOUT = 7 * MiB;
constexpr size_t WS_CONV_WIN = 11 * MiB, WS_CONV_WOUT = 17 * MiB;
constexpr size_t WS_GMLP_WIN = 19 * MiB, WS_GMLP_WOUT = 31 * MiB;
constexpr size_t WS_PEER_WQ = 37 * MiB, WS_KEYS = 53 * MiB;
constexpr size_t WS_H = 56 * MiB;
constexpr size_t WS_SELI = 120 * MiB, WS_SELW = 136 * MiB;
constexpr size_t WS_TABU = 152 * MiB, WS_TABV = 280 * MiB;
constexpr size_t WS_MIX = 408 * MiB;
constexpr size_t WS_ADAP = 792 * MiB;
constexpr size_t WS_COEF = 804 * MiB;
constexpr size_t WS_WEFF = 820 * MiB;
constexpr size_t WS_WGS = 824 * MiB;
constexpr size_t WS_END = 825 * MiB;

__device__ __forceinline__ unsigned cvt_pk_bf16(float lo, float hi) { unsigned r; asm volatile("v_cvt_pk_bf16_f32 %0, %1, %2" : "=v"(r) : "v"(lo), "v"(hi)); return r; }
__device__ __forceinline__ int opaque(int x) { asm volatile("" : "+v"(x)); return x; }
__device__ __forceinline__ float bf_lo(unsigned w) { return __uint_as_float(w << 16); }
__device__ __forceinline__ float bf_hi(unsigned w) { return __uint_as_float(w & 0xffff0000u); }
__device__ __forceinline__ float gelu_tanh(float x) {
    const float y = x * (1.0f + 0.044715f * x * x);
    const float e = __builtin_amdgcn_exp2f(-2.302208198f * y);
    return x * __builtin_amdgcn_rcpf(1.0f + e);
}
__device__ __forceinline__ float wave_sum_all(float v) {
#pragma unroll
    for (int o = 1; o < 64; o <<= 1) v += __shfl_xor(v, o);
    return v;
}
__device__ __forceinline__ float dot2_bf16(unsigned w, unsigned x, float acc) { return __builtin_amdgcn_fdot2_f32_bf16(__builtin_bit_cast(bf16x2, w), __builtin_bit_cast(bf16x2, x), acc, false); }


__device__ __forceinline__ float dpp_row_shr(float v, int n) {
    const int iv = __builtin_bit_cast(int, v); int r;
    switch (n) { case 1: r = __builtin_amdgcn_update_dpp(0, iv, 0x111, 0xf, 0xf, true); break; case 2: r = __builtin_amdgcn_update_dpp(0, iv, 0x112, 0xf, 0xf, true); break;
                 case 4: r = __builtin_amdgcn_update_dpp(0, iv, 0x114, 0xf, 0xf, true); break; default: r = __builtin_amdgcn_update_dpp(0, iv, 0x118, 0xf, 0xf, true); break; }
    return __builtin_bit_cast(float, r);
}
__device__ __forceinline__ float wave_sum_uniform(float v) {
    v += dpp_row_shr(v, 1); v += dpp_row_shr(v, 2); v += dpp_row_shr(v, 4); v += dpp_row_shr(v, 8);
    v += __builtin_bit_cast(float, __builtin_amdgcn_update_dpp(0, __builtin_bit_cast(int, v), 0x142, 0xa, 0xf, false));
    v += __builtin_bit_cast(float, __builtin_amdgcn_update_dpp(0, __builtin_bit_cast(int, v), 0x143, 0xc, 0xf, false));
    return __uint_as_float(__builtin_amdgcn_readlane(__float_as_uint(v), 63));
}

namespace pg8 {
constexpr int BM = 256, BK = 64, HALF = 128, HTB = HALF * BK * 2, STAGE_BYTES = 8 * HTB, NXCD = 8, WGM = 8;
__device__ __forceinline__ int lds_byte(int r, int c) { const int st = (r >> 4) * 2 + (c >> 5), rr = r & 15, cc = c & 31, ob = rr * 64 + cc * 2; return st * 1024 + (ob ^ (((ob >> 9) & 1) << 5)); }
__device__ __forceinline__ void stage_rc(int b, int& R, int& C) { const int st = b / 1024, sb = b % 1024, swz = sb ^ (((sb >> 9) & 1) << 5); R = (st >> 1) * 16 + swz / 64; C = (st & 1) * 32 + (swz % 64) / 2; }
__device__ __forceinline__ int perm32(int rho) { const int n = rho >> 4, i = rho & 15; return 8 * (i >> 2) + 4 * n + (i & 3); }

struct Unit { int pm, pn; };
struct Gemm { const bf16_t* A; const bf16_t* Bt; int M, N, K, lda, ldb, a_pn_off; };

struct StaticOrder {
    int nM, nN, nwg, G, c;
    __device__ __forceinline__ void init(int M, int N, int G_, int c_) { nM = M / BM; nN = N / BM; nwg = nM * nN; G = G_; c = c_; }
    __device__ __forceinline__ bool next(int i, Unit& u) const {
        const int L = i * G + c; if (L >= nwg) return false;
        int wgid = L; { const int q = nwg / NXCD, r = nwg % NXCD, xcd = wgid % NXCD, off = wgid / NXCD; wgid = (xcd < r ? xcd * (q + 1) : r * (q + 1) + (xcd - r) * q) + off; }
        const int nig = WGM * nN, gid = wgid / nig, fm = gid * WGM, gsz = (nM - fm) < WGM ? (nM - fm) : WGM;
        u.pm = fm + ((wgid % nig) % gsz); u.pn = (wgid % nig) / gsz; return true;
    }
};

template <class Epi>
__device__ __forceinline__ void gemm_phase(LAS unsigned char* lds, const Gemm g, const StaticOrder& S, const Epi& E) {
    const int tid = opaque((int)threadIdx.x), wid = __builtin_amdgcn_readfirstlane(tid >> 6), lane = tid & 63, wr = wid >> 2, wc = wid & 3, fr = lane & 15, fq = lane >> 4;
    int nt = g.K / BK; asm volatile("" : "+s"(nt));
    unsigned voffA[2], voffB[2];
#pragma unroll
    for (int i = 0; i < 2; ++i) { int R, C; stage_rc(tid * 16 + i * 8192, R, C); const int Rb = Epi::PERM ? ((R & ~31) + perm32(R & 31)) : R;
        voffA[i] = (unsigned)(R * g.lda + C) * 2u; voffB[i] = (unsigned)(Rb * g.ldb + C) * 2u; }
    const size_t kstep = (size_t)(BK * 2);
    const size_t hstepA = (size_t)HALF * g.lda * 2, hstepB = (size_t)HALF * g.ldb * 2;
    const size_t tstepA = 2 * hstepA, tstepB = 2 * hstepB;
    const unsigned ldsw = (unsigned)wid * 1024u;
    const int aoff = lds_byte(wr * 64 + fr, fq * 8), boff = lds_byte(wc * 32 + fr, fq * 8);
#define PG8_SA(b, h) (((b) * 2 + (h)) * HTB)
#define PG8_SB(b, h) ((4 + (b) * 2 + (h)) * HTB)
#define PG8_STAGE(bufoff, gbase, voff) do { _Pragma("unroll") for (int _i = 0; _i < 2; ++_i) \
        __builtin_amdgcn_global_load_lds((const unsigned*)((const char*)(gbase) + (voff)[_i]), (LAS unsigned*)(lds + (bufoff) + ldsw + _i * 8192), 16, 0, 0); } while (0)
#define PG8_LDA(dst, b, h) do { _Pragma("unroll") for (int m = 0; m < 4; ++m) _Pragma("unroll") for (int k = 0; k < 2; ++k) dst[m][k] = *(const LAS bf16x8*)(lds + PG8_SA(b, h) + aoff + m * 2048 + k * 1024); } while (0)
#define PG8_LDB(dst, b, h) do { _Pragma("unroll") for (int n = 0; n < 2; ++n) _Pragma("unroll") for (int k = 0; k < 2; ++k) dst[n][k] = *(const LAS bf16x8*)(lds + PG8_SB(b, h) + boff + n * 2048 + k * 1024); } while (0)
#define PG8_MMA(ai, bj, At, Bt) do { __builtin_amdgcn_s_setprio(1); _Pragma("unroll") for (int m = 0; m < 4; ++m) _Pragma("unroll") for (int n = 0; n < 2; ++n) _Pragma("unroll") for (int k = 0; k < 2; ++k) \
        acc[ai][bj][m][n] = Epi::SWAP ? __builtin_amdgcn_mfma_f32_16x16x32_bf16(At[m][k], Bt[n][k], acc[ai][bj][m][n], 0, 0, 0) \
                                      : __builtin_amdgcn_mfma_f32_16x16x32_bf16(Bt[n][k], At[m][k], acc[ai][bj][m][n], 0, 0, 0); __builtin_amdgcn_s_setprio(0); } while (0)
#define PG8_WAIT_V(n) asm volatile("s_waitcnt vmcnt(" #n ")" ::: "memory")
#define PG8_WAIT_L(n) asm volatile("s_waitcnt lgkmcnt(" #n ")" ::: "memory")
#define PG8_BAR __builtin_amdgcn_s_barrier()
#define PG8_SCHED __builtin_amdgcn_sched_barrier(0)
    Unit cur, nxt; int ui = 0;
    if (!S.next(0, cur)) return;
    f32x4 acc[2][2][4][2];
#pragma unroll
    for (int a = 0; a < 2; ++a)
#pragma unroll
        for (int b = 0; b < 2; ++b)
#pragma unroll
            for (int m = 0; m < 4; ++m)
#pragma unroll
                for (int n = 0; n < 2; ++n) acc[a][b][m][n] = (f32x4){0.f, 0.f, 0.f, 0.f};
    bf16x8 At[4][2], B0[2][2], B1[2][2];
    const char* cA = (const char*)g.A + (size_t)cur.pm * tstepA + (size_t)cur.pn * g.a_pn_off * 2; const char* cB = (const char*)g.Bt + (size_t)cur.pn * tstepB;
    PG8_STAGE(PG8_SB(0, 0), cB, voffB); PG8_STAGE(PG8_SB(0, 1), cB + hstepB, voffB); PG8_STAGE(PG8_SA(0, 0), cA, voffA); PG8_STAGE(PG8_SA(0, 1), cA + hstepA, voffA);
    if (wr == 1) PG8_BAR;
    PG8_WAIT_V(2); PG8_BAR;
    PG8_STAGE(PG8_SB(1, 0), cB + kstep, voffB); PG8_STAGE(PG8_SA(1, 0), cA + kstep, voffA); PG8_STAGE(PG8_SB(1, 1), cB + hstepB + kstep, voffB);
    PG8_WAIT_V(6); PG8_BAR;
    for (;;) {
        const bool has_next = S.next(ui + 1, nxt);
        const char* nA = has_next ? (const char*)g.A + (size_t)nxt.pm * tstepA + (size_t)nxt.pn * g.a_pn_off * 2 : cA; const char* nB = has_next ? (const char*)g.Bt + (size_t)nxt.pn * tstepB : cB;
        for (int t = 0; t < nt; t += 2) {
            const bool last = (t == nt - 2);
            const char* a1 = cA + (size_t)(t + 1) * kstep;
            const char* a2 = last ? nA : cA + (size_t)(t + 2) * kstep; const char* b2 = last ? nB : cB + (size_t)(t + 2) * kstep;
            const char* a3 = a2 + kstep; const char* b3 = b2 + kstep;
            PG8_LDB(B0, 0, 0); PG8_LDB(B1, 0, 1); PG8_SCHED; PG8_LDA(At, 0, 0); PG8_STAGE(PG8_SA(1, 1), a1 + hstepA, voffA);
            PG8_WAIT_V(8); PG8_WAIT_L(0); PG8_BAR; PG8_MMA(0, 0, At, B0); PG8_MMA(0, 1, At, B1); PG8_BAR; PG8_SCHED;
            PG8_LDA(At, 0, 1); PG8_STAGE(PG8_SB(0, 0), b2, voffB); PG8_STAGE(PG8_SB(0, 1), b2 + hstepB, voffB); PG8_STAGE(PG8_SA(0, 0), a2, voffA);
            PG8_WAIT_V(8); PG8_WAIT_L(0); PG8_BAR; PG8_MMA(1, 0, At, B0); PG8_MMA(1, 1, At, B1); PG8_BAR; PG8_SCHED;
            PG8_LDB(B0, 1, 0); PG8_LDB(B1, 1, 1); PG8_SCHED; PG8_LDA(At, 1, 0); PG8_STAGE(PG8_SA(0, 1), a2 + hstepA, voffA);
            PG8_WAIT_V(8); PG8_WAIT_L(0); PG8_BAR; PG8_MMA(0, 0, At, B0); PG8_MMA(0, 1, At, B1); PG8_BAR; PG8_SCHED;
            PG8_LDA(At, 1, 1); PG8_STAGE(PG8_SB(1, 0), b3, voffB); PG8_STAGE(PG8_SB(1, 1), b3 + hstepB, voffB); PG8_STAGE(PG8_SA(1, 0), a3, voffA);
            PG8_WAIT_V(8); PG8_WAIT_L(0); PG8_BAR; PG8_MMA(1, 0, At, B0); PG8_MMA(1, 1, At, B1); PG8_BAR; PG8_SCHED;
        }
        { const int l2 = opaque((int)threadIdx.x) & 63; E(acc, cur, wr, wc, l2 & 15, l2 >> 4); }
        if (!has_next) break;
#pragma unroll
        for (int a = 0; a < 2; ++a)
#pragma unroll
            for (int b = 0; b < 2; ++b)
#pragma unroll
                for (int m = 0; m < 4; ++m)
#pragma unroll
                    for (int n = 0; n < 2; ++n) acc[a][b][m][n] = (f32x4){0.f, 0.f, 0.f, 0.f};
        cur = nxt; cA = nA; cB = nB; ++ui;
    }
    PG8_WAIT_V(0);
    if (wr == 0) PG8_BAR;
    PG8_BAR;
#undef PG8_SA
#undef PG8_SB
#undef PG8_STAGE
#undef PG8_LDA
#undef PG8_LDB
#undef PG8_MMA
#undef PG8_WAIT_V
#undef PG8_WAIT_L
#undef PG8_BAR
#undef PG8_SCHED
}

template <int ACT> struct EpiBf16 {
    static constexpr bool PERM = true, SWAP = false;
    bf16_t* O; int ldc;
    __device__ __forceinline__ void operator()(const f32x4 (&acc)[2][2][4][2], const Unit& u, int wr, int wc, int fr, int fq) const {
        const int row0 = u.pm * BM + wr * 64 + fr, col0 = u.pn * BM + wc * 32 + 8 * fq;
#pragma unroll
        for (int ai = 0; ai < 2; ++ai)
#pragma unroll
            for (int m = 0; m < 4; ++m) { bf16_t* rowp = O + (size_t)(row0 + ai * HALF + m * 16) * ldc + col0;
#pragma unroll
                for (int bj = 0; bj < 2; ++bj) { f32x4 v0 = acc[ai][bj][m][0], v1 = acc[ai][bj][m][1];
                    if (ACT == 1) {
#pragma unroll
                        for (int j = 0; j < 4; ++j) { v0[j] = gelu_tanh(v0[j]); v1[j] = gelu_tanh(v1[j]); } }
                    u32x4 w; w.x = cvt_pk_bf16(v0[0], v0[1]); w.y = cvt_pk_bf16(v0[2], v0[3]); w.z = cvt_pk_bf16(v1[0], v1[1]); w.w = cvt_pk_bf16(v1[2], v1[3]);
                    *(u32x4*)(rowp + bj * HALF) = w; } }
    }
};
struct EpiQT {
    static constexpr bool PERM = true, SWAP = false;
    bf16_t* O;
    __device__ __forceinline__ void operator()(const f32x4 (&acc)[2][2][4][2], const Unit& u, int wr, int wc, int fr, int fq) const {
        const int row0 = u.pm * BM + wr * 64 + fr;
#pragma unroll
        for (int ai = 0; ai < 2; ++ai)
#pragma unroll
            for (int m = 0; m < 4; ++m) { const int row = row0 + ai * HALF + m * 16;
                bf16_t* base = O + ((size_t)((row >> 7) * 8 + u.pn) * 32 * 128 + (row & 127)) * 8;
#pragma unroll
                for (int bj = 0; bj < 2; ++bj) { const f32x4 v0 = acc[ai][bj][m][0], v1 = acc[ai][bj][m][1];
                    u32x4 w; w.x = cvt_pk_bf16(v0[0], v0[1]); w.y = cvt_pk_bf16(v0[2], v0[3]); w.z = cvt_pk_bf16(v1[0], v1[1]); w.w = cvt_pk_bf16(v1[2], v1[3]);
                    *(u32x4*)(base + (size_t)(16 * bj + 4 * wc + fq) * 128 * 8) = w; } }
    }
};
struct EpiPoolGrp {
    static constexpr bool PERM = true, SWAP = false;
    bf16_t* O; const float* scale;
    __device__ __forceinline__ void operator()(const f32x4 (&acc)[2][2][4][2], const Unit& u, int wr, int wc, int fr, int fq) const {
        const int row0 = u.pm * BM + wr * 64 + fr, col0 = u.pn * BM + wc * 32 + 8 * fq;
#pragma unroll
        for (int bj = 0; bj < 2; ++bj) {
            const f32x4 s0 = *(const f32x4*)(scale + col0 + bj * HALF), s1 = *(const f32x4*)(scale + col0 + bj * HALF + 4);
#pragma unroll
            for (int ai = 0; ai < 2; ++ai)
#pragma unroll
                for (int m = 0; m < 4; ++m) { bf16_t* rowp = O + (size_t)(row0 + ai * HALF + m * 16) * DM + col0 + bj * HALF;
                    const f32x4 v0 = acc[ai][bj][m][0] * s0, v1 = acc[ai][bj][m][1] * s1;
                    u32x4 w; w.x = cvt_pk_bf16(v0[0], v0[1]); w.y = cvt_pk_bf16(v0[2], v0[3]); w.z = cvt_pk_bf16(v1[0], v1[1]); w.w = cvt_pk_bf16(v1[2], v1[3]);
                    *(u32x4*)rowp = w; }
            asm volatile("" ::: "memory");
        }
    }
};
struct EpiConvIn {
    static constexpr bool PERM = true, SWAP = false;
    bf16_t* BG; bf16_t* Z;
    __device__ __forceinline__ void operator()(const f32x4 (&acc)[2][2][4][2], const Unit& u, int wr, int wc, int fr, int fq) const {
        const int row0 = u.pm * BM + wr * 64 + fr;
        if (u.pn < 4) {
            const int col0 = u.pn * BM + wc * 32 + 8 * fq;
#pragma unroll
            for (int ai = 0; ai < 2; ++ai)
#pragma unroll
                for (int m = 0; m < 4; ++m) { bf16_t* rowp = BG + (size_t)(row0 + ai * HALF + m * 16) * DM + col0;
#pragma unroll
                    for (int bj = 0; bj < 2; ++bj) { const f32x4 v0 = acc[ai][bj][m][0], v1 = acc[ai][bj][m][1];
                        u32x4 w; w.x = cvt_pk_bf16(v0[0], v0[1]); w.y = cvt_pk_bf16(v0[2], v0[3]); w.z = cvt_pk_bf16(v1[0], v1[1]); w.w = cvt_pk_bf16(v1[2], v1[3]);
                        *(u32x4*)(rowp + bj * HALF) = w; } }
        } else {
            const int col0 = (u.pn - 4) * HALF + wc * 32 + 8 * fq;
#pragma unroll
            for (int ai = 0; ai < 2; ++ai)
#pragma unroll
                for (int m = 0; m < 4; ++m) { bf16_t* rowp = Z + (size_t)(row0 + ai * HALF + m * 16) * DM + col0;
                    const f32x4 v0 = acc[ai][0][m][0] * acc[ai][1][m][0], v1 = acc[ai][0][m][1] * acc[ai][1][m][1];
                    u32x4 w; w.x = cvt_pk_bf16(v0[0], v0[1]); w.y = cvt_pk_bf16(v0[2], v0[3]); w.z = cvt_pk_bf16(v1[0], v1[1]); w.w = cvt_pk_bf16(v1[2], v1[3]);
                    *(u32x4*)rowp = w; }
        }
    }
};
struct EpiResid {
    static constexpr bool PERM = false, SWAP = false;
    const float* base; float* out; const float* gacc; const float* gbias;
    __device__ __forceinline__ void operator()(const f32x4 (&acc)[2][2][4][2], const Unit& u, int wr, int wc, int fr, int fq) const {
        const int row0 = u.pm * BM + wr * 64 + fr, col0 = u.pn * BM + wc * 32 + 4 * fq;
        const float* gp = gacc + (size_t)(u.pm >> 4) * (6 * DM);
#pragma unroll
        for (int bj = 0; bj < 2; ++bj)
#pragma unroll
            for (int n = 0; n < 2; ++n) { const int cc = col0 + bj * HALF + n * 16;
                const f32x4 gv = *(const f32x4*)(gp + cc);
#pragma unroll
                for (int ai = 0; ai < 2; ++ai) {
#pragma unroll
                    for (int m = 0; m < 4; ++m) { const size_t off = (size_t)(row0 + ai * HALF + m * 16) * DM + cc;
                        const f32x4 bs = *(const f32x4*)(base + off);
                        *(f32x4*)(out + off) = bs + gv * acc[ai][bj][m][n]; }
                    asm volatile("" ::: "memory"); } }
    }
};
struct EpiGmlpV {
    static constexpr bool PERM = false, SWAP = true;
    bf16_t* VT;
    __device__ __forceinline__ void operator()(const f32x4 (&acc)[2][2][4][2], const Unit& u, int wr, int wc, int fr, int fq) const {
        const int row0 = u.pm * BM + wr * 64 + 4 * fq, col0 = u.pn * BM + wc * 32 + fr;
#pragma unroll
        for (int bj = 0; bj < 2; ++bj)
#pragma unroll
            for (int n = 0; n < 2; ++n) { const int c = col0 + bj * HALF + n * 16;
#pragma unroll
                for (int ai = 0; ai < 2; ++ai)
#pragma unroll
                    for (int m = 0; m < 4; ++m) { const f32x4 v = acc[ai][bj][m][n]; const int r = row0 + ai * HALF + m * 16;
                        u32x2 w; w.x = cvt_pk_bf16(gelu_tanh(v[0]), gelu_tanh(v[1])); w.y = cvt_pk_bf16(gelu_tanh(v[2]), gelu_tanh(v[3]));
                        *(u32x2*)(VT + ((size_t)(r >> 7) * GH + c) * 128 + (r & 127)) = w; } }
    }
};
}

constexpr int RING_BYTES = 131072;
constexpr int LDS_BYTES = 147456;
constexpr int LDS_XB_OFF = LDS_BYTES - 64;
constexpr int NTHREADS = 512;

#define CE_DESC(a, b) do { const float _x = fmaxf(a, b), _y = fminf(a, b); a = _x; b = _y; } while (0)
#define CE_ASC(a, b)  do { const float _x = fminf(a, b), _y = fmaxf(a, b); a = _x; b = _y; } while (0)
template <int OFF, int N>
__device__ __forceinline__ void sort16_desc(float (&v)[N]) {
#pragma unroll
    for (int k = 2; k <= 16; k <<= 1)
#pragma unroll
        for (int j = k >> 1; j > 0; j >>= 1)
#pragma unroll
            for (int i = 0; i < 16; ++i) { const int l = i ^ j; if (l > i) { if ((i & k) == 0) CE_DESC(v[OFF + i], v[OFF + l]); else CE_ASC(v[OFF + i], v[OFF + l]); } }
}
template <int OFF, int N>
__device__ __forceinline__ void bmerge16_desc(float (&v)[N]) {
#pragma unroll
    for (int j = 8; j > 0; j >>= 1)
#pragma unroll
        for (int i = 0; i < 16; ++i) { const int l = i ^ j; if (l > i) CE_DESC(v[OFF + i], v[OFF + l]); }
}
template <int A, int B, int N>
__device__ __forceinline__ void merge_top16(float (&v)[N]) {
#pragma unroll
    for (int i = 0; i < 16; ++i) v[A + i] = fmaxf(v[A + i], v[B + 15 - i]);
    bmerge16_desc<A, N>(v);
}
__device__ __forceinline__ void top16_of_64(float (&v)[64]) {
    sort16_desc<0, 64>(v); sort16_desc<16, 64>(v); sort16_desc<32, 64>(v); sort16_desc<48, 64>(v);
    merge_top16<0, 16, 64>(v); merge_top16<32, 48, 64>(v); merge_top16<0, 32, 64>(v);
}

struct Args { const float* in[23]; float* out; unsigned char* ws; int ph_lo, ph_hi; };
typedef const __attribute__((address_space(4))) Args* ArgP;
enum { I_X = 0, I_C, I_ADA_W, I_ADA_B, I_NORM_G, I_POOL_WIN, I_POOL_WGRP, I_POOL_SCALE, I_POOL_WOUT, I_CONV_WIN, I_CONV_W, I_CONV_WOUT,
       I_GMLP_WIN, I_GMLP_LNG, I_GMLP_LNB, I_GMLP_WS, I_GMLP_BS, I_GMLP_WOUT, I_PEER_WQ, I_PEER_KEYS, I_PEER_U, I_PEER_V, I_FINAL_G };

__device__ __forceinline__ void transpose_item(const float* W, int K, int N, bf16_t* WT, int dst_row0, LAS float* scr, int k0, int n0, int lane) {
#pragma unroll 8
    for (int i = 0; i < 32; ++i) { const int kk = 2 * i + (lane >> 5); scr[kk * 33 + (lane & 31)] = W[(size_t)(k0 + kk) * N + n0 + (lane & 31)]; }
    asm volatile("s_waitcnt lgkmcnt(0)" ::: "memory");
    const int c = lane & 7;
#pragma unroll
    for (int j = 0; j < 4; ++j) { const int n = (lane >> 3) + 8 * j; const LAS float* s = scr + (8 * c) * 33 + n;
        u32x4 o; o.x = cvt_pk_bf16(s[0 * 33], s[1 * 33]); o.y = cvt_pk_bf16(s[2 * 33], s[3 * 33]); o.z = cvt_pk_bf16(s[4 * 33], s[5 * 33]); o.w = cvt_pk_bf16(s[6 * 33], s[7 * 33]);
        *(u32x4*)(WT + (size_t)(dst_row0 + n) * K + k0 + 8 * c) = o; }
    asm volatile("s_waitcnt lgkmcnt(0)" ::: "memory");
}
__device__ __forceinline__ void convert_stream(const float* src, bf16_t* dst, size_t n8, size_t gt, size_t stride) {
    for (size_t i = gt; i < n8; i += stride) {
        const f32x4 a = __builtin_nontemporal_load((const f32x4*)src + 2 * i), b = __builtin_nontemporal_load((const f32x4*)src + 2 * i + 1);
        u32x4 o; o.x = cvt_pk_bf16(a[0], a[1]); o.y = cvt_pk_bf16(a[2], a[3]); o.z = cvt_pk_bf16(b[0], b[1]); o.w = cvt_pk_bf16(b[2], b[3]);
        *((u32x4*)dst + i) = o; }
}
__device__ __forceinline__ unsigned e2m1_code(float a) { const float aa = fabsf(a);
    const unsigned c = (aa > 0.25f ? 1u : 0u) + (aa > 0.75f ? 1u : 0u) + (aa > 1.25f ? 1u : 0u) + (aa > 1.75f ? 1u : 0u) + (aa > 2.5f ? 1u : 0u) + (aa > 3.5f ? 1u : 0u) + (aa > 5.0f ? 1u : 0u);
    return c | ((__builtin_bit_cast(unsigned, a) >> 28) & 8u); }
__device__ __forceinline__ void prologue_phase(ArgP Ap, LAS unsigned char* lds, int vcu, int G, int tid, int wid, int lane) {
    unsigned char* ws = Ap->ws;
    const int gw = vcu * 8 + wid, NGW = G * 8;
    LAS float* scr = (LAS float*)(lds + wid * 16384);
    constexpr int NT_ITEMS = 1024 + 256 + 1024 + 1536 + 512 + 3072 + 1536 + 4096;
    for (int it = gw; it < NT_ITEMS; it += NGW) {
        int r = it; const float* src; bf16_t* dst; int K, N, kind = 0;
        if (r < 1024) { const int m = r >> 9; r &= 511; src = Ap->in[I_POOL_WIN] + (size_t)m * DM * DM; dst = (bf16_t*)(ws + WS_POOL_WIN) + (size_t)m * DM * DM; K = DM; N = DM; }
        else if ((r -= 1024) < 256) { const int m = r >> 5; r &= 31; src = Ap->in[I_POOL_WGRP] + (size_t)m * 65536; dst = (bf16_t*)(ws + WS_POOL_WGRP) + (size_t)m * 65536; K = 256; N = 256; }
        else if ((r -= 256) < 1024) { const int m = r >> 9; r &= 511; src = Ap->in[I_POOL_WOUT] + (size_t)m * DM * DM; dst = (bf16_t*)(ws + WS_POOL_WOUT) + (size_t)m * DM * DM; K = DM; N = DM; }
        else if ((r -= 1024) < 1536) { src = Ap->in[I_CONV_WIN]; dst = (bf16_t*)(ws + WS_CONV_WIN); K = DM; N = 3 * DM; kind = 1; }
        else if ((r -= 1536) < 512) { src = Ap->in[I_CONV_WOUT]; dst = (bf16_t*)(ws + WS_CONV_WOUT); K = DM; N = DM; }
        else if ((r -= 512) < 3072) { src = Ap->in[I_GMLP_WIN]; dst = (bf16_t*)(ws + WS_GMLP_WIN); K = DM; N = 2 * GH; }
        else if ((r -= 3072) < 1536) { src = Ap->in[I_GMLP_WOUT]; dst = (bf16_t*)(ws + WS_GMLP_WOUT); K = GH; N = DM; }
        else { r -= 1536; const int m = r >> 10; r &= 1023; src = Ap->in[I_PEER_WQ] + (size_t)m * DM * 2048; dst = (bf16_t*)(ws + WS_PEER_WQ) + (size_t)m * DM * 2048; K = DM; N = 2048; }
        const int nblk = N / 32, kb = r / nblk, nb = r % nblk, n0 = 32 * nb;
        int drow = n0;
        if (kind == 1 && n0 >= DM) { const int xt = n0 >= 2 * DM, ch = n0 - (xt ? 2 * DM : DM); drow = DM + 256 * (ch >> 7) + 128 * xt + (ch & 127); }
        transpose_item(src, K, N, dst, drow, scr, 64 * kb, n0, lane);
    }
    const size_t gt = (size_t)vcu * NTHREADS + tid, stride = (size_t)G * NTHREADS;
    convert_stream(Ap->in[I_PEER_KEYS], (bf16_t*)(ws + WS_KEYS), (size_t)DEPTH * 16 * 128 * 128 / 8, gt, stride);
    for (int row0 = gw * 4; row0 < 2 * DEPTH * NEXP; row0 += NGW * 4) {
        f32x4 v[4][4]; float m[4];
#pragma unroll
        for (int rr = 0; rr < 4; ++rr) { const int row = row0 + rr, tab = row >> 16, lrow = row & 65535;
            const f32x4* src = (const f32x4*)((tab ? Ap->in[I_PEER_V] : Ap->in[I_PEER_U]) + (size_t)lrow * DM) + lane;
#pragma unroll
            for (int j = 0; j < 4; ++j) v[rr][j] = __builtin_nontemporal_load(src + 64 * j); }
#pragma unroll
        for (int rr = 0; rr < 4; ++rr) { float mm = 0.f;
#pragma unroll
            for (int j = 0; j < 4; ++j) mm = fmaxf(fmaxf(mm, fmaxf(fabsf(v[rr][j][0]), fabsf(v[rr][j][1]))), fmaxf(fabsf(v[rr][j][2]), fabsf(v[rr][j][3])));
#pragma unroll
            for (int o = 1; o < 64; o <<= 1) mm = fmaxf(mm, __shfl_xor(mm, o));
            m[rr] = mm; }
#pragma unroll
        for (int rr = 0; rr < 4; ++rr) { const int row = row0 + rr, tab = row >> 16, lrow = row & 65535, l = lrow >> 14, e = lrow & (NEXP - 1);
            {
                const float S = m[rr] > 0.f ? (6.0f / 0.9f) / m[rr] : 1.0f;
                unsigned char* dstt = ws + (tab ? WS_TABV : WS_TABU);
#pragma unroll
                for (int j = 0; j < 4; ++j) { unsigned pk = e2m1_code(v[rr][j][0] * S) | (e2m1_code(v[rr][j][1] * S) << 4) | (e2m1_code(v[rr][j][2] * S) << 8) | (e2m1_code(v[rr][j][3] * S) << 12);
                    pk |= (unsigned)__shfl_xor((int)pk, 1) << 16;
                    if (!(lane & 1)) *(unsigned*)(dstt + (((size_t)l * 4 + j) * NEXP + e) * 128 + 2 * lane) = pk; }
            }
            if (lane == 0) ((unsigned short*)(ws + WS_SCU))[2 * lrow + tab] = (unsigned short)(cvt_pk_bf16(m[rr] > 0.f ? m[rr] * (0.9f / 6.0f) : 1.0f, 0.f) & 0xffffu); }
    }
    for (size_t i = gt; i < (size_t)2 * 4 * 256 * 256 / 8; i += stride) { const size_t idx = i * 8; const int l = (int)(idx >> 18), g = (int)(idx >> 16) & 3, j0 = (int)idx & 255;
        const f32x4 a = *((const f32x4*)Ap->in[I_POOL_WGRP] + 2 * i), b = *((const f32x4*)Ap->in[I_POOL_WGRP] + 2 * i + 1);
        const float* sp = Ap->in[I_POOL_SCALE] + (size_t)l * DM + 256 * g + j0; const f32x4 sa = *(const f32x4*)sp, sb = *(const f32x4*)(sp + 4);
        u32x4 o; o.x = cvt_pk_bf16(a[0] * sa[0], a[1] * sa[1]); o.y = cvt_pk_bf16(a[2] * sa[2], a[3] * sa[3]); o.z = cvt_pk_bf16(b[0] * sb[0], b[1] * sb[1]); o.w = cvt_pk_bf16(b[2] * sb[2], b[3] * sb[3]);
        *((u32x4*)(ws + WS_WGS) + i) = o; }
    __syncthreads();
    LAS float* cond = (LAS float*)lds;
    for (int i = tid; i < BATCH * DM; i += NTHREADS) { const int b = i >> 10, k = i & 1023; const float c = Ap->in[I_C][i]; cond[k * 8 + b] = c * __builtin_amdgcn_rcpf(1.0f + __expf(-c)); }
    __syncthreads();
    float* modp = (float*)(ws + WS_ADAP);
    for (int it = gw; it < DEPTH * 24 * 16; it += NGW) {
        const int l = it / 384, r = it % 384, cgp = r >> 4, kc = r & 15;
        const float* wp = Ap->in[I_ADA_W] + ((size_t)l * DM + kc * 64) * (6 * DM) + cgp * 256 + 4 * lane;
        f32x4 acc[8];
#pragma unroll
        for (int b = 0; b < 8; ++b) acc[b] = (f32x4){0.f, 0.f, 0.f, 0.f};
#pragma unroll 8
        for (int k = 0; k < 64; ++k) { const f32x4 w = __builtin_nontemporal_load((const f32x4*)(wp + (size_t)k * (6 * DM)));
            const f32x4 c0 = *(const LAS f32x4*)(cond + (kc * 64 + k) * 8), c1 = *(const LAS f32x4*)(cond + (kc * 64 + k) * 8 + 4);
            acc[0] += c0[0] * w; acc[1] += c0[1] * w; acc[2] += c0[2] * w; acc[3] += c0[3] * w; acc[4] += c1[0] * w; acc[5] += c1[1] * w; acc[6] += c1[2] * w; acc[7] += c1[3] * w; }
#pragma unroll
        for (int b = 0; b < 8; ++b) *(f32x4*)(modp + (((size_t)kc * DEPTH + l) * 8 + b) * (6 * DM) + cgp * 256 + 4 * lane) = acc[b];
    }
}
__device__ __forceinline__ void modreduce_phase(ArgP Ap, int vcu, int G, int tid) {
    unsigned char* ws = Ap->ws; const float* modp = (const float*)(ws + WS_ADAP); float* mod = (float*)(ws + WS_MOD);
    constexpr int N4 = DEPTH * BATCH * 6 * DM / 4;
    for (int i = vcu * NTHREADS + tid; i < N4; i += G * NTHREADS) {
        const int n4 = i % (6 * DM / 4), l = i / (BATCH * 6 * DM / 4);
        f32x4 a = *((const f32x4*)(Ap->in[I_ADA_B] + (size_t)l * 6 * DM) + n4);
#pragma unroll
        for (int kc = 0; kc < 16; ++kc) a += *((const f32x4*)modp + (size_t)kc * N4 + i);
        *((f32x4*)mod + i) = a; }
}

__device__ __forceinline__ void norm_phase(const float* x, const float* gn, const float* macc  , const float* mbias  , int sh_off, int sc_off, bf16_t* H, int gw, int NGW, int lane) {
    for (int ch = gw; ch < MTOK / 16; ch += NGW) {
        const int row0 = ch * 16, b = row0 >> 12;
        f32x4 c1[4], shv[4];
#pragma unroll
        for (int j = 0; j < 4; ++j) { const int col = 4 * lane + 256 * j;
            const f32x4 sc = *(const f32x4*)(macc + (size_t)b * 6 * DM + sc_off + col);
            c1[j] = *(const f32x4*)(gn + col) * (1.0f + sc);
            shv[j] = *(const f32x4*)(macc + (size_t)b * 6 * DM + sh_off + col); }
        for (int r = row0; r < row0 + 16; ++r) {
            const f32x4* xr = (const f32x4*)(x + (size_t)r * DM) + lane;
            f32x4 v[4]; float ss = 0.f;
#pragma unroll
            for (int j = 0; j < 4; ++j) { v[j] = xr[64 * j]; ss += (v[j][0] * v[j][0] + v[j][1] * v[j][1]) + (v[j][2] * v[j][2] + v[j][3] * v[j][3]); }
            const float rstd = __builtin_amdgcn_rsqf(wave_sum_all(ss) * (1.0f / DM) + EPS);
            u32x2* o8 = (u32x2*)(H + (size_t)r * DM) + lane;
#pragma unroll
            for (int j = 0; j < 4; ++j) { const f32x4 o = v[j] * rstd * c1[j] + shv[j]; u32x2 w; w.x = cvt_pk_bf16(o[0], o[1]); w.y = cvt_pk_bf16(o[2], o[3]); o8[64 * j] = w; }
        }
    }
}
__device__ __forceinline__ void resnorm_phase(const float* xf  , const bf16_t* xsi, bf16_t* xso  , const bf16_t* Y, const float* gate  , const float* gn, const float* macc, int sh_off, int sc_off, bf16_t* H, int gw, int NGW, int lane) {
    for (int ch = gw; ch < MTOK / 16; ch += NGW) {
        const int row0 = ch * 16, b = row0 >> 12;
        f32x4 c1[4], shv[4], gt[4];
#pragma unroll
        for (int j = 0; j < 4; ++j) { const int col = 4 * lane + 256 * j;
            const f32x4 sc = *(const f32x4*)(macc + (size_t)b * 6 * DM + sc_off + col);
            c1[j] = *(const f32x4*)(gn + col) * (1.0f + sc);
            shv[j] = *(const f32x4*)(macc + (size_t)b * 6 * DM + sh_off + col);
            gt[j] = *(const f32x4*)(gate + (size_t)b * 6 * DM + col); }
#pragma unroll 1
        for (int r0 = row0; r0 < row0 + 16; r0 += 4) {
            u32x2 yv[4][4]; f32x4 v[4][4];
#pragma unroll
            for (int rr = 0; rr < 4; ++rr) { const u32x2* yr = (const u32x2*)(Y + (size_t)(r0 + rr) * DM) + lane;
#pragma unroll
                for (int j = 0; j < 4; ++j) yv[rr][j] = yr[64 * j]; }
            if (xf) {
#pragma unroll
                for (int rr = 0; rr < 4; ++rr) { const f32x4* xr = (const f32x4*)(xf + (size_t)(r0 + rr) * DM) + lane;
#pragma unroll
                    for (int j = 0; j < 4; ++j) v[rr][j] = xr[64 * j]; } }
            else { u32x2 xv[4][4];
#pragma unroll
                for (int rr = 0; rr < 4; ++rr) { const u32x2* xr = (const u32x2*)(xsi + (size_t)(r0 + rr) * DM) + lane;
#pragma unroll
                    for (int j = 0; j < 4; ++j) xv[rr][j] = xr[64 * j]; }
#pragma unroll
                for (int rr = 0; rr < 4; ++rr)
#pragma unroll
                    for (int j = 0; j < 4; ++j) v[rr][j] = (f32x4){bf_lo(xv[rr][j].x), bf_hi(xv[rr][j].x), bf_lo(xv[rr][j].y), bf_hi(xv[rr][j].y)}; }
            float ss[4];
#pragma unroll
            for (int rr = 0; rr < 4; ++rr) { float q = 0.f;
#pragma unroll
                for (int j = 0; j < 4; ++j) { const u32x2 y = yv[rr][j]; v[rr][j] += gt[j] * (f32x4){bf_lo(y.x), bf_hi(y.x), bf_lo(y.y), bf_hi(y.y)};
                    q += (v[rr][j][0] * v[rr][j][0] + v[rr][j][1] * v[rr][j][1]) + (v[rr][j][2] * v[rr][j][2] + v[rr][j][3] * v[rr][j][3]); }
                ss[rr] = q; }
#pragma unroll
            for (int o = 1; o < 64; o <<= 1) {
#pragma unroll
                for (int rr = 0; rr < 4; ++rr) ss[rr] += __shfl_xor(ss[rr], o); }
#pragma unroll
            for (int rr = 0; rr < 4; ++rr) { const int r = r0 + rr; const float rstd = __builtin_amdgcn_rsqf(ss[rr] * (1.0f / DM) + EPS);
                u32x2* xw = (u32x2*)(xso + (size_t)r * DM) + lane; u32x2* o8 = (u32x2*)(H + (size_t)r * DM) + lane;
#pragma unroll
                for (int j = 0; j < 4; ++j) { u32x2 w; w.x = cvt_pk_bf16(v[rr][j][0], v[rr][j][1]); w.y = cvt_pk_bf16(v[rr][j][2], v[rr][j][3]); xw[64 * j] = w;
                    const f32x4 o = v[rr][j] * rstd * c1[j] + shv[j]; w.x = cvt_pk_bf16(o[0], o[1]); w.y = cvt_pk_bf16(o[2], o[3]); o8[64 * j] = w; } }
        }
    }
}
__device__ __forceinline__ void final_phase(float* x, const float* gf, int gw, int NGW, int lane) {
    f32x4 gv[4];
#pragma unroll
    for (int j = 0; j < 4; ++j) gv[j] = *(const f32x4*)(gf + 4 * lane + 256 * j);
    for (int r = gw; r < MTOK; r += NGW) {
        f32x4* xr = (f32x4*)(x + (size_t)r * DM) + lane;
        f32x4 v[4]; float ss = 0.f;
#pragma unroll
        for (int j = 0; j < 4; ++j) { v[j] = xr[64 * j]; ss += (v[j][0] * v[j][0] + v[j][1] * v[j][1]) + (v[j][2] * v[j][2] + v[j][3] * v[j][3]); }
        const float rstd = __builtin_amdgcn_rsqf(wave_sum_all(ss) * (1.0f / DM) + EPS);
#pragma unroll
        for (int j = 0; j < 4; ++j) xr[64 * j] = v[j] * rstd * gv[j];
    }
}

__device__ __forceinline__ void unpack8(const u32x4 w, float (&f)[8]) { f[0] = bf_lo(w.x); f[1] = bf_hi(w.x); f[2] = bf_lo(w.y); f[3] = bf_hi(w.y); f[4] = bf_lo(w.z); f[5] = bf_hi(w.z); f[6] = bf_lo(w.w); f[7] = bf_hi(w.w); }
__device__ __forceinline__ u32x4 pack8(const float (&f)[8]) { u32x4 o; o.x = cvt_pk_bf16(f[0], f[1]); o.y = cvt_pk_bf16(f[2], f[3]); o.z = cvt_pk_bf16(f[4], f[5]); o.w = cvt_pk_bf16(f[6], f[7]); return o; }
__device__ __forceinline__ void pool_elem_phase(const bf16_t* U, bf16_t* P, int vcu, int G, int tid) {
    const int chunk = tid & 127, run = tid >> 7, c0 = 8 * chunk, w = 2 << (c0 >> 8);
    for (int unit = vcu; unit < MTOK / 128; unit += G) {
        const int t0 = unit * 128 + run * 32, seq0 = t0 & ~(SEQ - 1);
        float s[8];
#pragma unroll
        for (int j = 0; j < 8; ++j) s[j] = 0.f;
        for (int tau = t0 - w; tau < t0; ++tau) if (tau >= seq0) { float f[8];     unpack8(*(const u32x4*)(U + (size_t)tau * DM + c0), f);
#pragma unroll
            for (int j = 0; j < 8; ++j) s[j] += f[j]; }
#pragma unroll 1
        for (int tb = t0; tb < t0 + 32; tb += 8) {
            u32x4 cur[8], old[8];
#pragma unroll
            for (int i = 0; i < 8; ++i) { cur[i] = *(const u32x4*)(U + (size_t)(tb + i) * DM + c0);
                const int tl = tb + i - w; old[i] = *(const u32x4*)(U + (size_t)(tl >= seq0 ? tl : seq0) * DM + c0); }
#pragma unroll
            for (int i = 0; i < 8; ++i) { const int t = tb + i; float f[8], o[8]; unpack8(cur[i], f);
#pragma unroll
                for (int j = 0; j < 8; ++j) s[j] += f[j];
                if (t - w >= seq0) { float q[8]; unpack8(old[i], q);
#pragma unroll
                    for (int j = 0; j < 8; ++j) s[j] -= q[j]; }
                const int pos1 = t - seq0 + 1; const float inv = 1.0f / (float)(pos1 < w ? pos1 : w);
#pragma unroll
                for (int j = 0; j < 8; ++j) o[j] = s[j] * inv - f[j];
                *(u32x4*)(P + (size_t)t * DM + c0) = pack8(o); }
        }
    }
}
__device__ __forceinline__ void conv_elem_phase(const bf16_t* BG, const bf16_t* Z, const float* cw  , bf16_t* Aout, int vcu, int G, int tid) {
    const int chunk = tid & 127, run = tid >> 7, c0 = 8 * chunk;
    float w0[8], w1[8], w2[8];
#pragma unroll
    for (int j = 0; j < 8; ++j) { w0[j] = cw[c0 + j]; w1[j] = cw[DM + c0 + j]; w2[j] = cw[2 * DM + c0 + j]; }
    for (int unit = vcu; unit < MTOK / 128; unit += G) {
        const int t0 = unit * 128 + run * 32, seq0 = t0 & ~(SEQ - 1);
        float zm2[8], zm1[8];
#pragma unroll
        for (int j = 0; j < 8; ++j) { zm2[j] = 0.f; zm1[j] = 0.f; }
        if (t0 - 2 >= seq0) unpack8(*(const u32x4*)(Z + (size_t)(t0 - 2) * DM + c0), zm2);
        if (t0 - 1 >= seq0) unpack8(*(const u32x4*)(Z + (size_t)(t0 - 1) * DM + c0), zm1);
#pragma unroll 1
        for (int tb = t0; tb < t0 + 32; tb += 8) {
            u32x4 zr[8], br[8];
#pragma unroll
            for (int i = 0; i < 8; ++i) { zr[i] = *(const u32x4*)(Z + (size_t)(tb + i) * DM + c0); br[i] = *(const u32x4*)(BG + (size_t)(tb + i) * DM + c0); }
#pragma unroll
            for (int i = 0; i < 8; ++i) { float z[8], bg[8], o[8]; unpack8(zr[i], z); unpack8(br[i], bg);
#pragma unroll
                for (int j = 0; j < 8; ++j) { o[j] = bg[j] * (w0[j] * zm2[j] + w1[j] * zm1[j] + w2[j] * z[j]); zm2[j] = zm1[j]; zm1[j] = z[j]; }
                *(u32x4*)(Aout + (size_t)(tb + i) * DM + c0) = pack8(o); }
        }
    }
}

__device__ __forceinline__ int wp_off(int row, int chunk) { return row * 256 + ((chunk ^ (row & 15)) << 4); }
__device__ __forceinline__ void mix_phase(LAS unsigned char* lds, bf16_t* UA, const bf16_t* VT, const float* WS, const float* BS, const float* LNG, const float* LNB, int vcu, int G, int tid, int wid, int lane) {
    LAS unsigned char* WP = lds;
    LAS float* MU = (LAS float*)(lds + 32768); LAS float* RSTD = MU + 128; LAS float* R1 = MU + 256; LAS float* R2 = MU + 384;
    LAS float* PART = (LAS float*)(lds + 36864);
    LAS unsigned char* VS = lds + 36864;
    for (int n = vcu; n < MTOK / 128; n += G) {
        {
            const int cgp = tid >> 4, tl = tid & 15;
            float s[8], q[8];
#pragma unroll
            for (int j = 0; j < 8; ++j) { s[j] = 0.f; q[j] = 0.f; }
#pragma unroll 4
            for (int it = 0; it < GH / 32; ++it) { float f[8]; unpack8(*(const u32x4*)(VT + ((size_t)n * GH + it * 32 + cgp) * 128 + tl * 8), f);
#pragma unroll
                for (int j = 0; j < 8; ++j) { s[j] += f[j]; q[j] += f[j] * f[j]; } }
#pragma unroll
            for (int j = 0; j < 8; ++j) { PART[(cgp * 128 + tl * 8 + j) * 2] = s[j]; PART[(cgp * 128 + tl * 8 + j) * 2 + 1] = q[j]; }
            __syncthreads();
            if (tid < 128) { float S = 0.f, Q = 0.f;
                for (int k = 0; k < 32; ++k) { S += PART[(k * 128 + tid) * 2]; Q += PART[(k * 128 + tid) * 2 + 1]; }
                const float mu = S * (1.0f / GH), var = Q * (1.0f / GH) - mu * mu; MU[tid] = mu; RSTD[tid] = __builtin_amdgcn_rsqf(fmaxf(var, 0.f) + EPS); }
            __syncthreads();
        }
        for (int g = 0; g < 8; ++g) {
            const int fr = lane & 15, fq = lane >> 4, cbase = g * 384 + wid * 48;
            bf16x8 av[4][3];
#pragma unroll
            for (int ks = 0; ks < 4; ++ks)
#pragma unroll
                for (int ct = 0; ct < 3; ++ct) av[ks][ct] = *(const bf16x8*)(VT + ((size_t)n * GH + cbase + ct * 16 + fr) * 128 + ks * 32 + fq * 8);
            {
                const int i = tid >> 2, part = tid & 3;
                const float* wrow = WS + ((size_t)g * 128 + i) * 128 + part * 32;
                float r1 = 0.f, r2 = 0.f;
#pragma unroll
                for (int jj = 0; jj < 32; jj += 8) { const int j0 = part * 32 + jj;
                    f32x4 a = *(const f32x4*)(wrow + jj), b = *(const f32x4*)(wrow + jj + 4);
                    if (i < 64 && j0 >= 64) { a = (f32x4){0.f, 0.f, 0.f, 0.f}; b = a; }
                    const f32x4 ra = *(const LAS f32x4*)(RSTD + j0), rb = *(const LAS f32x4*)(RSTD + j0 + 4), ma = *(const LAS f32x4*)(MU + j0), mb = *(const LAS f32x4*)(MU + j0 + 4);
                    const f32x4 wa = a * ra, wb = b * rb;
                    r1 += (wa[0] * ma[0] + wa[1] * ma[1]) + (wa[2] * ma[2] + wa[3] * ma[3]) + (wb[0] * mb[0] + wb[1] * mb[1]) + (wb[2] * mb[2] + wb[3] * mb[3]);
                    r2 += (a[0] + a[1]) + (a[2] + a[3]) + (b[0] + b[1]) + (b[2] + b[3]);
                    u32x4 o; o.x = cvt_pk_bf16(wa[0], wa[1]); o.y = cvt_pk_bf16(wa[2], wa[3]); o.z = cvt_pk_bf16(wb[0], wb[1]); o.w = cvt_pk_bf16(wb[2], wb[3]);
                    *(LAS u32x4*)(WP + wp_off(i, j0 >> 3)) = o; }
                r1 += __shfl_xor(r1, 1); r1 += __shfl_xor(r1, 2); r2 += __shfl_xor(r2, 1); r2 += __shfl_xor(r2, 2);
                if (part == 0) { R1[i] = r1; R2[i] = r2; }
            }
            __syncthreads();
            f32x4 acc[3][8];
#pragma unroll
            for (int ct = 0; ct < 3; ++ct)
#pragma unroll
                for (int it = 0; it < 8; ++it) acc[ct][it] = (f32x4){0.f, 0.f, 0.f, 0.f};
#pragma unroll
            for (int ks = 0; ks < 4; ++ks) {
#pragma unroll
                for (int it = 0; it < 8; ++it) { const bf16x8 bw = *(const LAS bf16x8*)(WP + wp_off(it * 16 + fr, ks * 4 + fq));
#pragma unroll
                    for (int ct = 0; ct < 3; ++ct) acc[ct][it] = __builtin_amdgcn_mfma_f32_16x16x32_bf16(av[ks][ct], bw, acc[ct][it], 0, 0, 0); }
                __builtin_amdgcn_sched_barrier(0);
            }
#pragma unroll
            for (int ct = 0; ct < 3; ++ct) { const int c4 = cbase + ct * 16 + 4 * fq;
                const f32x4 lg = *(const f32x4*)(LNG + c4), lb = *(const f32x4*)(LNB + c4);
#pragma unroll
                for (int it = 0; it < 8; ++it) { const int i = it * 16 + fr; const float r1 = R1[i], r2 = R2[i], bs = BS[g * 128 + i];
                    const f32x4 vs = lg * (acc[ct][it] - r1) + lb * r2 + bs;
                    u32x2 o; o.x = cvt_pk_bf16(vs[0], vs[1]); o.y = cvt_pk_bf16(vs[2], vs[3]);
                    *(LAS u32x2*)(VS + i * 784 + (wid * 48 + ct * 16 + 4 * fq) * 2) = o; } }
            __syncthreads();
#pragma unroll 4
            for (int c = tid; c < 128 * 48; c += NTHREADS) { const int tok = c / 48, ch8 = c - tok * 48;
                const u32x4 vv = *(const LAS u32x4*)(VS + tok * 784 + ch8 * 16);
                u32x4* up = (u32x4*)(UA + (size_t)(n * 128 + tok) * GH + g * 384 + ch8 * 8); const u32x4 uu = *up;
                u32x4 o; o.x = cvt_pk_bf16(bf_lo(uu.x) * bf_lo(vv.x), bf_hi(uu.x) * bf_hi(vv.x)); o.y = cvt_pk_bf16(bf_lo(uu.y) * bf_lo(vv.y), bf_hi(uu.y) * bf_hi(vv.y));
                o.z = cvt_pk_bf16(bf_lo(uu.z) * bf_lo(vv.z), bf_hi(uu.z) * bf_hi(vv.z)); o.w = cvt_pk_bf16(bf_lo(uu.w) * bf_lo(vv.w), bf_hi(uu.w) * bf_hi(vv.w));
                *up = o; }
            __syncthreads();
        }
    }
}

__device__ __forceinline__ void topk_units(LAS unsigned char* lds, const bf16_t* Q, const bf16_t* KEYS, int* SELI, float* SELW, const pg8::StaticOrder& S, int tid, int wid, int lane) {
    LAS unsigned char* kl = lds;
    LAS float* topv = (LAS float*)(lds + 65536);
    const int p = wid >> 2, sub = wid & 3, tl = lane & 31, hi = lane >> 5;
    int hprev = -1;
#pragma unroll 1
    for (int k = 0; ; k = (k & 1) ? k + 3 : k + 1) {
        pg8::Unit ua, ub; if (!S.next(k, ua)) break;
        const bool hasb = S.next(k + 2, ub);
        const bool pair = hasb && ub.pn == ua.pn;
#pragma unroll 1
        for (int part = 0; part < ((hasb && !pair) ? 2 : 1); ++part) {
            const int h = part ? ub.pn : ua.pn, pm0 = part ? ub.pm : ua.pm, pm1 = ub.pm, ntile = pair ? 4 : 2;
            __syncthreads();
            if (h != hprev) {
                for (int c = tid; c < 4096; c += NTHREADS) { const int row = c >> 4, ch = c & 15;
                    const u32x4 v = *(const u32x4*)(KEYS + ((size_t)h * 256 + row) * 128 + ch * 8);
                    *(LAS u32x4*)(kl + row * 256 + ((ch ^ (row & 15)) << 4)) = v; }
                hprev = h; }
            __syncthreads();
#pragma unroll 1
            for (int t4 = 0; t4 < ntile; ++t4) {
                const int tile = 2 * (t4 < 2 ? pm0 : pm1) + (t4 & 1);
                const bf16_t* qrow = Q + ((size_t)((tile * 8 + h) * 32 + 16 * p + hi) * 128 + sub * 32 + tl) * 8;
                bf16x8 bq[8];
#pragma unroll
                for (int ks = 0; ks < 8; ++ks) bq[ks] = *(const bf16x8*)(qrow + (size_t)ks * 2 * 128 * 8);
                f32x16 acc[4];
#pragma unroll
                for (int kt = 0; kt < 4; ++kt)
#pragma unroll
                    for (int r = 0; r < 16; ++r) acc[kt][r] = 0.f;
#pragma unroll
                for (int ks = 0; ks < 8; ++ks)
#pragma unroll
                    for (int kt = 0; kt < 4; ++kt) { const int row = p * 128 + kt * 32 + tl;
                        const bf16x8 ak = *(const LAS bf16x8*)(kl + row * 256 + (((2 * ks + hi) ^ (row & 15)) << 4));
                        acc[kt] = __builtin_amdgcn_mfma_f32_32x32x16_bf16(ak, bq[ks], acc[kt], 0, 0, 0); }
                float v[64];
#pragma unroll
                for (int kt = 0; kt < 4; ++kt)
#pragma unroll
                    for (int r = 0; r < 16; ++r) { const unsigned key = (unsigned)(kt * 32 + (r & 3) + 8 * (r >> 2) + 4 * hi);
                        v[kt * 16 + r] = __uint_as_float((__float_as_uint(acc[kt][r]) & ~127u) | key); }
                top16_of_64(v);
                float m[16];
#pragma unroll
                for (int i = 0; i < 16; ++i) m[i] = fmaxf(v[i], __shfl_xor(v[15 - i], 32));
                bmerge16_desc<0, 16>(m);
                if (hi == 0) { LAS f32x4* dst = (LAS f32x4*)(topv + ((t4 * 2 + p) * 128 + sub * 32 + tl) * 16);
#pragma unroll
                    for (int i = 0; i < 4; ++i) dst[i] = (f32x4){m[4 * i], m[4 * i + 1], m[4 * i + 2], m[4 * i + 3]}; }
            }
            __syncthreads();
            if (tid < ntile * 128) {
                const int t4 = tid >> 7, tok = tid & 127, tile = 2 * (t4 < 2 ? pm0 : pm1) + (t4 & 1);
                const LAS float* t0 = topv + ((t4 * 2 + 0) * 128 + tok) * 16; const LAS float* t1 = topv + ((t4 * 2 + 1) * 128 + tok) * 16;
                float s0[16], s1[16];
#pragma unroll
                for (int i = 0; i < 4; ++i) { const f32x4 a = *(const LAS f32x4*)(t0 + 4 * i), b = *(const LAS f32x4*)(t1 + 4 * i);
                    s0[4 * i] = a[0]; s0[4 * i + 1] = a[1]; s0[4 * i + 2] = a[2]; s0[4 * i + 3] = a[3]; s1[4 * i] = b[0]; s1[4 * i + 1] = b[1]; s1[4 * i + 2] = b[2]; s1[4 * i + 3] = b[3]; }
                float c[64];
                constexpr int pre[16] = {0, 16, 24, 29, 33, 36, 38, 40, 42, 43, 44, 45, 46, 47, 48, 49};
#pragma unroll
                for (int a = 0; a < 16; ++a)
#pragma unroll
                    for (int b = 0; b < 16; ++b) if ((a + 1) * (b + 1) <= 16) c[pre[a] + b] = __uint_as_float((__float_as_uint(s0[a] + s1[b]) & ~255u) | (unsigned)(a * 16 + b));
#pragma unroll
                for (int i = 50; i < 64; ++i) c[i] = -3.0e38f;
                top16_of_64(c);
                float e[16], sum = 0.f;
#pragma unroll
                for (int kk = 0; kk < 16; ++kk) { e[kk] = __builtin_amdgcn_exp2f((c[kk] - c[0]) * 1.44269504f); sum += e[kk]; }
                const float inv = 1.0f / sum;
                const size_t o = (size_t)(tile * 128 + tok) * NPICK + h * 16;
#pragma unroll
                for (int k4 = 0; k4 < 4; ++k4) { i32x4 ei; f32x4 wv;
#pragma unroll
                    for (int j = 0; j < 4; ++j) { const unsigned code = __float_as_uint(c[4 * k4 + j]) & 255u;
                        const unsigned i1 = __float_as_uint(t0[code >> 4]) & 127u, i2 = __float_as_uint(t1[code & 15u]) & 127u;
                        ei[j] = (int)(i1 * 128u + i2); wv[j] = e[4 * k4 + j] * inv; }
                    *(i32x4*)(SELI + o + 4 * k4) = ei; *(f32x4*)(SELW + o + 4 * k4) = wv; }
            }
        }
    }
    __syncthreads();
}

typedef const unsigned char* cbytes;
#ifndef DUP_MASK
#define DUP_MASK 0
#endif
template <int CTRL> __device__ __forceinline__ float dpp_f(float v) { return __builtin_bit_cast(float, __builtin_amdgcn_update_dpp(0, __builtin_bit_cast(int, v), CTRL, 0xf, 0xf, false)); }
#define DPP_F(v, ctrl) dpp_f<(ctrl)>(v)
#define PG_IDX(EV, TKN) do { const LAS u32x4* _ip = (const LAS u32x4*)(idxw + (TKN) * 128 + 16 * g8); \
        _Pragma("unroll") for (int q = 0; q < 2; ++q) { const u32x4 _e = _ip[q]; _Pragma("unroll") for (int w = 0; w < 4; ++w) { EV[8 * q + 2 * w] = (int)(_e[w] & 0xffffu); EV[8 * q + 2 * w + 1] = (int)(_e[w] >> 16); } } } while (0)
#define PG_GATHER8(BUF, SL, EV, J0) do { _Pragma("unroll") for (int j = 0; j < 8; ++j) BUF[j] = *(const u32x4*)((SL) + ((unsigned)EV[(J0) + j] * 128u + s8 * 16u)); } while (0)
#define PGU_IDX(EV, TKN) do { const LAS u32x4* _ip = (const LAS u32x4*)(idxw + (TKN) * 128 + 16 * slotA); \
        _Pragma("unroll") for (int q = 0; q < 2; ++q) { const u32x4 _e = _ip[q]; _Pragma("unroll") for (int w = 0; w < 4; ++w) { EV[8 * q + 2 * w] = (int)(_e[w] & 0xffffu); EV[8 * q + 2 * w + 1] = (int)(_e[w] >> 16); } } } while (0)
#define PGU_GATHER8(BUF, SL, EV, M0) do { _Pragma("unroll") for (int j = 0; j < 8; ++j) BUF[j] = *(const u32x4*)((SL) + ((unsigned)EV[4 * (((M0) + j) & 3) + (((M0) + j) >> 2)] * 128u + pieceA * 16u)); } while (0)
#define PGU_HB(HR, IT) do { const int _it = (IT) < 63 ? (IT) : 63; const u32x4* _hp = (const u32x4*)(H + (size_t)(tk0 + (_it & 15)) * DM + (((xg + (_it >> 4)) & 3) * 256) + hoffB); HR[0] = _hp[0]; HR[1] = _hp[1]; } while (0)
#define PGU_CVT8(W0, W1) __builtin_amdgcn_cvt_pk_fp8_f32(bf_lo(W1), bf_hi(W1), __builtin_amdgcn_cvt_pk_fp8_f32(bf_lo(W0), bf_hi(W0), 0, false), true)
#define PGU_BOP(BV, HR) do { const int _q0 = PGU_CVT8(HR[0].x, HR[0].y), _q1 = PGU_CVT8(HR[0].z, HR[0].w), _q2 = PGU_CVT8(HR[1].x, HR[1].y), _q3 = PGU_CVT8(HR[1].z, HR[1].w); \
        BV = (i32x8){blo ? _q0 : 0, blo ? _q1 : 0, blo ? _q2 : 0, blo ? _q3 : 0, bhi ? _q0 : 0, bhi ? _q1 : 0, bhi ? _q2 : 0, bhi ? _q3 : 0}; } while (0)
#define PGU_MMA8(BUF, _b, ACC, M0) do { \
        _Pragma("unroll") for (int j = 0; j < 8; ++j) { const u32x4 _u = BUF[j]; const i32x8 _a = {(int)_u.x, (int)_u.y, (int)_u.z, (int)_u.w, 0, 0, 0, 0}; \
            const f32x4 _d = __builtin_amdgcn_mfma_scale_f32_16x16x128_f8f6f4(_a, _b, (f32x4){0.f, 0.f, 0.f, 0.f}, 4, 0, 0, 0, 0, 0); \
            float _v = i4 == 0 ? _d[0] : i4 == 1 ? _d[1] : i4 == 2 ? _d[2] : _d[3]; _v += DPP_F(_v, 0xB1); _v += DPP_F(_v, 0x4E); \
            ACC[((M0) + j) >> 2] = (i4 == (((M0) + j) & 3)) ? _v : ACC[((M0) + j) >> 2]; } } while (0)
#define PGU_DOTS(ACC, TKN) do { if (n16 < 8) { LAS f32x4* _dp = (LAS f32x4*)(dotw + (TKN) * 128 + 32 * c4 + 4 * n16); *_dp += ACC; } } while (0)
#define PG_VCOMP8(BUF, CV, J0) do { _Pragma("unroll") for (int j = 0; j < 8; ++j) { const u32x4 v = BUF[j]; const float c = CV[(J0) + j]; \
            acc[0] += c * __builtin_amdgcn_cvt_pk_f32_fp8(v.x, false); acc[1] += c * __builtin_amdgcn_cvt_pk_f32_fp8(v.x, true); \
            acc[2] += c * __builtin_amdgcn_cvt_pk_f32_fp8(v.y, false); acc[3] += c * __builtin_amdgcn_cvt_pk_f32_fp8(v.y, true); \
            acc[4] += c * __builtin_amdgcn_cvt_pk_f32_fp8(v.z, false); acc[5] += c * __builtin_amdgcn_cvt_pk_f32_fp8(v.z, true); \
            acc[6] += c * __builtin_amdgcn_cvt_pk_f32_fp8(v.w, false); acc[7] += c * __builtin_amdgcn_cvt_pk_f32_fp8(v.w, true); } } while (0)
#define PG_COEF(CV, TKN) do { const LAS f32x4* _cp = (const LAS f32x4*)(dotw + (TKN) * 128 + 16 * g8); \
        _Pragma("unroll") for (int q = 0; q < 4; ++q) { const f32x4 _c = _cp[q]; CV[4 * q] = _c[0]; CV[4 * q + 1] = _c[1]; CV[4 * q + 2] = _c[2]; CV[4 * q + 3] = _c[3]; } } while (0)
#define PG_COEF8(CV, TKN, J0) do { const LAS f32x4* _cp = (const LAS f32x4*)(dotw + (TKN) * 128 + 16 * g8 + (J0)); \
        const f32x4 _c0 = _cp[0], _c1 = _cp[1]; CV[0] = _c0[0]; CV[1] = _c0[1]; CV[2] = _c0[2]; CV[3] = _c0[3]; CV[4] = _c1[0]; CV[5] = _c1[1]; CV[6] = _c1[2]; CV[7] = _c1[3]; } while (0)
#define PG_XOFFS(IT) ((size_t)(tk0 + ((IT) & 15)) * DM + (((xg + ((IT) >> 4)) & 7) * 128) + xoff)
#define PG_XADDR(IT) (x + PG_XOFFS(IT))
#define PG_XLOAD(XV, IT) do { XV = *(const unsigned*)PG_XADDR(IT); } while (0)
__device__ __forceinline__ void peer_gather_phase(LAS unsigned char* lds, const bf16_t* H, cbytes TUP, cbytes TVP, const int* SELI, const float* SELW, const unsigned* SC, bf16_t* x  , float* outf  , const float* gacc, const float* gn_next  , const float* mod_next  , bf16_t* Hout, bool last, int vcu, int G, int wid, int lane) {
    const int g8 = lane >> 3, s8 = lane & 7, n16 = lane & 15, c4 = lane >> 4, i4 = lane & 3, slotA = 2 * ((lane >> 2) & 3) + (c4 >> 1), pieceA = 4 * (c4 & 1) + i4, hoffB = 128 * (c4 >> 1) + 32 * i4 + 16 * (c4 & 1);
    const bool blo = n16 < 4, bhi = n16 >= 4 && n16 < 8;
    const bool b3 = (lane & 8) != 0, b4 = (lane & 16) != 0, b5 = (lane & 32) != 0;
    const int xoff = s8 * 16 + 8 * (g8 & 1) + 4 * ((g8 >> 1) & 1) + 2 * (g8 >> 2);
    LAS unsigned short* idxw = (LAS unsigned short*)(lds + wid * 18432);
    LAS unsigned char* stg = lds + wid * 18432 + 4096;
    LAS float* outw = (LAS float*)(lds + wid * 18432 + 13312);
    LAS unsigned char* coefA = lds + wid * 18432 + 14336;
    LAS float* dotw = (LAS float*)(lds + wid * 18432 + 4096);
    for (int blk = vcu; blk < 256; blk += G) {
        const int xg = blk >> 5, tk0 = blk * 128 + wid * 16;
        const int nrep_u = (DUP_MASK & 0x20000) ? opaque(2) : 1;
#pragma unroll 1
        for (int rep_u = 0; rep_u < nrep_u; ++rep_u) {
#pragma unroll 4
        for (int i = 0; i < 16; ++i) { const int e0 = SELI[(size_t)(tk0 + i) * NPICK + lane], e1 = SELI[(size_t)(tk0 + i) * NPICK + 64 + lane];
            idxw[i * 128 + lane] = (unsigned short)e0; idxw[i * 128 + 64 + lane] = (unsigned short)e1; dotw[i * 128 + lane] = 0.f; dotw[i * 128 + 64 + lane] = 0.f; }
        asm volatile("" ::: "memory");
        {
            int ev[16]; u32x4 bufA[8], bufB[8], bufC[8], bufD[8]; u32x4 hr0[2], hr1[2]; i32x8 bop;
            { cbytes sl0 = TUP + (size_t)(xg & 3) * NEXP * 128;
              PGU_IDX(ev, 0); PGU_GATHER8(bufA, sl0, ev, 0); PGU_GATHER8(bufB, sl0, ev, 8);
              PGU_IDX(ev, 1); PGU_GATHER8(bufC, sl0, ev, 0); PGU_GATHER8(bufD, sl0, ev, 8); }
            PGU_HB(hr0, 0); PGU_HB(hr1, 1);
#pragma unroll 1
            for (int it = 0; it < 64; it += 2) {
                const int tkn = it & 15, it2 = it + 2 < 63 ? it + 2 : 63, it3 = it + 3 < 63 ? it + 3 : 63;
                cbytes sl2 = TUP + (size_t)((xg + (it2 >> 4)) & 3) * NEXP * 128;
                f32x4 acc4 = {0.f, 0.f, 0.f, 0.f};
                PGU_IDX(ev, it2 & 15); PGU_BOP(bop, hr0);
                PGU_MMA8(bufA, bop, acc4, 0); __builtin_amdgcn_sched_barrier(0);
                PGU_GATHER8(bufA, sl2, ev, 0); __builtin_amdgcn_sched_barrier(0);
                PGU_MMA8(bufB, bop, acc4, 8); __builtin_amdgcn_sched_barrier(0);
                PGU_GATHER8(bufB, sl2, ev, 8); PGU_HB(hr0, it + 2); __builtin_amdgcn_sched_barrier(0);
                PGU_DOTS(acc4, tkn);
                acc4 = (f32x4){0.f, 0.f, 0.f, 0.f};
                PGU_IDX(ev, it3 & 15); PGU_BOP(bop, hr1);
                PGU_MMA8(bufC, bop, acc4, 0); __builtin_amdgcn_sched_barrier(0);
                PGU_GATHER8(bufC, sl2, ev, 0); __builtin_amdgcn_sched_barrier(0);
                PGU_MMA8(bufD, bop, acc4, 8); __builtin_amdgcn_sched_barrier(0);
                PGU_GATHER8(bufD, sl2, ev, 8); PGU_HB(hr1, it + 3); __builtin_amdgcn_sched_barrier(0);
                PGU_DOTS(acc4, tkn + 1);
            }
        }
        asm volatile("" ::: "memory");
        }
#pragma unroll 2
        for (int i = 0; i < 16; ++i) {
#pragma unroll
            for (int hh = 0; hh < 2; ++hh) { const int k = 16 * g8 + s8 + 8 * hh; const int e = idxw[i * 128 + k];
                const float w = SELW[(size_t)(tk0 + i) * NPICK + k]; const unsigned sc = SC[e];
                const float cf = w * gelu_tanh(dotw[i * 128 + k] * bf_lo(sc)) * bf_hi(sc);
                const float c64 = fminf(fmaxf(cf * 64.0f, -448.0f), 448.0f);
                coefA[((i * 2 + hh) * 4 + (s8 >> 1)) * 16 + g8 + 8 * (s8 & 1)] = (unsigned char)(__builtin_amdgcn_cvt_pk_fp8_f32(c64, 0.f, 0, false) & 0xff); } }
        asm volatile("" ::: "memory");
        {
            typedef int i32x2v __attribute__((ext_vector_type(2)));
            const int lane = opaque((int)threadIdx.x) & 63, g8 = lane >> 3, s8 = lane & 7, n16 = lane & 15, c4 = lane >> 4;
            const float* gp = gacc + (size_t)(tk0 >> 12) * 6 * DM + 4 * lane;
            const int rowB = 32 * (c4 & 1) + n16;
            int ev[8]; u32x4 bufA[8], bufB[8], bufC[8], bufD[8]; u32x2 xv; f32x4 gate; float dv[16]; i32x8 aop;
#define PGM_IDX8(TKN, J0) do { const u32x4 _e = *(const LAS u32x4*)(idxw + (TKN) * 128 + 16 * g8 + (J0)); _Pragma("unroll") for (int w = 0; w < 4; ++w) { ev[2 * w] = (int)(_e[w] & 0xffffu); ev[2 * w + 1] = (int)(_e[w] >> 16); } } while (0)
#define PGM_XADDR(IT) (x + (size_t)(tk0 + ((IT) & 15)) * DM + (((xg + ((IT) >> 4)) & 3) * 256) + 4 * lane)
#define PGM_STAGE(BUF) do { asm volatile("" ::: "memory"); _Pragma("unroll") for (int j = 0; j < 8; ++j) *(LAS u32x4*)(stg + (8 * j + g8) * 144 + 16 * s8) = BUF[j]; asm volatile("" ::: "memory"); } while (0)
#define PGM_AOP(TKN, HH) do { const u32x4 _c = *(const LAS u32x4*)(coefA + (((TKN) * 2 + (HH)) * 4 + c4) * 16); const bool _m0 = n16 == 0; \
        aop = (i32x8){_m0 ? (int)_c.x : 0, _m0 ? (int)_c.y : 0, _m0 ? (int)_c.z : 0, _m0 ? (int)_c.w : 0, 0, 0, 0, 0}; } while (0)
#define PGM_MMA16(FIRST) do { _Pragma("unroll") for (int cb = 0; cb < 16; ++cb) { \
            const i32x2v _b0 = __builtin_amdgcn_ds_read_tr4_b64_v2i32((LAS i32x2v*)(stg + rowB * 144 + 8 * cb)); \
            const i32x2v _b1 = __builtin_amdgcn_ds_read_tr4_b64_v2i32((LAS i32x2v*)(stg + (rowB + 16) * 144 + 8 * cb)); \
            const i32x8 _b = {_b0.x, _b0.y, _b1.x, _b1.y, 0, 0, 0, 0}; \
            const f32x4 _d = __builtin_amdgcn_mfma_scale_f32_16x16x128_f8f6f4(aop, _b, (f32x4){0.f, 0.f, 0.f, 0.f}, 0, 4, 0, 0, 0, 0); \
            dv[cb] = (FIRST) ? _d[0] : dv[cb] + _d[0];                        \
            if ((cb & 3) == 3) __builtin_amdgcn_sched_barrier(0); } } while (0)
#define PGM_OUT(XV, IT) do { asm volatile("" ::: "memory"); if (lane < 16) { _Pragma("unroll") for (int cb = 0; cb < 16; ++cb) outw[16 * cb + lane] = dv[cb]; } asm volatile("" ::: "memory"); \
            const f32x4 _o = *(const LAS f32x4*)(outw + 4 * lane) * (1.0f / 64.0f); asm volatile("" ::: "memory"); \
            const f32x4 _xn = (f32x4){bf_lo(XV.x), bf_hi(XV.x), bf_lo(XV.y), bf_hi(XV.y)} + gate * _o; \
            u32x2 _w; _w.x = cvt_pk_bf16(_xn[0], _xn[1]); _w.y = cvt_pk_bf16(_xn[2], _xn[3]); *(u32x2*)PGM_XADDR(IT) = _w; } while (0)
            { cbytes sl0 = TVP + (size_t)(xg & 3) * NEXP * 128;
              PGM_IDX8(0, 0); PG_GATHER8(bufA, sl0, ev, 0); PGM_IDX8(0, 8); PG_GATHER8(bufB, sl0, ev, 0);
              PGM_IDX8(1, 0); PG_GATHER8(bufC, sl0, ev, 0); PGM_IDX8(1, 8); PG_GATHER8(bufD, sl0, ev, 0); }
#pragma unroll 1
            for (int it = 0; it < 64; it += 2) {
                const int tkn = it & 15, it2 = it + 2 < 63 ? it + 2 : 63, it3 = it + 3 < 63 ? it + 3 : 63, sl = (xg + (it >> 4)) & 3;
                cbytes sl2 = TVP + (size_t)((xg + (it2 >> 4)) & 3) * NEXP * 128;
                PGM_IDX8(it2 & 15, 0); xv = *(const u32x2*)PGM_XADDR(it); gate = *(const f32x4*)(gp + sl * 256);
                PGM_STAGE(bufA); PG_GATHER8(bufA, sl2, ev, 0); PGM_AOP(tkn, 0); PGM_MMA16(true);
                PGM_IDX8(it2 & 15, 8);
                PGM_STAGE(bufB); PG_GATHER8(bufB, sl2, ev, 0); PGM_AOP(tkn, 1); PGM_MMA16(false);
                PGM_OUT(xv, it);
                PGM_IDX8(it3 & 15, 0); xv = *(const u32x2*)PGM_XADDR(it + 1); gate = *(const f32x4*)(gp + sl * 256);
                PGM_STAGE(bufC); PG_GATHER8(bufC, sl2, ev, 0); PGM_AOP(tkn + 1, 0); PGM_MMA16(true);
                PGM_IDX8(it3 & 15, 8);
                PGM_STAGE(bufD); PG_GATHER8(bufD, sl2, ev, 0); PGM_AOP(tkn + 1, 1); PGM_MMA16(false);
                PGM_OUT(xv, it + 1);
            }
#undef PGM_IDX8
#undef PGM_XADDR
#undef PGM_STAGE
#undef PGM_AOP
#undef PGM_MMA16
#undef PGM_OUT
        }
        asm volatile("s_waitcnt vmcnt(0)" ::: "memory");
        {
            const int lane = opaque((int)threadIdx.x) & 63;
            const int b = tk0 >> 12;
            f32x4 c1[4], shv[4];
#pragma unroll
            for (int j = 0; j < 4; ++j) { const int col = 4 * lane + 256 * j;
                if (last) { c1[j] = *(const f32x4*)(gn_next + col); shv[j] = (f32x4){0.f, 0.f, 0.f, 0.f}; }
                else { c1[j] = *(const f32x4*)(gn_next + col) * (1.0f + *(const f32x4*)(mod_next + (size_t)b * 6 * DM + DM + col)); shv[j] = *(const f32x4*)(mod_next + (size_t)b * 6 * DM + col); } }
#pragma unroll 1
            for (int i0 = 0; i0 < 16; i0 += 4) {
                f32x4 v[4][4]; float ss[4];
#pragma unroll
                for (int rr = 0; rr < 4; ++rr) { const u32x2* xr = (const u32x2*)(x + (size_t)(tk0 + i0 + rr) * DM) + lane;
#pragma unroll
                    for (int j = 0; j < 4; ++j) { const u32x2 xv = xr[64 * j]; v[rr][j] = (f32x4){bf_lo(xv.x), bf_hi(xv.x), bf_lo(xv.y), bf_hi(xv.y)}; } }
#pragma unroll
                for (int rr = 0; rr < 4; ++rr) { float q = 0.f;
#pragma unroll
                    for (int j = 0; j < 4; ++j) q += (v[rr][j][0] * v[rr][j][0] + v[rr][j][1] * v[rr][j][1]) + (v[rr][j][2] * v[rr][j][2] + v[rr][j][3] * v[rr][j][3]);
                    ss[rr] = q; }
#pragma unroll
                for (int o = 1; o < 64; o <<= 1) {
#pragma unroll
                    for (int rr = 0; rr < 4; ++rr) ss[rr] += __shfl_xor(ss[rr], o); }
#pragma unroll
                for (int rr = 0; rr < 4; ++rr) { const int r = tk0 + i0 + rr; const float rstd = __builtin_amdgcn_rsqf(ss[rr] * (1.0f / DM) + EPS);
                    if (last) { f32x4* xr = (f32x4*)(outf + (size_t)r * DM) + lane;
#pragma unroll
                        for (int j = 0; j < 4; ++j) xr[64 * j] = v[rr][j] * rstd * c1[j]; }
                    else { u32x2* o8 = (u32x2*)(Hout + (size_t)r * DM) + lane;
#pragma unroll
                        for (int j = 0; j < 4; ++j) { const f32x4 o = v[rr][j] * rstd * c1[j] + shv[j]; u32x2 w; w.x = cvt_pk_bf16(o[0], o[1]); w.y = cvt_pk_bf16(o[2], o[3]); o8[64 * j] = w; } } }
            }
        }
    }
}
#undef PG_IDX
#undef PG_GATHER8
#undef PGU_IDX
#undef PGU_GATHER8
#undef PGU_HB
#undef PGU_CVT8
#undef PGU_BOP
#undef PGU_MMA8
#undef PGU_DOTS
#undef PG_VCOMP8
#undef PG_COEF
#undef PG_COEF8
#undef PG_XADDR
#undef PG_XOFFS
#undef PG_XLOAD

constexpr size_t WS_BAR = 768 * 1024;
#define XB_TMO      128
#define XB_XCNT(j)  (256  + 64 * (j))
#define XB_XSUB(j)  (1280 + 64 * (j))
#define XB_XGEN(j)  (2304 + 64 * (j))
#define XB_TOP      3328
#define XB_TOPGEN   3392
#define XCD_BAR_WORDS 3456
#define XB_SPIN_CAP (1u << 22)
__device__ __forceinline__ unsigned xb_ld(unsigned* p)              { return __hip_atomic_load(p, __ATOMIC_RELAXED, __HIP_MEMORY_SCOPE_AGENT); }
__device__ __forceinline__ unsigned xb_add(unsigned* p, unsigned v) { return __hip_atomic_fetch_add(p, v, __ATOMIC_RELAXED, __HIP_MEMORY_SCOPE_AGENT); }
__device__ __forceinline__ unsigned xb_xcc_id() { return (unsigned)__builtin_amdgcn_s_getreg((3 << 11) | 20) & 0xFu; }
#define XB_SPIN(cond, bar) do { unsigned _sp = 0; while (cond) { __builtin_amdgcn_s_sleep(1); \
    if ((++_sp & 255u) == 0u) { if (xb_ld(&(bar)[XB_TMO])) break; if (_sp > XB_SPIN_CAP) { atomicAdd(&(bar)[XB_TMO], 1u); break; } } } } while (0)
struct XcdBarrier { unsigned* bar; unsigned x; volatile LAS unsigned* st; };
__device__ __forceinline__ void xcd_barrier_complete(unsigned* bar, unsigned x, unsigned& nloc, unsigned& nx) {
    const unsigned G = gridDim.x * gridDim.y * gridDim.z;
    unsigned sum, cnt, mine, sp = 0u;
    for (;;) {
        sum = 0u; cnt = 0u; mine = 0u;
#pragma unroll
        for (unsigned j = 0; j < 16; ++j) { const unsigned c = xb_ld(&bar[XB_XCNT(j)]); sum += c; cnt += (c > 0u) ? 1u : 0u; mine = (j == x) ? c : mine; }
        if (sum == G) break;
        __builtin_amdgcn_s_sleep(1);
        if ((++sp & 255u) == 0u) { if (xb_ld(&bar[XB_TMO])) break; if (sp > XB_SPIN_CAP) { atomicAdd(&bar[XB_TMO], 1u); break; } }
    }
    nloc = mine > 0u ? mine : 1u; nx = cnt > 0u ? cnt : 1u;
}
__device__ __forceinline__ void xcd_barrier(const XcdBarrier& b) {
    asm volatile("s_waitcnt vmcnt(0)" ::: "memory");
    __syncthreads();
    if (threadIdx.x == 0) {
        unsigned* bar = b.bar;
        __builtin_amdgcn_s_waitcnt(0);
        unsigned nloc = b.st[0], nx = b.st[1];
        if (nloc == 0u) { xcd_barrier_complete(bar, b.x, nloc, nx); b.st[0] = nloc; b.st[1] = nx; }
        const unsigned old = xb_add(&bar[XB_XSUB(b.x)], 1u);
        const unsigned gen = old / nloc;
        if (old + 1u == (gen + 1u) * nloc) {
            __builtin_amdgcn_fence(__ATOMIC_RELEASE, "agent");
            asm volatile("s_waitcnt vmcnt(0)" ::: "memory");
            const unsigned og = xb_add(&bar[XB_TOP], 1u);
            const unsigned tg = og / nx;
            if (og + 1u == (tg + 1u) * nx) xb_add(&bar[XB_TOPGEN], 1u);
            else XB_SPIN(xb_ld(&bar[XB_TOPGEN]) == tg, bar);
            __builtin_amdgcn_fence(__ATOMIC_ACQUIRE, "agent");
            xb_add(&bar[XB_XGEN(b.x)], 1u);
            asm volatile("s_waitcnt vmcnt(0)" ::: "memory");
        } else {
            XB_SPIN(xb_ld(&bar[XB_XGEN(b.x)]) == gen, bar);
            __builtin_amdgcn_fence(__ATOMIC_ACQUIRE, "agent");
            asm volatile("s_waitcnt vmcnt(0)" ::: "memory");
        }
    }
    __syncthreads();
}

constexpr int NPHASES = 27;
#ifndef PH_MASK
#define PH_MASK 0xFFFFFF
#endif
#ifndef DUP_MASK
#define DUP_MASK 0
#endif
#ifndef TIME_MASK
#define TIME_MASK 0
#endif
__device__ __forceinline__ int opaque_s(int x) { asm volatile("" : "+s"(x)); return x; }
#define PHM(bit, call) do { if constexpr ((PH_MASK & (bit)) != 0) { if constexpr ((DUP_MASK & (bit)) != 0) { const int _nrep = opaque_s(2); for (int _rep = 0; _rep < _nrep; ++_rep) { call; __syncthreads(); } } else { call; } } } while (0)
__global__ void __launch_bounds__(NTHREADS, 2) trunk_fwd(Args A) {
    extern __shared__ __attribute__((aligned(16))) unsigned char lds_raw[];
    LAS unsigned char* lds = (LAS unsigned char*)lds_raw;
    const int tid0 = threadIdx.x, wid = __builtin_amdgcn_readfirstlane(tid0 >> 6);
    const int G = gridDim.x, bx = blockIdx.x, vcu = (G % 8 == 0) ? (bx % 8) * (G / 8) + bx / 8 : bx;
    const int gw = vcu * 8 + wid, NGW = G * 8;
    const int ph_lo = A.ph_lo, ph_hi = A.ph_hi;
    unsigned long long t_acc = 0;
#if MK_ONE_LAUNCH
    if (tid0 < 2) ((volatile LAS unsigned*)(lds + LDS_XB_OFF))[tid0] = 0u;
    if (bx == 0) { unsigned* b0 = (unsigned*)(A.ws + WS_BAR); for (int i = tid0; i < XCD_BAR_WORDS; i += NTHREADS) b0[i] = 0u; }
#endif

    for (int ph = ph_lo; ph < ph_hi; ++ph) {
        const int tid = opaque(tid0), lane = tid & 63;
        ArgP Ap = (ArgP)__builtin_amdgcn_kernarg_segment_ptr();
        asm volatile("" : "+s"(Ap));
        unsigned char* ws = Ap->ws;
        bf16_t* Hb = (bf16_t*)(ws + WS_H);
        unsigned char* mixb = ws + WS_MIX;
        const float* mod = (const float*)(ws + WS_MOD);
        float* xo = Ap->out;
        int layer, step;
        if (ph < 2) { layer = -1; step = ph; }
        else if (ph < 9) { layer = 0; step = ph - 2; }
        else if (ph < 15) { layer = 1; step = ph - 9 + 1; }
        else if (ph < 21) { layer = 2; step = ph - 15 + 1; }
        else { layer = 3; step = ph - 21 + 1; }
        const int kind = layer % 3, jl = layer / 3;
        unsigned long long t_ph0 = 0; if constexpr (TIME_MASK != 0) t_ph0 = __builtin_amdgcn_s_memrealtime();
        const int nmix = 4;
        int ptype = 0;
        if (layer < 0) ptype = 1; else if (layer > 3) ptype = 2048; else if (step == 0 || step == nmix) ptype = 2;
        else if (step < nmix) ptype = (step == 1) ? 4 : (step == nmix - 1) ? 32 : (kind == 0 && step == 3) ? 16 : 8;
        else ptype = 64 << (step - nmix - 1);
        const float* macc = mod + (size_t)(layer < 0 ? 0 : (layer > 3 ? 3 : layer)) * BATCH * 6 * DM;
        const float* mbias = Ap->in[I_ADA_B] + (size_t)(layer < 0 ? 0 : (layer > 3 ? 3 : layer)) * 6 * DM;
        const float* xin = (layer == 0) ? Ap->in[I_X] : xo;

        if (layer < 0) {
            if (step == 0) { PHM(1, prologue_phase(Ap, lds, vcu, G, tid, wid, lane)); }
            else { PHM(1, modreduce_phase(Ap, vcu, G, tid));
#pragma unroll 1
                for (int pl = 0; pl < 2; ++pl) { pg8::StaticOrder S; pg8::Gemm g{(const bf16_t*)(ws + WS_POOL_WOUT) + (size_t)pl * DM * DM, (const bf16_t*)(ws + WS_WGS) + (size_t)pl * 4 * 65536, DM, DM, 256, DM, 256, 256}; S.init(DM, DM, G, bx);
                    pg8::EpiBf16<0> E{(bf16_t*)(ws + WS_WEFF) + (size_t)pl * DM * DM, DM}; PHM(0x2000, pg8::gemm_phase(lds, g, S, E)); } }
        } else if (layer > 3) {
            PHM(256, final_phase(xo, Ap->in[I_FINAL_G], gw, NGW, lane));
        } else if (step == 0) {
            PHM(2, norm_phase(xin, Ap->in[I_NORM_G] + (size_t)(layer * 2 + 0) * DM, macc, mbias, 0, DM, Hb, gw, NGW, lane));
        } else if (step < nmix) {
            pg8::StaticOrder S;
            if (kind == 0) {
                bf16_t* U = (bf16_t*)mixb; bf16_t* P = (bf16_t*)(mixb + 64 * MiB); bf16_t* Z = (bf16_t*)(mixb + 128 * MiB);
                if (step == 1) { pg8::Gemm g{Hb, (const bf16_t*)(ws + WS_POOL_WIN) + (size_t)jl * DM * DM, MTOK, DM, DM, DM, DM, 0}; S.init(MTOK, DM, G, bx);
                    pg8::EpiBf16<0> E{U, DM}; PHM(0x1000, pg8::gemm_phase(lds, g, S, E)); }
                else if (step == 2) { PHM(8, pool_elem_phase(U, P, vcu, G, tid)); }
                else { pg8::Gemm g{P, (const bf16_t*)(ws + WS_WEFF) + (size_t)jl * DM * DM, MTOK, DM, DM, DM, DM, 0}; S.init(MTOK, DM, G, bx);
                    pg8::EpiBf16<0> E{(bf16_t*)(mixb + 192 * MiB), DM}; PHM(0x8000, pg8::gemm_phase(lds, g, S, E));   }
            } else if (kind == 1) {
                bf16_t* BG = (bf16_t*)mixb; bf16_t* Z = (bf16_t*)(mixb + 64 * MiB); bf16_t* AA = (bf16_t*)(mixb + 128 * MiB);
                if (step == 1) { pg8::Gemm g{Hb, (const bf16_t*)(ws + WS_CONV_WIN), MTOK, 3 * DM, DM, DM, DM, 0}; S.init(MTOK, 3 * DM, G, bx);
                    pg8::EpiConvIn E{BG, Z}; PHM(0x4000, pg8::gemm_phase(lds, g, S, E)); }
                else if (step == 2) { PHM(16, conv_elem_phase(BG, Z, Ap->in[I_CONV_W], AA, vcu, G, tid)); }
                else { pg8::Gemm g{AA, (const bf16_t*)(ws + WS_CONV_WOUT), MTOK, DM, DM, DM, DM, 0}; S.init(MTOK, DM, G, bx);
                    pg8::EpiBf16<0> E{(bf16_t*)(mixb + 192 * MiB), DM}; PHM(0x8000, pg8::gemm_phase(lds, g, S, E));   }
            } else {
                bf16_t* UA = (bf16_t*)mixb; bf16_t* VT = (bf16_t*)(mixb + 192 * MiB);
                if (step == 1) {
                    { pg8::Gemm g{Hb, (const bf16_t*)(ws + WS_GMLP_WIN), MTOK, GH, DM, DM, DM, 0}; S.init(MTOK, GH, G, bx);
                      pg8::EpiBf16<1> E{UA, GH}; PHM(0x1000, pg8::gemm_phase(lds, g, S, E)); }
                    { pg8::Gemm g{Hb, (const bf16_t*)(ws + WS_GMLP_WIN) + (size_t)GH * DM, MTOK, GH, DM, DM, DM, 0}; S.init(MTOK, GH, G, bx);
                      pg8::EpiGmlpV E{VT}; PHM(0x10000, pg8::gemm_phase(lds, g, S, E)); }
                }
                else if (step == 2) { PHM(32, mix_phase(lds, UA, VT, Ap->in[I_GMLP_WS], Ap->in[I_GMLP_BS], Ap->in[I_GMLP_LNG], Ap->in[I_GMLP_LNB], vcu, G, tid, wid, lane)); }
                else { pg8::Gemm g{UA, (const bf16_t*)(ws + WS_GMLP_WOUT), MTOK, DM, GH, GH, GH, 0}; S.init(MTOK, DM, G, bx);
                    pg8::EpiBf16<0> E{(bf16_t*)(mixb + 192 * MiB), DM}; PHM(0x8000, pg8::gemm_phase(lds, g, S, E));   }
            }
        } else {
            const int ps = step - nmix;
            bf16_t* Qb = (bf16_t*)mixb;
            bf16_t* xs = (layer == 3) ? (bf16_t*)(mixb + 192 * MiB) : (bf16_t*)xo;
            if (ps == 0) { resnorm_phase(layer == 0 ? Ap->in[I_X] : nullptr, (const bf16_t*)xo, xs, (const bf16_t*)(mixb + 192 * MiB), macc + 2 * DM, Ap->in[I_NORM_G] + (size_t)(layer * 2 + 1) * DM, macc, 3 * DM, 4 * DM, Hb, gw, NGW, lane); }
            else if (ps == 1) { pg8::StaticOrder S; pg8::Gemm g{Hb, (const bf16_t*)(ws + WS_PEER_WQ) + (size_t)layer * DM * 2048, MTOK, 2048, DM, DM, DM, 0}; S.init(MTOK, 2048, G, bx);
                pg8::EpiQT E{Qb}; PHM(0x1000, pg8::gemm_phase(lds, g, S, E));
                asm volatile("s_waitcnt vmcnt(0)" ::: "memory"); __syncthreads();
                PHM(64, topk_units(lds, Qb, (const bf16_t*)(ws + WS_KEYS) + (size_t)layer * 16 * 128 * 128, (int*)(ws + WS_SELI), (float*)(ws + WS_SELW), S, tid, wid, lane)); }
            else { PHM(128, peer_gather_phase(lds, Hb, (cbytes)(ws + WS_TABU) + (size_t)layer * NEXP * (DM / 2), (cbytes)(ws + WS_TABV) + (size_t)layer * NEXP * (DM / 2), (const int*)(ws + WS_SELI), (const float*)(ws + WS_SELW),
                              (const unsigned*)(ws + WS_SCU) + (size_t)layer * NEXP, xs, xo, macc + 5 * DM,
                              layer == 3 ? Ap->in[I_FINAL_G] : Ap->in[I_NORM_G] + (size_t)((layer + 1) * 2) * DM, mod + (size_t)(layer == 3 ? 3 : layer + 1) * BATCH * 6 * DM, Hb, layer == 3, vcu, G, wid, lane)); }
        }
#if MK_ONE_LAUNCH
        if constexpr (TIME_MASK != 0) if (ph + 1 >= ph_hi) { if (ptype & TIME_MASK) t_acc += __builtin_amdgcn_s_memrealtime() - t_ph0; }
        if (ph + 1 < ph_hi) {
            XcdBarrier xbar; xbar.bar = (unsigned*)(Ap->ws + WS_BAR); xbar.x = xb_xcc_id(); xbar.st = (volatile LAS unsigned*)(lds + LDS_XB_OFF);
            if (ph == ph_lo) { cg::this_grid().sync(); if (tid0 == 0) (void)xb_add(&xbar.bar[XB_XCNT(xbar.x)], 1u); }
            else { xcd_barrier(xbar); if constexpr ((DUP_MASK & 0x800) != 0) xcd_barrier(xbar); }
            if constexpr (TIME_MASK != 0) { if (ptype & TIME_MASK) t_acc += __builtin_amdgcn_s_memrealtime() - t_ph0; }
        }
#endif
    }
    if constexpr (TIME_MASK != 0) { const unsigned long long t0 = __builtin_amdgcn_s_memrealtime(); while (__builtin_amdgcn_s_memrealtime() - t0 < 4ull * t_acc) __builtin_amdgcn_s_sleep(8); }
}

extern "C" void kernel_launch(void* const* d_in, const int* in_sizes, int n_in, void* d_out, int out_size, void* d_ws, size_t ws_size, hipStream_t stream) {
    static int grid = 0;
    if (grid == 0) {
        if (n_in != 23 || in_sizes[0] != MTOK * DM || out_size != MTOK * DM || ws_size < WS_END) {
            fprintf(stderr, "kernel_launch: unexpected shapes (n_in %d, in0 %d, out %d, ws %zu; need ws >= %zu); nothing launched\n", n_in, n_in > 0 ? in_sizes[0] : -1, out_size, ws_size, (size_t)WS_END); grid = -1; return; }
        int dev = 0, cus = 0, per_cu = 0;
        if (hipGetDevice(&dev) != hipSuccess || hipDeviceGetAttribute(&cus, hipDeviceAttributeMultiprocessorCount, dev) != hipSuccess) { grid = -1; return; }
        if (hipFuncSetAttribute((const void*)trunk_fwd, hipFuncAttributeMaxDynamicSharedMemorySize, LDS_BYTES) != hipSuccess) { fprintf(stderr, "kernel_launch: hipFuncSetAttribute failed\n"); grid = -1; return; }
        if (hipOccupancyMaxActiveBlocksPerMultiprocessor(&per_cu, (const void*)trunk_fwd, NTHREADS, LDS_BYTES) != hipSuccess || per_cu < 1) { fprintf(stderr, "kernel_launch: occupancy query says %d blocks per CU\n", per_cu); (void)hipGetLastError(); grid = -1; return; }
        grid = cus * (per_cu < 1 ? 1 : 1);
    }
    if (grid < 0) return;
    Args a{};
    for (int i = 0; i < 23; ++i) a.in[i] = (const float*)d_in[i];
    a.out = (float*)d_out; a.ws = (unsigned char*)d_ws;
#if MK_ONE_LAUNCH
    a.ph_lo = 0; a.ph_hi = NPHASES;
    void* args[] = {&a};
    hipError_t e = hipLaunchCooperativeKernel((const void*)trunk_fwd, dim3(grid), dim3(NTHREADS), args, LDS_BYTES, stream);
    if (e != hipSuccess) fprintf(stderr, "cooperative launch failed: %s (grid %d)\n", hipGetErrorString(e), grid);
#else
    for (int ph = 0; ph < NPHASES; ++ph) { a.ph_lo = ph; a.ph_hi = ph + 1; hipLaunchKernelGGL(trunk_fwd, dim3(grid), dim3(NTHREADS), LDS_BYTES, stream, a); }
#endif
}
```

```cpp
#include <hip/hip_runtime.h>
#include <hip/hip_cooperative_groups.h>
#include <cstdio>
#include <cstdint>
namespace cg = cooperative_groups;

#ifndef MK_ONE_LAUNCH
#define MK_ONE_LAUNCH 1
#endif

#define LAS __attribute__((address_space(3)))
typedef unsigned short bf16_t;
typedef short bf16x8 __attribute__((ext_vector_type(8)));
typedef float f32x2 __attribute__((ext_vector_type(2)));
typedef float f32x4 __attribute__((ext_vector_type(4)));
typedef float f32x16 __attribute__((ext_vector_type(16)));
typedef unsigned u32x2 __attribute__((ext_vector_type(2)));
typedef unsigned u32x4 __attribute__((ext_vector_type(4)));
typedef int i32x4 __attribute__((ext_vector_type(4)));
typedef int i32x8 __attribute__((ext_vector_type(8)));
typedef _Float16 h16x2 __attribute__((ext_vector_type(2)));
typedef __bf16 bf16x2 __attribute__((ext_vector_type(2)));

constexpr int DM = 1024, BATCH = 8, SEQ = 4096, MTOK = BATCH * SEQ, DEPTH = 4;
constexpr int GH = 3072;
constexpr int NEXP = 16384, NPICK = 128;
constexpr float EPS = 1e-6f;

constexpr size_t MiB = 1u << 20;
constexpr size_t WS_CTL = 0, WS_SCU = 0, WS_SCV = 512 * 1024, WS_MOD = 1 * MiB, ZERO_BYTES = 2 * MiB;
constexpr size_t WS_POOL_WIN = 2 * MiB, WS_POOL_WGRP = 6 * MiB, WS_POOL_WOUT = 7 * MiB;
constexpr size_t WS_CONV_WIN = 11 * MiB, WS_CONV_WOUT = 17 * MiB;
constexpr size_t WS_GMLP_WIN = 19 * MiB, WS_GMLP_WOUT = 31 * MiB;
constexpr size_t WS_PEER_WQ = 37 * MiB, WS_KEYS = 53 * MiB;
constexpr size_t WS_H = 56 * MiB;
constexpr size_t WS_SELI = 120 * MiB, WS_SELW = 136 * MiB;
constexpr size_t WS_TABU = 152 * MiB, WS_TABV = 280 * MiB;
constexpr size_t WS_MIX = 408 * MiB;
constexpr size_t WS_ADAP = 792 * MiB;
constexpr size_t WS_COEF = 804 * MiB;
constexpr size_t WS_WEFF = 820 * MiB;
constexpr size_t WS_WGS = 824 * MiB;
constexpr size_t WS_END = 825 * MiB;

__device__ __forceinline__ unsigned cvt_pk_bf16(float lo, float hi) { unsigned r; asm volatile("v_cvt_pk_bf16_f32 %0, %1, %2" : "=v"(r) : "v"(lo), "v"(hi)); return r; }
__device__ __forceinline__ int opaque(int x) { asm volatile("" : "+v"(x)); return x; }
__device__ __forceinline__ float bf_lo(unsigned w) { return __uint_as_float(w << 16); }
__device__ __forceinline__ float bf_hi(unsigned w) { return __uint_as_float(w & 0xffff0000u); }
__device__ __forceinline__ float gelu_tanh(float x) {
    const float y = x * (1.0f + 0.044715f * x * x);
    const float e = __builtin_amdgcn_exp2f(-2.302208198f * y);
    return x * __builtin_amdgcn_rcpf(1.0f + e);
}
__device__ __forceinline__ float wave_sum_all(float v) {
#pragma unroll
    for (int o = 1; o < 64; o <<= 1) v += __shfl_xor(v, o);
    return v;
}
__device__ __forceinline__ float dot2_bf16(unsigned w, unsigned x, float acc) { return __builtin_amdgcn_fdot2_f32_bf16(__builtin_bit_cast(bf16x2, w), __builtin_bit_cast(bf16x2, x), acc, false); }


__device__ __forceinline__ float dpp_row_shr(float v, int n) {
    const int iv = __builtin_bit_cast(int, v); int r;
    switch (n) { case 1: r = __builtin_amdgcn_update_dpp(0, iv, 0x111, 0xf, 0xf, true); break; case 2: r = __builtin_amdgcn_update_dpp(0, iv, 0x112, 0xf, 0xf, true); break;
                 case 4: r = __builtin_amdgcn_update_dpp(0, iv, 0x114, 0xf, 0xf, true); break; default: r = __builtin_amdgcn_update_dpp(0, iv, 0x118, 0xf, 0xf, true); break; }
    return __builtin_bit_cast(float, r);
}
__device__ __forceinline__ float wave_sum_uniform(float v) {
    v += dpp_row_shr(v, 1); v += dpp_row_shr(v, 2); v += dpp_row_shr(v, 4); v += dpp_row_shr(v, 8);
    v += __builtin_bit_cast(float, __builtin_amdgcn_update_dpp(0, __builtin_bit_cast(int, v), 0x142, 0xa, 0xf, false));
    v += __builtin_bit_cast(float, __builtin_amdgcn_update_dpp(0, __builtin_bit_cast(int, v), 0x143, 0xc, 0xf, false));
    return __uint_as_float(__builtin_amdgcn_readlane(__float_as_uint(v), 63));
}

namespace pg8 {
constexpr int BM = 256, BK = 64, HALF = 128, HTB = HALF * BK * 2, STAGE_BYTES = 8 * HTB, NXCD = 8, WGM = 8;
__device__ __forceinline__ int lds_byte(int r, int c) { const int st = (r >> 4) * 2 + (c >> 5), rr = r & 15, cc = c & 31, ob = rr * 64 + cc * 2; return st * 1024 + (ob ^ (((ob >> 9) & 1) << 5)); }
__device__ __forceinline__ void stage_rc(int b, int& R, int& C) { const int st = b / 1024, sb = b % 1024, swz = sb ^ (((sb >> 9) & 1) << 5); R = (st >> 1) * 16 + swz / 64; C = (st & 1) * 32 + (swz % 64) / 2; }
__device__ __forceinline__ int perm32(int rho) { const int n = rho >> 4, i = rho & 15; return 8 * (i >> 2) + 4 * n + (i & 3); }

struct Unit { int pm, pn; };
struct Gemm { const bf16_t* A; const bf16_t* Bt; int M, N, K, lda, ldb, a_pn_off; };

struct StaticOrder {
    int nM, nN, nwg, G, c;
    __device__ __forceinline__ void init(int M, int N, int G_, int c_) { nM = M / BM; nN = N / BM; nwg = nM * nN; G = G_; c = c_; }
    __device__ __forceinline__ bool next(int i, Unit& u) const {
        const int L = i * G + c; if (L >= nwg) return false;
        int wgid = L; { const int q = nwg / NXCD, r = nwg % NXCD, xcd = wgid % NXCD, off = wgid / NXCD; wgid = (xcd < r ? xcd * (q + 1) : r * (q + 1) + (xcd - r) * q) + off; }
        const int nig = WGM * nN, gid = wgid / nig, fm = gid * WGM, gsz = (nM - fm) < WGM ? (nM - fm) : WGM;
        u.pm = fm + ((wgid % nig) % gsz); u.pn = (wgid % nig) / gsz; return true;
    }
};

template <class Epi>
__device__ __forceinline__ void gemm_phase(LAS unsigned char* lds, const Gemm g, const StaticOrder& S, const Epi& E) {
    const int tid = opaque((int)threadIdx.x), wid = __builtin_amdgcn_readfirstlane(tid >> 6), lane = tid & 63, wr = wid >> 2, wc = wid & 3, fr = lane & 15, fq = lane >> 4;
    int nt = g.K / BK; asm volatile("" : "+s"(nt));
    unsigned voffA[2], voffB[2];
#pragma unroll
    for (int i = 0; i < 2; ++i) { int R, C; stage_rc(tid * 16 + i * 8192, R, C); const int Rb = Epi::PERM ? ((R & ~31) + perm32(R & 31)) : R;
        voffA[i] = (unsigned)(R * g.lda + C) * 2u; voffB[i] = (unsigned)(Rb * g.ldb + C) * 2u; }
    const size_t kstep = (size_t)(BK * 2);
    const size_t hstepA = (size_t)HALF * g.lda * 2, hstepB = (size_t)HALF * g.ldb * 2;
    const size_t tstepA = 2 * hstepA, tstepB = 2 * hstepB;
    const unsigned ldsw = (unsigned)wid * 1024u;
    const int aoff = lds_byte(wr * 64 + fr, fq * 8), boff = lds_byte(wc * 32 + fr, fq * 8);
#define PG8_SA(b, h) (((b) * 2 + (h)) * HTB)
#define PG8_SB(b, h) ((4 + (b) * 2 + (h)) * HTB)
#define PG8_STAGE(bufoff, gbase, voff) do { _Pragma("unroll") for (int _i = 0; _i < 2; ++_i) \
        __builtin_amdgcn_global_load_lds((const unsigned*)((const char*)(gbase) + (voff)[_i]), (LAS unsigned*)(lds + (bufoff) + ldsw + _i * 8192), 16, 0, 0); } while (0)
#define PG8_LDA(dst, b, h) do { _Pragma("unroll") for (int m = 0; m < 4; ++m) _Pragma("unroll") for (int k = 0; k < 2; ++k) dst[m][k] = *(const LAS bf16x8*)(lds + PG8_SA(b, h) + aoff + m * 2048 + k * 1024); } while (0)
#define PG8_LDB(dst, b, h) do { _Pragma("unroll") for (int n = 0; n < 2; ++n) _Pragma("unroll") for (int k = 0; k < 2; ++k) dst[n][k] = *(const LAS bf16x8*)(lds + PG8_SB(b, h) + boff + n * 2048 + k * 1024); } while (0)
#define PG8_MMA(ai, bj, At, Bt) do { __builtin_amdgcn_s_setprio(1); _Pragma("unroll") for (int m = 0; m < 4; ++m) _Pragma("unroll") for (int n = 0; n < 2; ++n) _Pragma("unroll") for (int k = 0; k < 2; ++k) \
        acc[ai][bj][m][n] = Epi::SWAP ? __builtin_amdgcn_mfma_f32_16x16x32_bf16(At[m][k], Bt[n][k], acc[ai][bj][m][n], 0, 0, 0) \
                                      : __builtin_amdgcn_mfma_f32_16x16x32_bf16(Bt[n][k], At[m][k], acc[ai][bj][m][n], 0, 0, 0); __builtin_amdgcn_s_setprio(0); } while (0)
#define PG8_WAIT_V(n) asm volatile("s_waitcnt vmcnt(" #n ")" ::: "memory")
#define PG8_WAIT_L(n) asm volatile("s_waitcnt lgkmcnt(" #n ")" ::: "memory")
#define PG8_BAR __builtin_amdgcn_s_barrier()
#define PG8_SCHED __builtin_amdgcn_sched_barrier(0)
    Unit cur, nxt; int ui = 0;
    if (!S.next(0, cur)) return;
    f32x4 acc[2][2][4][2];
#pragma unroll
    for (int a = 0; a < 2; ++a)
#pragma unroll
        for (int b = 0; b < 2; ++b)
#pragma unroll
            for (int m = 0; m < 4; ++m)
#pragma unroll
                for (int n = 0; n < 2; ++n) acc[a][b][m][n] = (f32x4){0.f, 0.f, 0.f, 0.f};
    bf16x8 At[4][2], B0[2][2], B1[2][2];
    const char* cA = (const char*)g.A + (size_t)cur.pm * tstepA + (size_t)cur.pn * g.a_pn_off * 2; const char* cB = (const char*)g.Bt + (size_t)cur.pn * tstepB;
    PG8_STAGE(PG8_SB(0, 0), cB, voffB); PG8_STAGE(PG8_SB(0, 1), cB + hstepB, voffB); PG8_STAGE(PG8_SA(0, 0), cA, voffA); PG8_STAGE(PG8_SA(0, 1), cA + hstepA, voffA);
    if (wr == 1) PG8_BAR;
    PG8_WAIT_V(2); PG8_BAR;
    PG8_STAGE(PG8_SB(1, 0), cB + kstep, voffB); PG8_STAGE(PG8_SA(1, 0), cA + kstep, voffA); PG8_STAGE(PG8_SB(1, 1), cB + hstepB + kstep, voffB);
    PG8_WAIT_V(6); PG8_BAR;
    for (;;) {
        const bool has_next = S.next(ui + 1, nxt);
        const char* nA = has_next ? (const char*)g.A + (size_t)nxt.pm * tstepA + (size_t)nxt.pn * g.a_pn_off * 2 : cA; const char* nB = has_next ? (const char*)g.Bt + (size_t)nxt.pn * tstepB : cB;
        for (int t = 0; t < nt; t += 2) {
            const bool last = (t == nt - 2);
            const char* a1 = cA + (size_t)(t + 1) * kstep;
            const char* a2 = last ? nA : cA + (size_t)(t + 2) * kstep; const char* b2 = last ? nB : cB + (size_t)(t + 2) * kstep;
            const char* a3 = a2 + kstep; const char* b3 = b2 + kstep;
            PG8_LDB(B0, 0, 0); PG8_LDB(B1, 0, 1); PG8_SCHED; PG8_LDA(At, 0, 0); PG8_STAGE(PG8_SA(1, 1), a1 + hstepA, voffA);
            PG8_WAIT_V(8); PG8_WAIT_L(0); PG8_BAR; PG8_MMA(0, 0, At, B0); PG8_MMA(0, 1, At, B1); PG8_BAR; PG8_SCHED;
            PG8_LDA(At, 0, 1); PG8_STAGE(PG8_SB(0, 0), b2, voffB); PG8_STAGE(PG8_SB(0, 1), b2 + hstepB, voffB); PG8_STAGE(PG8_SA(0, 0), a2, voffA);
            PG8_WAIT_V(8); PG8_WAIT_L(0); PG8_BAR; PG8_MMA(1, 0, At, B0); PG8_MMA(1, 1, At, B1); PG8_BAR; PG8_SCHED;
            PG8_LDB(B0, 1, 0); PG8_LDB(B1, 1, 1); PG8_SCHED; PG8_LDA(At, 1, 0); PG8_STAGE(PG8_SA(0, 1), a2 + hstepA, voffA);
            PG8_WAIT_V(8); PG8_WAIT_L(0); PG8_BAR; PG8_MMA(0, 0, At, B0); PG8_MMA(0, 1, At, B1); PG8_BAR; PG8_SCHED;
            PG8_LDA(At, 1, 1); PG8_STAGE(PG8_SB(1, 0), b3, voffB); PG8_STAGE(PG8_SB(1, 1), b3 + hstepB, voffB); PG8_STAGE(PG8_SA(1, 0), a3, voffA);
            PG8_WAIT_V(8); PG8_WAIT_L(0); PG8_BAR; PG8_MMA(1, 0, At, B0); PG8_MMA(1, 1, At, B1); PG8_BAR; PG8_SCHED;
        }
        { const int l2 = opaque((int)threadIdx.x) & 63; E(acc, cur, wr, wc, l2 & 15, l2 >> 4); }
        if (!has_next) break;
#pragma unroll
        for (int a = 0; a < 2; ++a)
#pragma unroll
            for (int b = 0; b < 2; ++b)
#pragma unroll
                for (int m = 0; m < 4; ++m)
#pragma unroll
                    for (int n = 0; n < 2; ++n) acc[a][b][m][n] = (f32x4){0.f, 0.f, 0.f, 0.f};
        cur = nxt; cA = nA; cB = nB; ++ui;
    }
    PG8_WAIT_V(0);
    if (wr == 0) PG8_BAR;
    PG8_BAR;
#undef PG8_SA
#undef PG8_SB
#undef PG8_STAGE
#undef PG8_LDA
#undef PG8_LDB
#undef PG8_MMA
#undef PG8_WAIT_V
#undef PG8_WAIT_L
#undef PG8_BAR
#undef PG8_SCHED
}

template <int ACT> struct EpiBf16 {
    static constexpr bool PERM = true, SWAP = false;
    bf16_t* O; int ldc;
    __device__ __forceinline__ void operator()(const f32x4 (&acc)[2][2][4][2], const Unit& u, int wr, int wc, int fr, int fq) const {
        const int row0 = u.pm * BM + wr * 64 + fr, col0 = u.pn * BM + wc * 32 + 8 * fq;
#pragma unroll
        for (int ai = 0; ai < 2; ++ai)
#pragma unroll
            for (int m = 0; m < 4; ++m) { bf16_t* rowp = O + (size_t)(row0 + ai * HALF + m * 16) * ldc + col0;
#pragma unroll
                for (int bj = 0; bj < 2; ++bj) { f32x4 v0 = acc[ai][bj][m][0], v1 = acc[ai][bj][m][1];
                    if (ACT == 1) {
#pragma unroll
                        for (int j = 0; j < 4; ++j) { v0[j] = gelu_tanh(v0[j]); v1[j] = gelu_tanh(v1[j]); } }
                    u32x4 w; w.x = cvt_pk_bf16(v0[0], v0[1]); w.y = cvt_pk_bf16(v0[2], v0[3]); w.z = cvt_pk_bf16(v1[0], v1[1]); w.w = cvt_pk_bf16(v1[2], v1[3]);
                    *(u32x4*)(rowp + bj * HALF) = w; } }
    }
};
struct EpiQT {
    static constexpr bool PERM = true, SWAP = false;
    bf16_t* O;
    __device__ __forceinline__ void operator()(const f32x4 (&acc)[2][2][4][2], const Unit& u, int wr, int wc, int fr, int fq) const {
        const int row0 = u.pm * BM + wr * 64 + fr;
#pragma unroll
        for (int ai = 0; ai < 2; ++ai)
#pragma unroll
            for (int m = 0; m < 4; ++m) { const int row = row0 + ai * HALF + m * 16;
                bf16_t* base = O + ((size_t)((row >> 7) * 8 + u.pn) * 32 * 128 + (row & 127)) * 8;
#pragma unroll
                for (int bj = 0; bj < 2; ++bj) { const f32x4 v0 = acc[ai][bj][m][0], v1 = acc[ai][bj][m][1];
                    u32x4 w; w.x = cvt_pk_bf16(v0[0], v0[1]); w.y = cvt_pk_bf16(v0[2], v0[3]); w.z = cvt_pk_bf16(v1[0], v1[1]); w.w = cvt_pk_bf16(v1[2], v1[3]);
                    *(u32x4*)(base + (size_t)(16 * bj + 4 * wc + fq) * 128 * 8) = w; } }
    }
};
struct EpiPoolGrp {
    static constexpr bool PERM = true, SWAP = false;
    bf16_t* O; const float* scale;
    __device__ __forceinline__ void operator()(const f32x4 (&acc)[2][2][4][2], const Unit& u, int wr, int wc, int fr, int fq) const {
        const int row0 = u.pm * BM + wr * 64 + fr, col0 = u.pn * BM + wc * 32 + 8 * fq;
#pragma unroll
        for (int bj = 0; bj < 2; ++bj) {
            const f32x4 s0 = *(const f32x4*)(scale + col0 + bj * HALF), s1 = *(const f32x4*)(scale + col0 + bj * HALF + 4);
#pragma unroll
            for (int ai = 0; ai < 2; ++ai)
#pragma unroll
                for (int m = 0; m < 4; ++m) { bf16_t* rowp = O + (size_t)(row0 + ai * HALF + m * 16) * DM + col0 + bj * HALF;
                    const f32x4 v0 = acc[ai][bj][m][0] * s0, v1 = acc[ai][bj][m][1] * s1;
                    u32x4 w; w.x = cvt_pk_bf16(v0[0], v0[1]); w.y = cvt_pk_bf16(v0[2], v0[3]); w.z = cvt_pk_bf16(v1[0], v1[1]); w.w = cvt_pk_bf16(v1[2], v1[3]);
                    *(u32x4*)rowp = w; }
            asm volatile("" ::: "memory");
        }
    }
};
struct EpiConvIn {
    static constexpr bool PERM = true, SWAP = false;
    bf16_t* BG; bf16_t* Z;
    __device__ __forceinline__ void operator()(const f32x4 (&acc)[2][2][4][2], const Unit& u, int wr, int wc, int fr, int fq) const {
        const int row0 = u.pm * BM + wr * 64 + fr;
        if (u.pn < 4) {
            const int col0 = u.pn * BM + wc * 32 + 8 * fq;
#pragma unroll
            for (int ai = 0; ai < 2; ++ai)
#pragma unroll
                for (int m = 0; m < 4; ++m) { bf16_t* rowp = BG + (size_t)(row0 + ai * HALF + m * 16) * DM + col0;
#pragma unroll
                    for (int bj = 0; bj < 2; ++bj) { const f32x4 v0 = acc[ai][bj][m][0], v1 = acc[ai][bj][m][1];
                        u32x4 w; w.x = cvt_pk_bf16(v0[0], v0[1]); w.y = cvt_pk_bf16(v0[2], v0[3]); w.z = cvt_pk_bf16(v1[0], v1[1]); w.w = cvt_pk_bf16(v1[2], v1[3]);
                        *(u32x4*)(rowp + bj * HALF) = w; } }
        } else {
            const int col0 = (u.pn - 4) * HALF + wc * 32 + 8 * fq;
#pragma unroll
            for (int ai = 0; ai < 2; ++ai)
#pragma unroll
                for (int m = 0; m < 4; ++m) { bf16_t* rowp = Z + (size_t)(row0 + ai * HALF + m * 16) * DM + col0;
                    const f32x4 v0 = acc[ai][0][m][0] * acc[ai][1][m][0], v1 = acc[ai][0][m][1] * acc[ai][1][m][1];
                    u32x4 w; w.x = cvt_pk_bf16(v0[0], v0[1]); w.y = cvt_pk_bf16(v0[2], v0[3]); w.z = cvt_pk_bf16(v1[0], v1[1]); w.w = cvt_pk_bf16(v1[2], v1[3]);
                    *(u32x4*)rowp = w; }
        }
    }
};
struct EpiResid {
    static constexpr bool PERM = false, SWAP = false;
    const float* base; float* out; const float* gacc; const float* gbias;
    __device__ __forceinline__ void operator()(const f32x4 (&acc)[2][2][4][2], const Unit& u, int wr, int wc, int fr, int fq) const {
        const int row0 = u.pm * BM + wr * 64 + fr, col0 = u.pn * BM + wc * 32 + 4 * fq;
        const float* gp = gacc + (size_t)(u.pm >> 4) * (6 * DM);
#pragma unroll
        for (int bj = 0; bj < 2; ++bj)
#pragma unroll
            for (int n = 0; n < 2; ++n) { const int cc = col0 + bj * HALF + n * 16;
                const f32x4 gv = *(const f32x4*)(gp + cc);
#pragma unroll
                for (int ai = 0; ai < 2; ++ai) {
#pragma unroll
                    for (int m = 0; m < 4; ++m) { const size_t off = (size_t)(row0 + ai * HALF + m * 16) * DM + cc;
                        const f32x4 bs = *(const f32x4*)(base + off);
                        *(f32x4*)(out + off) = bs + gv * acc[ai][bj][m][n]; }
                    asm volatile("" ::: "memory"); } }
    }
};
struct EpiGmlpV {
    static constexpr bool PERM = false, SWAP = true;
    bf16_t* VT;
    __device__ __forceinline__ void operator()(const f32x4 (&acc)[2][2][4][2], const Unit& u, int wr, int wc, int fr, int fq) const {
        const int row0 = u.pm * BM + wr * 64 + 4 * fq, col0 = u.pn * BM + wc * 32 + fr;
#pragma unroll
        for (int bj = 0; bj < 2; ++bj)
#pragma unroll
            for (int n = 0; n < 2; ++n) { const int c = col0 + bj * HALF + n * 16;
#pragma unroll
                for (int ai = 0; ai < 2; ++ai)
#pragma unroll
                    for (int m = 0; m < 4; ++m) { const f32x4 v = acc[ai][bj][m][n]; const int r = row0 + ai * HALF + m * 16;
                        u32x2 w; w.x = cvt_pk_bf16(gelu_tanh(v[0]), gelu_tanh(v[1])); w.y = cvt_pk_bf16(gelu_tanh(v[2]), gelu_tanh(v[3]));
                        *(u32x2*)(VT + ((size_t)(r >> 7) * GH + c) * 128 + (r & 127)) = w; } }
    }
};
}

constexpr int RING_BYTES = 131072;
constexpr int LDS_BYTES = 147456;
constexpr int LDS_XB_OFF = LDS_BYTES - 64;
constexpr int NTHREADS = 512;

#define CE_DESC(a, b) do { const float _x = fmaxf(a, b), _y = fminf(a, b); a = _x; b = _y; } while (0)
#define CE_ASC(a, b)  do { const float _x = fminf(a, b), _y = fmaxf(a, b); a = _x; b = _y; } while (0)
template <int OFF, int N>
__device__ __forceinline__ void sort16_desc(float (&v)[N]) {
#pragma unroll
    for (int k = 2; k <= 16; k <<= 1)
#pragma unroll
        for (int j = k >> 1; j > 0; j >>= 1)
#pragma unroll
            for (int i = 0; i < 16; ++i) { const int l = i ^ j; if (l > i) { if ((i & k) == 0) CE_DESC(v[OFF + i], v[OFF + l]); else CE_ASC(v[OFF + i], v[OFF + l]); } }
}
template <int OFF, int N>
__device__ __forceinline__ void bmerge16_desc(float (&v)[N]) {
#pragma unroll
    for (int j = 8; j > 0; j >>= 1)
#pragma unroll
        for (int i = 0; i < 16; ++i) { const int l = i ^ j; if (l > i) CE_DESC(v[OFF + i], v[OFF + l]); }
}
template <int A, int B, int N>
__device__ __forceinline__ void merge_top16(float (&v)[N]) {
#pragma unroll
    for (int i = 0; i < 16; ++i) v[A + i] = fmaxf(v[A + i], v[B + 15 - i]);
    bmerge16_desc<A, N>(v);
}
__device__ __forceinline__ void top16_of_64(float (&v)[64]) {
    sort16_desc<0, 64>(v); sort16_desc<16, 64>(v); sort16_desc<32, 64>(v); sort16_desc<48, 64>(v);
    merge_top16<0, 16, 64>(v); merge_top16<32, 48, 64>(v); merge_top16<0, 32, 64>(v);
}

struct Args { const float* in[23]; float* out; unsigned char* ws; int ph_lo, ph_hi; };
typedef const __attribute__((address_space(4))) Args* ArgP;
enum { I_X = 0, I_C, I_ADA_W, I_ADA_B, I_NORM_G, I_POOL_WIN, I_POOL_WGRP, I_POOL_SCALE, I_POOL_WOUT, I_CONV_WIN, I_CONV_W, I_CONV_WOUT,
       I_GMLP_WIN, I_GMLP_LNG, I_GMLP_LNB, I_GMLP_WS, I_GMLP_BS, I_GMLP_WOUT, I_PEER_WQ, I_PEER_KEYS, I_PEER_U, I_PEER_V, I_FINAL_G };

__device__ __forceinline__ void transpose_item(const float* W, int K, int N, bf16_t* WT, int dst_row0, LAS float* scr, int k0, int n0, int lane) {
#pragma unroll 8
    for (int i = 0; i < 32; ++i) { const int kk = 2 * i + (lane >> 5); scr[kk * 33 + (lane & 31)] = W[(size_t)(k0 + kk) * N + n0 + (lane & 31)]; }
    asm volatile("s_waitcnt lgkmcnt(0)" ::: "memory");
    const int c = lane & 7;
#pragma unroll
    for (int j = 0; j < 4; ++j) { const int n = (lane >> 3) + 8 * j; const LAS float* s = scr + (8 * c) * 33 + n;
        u32x4 o; o.x = cvt_pk_bf16(s[0 * 33], s[1 * 33]); o.y = cvt_pk_bf16(s[2 * 33], s[3 * 33]); o.z = cvt_pk_bf16(s[4 * 33], s[5 * 33]); o.w = cvt_pk_bf16(s[6 * 33], s[7 * 33]);
        *(u32x4*)(WT + (size_t)(dst_row0 + n) * K + k0 + 8 * c) = o; }
    asm volatile("s_waitcnt lgkmcnt(0)" ::: "memory");
}
__device__ __forceinline__ void convert_stream(const float* src, bf16_t* dst, size_t n8, size_t gt, size_t stride) {
    for (size_t i = gt; i < n8; i += stride) {
        const f32x4 a = __builtin_nontemporal_load((const f32x4*)src + 2 * i), b = __builtin_nontemporal_load((const f32x4*)src + 2 * i + 1);
        u32x4 o; o.x = cvt_pk_bf16(a[0], a[1]); o.y = cvt_pk_bf16(a[2], a[3]); o.z = cvt_pk_bf16(b[0], b[1]); o.w = cvt_pk_bf16(b[2], b[3]);
        *((u32x4*)dst + i) = o; }
}
__device__ __forceinline__ unsigned e2m1_code(float a) { const float aa = fabsf(a);
    const unsigned c = (aa > 0.25f ? 1u : 0u) + (aa > 0.75f ? 1u : 0u) + (aa > 1.25f ? 1u : 0u) + (aa > 1.75f ? 1u : 0u) + (aa > 2.5f ? 1u : 0u) + (aa > 3.5f ? 1u : 0u) + (aa > 5.0f ? 1u : 0u);
    return c | ((__builtin_bit_cast(unsigned, a) >> 28) & 8u); }
__device__ __forceinline__ void prologue_phase(ArgP Ap, LAS unsigned char* lds, int vcu, int G, int tid, int wid, int lane) {
    unsigned char* ws = Ap->ws;
    const int gw = vcu * 8 + wid, NGW = G * 8;
    LAS float* scr = (LAS float*)(lds + wid * 16384);
    constexpr int NT_ITEMS = 1024 + 256 + 1024 + 1536 + 512 + 3072 + 1536 + 4096;
    for (int it = gw; it < NT_ITEMS; it += NGW) {
        int r = it; const float* src; bf16_t* dst; int K, N, kind = 0;
        if (r < 1024) { const int m = r >> 9; r &= 511; src = Ap->in[I_POOL_WIN] + (size_t)m * DM * DM; dst = (bf16_t*)(ws + WS_POOL_WIN) + (size_t)m * DM * DM; K = DM; N = DM; }
        else if ((r -= 1024) < 256) { const int m = r >> 5; r &= 31; src = Ap->in[I_POOL_WGRP] + (size_t)m * 65536; dst = (bf16_t*)(ws + WS_POOL_WGRP) + (size_t)m * 65536; K = 256; N = 256; }
        else if ((r -= 256) < 1024) { const int m = r >> 9; r &= 511; src = Ap->in[I_POOL_WOUT] + (size_t)m * DM * DM; dst = (bf16_t*)(ws + WS_POOL_WOUT) + (size_t)m * DM * DM; K = DM; N = DM; }
        else if ((r -= 1024) < 1536) { src = Ap->in[I_CONV_WIN]; dst = (bf16_t*)(ws + WS_CONV_WIN); K = DM; N = 3 * DM; kind = 1; }
        else if ((r -= 1536) < 512) { src = Ap->in[I_CONV_WOUT]; dst = (bf16_t*)(ws + WS_CONV_WOUT); K = DM; N = DM; }
        else if ((r -= 512) < 3072) { src = Ap->in[I_GMLP_WIN]; dst = (bf16_t*)(ws + WS_GMLP_WIN); K = DM; N = 2 * GH; }
        else if ((r -= 3072) < 1536) { src = Ap->in[I_GMLP_WOUT]; dst = (bf16_t*)(ws + WS_GMLP_WOUT); K = GH; N = DM; }
        else { r -= 1536; const int m = r >> 10; r &= 1023; src = Ap->in[I_PEER_WQ] + (size_t)m * DM * 2048; dst = (bf16_t*)(ws + WS_PEER_WQ) + (size_t)m * DM * 2048; K = DM; N = 2048; }
        const int nblk = N / 32, kb = r / nblk, nb = r % nblk, n0 = 32 * nb;
        int drow = n0;
        if (kind == 1 && n0 >= DM) { const int xt = n0 >= 2 * DM, ch = n0 - (xt ? 2 * DM : DM); drow = DM + 256 * (ch >> 7) + 128 * xt + (ch & 127); }
        transpose_item(src, K, N, dst, drow, scr, 64 * kb, n0, lane);
    }
    const size_t gt = (size_t)vcu * NTHREADS + tid, stride = (size_t)G * NTHREADS;
    convert_stream(Ap->in[I_PEER_KEYS], (bf16_t*)(ws + WS_KEYS), (size_t)DEPTH * 16 * 128 * 128 / 8, gt, stride);
    for (int row0 = gw * 4; row0 < 2 * DEPTH * NEXP; row0 += NGW * 4) {
        f32x4 v[4][4]; float m[4];
#pragma unroll
        for (int rr = 0; rr < 4; ++rr) { const int row = row0 + rr, tab = row >> 16, lrow = row & 65535;
            const f32x4* src = (const f32x4*)((tab ? Ap->in[I_PEER_V] : Ap->in[I_PEER_U]) + (size_t)lrow * DM) + lane;
#pragma unroll
            for (int j = 0; j < 4; ++j) v[rr][j] = __builtin_nontemporal_load(src + 64 * j); }
#pragma unroll
        for (int rr = 0; rr < 4; ++rr) { float mm = 0.f;
#pragma unroll
            for (int j = 0; j < 4; ++j) mm = fmaxf(fmaxf(mm, fmaxf(fabsf(v[rr][j][0]), fabsf(v[rr][j][1]))), fmaxf(fabsf(v[rr][j][2]), fabsf(v[rr][j][3])));
#pragma unroll
            for (int o = 1; o < 64; o <<= 1) mm = fmaxf(mm, __shfl_xor(mm, o));
            m[rr] = mm; }
#pragma unroll
        for (int rr = 0; rr < 4; ++rr) { const int row = row0 + rr, tab = row >> 16, lrow = row & 65535, l = lrow >> 14, e = lrow & (NEXP - 1);
            {
                const float S = m[rr] > 0.f ? (6.0f / 0.9f) / m[rr] : 1.0f;
                unsigned char* dstt = ws + (tab ? WS_TABV : WS_TABU);
#pragma unroll
                for (int j = 0; j < 4; ++j) { unsigned pk = e2m1_code(v[rr][j][0] * S) | (e2m1_code(v[rr][j][1] * S) << 4) | (e2m1_code(v[rr][j][2] * S) << 8) | (e2m1_code(v[rr][j][3] * S) << 12);
                    pk |= (unsigned)__shfl_xor((int)pk, 1) << 16;
                    if (!(lane & 1)) *(unsigned*)(dstt + (((size_t)l * 4 + j) * NEXP + e) * 128 + 2 * lane) = pk; }
            }
            if (lane == 0) ((unsigned short*)(ws + WS_SCU))[2 * lrow + tab] = (unsigned short)(cvt_pk_bf16(m[rr] > 0.f ? m[rr] * (0.9f / 6.0f) : 1.0f, 0.f) & 0xffffu); }
    }
    for (size_t i = gt; i < (size_t)2 * 4 * 256 * 256 / 8; i += stride) { const size_t idx = i * 8; const int l = (int)(idx >> 18), g = (int)(idx >> 16) & 3, j0 = (int)idx & 255;
        const f32x4 a = *((const f32x4*)Ap->in[I_POOL_WGRP] + 2 * i), b = *((const f32x4*)Ap->in[I_POOL_WGRP] + 2 * i + 1);
        const float* sp = Ap->in[I_POOL_SCALE] + (size_t)l * DM + 256 * g + j0; const f32x4 sa = *(const f32x4*)sp, sb = *(const f32x4*)(sp + 4);
        u32x4 o; o.x = cvt_pk_bf16(a[0] * sa[0], a[1] * sa[1]); o.y = cvt_pk_bf16(a[2] * sa[2], a[3] * sa[3]); o.z = cvt_pk_bf16(b[0] * sb[0], b[1] * sb[1]); o.w = cvt_pk_bf16(b[2] * sb[2], b[3] * sb[3]);
        *((u32x4*)(ws + WS_WGS) + i) = o; }
    __syncthreads();
    LAS float* cond = (LAS float*)lds;
    for (int i = tid; i < BATCH * DM; i += NTHREADS) { const int b = i >> 10, k = i & 1023; const float c = Ap->in[I_C][i]; cond[k * 8 + b] = c * __builtin_amdgcn_rcpf(1.0f + __expf(-c)); }
    __syncthreads();
    float* modp = (float*)(ws + WS_ADAP);
    for (int it = gw; it < DEPTH * 24 * 16; it += NGW) {
        const int l = it / 384, r = it % 384, cgp = r >> 4, kc = r & 15;
        const float* wp = Ap->in[I_ADA_W] + ((size_t)l * DM + kc * 64) * (6 * DM) + cgp * 256 + 4 * lane;
        f32x4 acc[8];
#pragma unroll
        for (int b = 0; b < 8; ++b) acc[b] = (f32x4){0.f, 0.f, 0.f, 0.f};
#pragma unroll 8
        for (int k = 0; k < 64; ++k) { const f32x4 w = __builtin_nontemporal_load((const f32x4*)(wp + (size_t)k * (6 * DM)));
            const f32x4 c0 = *(const LAS f32x4*)(cond + (kc * 64 + k) * 8), c1 = *(const LAS f32x4*)(cond + (kc * 64 + k) * 8 + 4);
            acc[0] += c0[0] * w; acc[1] += c0[1] * w; acc[2] += c0[2] * w; acc[3] += c0[3] * w; acc[4] += c1[0] * w; acc[5] += c1[1] * w; acc[6] += c1[2] * w; acc[7] += c1[3] * w; }
#pragma unroll
        for (int b = 0; b < 8; ++b) *(f32x4*)(modp + (((size_t)kc * DEPTH + l) * 8 + b) * (6 * DM) + cgp * 256 + 4 * lane) = acc[b];
    }
}
__device__ __forceinline__ void modreduce_phase(ArgP Ap, int vcu, int G, int tid) {
    unsigned char* ws = Ap->ws; const float* modp = (const float*)(ws + WS_ADAP); float* mod = (float*)(ws + WS_MOD);
    constexpr int N4 = DEPTH * BATCH * 6 * DM / 4;
    for (int i = vcu * NTHREADS + tid; i < N4; i += G * NTHREADS) {
        const int n4 = i % (6 * DM / 4), l = i / (BATCH * 6 * DM / 4);
        f32x4 a = *((const f32x4*)(Ap->in[I_ADA_B] + (size_t)l * 6 * DM) + n4);
#pragma unroll
        for (int kc = 0; kc < 16; ++kc) a += *((const f32x4*)modp + (size_t)kc * N4 + i);
        *((f32x4*)mod + i) = a; }
}

__device__ __forceinline__ void norm_phase(const float* x, const float* gn, const float* macc  , const float* mbias  , int sh_off, int sc_off, bf16_t* H, int gw, int NGW, int lane) {
    for (int ch = gw; ch < MTOK / 16; ch += NGW) {
        const int row0 = ch * 16, b = row0 >> 12;
        f32x4 c1[4], shv[4];
#pragma unroll
        for (int j = 0; j < 4; ++j) { const int col = 4 * lane + 256 * j;
            const f32x4 sc = *(const f32x4*)(macc + (size_t)b * 6 * DM + sc_off + col);
            c1[j] = *(const f32x4*)(gn + col) * (1.0f + sc);
            shv[j] = *(const f32x4*)(macc + (size_t)b * 6 * DM + sh_off + col); }
        for (int r = row0; r < row0 + 16; ++r) {
            const f32x4* xr = (const f32x4*)(x + (size_t)r * DM) + lane;
            f32x4 v[4]; float ss = 0.f;
#pragma unroll
            for (int j = 0; j < 4; ++j) { v[j] = xr[64 * j]; ss += (v[j][0] * v[j][0] + v[j][1] * v[j][1]) + (v[j][2] * v[j][2] + v[j][3] * v[j][3]); }
            const float rstd = __builtin_amdgcn_rsqf(wave_sum_all(ss) * (1.0f / DM) + EPS);
            u32x2* o8 = (u32x2*)(H + (size_t)r * DM) + lane;
#pragma unroll
            for (int j = 0; j < 4; ++j) { const f32x4 o = v[j] * rstd * c1[j] + shv[j]; u32x2 w; w.x = cvt_pk_bf16(o[0], o[1]); w.y = cvt_pk_bf16(o[2], o[3]); o8[64 * j] = w; }
        }
    }
}
__device__ __forceinline__ void resnorm_phase(const float* xf  , const bf16_t* xsi, bf16_t* xso  , const bf16_t* Y, const float* gate  , const float* gn, const float* macc, int sh_off, int sc_off, bf16_t* H, int gw, int NGW, int lane) {
    for (int ch = gw; ch < MTOK / 16; ch += NGW) {
        const int row0 = ch * 16, b = row0 >> 12;
        f32x4 c1[4], shv[4], gt[4];
#pragma unroll
        for (int j = 0; j < 4; ++j) { const int col = 4 * lane + 256 * j;
            const f32x4 sc = *(const f32x4*)(macc + (size_t)b * 6 * DM + sc_off + col);
            c1[j] = *(const f32x4*)(gn + col) * (1.0f + sc);
            shv[j] = *(const f32x4*)(macc + (size_t)b * 6 * DM + sh_off + col);
            gt[j] = *(const f32x4*)(gate + (size_t)b * 6 * DM + col); }
#pragma unroll 1
        for (int r0 = row0; r0 < row0 + 16; r0 += 4) {
            u32x2 yv[4][4]; f32x4 v[4][4];
#pragma unroll
            for (int rr = 0; rr < 4; ++rr) { const u32x2* yr = (const u32x2*)(Y + (size_t)(r0 + rr) * DM) + lane;
#pragma unroll
                for (int j = 0; j < 4; ++j) yv[rr][j] = yr[64 * j]; }
            if (xf) {
#pragma unroll
                for (int rr = 0; rr < 4; ++rr) { const f32x4* xr = (const f32x4*)(xf + (size_t)(r0 + rr) * DM) + lane;
#pragma unroll
                    for (int j = 0; j < 4; ++j) v[rr][j] = xr[64 * j]; } }
            else { u32x2 xv[4][4];
#pragma unroll
                for (int rr = 0; rr < 4; ++rr) { const u32x2* xr = (const u32x2*)(xsi + (size_t)(r0 + rr) * DM) + lane;
#pragma unroll
                    for (int j = 0; j < 4; ++j) xv[rr][j] = xr[64 * j]; }
#pragma unroll
                for (int rr = 0; rr < 4; ++rr)
#pragma unroll
                    for (int j = 0; j < 4; ++j) v[rr][j] = (f32x4){bf_lo(xv[rr][j].x), bf_hi(xv[rr][j].x), bf_lo(xv[rr][j].y), bf_hi(xv[rr][j].y)}; }
            float ss[4];
#pragma unroll
            for (int rr = 0; rr < 4; ++rr) { float q = 0.f;
#pragma unroll
                for (int j = 0; j < 4; ++j) { const u32x2 y = yv[rr][j]; v[rr][j] += gt[j] * (f32x4){bf_lo(y.x), bf_hi(y.x), bf_lo(y.y), bf_hi(y.y)};
                    q += (v[rr][j][0] * v[rr][j][0] + v[rr][j][1] * v[rr][j][1]) + (v[rr][j][2] * v[rr][j][2] + v[rr][j][3] * v[rr][j][3]); }
                ss[rr] = q; }
#pragma unroll
            for (int o = 1; o < 64; o <<= 1) {
#pragma unroll
                for (int rr = 0; rr < 4; ++rr) ss[rr] += __shfl_xor(ss[rr], o); }
#pragma unroll
            for (int rr = 0; rr < 4; ++rr) { const int r = r0 + rr; const float rstd = __builtin_amdgcn_rsqf(ss[rr] * (1.0f / DM) + EPS);
                u32x2* xw = (u32x2*)(xso + (size_t)r * DM) + lane; u32x2* o8 = (u32x2*)(H + (size_t)r * DM) + lane;
#pragma unroll
                for (int j = 0; j < 4; ++j) { u32x2 w; w.x = cvt_pk_bf16(v[rr][j][0], v[rr][j][1]); w.y = cvt_pk_bf16(v[rr][j][2], v[rr][j][3]); xw[64 * j] = w;
                    const f32x4 o = v[rr][j] * rstd * c1[j] + shv[j]; w.x = cvt_pk_bf16(o[0], o[1]); w.y = cvt_pk_bf16(o[2], o[3]); o8[64 * j] = w; } }
        }
    }
}
__device__ __forceinline__ void final_phase(float* x, const float* gf, int gw, int NGW, int lane) {
    f32x4 gv[4];
#pragma unroll
    for (int j = 0; j < 4; ++j) gv[j] = *(const f32x4*)(gf + 4 * lane + 256 * j);
    for (int r = gw; r < MTOK; r += NGW) {
        f32x4* xr = (f32x4*)(x + (size_t)r * DM) + lane;
        f32x4 v[4]; float ss = 0.f;
#pragma unroll
        for (int j = 0; j < 4; ++j) { v[j] = xr[64 * j]; ss += (v[j][0] * v[j][0] + v[j][1] * v[j][1]) + (v[j][2] * v[j][2] + v[j][3] * v[j][3]); }
        const float rstd = __builtin_amdgcn_rsqf(wave_sum_all(ss) * (1.0f / DM) + EPS);
#pragma unroll
        for (int j = 0; j < 4; ++j) xr[64 * j] = v[j] * rstd * gv[j];
    }
}

__device__ __forceinline__ void unpack8(const u32x4 w, float (&f)[8]) { f[0] = bf_lo(w.x); f[1] = bf_hi(w.x); f[2] = bf_lo(w.y); f[3] = bf_hi(w.y); f[4] = bf_lo(w.z); f[5] = bf_hi(w.z); f[6] = bf_lo(w.w); f[7] = bf_hi(w.w); }
__device__ __forceinline__ u32x4 pack8(const float (&f)[8]) { u32x4 o; o.x = cvt_pk_bf16(f[0], f[1]); o.y = cvt_pk_bf16(f[2], f[3]); o.z = cvt_pk_bf16(f[4], f[5]); o.w = cvt_pk_bf16(f[6], f[7]); return o; }
__device__ __forceinline__ void pool_elem_phase(const bf16_t* U, bf16_t* P, int vcu, int G, int tid) {
    const int chunk = tid & 127, run = tid >> 7, c0 = 8 * chunk, w = 2 << (c0 >> 8);
    for (int unit = vcu; unit < MTOK / 128; unit += G) {
        const int t0 = unit * 128 + run * 32, seq0 = t0 & ~(SEQ - 1);
        float s[8];
#pragma unroll
        for (int j = 0; j < 8; ++j) s[j] = 0.f;
        for (int tau = t0 - w; tau < t0; ++tau) if (tau >= seq0) { float f[8];     unpack8(*(const u32x4*)(U + (size_t)tau * DM + c0), f);
#pragma unroll
            for (int j = 0; j < 8; ++j) s[j] += f[j]; }
#pragma unroll 1
        for (int tb = t0; tb < t0 + 32; tb += 8) {
            u32x4 cur[8], old[8];
#pragma unroll
            for (int i = 0; i < 8; ++i) { cur[i] = *(const u32x4*)(U + (size_t)(tb + i) * DM + c0);
                const int tl = tb + i - w; old[i] = *(const u32x4*)(U + (size_t)(tl >= seq0 ? tl : seq0) * DM + c0); }
#pragma unroll
            for (int i = 0; i < 8; ++i) { const int t = tb + i; float f[8], o[8]; unpack8(cur[i], f);
#pragma unroll
                for (int j = 0; j < 8; ++j) s[j] += f[j];
                if (t - w >= seq0) { float q[8]; unpack8(old[i], q);
#pragma unroll
                    for (int j = 0; j < 8; ++j) s[j] -= q[j]; }
                const int pos1 = t - seq0 + 1; const float inv = 1.0f / (float)(pos1 < w ? pos1 : w);
#pragma unroll
                for (int j = 0; j < 8; ++j) o[j] = s[j] * inv - f[j];
                *(u32x4*)(P + (size_t)t * DM + c0) = pack8(o); }
        }
    }
}
__device__ __forceinline__ void conv_elem_phase(const bf16_t* BG, const bf16_t* Z, const float* cw  , bf16_t* Aout, int vcu, int G, int tid) {
    const int chunk = tid & 127, run = tid >> 7, c0 = 8 * chunk;
    float w0[8], w1[8], w2[8];
#pragma unroll
    for (int j = 0; j < 8; ++j) { w0[j] = cw[c0 + j]; w1[j] = cw[DM + c0 + j]; w2[j] = cw[2 * DM + c0 + j]; }
    for (int unit = vcu; unit < MTOK / 128; unit += G) {
        const int t0 = unit * 128 + run * 32, seq0 = t0 & ~(SEQ - 1);
        float zm2[8], zm1[8];
#pragma unroll
        for (int j = 0; j < 8; ++j) { zm2[j] = 0.f; zm1[j] = 0.f; }
        if (t0 - 2 >= seq0) unpack8(*(const u32x4*)(Z + (size_t)(t0 - 2) * DM + c0), zm2);
        if (t0 - 1 >= seq0) unpack8(*(const u32x4*)(Z + (size_t)(t0 - 1) * DM + c0), zm1);
#pragma unroll 1
        for (int tb = t0; tb < t0 + 32; tb += 8) {
            u32x4 zr[8], br[8];
#pragma unroll
            for (int i = 0; i < 8; ++i) { zr[i] = *(const u32x4*)(Z + (size_t)(tb + i) * DM + c0); br[i] = *(const u32x4*)(BG + (size_t)(tb + i) * DM + c0); }
#pragma unroll
            for (int i = 0; i < 8; ++i) { float z[8], bg[8], o[8]; unpack8(zr[i], z); unpack8(br[i], bg);
#pragma unroll
                for (int j = 0; j < 8; ++j) { o[j] = bg[j] * (w0[j] * zm2[j] + w1[j] * zm1[j] + w2[j] * z[j]); zm2[j] = zm1[j]; zm1[j] = z[j]; }
                *(u32x4*)(Aout + (size_t)(tb + i) * DM + c0) = pack8(o); }
        }
    }
}

__device__ __forceinline__ int wp_off(int row, int chunk) { return row * 256 + ((chunk ^ (row & 15)) << 4); }
__device__ __forceinline__ void mix_phase(LAS unsigned char* lds, bf16_t* UA, const bf16_t* VT, const float* WS, const float* BS, const float* LNG, const float* LNB, int vcu, int G, int tid, int wid, int lane) {
    LAS unsigned char* WP = lds;
    LAS float* MU = (LAS float*)(lds + 32768); LAS float* RSTD = MU + 128; LAS float* R1 = MU + 256; LAS float* R2 = MU + 384;
    LAS float* PART = (LAS float*)(lds + 36864);
    LAS unsigned char* VS = lds + 36864;
    for (int n = vcu; n < MTOK / 128; n += G) {
        {
            const int cgp = tid >> 4, tl = tid & 15;
            float s[8], q[8];
#pragma unroll
            for (int j = 0; j < 8; ++j) { s[j] = 0.f; q[j] = 0.f; }
#pragma unroll 4
            for (int it = 0; it < GH / 32; ++it) { float f[8]; unpack8(*(const u32x4*)(VT + ((size_t)n * GH + it * 32 + cgp) * 128 + tl * 8), f);
#pragma unroll
                for (int j = 0; j < 8; ++j) { s[j] += f[j]; q[j] += f[j] * f[j]; } }
#pragma unroll
            for (int j = 0; j < 8; ++j) { PART[(cgp * 128 + tl * 8 + j) * 2] = s[j]; PART[(cgp * 128 + tl * 8 + j) * 2 + 1] = q[j]; }
            __syncthreads();
            if (tid < 128) { float S = 0.f, Q = 0.f;
                for (int k = 0; k < 32; ++k) { S += PART[(k * 128 + tid) * 2]; Q += PART[(k * 128 + tid) * 2 + 1]; }
                const float mu = S * (1.0f / GH), var = Q * (1.0f / GH) - mu * mu; MU[tid] = mu; RSTD[tid] = __builtin_amdgcn_rsqf(fmaxf(var, 0.f) + EPS); }
            __syncthreads();
        }
        for (int g = 0; g < 8; ++g) {
            const int fr = lane & 15, fq = lane >> 4, cbase = g * 384 + wid * 48;
            bf16x8 av[4][3];
#pragma unroll
            for (int ks = 0; ks < 4; ++ks)
#pragma unroll
                for (int ct = 0; ct < 3; ++ct) av[ks][ct] = *(const bf16x8*)(VT + ((size_t)n * GH + cbase + ct * 16 + fr) * 128 + ks * 32 + fq * 8);
            {
                const int i = tid >> 2, part = tid & 3;
                const float* wrow = WS + ((size_t)g * 128 + i) * 128 + part * 32;
                float r1 = 0.f, r2 = 0.f;
#pragma unroll
                for (int jj = 0; jj < 32; jj += 8) { const int j0 = part * 32 + jj;
                    f32x4 a = *(const f32x4*)(wrow + jj), b = *(const f32x4*)(wrow + jj + 4);
                    if (i < 64 && j0 >= 64) { a = (f32x4){0.f, 0.f, 0.f, 0.f}; b = a; }
                    const f32x4 ra = *(const LAS f32x4*)(RSTD + j0), rb = *(const LAS f32x4*)(RSTD + j0 + 4), ma = *(const LAS f32x4*)(MU + j0), mb = *(const LAS f32x4*)(MU + j0 + 4);
                    const f32x4 wa = a * ra, wb = b * rb;
                    r1 += (wa[0] * ma[0] + wa[1] * ma[1]) + (wa[2] * ma[2] + wa[3] * ma[3]) + (wb[0] * mb[0] + wb[1] * mb[1]) + (wb[2] * mb[2] + wb[3] * mb[3]);
                    r2 += (a[0] + a[1]) + (a[2] + a[3]) + (b[0] + b[1]) + (b[2] + b[3]);
                    u32x4 o; o.x = cvt_pk_bf16(wa[0], wa[1]); o.y = cvt_pk_bf16(wa[2], wa[3]); o.z = cvt_pk_bf16(wb[0], wb[1]); o.w = cvt_pk_bf16(wb[2], wb[3]);
                    *(LAS u32x4*)(WP + wp_off(i, j0 >> 3)) = o; }
                r1 += __shfl_xor(r1, 1); r1 += __shfl_xor(r1, 2); r2 += __shfl_xor(r2, 1); r2 += __shfl_xor(r2, 2);
                if (part == 0) { R1[i] = r1; R2[i] = r2; }
            }
            __syncthreads();
            f32x4 acc[3][8];
#pragma unroll
            for (int ct = 0; ct < 3; ++ct)
#pragma unroll
                for (int it = 0; it < 8; ++it) acc[ct][it] = (f32x4){0.f, 0.f, 0.f, 0.f};
#pragma unroll
            for (int ks = 0; ks < 4; ++ks) {
#pragma unroll
                for (int it = 0; it < 8; ++it) { const bf16x8 bw = *(const LAS bf16x8*)(WP + wp_off(it * 16 + fr, ks * 4 + fq));
#pragma unroll
                    for (int ct = 0; ct < 3; ++ct) acc[ct][it] = __builtin_amdgcn_mfma_f32_16x16x32_bf16(av[ks][ct], bw, acc[ct][it], 0, 0, 0); }
                __builtin_amdgcn_sched_barrier(0);
            }
#pragma unroll
            for (int ct = 0; ct < 3; ++ct) { const int c4 = cbase + ct * 16 + 4 * fq;
                const f32x4 lg = *(const f32x4*)(LNG + c4), lb = *(const f32x4*)(LNB + c4);
#pragma unroll
                for (int it = 0; it < 8; ++it) { const int i = it * 16 + fr; const float r1 = R1[i], r2 = R2[i], bs = BS[g * 128 + i];
                    const f32x4 vs = lg * (acc[ct][it] - r1) + lb * r2 + bs;
                    u32x2 o; o.x = cvt_pk_bf16(vs[0], vs[1]); o.y = cvt_pk_bf16(vs[2], vs[3]);
                    *(LAS u32x2*)(VS + i * 784 + (wid * 48 + ct * 16 + 4 * fq) * 2) = o; } }
            __syncthreads();
#pragma unroll 4
            for (int c = tid; c < 128 * 48; c += NTHREADS) { const int tok = c / 48, ch8 = c - tok * 48;
                const u32x4 vv = *(const LAS u32x4*)(VS + tok * 784 + ch8 * 16);
                u32x4* up = (u32x4*)(UA + (size_t)(n * 128 + tok) * GH + g * 384 + ch8 * 8); const u32x4 uu = *up;
                u32x4 o; o.x = cvt_pk_bf16(bf_lo(uu.x) * bf_lo(vv.x), bf_hi(uu.x) * bf_hi(vv.x)); o.y = cvt_pk_bf16(bf_lo(uu.y) * bf_lo(vv.y), bf_hi(uu.y) * bf_hi(vv.y));
                o.z = cvt_pk_bf16(bf_lo(uu.z) * bf_lo(vv.z), bf_hi(uu.z) * bf_hi(vv.z)); o.w = cvt_pk_bf16(bf_lo(uu.w) * bf_lo(vv.w), bf_hi(uu.w) * bf_hi(vv.w));
                *up = o; }
            __syncthreads();
        }
    }
}

__device__ __forceinline__ void topk_units(LAS unsigned char* lds, const bf16_t* Q, const bf16_t* KEYS, int* SELI, float* SELW, const pg8::StaticOrder& S, int tid, int wid, int lane) {
    LAS unsigned char* kl = lds;
    LAS float* topv = (LAS float*)(lds + 65536);
    const int p = wid >> 2, sub = wid & 3, tl = lane & 31, hi = lane >> 5;
    int hprev = -1;
#pragma unroll 1
    for (int k = 0; ; k = (k & 1) ? k + 3 : k + 1) {
        pg8::Unit ua, ub; if (!S.next(k, ua)) break;
        const bool hasb = S.next(k + 2, ub);
        const bool pair = hasb && ub.pn == ua.pn;
#pragma unroll 1
        for (int part = 0; part < ((hasb && !pair) ? 2 : 1); ++part) {
            const int h = part ? ub.pn : ua.pn, pm0 = part ? ub.pm : ua.pm, pm1 = ub.pm, ntile = pair ? 4 : 2;
            __syncthreads();
            if (h != hprev) {
                for (int c = tid; c < 4096; c += NTHREADS) { const int row = c >> 4, ch = c & 15;
                    const u32x4 v = *(const u32x4*)(KEYS + ((size_t)h * 256 + row) * 128 + ch * 8);
                    *(LAS u32x4*)(kl + row * 256 + ((ch ^ (row & 15)) << 4)) = v; }
                hprev = h; }
            __syncthreads();
#pragma unroll 1
            for (int t4 = 0; t4 < ntile; ++t4) {
                const int tile = 2 * (t4 < 2 ? pm0 : pm1) + (t4 & 1);
                const bf16_t* qrow = Q + ((size_t)((tile * 8 + h) * 32 + 16 * p + hi) * 128 + sub * 32 + tl) * 8;
                bf16x8 bq[8];
#pragma unroll
                for (int ks = 0; ks < 8; ++ks) bq[ks] = *(const bf16x8*)(qrow + (size_t)ks * 2 * 128 * 8);
                f32x16 acc[4];
#pragma unroll
                for (int kt = 0; kt < 4; ++kt)
#pragma unroll
                    for (int r = 0; r < 16; ++r) acc[kt][r] = 0.f;
#pragma unroll
                for (int ks = 0; ks < 8; ++ks)
#pragma unroll
                    for (int kt = 0; kt < 4; ++kt) { const int row = p * 128 + kt * 32 + tl;
                        const bf16x8 ak = *(const LAS bf16x8*)(kl + row * 256 + (((2 * ks + hi) ^ (row & 15)) << 4));
                        acc[kt] = __builtin_amdgcn_mfma_f32_32x32x16_bf16(ak, bq[ks], acc[kt], 0, 0, 0); }
                float v[64];
#pragma unroll
                for (int kt = 0; kt < 4; ++kt)
#pragma unroll
                    for (int r = 0; r < 16; ++r) { const unsigned key = (unsigned)(kt * 32 + (r & 3) + 8 * (r >> 2) + 4 * hi);
                        v[kt * 16 + r] = __uint_as_float((__float_as_uint(acc[kt][r]) & ~127u) | key); }
                top16_of_64(v);
                float m[16];
#pragma unroll
                for (int i = 0; i < 16; ++i) m[i] = fmaxf(v[i], __shfl_xor(v[15 - i], 32));
                bmerge16_desc<0, 16>(m);
                if (hi == 0) { LAS f32x4* dst = (LAS f32x4*)(topv + ((t4 * 2 + p) * 128 + sub * 32 + tl) * 16);
#pragma unroll
                    for (int i = 0; i < 4; ++i) dst[i] = (f32x4){m[4 * i], m[4 * i + 1], m[4 * i + 2], m[4 * i + 3]}; }
            }
            __syncthreads();
            if (tid < ntile * 128) {
                const int t4 = tid >> 7, tok = tid & 127, tile = 2 * (t4 < 2 ? pm0 : pm1) + (t4 & 1);
                const LAS float* t0 = topv + ((t4 * 2 + 0) * 128 + tok) * 16; const LAS float* t1 = topv + ((t4 * 2 + 1) * 128 + tok) * 16;
                float s0[16], s1[16];
#pragma unroll
                for (int i = 0; i < 4; ++i) { const f32x4 a = *(const LAS f32x4*)(t0 + 4 * i), b = *(const LAS f32x4*)(t1 + 4 * i);
                    s0[4 * i] = a[0]; s0[4 * i + 1] = a[1]; s0[4 * i + 2] = a[2]; s0[4 * i + 3] = a[3]; s1[4 * i] = b[0]; s1[4 * i + 1] = b[1]; s1[4 * i + 2] = b[2]; s1[4 * i + 3] = b[3]; }
                float c[64];
                constexpr int pre[16] = {0, 16, 24, 29, 33, 36, 38, 40, 42, 43, 44, 45, 46, 47, 48, 49};
#pragma unroll
                for (int a = 0; a < 16; ++a)
#pragma unroll
                    for (int b = 0; b < 16; ++b) if ((a + 1) * (b + 1) <= 16) c[pre[a] + b] = __uint_as_float((__float_as_uint(s0[a] + s1[b]) & ~255u) | (unsigned)(a * 16 + b));
#pragma unroll
                for (int i = 50; i < 64; ++i) c[i] = -3.0e38f;
                top16_of_64(c);
                float e[16], sum = 0.f;
#pragma unroll
                for (int kk = 0; kk < 16; ++kk) { e[kk] = __builtin_amdgcn_exp2f((c[kk] - c[0]) * 1.44269504f); sum += e[kk]; }
                const float inv = 1.0f / sum;
                const size_t o = (size_t)(tile * 128 + tok) * NPICK + h * 16;
#pragma unroll
                for (int k4 = 0; k4 < 4; ++k4) { i32x4 ei; f32x4 wv;
#pragma unroll
                    for (int j = 0; j < 4; ++j) { const unsigned code = __float_as_uint(c[4 * k4 + j]) & 255u;
                        const unsigned i1 = __float_as_uint(t0[code >> 4]) & 127u, i2 = __float_as_uint(t1[code & 15u]) & 127u;
                        ei[j] = (int)(i1 * 128u + i2); wv[j] = e[4 * k4 + j] * inv; }
                    *(i32x4*)(SELI + o + 4 * k4) = ei; *(f32x4*)(SELW + o + 4 * k4) = wv; }
            }
        }
    }
    __syncthreads();
}

typedef const unsigned char* cbytes;
#ifndef DUP_MASK
#define DUP_MASK 0
#endif
template <int CTRL> __device__ __forceinline__ float dpp_f(float v) { return __builtin_bit_cast(float, __builtin_amdgcn_update_dpp(0, __builtin_bit_cast(int, v), CTRL, 0xf, 0xf, false)); }
#define DPP_F(v, ctrl) dpp_f<(ctrl)>(v)
#define PG_IDX(EV, TKN) do { const LAS u32x4* _ip = (const LAS u32x4*)(idxw + (TKN) * 128 + 16 * g8); \
        _Pragma("unroll") for (int q = 0; q < 2; ++q) { const u32x4 _e = _ip[q]; _Pragma("unroll") for (int w = 0; w < 4; ++w) { EV[8 * q + 2 * w] = (int)(_e[w] & 0xffffu); EV[8 * q + 2 * w + 1] = (int)(_e[w] >> 16); } } } while (0)
#define PG_GATHER8(BUF, SL, EV, J0) do { _Pragma("unroll") for (int j = 0; j < 8; ++j) BUF[j] = *(const u32x4*)((SL) + ((unsigned)EV[(J0) + j] * 128u + s8 * 16u)); } while (0)
#define PGU_IDX(EV, TKN) do { const LAS u32x4* _ip = (const LAS u32x4*)(idxw + (TKN) * 128 + 16 * slotA); \
        _Pragma("unroll") for (int q = 0; q < 2; ++q) { const u32x4 _e = _ip[q]; _Pragma("unroll") for (int w = 0; w < 4; ++w) { EV[8 * q + 2 * w] = (int)(_e[w] & 0xffffu); EV[8 * q + 2 * w + 1] = (int)(_e[w] >> 16); } } } while (0)
#define PGU_GATHER8(BUF, SL, EV, M0) do { _Pragma("unroll") for (int j = 0; j < 8; ++j) BUF[j] = *(const u32x4*)((SL) + ((unsigned)EV[4 * (((M0) + j) & 3) + (((M0) + j) >> 2)] * 128u + pieceA * 16u)); } while (0)
#define PGU_HB(HR, IT) do { const int _it = (IT) < 63 ? (IT) : 63; const u32x4* _hp = (const u32x4*)(H + (size_t)(tk0 + (_it & 15)) * DM + (((xg + (_it >> 4)) & 3) * 256) + hoffB); HR[0] = _hp[0]; HR[1] = _hp[1]; } while (0)
#define PGU_CVT8(W0, W1) __builtin_amdgcn_cvt_pk_fp8_f32(bf_lo(W1), bf_hi(W1), __builtin_amdgcn_cvt_pk_fp8_f32(bf_lo(W0), bf_hi(W0), 0, false), true)
#define PGU_BOP(BV, HR) do { const int _q0 = PGU_CVT8(HR[0].x, HR[0].y), _q1 = PGU_CVT8(HR[0].z, HR[0].w), _q2 = PGU_CVT8(HR[1].x, HR[1].y), _q3 = PGU_CVT8(HR[1].z, HR[1].w); \
        BV = (i32x8){blo ? _q0 : 0, blo ? _q1 : 0, blo ? _q2 : 0, blo ? _q3 : 0, bhi ? _q0 : 0, bhi ? _q1 : 0, bhi ? _q2 : 0, bhi ? _q3 : 0}; } while (0)
#define PGU_MMA8(BUF, _b, ACC, M0) do { \
        _Pragma("unroll") for (int j = 0; j < 8; ++j) { const u32x4 _u = BUF[j]; const i32x8 _a = {(int)_u.x, (int)_u.y, (int)_u.z, (int)_u.w, 0, 0, 0, 0}; \
            const f32x4 _d = __builtin_amdgcn_mfma_scale_f32_16x16x128_f8f6f4(_a, _b, (f32x4){0.f, 0.f, 0.f, 0.f}, 4, 0, 0, 0, 0, 0); \
            float _v = i4 == 0 ? _d[0] : i4 == 1 ? _d[1] : i4 == 2 ? _d[2] : _d[3]; _v += DPP_F(_v, 0xB1); _v += DPP_F(_v, 0x4E); \
            ACC[((M0) + j) >> 2] = (i4 == (((M0) + j) & 3)) ? _v : ACC[((M0) + j) >> 2]; } } while (0)
#define PGU_DOTS(ACC, TKN) do { if (n16 < 8) { LAS f32x4* _dp = (LAS f32x4*)(dotw + (TKN) * 128 + 32 * c4 + 4 * n16); *_dp += ACC; } } while (0)
#define PG_VCOMP8(BUF, CV, J0) do { _Pragma("unroll") for (int j = 0; j < 8; ++j) { const u32x4 v = BUF[j]; const float c = CV[(J0) + j]; \
            acc[0] += c * __builtin_amdgcn_cvt_pk_f32_fp8(v.x, false); acc[1] += c * __builtin_amdgcn_cvt_pk_f32_fp8(v.x, true); \
            acc[2] += c * __builtin_amdgcn_cvt_pk_f32_fp8(v.y, false); acc[3] += c * __builtin_amdgcn_cvt_pk_f32_fp8(v.y, true); \
            acc[4] += c * __builtin_amdgcn_cvt_pk_f32_fp8(v.z, false); acc[5] += c * __builtin_amdgcn_cvt_pk_f32_fp8(v.z, true); \
            acc[6] += c * __builtin_amdgcn_cvt_pk_f32_fp8(v.w, false); acc[7] += c * __builtin_amdgcn_cvt_pk_f32_fp8(v.w, true); } } while (0)
#define PG_COEF(CV, TKN) do { const LAS f32x4* _cp = (const LAS f32x4*)(dotw + (TKN) * 128 + 16 * g8); \
        _Pragma("unroll") for (int q = 0; q < 4; ++q) { const f32x4 _c = _cp[q]; CV[4 * q] = _c[0]; CV[4 * q + 1] = _c[1]; CV[4 * q + 2] = _c[2]; CV[4 * q + 3] = _c[3]; } } while (0)
#define PG_COEF8(CV, TKN, J0) do { const LAS f32x4* _cp = (const LAS f32x4*)(dotw + (TKN) * 128 + 16 * g8 + (J0)); \
        const f32x4 _c0 = _cp[0], _c1 = _cp[1]; CV[0] = _c0[0]; CV[1] = _c0[1]; CV[2] = _c0[2]; CV[3] = _c0[3]; CV[4] = _c1[0]; CV[5] = _c1[1]; CV[6] = _c1[2]; CV[7] = _c1[3]; } while (0)
#define PG_XOFFS(IT) ((size_t)(tk0 + ((IT) & 15)) * DM + (((xg + ((IT) >> 4)) & 7) * 128) + xoff)
#define PG_XADDR(IT) (x + PG_XOFFS(IT))
#define PG_XLOAD(XV, IT) do { XV = *(const unsigned*)PG_XADDR(IT); } while (0)
__device__ __forceinline__ void peer_gather_phase(LAS unsigned char* lds, const bf16_t* H, cbytes TUP, cbytes TVP, const int* SELI, const float* SELW, const unsigned* SC, bf16_t* x  , float* outf  , const float* gacc, const float* gn_next  , const float* mod_next  , bf16_t* Hout, bool last, int vcu, int G, int wid, int lane) {
    const int g8 = lane >> 3, s8 = lane & 7, n16 = lane & 15, c4 = lane >> 4, i4 = lane & 3, slotA = 2 * ((lane >> 2) & 3) + (c4 >> 1), pieceA = 4 * (c4 & 1) + i4, hoffB = 128 * (c4 >> 1) + 32 * i4 + 16 * (c4 & 1);
    const bool blo = n16 < 4, bhi = n16 >= 4 && n16 < 8;
    const bool b3 = (lane & 8) != 0, b4 = (lane & 16) != 0, b5 = (lane & 32) != 0;
    const int xoff = s8 * 16 + 8 * (g8 & 1) + 4 * ((g8 >> 1) & 1) + 2 * (g8 >> 2);
    LAS unsigned short* idxw = (LAS unsigned short*)(lds + wid * 18432);
    LAS unsigned char* stg = lds + wid * 18432 + 4096;
    LAS float* outw = (LAS float*)(lds + wid * 18432 + 13312);
    LAS unsigned char* coefA = lds + wid * 18432 + 14336;
    LAS float* dotw = (LAS float*)(lds + wid * 18432 + 4096);
    for (int blk = vcu; blk < 256; blk += G) {
        const int xg = blk >> 5, tk0 = blk * 128 + wid * 16;
        const int nrep_u = (DUP_MASK & 0x20000) ? opaque(2) : 1;
#pragma unroll 1
        for (int rep_u = 0; rep_u < nrep_u; ++rep_u) {
#pragma unroll 4
        for (int i = 0; i < 16; ++i) { const int e0 = SELI[(size_t)(tk0 + i) * NPICK + lane], e1 = SELI[(size_t)(tk0 + i) * NPICK + 64 + lane];
            idxw[i * 128 + lane] = (unsigned short)e0; idxw[i * 128 + 64 + lane] = (unsigned short)e1; dotw[i * 128 + lane] = 0.f; dotw[i * 128 + 64 + lane] = 0.f; }
        asm volatile("" ::: "memory");
        {
            int ev[16]; u32x4 bufA[8], bufB[8], bufC[8], bufD[8]; u32x4 hr0[2], hr1[2]; i32x8 bop;
            { cbytes sl0 = TUP + (size_t)(xg & 3) * NEXP * 128;
              PGU_IDX(ev, 0); PGU_GATHER8(bufA, sl0, ev, 0); PGU_GATHER8(bufB, sl0, ev, 8);
              PGU_IDX(ev, 1); PGU_GATHER8(bufC, sl0, ev, 0); PGU_GATHER8(bufD, sl0, ev, 8); }
            PGU_HB(hr0, 0); PGU_HB(hr1, 1);
#pragma unroll 1
            for (int it = 0; it < 64; it += 2) {
                const int tkn = it & 15, it2 = it + 2 < 63 ? it + 2 : 63, it3 = it + 3 < 63 ? it + 3 : 63;
                cbytes sl2 = TUP + (size_t)((xg + (it2 >> 4)) & 3) * NEXP * 128;
                f32x4 acc4 = {0.f, 0.f, 0.f, 0.f};
                PGU_IDX(ev, it2 & 15); PGU_BOP(bop, hr0);
                PGU_MMA8(bufA, bop, acc4, 0); __builtin_amdgcn_sched_barrier(0);
                PGU_GATHER8(bufA, sl2, ev, 0); __builtin_amdgcn_sched_barrier(0);
                PGU_MMA8(bufB, bop, acc4, 8); __builtin_amdgcn_sched_barrier(0);
                PGU_GATHER8(bufB, sl2, ev, 8); PGU_HB(hr0, it + 2); __builtin_amdgcn_sched_barrier(0);
                PGU_DOTS(acc4, tkn);
                acc4 = (f32x4){0.f, 0.f, 0.f, 0.f};
                PGU_IDX(ev, it3 & 15); PGU_BOP(bop, hr1);
                PGU_MMA8(bufC, bop, acc4, 0); __builtin_amdgcn_sched_barrier(0);
                PGU_GATHER8(bufC, sl2, ev, 0); __builtin_amdgcn_sched_barrier(0);
                PGU_MMA8(bufD, bop, acc4, 8); __builtin_amdgcn_sched_barrier(0);
                PGU_GATHER8(bufD, sl2, ev, 8); PGU_HB(hr1, it + 3); __builtin_amdgcn_sched_barrier(0);
                PGU_DOTS(acc4, tkn + 1);
            }
        }
        asm volatile("" ::: "memory");
        }
#pragma unroll 2
        for (int i = 0; i < 16; ++i) {
#pragma unroll
            for (int hh = 0; hh < 2; ++hh) { const int k = 16 * g8 + s8 + 8 * hh; const int e = idxw[i * 128 + k];
                const float w = SELW[(size_t)(tk0 + i) * NPICK + k]; const unsigned sc = SC[e];
                const float cf = w * gelu_tanh(dotw[i * 128 + k] * bf_lo(sc)) * bf_hi(sc);
                const float c64 = fminf(fmaxf(cf * 64.0f, -448.0f), 448.0f);
                coefA[((i * 2 + hh) * 4 + (s8 >> 1)) * 16 + g8 + 8 * (s8 & 1)] = (unsigned char)(__builtin_amdgcn_cvt_pk_fp8_f32(c64, 0.f, 0, false) & 0xff); } }
        asm volatile("" ::: "memory");
        {
            typedef int i32x2v __attribute__((ext_vector_type(2)));
            const int lane = opaque((int)threadIdx.x) & 63, g8 = lane >> 3, s8 = lane & 7, n16 = lane & 15, c4 = lane >> 4;
            const float* gp = gacc + (size_t)(tk0 >> 12) * 6 * DM + 4 * lane;
            const int rowB = 32 * (c4 & 1) + n16;
            int ev[8]; u32x4 bufA[8], bufB[8], bufC[8], bufD[8]; u32x2 xv, gatep; float dv[16]; i32x8 aop;
#define PGM_IDX8(TKN, J0) do { const u32x4 _e = *(const LAS u32x4*)(idxw + (TKN) * 128 + 16 * g8 + (J0)); _Pragma("unroll") for (int w = 0; w < 4; ++w) { ev[2 * w] = (int)(_e[w] & 0xffffu); ev[2 * w + 1] = (int)(_e[w] >> 16); } } while (0)
#define PGM_XADDR(IT) (x + (size_t)(tk0 + ((IT) & 15)) * DM + (((xg + ((IT) >> 4)) & 3) * 256) + 4 * lane)
#define PGM_STAGE(BUF) do { asm volatile("" ::: "memory"); _Pragma("unroll") for (int j = 0; j < 8; ++j) *(LAS u32x4*)(stg + (8 * j + g8) * 144 + 16 * s8) = BUF[j]; asm volatile("" ::: "memory"); } while (0)
#define PGM_AOP(TKN, HH) do { const u32x4 _c = *(const LAS u32x4*)(coefA + (((TKN) * 2 + (HH)) * 4 + c4) * 16); const bool _m0 = n16 == 0; \
        aop = (i32x8){_m0 ? (int)_c.x : 0, _m0 ? (int)_c.y : 0, _m0 ? (int)_c.z : 0, _m0 ? (int)_c.w : 0, 0, 0, 0, 0}; } while (0)
#define PGM_TRP(SET, P) do { tb[SET][0] = __builtin_amdgcn_ds_read_tr4_b64_v2i32((LAS i32x2v*)(stg + rowB * 144 + 16 * (P))); tb[SET][1] = __builtin_amdgcn_ds_read_tr4_b64_v2i32((LAS i32x2v*)(stg + (rowB + 16) * 144 + 16 * (P))); \
        tb[SET][2] = __builtin_amdgcn_ds_read_tr4_b64_v2i32((LAS i32x2v*)(stg + rowB * 144 + 16 * (P) + 8)); tb[SET][3] = __builtin_amdgcn_ds_read_tr4_b64_v2i32((LAS i32x2v*)(stg + (rowB + 16) * 144 + 16 * (P) + 8)); } while (0)
#define PGM_MMP(SET, P, FIRST) do { _Pragma("unroll") for (int q = 0; q < 2; ++q) { const i32x8 _b = {tb[SET][2 * q].x, tb[SET][2 * q].y, tb[SET][2 * q + 1].x, tb[SET][2 * q + 1].y, 0, 0, 0, 0}; \
            const f32x4 _d = __builtin_amdgcn_mfma_scale_f32_16x16x128_f8f6f4(aop, _b, (f32x4){0.f, 0.f, 0.f, 0.f}, 0, 4, 0, 0, 0, 0); \
            dv[2 * (P) + q] = (FIRST) ? _d[0] : dv[2 * (P) + q] + _d[0]; } } while (0)
#define PGM_MMA16(FIRST) do { i32x2v tb[2][4]; PGM_TRP(0, 0); \
        _Pragma("unroll") for (int P = 0; P < 8; ++P) { if (P < 7) { if (P & 1) PGM_TRP(0, P + 1); else PGM_TRP(1, P + 1); } \
            if (P & 1) PGM_MMP(1, P, FIRST); else PGM_MMP(0, P, FIRST); __builtin_amdgcn_sched_barrier(0); } } while (0)
#define PGM_OUT(XV, IT) do { asm volatile("" ::: "memory"); if (lane < 16) { _Pragma("unroll") for (int cb = 0; cb < 16; ++cb) outw[16 * cb + lane] = dv[cb]; } asm volatile("" ::: "memory"); \
            const f32x4 _o = *(const LAS f32x4*)(outw + 4 * lane) * (1.0f / 64.0f); asm volatile("" ::: "memory"); \
            const f32x4 _xn = (f32x4){bf_lo(XV.x), bf_hi(XV.x), bf_lo(XV.y), bf_hi(XV.y)} + (f32x4){bf_lo(gatep.x), bf_hi(gatep.x), bf_lo(gatep.y), bf_hi(gatep.y)} * _o; \
            u32x2 _w; _w.x = cvt_pk_bf16(_xn[0], _xn[1]); _w.y = cvt_pk_bf16(_xn[2], _xn[3]); *(u32x2*)PGM_XADDR(IT) = _w; } while (0)
            { cbytes sl0 = TVP + (size_t)(xg & 3) * NEXP * 128;
              PGM_IDX8(0, 0); PG_GATHER8(bufA, sl0, ev, 0); PGM_IDX8(0, 8); PG_GATHER8(bufB, sl0, ev, 0);
              PGM_IDX8(1, 0); PG_GATHER8(bufC, sl0, ev, 0); PGM_IDX8(1, 8); PG_GATHER8(bufD, sl0, ev, 0); }
#pragma unroll 1
            for (int it = 0; it < 64; it += 2) {
                const int tkn = it & 15, it2 = it + 2 < 63 ? it + 2 : 63, it3 = it + 3 < 63 ? it + 3 : 63, sl = (xg + (it >> 4)) & 3;
                cbytes sl2 = TVP + (size_t)((xg + (it2 >> 4)) & 3) * NEXP * 128;
                PGM_IDX8(it2 & 15, 0); xv = *(const u32x2*)PGM_XADDR(it); { const f32x4 _g = *(const f32x4*)(gp + sl * 256); gatep.x = cvt_pk_bf16(_g[0], _g[1]); gatep.y = cvt_pk_bf16(_g[2], _g[3]); }
                PGM_STAGE(bufA); PG_GATHER8(bufA, sl2, ev, 0); PGM_AOP(tkn, 0); PGM_MMA16(true);
                PGM_IDX8(it2 & 15, 8);
                PGM_STAGE(bufB); PG_GATHER8(bufB, sl2, ev, 0); PGM_AOP(tkn, 1); PGM_MMA16(false);
                PGM_OUT(xv, it);
                PGM_IDX8(it3 & 15, 0); xv = *(const u32x2*)PGM_XADDR(it + 1); { const f32x4 _g = *(const f32x4*)(gp + sl * 256); gatep.x = cvt_pk_bf16(_g[0], _g[1]); gatep.y = cvt_pk_bf16(_g[2], _g[3]); }
                PGM_STAGE(bufC); PG_GATHER8(bufC, sl2, ev, 0); PGM_AOP(tkn + 1, 0); PGM_MMA16(true);
                PGM_IDX8(it3 & 15, 8);
                PGM_STAGE(bufD); PG_GATHER8(bufD, sl2, ev, 0); PGM_AOP(tkn + 1, 1); PGM_MMA16(false);
                PGM_OUT(xv, it + 1);
            }
#undef PGM_IDX8
#undef PGM_XADDR
#undef PGM_STAGE
#undef PGM_AOP
#undef PGM_MMA16
#undef PGM_TRP
#undef PGM_MMP
#undef PGM_OUT
        }
        asm volatile("s_waitcnt vmcnt(0)" ::: "memory");
        {
            const int lane = opaque((int)threadIdx.x) & 63;
            const int b = tk0 >> 12;
            f32x4 c1[4], shv[4];
#pragma unroll
            for (int j = 0; j < 4; ++j) { const int col = 4 * lane + 256 * j;
                if (last) { c1[j] = *(const f32x4*)(gn_next + col); shv[j] = (f32x4){0.f, 0.f, 0.f, 0.f}; }
                else { c1[j] = *(const f32x4*)(gn_next + col) * (1.0f + *(const f32x4*)(mod_next + (size_t)b * 6 * DM + DM + col)); shv[j] = *(const f32x4*)(mod_next + (size_t)b * 6 * DM + col); } }
#pragma unroll 1
            for (int i0 = 0; i0 < 16; i0 += 4) {
                f32x4 v[4][4]; float ss[4];
#pragma unroll
                for (int rr = 0; rr < 4; ++rr) { const u32x2* xr = (const u32x2*)(x + (size_t)(tk0 + i0 + rr) * DM) + lane;
#pragma unroll
                    for (int j = 0; j < 4; ++j) { const u32x2 xv = xr[64 * j]; v[rr][j] = (f32x4){bf_lo(xv.x), bf_hi(xv.x), bf_lo(xv.y), bf_hi(xv.y)}; } }
#pragma unroll
                for (int rr = 0; rr < 4; ++rr) { float q = 0.f;
#pragma unroll
                    for (int j = 0; j < 4; ++j) q += (v[rr][j][0] * v[rr][j][0] + v[rr][j][1] * v[rr][j][1]) + (v[rr][j][2] * v[rr][j][2] + v[rr][j][3] * v[rr][j][3]);
                    ss[rr] = q; }
#pragma unroll
                for (int o = 1; o < 64; o <<= 1) {
#pragma unroll
                    for (int rr = 0; rr < 4; ++rr) ss[rr] += __shfl_xor(ss[rr], o); }
#pragma unroll
                for (int rr = 0; rr < 4; ++rr) { const int r = tk0 + i0 + rr; const float rstd = __builtin_amdgcn_rsqf(ss[rr] * (1.0f / DM) + EPS);
                    if (last) { f32x4* xr = (f32x4*)(outf + (size_t)r * DM) + lane;
#pragma unroll
                        for (int j = 0; j < 4; ++j) xr[64 * j] = v[rr][j] * rstd * c1[j]; }
                    else { u32x2* o8 = (u32x2*)(Hout + (size_t)r * DM) + lane;
#pragma unroll
                        for (int j = 0; j < 4; ++j) { const f32x4 o = v[rr][j] * rstd * c1[j] + shv[j]; u32x2 w; w.x = cvt_pk_bf16(o[0], o[1]); w.y = cvt_pk_bf16(o[2], o[3]); o8[64 * j] = w; } } }
            }
        }
    }
}
#undef PG_IDX
#undef PG_GATHER8
#undef PGU_IDX
#undef PGU_GATHER8
#undef PGU_HB
#undef PGU_CVT8
#undef PGU_BOP
#undef PGU_MMA8
#undef PGU_DOTS
#undef PG_VCOMP8
#undef PG_COEF
#undef PG_COEF8
#undef PG_XADDR
#undef PG_XOFFS
#undef PG_XLOAD

constexpr size_t WS_BAR = 768 * 1024;
#define XB_TMO      128
#define XB_XCNT(j)  (256  + 64 * (j))
#define XB_XSUB(j)  (1280 + 64 * (j))
#define XB_XGEN(j)  (2304 + 64 * (j))
#define XB_TOP      3328
#define XB_TOPGEN   3392
#define XCD_BAR_WORDS 3456
#define XB_SPIN_CAP (1u << 22)
__device__ __forceinline__ unsigned xb_ld(unsigned* p)              { return __hip_atomic_load(p, __ATOMIC_RELAXED, __HIP_MEMORY_SCOPE_AGENT); }
__device__ __forceinline__ unsigned xb_add(unsigned* p, unsigned v) { return __hip_atomic_fetch_add(p, v, __ATOMIC_RELAXED, __HIP_MEMORY_SCOPE_AGENT); }
__device__ __forceinline__ unsigned xb_xcc_id() { return (unsigned)__builtin_amdgcn_s_getreg((3 << 11) | 20) & 0xFu; }
#define XB_SPIN(cond, bar) do { unsigned _sp = 0; while (cond) { __builtin_amdgcn_s_sleep(1); \
    if ((++_sp & 255u) == 0u) { if (xb_ld(&(bar)[XB_TMO])) break; if (_sp > XB_SPIN_CAP) { atomicAdd(&(bar)[XB_TMO], 1u); break; } } } } while (0)
struct XcdBarrier { unsigned* bar; unsigned x; volatile LAS unsigned* st; };
__device__ __forceinline__ void xcd_barrier_complete(unsigned* bar, unsigned x, unsigned& nloc, unsigned& nx) {
    const unsigned G = gridDim.x * gridDim.y * gridDim.z;
    unsigned sum, cnt, mine, sp = 0u;
    for (;;) {
        sum = 0u; cnt = 0u; mine = 0u;
#pragma unroll
        for (unsigned j = 0; j < 16; ++j) { const unsigned c = xb_ld(&bar[XB_XCNT(j)]); sum += c; cnt += (c > 0u) ? 1u : 0u; mine = (j == x) ? c : mine; }
        if (sum == G) break;
        __builtin_amdgcn_s_sleep(1);
        if ((++sp & 255u) == 0u) { if (xb_ld(&bar[XB_TMO])) break; if (sp > XB_SPIN_CAP) { atomicAdd(&bar[XB_TMO], 1u); break; } }
    }
    nloc = mine > 0u ? mine : 1u; nx = cnt > 0u ? cnt : 1u;
}
__device__ __forceinline__ void xcd_barrier(const XcdBarrier& b) {
    asm volatile("s_waitcnt vmcnt(0)" ::: "memory");
    __syncthreads();
    if (threadIdx.x == 0) {
        unsigned* bar = b.bar;
        __builtin_amdgcn_s_waitcnt(0);
        unsigned nloc = b.st[0], nx = b.st[1];
        if (nloc == 0u) { xcd_barrier_complete(bar, b.x, nloc, nx); b.st[0] = nloc; b.st[1] = nx; }
        const unsigned old = xb_add(&bar[XB_XSUB(b.x)], 1u);
        const unsigned gen = old / nloc;
        if (old + 1u == (gen + 1u) * nloc) {
            __builtin_amdgcn_fence(__ATOMIC_RELEASE, "agent");
            asm volatile("s_waitcnt vmcnt(0)" ::: "memory");
            const unsigned og = xb_add(&bar[XB_TOP], 1u);
            const unsigned tg = og / nx;
            if (og + 1u == (tg + 1u) * nx) xb_add(&bar[XB_TOPGEN], 1u);
            else XB_SPIN(xb_ld(&bar[XB_TOPGEN]) == tg, bar);
            __builtin_amdgcn_fence(__ATOMIC_ACQUIRE, "agent");
            xb_add(&bar[XB_XGEN(b.x)], 1u);
            asm volatile("s_waitcnt vmcnt(0)" ::: "memory");
        } else {
            XB_SPIN(xb_ld(&bar[XB_XGEN(b.x)]) == gen, bar);
            __builtin_amdgcn_fence(__ATOMIC_ACQUIRE, "agent");
            asm volatile("s_waitcnt vmcnt(0)" ::: "memory");
        }
    }
    __syncthreads();
}

constexpr int NPHASES = 27;
#ifndef PH_MASK
#define PH_MASK 0xFFFFFF
#endif
#ifndef DUP_MASK
#define DUP_MASK 0
#endif
#ifndef TIME_MASK
#define TIME_MASK 0
#endif
__device__ __forceinline__ int opaque_s(int x) { asm volatile("" : "+s"(x)); return x; }
#define PHM(bit, call) do { if constexpr ((PH_MASK & (bit)) != 0) { if constexpr ((DUP_MASK & (bit)) != 0) { const int _nrep = opaque_s(2); for (int _rep = 0; _rep < _nrep; ++_rep) { call; __syncthreads(); } } else { call; } } } while (0)
__global__ void __launch_bounds__(NTHREADS, 2) trunk_fwd(Args A) {
    extern __shared__ __attribute__((aligned(16))) unsigned char lds_raw[];
    LAS unsigned char* lds = (LAS unsigned char*)lds_raw;
    const int tid0 = threadIdx.x, wid = __builtin_amdgcn_readfirstlane(tid0 >> 6);
    const int G = gridDim.x, bx = blockIdx.x, vcu = (G % 8 == 0) ? (bx % 8) * (G / 8) + bx / 8 : bx;
    const int gw = vcu * 8 + wid, NGW = G * 8;
    const int ph_lo = A.ph_lo, ph_hi = A.ph_hi;
    unsigned long long t_acc = 0;
#if MK_ONE_LAUNCH
    if (tid0 < 2) ((volatile LAS unsigned*)(lds + LDS_XB_OFF))[tid0] = 0u;
    if (bx == 0) { unsigned* b0 = (unsigned*)(A.ws + WS_BAR); for (int i = tid0; i < XCD_BAR_WORDS; i += NTHREADS) b0[i] = 0u; }
#endif

    for (int ph = ph_lo; ph < ph_hi; ++ph) {
        const int tid = opaque(tid0), lane = tid & 63;
        ArgP Ap = (ArgP)__builtin_amdgcn_kernarg_segment_ptr();
        asm volatile("" : "+s"(Ap));
        unsigned char* ws = Ap->ws;
        bf16_t* Hb = (bf16_t*)(ws + WS_H);
        unsigned char* mixb = ws + WS_MIX;
        const float* mod = (const float*)(ws + WS_MOD);
        float* xo = Ap->out;
        int layer, step;
        if (ph < 2) { layer = -1; step = ph; }
        else if (ph < 9) { layer = 0; step = ph - 2; }
        else if (ph < 15) { layer = 1; step = ph - 9 + 1; }
        else if (ph < 21) { layer = 2; step = ph - 15 + 1; }
        else { layer = 3; step = ph - 21 + 1; }
        const int kind = layer % 3, jl = layer / 3;
        unsigned long long t_ph0 = 0; if constexpr (TIME_MASK != 0) t_ph0 = __builtin_amdgcn_s_memrealtime();
        const int nmix = 4;
        int ptype = 0;
        if (layer < 0) ptype = 1; else if (layer > 3) ptype = 2048; else if (step == 0 || step == nmix) ptype = 2;
        else if (step < nmix) ptype = (step == 1) ? 4 : (step == nmix - 1) ? 32 : (kind == 0 && step == 3) ? 16 : 8;
        else ptype = 64 << (step - nmix - 1);
        const float* macc = mod + (size_t)(layer < 0 ? 0 : (layer > 3 ? 3 : layer)) * BATCH * 6 * DM;
        const float* mbias = Ap->in[I_ADA_B] + (size_t)(layer < 0 ? 0 : (layer > 3 ? 3 : layer)) * 6 * DM;
        const float* xin = (layer == 0) ? Ap->in[I_X] : xo;

        if (layer < 0) {
            if (step == 0) { PHM(1, prologue_phase(Ap, lds, vcu, G, tid, wid, lane)); }
            else { PHM(1, modreduce_phase(Ap, vcu, G, tid));
#pragma unroll 1
                for (int pl = 0; pl < 2; ++pl) { pg8::StaticOrder S; pg8::Gemm g{(const bf16_t*)(ws + WS_POOL_WOUT) + (size_t)pl * DM * DM, (const bf16_t*)(ws + WS_WGS) + (size_t)pl * 4 * 65536, DM, DM, 256, DM, 256, 256}; S.init(DM, DM, G, bx);
                    pg8::EpiBf16<0> E{(bf16_t*)(ws + WS_WEFF) + (size_t)pl * DM * DM, DM}; PHM(0x2000, pg8::gemm_phase(lds, g, S, E)); } }
        } else if (layer > 3) {
            PHM(256, final_phase(xo, Ap->in[I_FINAL_G], gw, NGW, lane));
        } else if (step == 0) {
            PHM(2, norm_phase(xin, Ap->in[I_NORM_G] + (size_t)(layer * 2 + 0) * DM, macc, mbias, 0, DM, Hb, gw, NGW, lane));
        } else if (step < nmix) {
            pg8::StaticOrder S;
            if (kind == 0) {
                bf16_t* U = (bf16_t*)mixb; bf16_t* P = (bf16_t*)(mixb + 64 * MiB); bf16_t* Z = (bf16_t*)(mixb + 128 * MiB);
                if (step == 1) { pg8::Gemm g{Hb, (const bf16_t*)(ws + WS_POOL_WIN) + (size_t)jl * DM * DM, MTOK, DM, DM, DM, DM, 0}; S.init(MTOK, DM, G, bx);
                    pg8::EpiBf16<0> E{U, DM}; PHM(0x1000, pg8::gemm_phase(lds, g, S, E)); }
                else if (step == 2) { PHM(8, pool_elem_phase(U, P, vcu, G, tid)); }
                else { pg8::Gemm g{P, (const bf16_t*)(ws + WS_WEFF) + (size_t)jl * DM * DM, MTOK, DM, DM, DM, DM, 0}; S.init(MTOK, DM, G, bx);
                    pg8::EpiBf16<0> E{(bf16_t*)(mixb + 192 * MiB), DM}; PHM(0x8000, pg8::gemm_phase(lds, g, S, E));   }
            } else if (kind == 1) {
                bf16_t* BG = (bf16_t*)mixb; bf16_t* Z = (bf16_t*)(mixb + 64 * MiB); bf16_t* AA = (bf16_t*)(mixb + 128 * MiB);
                if (step == 1) { pg8::Gemm g{Hb, (const bf16_t*)(ws + WS_CONV_WIN), MTOK, 3 * DM, DM, DM, DM, 0}; S.init(MTOK, 3 * DM, G, bx);
                    pg8::EpiConvIn E{BG, Z}; PHM(0x4000, pg8::gemm_phase(lds, g, S, E)); }
                else if (step == 2) { PHM(16, conv_elem_phase(BG, Z, Ap->in[I_CONV_W], AA, vcu, G, tid)); }
                else { pg8::Gemm g{AA, (const bf16_t*)(ws + WS_CONV_WOUT), MTOK, DM, DM, DM, DM, 0}; S.init(MTOK, DM, G, bx);
                    pg8::EpiBf16<0> E{(bf16_t*)(mixb + 192 * MiB), DM}; PHM(0x8000, pg8::gemm_phase(lds, g, S, E));   }
            } else {
                bf16_t* UA = (bf16_t*)mixb; bf16_t* VT = (bf16_t*)(mixb + 192 * MiB);
                if (step == 1) {
                    { pg8::Gemm g{Hb, (const bf16_t*)(ws + WS_GMLP_WIN), MTOK, GH, DM, DM, DM, 0}; S.init(MTOK, GH, G, bx);
                      pg8::EpiBf16<1> E{UA, GH}; PHM(0x1000, pg8::gemm_phase(lds, g, S, E)); }
                    { pg8::Gemm g{Hb, (const bf16_t*)(ws + WS_GMLP_WIN) + (size_t)GH * DM, MTOK, GH, DM, DM, DM, 0}; S.init(MTOK, GH, G, bx);
                      pg8::EpiGmlpV E{VT}; PHM(0x10000, pg8::gemm_phase(lds, g, S, E)); }
                }
                else if (step == 2) { PHM(32, mix_phase(lds, UA, VT, Ap->in[I_GMLP_WS], Ap->in[I_GMLP_BS], Ap->in[I_GMLP_LNG], Ap->in[I_GMLP_LNB], vcu, G, tid, wid, lane)); }
                else { pg8::Gemm g{UA, (const bf16_t*)(ws + WS_GMLP_WOUT), MTOK, DM, GH, GH, GH, 0}; S.init(MTOK, DM, G, bx);
                    pg8::EpiBf16<0> E{(bf16_t*)(mixb + 192 * MiB), DM}; PHM(0x8000, pg8::gemm_phase(lds, g, S, E));   }
            }
        } else {
            const int ps = step - nmix;
            bf16_t* Qb = (bf16_t*)mixb;
            bf16_t* xs = (layer == 3) ? (bf16_t*)(mixb + 192 * MiB) : (bf16_t*)xo;
            if (ps == 0) { resnorm_phase(layer == 0 ? Ap->in[I_X] : nullptr, (const bf16_t*)xo, xs, (const bf16_t*)(mixb + 192 * MiB), macc + 2 * DM, Ap->in[I_NORM_G] + (size_t)(layer * 2 + 1) * DM, macc, 3 * DM, 4 * DM, Hb, gw, NGW, lane); }
            else if (ps == 1) { pg8::StaticOrder S; pg8::Gemm g{Hb, (const bf16_t*)(ws + WS_PEER_WQ) + (size_t)layer * DM * 2048, MTOK, 2048, DM, DM, DM, 0}; S.init(MTOK, 2048, G, bx);
                pg8::EpiQT E{Qb}; PHM(0x1000, pg8::gemm_phase(lds, g, S, E));
                asm volatile("s_waitcnt vmcnt(0)" ::: "memory"); __syncthreads();
                PHM(64, topk_units(lds, Qb, (const bf16_t*)(ws + WS_KEYS) + (size_t)layer * 16 * 128 * 128, (int*)(ws + WS_SELI), (float*)(ws + WS_SELW), S, tid, wid, lane)); }
            else { PHM(128, peer_gather_phase(lds, Hb, (cbytes)(ws + WS_TABU) + (size_t)layer * NEXP * (DM / 2), (cbytes)(ws + WS_TABV) + (size_t)layer * NEXP * (DM / 2), (const int*)(ws + WS_SELI), (const float*)(ws + WS_SELW),
                              (const unsigned*)(ws + WS_SCU) + (size_t)layer * NEXP, xs, xo, macc + 5 * DM,
                              layer == 3 ? Ap->in[I_FINAL_G] : Ap->in[I_NORM_G] + (size_t)((layer + 1) * 2) * DM, mod + (size_t)(layer == 3 ? 3 : layer + 1) * BATCH * 6 * DM, Hb, layer == 3, vcu, G, wid, lane)); }
        }
#if MK_ONE_LAUNCH
        if constexpr (TIME_MASK != 0) if (ph + 1 >= ph_hi) { if (ptype & TIME_MASK) t_acc += __builtin_amdgcn_s_memrealtime() - t_ph0; }
        if (ph + 1 < ph_hi) {
            XcdBarrier xbar; xbar.bar = (unsigned*)(Ap->ws + WS_BAR); xbar.x = xb_xcc_id(); xbar.st = (volatile LAS unsigned*)(lds + LDS_XB_OFF);
            if (ph == ph_lo) { cg::this_grid().sync(); if (tid0 == 0) (void)xb_add(&xbar.bar[XB_XCNT(xbar.x)], 1u); }
            else { xcd_barrier(xbar); if constexpr ((DUP_MASK & 0x800) != 0) xcd_barrier(xbar); }
            if constexpr (TIME_MASK != 0) { if (ptype & TIME_MASK) t_acc += __builtin_amdgcn_s_memrealtime() - t_ph0; }
        }
#endif
    }
    if constexpr (TIME_MASK != 0) { const unsigned long long t0 = __builtin_amdgcn_s_memrealtime(); while (__builtin_amdgcn_s_memrealtime() - t0 < 4ull * t_acc) __builtin_amdgcn_s_sleep(8); }
}

extern "C" void kernel_launch(void* const* d_in, const int* in_sizes, int n_in, void* d_out, int out_size, void* d_ws, size_t ws_size, hipStream_t stream) {
    static int grid = 0;
    if (grid == 0) {
        if (n_in != 23 || in_sizes[0] != MTOK * DM || out_size != MTOK * DM || ws_size < WS_END) {
            fprintf(stderr, "kernel_launch: unexpected shapes (n_in %d, in0 %d, out %d, ws %zu; need ws >= %zu); nothing launched\n", n_in, n_in > 0 ? in_sizes[0] : -1, out_size, ws_size, (size_t)WS_END); grid = -1; return; }
        int dev = 0, cus = 0, per_cu = 0;
        if (hipGetDevice(&dev) != hipSuccess || hipDeviceGetAttribute(&cus, hipDeviceAttributeMultiprocessorCount, dev) != hipSuccess) { grid = -1; return; }
        if (hipFuncSetAttribute((const void*)trunk_fwd, hipFuncAttributeMaxDynamicSharedMemorySize, LDS_BYTES) != hipSuccess) { fprintf(stderr, "kernel_launch: hipFuncSetAttribute failed\n"); grid = -1; return; }
        if (hipOccupancyMaxActiveBlocksPerMultiprocessor(&per_cu, (const void*)trunk_fwd, NTHREADS, LDS_BYTES) != hipSuccess || per_cu < 1) { fprintf(stderr, "kernel_launch: occupancy query says %d blocks per CU\n", per_cu); (void)hipGetLastError(); grid = -1; return; }
        grid = cus * (per_cu < 1 ? 1 : 1);
    }
    if (grid < 0) return;
    Args a{};
    for (int i = 0; i < 23; ++i) a.in[i] = (const float*)d_in[i];
    a.out = (float*)d_out; a.ws = (unsigned char*)d_ws;
#if MK_ONE_LAUNCH
    a.ph_lo = 0; a.ph_hi = NPHASES;
    void* args[] = {&a};
    hipError_t e = hipLaunchCooperativeKernel((const void*)trunk_fwd, dim3(grid), dim3(NTHREADS), args, LDS_BYTES, stream);
    if (e != hipSuccess) fprintf(stderr, "cooperative launch failed: %s (grid %d)\n", hipGetErrorString(e), grid);
#else
    for (int ph = 0; ph < NPHASES; ++ph) { a.ph_lo = ph; a.ph_hi = ph + 1; hipLaunchKernelGGL(trunk_fwd, dim3(grid), dim3(NTHREADS), LDS_BYTES, stream, a); }
#endif
}
```
